# Optimizing an MI355X kernel written in HIP

```python
import math
import jax
import jax.numpy as jnp
from jax import lax
import numpy as np

D_MODEL = 1024
BATCH = 8
SEQ = 2048
DEPTH = 2

A_HEADS = 4
A_NOPE = 64
A_ROPE = 32
A_V = 64
Q_LORA = 192
KV_LORA = 128
ROPE_THETA = 10000.0
B_HEADS = 4
B_DIM = 64
DILATED_PATTERNS = ((128, 1), (512, 4), (2048, 16))
DIL_BLOCK = 128
C_HEADS = 4
C_DIM = 64
IDX_HEADS = 8
IDX_DIM = 32
IDX_TOPK_MAX = 256
D_HEADS = 4
D_QK = 32
D_V = 64
BRANCH_WIDTH = 256
MIX_WIDTH = 4 * BRANCH_WIDTH
NUM_BUCKETS = 32
MAX_DISTANCE = 2048
BIAS_HEADS = B_HEADS + C_HEADS + D_HEADS
Q_BLOCK = 128
NEG_INF = -1e30
EPS = 1e-6
SPLIT_SIZES = (
    Q_LORA, KV_LORA, A_ROPE, BRANCH_WIDTH,
    BRANCH_WIDTH, BRANCH_WIDTH, BRANCH_WIDTH, BRANCH_WIDTH,
    BRANCH_WIDTH, BRANCH_WIDTH, BRANCH_WIDTH, IDX_HEADS * IDX_DIM, IDX_DIM, IDX_HEADS, BRANCH_WIDTH,
    2 * D_HEADS * D_QK, 2 * D_HEADS * D_QK, D_HEADS * D_V, BRANCH_WIDTH,
)
IN_COLS = sum(SPLIT_SIZES)

kernel_name = "hybrid_mla_dilated_dsa_diff_parallel_heads"


def rms_norm(x, g):
    xf = x.astype(jnp.float32)
    y = xf * lax.rsqrt(jnp.mean(xf * xf, axis=-1, keepdims=True) + EPS)
    return (y * g.astype(jnp.float32)).astype(x.dtype)


def t5_bucket(rel):
    n = jnp.maximum(rel, 0)
    max_exact = NUM_BUCKETS // 2
    nf = jnp.maximum(n, max_exact).astype(jnp.float32)
    large = max_exact + (jnp.log(nf / max_exact) / math.log(MAX_DISTANCE / max_exact)
                         * (NUM_BUCKETS - max_exact)).astype(jnp.int32)
    large = jnp.minimum(large, NUM_BUCKETS - 1)
    return jnp.where(n < max_exact, n, large)


def rope_tables(seq):
    inv = ROPE_THETA ** (-jnp.arange(0, A_ROPE, 2, dtype=jnp.float32) / A_ROPE)
    ang = jnp.arange(seq, dtype=jnp.float32)[:, None] * inv[None, :]
    return jnp.cos(ang), jnp.sin(ang)


def apply_rope(x, cos, sin):
    half = x.shape[-1] // 2
    x1, x2 = x[..., :half], x[..., half:]
    return jnp.concatenate([x1 * cos - x2 * sin, x1 * sin + x2 * cos], axis=-1).astype(x.dtype)


def to_blocks(a, nb):
    return jnp.moveaxis(a.reshape((a.shape[0], nb, Q_BLOCK) + a.shape[2:]), 1, 0)


def from_blocks(a):
    a = jnp.moveaxis(a, 0, 1)
    return a.reshape((a.shape[0], a.shape[1] * a.shape[2]) + a.shape[3:])


def mla_branch(c_q, c_kv, k_rope, q_norm, kv_norm, w_uq, w_ukv, cos, sin):
    bsz, seq, _ = c_q.shape
    q = (rms_norm(c_q, q_norm) @ w_uq).reshape(bsz, seq, A_HEADS, A_NOPE + A_ROPE)
    q_nope = q[..., :A_NOPE]
    q_rope = apply_rope(q[..., A_NOPE:], cos[:, None, :], sin[:, None, :])
    kv = (rms_norm(c_kv, kv_norm) @ w_ukv).reshape(bsz, seq, A_HEADS, A_NOPE + A_V)
    k_nope, v = kv[..., :A_NOPE], kv[..., A_NOPE:]
    k_rope = apply_rope(k_rope, cos, sin)
    scale = (A_NOPE + A_ROPE) ** -0.5
    keys = jnp.arange(seq)

    def block(args):
        qn, qr, t0 = args
        t = t0 + jnp.arange(Q_BLOCK)
        s = (jnp.einsum('bqhd,bshd->bhqs', qn, k_nope)
             + jnp.einsum('bqhd,bsd->bhqs', qr, k_rope)).astype(jnp.float32) * scale
        s = jnp.where(keys[None, :] <= t[:, None], s, NEG_INF)
        p = jax.nn.softmax(s, axis=-1).astype(v.dtype)
        return jnp.einsum('bhqs,bshd->bqhd', p, v)

    nb = seq // Q_BLOCK
    o = lax.map(block, (to_blocks(q_nope, nb), to_blocks(q_rope, nb), jnp.arange(nb) * Q_BLOCK))
    return from_blocks(o).reshape(bsz, seq, A_HEADS * A_V)


def dilated_pattern(q, k, v, table, window, dilation):
    bsz, seq, heads, dim = q.shape
    n = seq // dilation
    span = window // dilation
    blk = min(DIL_BLOCK, n)
    nb = -(-n // blk)
    n_pad = nb * blk

    def to_classes(a):
        a = jnp.swapaxes(a.reshape(bsz, n, dilation, heads, dim), 1, 2)
        a = jnp.pad(a, ((0, 0), (0, 0), (0, n_pad - n), (0, 0), (0, 0)))
        return a.reshape(bsz, dilation, nb, blk, heads, dim)

    def with_prev(a):
        prev = jnp.pad(a, ((0, 0), (0, 0), (1, 0), (0, 0), (0, 0), (0, 0)))[:, :, :-1]
        return jnp.concatenate([prev, a], axis=3)

    qc = to_classes(q)
    kc = with_prev(to_classes(k))
    vc = with_prev(to_classes(v))
    rel = jnp.arange(blk)[:, None] + blk - jnp.arange(2 * blk)[None, :]
    bias = jnp.transpose(table[t5_bucket(rel * dilation)], (0, 2, 1))
    in_band = ((rel >= 0) & (rel <= span))[None, :, None, :]
    has_prev = (jnp.arange(nb)[:, None, None, None] > 0) | (jnp.arange(2 * blk)[None, None, None, :] >= blk)
    mask = in_band & has_prev
    s = jnp.einsum('brnqhd,brnkhd->brnqhk', qc, kc).astype(jnp.float32) * (dim ** -0.5)
    s = jnp.where(mask, s + bias, NEG_INF)
    m = jnp.max(s, axis=-1)
    p = jnp.exp(s - m[..., None])
    l = jnp.sum(p, axis=-1)
    o = jnp.einsum('brnqhk,brnkhd->brnqhd', p, vc.astype(jnp.float32)) / l[..., None]

    def from_classes(a):
        a = a.reshape((bsz, dilation, n_pad) + a.shape[4:])[:, :, :n]
        return jnp.swapaxes(a, 1, 2).reshape((bsz, seq) + a.shape[3:])

    return from_classes(o), from_classes(m), from_classes(l)


def dilated_branch(q, k, v, table):
    bsz, seq, _ = q.shape
    q, k, v = (a.reshape(bsz, seq, B_HEADS, B_DIM) for a in (q, k, v))
    outs = [dilated_pattern(q, k, v, table, w, d) for (w, d) in DILATED_PATTERNS]
    o = jnp.stack([r[0] for r in outs])
    m = jnp.stack([r[1] for r in outs])
    l = jnp.stack([r[2] for r in outs])
    wts = l * jnp.exp(m - jnp.max(m, axis=0, keepdims=True))
    y = jnp.sum(wts[..., None] * o, axis=0) / jnp.sum(wts, axis=0)[..., None]
    return y.reshape(bsz, seq, BRANCH_WIDTH).astype(q.dtype)


def sparse_branch(q, k, v, q_idx, k_idx, w_idx, table, k_top):
    bsz, seq, _ = q.shape
    q = q.reshape(bsz, seq, C_HEADS, C_DIM)
    k = k.reshape(bsz, seq, C_HEADS, C_DIM)
    v = v.reshape(bsz, seq, C_HEADS, C_DIM)
    q_idx = q_idx.reshape(bsz, seq, IDX_HEADS, IDX_DIM)
    keys = jnp.arange(seq)
    gather = jax.vmap(lambda kb, ib: kb[ib])

    def block(args):
        qb, qib, wb, t0 = args
        t = t0 + jnp.arange(Q_BLOCK)
        logit = jnp.einsum('bqhd,bsd->bqhs', qib, k_idx).astype(jnp.float32) * (IDX_DIM ** -0.5)
        score = jnp.einsum('bqhs,bqh->bqs', jax.nn.relu(logit), wb.astype(jnp.float32)) * (IDX_HEADS ** -0.5)
        score = jnp.where(keys[None, None, :] <= t[None, :, None], score, NEG_INF)
        _, idx = lax.top_k(score, k_top)
        k_sel = gather(k, idx)
        v_sel = gather(v, idx)
        s = jnp.einsum('bqhd,bqkhd->bhqk', qb, k_sel).astype(jnp.float32) * (C_DIM ** -0.5)
        rel = t[None, :, None] - idx
        bias = jnp.transpose(table[t5_bucket(rel)], (0, 3, 1, 2))
        s = jnp.where((rel >= 0)[:, None], s + bias, NEG_INF)
        p = jax.nn.softmax(s, axis=-1).astype(v.dtype)
        return jnp.einsum('bhqk,bqkhd->bqhd', p, v_sel)

    nb = seq // Q_BLOCK
    o = lax.map(block, (to_blocks(q, nb), to_blocks(q_idx, nb), to_blocks(w_idx, nb),
                        jnp.arange(nb) * Q_BLOCK))
    return from_blocks(o).reshape(bsz, seq, BRANCH_WIDTH)


def diff_branch(q, k, v, lam_params, subln, table, lambda_init):
    bsz, seq, _ = q.shape
    q = q.reshape(bsz, seq, D_HEADS, 2, D_QK)
    k = k.reshape(bsz, seq, D_HEADS, 2, D_QK)
    v = v.reshape(bsz, seq, D_HEADS, D_V)
    lp = lam_params.astype(jnp.float32)
    lam = jnp.exp(jnp.sum(lp[0] * lp[1])) - jnp.exp(jnp.sum(lp[2] * lp[3])) + lambda_init
    keys = jnp.arange(seq)

    def block(args):
        qb, t0 = args
        t = t0 + jnp.arange(Q_BLOCK)
        s = jnp.einsum('bqhmd,bshmd->bmhqs', qb, k).astype(jnp.float32) * (D_QK ** -0.5)
        rel = t[:, None] - keys[None, :]
        bias = jnp.transpose(table[t5_bucket(rel)], (2, 0, 1))
        s = jnp.where(rel >= 0, s + bias, NEG_INF)
        p = jax.nn.softmax(s, axis=-1)
        a = p[:, 0] - lam * p[:, 1]
        return jnp.einsum('bhqs,bshd->bqhd', a.astype(v.dtype), v)

    nb = seq // Q_BLOCK
    o = from_blocks(lax.map(block, (to_blocks(q, nb), jnp.arange(nb) * Q_BLOCK)))
    o = rms_norm(o, subln) * (1.0 - lambda_init)
    return o.reshape(bsz, seq, BRANCH_WIDTH)


def setup_inputs(seed: int = 0) -> dict:
    key = jax.random.key(seed)
    ks = jax.random.split(key, 12)
    nrm = jax.random.normal
    return {
        "x": nrm(ks[0], (BATCH, SEQ, D_MODEL), jnp.float32),
        "w_in": nrm(ks[1], (DEPTH, D_MODEL, IN_COLS), jnp.float32) * D_MODEL ** -0.5,
        "w_out": nrm(ks[2], (DEPTH, MIX_WIDTH, D_MODEL), jnp.float32) * MIX_WIDTH ** -0.5,
        "norm_pre": 1.0 + 0.05 * nrm(ks[3], (DEPTH, D_MODEL), jnp.float32),
        "norm_post": 1.0 + 0.05 * nrm(ks[4], (DEPTH, D_MODEL), jnp.float32),
        "mla_q_norm": 1.0 + 0.05 * nrm(ks[5], (DEPTH, Q_LORA), jnp.float32),
        "mla_kv_norm": 1.0 + 0.05 * nrm(ks[6], (DEPTH, KV_LORA), jnp.float32),
        "mla_w_uq": nrm(ks[7], (DEPTH, Q_LORA, A_HEADS * (A_NOPE + A_ROPE)), jnp.float32) * Q_LORA ** -0.5,
        "mla_w_ukv": nrm(ks[8], (DEPTH, KV_LORA, A_HEADS * (A_NOPE + A_V)), jnp.float32) * KV_LORA ** -0.5,
        "diff_lambda": 0.1 * nrm(ks[9], (DEPTH, 4, D_QK), jnp.float32),
        "diff_subln": 1.0 + 0.05 * nrm(ks[10], (DEPTH, D_V), jnp.float32),
        "rel_bias": 0.5 * nrm(ks[11], (NUM_BUCKETS, BIAS_HEADS), jnp.float32),
    }


def reference(x, w_in, w_out, norm_pre, norm_post, mla_q_norm, mla_kv_norm, mla_w_uq, mla_w_ukv,
              diff_lambda, diff_subln, rel_bias):
    seq = x.shape[1]
    cos, sin = rope_tables(seq)
    k_top = min(IDX_TOPK_MAX, seq // 4)
    bias_b = rel_bias[:, :B_HEADS]
    bias_c = rel_bias[:, B_HEADS:B_HEADS + C_HEADS]
    bias_d = rel_bias[:, B_HEADS + C_HEADS:]
    split_at = np.cumsum(SPLIT_SIZES)[:-1].tolist()
    h = x
    for layer in range(DEPTH):
        u = rms_norm(h, norm_pre[layer])
        proj = u @ w_in[layer]
        (a_cq, a_ckv, a_kr, a_g,
         b_q, b_k, b_v, b_g,
         c_q, c_k, c_v, c_qi, c_ki, c_wi, c_g,
         d_q, d_k, d_v, d_g) = jnp.split(proj, split_at, axis=-1)
        y_a = mla_branch(a_cq, a_ckv, a_kr, mla_q_norm[layer], mla_kv_norm[layer],
                         mla_w_uq[layer], mla_w_ukv[layer], cos, sin) * jax.nn.silu(a_g)
        y_b = dilated_branch(b_q, b_k, b_v, bias_b) * jax.nn.silu(b_g)
        y_c = sparse_branch(c_q, c_k, c_v, c_qi, c_ki, c_wi, bias_c, k_top) * jax.nn.silu(c_g)
        lambda_init = 0.8 - 0.6 * math.exp(-0.3 * layer)
        y_d = diff_branch(d_q, d_k, d_v, diff_lambda[layer], diff_subln[layer], bias_d,
                          lambda_init) * jax.nn.silu(d_g)
        y = jnp.concatenate([y_a, y_b, y_c, y_d], axis=-1) @ w_out[layer]
        h = h + rms_norm(y, norm_post[layer])
    return h
```

```cpp
#include <hip/hip_runtime.h>
#include <stdint.h>
#include <math.h>

typedef _Float16 h16;
#define DEVI __device__ __forceinline__

constexpr int NB = 8, SEQ = 2048, DM = 1024, NT = NB * SEQ, INC = 3976, MYC = 4096;
constexpr float LOG2E = 1.4426950408889634f;
constexpr float EPS = 1e-6f;

__host__ __device__ constexpr int ref_col(int my) {
    if (my < 352) return my;
    if (my < 384) return -1;
    if (my < 640) return 352 + (my - 384);
    if (my < 896) return 1376 + (my - 640);
    if (my < 1152) return 2696 + (my - 896);
    if (my < 1408) return 3720 + (my - 1152);
    if (my < 1664) return 608 + (my - 1408);
    if (my < 1920) return 864 + (my - 1664);
    if (my < 2176) return 1632 + (my - 1920);
    if (my < 2432) return 1888 + (my - 2176);
    if (my < 2688) return 2952 + (my - 2432);
    if (my < 2944) return 3208 + (my - 2688);
    if (my < 3200) return 1120 + (my - 2944);
    if (my < 3456) return 2144 + (my - 3200);
    if (my < 3712) return 3464 + (my - 3456);
    if (my < 3968) return 2400 + (my - 3712);
    if (my < 4000) return 2656 + (my - 3968);
    if (my < 4008) return 2688 + (my - 4000);
    return -1;
}

constexpr size_t MiB = 1024 * 1024;
constexpr size_t OFF_CTL = 0;
constexpr size_t OFF_RSTD = 64 * 1024;
constexpr size_t OFF_BIAS = 128 * 1024;
constexpr size_t OFF_COS = 256 * 1024;
constexpr size_t OFF_SIN = 384 * 1024;
constexpr size_t OFF_CA = 1 * MiB;
constexpr size_t OFF_GATE = OFF_CA + 12 * MiB;
constexpr size_t OFF_QB = OFF_GATE + 32 * MiB;
constexpr size_t OFF_KB = OFF_QB + 8 * MiB;
constexpr size_t OFF_QC = OFF_KB + 8 * MiB;
constexpr size_t OFF_KC = OFF_QC + 8 * MiB;
constexpr size_t OFF_QD = OFF_KC + 8 * MiB;
constexpr size_t OFF_KD = OFF_QD + 8 * MiB;
constexpr size_t OFF_IDX = OFF_KD + 8 * MiB;
constexpr size_t OFF_MIX = OFF_IDX + 10 * MiB;
constexpr size_t OFF_VTMP = OFF_MIX + 32 * MiB;
constexpr size_t OFF_QA = OFF_VTMP + 24 * MiB;
constexpr size_t OFF_KA = OFF_QA + 12 * MiB;
constexpr size_t OFF_VA = OFF_KA + 8 * MiB;
constexpr size_t OFF_KAR = OFF_VA + 8 * MiB;
constexpr size_t OFF_MASK = OFF_KAR + 1 * MiB;
constexpr size_t OFF_END = OFF_MASK + 4 * MiB;
static_assert(OFF_END <= 256 * MiB, "ws map");

struct Route { int buf; int dcol; int pitch; float scale; int silu; };
__host__ __device__ inline Route route(int my) {
    Route r{-1, 0, 0, 1.f, 0};
    if (my < 384) { r.buf = 0; r.dcol = my; r.pitch = 384; }
    else if (my < 1408) { r.buf = 1; r.dcol = my - 384; r.pitch = 1024; r.silu = 1; }
    else if (my < 1664) { r.buf = 2; r.dcol = my - 1408; r.pitch = 256; r.scale = 0.125f * LOG2E; }
    else if (my < 1920) { r.buf = 3; r.dcol = my - 1664; r.pitch = 256; }
    else if (my < 2176) { r.buf = 4; r.dcol = my - 1920; r.pitch = 256; r.scale = 0.125f * LOG2E; }
    else if (my < 2432) { r.buf = 5; r.dcol = my - 2176; r.pitch = 256; }
    else if (my < 2688) { r.buf = 6; r.dcol = my - 2432; r.pitch = 256; r.scale = 0.17677669529663687f * LOG2E; }
    else if (my < 2944) { r.buf = 7; r.dcol = my - 2688; r.pitch = 256; }
    else if (my < 3712) { r.buf = 8; r.dcol = my - 2944; r.pitch = 768; }
    else if (my < 4032) { r.buf = 9; r.dcol = my - 3712; r.pitch = 320; r.scale = (my < 3968) ? 0.17677669529663687f : 1.f; }
    return r;
}
DEVI size_t buf_off(int buf) {
    switch (buf) {
        case 0: return OFF_CA; case 1: return OFF_GATE; case 2: return OFF_QB; case 3: return OFF_KB; case 4: return OFF_QC;
        case 5: return OFF_KC; case 6: return OFF_QD; case 7: return OFF_KD; case 8: return OFF_VTMP; default: return OFF_IDX;
    }
}

__device__ __constant__ int kBucketStart[16] = {16, 22, 30, 40, 54, 73, 99, 134, 182, 246, 332, 450, 609, 825, 1117, 1513};
DEVI int t5_bucket(int n) {
    if (n < 16) return n;
    int b = 16;
#pragma unroll
    for (int j = 1; j < 16; ++j) b += (n >= kBucketStart[j]) ? 1 : 0;
    return b;
}

__global__ void k_tables(const float* __restrict__ rel_bias, float* biasTab, float* cosT, float* sinT) {
    int i = blockIdx.x * blockDim.x + threadIdx.x;
    if (i < 12 * 2048) { int hh = i / 2048, n = i % 2048; biasTab[i] = rel_bias[t5_bucket(n) * 12 + hh] * LOG2E; }
    if (i < 2048 * 16) {
        int pos = i / 16, j = i % 16;
        float inv = (float)pow(10000.0, -(double)(2 * j) / 32.0);
        float ang = (float)pos * inv;
        cosT[i] = (float)cos((double)ang); sinT[i] = (float)sin((double)ang);
    }
}

__global__ void k_rowstat(const float* __restrict__ h, float* __restrict__ rstd) {
    int row = blockIdx.x * 4 + (threadIdx.x >> 6), lane = threadIdx.x & 63;
    const float4* p = (const float4*)(h + (size_t)row * DM);
    float s = 0.f;
    for (int i = lane; i < 256; i += 64) { float4 v = p[i]; s += v.x * v.x + v.y * v.y + v.z * v.z + v.w * v.w; }
    for (int o = 32; o; o >>= 1) s += __shfl_xor(s, o);
    if (lane == 0) rstd[row] = rsqrtf(s / DM + EPS);
}

__global__ void __launch_bounds__(256) k_gemm_in_naive(const float* __restrict__ h, const float* __restrict__ g, const float* __restrict__ w,
                                                       const float* __restrict__ rstd, unsigned char* ws) {
    __shared__ float As[16][68], Bs[16][68];
    const int tid = threadIdx.x, ty = tid >> 4, tx = tid & 15;
    const int col0 = blockIdx.x * 64, row0 = blockIdx.y * 64;
    float acc[4][4] = {};
    const int ar = tid >> 2, ak = (tid & 3) * 4;
    const int bk = tid >> 4, bc = (tid & 15) * 4;
    int rc[4];
#pragma unroll
    for (int j = 0; j < 4; ++j) rc[j] = ref_col(col0 + bc + j);
    for (int k0 = 0; k0 < DM; k0 += 16) {
        float4 av = *(const float4*)(h + (size_t)(row0 + ar) * DM + k0 + ak);
        float4 gv = *(const float4*)(g + k0 + ak);
        As[ak + 0][ar] = av.x * gv.x; As[ak + 1][ar] = av.y * gv.y; As[ak + 2][ar] = av.z * gv.z; As[ak + 3][ar] = av.w * gv.w;
#pragma unroll
        for (int j = 0; j < 4; ++j) Bs[bk][bc + j] = rc[j] >= 0 ? w[(size_t)(k0 + bk) * INC + rc[j]] : 0.f;
        __syncthreads();
#pragma unroll
        for (int kk = 0; kk < 16; ++kk) {
            float a[4], b[4];
#pragma unroll
            for (int i = 0; i < 4; ++i) { a[i] = As[kk][ty * 4 + i]; b[i] = Bs[kk][tx * 4 + i]; }
#pragma unroll
            for (int i = 0; i < 4; ++i)
#pragma unroll
                for (int j = 0; j < 4; ++j) acc[i][j] += a[i] * b[j];
        }
        __syncthreads();
    }
    const int c = col0 + tx * 4;
    Route r = route(c);
    if (r.buf < 0) return;
    h16* dst = (h16*)(ws + buf_off(r.buf));
#pragma unroll
    for (int i = 0; i < 4; ++i) {
        int row = row0 + ty * 4 + i; float rs = rstd[row];
#pragma unroll
        for (int j = 0; j < 4; ++j) {
            float v = acc[i][j] * rs * r.scale;
            if (r.silu) v = v / (1.f + __expf(-v));
            dst[(size_t)row * r.pitch + r.dcol + j] = (h16)v;
        }
    }
}

__global__ void __launch_bounds__(128) k_mla_naive(const h16* __restrict__ cA, const float* __restrict__ qn, const float* __restrict__ kvn,
                                                   const float* __restrict__ wuq, const float* __restrict__ wukv,
                                                   const float* __restrict__ cosT, const float* __restrict__ sinT,
                                                   h16* qA, h16* kA, h16* vA, h16* kAr) {
    __shared__ float cq[192], ckv[128], kr[32], qout[384], red[2];
    const int tok = blockIdx.x, s = tok % SEQ, tid = threadIdx.x;
    for (int i = tid; i < 192; i += 128) cq[i] = (float)cA[(size_t)tok * 384 + i];
    ckv[tid] = (float)cA[(size_t)tok * 384 + 192 + tid];
    if (tid < 32) kr[tid] = (float)cA[(size_t)tok * 384 + 320 + tid];
    __syncthreads();
    if (tid < 64) {
        float a = 0.f; for (int i = tid; i < 192; i += 64) a += cq[i] * cq[i];
        for (int o = 32; o; o >>= 1) a += __shfl_xor(a, o);
        if (tid == 0) red[0] = rsqrtf(a / 192.f + EPS);
    } else {
        int l = tid - 64; float a = 0.f; for (int i = l; i < 128; i += 64) a += ckv[i] * ckv[i];
        for (int o = 32; o; o >>= 1) a += __shfl_xor(a, o);
        if (l == 0) red[1] = rsqrtf(a / 128.f + EPS);
    }
    __syncthreads();
    for (int i = tid; i < 192; i += 128) cq[i] = cq[i] * red[0] * qn[i];
    ckv[tid] = ckv[tid] * red[1] * kvn[tid];
    __syncthreads();
    for (int n = tid; n < 384; n += 128) { float a = 0.f; for (int k = 0; k < 192; ++k) a += cq[k] * wuq[k * 384 + n]; qout[n] = a; }
    __syncthreads();
    const float qs = 0.10206207261596577f * LOG2E;
    for (int idx = tid; idx < 384; idx += 128) {
        int hh = idx / 96, j = idx % 96; float val;
        if (j < 64) val = qout[idx];
        else { int r = j - 64, i = r & 15; float x1 = qout[hh * 96 + 64 + i], x2 = qout[hh * 96 + 80 + i], c = cosT[s * 16 + i], sn = sinT[s * 16 + i];
               val = r < 16 ? x1 * c - x2 * sn : x1 * sn + x2 * c; }
        qA[(size_t)tok * 384 + idx] = (h16)(val * qs);
    }
    for (int n = tid; n < 512; n += 128) {
        float a = 0.f; for (int k = 0; k < 128; ++k) a += ckv[k] * wukv[k * 512 + n];
        int hh = n / 128, j = n % 128;
        if (j < 64) kA[(size_t)tok * 256 + hh * 64 + j] = (h16)a; else vA[(size_t)tok * 256 + hh * 64 + j - 64] = (h16)a;
    }
    if (tid < 32) { int i = tid & 15; float x1 = kr[i], x2 = kr[16 + i], c = cosT[s * 16 + i], sn = sinT[s * 16 + i];
        kAr[(size_t)tok * 32 + tid] = (h16)(tid < 16 ? x1 * c - x2 * sn : x1 * sn + x2 * c); }
}

__global__ void __launch_bounds__(64) k_attnA_naive(const h16* __restrict__ qA, const h16* __restrict__ kA, const h16* __restrict__ vA, const h16* __restrict__ kAr,
                                                    const h16* __restrict__ gate, h16* mix) {
    const int chunk = blockIdx.x % 32, bh = blockIdx.x / 32, b = bh / 4, hh = bh % 4;
    const int t = chunk * 64 + threadIdx.x; const size_t tok = (size_t)b * SEQ + t;
    float q[96], o[64];
#pragma unroll
    for (int i = 0; i < 96; ++i) q[i] = (float)qA[tok * 384 + hh * 96 + i];
#pragma unroll
    for (int i = 0; i < 64; ++i) o[i] = 0.f;
    float m = -1e30f, l = 0.f;
    const int smax = chunk * 64 + 63;
    for (int s = 0; s <= smax; ++s) {
        const size_t ks = (size_t)b * SEQ + s;
        const h16* kp = kA + ks * 256 + hh * 64; const h16* kr = kAr + ks * 32; const h16* vp = vA + ks * 256 + hh * 64;
        float sc = 0.f;
#pragma unroll
        for (int i = 0; i < 64; ++i) sc += q[i] * (float)kp[i];
#pragma unroll
        for (int i = 0; i < 32; ++i) sc += q[64 + i] * (float)kr[i];
        if (s <= t) {
            if (sc > m) { float a = exp2f(m - sc); l *= a;
#pragma unroll
                for (int i = 0; i < 64; ++i) o[i] *= a;
                m = sc; }
            float p = exp2f(sc - m); l += p;
#pragma unroll
            for (int i = 0; i < 64; ++i) o[i] += p * (float)vp[i];
        }
    }
    float il = 1.f / l;
#pragma unroll
    for (int i = 0; i < 64; ++i) mix[tok * 1024 + hh * 64 + i] = (h16)(o[i] * il * (float)gate[tok * 1024 + hh * 64 + i]);
}

__global__ void __launch_bounds__(64) k_attnB_naive(const h16* __restrict__ qB, const h16* __restrict__ kB, const h16* __restrict__ vt,
                                                    const float* __restrict__ biasTab, const h16* __restrict__ gate, h16* mix) {
    const int chunk = blockIdx.x % 32, bh = blockIdx.x / 32, b = bh / 4, hh = bh % 4;
    const int t = chunk * 64 + threadIdx.x; const size_t tok = (size_t)b * SEQ + t;
    float q[64], o[64];
#pragma unroll
    for (int i = 0; i < 64; ++i) { q[i] = (float)qB[tok * 256 + hh * 64 + i]; o[i] = 0.f; }
    float m = -1e30f, l = 0.f;
    const float* bt = biasTab + hh * 2048;
    for (int pat = 0; pat < 3; ++pat) {
        const int d = pat == 0 ? 1 : (pat == 1 ? 4 : 16);
        for (int k = 0; k <= 128; ++k) {
            const int s = t - k * d; if (s < 0) break;
            const size_t ks = (size_t)b * SEQ + s;
            const h16* kp = kB + ks * 256 + hh * 64; const h16* vp = vt + ks * 768 + hh * 64;
            float sc = bt[k * d];
#pragma unroll
            for (int i = 0; i < 64; ++i) sc += q[i] * (float)kp[i];
            if (sc > m) { float a = exp2f(m - sc); l *= a;
#pragma unroll
                for (int i = 0; i < 64; ++i) o[i] *= a;
                m = sc; }
            float p = exp2f(sc - m); l += p;
#pragma unroll
            for (int i = 0; i < 64; ++i) o[i] += p * (float)vp[i];
        }
    }
    float il = 1.f / l;
#pragma unroll
    for (int i = 0; i < 64; ++i) mix[tok * 1024 + 256 + hh * 64 + i] = (h16)(o[i] * il * (float)gate[tok * 1024 + 256 + hh * 64 + i]);
}

__global__ void __launch_bounds__(256) k_topk_naive(const h16* __restrict__ idx, unsigned* __restrict__ mask) {
    __shared__ float sc[2048]; __shared__ float qi[256]; __shared__ float wi[8]; __shared__ unsigned msk[64];
    const int tok = blockIdx.x, b = tok / SEQ, t = tok % SEQ, tid = threadIdx.x;
    qi[tid] = (float)idx[(size_t)tok * 320 + tid];
    if (tid < 8) wi[tid] = (float)idx[(size_t)tok * 320 + 288 + tid] * 0.35355339059327373f;
    if (tid < 64) msk[tid] = 0u;
    __syncthreads();
    for (int s = tid; s <= t; s += 256) {
        const h16* kp = idx + ((size_t)b * SEQ + s) * 320 + 256;
        float kk[32];
#pragma unroll
        for (int d = 0; d < 32; ++d) kk[d] = (float)kp[d];
        float score = 0.f;
#pragma unroll
        for (int hh = 0; hh < 8; ++hh) { float lg = 0.f;
#pragma unroll
            for (int d = 0; d < 32; ++d) lg += qi[hh * 32 + d] * kk[d];
            score += fmaxf(lg, 0.f) * wi[hh]; }
        sc[s] = score;
    }
    __syncthreads();
    if (t + 1 <= 256) {
        for (int i = tid; i <= t; i += 256) atomicOr(&msk[i >> 5], 1u << (i & 31));
    } else {
        for (int i = tid; i <= t; i += 256) {
            const float si = sc[i]; int rank = 0;
            for (int j = 0; j <= t; ++j) { float sj = sc[j]; rank += (sj > si || (sj == si && j < i)) ? 1 : 0; }
            if (rank < 256) atomicOr(&msk[i >> 5], 1u << (i & 31));
        }
    }
    __syncthreads();
    if (tid < 64) mask[(size_t)tok * 64 + tid] = msk[tid];
}

__global__ void __launch_bounds__(64) k_attnC_naive(const h16* __restrict__ qC, const h16* __restrict__ kC, const h16* __restrict__ vt, const unsigned* __restrict__ mask,
                                                    const float* __restrict__ biasTab, const h16* __restrict__ gate, h16* mix) {
    const int chunk = blockIdx.x % 32, bh = blockIdx.x / 32, b = bh / 4, hh = bh % 4;
    const int t = chunk * 64 + threadIdx.x; const size_t tok = (size_t)b * SEQ + t;
    float q[64], o[64];
#pragma unroll
    for (int i = 0; i < 64; ++i) { q[i] = (float)qC[tok * 256 + hh * 64 + i]; o[i] = 0.f; }
    float m = -1e30f, l = 0.f;
    const float* bt = biasTab + (4 + hh) * 2048;
    const int smax = chunk * 64 + 63;
    unsigned mw = 0;
    for (int s = 0; s <= smax; ++s) {
        if ((s & 31) == 0) mw = mask[tok * 64 + (s >> 5)];
        const size_t ks = (size_t)b * SEQ + s;
        const h16* kp = kC + ks * 256 + hh * 64; const h16* vp = vt + ks * 768 + 256 + hh * 64;
        float sc = 0.f;
#pragma unroll
        for (int i = 0; i < 64; ++i) sc += q[i] * (float)kp[i];
        if (s <= t && ((mw >> (s & 31)) & 1u)) {
            sc += bt[t - s];
            if (sc > m) { float a = exp2f(m - sc); l *= a;
#pragma unroll
                for (int i = 0; i < 64; ++i) o[i] *= a;
                m = sc; }
            float p = exp2f(sc - m); l += p;
#pragma unroll
            for (int i = 0; i < 64; ++i) o[i] += p * (float)vp[i];
        }
    }
    float il = 1.f / l;
#pragma unroll
    for (int i = 0; i < 64; ++i) mix[tok * 1024 + 512 + hh * 64 + i] = (h16)(o[i] * il * (float)gate[tok * 1024 + 512 + hh * 64 + i]);
}

__global__ void __launch_bounds__(64) k_attnD_naive(const h16* __restrict__ qD, const h16* __restrict__ kD, const h16* __restrict__ vt,
                                                    const float* __restrict__ biasTab, const float* __restrict__ lam_p, const float* __restrict__ subln,
                                                    float lambda_init, const h16* __restrict__ gate, h16* mix) {
    const int chunk = blockIdx.x % 32, bh = blockIdx.x / 32, b = bh / 4, hh = bh % 4;
    const int t = chunk * 64 + threadIdx.x; const size_t tok = (size_t)b * SEQ + t;
    float q[64], o1[64], o2[64];
#pragma unroll
    for (int i = 0; i < 64; ++i) { q[i] = (float)qD[tok * 256 + hh * 64 + i]; o1[i] = 0.f; o2[i] = 0.f; }
    float m1 = -1e30f, l1 = 0.f, m2 = -1e30f, l2 = 0.f;
    float a1 = 0.f, a2 = 0.f;
    for (int i = 0; i < 32; ++i) { a1 += lam_p[i] * lam_p[32 + i]; a2 += lam_p[64 + i] * lam_p[96 + i]; }
    const float lam = expf(a1) - expf(a2) + lambda_init;
    const float* bt = biasTab + (8 + hh) * 2048;
    const int smax = chunk * 64 + 63;
    for (int s = 0; s <= smax; ++s) {
        const size_t ks = (size_t)b * SEQ + s;
        const h16* kp = kD + ks * 256 + hh * 64; const h16* vp = vt + ks * 768 + 512 + hh * 64;
        float s1 = 0.f, s2 = 0.f;
#pragma unroll
        for (int i = 0; i < 32; ++i) { s1 += q[i] * (float)kp[i]; s2 += q[32 + i] * (float)kp[32 + i]; }
        if (s <= t) {
            float bb = bt[t - s]; s1 += bb; s2 += bb;
            if (s1 > m1) { float a = exp2f(m1 - s1); l1 *= a;
#pragma unroll
                for (int i = 0; i < 64; ++i) o1[i] *= a;
                m1 = s1; }
            if (s2 > m2) { float a = exp2f(m2 - s2); l2 *= a;
#pragma unroll
                for (int i = 0; i < 64; ++i) o2[i] *= a;
                m2 = s2; }
            float p1 = exp2f(s1 - m1), p2 = exp2f(s2 - m2); l1 += p1; l2 += p2;
#pragma unroll
            for (int i = 0; i < 64; ++i) { float v = (float)vp[i]; o1[i] += p1 * v; o2[i] += p2 * v; }
        }
    }
    float i1 = 1.f / l1, i2 = lam / l2, ss = 0.f;
#pragma unroll
    for (int i = 0; i < 64; ++i) { o1[i] = o1[i] * i1 - o2[i] * i2; ss += o1[i] * o1[i]; }
    float rs = rsqrtf(ss / 64.f + EPS) * (1.f - lambda_init);
#pragma unroll
    for (int i = 0; i < 64; ++i) mix[tok * 1024 + 768 + hh * 64 + i] = (h16)(o1[i] * rs * subln[i] * (float)gate[tok * 1024 + 768 + hh * 64 + i]);
}

__global__ void __launch_bounds__(256) k_out_naive(const h16* __restrict__ mix, const float* __restrict__ w, const float* __restrict__ g,
                                                   const float* h_in, float* h_out) {
    __shared__ float A[8][1024]; __shared__ float red[8][4];
    const int tid = threadIdx.x, row0 = blockIdx.x * 8;
    for (int i = tid; i < 8 * 1024; i += 256) A[i >> 10][i & 1023] = (float)mix[(size_t)(row0 + (i >> 10)) * 1024 + (i & 1023)];
    __syncthreads();
    float acc[8][4] = {};
    for (int k = 0; k < 1024; ++k) {
        float wv[4];
#pragma unroll
        for (int j = 0; j < 4; ++j) wv[j] = w[(size_t)k * 1024 + tid + 256 * j];
#pragma unroll
        for (int r = 0; r < 8; ++r) { float a = A[r][k];
#pragma unroll
            for (int j = 0; j < 4; ++j) acc[r][j] += a * wv[j]; }
    }
#pragma unroll
    for (int r = 0; r < 8; ++r) {
        float s = 0.f;
#pragma unroll
        for (int j = 0; j < 4; ++j) s += acc[r][j] * acc[r][j];
        for (int o = 32; o; o >>= 1) s += __shfl_xor(s, o);
        if ((tid & 63) == 0) red[r][tid >> 6] = s;
    }
    __syncthreads();
#pragma unroll
    for (int r = 0; r < 8; ++r) {
        float rs = rsqrtf((red[r][0] + red[r][1] + red[r][2] + red[r][3]) / 1024.f + EPS);
#pragma unroll
        for (int j = 0; j < 4; ++j) { int n = tid + 256 * j; size_t o = (size_t)(row0 + r) * 1024 + n; h_out[o] = h_in[o] + acc[r][j] * rs * g[n]; }
    }
}

extern "C" void kernel_launch(void* const* d_in, const int* in_sizes, int n_in, void* d_out, int out_size, void* d_ws, size_t ws_size, hipStream_t stream) {
    const float* x = (const float*)d_in[0];
    const float* w_in = (const float*)d_in[1];
    const float* w_out = (const float*)d_in[2];
    const float* norm_pre = (const float*)d_in[3];
    const float* norm_post = (const float*)d_in[4];
    const float* q_norm = (const float*)d_in[5];
    const float* kv_norm = (const float*)d_in[6];
    const float* w_uq = (const float*)d_in[7];
    const float* w_ukv = (const float*)d_in[8];
    const float* diff_lambda = (const float*)d_in[9];
    const float* diff_subln = (const float*)d_in[10];
    const float* rel_bias = (const float*)d_in[11];
    unsigned char* ws = (unsigned char*)d_ws;
    float* out = (float*)d_out;
    float* rstd = (float*)(ws + OFF_RSTD); float* biasTab = (float*)(ws + OFF_BIAS); float* cosT = (float*)(ws + OFF_COS); float* sinT = (float*)(ws + OFF_SIN);
    h16* cA = (h16*)(ws + OFF_CA); h16* gate = (h16*)(ws + OFF_GATE);
    h16* qB = (h16*)(ws + OFF_QB); h16* kB = (h16*)(ws + OFF_KB); h16* qC = (h16*)(ws + OFF_QC); h16* kC = (h16*)(ws + OFF_KC);
    h16* qD = (h16*)(ws + OFF_QD); h16* kD = (h16*)(ws + OFF_KD); h16* idx = (h16*)(ws + OFF_IDX); h16* mix = (h16*)(ws + OFF_MIX);
    h16* vt = (h16*)(ws + OFF_VTMP); h16* qA = (h16*)(ws + OFF_QA); h16* kA = (h16*)(ws + OFF_KA); h16* vA = (h16*)(ws + OFF_VA); h16* kAr = (h16*)(ws + OFF_KAR);
    unsigned* mask = (unsigned*)(ws + OFF_MASK);

    k_tables<<<(2048 * 16 + 255) / 256, 256, 0, stream>>>(rel_bias, biasTab, cosT, sinT);
    for (int layer = 0; layer < 2; ++layer) {
        const float* h_in = layer == 0 ? x : out;
        const float lambda_init = 0.8f - 0.6f * (float)exp(-0.3 * layer);
        k_rowstat<<<NT / 4, 256, 0, stream>>>(h_in, rstd);
        k_gemm_in_naive<<<dim3(MYC / 64, NT / 64), 256, 0, stream>>>(h_in, norm_pre + layer * DM, w_in + (size_t)layer * DM * INC, rstd, ws);
        k_mla_naive<<<NT, 128, 0, stream>>>(cA, q_norm + layer * 192, kv_norm + layer * 128, w_uq + (size_t)layer * 192 * 384, w_ukv + (size_t)layer * 128 * 512, cosT, sinT, qA, kA, vA, kAr);
        k_attnA_naive<<<NT * 4 / 64, 64, 0, stream>>>(qA, kA, vA, kAr, gate, mix);
        k_attnB_naive<<<NT * 4 / 64, 64, 0, stream>>>(qB, kB, vt, biasTab, gate, mix);
        k_topk_naive<<<NT, 256, 0, stream>>>(idx, mask);
        k_attnC_naive<<<NT * 4 / 64, 64, 0, stream>>>(qC, kC, vt, mask, biasTab, gate, mix);
        k_attnD_naive<<<NT * 4 / 64, 64, 0, stream>>>(qD, kD, vt, biasTab, diff_lambda + layer * 128, diff_subln + layer * 64, lambda_init, gate, mix);
        k_out_naive<<<NT / 8, 256, 0, stream>>>(mix, w_out + (size_t)layer * DM * DM, norm_post + layer * DM, h_in, out);
    }
}
```

```cpp
#include <hip/hip_runtime.h>
#include <stdint.h>
#include <math.h>

typedef _Float16 h16;
#define DEVI __device__ __forceinline__

constexpr int NB = 8, SEQ = 2048, DM = 1024, NT = NB * SEQ, INC = 3976, MYC = 4096;
constexpr float LOG2E = 1.4426950408889634f;
constexpr float EPS = 1e-6f;

__host__ __device__ constexpr int ref_col(int my) {
    if (my < 352) return my;
    if (my < 384) return -1;
    if (my < 640) return 352 + (my - 384);
    if (my < 896) return 1376 + (my - 640);
    if (my < 1152) return 2696 + (my - 896);
    if (my < 1408) return 3720 + (my - 1152);
    if (my < 1664) return 608 + (my - 1408);
    if (my < 1920) return 864 + (my - 1664);
    if (my < 2176) return 1632 + (my - 1920);
    if (my < 2432) return 1888 + (my - 2176);
    if (my < 2688) return 2952 + (my - 2432);
    if (my < 2944) return 3208 + (my - 2688);
    if (my < 3200) return 1120 + (my - 2944);
    if (my < 3456) return 2144 + (my - 3200);
    if (my < 3712) return 3464 + (my - 3456);
    if (my < 3968) return 2400 + (my - 3712);
    if (my < 4000) return 2656 + (my - 3968);
    if (my < 4008) return 2688 + (my - 4000);
    return -1;
}

constexpr size_t MiB = 1024 * 1024;
constexpr size_t OFF_CTL = 0;
constexpr size_t OFF_RSTD = 64 * 1024;
constexpr size_t OFF_BIAS = 128 * 1024;
constexpr size_t OFF_COS = 256 * 1024;
constexpr size_t OFF_SIN = 384 * 1024;
constexpr size_t OFF_CA = 1 * MiB;
constexpr size_t OFF_GATE = OFF_CA + 12 * MiB;
constexpr size_t OFF_QB = OFF_GATE + 32 * MiB;
constexpr size_t OFF_KB = OFF_QB + 8 * MiB;
constexpr size_t OFF_QC = OFF_KB + 8 * MiB;
constexpr size_t OFF_KC = OFF_QC + 8 * MiB;
constexpr size_t OFF_QD = OFF_KC + 8 * MiB;
constexpr size_t OFF_KD = OFF_QD + 8 * MiB;
constexpr size_t OFF_IDX = OFF_KD + 8 * MiB;
constexpr size_t OFF_MIX = OFF_IDX + 10 * MiB;
constexpr size_t OFF_VTMP = OFF_MIX + 32 * MiB;
constexpr size_t OFF_QA = OFF_VTMP + 24 * MiB;
constexpr size_t OFF_KA = OFF_QA + 12 * MiB;
constexpr size_t OFF_VA = OFF_KA + 8 * MiB;
constexpr size_t OFF_KAR = OFF_VA + 8 * MiB;
constexpr size_t OFF_MASK = OFF_KAR + 1 * MiB;
constexpr size_t OFF_END = OFF_MASK + 4 * MiB;
static_assert(OFF_END <= 256 * MiB, "ws map");

struct Route { int buf; int dcol; int pitch; float scale; int silu; };
__host__ __device__ inline Route route(int my) {
    Route r{-1, 0, 0, 1.f, 0};
    if (my < 384) { r.buf = 0; r.dcol = my; r.pitch = 384; }
    else if (my < 1408) { r.buf = 1; r.dcol = my - 384; r.pitch = 1024; r.silu = 1; }
    else if (my < 1664) { r.buf = 2; r.dcol = my - 1408; r.pitch = 256; r.scale = 0.125f * LOG2E; }
    else if (my < 1920) { r.buf = 3; r.dcol = my - 1664; r.pitch = 256; }
    else if (my < 2176) { r.buf = 4; r.dcol = my - 1920; r.pitch = 256; r.scale = 0.125f * LOG2E; }
    else if (my < 2432) { r.buf = 5; r.dcol = my - 2176; r.pitch = 256; }
    else if (my < 2688) { r.buf = 6; r.dcol = my - 2432; r.pitch = 256; r.scale = 0.17677669529663687f * LOG2E; }
    else if (my < 2944) { r.buf = 7; r.dcol = my - 2688; r.pitch = 256; }
    else if (my < 3712) { r.buf = 8; r.dcol = my - 2944; r.pitch = 768; }
    else if (my < 4032) { r.buf = 9; r.dcol = my - 3712; r.pitch = 320; r.scale = (my < 3968) ? 0.17677669529663687f : 1.f; }
    return r;
}
DEVI size_t buf_off(int buf) {
    switch (buf) {
        case 0: return OFF_CA; case 1: return OFF_GATE; case 2: return OFF_QB; case 3: return OFF_KB; case 4: return OFF_QC;
        case 5: return OFF_KC; case 6: return OFF_QD; case 7: return OFF_KD; case 8: return OFF_VTMP; default: return OFF_IDX;
    }
}

__device__ __constant__ int kBucketStart[16] = {16, 22, 30, 40, 54, 73, 99, 134, 182, 246, 332, 450, 609, 825, 1117, 1513};
DEVI int t5_bucket(int n) {
    if (n < 16) return n;
    int b = 16;
#pragma unroll
    for (int j = 1; j < 16; ++j) b += (n >= kBucketStart[j]) ? 1 : 0;
    return b;
}


#define XB_TMO      128
#define XB_XCNT(j)  (256  + 64 * (j))
#define XB_XSUB(j)  (1280 + 64 * (j))
#define XB_XGEN(j)  (2304 + 64 * (j))
#define XB_TOP      3328
#define XB_TOPGEN   3392
#define XCD_BAR_WORDS 3456
#define XB_SPIN_CAP (1u << 18)
#define LAS __attribute__((address_space(3)))
__device__ __forceinline__ unsigned xb_ld(unsigned* p)              { return __hip_atomic_load(p, __ATOMIC_RELAXED, __HIP_MEMORY_SCOPE_AGENT); }
__device__ __forceinline__ unsigned xb_add(unsigned* p, unsigned v) { return __hip_atomic_fetch_add(p, v, __ATOMIC_RELAXED, __HIP_MEMORY_SCOPE_AGENT); }
__device__ __forceinline__ unsigned xb_xcc_id() { return (unsigned)__builtin_amdgcn_s_getreg((3 << 11) | 20) & 0xFu; }
#define XB_SPIN(cond, bar) do { unsigned _sp = 0; while (cond) { __builtin_amdgcn_s_sleep(1); \
    if ((++_sp & 255u) == 0u) { if (xb_ld(&(bar)[XB_TMO])) break; if (_sp > XB_SPIN_CAP) { atomicAdd(&(bar)[XB_TMO], 1u); break; } } } } while (0)
struct XcdBarrier { unsigned* bar; unsigned x; volatile LAS unsigned* st; };
__device__ __forceinline__ XcdBarrier xcd_barrier_post(unsigned* bar, volatile LAS unsigned* st) {
    XcdBarrier b; b.bar = bar; b.x = xb_xcc_id(); b.st = st;
    if (threadIdx.x == 0) (void)xb_add(&bar[XB_XCNT(b.x)], 1u);
    return b;
}
__device__ __forceinline__ void xcd_barrier_complete(unsigned* bar, unsigned x, unsigned& nloc, unsigned& nx) {
    const unsigned G = gridDim.x * gridDim.y * gridDim.z;
    unsigned sum, cnt, mine, sp = 0u;
    for (;;) {
        sum = 0u; cnt = 0u; mine = 0u;
#pragma unroll
        for (unsigned j = 0; j < 16; ++j) { const unsigned c = xb_ld(&bar[XB_XCNT(j)]); sum += c; cnt += (c > 0u) ? 1u : 0u; mine = (j == x) ? c : mine; }
        if (sum == G) break;
        __builtin_amdgcn_s_sleep(1);
        if ((++sp & 255u) == 0u) { if (xb_ld(&bar[XB_TMO])) break; if (sp > XB_SPIN_CAP) { atomicAdd(&bar[XB_TMO], 1u); break; } }
    }
    nloc = mine > 0u ? mine : 1u; nx = cnt > 0u ? cnt : 1u;
}
__device__ __forceinline__ void xcd_barrier(const XcdBarrier& b) {
    asm volatile("s_waitcnt vmcnt(0)" ::: "memory");
    __syncthreads();
    if (threadIdx.x == 0) {
        unsigned* bar = b.bar;
        __builtin_amdgcn_s_waitcnt(0);
        unsigned nloc = b.st[0], nx = b.st[1];
        if (nloc == 0u) { xcd_barrier_complete(bar, b.x, nloc, nx); b.st[0] = nloc; b.st[1] = nx; }
        const unsigned old = xb_add(&bar[XB_XSUB(b.x)], 1u);
        const unsigned gen = old / nloc;
        if (old + 1u == (gen + 1u) * nloc) {
            __builtin_amdgcn_fence(__ATOMIC_RELEASE, "agent");
            asm volatile("s_waitcnt vmcnt(0)" ::: "memory");
            const unsigned og = xb_add(&bar[XB_TOP], 1u);
            const unsigned tg = og / nx;
            if (og + 1u == (tg + 1u) * nx) xb_add(&bar[XB_TOPGEN], 1u);
            else XB_SPIN(xb_ld(&bar[XB_TOPGEN]) == tg, bar);
            __builtin_amdgcn_fence(__ATOMIC_ACQUIRE, "agent");
            xb_add(&bar[XB_XGEN(b.x)], 1u);
            asm volatile("s_waitcnt vmcnt(0)" ::: "memory");
        } else {
            XB_SPIN(xb_ld(&bar[XB_XGEN(b.x)]) == gen, bar);
            __builtin_amdgcn_fence(__ATOMIC_ACQUIRE, "agent");
            asm volatile("s_waitcnt vmcnt(0)" ::: "memory");
        }
    }
    __syncthreads();
}

constexpr int NTHR = 512, NWAVE = 8;
DEVI int otid() { int t = threadIdx.x; asm volatile("" : "+v"(t)); return t; }
constexpr int LDS_BYTES = 144 * 1024;
struct Params { const float* in[12]; float* out; unsigned char* ws; };

DEVI void ph_tables(const float* __restrict__ rel_bias, float* biasTab, float* cosT, float* sinT) {
    for (int i = blockIdx.x * NTHR + threadIdx.x; i < 2048 * 16; i += gridDim.x * NTHR) {
        if (i < 12 * 2048) { int hh = i / 2048, n = i % 2048; biasTab[i] = rel_bias[t5_bucket(n) * 12 + hh] * LOG2E; }
        int pos = i / 16, j = i % 16;
        float inv = (float)pow(10000.0, -(double)(2 * j) / 32.0);
        float ang = (float)pos * inv;
        cosT[i] = (float)cos((double)ang); sinT[i] = (float)sin((double)ang);
    }
}

DEVI void ph_rowstat(const float* h, float* rstd) {
    const int lane = threadIdx.x & 63, gw = blockIdx.x * NWAVE + (threadIdx.x >> 6), nw = gridDim.x * NWAVE;
    for (int row = gw; row < NT; row += nw) {
        const float4* p = (const float4*)(h + (size_t)row * DM);
        float s = 0.f;
        for (int i = lane; i < 256; i += 64) { float4 v = p[i]; s += v.x * v.x + v.y * v.y + v.z * v.z + v.w * v.w; }
        for (int o = 32; o; o >>= 1) s += __shfl_xor(s, o);
        if (lane == 0) rstd[row] = rsqrtf(s / DM + EPS);
    }
}

DEVI void ph_gemm_in_naive(const float* h, const float* __restrict__ g, const float* __restrict__ w, const float* rstd, unsigned char* ws, unsigned char* lds) {
    const int t_ = otid(); const int sub = t_ >> 8, tid = t_ & 255, ty = tid >> 4, tx = tid & 15;
    float (*As)[68] = (float (*)[68])(lds + sub * 2 * 16 * 68 * 4);
    float (*Bs)[68] = (float (*)[68])(lds + sub * 2 * 16 * 68 * 4 + 16 * 68 * 4);
    for (int it = blockIdx.x; it < 64 * 256 / 2; it += gridDim.x) {
        const int vb = it * 2 + sub, col0 = (vb & 63) * 64, row0 = (vb >> 6) * 64;
        float acc[4][4] = {};
        const int ar = tid >> 2, ak = (tid & 3) * 4, bk = tid >> 4, bc = (tid & 15) * 4;
        int rc[4];
#pragma unroll
        for (int j = 0; j < 4; ++j) rc[j] = ref_col(col0 + bc + j);
        for (int k0 = 0; k0 < DM; k0 += 16) {
            float4 av = *(const float4*)(h + (size_t)(row0 + ar) * DM + k0 + ak);
            float4 gv = *(const float4*)(g + k0 + ak);
            As[ak + 0][ar] = av.x * gv.x; As[ak + 1][ar] = av.y * gv.y; As[ak + 2][ar] = av.z * gv.z; As[ak + 3][ar] = av.w * gv.w;
#pragma unroll
            for (int j = 0; j < 4; ++j) Bs[bk][bc + j] = rc[j] >= 0 ? w[(size_t)(k0 + bk) * INC + rc[j]] : 0.f;
            __syncthreads();
#pragma unroll
            for (int kk = 0; kk < 16; ++kk) {
                float a[4], b[4];
#pragma unroll
                for (int i = 0; i < 4; ++i) { a[i] = As[kk][ty * 4 + i]; b[i] = Bs[kk][tx * 4 + i]; }
#pragma unroll
                for (int i = 0; i < 4; ++i)
#pragma unroll
                    for (int j = 0; j < 4; ++j) acc[i][j] += a[i] * b[j];
            }
            __syncthreads();
        }
        const int c = col0 + tx * 4;
        Route r = route(c);
        if (r.buf >= 0) {
            h16* dst = (h16*)(ws + buf_off(r.buf));
#pragma unroll
            for (int i = 0; i < 4; ++i) {
                int row = row0 + ty * 4 + i; float rs = rstd[row];
#pragma unroll
                for (int j = 0; j < 4; ++j) {
                    float v = acc[i][j] * rs * r.scale;
                    if (r.silu) v = v / (1.f + __expf(-v));
                    dst[(size_t)row * r.pitch + r.dcol + j] = (h16)v;
                }
            }
        }
    }
}

DEVI void ph_mla_naive(const h16* cA, const float* __restrict__ qn, const float* __restrict__ kvn, const float* __restrict__ wuq, const float* __restrict__ wukv,
                       const float* cosT, const float* sinT, h16* qA, h16* kA, h16* vA, h16* kAr, unsigned char* lds) {
    const int t_ = otid(); const int sub = t_ >> 7, tid = t_ & 127;
    float* cq = (float*)(lds + sub * 3072); float* ckv = cq + 192; float* kr = ckv + 128; float* qout = kr + 32; float* red = qout + 384;
    for (int it = blockIdx.x; it < NT / 4; it += gridDim.x) {
        const int tok = it * 4 + sub, s = tok % SEQ;
        __syncthreads();
        for (int i = tid; i < 192; i += 128) cq[i] = (float)cA[(size_t)tok * 384 + i];
        ckv[tid] = (float)cA[(size_t)tok * 384 + 192 + tid];
        if (tid < 32) kr[tid] = (float)cA[(size_t)tok * 384 + 320 + tid];
        __syncthreads();
        if (tid < 64) {
            float a = 0.f; for (int i = tid; i < 192; i += 64) a += cq[i] * cq[i];
            for (int o = 32; o; o >>= 1) a += __shfl_xor(a, o);
            if (tid == 0) red[0] = rsqrtf(a / 192.f + EPS);
        } else {
            int l = tid - 64; float a = 0.f; for (int i = l; i < 128; i += 64) a += ckv[i] * ckv[i];
            for (int o = 32; o; o >>= 1) a += __shfl_xor(a, o);
            if (l == 0) red[1] = rsqrtf(a / 128.f + EPS);
        }
        __syncthreads();
        for (int i = tid; i < 192; i += 128) cq[i] = cq[i] * red[0] * qn[i];
        ckv[tid] = ckv[tid] * red[1] * kvn[tid];
        __syncthreads();
        for (int n = tid; n < 384; n += 128) { float a = 0.f; for (int k = 0; k < 192; ++k) a += cq[k] * wuq[k * 384 + n]; qout[n] = a; }
        __syncthreads();
        const float qs = 0.10206207261596577f * LOG2E;
        for (int idx = tid; idx < 384; idx += 128) {
            int hh = idx / 96, j = idx % 96; float val;
            if (j < 64) val = qout[idx];
            else { int r = j - 64, i = r & 15; float x1 = qout[hh * 96 + 64 + i], x2 = qout[hh * 96 + 80 + i], c = cosT[s * 16 + i], sn = sinT[s * 16 + i];
                   val = r < 16 ? x1 * c - x2 * sn : x1 * sn + x2 * c; }
            qA[(size_t)tok * 384 + idx] = (h16)(val * qs);
        }
        for (int n = tid; n < 512; n += 128) {
            float a = 0.f; for (int k = 0; k < 128; ++k) a += ckv[k] * wukv[k * 512 + n];
            int hh = n / 128, j = n % 128;
            if (j < 64) kA[(size_t)tok * 256 + hh * 64 + j] = (h16)a; else vA[(size_t)tok * 256 + hh * 64 + j - 64] = (h16)a;
        }
        if (tid < 32) { int i = tid & 15; float x1 = kr[i], x2 = kr[16 + i], c = cosT[s * 16 + i], sn = sinT[s * 16 + i];
            kAr[(size_t)tok * 32 + tid] = (h16)(tid < 16 ? x1 * c - x2 * sn : x1 * sn + x2 * c); }
    }
}

DEVI void ph_attnA_naive(int vb, const h16* qA, const h16* kA, const h16* vA, const h16* kAr, const h16* gate, h16* mix) {
    const int chunk = 63 - (vb % 64), bh = vb / 64, b = bh / 4, hh = bh % 4, half = (threadIdx.x >> 5) & 1;
    const int t = chunk * 32 + (threadIdx.x & 31); const size_t tok = (size_t)b * SEQ + t;
    float q[96], o[32];
#pragma unroll
    for (int i = 0; i < 96; ++i) q[i] = (float)qA[tok * 384 + hh * 96 + i];
#pragma unroll
    for (int i = 0; i < 32; ++i) o[i] = 0.f;
    float m = -1e30f, l = 0.f;
    const int smax = chunk * 32 + 31;
    for (int s = 0; s <= smax; ++s) {
        const size_t ks = (size_t)b * SEQ + s;
        const h16* kp = kA + ks * 256 + hh * 64; const h16* kr = kAr + ks * 32; const h16* vp = vA + ks * 256 + hh * 64 + half * 32;
        float sc = 0.f;
#pragma unroll
        for (int i = 0; i < 64; ++i) sc += q[i] * (float)kp[i];
#pragma unroll
        for (int i = 0; i < 32; ++i) sc += q[64 + i] * (float)kr[i];
        if (s <= t) {
            if (sc > m) { float a = exp2f(m - sc); l *= a;
#pragma unroll
                for (int i = 0; i < 32; ++i) o[i] *= a;
                m = sc; }
            float p = exp2f(sc - m); l += p;
#pragma unroll
            for (int i = 0; i < 32; ++i) o[i] += p * (float)vp[i];
        }
    }
    float il = 1.f / l;
#pragma unroll
    for (int i = 0; i < 32; ++i) mix[tok * 1024 + hh * 64 + half * 32 + i] = (h16)(o[i] * il * (float)gate[tok * 1024 + hh * 64 + half * 32 + i]);
}

DEVI void ph_attnB_naive(int vb, const h16* qB, const h16* kB, const h16* vt, const float* biasTab, const h16* gate, h16* mix) {
    const int chunk = vb % 32, bh = vb / 32, b = bh / 4, hh = bh % 4;
    const int t = chunk * 64 + (threadIdx.x & 63); const size_t tok = (size_t)b * SEQ + t;
    float q[64], o[64];
#pragma unroll
    for (int i = 0; i < 64; ++i) { q[i] = (float)qB[tok * 256 + hh * 64 + i]; o[i] = 0.f; }
    float m = -1e30f, l = 0.f;
    const float* bt = biasTab + hh * 2048;
    for (int pat = 0; pat < 3; ++pat) {
        const int d = pat == 0 ? 1 : (pat == 1 ? 4 : 16);
        for (int k = 0; k <= 128; ++k) {
            const int s = t - k * d; if (s < 0) break;
            const size_t ks = (size_t)b * SEQ + s;
            const h16* kp = kB + ks * 256 + hh * 64; const h16* vp = vt + ks * 768 + hh * 64;
            float sc = bt[k * d];
#pragma unroll
            for (int i = 0; i < 64; ++i) sc += q[i] * (float)kp[i];
            if (sc > m) { float a = exp2f(m - sc); l *= a;
#pragma unroll
                for (int i = 0; i < 64; ++i) o[i] *= a;
                m = sc; }
            float p = exp2f(sc - m); l += p;
#pragma unroll
            for (int i = 0; i < 64; ++i) o[i] += p * (float)vp[i];
        }
    }
    float il = 1.f / l;
#pragma unroll
    for (int i = 0; i < 64; ++i) mix[tok * 1024 + 256 + hh * 64 + i] = (h16)(o[i] * il * (float)gate[tok * 1024 + 256 + hh * 64 + i]);
}

DEVI void ph_topk_naive(const h16* idx, unsigned* mask, unsigned char* lds) {
    const int t_ = otid(); const int sub = t_ >> 8, tid = t_ & 255;
    float* sc = (float*)(lds + sub * 9728); float* qi = sc + 2048; float* wi = qi + 256; unsigned* msk = (unsigned*)(wi + 8);
    for (int it = blockIdx.x; it < NT / 2; it += gridDim.x) {
        const int tok = (NT / 2 - 1 - it) * 2 + sub, b = tok / SEQ, t = tok % SEQ;
        __syncthreads();
        qi[tid] = (float)idx[(size_t)tok * 320 + tid];
        if (tid < 8) wi[tid] = (float)idx[(size_t)tok * 320 + 288 + tid] * 0.35355339059327373f;
        if (tid < 64) msk[tid] = 0u;
        __syncthreads();
        for (int s = tid; s <= t; s += 256) {
            const h16* kp = idx + ((size_t)b * SEQ + s) * 320 + 256;
            float kk[32];
#pragma unroll
            for (int d = 0; d < 32; ++d) kk[d] = (float)kp[d];
            float score = 0.f;
#pragma unroll 1
            for (int hh = 0; hh < 8; ++hh) { float lg = 0.f;
#pragma unroll
                for (int d = 0; d < 32; ++d) lg += qi[hh * 32 + d] * kk[d];
                score += fmaxf(lg, 0.f) * wi[hh]; }
            sc[s] = score;
        }
        __syncthreads();
        if (t + 1 <= 256) {
            for (int i = tid; i <= t; i += 256) atomicOr(&msk[i >> 5], 1u << (i & 31));
        } else {
            for (int i = tid; i <= t; i += 256) {
                const float si = sc[i]; int rank = 0;
                for (int j = 0; j <= t; ++j) { float sj = sc[j]; rank += (sj > si || (sj == si && j < i)) ? 1 : 0; }
                if (rank < 256) atomicOr(&msk[i >> 5], 1u << (i & 31));
            }
        }
        __syncthreads();
        if (tid < 64) mask[(size_t)tok * 64 + tid] = msk[tid];
    }
}

DEVI void ph_attnC_naive(int vb, const h16* qC, const h16* kC, const h16* vt, const unsigned* mask, const float* biasTab, const h16* gate, h16* mix) {
    const int chunk = 31 - (vb % 32), bh = vb / 32, b = bh / 4, hh = bh % 4;
    const int t = chunk * 64 + (threadIdx.x & 63); const size_t tok = (size_t)b * SEQ + t;
    float q[64], o[64];
#pragma unroll
    for (int i = 0; i < 64; ++i) { q[i] = (float)qC[tok * 256 + hh * 64 + i]; o[i] = 0.f; }
    float m = -1e30f, l = 0.f;
    const float* bt = biasTab + (4 + hh) * 2048;
    const int smax = chunk * 64 + 63;
    unsigned mw = 0;
    for (int s = 0; s <= smax; ++s) {
        if ((s & 31) == 0) mw = mask[tok * 64 + (s >> 5)];
        const size_t ks = (size_t)b * SEQ + s;
        const h16* kp = kC + ks * 256 + hh * 64; const h16* vp = vt + ks * 768 + 256 + hh * 64;
        float sc = 0.f;
#pragma unroll
        for (int i = 0; i < 64; ++i) sc += q[i] * (float)kp[i];
        if (s <= t && ((mw >> (s & 31)) & 1u)) {
            sc += bt[t - s];
            if (sc > m) { float a = exp2f(m - sc); l *= a;
#pragma unroll
                for (int i = 0; i < 64; ++i) o[i] *= a;
                m = sc; }
            float p = exp2f(sc - m); l += p;
#pragma unroll
            for (int i = 0; i < 64; ++i) o[i] += p * (float)vp[i];
        }
    }
    float il = 1.f / l;
#pragma unroll
    for (int i = 0; i < 64; ++i) mix[tok * 1024 + 512 + hh * 64 + i] = (h16)(o[i] * il * (float)gate[tok * 1024 + 512 + hh * 64 + i]);
}

DEVI void ph_attnD_naive(int vb, const h16* qD, const h16* kD, const h16* vt, const float* biasTab, const float* __restrict__ lam_p, const float* __restrict__ subln,
                         float lambda_init, const h16* gate, h16* mix) {
    const int chunk = 63 - (vb % 64), bh = vb / 64, b = bh / 4, hh = bh % 4, mp = (threadIdx.x >> 5) & 1;
    const int t = chunk * 32 + (threadIdx.x & 31); const size_t tok = (size_t)b * SEQ + t;
    float q[32], o[64];
#pragma unroll
    for (int i = 0; i < 32; ++i) q[i] = (float)qD[tok * 256 + hh * 64 + mp * 32 + i];
#pragma unroll
    for (int i = 0; i < 64; ++i) o[i] = 0.f;
    float m = -1e30f, l = 0.f;
    float a1 = 0.f, a2 = 0.f;
    for (int i = 0; i < 32; ++i) { a1 += lam_p[i] * lam_p[32 + i]; a2 += lam_p[64 + i] * lam_p[96 + i]; }
    const float lam = expf(a1) - expf(a2) + lambda_init;
    const float* bt = biasTab + (8 + hh) * 2048;
    const int smax = chunk * 32 + 31;
    for (int s = 0; s <= smax; ++s) {
        const size_t ks = (size_t)b * SEQ + s;
        const h16* kp = kD + ks * 256 + hh * 64 + mp * 32; const h16* vp = vt + ks * 768 + 512 + hh * 64;
        float sc = 0.f;
#pragma unroll
        for (int i = 0; i < 32; ++i) sc += q[i] * (float)kp[i];
        if (s <= t) {
            sc += bt[t - s];
            if (sc > m) { float a = exp2f(m - sc); l *= a;
#pragma unroll
                for (int i = 0; i < 64; ++i) o[i] *= a;
                m = sc; }
            float p = exp2f(sc - m); l += p;
#pragma unroll
            for (int i = 0; i < 64; ++i) o[i] += p * (float)vp[i];
        }
    }
    const float sgn = mp ? -lam : 1.f; const float il = sgn / l;
    float ss = 0.f;
#pragma unroll
    for (int i = 0; i < 64; ++i) { float v = o[i] * il; v += __shfl_xor(v, 32); o[i] = v; ss += v * v; }
    float rs = rsqrtf(ss / 64.f + EPS) * (1.f - lambda_init);
    if (mp == 0) {
#pragma unroll
        for (int i = 0; i < 64; ++i) mix[tok * 1024 + 768 + hh * 64 + i] = (h16)(o[i] * rs * subln[i] * (float)gate[tok * 1024 + 768 + hh * 64 + i]);
    }
}

DEVI void ph_out_naive(const h16* mix, const float* __restrict__ w, const float* __restrict__ g, const float* h_in, float* h_out, unsigned char* lds) {
    const int t_ = otid(); const int sub = t_ >> 8, tid = t_ & 255;
    float (*A)[1024] = (float (*)[1024])(lds + sub * 33024); float (*red)[4] = (float (*)[4])(lds + sub * 33024 + 32768);
    for (int it = blockIdx.x; it < NT / 16; it += gridDim.x) {
        const int row0 = (it * 2 + sub) * 8;
        __syncthreads();
        for (int i = tid; i < 8 * 1024; i += 256) A[i >> 10][i & 1023] = (float)mix[(size_t)(row0 + (i >> 10)) * 1024 + (i & 1023)];
        __syncthreads();
        float acc[8][4] = {};
        for (int k = 0; k < 1024; ++k) {
            float wv[4];
#pragma unroll
            for (int j = 0; j < 4; ++j) wv[j] = w[(size_t)k * 1024 + tid + 256 * j];
#pragma unroll
            for (int r = 0; r < 8; ++r) { float a = A[r][k];
#pragma unroll
                for (int j = 0; j < 4; ++j) acc[r][j] += a * wv[j]; }
        }
#pragma unroll
        for (int r = 0; r < 8; ++r) {
            float s = 0.f;
#pragma unroll
            for (int j = 0; j < 4; ++j) s += acc[r][j] * acc[r][j];
            for (int o = 32; o; o >>= 1) s += __shfl_xor(s, o);
            if ((tid & 63) == 0) red[r][tid >> 6] = s;
        }
        __syncthreads();
#pragma unroll
        for (int r = 0; r < 8; ++r) {
            float rs = rsqrtf((red[r][0] + red[r][1] + red[r][2] + red[r][3]) / 1024.f + EPS);
#pragma unroll
            for (int j = 0; j < 4; ++j) { int n = tid + 256 * j; size_t o = (size_t)(row0 + r) * 1024 + n; h_out[o] = h_in[o] + acc[r][j] * rs * g[n]; }
        }
    }
}

extern __shared__ __attribute__((aligned(16))) unsigned char smem[];

__global__ void __launch_bounds__(NTHR, 2) mega(Params p) {
    unsigned char* ws = p.ws;
    if (threadIdx.x == 0) *(uint4*)smem = make_uint4(0u, 0u, 0u, 0u);
    __syncthreads();
    XcdBarrier bar = xcd_barrier_post((unsigned*)(ws + OFF_CTL), (volatile LAS unsigned*)smem);
    unsigned char* lds = smem + 16;
    const float* x = p.in[0]; const float* w_in = p.in[1]; const float* w_out = p.in[2]; const float* norm_pre = p.in[3]; const float* norm_post = p.in[4];
    const float* q_norm = p.in[5]; const float* kv_norm = p.in[6]; const float* w_uq = p.in[7]; const float* w_ukv = p.in[8];
    const float* diff_lambda = p.in[9]; const float* diff_subln = p.in[10]; const float* rel_bias = p.in[11];
    float* out = p.out;
    float* rstd = (float*)(ws + OFF_RSTD); float* biasTab = (float*)(ws + OFF_BIAS); float* cosT = (float*)(ws + OFF_COS); float* sinT = (float*)(ws + OFF_SIN);
    h16* cA = (h16*)(ws + OFF_CA); h16* gate = (h16*)(ws + OFF_GATE);
    h16* qB = (h16*)(ws + OFF_QB); h16* kB = (h16*)(ws + OFF_KB); h16* qC = (h16*)(ws + OFF_QC); h16* kC = (h16*)(ws + OFF_KC);
    h16* qD = (h16*)(ws + OFF_QD); h16* kD = (h16*)(ws + OFF_KD); h16* idx = (h16*)(ws + OFF_IDX); h16* mix = (h16*)(ws + OFF_MIX);
    h16* vt = (h16*)(ws + OFF_VTMP); h16* qA = (h16*)(ws + OFF_QA); h16* kA = (h16*)(ws + OFF_KA); h16* vA = (h16*)(ws + OFF_VA); h16* kAr = (h16*)(ws + OFF_KAR);
    unsigned* mask = (unsigned*)(ws + OFF_MASK);
    const int gw = blockIdx.x * NWAVE + (threadIdx.x >> 6), nw = gridDim.x * NWAVE;

    ph_tables(rel_bias, biasTab, cosT, sinT);
    for (int layer = 0; layer < 2; ++layer) {
        const float* h_in = layer == 0 ? x : out;
        const float lambda_init = layer == 0 ? 0.2f : 0.35550906759f;
        ph_rowstat(h_in, rstd);
        xcd_barrier(bar);
        ph_gemm_in_naive(h_in, norm_pre + layer * DM, w_in + (size_t)layer * DM * INC, rstd, ws, lds);
        xcd_barrier(bar);
        ph_mla_naive(cA, q_norm + layer * 192, kv_norm + layer * 128, w_uq + (size_t)layer * 192 * 384, w_ukv + (size_t)layer * 128 * 512, cosT, sinT, qA, kA, vA, kAr, lds);
        ph_topk_naive(idx, mask, lds);
        xcd_barrier(bar);
        for (int vb = gw; vb < 2048; vb += nw) ph_attnA_naive(vb, qA, kA, vA, kAr, gate, mix);
        for (int vb = nw - 1 - gw; vb < 2048; vb += nw) ph_attnD_naive(vb, qD, kD, vt, biasTab, diff_lambda + layer * 128, diff_subln + layer * 64, lambda_init, gate, mix);
        for (int vb = gw; vb < 1024; vb += nw) ph_attnC_naive(vb, qC, kC, vt, mask, biasTab, gate, mix);
        for (int vb = nw - 1 - gw; vb < 1024; vb += nw) ph_attnB_naive(vb, qB, kB, vt, biasTab, gate, mix);
        xcd_barrier(bar);
        ph_out_naive(mix, w_out + (size_t)layer * DM * DM, norm_post + layer * DM, h_in, out, lds);
        xcd_barrier(bar);
    }
}

extern "C" void kernel_launch(void* const* d_in, const int* in_sizes, int n_in, void* d_out, int out_size, void* d_ws, size_t ws_size, hipStream_t stream) {
    static int grid = 0;
    if (grid == 0) {
        int dev = 0, cus = 0, per_cu = 0;
        hipGetDevice(&dev);
        hipDeviceGetAttribute(&cus, hipDeviceAttributeMultiprocessorCount, dev);
        hipFuncSetAttribute((const void*)mega, hipFuncAttributeMaxDynamicSharedMemorySize, LDS_BYTES);
        hipOccupancyMaxActiveBlocksPerMultiprocessor(&per_cu, (const void*)mega, NTHR, LDS_BYTES);
        (void)hipGetLastError();
        grid = cus > 0 ? cus : 256;
    }
    hipMemsetAsync((char*)d_ws + OFF_CTL, 0, 16384, stream);
    Params p{};
    for (int i = 0; i < 12; ++i) p.in[i] = (const float*)d_in[i];
    p.out = (float*)d_out; p.ws = (unsigned char*)d_ws;
    hipLaunchKernelGGL(mega, dim3(grid), dim3(NTHR), LDS_BYTES, stream, p);
}
```

```cpp
#include <hip/hip_runtime.h>
#include <stdint.h>
#include <math.h>

typedef _Float16 h16;
#define DEVI __device__ __forceinline__
DEVI int ogw();
DEVI int otid() { int t = threadIdx.x; asm volatile("" : "+v"(t)); return t; }

constexpr int NB = 8, SEQ = 2048, DM = 1024, NT = NB * SEQ, INC = 3976, MYC = 4096;
constexpr float LOG2E = 1.4426950408889634f;
constexpr float EPS = 1e-6f;

DEVI int ogw() { return blockIdx.x * 8 + (otid() >> 6); }
__host__ __device__ constexpr int ref_col(int my) {
    if (my < 352) return my;
    if (my < 384) return -1;
    if (my < 640) return 352 + (my - 384);
    if (my < 896) return 1376 + (my - 640);
    if (my < 1152) return 2696 + (my - 896);
    if (my < 1408) return 3720 + (my - 1152);
    if (my < 1664) return 608 + (my - 1408);
    if (my < 1920) return 864 + (my - 1664);
    if (my < 2176) return 1632 + (my - 1920);
    if (my < 2432) return 1888 + (my - 2176);
    if (my < 2688) return 2952 + (my - 2432);
    if (my < 2944) return 3208 + (my - 2688);
    if (my < 3200) return 1120 + (my - 2944);
    if (my < 3456) return 2144 + (my - 3200);
    if (my < 3712) return 3464 + (my - 3456);
    if (my < 3968) return 2400 + (my - 3712);
    if (my < 4000) return 2656 + (my - 3968);
    if (my < 4008) return 2688 + (my - 4000);
    return -1;
}

constexpr size_t MiB = 1024 * 1024;
constexpr size_t OFF_CTL = 0;
constexpr size_t OFF_RSTD = 64 * 1024;
constexpr size_t OFF_BIAS = 128 * 1024;
constexpr size_t OFF_COS = 256 * 1024;
constexpr size_t OFF_SIN = 384 * 1024;
constexpr size_t OFF_CA = 1 * MiB;
constexpr size_t OFF_GATE = OFF_CA + 12 * MiB;
constexpr size_t OFF_QB = OFF_GATE + 32 * MiB;
constexpr size_t OFF_KB = OFF_QB + 8 * MiB;
constexpr size_t OFF_QC = OFF_KB + 8 * MiB;
constexpr size_t OFF_KC = OFF_QC + 8 * MiB;
constexpr size_t OFF_QD = OFF_KC + 8 * MiB;
constexpr size_t OFF_KD = OFF_QD + 8 * MiB;
constexpr size_t OFF_IDX = OFF_KD + 8 * MiB;
constexpr size_t OFF_MIX = OFF_IDX + 10 * MiB;
constexpr size_t OFF_VTMP = OFF_MIX + 32 * MiB;
constexpr size_t OFF_QA = OFF_VTMP + 24 * MiB;
constexpr size_t OFF_KA = OFF_QA + 12 * MiB;
constexpr size_t OFF_VA = OFF_KA + 8 * MiB;
constexpr size_t OFF_KAR = OFF_VA + 8 * MiB;
constexpr size_t OFF_MASK = OFF_KAR + 1 * MiB;
constexpr size_t OFF_H16 = OFF_MASK + 4 * MiB;
constexpr size_t OFF_WINT = OFF_H16 + 32 * MiB;
constexpr size_t OFF_WOUTT = OFF_WINT + 16 * MiB;
constexpr size_t OFF_WUQT = OFF_WOUTT + 4 * MiB;
constexpr size_t OFF_WUKVT = OFF_WUQT + 512 * 1024;
constexpr size_t OFF_END = OFF_WUKVT + 512 * 1024;
static_assert(OFF_END <= 256 * MiB, "ws map");

struct Route { int buf; int dcol; int pitch; float scale; int silu; };
__host__ __device__ inline Route route(int my) {
    Route r{-1, 0, 0, 1.f, 0};
    if (my < 384) { r.buf = 0; r.dcol = my; r.pitch = 384; }
    else if (my < 1408) { r.buf = 1; r.dcol = my - 384; r.pitch = 1024; r.silu = 1; }
    else if (my < 1664) { r.buf = 2; r.dcol = my - 1408; r.pitch = 256; r.scale = 0.125f * LOG2E; }
    else if (my < 1920) { r.buf = 3; r.dcol = my - 1664; r.pitch = 256; }
    else if (my < 2176) { r.buf = 4; r.dcol = my - 1920; r.pitch = 256; r.scale = 0.125f * LOG2E; }
    else if (my < 2432) { r.buf = 5; r.dcol = my - 2176; r.pitch = 256; }
    else if (my < 2688) { r.buf = 6; r.dcol = my - 2432; r.pitch = 256; r.scale = 0.17677669529663687f * LOG2E; }
    else if (my < 2944) { r.buf = 7; r.dcol = my - 2688; r.pitch = 256; }
    else if (my < 3712) { r.buf = 8; r.dcol = my - 2944; r.pitch = 768; }
    else if (my < 4032) { r.buf = 9; r.dcol = my - 3712; r.pitch = 320; r.scale = (my < 3968) ? 0.17677669529663687f : 1.f; }
    return r;
}
DEVI size_t buf_off(int buf) {
    switch (buf) {
        case 0: return OFF_CA; case 1: return OFF_GATE; case 2: return OFF_QB; case 3: return OFF_KB; case 4: return OFF_QC;
        case 5: return OFF_KC; case 6: return OFF_QD; case 7: return OFF_KD; case 8: return OFF_VTMP; default: return OFF_IDX;
    }
}

__device__ __constant__ int kBucketStart[16] = {16, 22, 30, 40, 54, 73, 99, 134, 182, 246, 332, 450, 609, 825, 1117, 1513};
DEVI int t5_bucket(int n) {
    if (n < 16) return n;
    int b = 16;
#pragma unroll
    for (int j = 1; j < 16; ++j) b += (n >= kBucketStart[j]) ? 1 : 0;
    return b;
}


#define XB_TMO      128
#define XB_XCNT(j)  (256  + 64 * (j))
#define XB_XSUB(j)  (1280 + 64 * (j))
#define XB_XGEN(j)  (2304 + 64 * (j))
#define XB_TOP      3328
#define XB_TOPGEN   3392
#define XCD_BAR_WORDS 3456
#define XB_SPIN_CAP (1u << 18)
#define LAS __attribute__((address_space(3)))
__device__ __forceinline__ unsigned xb_ld(unsigned* p)              { return __hip_atomic_load(p, __ATOMIC_RELAXED, __HIP_MEMORY_SCOPE_AGENT); }
__device__ __forceinline__ unsigned xb_add(unsigned* p, unsigned v) { return __hip_atomic_fetch_add(p, v, __ATOMIC_RELAXED, __HIP_MEMORY_SCOPE_AGENT); }
__device__ __forceinline__ unsigned xb_xcc_id() { return (unsigned)__builtin_amdgcn_s_getreg((3 << 11) | 20) & 0xFu; }
#define XB_SPIN(cond, bar) do { unsigned _sp = 0; while (cond) { __builtin_amdgcn_s_sleep(1); \
    if ((++_sp & 255u) == 0u) { if (xb_ld(&(bar)[XB_TMO])) break; if (_sp > XB_SPIN_CAP) { atomicAdd(&(bar)[XB_TMO], 1u); break; } } } } while (0)
struct XcdBarrier { unsigned* bar; unsigned x; volatile LAS unsigned* st; };
__device__ __forceinline__ XcdBarrier xcd_barrier_post(unsigned* bar, volatile LAS unsigned* st) {
    XcdBarrier b; b.bar = bar; b.x = xb_xcc_id(); b.st = st;
    if (threadIdx.x == 0) (void)xb_add(&bar[XB_XCNT(b.x)], 1u);
    return b;
}
__device__ __forceinline__ void xcd_barrier_complete(unsigned* bar, unsigned x, unsigned& nloc, unsigned& nx) {
    const unsigned G = gridDim.x * gridDim.y * gridDim.z;
    unsigned sum, cnt, mine, sp = 0u;
    for (;;) {
        sum = 0u; cnt = 0u; mine = 0u;
#pragma unroll
        for (unsigned j = 0; j < 16; ++j) { const unsigned c = xb_ld(&bar[XB_XCNT(j)]); sum += c; cnt += (c > 0u) ? 1u : 0u; mine = (j == x) ? c : mine; }
        if (sum == G) break;
        __builtin_amdgcn_s_sleep(1);
        if ((++sp & 255u) == 0u) { if (xb_ld(&bar[XB_TMO])) break; if (sp > XB_SPIN_CAP) { atomicAdd(&bar[XB_TMO], 1u); break; } }
    }
    nloc = mine > 0u ? mine : 1u; nx = cnt > 0u ? cnt : 1u;
}
__device__ __forceinline__ void xcd_barrier(const XcdBarrier& b) {
    asm volatile("s_waitcnt vmcnt(0)" ::: "memory");
    __syncthreads();
    if (otid() == 0) {
        unsigned* bar = b.bar; unsigned bx = b.x; asm volatile("" : "+s"(bx));
        __builtin_amdgcn_s_waitcnt(0);
        unsigned nloc = b.st[0], nx = b.st[1];
        if (nloc == 0u) { xcd_barrier_complete(bar, bx, nloc, nx); b.st[0] = nloc; b.st[1] = nx; }
        const unsigned old = xb_add(&bar[XB_XSUB(bx)], 1u);
        const unsigned gen = old / nloc;
        if (old + 1u == (gen + 1u) * nloc) {
            __builtin_amdgcn_fence(__ATOMIC_RELEASE, "agent");
            asm volatile("s_waitcnt vmcnt(0)" ::: "memory");
            const unsigned og = xb_add(&bar[XB_TOP], 1u);
            const unsigned tg = og / nx;
            if (og + 1u == (tg + 1u) * nx) xb_add(&bar[XB_TOPGEN], 1u);
            else XB_SPIN(xb_ld(&bar[XB_TOPGEN]) == tg, bar);
            __builtin_amdgcn_fence(__ATOMIC_ACQUIRE, "agent");
            xb_add(&bar[XB_XGEN(bx)], 1u);
            asm volatile("s_waitcnt vmcnt(0)" ::: "memory");
        } else {
            XB_SPIN(xb_ld(&bar[XB_XGEN(bx)]) == gen, bar);
            __builtin_amdgcn_fence(__ATOMIC_ACQUIRE, "agent");
            asm volatile("s_waitcnt vmcnt(0)" ::: "memory");
        }
    }
    __syncthreads();
}

namespace pg8 {
#define PG8_LAS __attribute__((address_space(3)))
typedef unsigned short bf16_t;
typedef _Float16 f16x8 __attribute__((ext_vector_type(8)));
typedef float f32x4 __attribute__((ext_vector_type(4)));
typedef unsigned u32x4 __attribute__((ext_vector_type(4)));
constexpr int BM = 256, BK = 64, HALF = 128, HTB = HALF * BK * 2  , STAGE_BYTES = 8 * HTB, NXCD = 8, WGM = 8;

__host__ __device__ __forceinline__ int lds_byte(int r, int c) { const int st = (r >> 4) * 2 + (c >> 5), rr = r & 15, cc = c & 31, ob = rr * 64 + cc * 2; return st * 1024 + (ob ^ (((ob >> 9) & 1) << 5)); }
__host__ __device__ __forceinline__ void stage_rc(int b, int& R, int& C) { const int st = b / 1024, sb = b % 1024, swz = sb ^ (((sb >> 9) & 1) << 5); R = (st >> 1) * 16 + swz / 64; C = (st & 1) * 32 + (swz % 64) / 2; }
__host__ __device__ __forceinline__ int perm32(int rho) { const int n = rho >> 4, i = rho & 15; return 8 * (i >> 2) + 4 * n + (i & 3); }

struct Unit { int pm, pn; };
struct Gemm { const bf16_t* A; const bf16_t* Bt; int M, N, K; };

struct StaticOrder {
    int nM, nN, nwg, G, c;
    __host__ __device__ void init(int M, int N, int G_, int c_) { nM = M / BM; nN = N / BM; nwg = nM * nN; G = G_; c = c_; }
    __host__ __device__ bool next(int i, Unit& u) const {
        const long L = (long)i * G + c; if (L >= nwg) return false;
        int wgid = (int)L; { const int q = nwg / NXCD, r = nwg % NXCD, xcd = wgid % NXCD, off = wgid / NXCD; wgid = (xcd < r ? xcd * (q + 1) : r * (q + 1) + (xcd - r) * q) + off; }
        const int nig = WGM * nN, gid = wgid / nig, fm = gid * WGM, gsz = (nM - fm) < WGM ? (nM - fm) : WGM;
        u.pm = fm + ((wgid % nig) % gsz); u.pn = (wgid % nig) / gsz; return true;
    }
    __device__ __forceinline__ void a_ready(const Unit&) const {}
    __device__ __forceinline__ void done(const Unit&) const {}
};

template <class Epi, class Sched, bool ALIGN_EPI = false, bool SP2 = false>
__device__ __forceinline__ void gemm_phase(PG8_LAS unsigned char* lds, const Gemm g, const Sched& S, const Epi& E) {
    const int tid = otid(), wid = __builtin_amdgcn_readfirstlane(tid >> 6), lane = tid & 63, wr = wid >> 2, wc = wid & 3, fr = lane & 15, fq = lane >> 4;
    const int K = g.K, nt = K / BK;
    unsigned voffA[2], voffB[2];
#pragma unroll
    for (int i = 0; i < 2; ++i) { int R, C; stage_rc(tid * 16 + i * 8192, R, C); const int Rb = Epi::PERM ? ((R & ~31) + perm32(R & 31)) : R;
        voffA[i] = (unsigned)(R * K + C) * 2u; voffB[i] = (unsigned)(Rb * K + C) * 2u; }
    const size_t kstep = (size_t)(BK * 2);
    const size_t hstep = (size_t)HALF * K * 2;
    const size_t tstep = 2 * hstep;
    const unsigned ldsw = (unsigned)wid * 1024u;
    const int aoff = lds_byte(wr * 64 + fr, fq * 8), boff = lds_byte(wc * 32 + fr, fq * 8);
#define PG8_SA(b, h) (((b) * 2 + (h)) * HTB)
#define PG8_SB(b, h) ((4 + (b) * 2 + (h)) * HTB)
#define PG8_STAGE(bufoff, gbase, voff) do { _Pragma("unroll") for (int _i = 0; _i < 2; ++_i) \
        __builtin_amdgcn_global_load_lds((const unsigned*)((const char*)(gbase) + (voff)[_i]), (PG8_LAS unsigned*)(lds + (bufoff) + ldsw + _i * 8192), 16, 0, 0); } while (0)
#define PG8_LDA(dst, b, h) do { _Pragma("unroll") for (int m = 0; m < 4; ++m) _Pragma("unroll") for (int k = 0; k < 2; ++k) dst[m][k] = *(const PG8_LAS f16x8*)(lds + PG8_SA(b, h) + aoff + m * 2048 + k * 1024); } while (0)
#define PG8_LDB(dst, b, h) do { _Pragma("unroll") for (int n = 0; n < 2; ++n) _Pragma("unroll") for (int k = 0; k < 2; ++k) dst[n][k] = *(const PG8_LAS f16x8*)(lds + PG8_SB(b, h) + boff + n * 2048 + k * 1024); } while (0)
#define PG8_MMA(ai, bj, At, Bt) do { __builtin_amdgcn_s_setprio(1); _Pragma("unroll") for (int m = 0; m < 4; ++m) _Pragma("unroll") for (int n = 0; n < 2; ++n) _Pragma("unroll") for (int k = 0; k < 2; ++k) \
        acc[ai][bj][m][n] = __builtin_amdgcn_mfma_f32_16x16x32_f16(Bt[n][k], At[m][k], acc[ai][bj][m][n], 0, 0, 0); __builtin_amdgcn_s_setprio(0); } while (0)
#define PG8_WAIT_V(n) asm volatile("s_waitcnt vmcnt(" #n ")" ::: "memory")
#define PG8_WAIT_L(n) asm volatile("s_waitcnt lgkmcnt(" #n ")" ::: "memory")
#define PG8_BAR __builtin_amdgcn_s_barrier()
#define PG8_SCHED __builtin_amdgcn_sched_barrier(0)
    Unit cur, nxt; int ui = 0;
    if (!S.next(0, cur)) return;
    f32x4 acc[2][2][4][2];
#pragma unroll
    for (int a = 0; a < 2; ++a)
#pragma unroll
        for (int b = 0; b < 2; ++b)
#pragma unroll
            for (int m = 0; m < 4; ++m)
#pragma unroll
                for (int n = 0; n < 2; ++n) acc[a][b][m][n] = (f32x4){0.f, 0.f, 0.f, 0.f};
    f16x8 At[4][2], B0[2][2], B1[2][2];
    const char* cA = (const char*)g.A + (size_t)cur.pm * tstep; const char* cB = (const char*)g.Bt + (size_t)cur.pn * tstep;
    S.a_ready(cur);
    if constexpr (SP2) {
        PG8_STAGE(PG8_SB(0, 0), cB, voffB); PG8_STAGE(PG8_SB(0, 1), cB + hstep, voffB); PG8_STAGE(PG8_SA(0, 0), cA, voffA); PG8_STAGE(PG8_SA(0, 1), cA + hstep, voffA);
        if (wr == 1) PG8_BAR;
        PG8_WAIT_V(2); PG8_BAR;
        PG8_STAGE(PG8_SB(1, 0), cB + kstep, voffB); PG8_STAGE(PG8_SA(1, 0), cA + kstep, voffA); PG8_STAGE(PG8_SB(1, 1), cB + hstep + kstep, voffB);
        PG8_WAIT_V(6); PG8_BAR;
    } else {
        PG8_STAGE(PG8_SB(0, 0), cB, voffB); PG8_STAGE(PG8_SA(0, 0), cA, voffA); PG8_STAGE(PG8_SB(0, 1), cB + hstep, voffB); PG8_STAGE(PG8_SA(0, 1), cA + hstep, voffA);
        if (wr == 1) PG8_BAR;
        PG8_WAIT_V(4); PG8_BAR;
        PG8_STAGE(PG8_SB(1, 0), cB + kstep, voffB); PG8_STAGE(PG8_SA(1, 0), cA + kstep, voffA); PG8_STAGE(PG8_SB(1, 1), cB + hstep + kstep, voffB);
        PG8_WAIT_V(6); PG8_BAR;
    }
    for (;;) {
        const bool has_next = S.next(ui + 1, nxt);
        const char* nA = has_next ? (const char*)g.A + (size_t)nxt.pm * tstep : cA; const char* nB = has_next ? (const char*)g.Bt + (size_t)nxt.pn * tstep : cB;
        for (int t = 0; t < nt; t += 2) {
            const bool last = (t == nt - 2);
            const char* a1 = cA + (size_t)(t + 1) * kstep;
            const char* a2 = last ? nA : cA + (size_t)(t + 2) * kstep; const char* b2 = last ? nB : cB + (size_t)(t + 2) * kstep;
            const char* a3 = a2 + kstep; const char* b3 = b2 + kstep;
            if (last && has_next) S.a_ready(nxt);
            if constexpr (SP2) {
            PG8_LDB(B0, 0, 0); PG8_LDB(B1, 0, 1); PG8_SCHED; PG8_LDA(At, 0, 0); PG8_STAGE(PG8_SA(1, 1), a1 + hstep, voffA);
            PG8_WAIT_V(8); PG8_WAIT_L(0); PG8_BAR; PG8_MMA(0, 0, At, B0); PG8_MMA(0, 1, At, B1); PG8_BAR; PG8_SCHED;
            PG8_LDA(At, 0, 1); PG8_STAGE(PG8_SB(0, 0), b2, voffB); PG8_STAGE(PG8_SB(0, 1), b2 + hstep, voffB); PG8_STAGE(PG8_SA(0, 0), a2, voffA);
            PG8_WAIT_V(8); PG8_WAIT_L(0); PG8_BAR; PG8_MMA(1, 0, At, B0); PG8_MMA(1, 1, At, B1); PG8_BAR; PG8_SCHED;
            PG8_LDB(B0, 1, 0); PG8_LDB(B1, 1, 1); PG8_SCHED; PG8_LDA(At, 1, 0); PG8_STAGE(PG8_SA(0, 1), a2 + hstep, voffA);
            PG8_WAIT_V(8); PG8_WAIT_L(0); PG8_BAR; PG8_MMA(0, 0, At, B0); PG8_MMA(0, 1, At, B1); PG8_BAR; PG8_SCHED;
            PG8_LDA(At, 1, 1); PG8_STAGE(PG8_SB(1, 0), b3, voffB); PG8_STAGE(PG8_SB(1, 1), b3 + hstep, voffB); PG8_STAGE(PG8_SA(1, 0), a3, voffA);
            PG8_WAIT_V(8); PG8_WAIT_L(0); PG8_BAR; PG8_MMA(1, 0, At, B0); PG8_MMA(1, 1, At, B1); PG8_BAR; PG8_SCHED;
            } else {
            PG8_LDB(B0, 0, 0); PG8_SCHED; PG8_LDA(At, 0, 0); PG8_STAGE(PG8_SA(1, 1), a1 + hstep, voffA);
            PG8_WAIT_L(8); PG8_BAR; PG8_WAIT_L(0); PG8_MMA(0, 0, At, B0); PG8_BAR; PG8_SCHED;
            PG8_LDB(B1, 0, 1); PG8_STAGE(PG8_SB(0, 0), b2, voffB);
            PG8_BAR; PG8_WAIT_L(0); PG8_MMA(0, 1, At, B1); PG8_BAR;
            PG8_LDA(At, 0, 1); PG8_STAGE(PG8_SA(0, 0), a2, voffA);
            PG8_BAR; PG8_WAIT_L(0); PG8_MMA(1, 0, At, B0); PG8_BAR; PG8_SCHED;
            PG8_STAGE(PG8_SB(0, 1), b2 + hstep, voffB);
            PG8_WAIT_V(6); PG8_BAR; PG8_MMA(1, 1, At, B1); PG8_BAR;
            PG8_LDB(B0, 1, 0); PG8_SCHED; PG8_LDA(At, 1, 0); PG8_STAGE(PG8_SA(0, 1), a2 + hstep, voffA);
            PG8_WAIT_L(8); PG8_BAR; PG8_WAIT_L(0); PG8_MMA(0, 0, At, B0); PG8_BAR; PG8_SCHED;
            PG8_LDB(B1, 1, 1); PG8_STAGE(PG8_SB(1, 0), b3, voffB);
            PG8_BAR; PG8_WAIT_L(0); PG8_MMA(0, 1, At, B1); PG8_BAR;
            PG8_LDA(At, 1, 1); PG8_STAGE(PG8_SA(1, 0), a3, voffA);
            PG8_BAR; PG8_WAIT_L(0); PG8_MMA(1, 0, At, B0); PG8_BAR; PG8_SCHED;
            PG8_STAGE(PG8_SB(1, 1), b3 + hstep, voffB);
            PG8_WAIT_V(6); PG8_BAR; PG8_MMA(1, 1, At, B1); PG8_BAR;
            }
        }
        if constexpr (ALIGN_EPI) { if (wr == 0) PG8_BAR; }
        if constexpr (!Epi::AFTER_DRAIN) { E(acc, cur, wr, wc, fr, fq); S.done(cur); }
        if (!has_next) break;
#pragma unroll
        for (int a = 0; a < 2; ++a)
#pragma unroll
            for (int b = 0; b < 2; ++b)
#pragma unroll
                for (int m = 0; m < 4; ++m)
#pragma unroll
                    for (int n = 0; n < 2; ++n) acc[a][b][m][n] = (f32x4){0.f, 0.f, 0.f, 0.f};
        cur = nxt; cA = nA; cB = nB; ++ui;
        if constexpr (ALIGN_EPI) { if (wr == 1) PG8_BAR; }
    }
    PG8_WAIT_V(0);
    if constexpr (!ALIGN_EPI) { if (wr == 0) PG8_BAR; }
    PG8_BAR;
    if constexpr (Epi::AFTER_DRAIN) { E.fused(acc, cur, wr, wc, fr, fq, lds, wid, lane); S.done(cur); }
#undef PG8_SA
#undef PG8_SB
#undef PG8_STAGE
#undef PG8_LDA
#undef PG8_LDB
#undef PG8_MMA
#undef PG8_WAIT_V
#undef PG8_WAIT_L
#undef PG8_BAR
#undef PG8_SCHED
}
}


typedef float f32x4_t __attribute__((ext_vector_type(4)));
typedef _Float16 h16x8 __attribute__((ext_vector_type(8)));
DEVI float silu_f(float v) { return v / (1.f + __expf(-v)); }
struct EpiRoute {
    static constexpr bool PERM = true, AFTER_DRAIN = false;
    unsigned char* ws; const float* rstd;
    DEVI void operator()(const pg8::f32x4 (&acc)[2][2][4][2], const pg8::Unit& u, int wr, int wc, int fr, int fq) const {
        const int row0 = u.pm * 256 + wr * 64 + fr;
        float rs[2][4];
#pragma unroll
        for (int ai = 0; ai < 2; ++ai)
#pragma unroll
            for (int m = 0; m < 4; ++m) rs[ai][m] = rstd[row0 + ai * 128 + m * 16];
#pragma unroll
        for (int bj = 0; bj < 2; ++bj) {
            const int cg = u.pn * 256 + bj * 128 + wc * 32;
            const Route r = route(cg);
            if (r.buf < 0) continue;
            h16* base = (h16*)(ws + buf_off(r.buf)) + r.dcol + 8 * fq;
#pragma unroll
            for (int ai = 0; ai < 2; ++ai)
#pragma unroll
                for (int m = 0; m < 4; ++m) {
                    const int row = row0 + ai * 128 + m * 16; const float sc = rs[ai][m] * r.scale;
                    float v[8];
#pragma unroll
                    for (int j = 0; j < 4; ++j) { v[j] = acc[ai][bj][m][0][j] * sc; v[4 + j] = acc[ai][bj][m][1][j] * sc; }
                    if (r.silu) {
#pragma unroll
                        for (int j = 0; j < 8; ++j) v[j] = silu_f(v[j]);
                    }
                    h16x8 o;
#pragma unroll
                    for (int j = 0; j < 8; ++j) o[j] = (h16)v[j];
                    *(h16x8*)(base + (size_t)row * r.pitch) = o;
                }
        }
    }
};

constexpr int NTHR = 512, NWAVE = 8;

template <bool REF>
DEVI void cvt_transpose(const float* __restrict__ src, int src_pitch, const float* __restrict__ g, h16* dst, int N, int K, unsigned char* lds, int item0, int nitems_total, int& item_base) {
    const int tid = otid();
    float (*tile)[65] = (float (*)[65])lds;
    const int ntn = N / 64, ntk = K / 64, n_it = ntn * ntk;
    for (int it = item0; it < nitems_total; it += gridDim.x) {
        const int li = it - item_base; if (li < 0 || li >= n_it) continue;
        const int n0 = (li % ntn) * 64, k0 = (li / ntn) * 64;
        __syncthreads();
        const int c = tid & 63; int rc = n0 + c; if (REF) rc = ref_col(rc);
#pragma unroll
        for (int ps = 0; ps < 8; ++ps) { const int k = ps * 8 + (tid >> 6);
            tile[k][c] = rc >= 0 ? src[(size_t)(k0 + k) * src_pitch + rc] * (g ? g[k0 + k] : 1.f) : 0.f; }
        __syncthreads();
        const int cc = tid >> 3, kq = (tid & 7) * 8;
        h16x8 o;
#pragma unroll
        for (int j = 0; j < 8; ++j) o[j] = (h16)tile[kq + j][cc];
        *(h16x8*)(dst + (size_t)(n0 + cc) * K + k0 + kq) = o;
    }
    item_base += n_it;
}

DEVI void ph_rowstat_cvt(const float* h, float* rstd, h16* h16o) {
    const int t_ = otid(); const int lane = t_ & 63, gw = blockIdx.x * NWAVE + (t_ >> 6), nw = gridDim.x * NWAVE;
    for (int row = gw; row < NT; row += nw) {
        const float4* p = (const float4*)(h + (size_t)row * DM);
        float s = 0.f;
#pragma unroll
        for (int i = 0; i < 4; ++i) { float4 v = p[lane + 64 * i]; s += v.x * v.x + v.y * v.y + v.z * v.z + v.w * v.w;
            typedef _Float16 h16x4 __attribute__((ext_vector_type(4)));
            h16x4 o; o[0] = (h16)v.x; o[1] = (h16)v.y; o[2] = (h16)v.z; o[3] = (h16)v.w;
            *(h16x4*)(h16o + (size_t)row * DM + (lane + 64 * i) * 4) = o; }
        for (int o = 32; o; o >>= 1) s += __shfl_xor(s, o);
        if (lane == 0) rstd[row] = rsqrtf(s / DM + EPS);
    }
}

constexpr int LDS_BYTES = 144 * 1024;
struct Params { const float* in[12]; float* out; unsigned char* ws; };

DEVI void ph_tables(const float* __restrict__ rel_bias, float* biasTab, float* cosT, float* sinT) {
    for (int i = blockIdx.x * NTHR + threadIdx.x; i < 2048 * 16; i += gridDim.x * NTHR) {
        if (i < 12 * 2048) { int hh = i / 2048, n = i % 2048; biasTab[i] = rel_bias[t5_bucket(n) * 12 + hh] * LOG2E; }
        int pos = i / 16, j = i % 16;
        float inv = (float)pow(10000.0, -(double)(2 * j) / 32.0);
        float ang = (float)pos * inv;
        cosT[i] = (float)cos((double)ang); sinT[i] = (float)sin((double)ang);
    }
}

DEVI void ph_rowstat(const float* h, float* rstd) {
    const int lane = threadIdx.x & 63, gw = blockIdx.x * NWAVE + (threadIdx.x >> 6), nw = gridDim.x * NWAVE;
    for (int row = gw; row < NT; row += nw) {
        const float4* p = (const float4*)(h + (size_t)row * DM);
        float s = 0.f;
        for (int i = lane; i < 256; i += 64) { float4 v = p[i]; s += v.x * v.x + v.y * v.y + v.z * v.z + v.w * v.w; }
        for (int o = 32; o; o >>= 1) s += __shfl_xor(s, o);
        if (lane == 0) rstd[row] = rsqrtf(s / DM + EPS);
    }
}

DEVI void ph_gemm_in_naive(const float* h, const float* __restrict__ g, const float* __restrict__ w, const float* rstd, unsigned char* ws, unsigned char* lds) {
    const int t_ = otid(); const int sub = t_ >> 8, tid = t_ & 255, ty = tid >> 4, tx = tid & 15;
    float (*As)[68] = (float (*)[68])(lds + sub * 2 * 16 * 68 * 4);
    float (*Bs)[68] = (float (*)[68])(lds + sub * 2 * 16 * 68 * 4 + 16 * 68 * 4);
    for (int it = blockIdx.x; it < 64 * 256 / 2; it += gridDim.x) {
        const int vb = it * 2 + sub, col0 = (vb & 63) * 64, row0 = (vb >> 6) * 64;
        float acc[4][4] = {};
        const int ar = tid >> 2, ak = (tid & 3) * 4, bk = tid >> 4, bc = (tid & 15) * 4;
        int rc[4];
#pragma unroll
        for (int j = 0; j < 4; ++j) rc[j] = ref_col(col0 + bc + j);
        for (int k0 = 0; k0 < DM; k0 += 16) {
            float4 av = *(const float4*)(h + (size_t)(row0 + ar) * DM + k0 + ak);
            float4 gv = *(const float4*)(g + k0 + ak);
            As[ak + 0][ar] = av.x * gv.x; As[ak + 1][ar] = av.y * gv.y; As[ak + 2][ar] = av.z * gv.z; As[ak + 3][ar] = av.w * gv.w;
#pragma unroll
            for (int j = 0; j < 4; ++j) Bs[bk][bc + j] = rc[j] >= 0 ? w[(size_t)(k0 + bk) * INC + rc[j]] : 0.f;
            __syncthreads();
#pragma unroll
            for (int kk = 0; kk < 16; ++kk) {
                float a[4], b[4];
#pragma unroll
                for (int i = 0; i < 4; ++i) { a[i] = As[kk][ty * 4 + i]; b[i] = Bs[kk][tx * 4 + i]; }
#pragma unroll
                for (int i = 0; i < 4; ++i)
#pragma unroll
                    for (int j = 0; j < 4; ++j) acc[i][j] += a[i] * b[j];
            }
            __syncthreads();
        }
        const int c = col0 + tx * 4;
        Route r = route(c);
        if (r.buf >= 0) {
            h16* dst = (h16*)(ws + buf_off(r.buf));
#pragma unroll
            for (int i = 0; i < 4; ++i) {
                int row = row0 + ty * 4 + i; float rs = rstd[row];
#pragma unroll
                for (int j = 0; j < 4; ++j) {
                    float v = acc[i][j] * rs * r.scale;
                    if (r.silu) v = v / (1.f + __expf(-v));
                    dst[(size_t)row * r.pitch + r.dcol + j] = (h16)v;
                }
            }
        }
    }
}

DEVI void ph_mla_naive(const h16* cA, const float* __restrict__ qn, const float* __restrict__ kvn, const float* __restrict__ wuq, const float* __restrict__ wukv,
                       const float* cosT, const float* sinT, h16* qA, h16* kA, h16* vA, h16* kAr, unsigned char* lds) {
    const int t_ = otid(); const int sub = t_ >> 7, tid = t_ & 127;
    float* cq = (float*)(lds + sub * 3072); float* ckv = cq + 192; float* kr = ckv + 128; float* qout = kr + 32; float* red = qout + 384;
    for (int it = blockIdx.x; it < NT / 4; it += gridDim.x) {
        const int tok = it * 4 + sub, s = tok % SEQ;
        __syncthreads();
        for (int i = tid; i < 192; i += 128) cq[i] = (float)cA[(size_t)tok * 384 + i];
        ckv[tid] = (float)cA[(size_t)tok * 384 + 192 + tid];
        if (tid < 32) kr[tid] = (float)cA[(size_t)tok * 384 + 320 + tid];
        __syncthreads();
        if (tid < 64) {
            float a = 0.f; for (int i = tid; i < 192; i += 64) a += cq[i] * cq[i];
            for (int o = 32; o; o >>= 1) a += __shfl_xor(a, o);
            if (tid == 0) red[0] = rsqrtf(a / 192.f + EPS);
        } else {
            int l = tid - 64; float a = 0.f; for (int i = l; i < 128; i += 64) a += ckv[i] * ckv[i];
            for (int o = 32; o; o >>= 1) a += __shfl_xor(a, o);
            if (l == 0) red[1] = rsqrtf(a / 128.f + EPS);
        }
        __syncthreads();
        for (int i = tid; i < 192; i += 128) cq[i] = cq[i] * red[0] * qn[i];
        ckv[tid] = ckv[tid] * red[1] * kvn[tid];
        __syncthreads();
        for (int n = tid; n < 384; n += 128) { float a = 0.f; for (int k = 0; k < 192; ++k) a += cq[k] * wuq[k * 384 + n]; qout[n] = a; }
        __syncthreads();
        const float qs = 0.10206207261596577f * LOG2E;
        for (int idx = tid; idx < 384; idx += 128) {
            int hh = idx / 96, j = idx % 96; float val;
            if (j < 64) val = qout[idx];
            else { int r = j - 64, i = r & 15; float x1 = qout[hh * 96 + 64 + i], x2 = qout[hh * 96 + 80 + i], c = cosT[s * 16 + i], sn = sinT[s * 16 + i];
                   val = r < 16 ? x1 * c - x2 * sn : x1 * sn + x2 * c; }
            qA[(size_t)tok * 384 + idx] = (h16)(val * qs);
        }
        for (int n = tid; n < 512; n += 128) {
            float a = 0.f; for (int k = 0; k < 128; ++k) a += ckv[k] * wukv[k * 512 + n];
            int hh = n / 128, j = n % 128;
            if (j < 64) kA[(size_t)tok * 256 + hh * 64 + j] = (h16)a; else vA[(size_t)tok * 256 + hh * 64 + j - 64] = (h16)a;
        }
        if (tid < 32) { int i = tid & 15; float x1 = kr[i], x2 = kr[16 + i], c = cosT[s * 16 + i], sn = sinT[s * 16 + i];
            kAr[(size_t)tok * 32 + tid] = (h16)(tid < 16 ? x1 * c - x2 * sn : x1 * sn + x2 * c); }
    }
}

DEVI void ph_attnA_naive(int vb, const h16* qA, const h16* kA, const h16* vA, const h16* kAr, const h16* gate, h16* mix) {
    const int chunk = 63 - (vb % 64), bh = vb / 64, b = bh / 4, hh = bh % 4, half = (otid() >> 5) & 1;
    const int t = chunk * 32 + (otid() & 31); const size_t tok = (size_t)b * SEQ + t;
    float q[96], o[32];
#pragma unroll
    for (int i = 0; i < 96; ++i) q[i] = (float)qA[tok * 384 + hh * 96 + i];
#pragma unroll
    for (int i = 0; i < 32; ++i) o[i] = 0.f;
    float m = -1e30f, l = 0.f;
    const int smax = chunk * 32 + 31;
    for (int s = 0; s <= smax; ++s) {
        const size_t ks = (size_t)b * SEQ + s;
        const h16* kp = kA + ks * 256 + hh * 64; const h16* kr = kAr + ks * 32; const h16* vp = vA + ks * 256 + hh * 64 + half * 32;
        float sc = 0.f;
#pragma unroll
        for (int i = 0; i < 64; ++i) sc += q[i] * (float)kp[i];
#pragma unroll
        for (int i = 0; i < 32; ++i) sc += q[64 + i] * (float)kr[i];
        if (s <= t) {
            if (sc > m) { float a = exp2f(m - sc); l *= a;
#pragma unroll
                for (int i = 0; i < 32; ++i) o[i] *= a;
                m = sc; }
            float p = exp2f(sc - m); l += p;
#pragma unroll
            for (int i = 0; i < 32; ++i) o[i] += p * (float)vp[i];
        }
    }
    float il = 1.f / l;
#pragma unroll
    for (int i = 0; i < 32; ++i) mix[tok * 1024 + hh * 64 + half * 32 + i] = (h16)(o[i] * il * (float)gate[tok * 1024 + hh * 64 + half * 32 + i]);
}

DEVI void ph_attnB_naive(int vb, const h16* qB, const h16* kB, const h16* vt, const float* biasTab, const h16* gate, h16* mix) {
    const int chunk = vb % 32, bh = vb / 32, b = bh / 4, hh = bh % 4;
    const int t = chunk * 64 + (otid() & 63); const size_t tok = (size_t)b * SEQ + t;
    float q[64], o[64];
#pragma unroll
    for (int i = 0; i < 64; ++i) { q[i] = (float)qB[tok * 256 + hh * 64 + i]; o[i] = 0.f; }
    float m = -1e30f, l = 0.f;
    const float* bt = biasTab + hh * 2048;
    for (int pat = 0; pat < 3; ++pat) {
        const int d = pat == 0 ? 1 : (pat == 1 ? 4 : 16);
        for (int k = 0; k <= 128; ++k) {
            const int s = t - k * d; if (s < 0) break;
            const size_t ks = (size_t)b * SEQ + s;
            const h16* kp = kB + ks * 256 + hh * 64; const h16* vp = vt + ks * 768 + hh * 64;
            float sc = bt[k * d];
#pragma unroll
            for (int i = 0; i < 64; ++i) sc += q[i] * (float)kp[i];
            if (sc > m) { float a = exp2f(m - sc); l *= a;
#pragma unroll
                for (int i = 0; i < 64; ++i) o[i] *= a;
                m = sc; }
            float p = exp2f(sc - m); l += p;
#pragma unroll
            for (int i = 0; i < 64; ++i) o[i] += p * (float)vp[i];
        }
    }
    float il = 1.f / l;
#pragma unroll
    for (int i = 0; i < 64; ++i) mix[tok * 1024 + 256 + hh * 64 + i] = (h16)(o[i] * il * (float)gate[tok * 1024 + 256 + hh * 64 + i]);
}

DEVI void ph_topk_naive(const h16* idx, unsigned* mask, unsigned char* lds) {
    const int t_ = otid(); const int sub = t_ >> 8, tid = t_ & 255;
    float* sc = (float*)(lds + sub * 9728); float* qi = sc + 2048; float* wi = qi + 256; unsigned* msk = (unsigned*)(wi + 8);
    for (int it = blockIdx.x; it < NT / 2; it += gridDim.x) {
        const int tok = (NT / 2 - 1 - it) * 2 + sub, b = tok / SEQ, t = tok % SEQ;
        __syncthreads();
        qi[tid] = (float)idx[(size_t)tok * 320 + tid];
        if (tid < 8) wi[tid] = (float)idx[(size_t)tok * 320 + 288 + tid] * 0.35355339059327373f;
        if (tid < 64) msk[tid] = 0u;
        __syncthreads();
        for (int s = tid; s <= t; s += 256) {
            const h16* kp = idx + ((size_t)b * SEQ + s) * 320 + 256;
            float kk[32];
#pragma unroll
            for (int d = 0; d < 32; ++d) kk[d] = (float)kp[d];
            float score = 0.f;
#pragma unroll 1
            for (int hh = 0; hh < 8; ++hh) { float lg = 0.f;
#pragma unroll
                for (int d = 0; d < 32; ++d) lg += qi[hh * 32 + d] * kk[d];
                score += fmaxf(lg, 0.f) * wi[hh]; }
            sc[s] = score;
        }
        __syncthreads();
        if (t + 1 <= 256) {
            for (int i = tid; i <= t; i += 256) atomicOr(&msk[i >> 5], 1u << (i & 31));
        } else {
            for (int i = tid; i <= t; i += 256) {
                const float si = sc[i]; int rank = 0;
                for (int j = 0; j <= t; ++j) { float sj = sc[j]; rank += (sj > si || (sj == si && j < i)) ? 1 : 0; }
                if (rank < 256) atomicOr(&msk[i >> 5], 1u << (i & 31));
            }
        }
        __syncthreads();
        if (tid < 64) mask[(size_t)tok * 64 + tid] = msk[tid];
    }
}

DEVI void ph_attnC_naive(int vb, const h16* qC, const h16* kC, const h16* vt, const unsigned* mask, const float* biasTab, const h16* gate, h16* mix) {
    const int chunk = 31 - (vb % 32), bh = vb / 32, b = bh / 4, hh = bh % 4;
    const int t = chunk * 64 + (otid() & 63); const size_t tok = (size_t)b * SEQ + t;
    float q[64], o[64];
#pragma unroll
    for (int i = 0; i < 64; ++i) { q[i] = (float)qC[tok * 256 + hh * 64 + i]; o[i] = 0.f; }
    float m = -1e30f, l = 0.f;
    const float* bt = biasTab + (4 + hh) * 2048;
    const int smax = chunk * 64 + 63;
    unsigned mw = 0;
    for (int s = 0; s <= smax; ++s) {
        if ((s & 31) == 0) mw = mask[tok * 64 + (s >> 5)];
        const size_t ks = (size_t)b * SEQ + s;
        const h16* kp = kC + ks * 256 + hh * 64; const h16* vp = vt + ks * 768 + 256 + hh * 64;
        float sc = 0.f;
#pragma unroll
        for (int i = 0; i < 64; ++i) sc += q[i] * (float)kp[i];
        if (s <= t && ((mw >> (s & 31)) & 1u)) {
            sc += bt[t - s];
            if (sc > m) { float a = exp2f(m - sc); l *= a;
#pragma unroll
                for (int i = 0; i < 64; ++i) o[i] *= a;
                m = sc; }
            float p = exp2f(sc - m); l += p;
#pragma unroll
            for (int i = 0; i < 64; ++i) o[i] += p * (float)vp[i];
        }
    }
    float il = 1.f / l;
#pragma unroll
    for (int i = 0; i < 64; ++i) mix[tok * 1024 + 512 + hh * 64 + i] = (h16)(o[i] * il * (float)gate[tok * 1024 + 512 + hh * 64 + i]);
}

DEVI void ph_attnD_naive(int vb, const h16* qD, const h16* kD, const h16* vt, const float* biasTab, const float* __restrict__ lam_p, const float* __restrict__ subln,
                         float lambda_init, const h16* gate, h16* mix) {
    const int t_ = otid();
    const int chunk = 127 - (vb % 128), bh = vb / 128, b = bh / 4, hh = bh % 4, mp = (t_ >> 4) & 1, half = (t_ >> 5) & 1;
    const int t = chunk * 16 + (t_ & 15); const size_t tok = (size_t)b * SEQ + t;
    float q[32], o[32];
#pragma unroll
    for (int i = 0; i < 32; ++i) { q[i] = (float)qD[tok * 256 + hh * 64 + mp * 32 + i]; o[i] = 0.f; }
    float m = -1e30f, l = 0.f;
    float a1 = 0.f, a2 = 0.f;
    for (int i = 0; i < 32; ++i) { a1 += lam_p[i] * lam_p[32 + i]; a2 += lam_p[64 + i] * lam_p[96 + i]; }
    const float lam = expf(a1) - expf(a2) + lambda_init;
    const float* bt = biasTab + (8 + hh) * 2048;
    const int smax = chunk * 16 + 15;
    for (int s = 0; s <= smax; ++s) {
        const size_t ks = (size_t)b * SEQ + s;
        const h16* kp = kD + ks * 256 + hh * 64 + mp * 32; const h16* vp = vt + ks * 768 + 512 + hh * 64 + half * 32;
        float sc = 0.f;
#pragma unroll
        for (int i = 0; i < 32; ++i) sc += q[i] * (float)kp[i];
        if (s <= t) {
            sc += bt[t - s];
            if (sc > m) { float a = exp2f(m - sc); l *= a;
#pragma unroll
                for (int i = 0; i < 32; ++i) o[i] *= a;
                m = sc; }
            float p = exp2f(sc - m); l += p;
#pragma unroll
            for (int i = 0; i < 32; ++i) o[i] += p * (float)vp[i];
        }
    }
    const float sgn = mp ? -lam : 1.f; const float il = sgn / l;
    float ss = 0.f;
#pragma unroll
    for (int i = 0; i < 32; ++i) { float v = o[i] * il; v += __shfl_xor(v, 16); o[i] = v; ss += v * v; }
    ss += __shfl_xor(ss, 32);
    float rs = rsqrtf(ss / 64.f + EPS) * (1.f - lambda_init);
    if (mp == 0) {
        int tt = b * SEQ + t; asm volatile("" : "+v"(tt)); const size_t tok2 = (size_t)tt;
#pragma unroll
        for (int i = 0; i < 32; ++i) mix[tok2 * 1024 + 768 + hh * 64 + half * 32 + i] = (h16)(o[i] * rs * subln[half * 32 + i] * (float)gate[tok2 * 1024 + 768 + hh * 64 + half * 32 + i]);
    }
}

DEVI void ph_out_naive(const h16* mix, const float* __restrict__ w, const float* __restrict__ g, const float* h_in, float* h_out, unsigned char* lds) {
    const int t_ = otid(); const int sub = t_ >> 8, tid = t_ & 255;
    float (*A)[1024] = (float (*)[1024])(lds + sub * 33024); float (*red)[4] = (float (*)[4])(lds + sub * 33024 + 32768);
    for (int it = blockIdx.x; it < NT / 16; it += gridDim.x) {
        const int row0 = (it * 2 + sub) * 8;
        __syncthreads();
        for (int i = tid; i < 8 * 1024; i += 256) A[i >> 10][i & 1023] = (float)mix[(size_t)(row0 + (i >> 10)) * 1024 + (i & 1023)];
        __syncthreads();
        float acc[8][4] = {};
        for (int k = 0; k < 1024; ++k) {
            float wv[4];
#pragma unroll
            for (int j = 0; j < 4; ++j) wv[j] = w[(size_t)k * 1024 + tid + 256 * j];
#pragma unroll
            for (int r = 0; r < 8; ++r) { float a = A[r][k];
#pragma unroll
                for (int j = 0; j < 4; ++j) acc[r][j] += a * wv[j]; }
        }
#pragma unroll
        for (int r = 0; r < 8; ++r) {
            float s = 0.f;
#pragma unroll
            for (int j = 0; j < 4; ++j) s += acc[r][j] * acc[r][j];
            for (int o = 32; o; o >>= 1) s += __shfl_xor(s, o);
            if ((tid & 63) == 0) red[r][tid >> 6] = s;
        }
        __syncthreads();
#pragma unroll
        for (int r = 0; r < 8; ++r) {
            float rs = rsqrtf((red[r][0] + red[r][1] + red[r][2] + red[r][3]) / 1024.f + EPS);
#pragma unroll
            for (int j = 0; j < 4; ++j) { int n = tid + 256 * j; size_t o = (size_t)(row0 + r) * 1024 + n; h_out[o] = h_in[o] + acc[r][j] * rs * g[n]; }
        }
    }
}

extern __shared__ __attribute__((aligned(16))) unsigned char smem[];
constexpr int LDS_BAR_OFF = 131072;

DEVI unsigned char* ows(unsigned char* w) { asm volatile("" : "+s"(w)); return w; }
#define WSP(T, off) ((T*)(w + (off)))

__global__ void __launch_bounds__(NTHR, 2) mega(Params p) {
    if (threadIdx.x == 0) *(uint4*)(smem + LDS_BAR_OFF) = make_uint4(0u, 0u, 0u, 0u);
    __syncthreads();
    XcdBarrier bar = xcd_barrier_post((unsigned*)(p.ws + OFF_CTL), (volatile LAS unsigned*)(smem + LDS_BAR_OFF));
    unsigned char* lds = smem;
    const int nw = gridDim.x * NWAVE;

    {
        unsigned char* w = ows(p.ws);
        ph_tables(p.in[11], WSP(float, OFF_BIAS), WSP(float, OFF_COS), WSP(float, OFF_SIN));
        int base = 0; const int total = 2 * (64 * 16) + 2 * (16 * 16);
        cvt_transpose<true>(p.in[1], INC, p.in[3], WSP(h16, OFF_WINT), MYC, DM, lds, blockIdx.x, total, base);
        cvt_transpose<true>(p.in[1] + (size_t)DM * INC, INC, p.in[3] + DM, WSP(h16, OFF_WINT) + (size_t)MYC * DM, MYC, DM, lds, blockIdx.x, total, base);
        cvt_transpose<false>(p.in[2], DM, nullptr, WSP(h16, OFF_WOUTT), DM, DM, lds, blockIdx.x, total, base);
        cvt_transpose<false>(p.in[2] + (size_t)DM * DM, DM, nullptr, WSP(h16, OFF_WOUTT) + (size_t)DM * DM, DM, DM, lds, blockIdx.x, total, base);
        ph_rowstat_cvt(p.in[0], WSP(float, OFF_RSTD), WSP(h16, OFF_H16));
    }
    xcd_barrier(bar);
    for (int layer = 0; layer < 2; ++layer) {
        const float lambda_init = layer == 0 ? 0.2f : 0.35550906759f;
        {
            unsigned char* w = ows(p.ws);
            pg8::Gemm g{WSP(const pg8::bf16_t, OFF_H16), WSP(const pg8::bf16_t, OFF_WINT) + (size_t)layer * MYC * DM, NT, MYC, DM};
            int bid_ = (int)blockIdx.x; asm volatile("" : "+s"(bid_));
            pg8::StaticOrder S; S.init(NT, MYC, (int)gridDim.x, bid_);
            EpiRoute E{w, WSP(float, OFF_RSTD)};
            pg8::gemm_phase<EpiRoute, pg8::StaticOrder, true, true>((PG8_LAS unsigned char*)lds, g, S, E);
        }
        xcd_barrier(bar);
        {
            unsigned char* w = ows(p.ws);
            ph_mla_naive(WSP(h16, OFF_CA), p.in[5] + layer * 192, p.in[6] + layer * 128, p.in[7] + (size_t)layer * 192 * 384, p.in[8] + (size_t)layer * 128 * 512,
                         WSP(float, OFF_COS), WSP(float, OFF_SIN), WSP(h16, OFF_QA), WSP(h16, OFF_KA), WSP(h16, OFF_VA), WSP(h16, OFF_KAR), lds);
        }
        {
            unsigned char* w = ows(p.ws);
            ph_topk_naive(WSP(h16, OFF_IDX), WSP(unsigned, OFF_MASK), lds);
        }
        xcd_barrier(bar);
        {
            unsigned char* w = ows(p.ws);
            for (int vb = ogw(); vb < 2048; vb += nw) ph_attnA_naive(vb, WSP(h16, OFF_QA), WSP(h16, OFF_KA), WSP(h16, OFF_VA), WSP(h16, OFF_KAR), WSP(h16, OFF_GATE), WSP(h16, OFF_MIX));
        }
        {
            unsigned char* w = ows(p.ws);
            for (int vb = nw - 1 - ogw(); vb < 4096; vb += nw) ph_attnD_naive(vb, WSP(h16, OFF_QD), WSP(h16, OFF_KD), WSP(h16, OFF_VTMP), WSP(float, OFF_BIAS), p.in[9] + layer * 128, p.in[10] + layer * 64, lambda_init, WSP(h16, OFF_GATE), WSP(h16, OFF_MIX));
        }
        {
            unsigned char* w = ows(p.ws);
            for (int vb = ogw(); vb < 1024; vb += nw) ph_attnC_naive(vb, WSP(h16, OFF_QC), WSP(h16, OFF_KC), WSP(h16, OFF_VTMP), WSP(unsigned, OFF_MASK), WSP(float, OFF_BIAS), WSP(h16, OFF_GATE), WSP(h16, OFF_MIX));
        }
        {
            unsigned char* w = ows(p.ws);
            for (int vb = nw - 1 - ogw(); vb < 1024; vb += nw) ph_attnB_naive(vb, WSP(h16, OFF_QB), WSP(h16, OFF_KB), WSP(h16, OFF_VTMP), WSP(float, OFF_BIAS), WSP(h16, OFF_GATE), WSP(h16, OFF_MIX));
        }
        xcd_barrier(bar);
        {
            unsigned char* w = ows(p.ws);
            ph_out_naive(WSP(h16, OFF_MIX), p.in[2] + (size_t)layer * DM * DM, p.in[4] + layer * DM, layer == 0 ? p.in[0] : (const float*)p.out, p.out, lds);
        }
        xcd_barrier(bar);
        if (layer == 0) { unsigned char* w = ows(p.ws); ph_rowstat_cvt(p.out, WSP(float, OFF_RSTD), WSP(h16, OFF_H16)); xcd_barrier(bar); }
    }
}

extern "C" void kernel_launch(void* const* d_in, const int* in_sizes, int n_in, void* d_out, int out_size, void* d_ws, size_t ws_size, hipStream_t stream) {
    static int grid = 0;
    if (grid == 0) {
        int dev = 0, cus = 0, per_cu = 0;
        (void)hipGetDevice(&dev);
        (void)hipDeviceGetAttribute(&cus, hipDeviceAttributeMultiprocessorCount, dev);
        (void)hipFuncSetAttribute((const void*)mega, hipFuncAttributeMaxDynamicSharedMemorySize, LDS_BYTES);
        (void)hipOccupancyMaxActiveBlocksPerMultiprocessor(&per_cu, (const void*)mega, NTHR, LDS_BYTES);
        (void)hipGetLastError();
        grid = cus > 0 ? cus : 256;
    }
    (void)hipMemsetAsync((char*)d_ws + OFF_CTL, 0, 16384, stream);
    Params p{};
    for (int i = 0; i < 12; ++i) p.in[i] = (const float*)d_in[i];
    p.out = (float*)d_out; p.ws = (unsigned char*)d_ws;
    hipLaunchKernelGGL(mega, dim3(grid), dim3(NTHR), LDS_BYTES, stream, p);
}
```

```cpp
#include <hip/hip_runtime.h>
#include <stdint.h>
#include <math.h>

typedef _Float16 h16;
#define DEVI __device__ __forceinline__
DEVI int ogw();
DEVI int otid() { int t = threadIdx.x; asm volatile("" : "+v"(t)); return t; }

constexpr int NB = 8, SEQ = 2048, DM = 1024, NT = NB * SEQ, INC = 3976, MYC = 4096;
constexpr float LOG2E = 1.4426950408889634f;
constexpr float EPS = 1e-6f;

DEVI int ogw() { return blockIdx.x * 8 + (otid() >> 6); }
__host__ __device__ constexpr int ref_col(int my) {
    if (my < 352) return my;
    if (my < 384) return -1;
    if (my < 640) return 352 + (my - 384);
    if (my < 896) return 1376 + (my - 640);
    if (my < 1152) return 2696 + (my - 896);
    if (my < 1408) return 3720 + (my - 1152);
    if (my < 1664) return 608 + (my - 1408);
    if (my < 1920) return 864 + (my - 1664);
    if (my < 2176) return 1632 + (my - 1920);
    if (my < 2432) return 1888 + (my - 2176);
    if (my < 2688) return 2952 + (my - 2432);
    if (my < 2944) return 3208 + (my - 2688);
    if (my < 3200) return 1120 + (my - 2944);
    if (my < 3456) return 2144 + (my - 3200);
    if (my < 3712) return 3464 + (my - 3456);
    if (my < 3968) return 2400 + (my - 3712);
    if (my < 4000) return 2656 + (my - 3968);
    if (my < 4008) return 2688 + (my - 4000);
    return -1;
}

constexpr size_t MiB = 1024 * 1024;
constexpr size_t OFF_CTL = 0;
constexpr size_t OFF_RSTD = 64 * 1024;
constexpr size_t OFF_BIAS = 128 * 1024;
constexpr size_t OFF_COS = 256 * 1024;
constexpr size_t OFF_SIN = 384 * 1024;
constexpr size_t OFF_CA = 1 * MiB;
constexpr size_t OFF_GATE = OFF_CA + 12 * MiB;
constexpr size_t OFF_QB = OFF_GATE + 32 * MiB;
constexpr size_t OFF_KB = OFF_QB + 8 * MiB;
constexpr size_t OFF_QC = OFF_KB + 8 * MiB;
constexpr size_t OFF_KC = OFF_QC + 8 * MiB;
constexpr size_t OFF_QD = OFF_KC + 8 * MiB;
constexpr size_t OFF_KD = OFF_QD + 8 * MiB;
constexpr size_t OFF_IDX = OFF_KD + 8 * MiB;
constexpr size_t OFF_MIX = OFF_IDX + 10 * MiB;
constexpr size_t OFF_VTMP = OFF_MIX + 32 * MiB;
constexpr size_t OFF_MASK = OFF_VTMP + 24 * MiB;
constexpr size_t OFF_H16 = OFF_MASK + 4 * MiB;
constexpr size_t OFF_QA = OFF_H16;
constexpr size_t OFF_KA = OFF_QA + 12 * MiB;
constexpr size_t OFF_KAR = OFF_KA + 8 * MiB;
constexpr size_t OFF_VAT = OFF_KAR + 1 * MiB;
constexpr size_t OFF_WINT = OFF_H16 + 32 * MiB;
constexpr size_t OFF_WOUTT = OFF_WINT + 16 * MiB;
constexpr size_t OFF_WUQT = OFF_WOUTT + 4 * MiB;
constexpr size_t OFF_WUKVT = OFF_WUQT + 512 * 1024;
constexpr size_t OFF_VT = OFF_WUKVT + 512 * 1024;
constexpr size_t OFF_END = OFF_VT + 40 * MiB;
static_assert(OFF_END <= 256 * MiB, "ws map");

struct Route { int buf; int dcol; int pitch; float scale; int silu; };
__host__ __device__ inline Route route(int my) {
    Route r{-1, 0, 0, 1.f, 0};
    if (my < 384) { r.buf = 0; r.dcol = my; r.pitch = 384; }
    else if (my < 1408) { r.buf = 1; r.dcol = my - 384; r.pitch = 1024; r.silu = 1; }
    else if (my < 1664) { r.buf = 2; r.dcol = my - 1408; r.pitch = 256; r.scale = 0.125f * LOG2E; }
    else if (my < 1920) { r.buf = 3; r.dcol = my - 1664; r.pitch = 256; }
    else if (my < 2176) { r.buf = 4; r.dcol = my - 1920; r.pitch = 256; r.scale = 0.125f * LOG2E; }
    else if (my < 2432) { r.buf = 5; r.dcol = my - 2176; r.pitch = 256; }
    else if (my < 2688) { r.buf = 6; r.dcol = my - 2432; r.pitch = 256; r.scale = 0.17677669529663687f * LOG2E; }
    else if (my < 2944) { r.buf = 7; r.dcol = my - 2688; r.pitch = 256; }
    else if (my < 3712) { r.buf = 8; r.dcol = my - 2944; r.pitch = 768; }
    else if (my < 4032) { r.buf = 9; r.dcol = my - 3712; r.pitch = 320; r.scale = (my < 3968) ? 0.17677669529663687f : 1.f; }
    return r;
}
DEVI size_t buf_off(int buf) {
    switch (buf) {
        case 0: return OFF_CA; case 1: return OFF_GATE; case 2: return OFF_QB; case 3: return OFF_KB; case 4: return OFF_QC;
        case 5: return OFF_KC; case 6: return OFF_QD; case 7: return OFF_KD; case 8: return OFF_VTMP; default: return OFF_IDX;
    }
}

__device__ __constant__ int kBucketStart[16] = {16, 22, 30, 40, 54, 73, 99, 134, 182, 246, 332, 450, 609, 825, 1117, 1513};
DEVI int t5_bucket(int n) {
    if (n < 16) return n;
    int b = 16;
#pragma unroll
    for (int j = 1; j < 16; ++j) b += (n >= kBucketStart[j]) ? 1 : 0;
    return b;
}


#define XB_TMO      128
#define XB_XCNT(j)  (256  + 64 * (j))
#define XB_XSUB(j)  (1280 + 64 * (j))
#define XB_XGEN(j)  (2304 + 64 * (j))
#define XB_TOP      3328
#define XB_TOPGEN   3392
#define XCD_BAR_WORDS 3456
#define XB_SPIN_CAP (1u << 18)
#define LAS __attribute__((address_space(3)))
__device__ __forceinline__ unsigned xb_ld(unsigned* p)              { return __hip_atomic_load(p, __ATOMIC_RELAXED, __HIP_MEMORY_SCOPE_AGENT); }
__device__ __forceinline__ unsigned xb_add(unsigned* p, unsigned v) { return __hip_atomic_fetch_add(p, v, __ATOMIC_RELAXED, __HIP_MEMORY_SCOPE_AGENT); }
__device__ __forceinline__ unsigned xb_xcc_id() { return (unsigned)__builtin_amdgcn_s_getreg((3 << 11) | 20) & 0xFu; }
#define XB_SPIN(cond, bar) do { unsigned _sp = 0; while (cond) { __builtin_amdgcn_s_sleep(1); \
    if ((++_sp & 255u) == 0u) { if (xb_ld(&(bar)[XB_TMO])) break; if (_sp > XB_SPIN_CAP) { atomicAdd(&(bar)[XB_TMO], 1u); break; } } } } while (0)
struct XcdBarrier { unsigned* bar; unsigned x; volatile LAS unsigned* st; };
__device__ __forceinline__ XcdBarrier xcd_barrier_post(unsigned* bar, volatile LAS unsigned* st) {
    XcdBarrier b; b.bar = bar; b.x = xb_xcc_id(); b.st = st;
    if (threadIdx.x == 0) (void)xb_add(&bar[XB_XCNT(b.x)], 1u);
    return b;
}
__device__ __forceinline__ void xcd_barrier_complete(unsigned* bar, unsigned x, unsigned& nloc, unsigned& nx) {
    const unsigned G = gridDim.x * gridDim.y * gridDim.z;
    unsigned sum, cnt, mine, sp = 0u;
    for (;;) {
        sum = 0u; cnt = 0u; mine = 0u;
#pragma unroll
        for (unsigned j = 0; j < 16; ++j) { const unsigned c = xb_ld(&bar[XB_XCNT(j)]); sum += c; cnt += (c > 0u) ? 1u : 0u; mine = (j == x) ? c : mine; }
        if (sum == G) break;
        __builtin_amdgcn_s_sleep(1);
        if ((++sp & 255u) == 0u) { if (xb_ld(&bar[XB_TMO])) break; if (sp > XB_SPIN_CAP) { atomicAdd(&bar[XB_TMO], 1u); break; } }
    }
    nloc = mine > 0u ? mine : 1u; nx = cnt > 0u ? cnt : 1u;
}
__device__ __forceinline__ void xcd_barrier(const XcdBarrier& b) {
    asm volatile("s_waitcnt vmcnt(0)" ::: "memory");
    __syncthreads();
    if (otid() == 0) {
        unsigned* bar = b.bar; unsigned bx = b.x; asm volatile("" : "+s"(bx));
        __builtin_amdgcn_s_waitcnt(0);
        unsigned nloc = b.st[0], nx = b.st[1];
        if (nloc == 0u) { xcd_barrier_complete(bar, bx, nloc, nx); b.st[0] = nloc; b.st[1] = nx; }
        const unsigned old = xb_add(&bar[XB_XSUB(bx)], 1u);
        const unsigned gen = old / nloc;
        if (old + 1u == (gen + 1u) * nloc) {
            __builtin_amdgcn_fence(__ATOMIC_RELEASE, "agent");
            asm volatile("s_waitcnt vmcnt(0)" ::: "memory");
            const unsigned og = xb_add(&bar[XB_TOP], 1u);
            const unsigned tg = og / nx;
            if (og + 1u == (tg + 1u) * nx) xb_add(&bar[XB_TOPGEN], 1u);
            else XB_SPIN(xb_ld(&bar[XB_TOPGEN]) == tg, bar);
            __builtin_amdgcn_fence(__ATOMIC_ACQUIRE, "agent");
            xb_add(&bar[XB_XGEN(bx)], 1u);
            asm volatile("s_waitcnt vmcnt(0)" ::: "memory");
        } else {
            XB_SPIN(xb_ld(&bar[XB_XGEN(bx)]) == gen, bar);
            __builtin_amdgcn_fence(__ATOMIC_ACQUIRE, "agent");
            asm volatile("s_waitcnt vmcnt(0)" ::: "memory");
        }
    }
    __syncthreads();
}

namespace pg8 {
#define PG8_LAS __attribute__((address_space(3)))
typedef unsigned short bf16_t;
typedef _Float16 f16x8 __attribute__((ext_vector_type(8)));
typedef float f32x4 __attribute__((ext_vector_type(4)));
typedef unsigned u32x4 __attribute__((ext_vector_type(4)));
constexpr int BM = 256, BK = 64, HALF = 128, HTB = HALF * BK * 2  , STAGE_BYTES = 8 * HTB, NXCD = 8, WGM = 8;

__host__ __device__ __forceinline__ int lds_byte(int r, int c) { const int st = (r >> 4) * 2 + (c >> 5), rr = r & 15, cc = c & 31, ob = rr * 64 + cc * 2; return st * 1024 + (ob ^ (((ob >> 9) & 1) << 5)); }
__host__ __device__ __forceinline__ void stage_rc(int b, int& R, int& C) { const int st = b / 1024, sb = b % 1024, swz = sb ^ (((sb >> 9) & 1) << 5); R = (st >> 1) * 16 + swz / 64; C = (st & 1) * 32 + (swz % 64) / 2; }
__host__ __device__ __forceinline__ int perm32(int rho) { const int n = rho >> 4, i = rho & 15; return 8 * (i >> 2) + 4 * n + (i & 3); }

struct Unit { int pm, pn; };
struct Gemm { const bf16_t* A; const bf16_t* Bt; int M, N, K; };

struct StaticOrder {
    int nM, nN, nwg, G, c;
    __host__ __device__ void init(int M, int N, int G_, int c_) { nM = M / BM; nN = N / BM; nwg = nM * nN; G = G_; c = c_; }
    __host__ __device__ bool next(int i, Unit& u) const {
        const long L = (long)i * G + c; if (L >= nwg) return false;
        int wgid = (int)L; { const int q = nwg / NXCD, r = nwg % NXCD, xcd = wgid % NXCD, off = wgid / NXCD; wgid = (xcd < r ? xcd * (q + 1) : r * (q + 1) + (xcd - r) * q) + off; }
        const int nig = WGM * nN, gid = wgid / nig, fm = gid * WGM, gsz = (nM - fm) < WGM ? (nM - fm) : WGM;
        u.pm = fm + ((wgid % nig) % gsz); u.pn = (wgid % nig) / gsz; return true;
    }
    __device__ __forceinline__ void a_ready(const Unit&) const {}
    __device__ __forceinline__ void done(const Unit&) const {}
};

template <class Epi, class Sched, bool ALIGN_EPI = false, bool SP2 = false>
__device__ __forceinline__ void gemm_phase(PG8_LAS unsigned char* lds, const Gemm g, const Sched& S, const Epi& E) {
    const int tid = otid(), wid = __builtin_amdgcn_readfirstlane(tid >> 6), lane = tid & 63, wr = wid >> 2, wc = wid & 3, fr = lane & 15, fq = lane >> 4;
    const int K = g.K, nt = K / BK;
    unsigned voffA[2], voffB[2];
#pragma unroll
    for (int i = 0; i < 2; ++i) { int R, C; stage_rc(tid * 16 + i * 8192, R, C); const int Rb = Epi::PERM ? ((R & ~31) + perm32(R & 31)) : R;
        voffA[i] = (unsigned)(R * K + C) * 2u; voffB[i] = (unsigned)(Rb * K + C) * 2u; }
    const size_t kstep = (size_t)(BK * 2);
    const size_t hstep = (size_t)HALF * K * 2;
    const size_t tstep = 2 * hstep;
    const unsigned ldsw = (unsigned)wid * 1024u;
    const int aoff = lds_byte(wr * 64 + fr, fq * 8), boff = lds_byte(wc * 32 + fr, fq * 8);
#define PG8_SA(b, h) (((b) * 2 + (h)) * HTB)
#define PG8_SB(b, h) ((4 + (b) * 2 + (h)) * HTB)
#define PG8_STAGE(bufoff, gbase, voff) do { _Pragma("unroll") for (int _i = 0; _i < 2; ++_i) \
        __builtin_amdgcn_global_load_lds((const unsigned*)((const char*)(gbase) + (voff)[_i]), (PG8_LAS unsigned*)(lds + (bufoff) + ldsw + _i * 8192), 16, 0, 0); } while (0)
#define PG8_LDA(dst, b, h) do { _Pragma("unroll") for (int m = 0; m < 4; ++m) _Pragma("unroll") for (int k = 0; k < 2; ++k) dst[m][k] = *(const PG8_LAS f16x8*)(lds + PG8_SA(b, h) + aoff + m * 2048 + k * 1024); } while (0)
#define PG8_LDB(dst, b, h) do { _Pragma("unroll") for (int n = 0; n < 2; ++n) _Pragma("unroll") for (int k = 0; k < 2; ++k) dst[n][k] = *(const PG8_LAS f16x8*)(lds + PG8_SB(b, h) + boff + n * 2048 + k * 1024); } while (0)
#define PG8_MMA(ai, bj, At, Bt) do { __builtin_amdgcn_s_setprio(1); _Pragma("unroll") for (int m = 0; m < 4; ++m) _Pragma("unroll") for (int n = 0; n < 2; ++n) _Pragma("unroll") for (int k = 0; k < 2; ++k) \
        acc[ai][bj][m][n] = __builtin_amdgcn_mfma_f32_16x16x32_f16(Bt[n][k], At[m][k], acc[ai][bj][m][n], 0, 0, 0); __builtin_amdgcn_s_setprio(0); } while (0)
#define PG8_WAIT_V(n) asm volatile("s_waitcnt vmcnt(" #n ")" ::: "memory")
#define PG8_WAIT_L(n) asm volatile("s_waitcnt lgkmcnt(" #n ")" ::: "memory")
#define PG8_BAR __builtin_amdgcn_s_barrier()
#define PG8_SCHED __builtin_amdgcn_sched_barrier(0)
    Unit cur, nxt; int ui = 0;
    if (!S.next(0, cur)) return;
    f32x4 acc[2][2][4][2];
#pragma unroll
    for (int a = 0; a < 2; ++a)
#pragma unroll
        for (int b = 0; b < 2; ++b)
#pragma unroll
            for (int m = 0; m < 4; ++m)
#pragma unroll
                for (int n = 0; n < 2; ++n) acc[a][b][m][n] = (f32x4){0.f, 0.f, 0.f, 0.f};
    f16x8 At[4][2], B0[2][2], B1[2][2];
    const char* cA = (const char*)g.A + (size_t)cur.pm * tstep; const char* cB = (const char*)g.Bt + (size_t)cur.pn * tstep;
    S.a_ready(cur);
    if constexpr (SP2) {
        PG8_STAGE(PG8_SB(0, 0), cB, voffB); PG8_STAGE(PG8_SB(0, 1), cB + hstep, voffB); PG8_STAGE(PG8_SA(0, 0), cA, voffA); PG8_STAGE(PG8_SA(0, 1), cA + hstep, voffA);
        if (wr == 1) PG8_BAR;
        PG8_WAIT_V(2); PG8_BAR;
        PG8_STAGE(PG8_SB(1, 0), cB + kstep, voffB); PG8_STAGE(PG8_SA(1, 0), cA + kstep, voffA); PG8_STAGE(PG8_SB(1, 1), cB + hstep + kstep, voffB);
        PG8_WAIT_V(6); PG8_BAR;
    } else {
        PG8_STAGE(PG8_SB(0, 0), cB, voffB); PG8_STAGE(PG8_SA(0, 0), cA, voffA); PG8_STAGE(PG8_SB(0, 1), cB + hstep, voffB); PG8_STAGE(PG8_SA(0, 1), cA + hstep, voffA);
        if (wr == 1) PG8_BAR;
        PG8_WAIT_V(4); PG8_BAR;
        PG8_STAGE(PG8_SB(1, 0), cB + kstep, voffB); PG8_STAGE(PG8_SA(1, 0), cA + kstep, voffA); PG8_STAGE(PG8_SB(1, 1), cB + hstep + kstep, voffB);
        PG8_WAIT_V(6); PG8_BAR;
    }
    for (;;) {
        const bool has_next = S.next(ui + 1, nxt);
        const char* nA = has_next ? (const char*)g.A + (size_t)nxt.pm * tstep : cA; const char* nB = has_next ? (const char*)g.Bt + (size_t)nxt.pn * tstep : cB;
        for (int t = 0; t < nt; t += 2) {
            const bool last = (t == nt - 2);
            const char* a1 = cA + (size_t)(t + 1) * kstep;
            const char* a2 = last ? nA : cA + (size_t)(t + 2) * kstep; const char* b2 = last ? nB : cB + (size_t)(t + 2) * kstep;
            const char* a3 = a2 + kstep; const char* b3 = b2 + kstep;
            if (last && has_next) S.a_ready(nxt);
            if constexpr (SP2) {
            PG8_LDB(B0, 0, 0); PG8_LDB(B1, 0, 1); PG8_SCHED; PG8_LDA(At, 0, 0); PG8_STAGE(PG8_SA(1, 1), a1 + hstep, voffA);
            PG8_WAIT_V(8); PG8_WAIT_L(0); PG8_BAR; PG8_MMA(0, 0, At, B0); PG8_MMA(0, 1, At, B1); PG8_BAR; PG8_SCHED;
            PG8_LDA(At, 0, 1); PG8_STAGE(PG8_SB(0, 0), b2, voffB); PG8_STAGE(PG8_SB(0, 1), b2 + hstep, voffB); PG8_STAGE(PG8_SA(0, 0), a2, voffA);
            PG8_WAIT_V(8); PG8_WAIT_L(0); PG8_BAR; PG8_MMA(1, 0, At, B0); PG8_MMA(1, 1, At, B1); PG8_BAR; PG8_SCHED;
            PG8_LDB(B0, 1, 0); PG8_LDB(B1, 1, 1); PG8_SCHED; PG8_LDA(At, 1, 0); PG8_STAGE(PG8_SA(0, 1), a2 + hstep, voffA);
            PG8_WAIT_V(8); PG8_WAIT_L(0); PG8_BAR; PG8_MMA(0, 0, At, B0); PG8_MMA(0, 1, At, B1); PG8_BAR; PG8_SCHED;
            PG8_LDA(At, 1, 1); PG8_STAGE(PG8_SB(1, 0), b3, voffB); PG8_STAGE(PG8_SB(1, 1), b3 + hstep, voffB); PG8_STAGE(PG8_SA(1, 0), a3, voffA);
            PG8_WAIT_V(8); PG8_WAIT_L(0); PG8_BAR; PG8_MMA(1, 0, At, B0); PG8_MMA(1, 1, At, B1); PG8_BAR; PG8_SCHED;
            } else {
            PG8_LDB(B0, 0, 0); PG8_SCHED; PG8_LDA(At, 0, 0); PG8_STAGE(PG8_SA(1, 1), a1 + hstep, voffA);
            PG8_WAIT_L(8); PG8_BAR; PG8_WAIT_L(0); PG8_MMA(0, 0, At, B0); PG8_BAR; PG8_SCHED;
            PG8_LDB(B1, 0, 1); PG8_STAGE(PG8_SB(0, 0), b2, voffB);
            PG8_BAR; PG8_WAIT_L(0); PG8_MMA(0, 1, At, B1); PG8_BAR;
            PG8_LDA(At, 0, 1); PG8_STAGE(PG8_SA(0, 0), a2, voffA);
            PG8_BAR; PG8_WAIT_L(0); PG8_MMA(1, 0, At, B0); PG8_BAR; PG8_SCHED;
            PG8_STAGE(PG8_SB(0, 1), b2 + hstep, voffB);
            PG8_WAIT_V(6); PG8_BAR; PG8_MMA(1, 1, At, B1); PG8_BAR;
            PG8_LDB(B0, 1, 0); PG8_SCHED; PG8_LDA(At, 1, 0); PG8_STAGE(PG8_SA(0, 1), a2 + hstep, voffA);
            PG8_WAIT_L(8); PG8_BAR; PG8_WAIT_L(0); PG8_MMA(0, 0, At, B0); PG8_BAR; PG8_SCHED;
            PG8_LDB(B1, 1, 1); PG8_STAGE(PG8_SB(1, 0), b3, voffB);
            PG8_BAR; PG8_WAIT_L(0); PG8_MMA(0, 1, At, B1); PG8_BAR;
            PG8_LDA(At, 1, 1); PG8_STAGE(PG8_SA(1, 0), a3, voffA);
            PG8_BAR; PG8_WAIT_L(0); PG8_MMA(1, 0, At, B0); PG8_BAR; PG8_SCHED;
            PG8_STAGE(PG8_SB(1, 1), b3 + hstep, voffB);
            PG8_WAIT_V(6); PG8_BAR; PG8_MMA(1, 1, At, B1); PG8_BAR;
            }
        }
        if constexpr (ALIGN_EPI) { if (wr == 0) PG8_BAR; }
        if constexpr (!Epi::AFTER_DRAIN) { E(acc, cur, wr, wc, fr, fq); S.done(cur); }
        if (!has_next) break;
#pragma unroll
        for (int a = 0; a < 2; ++a)
#pragma unroll
            for (int b = 0; b < 2; ++b)
#pragma unroll
                for (int m = 0; m < 4; ++m)
#pragma unroll
                    for (int n = 0; n < 2; ++n) acc[a][b][m][n] = (f32x4){0.f, 0.f, 0.f, 0.f};
        cur = nxt; cA = nA; cB = nB; ++ui;
        if constexpr (ALIGN_EPI) { if (wr == 1) PG8_BAR; }
    }
    PG8_WAIT_V(0);
    if constexpr (!ALIGN_EPI) { if (wr == 0) PG8_BAR; }
    PG8_BAR;
    if constexpr (Epi::AFTER_DRAIN) { E.fused(acc, cur, wr, wc, fr, fq, lds, wid, lane); S.done(cur); }
#undef PG8_SA
#undef PG8_SB
#undef PG8_STAGE
#undef PG8_LDA
#undef PG8_LDB
#undef PG8_MMA
#undef PG8_WAIT_V
#undef PG8_WAIT_L
#undef PG8_BAR
#undef PG8_SCHED
}
}


typedef float f32x4_t __attribute__((ext_vector_type(4)));
typedef _Float16 h16x8 __attribute__((ext_vector_type(8)));
DEVI float silu_f(float v) { return v / (1.f + __expf(-v)); }
struct EpiRoute {
    static constexpr bool PERM = true, AFTER_DRAIN = false;
    unsigned char* ws; const float* rstd;
    DEVI void operator()(const pg8::f32x4 (&acc)[2][2][4][2], const pg8::Unit& u, int wr, int wc, int fr, int fq) const {
        const int row0 = u.pm * 256 + wr * 64 + fr;
        float rs[2][4];
#pragma unroll
        for (int ai = 0; ai < 2; ++ai)
#pragma unroll
            for (int m = 0; m < 4; ++m) rs[ai][m] = rstd[row0 + ai * 128 + m * 16];
#pragma unroll
        for (int bj = 0; bj < 2; ++bj) {
            const int cg = u.pn * 256 + bj * 128 + wc * 32;
            const Route r = route(cg);
            if (r.buf < 0) continue;
            h16* base = (h16*)(ws + buf_off(r.buf)) + r.dcol + 8 * fq;
#pragma unroll
            for (int ai = 0; ai < 2; ++ai)
#pragma unroll
                for (int m = 0; m < 4; ++m) {
                    const int row = row0 + ai * 128 + m * 16; const float sc = rs[ai][m] * r.scale;
                    float v[8];
#pragma unroll
                    for (int j = 0; j < 4; ++j) { v[j] = acc[ai][bj][m][0][j] * sc; v[4 + j] = acc[ai][bj][m][1][j] * sc; }
                    if (r.silu) {
#pragma unroll
                        for (int j = 0; j < 8; ++j) v[j] = silu_f(v[j]);
                    }
                    h16x8 o;
#pragma unroll
                    for (int j = 0; j < 8; ++j) o[j] = (h16)v[j];
                    *(h16x8*)(base + (size_t)row * r.pitch) = o;
                }
        }
    }
};

constexpr int NTHR = 512, NWAVE = 8;

template <bool REF>
DEVI void cvt_transpose(const float* __restrict__ src, int src_pitch, const float* __restrict__ g, h16* dst, int N, int K, unsigned char* lds, int item0, int nitems_total, int& item_base) {
    const int tid = otid();
    float (*tile)[65] = (float (*)[65])lds;
    const int ntn = N / 64, ntk = K / 64, n_it = ntn * ntk;
    for (int it = item0; it < nitems_total; it += gridDim.x) {
        const int li = it - item_base; if (li < 0 || li >= n_it) continue;
        const int n0 = (li % ntn) * 64, k0 = (li / ntn) * 64;
        __syncthreads();
        const int c = tid & 63; int rc = n0 + c; if (REF) rc = ref_col(rc);
#pragma unroll
        for (int ps = 0; ps < 8; ++ps) { const int k = ps * 8 + (tid >> 6);
            tile[k][c] = rc >= 0 ? src[(size_t)(k0 + k) * src_pitch + rc] * (g ? g[k0 + k] : 1.f) : 0.f; }
        __syncthreads();
        const int cc = tid >> 3, kq = (tid & 7) * 8;
        h16x8 o;
#pragma unroll
        for (int j = 0; j < 8; ++j) o[j] = (h16)tile[kq + j][cc];
        *(h16x8*)(dst + (size_t)(n0 + cc) * K + k0 + kq) = o;
    }
    item_base += n_it;
}

DEVI void ph_rowstat_cvt(const float* h, float* rstd, h16* h16o) {
    const int t_ = otid(); const int lane = t_ & 63, gw = blockIdx.x * NWAVE + (t_ >> 6), nw = gridDim.x * NWAVE;
    for (int row = gw; row < NT; row += nw) {
        const float4* p = (const float4*)(h + (size_t)row * DM);
        float s = 0.f;
#pragma unroll
        for (int i = 0; i < 4; ++i) { float4 v = p[lane + 64 * i]; s += v.x * v.x + v.y * v.y + v.z * v.z + v.w * v.w;
            typedef _Float16 h16x4 __attribute__((ext_vector_type(4)));
            h16x4 o; o[0] = (h16)v.x; o[1] = (h16)v.y; o[2] = (h16)v.z; o[3] = (h16)v.w;
            *(h16x4*)(h16o + (size_t)row * DM + (lane + 64 * i) * 4) = o; }
        for (int o = 32; o; o >>= 1) s += __shfl_xor(s, o);
        if (lane == 0) rstd[row] = rsqrtf(s / DM + EPS);
    }
}

typedef float f32x16 __attribute__((ext_vector_type(16)));
typedef _Float16 h16x4 __attribute__((ext_vector_type(4)));
DEVI f32x16 mfma32(h16x8 a, h16x8 b, f32x16 c) { return __builtin_amdgcn_mfma_f32_32x32x16_f16(a, b, c, 0, 0, 0); }
#define CROW(r) (((r) & 3) + 8 * ((r) >> 2))
DEVI float xh_max(float x) { auto r = __builtin_amdgcn_permlane32_swap(__float_as_uint(x), __float_as_uint(x), false, false); return fmaxf(__uint_as_float(r[0]), __uint_as_float(r[1])); }
DEVI float xh_sum(float x) { auto r = __builtin_amdgcn_permlane32_swap(__float_as_uint(x), __float_as_uint(x), false, false); return __uint_as_float(r[0]) + __uint_as_float(r[1]); }
DEVI unsigned pk2h(float a, float b) { auto v = __builtin_amdgcn_cvt_pkrtz(a, b); return __builtin_bit_cast(unsigned, v); }
DEVI h16x8 pack8(const f32x16& p, int s) {
    typedef unsigned u32x4_t __attribute__((ext_vector_type(4)));
    u32x4_t w;
    w[0] = pk2h(p[8 * s + 0], p[8 * s + 1]); w[1] = pk2h(p[8 * s + 2], p[8 * s + 3]); w[2] = pk2h(p[8 * s + 4], p[8 * s + 5]); w[3] = pk2h(p[8 * s + 6], p[8 * s + 7]);
    return __builtin_bit_cast(h16x8, w);
}
DEVI h16x8 ldv8(const h16* p) {
    h16x4 a = *(const h16x4*)p, b = *(const h16x4*)(p + 8);
    h16x8 r; r[0] = a[0]; r[1] = a[1]; r[2] = a[2]; r[3] = a[3]; r[4] = b[0]; r[5] = b[1]; r[6] = b[2]; r[7] = b[3]; return r;
}
DEVI void softmax_tile(f32x16& S, float& m, float& l, f32x16& O0, f32x16& O1) {
    float mx = S[0];
#pragma unroll
    for (int r = 1; r < 16; ++r) mx = fmaxf(mx, S[r]);
    mx = xh_max(mx);
    if (__any(mx > m)) {
        const float mn = fmaxf(m, mx), al = __builtin_amdgcn_exp2f(m - mn);
        l *= al; O0 *= al; O1 *= al; m = mn;
    }
    float ls = 0.f;
#pragma unroll
    for (int r = 0; r < 16; ++r) { S[r] = __builtin_amdgcn_exp2f(S[r] - m); ls += S[r]; }
    l += ls;
}
DEVI int wq_next(unsigned* ctr) {
    int e = 0;
    if ((otid() & 63) == 0) e = (int)__hip_atomic_fetch_add(ctr, 1u, __ATOMIC_RELAXED, __HIP_MEMORY_SCOPE_AGENT);
    return __builtin_amdgcn_readfirstlane(e);
}

DEVI void flashA_item(int b, int hh, int qt, const h16* qA, const h16* kA, const h16* kAr, const h16* vAT, const h16* gate, h16* mix) {
    const int lane = otid() & 63, q = lane & 31, h = lane >> 5;
    const size_t tokq = (size_t)b * SEQ + qt * 32 + q;
    h16x8 qf[6];
#pragma unroll
    for (int ks = 0; ks < 6; ++ks) qf[ks] = *(const h16x8*)(qA + tokq * 384 + hh * 96 + ks * 16 + 8 * h);
    f32x16 O0 = {}, O1 = {};
    float m = -1e30f, l = 0.f;
    const h16* vbase = vAT + ((size_t)(b * 4 + hh) * 64 + q) * SEQ + 4 * h;
    h16x8 kf[6];
    {
        const size_t tk = (size_t)b * SEQ + q;
#pragma unroll
        for (int ks = 0; ks < 4; ++ks) kf[ks] = *(const h16x8*)(kA + tk * 256 + hh * 64 + ks * 16 + 8 * h);
#pragma unroll
        for (int ks = 0; ks < 2; ++ks) kf[4 + ks] = *(const h16x8*)(kAr + tk * 32 + ks * 16 + 8 * h);
    }
    for (int j = 0; j <= qt; ++j) {
        const int s0 = j * 32;
        h16x8 vf[2][2];
#pragma unroll
        for (int db = 0; db < 2; ++db)
#pragma unroll
            for (int sk = 0; sk < 2; ++sk) vf[db][sk] = ldv8(vbase + (size_t)db * 32 * SEQ + s0 + 16 * sk);
        f32x16 S = {};
#pragma unroll
        for (int ks = 0; ks < 6; ++ks) S = mfma32(kf[ks], qf[ks], S);
        if (j < qt) {
            const size_t tk = (size_t)b * SEQ + s0 + 32 + q;
#pragma unroll
            for (int ks = 0; ks < 4; ++ks) kf[ks] = *(const h16x8*)(kA + tk * 256 + hh * 64 + ks * 16 + 8 * h);
#pragma unroll
            for (int ks = 0; ks < 2; ++ks) kf[4 + ks] = *(const h16x8*)(kAr + tk * 32 + ks * 16 + 8 * h);
        } else {
#pragma unroll
            for (int r = 0; r < 16; ++r) S[r] = (CROW(r) + 4 * h > q) ? -3e38f : S[r];
        }
        softmax_tile(S, m, l, O0, O1);
        const h16x8 p0 = pack8(S, 0), p1 = pack8(S, 1);
        O0 = mfma32(vf[0][0], p0, O0); O0 = mfma32(vf[0][1], p1, O0);
        O1 = mfma32(vf[1][0], p0, O1); O1 = mfma32(vf[1][1], p1, O1);
    }
    const float il = 1.f / xh_sum(l);
    const h16* gp = gate + tokq * 1024 + hh * 64 + 4 * h; h16* op = mix + tokq * 1024 + hh * 64 + 4 * h;
#pragma unroll
    for (int db = 0; db < 2; ++db)
#pragma unroll
        for (int g = 0; g < 4; ++g) {
            const h16x4 gv = *(const h16x4*)(gp + db * 32 + 8 * g); h16x4 o;
#pragma unroll
            for (int e = 0; e < 4; ++e) o[e] = (h16)((db ? O1[4 * g + e] : O0[4 * g + e]) * il * (float)gv[e]);
            *(h16x4*)(op + db * 32 + 8 * g) = o;
        }
}

constexpr int L_NEAR = 0, L_R3 = 12288, L_R2 = 15360, L_R1 = 21504, L_LAM = 39936, L_P2END = 40000;
DEVI void p2_setup(const float* biasTab, const float* lam_p, float lambda_init, unsigned char* lds) {
    const int tid = otid();
    float* nearR = (float*)(lds + L_NEAR);
    for (int i = tid; i < 12 * 256; i += NTHR) { const int hb = i >> 8, u = i & 255, tix = 223 - u; nearR[i] = tix < 0 ? -3e38f : biasTab[hb * 2048 + tix]; }
    float* R3 = (float*)(lds + L_R3); float* R2 = (float*)(lds + L_R2); float* R1 = (float*)(lds + L_R1);
    for (int i = tid; i < 4 * 192; i += NTHR) { const int hb = i / 192, kk = 159 - (i % 192); R3[i] = (kk < 0 || kk > 128) ? -3e38f : biasTab[hb * 2048 + kk * 16]; }
    for (int i = tid; i < 4 * 384; i += NTHR) { const int hb = i / 384, kk = 255 - (i % 384); R2[i] = (kk < 0 || kk > 128) ? -3e38f : biasTab[hb * 2048 + kk * 4]; }
    for (int i = tid; i < 4 * 1152; i += NTHR) { const int hb = i / 1152, kk = 639 - (i % 1152); R1[i] = (kk < 0 || kk > 128) ? -3e38f : biasTab[hb * 2048 + kk]; }
    if (tid == 0) { float a1 = 0.f, a2 = 0.f; for (int i = 0; i < 32; ++i) { a1 += lam_p[i] * lam_p[32 + i]; a2 += lam_p[64 + i] * lam_p[96 + i]; }
        *(float*)(lds + L_LAM) = expf(a1) - expf(a2) + lambda_init; }
    __syncthreads();
}

DEVI void ph_vtrans(const h16* vtmp, h16* VT, unsigned char* lds) {
    const int tid = otid();
    h16 (*tile)[72] = (h16 (*)[72])lds;
    constexpr size_t VSZ = (size_t)32 * 64 * SEQ;
    for (int it = blockIdx.x; it < 3 * 32 * 32; it += gridDim.x) {
        const int src = it / 1024, bh = (it >> 5) & 31, s0 = (it & 31) * 64, b = bh >> 2, hh = bh & 3;
        __syncthreads();
        { const int r = tid >> 3, c8 = tid & 7;
          *(h16x8*)&tile[r][c8 * 8] = *(const h16x8*)(vtmp + ((size_t)b * SEQ + s0 + r) * 768 + src * 256 + hh * 64 + c8 * 8); }
        __syncthreads();
        const int d = tid >> 3;
        h16* rowN = VT + (src == 0 ? 0 : (src == 1 ? 3 * VSZ : 4 * VSZ)) + ((size_t)bh * 64 + d) * SEQ;
        { const int t8 = (tid & 7) * 8; h16x8 o;
#pragma unroll
          for (int j = 0; j < 8; ++j) o[j] = tile[t8 + j][d];
          *(h16x8*)(rowN + s0 + t8) = o; }
        if (src == 0) {
            const int blk = s0 >> 8;
            { const int r4 = (tid & 7) >> 1, half = tid & 1, i0 = (s0 & 255) >> 2; h16x8 o;
#pragma unroll
              for (int j = 0; j < 8; ++j) o[j] = tile[4 * (half * 8 + j) + r4][d];
              *(h16x8*)(rowN + VSZ + blk * 256 + r4 * 64 + i0 + half * 8) = o; }
            { const int i0 = (s0 & 255) >> 4;
#pragma unroll
              for (int rr = 0; rr < 2; ++rr) { const int r16 = 2 * (tid & 7) + rr; h16x4 o;
#pragma unroll
                  for (int j = 0; j < 4; ++j) o[j] = tile[16 * j + r16][d];
                  *(h16x4*)(rowN + 2 * VSZ + blk * 256 + r16 * 16 + i0) = o; } }
        }
    }
}

template <int NMAP, bool MASK>
DEVI void flashCD_item(int b, int hh, int qt, int hb, const h16* Q, const h16* K, const h16* VT, const unsigned* mask, const float* biasTab, const unsigned char* lds,
                       const float* subln, float lambda_init, const h16* gate, h16* mix, int mixcol) {
    constexpr int NKS = 4 / NMAP;
    const int lane = otid() & 63, q = lane & 31, h = lane >> 5;
    const size_t tokq = (size_t)b * SEQ + qt * 32 + q;
    h16x8 qf[NMAP][NKS], kf[NMAP][NKS];
#pragma unroll
    for (int mp = 0; mp < NMAP; ++mp)
#pragma unroll
        for (int ks = 0; ks < NKS; ++ks) {
            qf[mp][ks] = *(const h16x8*)(Q + tokq * 256 + hh * 64 + (mp * NKS + ks) * 16 + 8 * h);
            kf[mp][ks] = *(const h16x8*)(K + ((size_t)b * SEQ + q) * 256 + hh * 64 + (mp * NKS + ks) * 16 + 8 * h);
        }
    f32x16 O[NMAP][2]; float m[NMAP], l[NMAP];
#pragma unroll
    for (int mp = 0; mp < NMAP; ++mp) { O[mp][0] = (f32x16){}; O[mp][1] = (f32x16){}; m[mp] = -1e30f; l[mp] = 0.f; }
    const h16* vbase = VT + ((size_t)(b * 4 + hh) * 64 + q) * SEQ + 4 * h;
    const float* nearR = (const float*)(lds + L_NEAR) + hb * 256;
    const float* bt = biasTab + hb * 2048;
    for (int j = 0; j <= qt; ++j) {
        const int s0 = j * 32;
        h16x8 vf[2][2];
#pragma unroll
        for (int db = 0; db < 2; ++db)
#pragma unroll
            for (int sk = 0; sk < 2; ++sk) vf[db][sk] = ldv8(vbase + (size_t)db * 32 * SEQ + s0 + 16 * sk);
        unsigned mw = 0xffffffffu;
        if (MASK) mw = mask[tokq * 64 + j] >> (4 * h);
        f32x16 S[NMAP];
#pragma unroll
        for (int mp = 0; mp < NMAP; ++mp) { S[mp] = (f32x16){};
#pragma unroll
            for (int ks = 0; ks < NKS; ++ks) S[mp] = mfma32(kf[mp][ks], qf[mp][ks], S[mp]); }
        if (j < qt) {
            const size_t tk = (size_t)b * SEQ + s0 + 32 + q;
#pragma unroll
            for (int mp = 0; mp < NMAP; ++mp)
#pragma unroll
                for (int ks = 0; ks < NKS; ++ks) kf[mp][ks] = *(const h16x8*)(K + tk * 256 + hh * 64 + (mp * NKS + ks) * 16 + 8 * h);
        }
        const int D0 = (qt - j) * 32;
        if (D0 < 192) {
            const float* tp = nearR + (223 - D0 - q + 4 * h);
#pragma unroll
            for (int r = 0; r < 16; ++r) { const float bv = tp[CROW(r)];
#pragma unroll
                for (int mp = 0; mp < NMAP; ++mp) S[mp][r] += bv; }
        } else {
            const float lo = bt[D0 - 31], hi = bt[D0 + 31];
            if (lo == hi) {
#pragma unroll
                for (int mp = 0; mp < NMAP; ++mp) S[mp] += lo;
            } else {
                int bnd = 0;
#pragma unroll
                for (int jj = 8; jj < 16; ++jj) bnd = (D0 + 31 >= kBucketStart[jj]) ? kBucketStart[jj] : bnd;
                const int x = D0 + q - 4 * h - bnd;
#pragma unroll
                for (int r = 0; r < 16; ++r) { const float bv = (x >= CROW(r)) ? hi : lo;
#pragma unroll
                    for (int mp = 0; mp < NMAP; ++mp) S[mp][r] += bv; }
            }
        }
        if (MASK) {
#pragma unroll
            for (int r = 0; r < 16; ++r) S[0][r] = ((mw >> CROW(r)) & 1u) ? S[0][r] : -3e38f;
        }
#pragma unroll
        for (int mp = 0; mp < NMAP; ++mp) {
            softmax_tile(S[mp], m[mp], l[mp], O[mp][0], O[mp][1]);
            const h16x8 p0 = pack8(S[mp], 0), p1 = pack8(S[mp], 1);
            O[mp][0] = mfma32(vf[0][0], p0, O[mp][0]); O[mp][0] = mfma32(vf[0][1], p1, O[mp][0]);
            O[mp][1] = mfma32(vf[1][0], p0, O[mp][1]); O[mp][1] = mfma32(vf[1][1], p1, O[mp][1]);
        }
    }
    f32x16 R0, R1;
    if (NMAP == 2) {
        const float lam = *(const float*)(lds + L_LAM);
        const float i0 = 1.f / xh_sum(l[0]), i1 = lam / xh_sum(l[NMAP - 1]);
        R0 = O[0][0] * i0 - O[NMAP - 1][0] * i1; R1 = O[0][1] * i0 - O[NMAP - 1][1] * i1;
        float ss = 0.f;
#pragma unroll
        for (int r = 0; r < 16; ++r) ss += R0[r] * R0[r] + R1[r] * R1[r];
        ss = xh_sum(ss);
        const float rs = rsqrtf(ss * (1.f / 64.f) + EPS) * (1.f - lambda_init);
        R0 *= rs; R1 *= rs;
    } else {
        const float il = 1.f / xh_sum(l[0]);
        R0 = O[0][0] * il; R1 = O[0][1] * il;
    }
    const h16* gp = gate + tokq * 1024 + mixcol + hh * 64 + 4 * h; h16* op = mix + tokq * 1024 + mixcol + hh * 64 + 4 * h;
#pragma unroll
    for (int db = 0; db < 2; ++db)
#pragma unroll
        for (int g = 0; g < 4; ++g) {
            const h16x4 gv = *(const h16x4*)(gp + db * 32 + 8 * g); h16x4 o;
#pragma unroll
            for (int e = 0; e < 4; ++e) { float v = (db ? R1[4 * g + e] : R0[4 * g + e]) * (float)gv[e];
                if (NMAP == 2) v *= subln[db * 32 + 8 * g + 4 * h + e];
                o[e] = (h16)v; }
            *(h16x4*)(op + db * 32 + 8 * g) = o;
        }
}

DEVI void flashB_tile(const h16x8 (&qf)[4], const h16* krow, const h16* vrow, int vstep, const float* tp, f32x16& O0, f32x16& O1, float& m, float& l, int h) {
    h16x8 vf[2][2];
#pragma unroll
    for (int db = 0; db < 2; ++db)
#pragma unroll
        for (int sk = 0; sk < 2; ++sk) vf[db][sk] = ldv8(vrow + (size_t)db * 32 * SEQ + vstep * sk);
    f32x16 S = {};
#pragma unroll
    for (int ks = 0; ks < 4; ++ks) S = mfma32(*(const h16x8*)(krow + ks * 16 + 8 * h), qf[ks], S);
#pragma unroll
    for (int r = 0; r < 16; ++r) S[r] += tp[CROW(r)];
    softmax_tile(S, m, l, O0, O1);
    const h16x8 p0 = pack8(S, 0), p1 = pack8(S, 1);
    O0 = mfma32(vf[0][0], p0, O0); O0 = mfma32(vf[0][1], p1, O0);
    O1 = mfma32(vf[1][0], p0, O1); O1 = mfma32(vf[1][1], p1, O1);
}
DEVI void flashB_item(int b, int hh, int r, int qg, const h16* Q, const h16* K, const h16* VT, const unsigned char* lds, const h16* gate, h16* mix) {
    constexpr size_t VSZ = (size_t)32 * 64 * SEQ;
    const int lane = otid() & 63, q = lane & 31, h = lane >> 5;
    const size_t tokq = (size_t)b * SEQ + qg * 512 + 16 * q + r;
    h16x8 qf[4];
#pragma unroll
    for (int ks = 0; ks < 4; ++ks) qf[ks] = *(const h16x8*)(Q + tokq * 256 + hh * 64 + ks * 16 + 8 * h);
    f32x16 O0 = {}, O1 = {}; float m = -1e30f, l = 0.f;
    const h16* Kb = K + (size_t)b * SEQ * 256 + hh * 64;
    const h16* Vb = VT + ((size_t)(b * 4 + hh) * 64 + q) * SEQ + 4 * h;
    {
        const float* R3 = (const float*)(lds + L_R3) + hh * 192;
        for (int pk0 = (qg >= 4 ? qg - 4 : 0) * 32; pk0 <= qg * 32; pk0 += 32) {
            const int c = qg * 32 + q - pk0;
            flashB_tile(qf, Kb + (size_t)(16 * (pk0 + q) + r) * 256, Vb + 2 * VSZ + (pk0 >> 4) * 256 + r * 16, 256, R3 + (159 - c + 4 * h), O0, O1, m, l, h);
        }
    }
    {
        const float* R2 = (const float*)(lds + L_R2) + hh * 384; const int r4 = r & 3;
        for (int pk0 = (qg >= 1 ? qg * 128 - 128 : 0); pk0 <= qg * 128 + 96; pk0 += 32) {
            const int c = qg * 128 + 4 * q + (r >> 2) - pk0;
            flashB_tile(qf, Kb + (size_t)(4 * (pk0 + q) + r4) * 256, Vb + VSZ + (pk0 >> 6) * 256 + r4 * 64 + (pk0 & 63), 16, R2 + (255 - c + 4 * h), O0, O1, m, l, h);
        }
    }
    {
        const float* R1 = (const float*)(lds + L_R1) + hh * 1152;
        for (int s0 = (qg >= 1 ? qg * 512 - 128 : 0); s0 <= qg * 512 + 480; s0 += 32) {
            const int c = qg * 512 + 16 * q + r - s0;
            flashB_tile(qf, Kb + (size_t)(s0 + q) * 256, Vb + s0, 16, R1 + (639 - c + 4 * h), O0, O1, m, l, h);
        }
    }
    const float il = 1.f / xh_sum(l);
    const h16* gp = gate + tokq * 1024 + 256 + hh * 64 + 4 * h; h16* op = mix + tokq * 1024 + 256 + hh * 64 + 4 * h;
#pragma unroll
    for (int db = 0; db < 2; ++db)
#pragma unroll
        for (int g = 0; g < 4; ++g) {
            const h16x4 gv = *(const h16x4*)(gp + db * 32 + 8 * g); h16x4 o;
#pragma unroll
            for (int e = 0; e < 4; ++e) o[e] = (h16)((db ? O1[4 * g + e] : O0[4 * g + e]) * il * (float)gv[e]);
            *(h16x4*)(op + db * 32 + 8 * g) = o;
        }
}

constexpr int LDS_BYTES = 144 * 1024;
struct Params { const float* in[12]; float* out; unsigned char* ws; };

DEVI void ph_tables(const float* __restrict__ rel_bias, float* biasTab, float* cosT, float* sinT) {
    for (int i = blockIdx.x * NTHR + threadIdx.x; i < 2048 * 16; i += gridDim.x * NTHR) {
        if (i < 12 * 2048) { int hh = i / 2048, n = i % 2048; biasTab[i] = rel_bias[t5_bucket(n) * 12 + hh] * LOG2E; }
        int pos = i / 16, j = i % 16;
        float inv = (float)pow(10000.0, -(double)(2 * j) / 32.0);
        float ang = (float)pos * inv;
        cosT[i] = (float)cos((double)ang); sinT[i] = (float)sin((double)ang);
    }
}

DEVI void ph_rowstat(const float* h, float* rstd) {
    const int lane = threadIdx.x & 63, gw = blockIdx.x * NWAVE + (threadIdx.x >> 6), nw = gridDim.x * NWAVE;
    for (int row = gw; row < NT; row += nw) {
        const float4* p = (const float4*)(h + (size_t)row * DM);
        float s = 0.f;
        for (int i = lane; i < 256; i += 64) { float4 v = p[i]; s += v.x * v.x + v.y * v.y + v.z * v.z + v.w * v.w; }
        for (int o = 32; o; o >>= 1) s += __shfl_xor(s, o);
        if (lane == 0) rstd[row] = rsqrtf(s / DM + EPS);
    }
}

DEVI void ph_gemm_in_naive(const float* h, const float* __restrict__ g, const float* __restrict__ w, const float* rstd, unsigned char* ws, unsigned char* lds) {
    const int t_ = otid(); const int sub = t_ >> 8, tid = t_ & 255, ty = tid >> 4, tx = tid & 15;
    float (*As)[68] = (float (*)[68])(lds + sub * 2 * 16 * 68 * 4);
    float (*Bs)[68] = (float (*)[68])(lds + sub * 2 * 16 * 68 * 4 + 16 * 68 * 4);
    for (int it = blockIdx.x; it < 64 * 256 / 2; it += gridDim.x) {
        const int vb = it * 2 + sub, col0 = (vb & 63) * 64, row0 = (vb >> 6) * 64;
        float acc[4][4] = {};
        const int ar = tid >> 2, ak = (tid & 3) * 4, bk = tid >> 4, bc = (tid & 15) * 4;
        int rc[4];
#pragma unroll
        for (int j = 0; j < 4; ++j) rc[j] = ref_col(col0 + bc + j);
        for (int k0 = 0; k0 < DM; k0 += 16) {
            float4 av = *(const float4*)(h + (size_t)(row0 + ar) * DM + k0 + ak);
            float4 gv = *(const float4*)(g + k0 + ak);
            As[ak + 0][ar] = av.x * gv.x; As[ak + 1][ar] = av.y * gv.y; As[ak + 2][ar] = av.z * gv.z; As[ak + 3][ar] = av.w * gv.w;
#pragma unroll
            for (int j = 0; j < 4; ++j) Bs[bk][bc + j] = rc[j] >= 0 ? w[(size_t)(k0 + bk) * INC + rc[j]] : 0.f;
            __syncthreads();
#pragma unroll
            for (int kk = 0; kk < 16; ++kk) {
                float a[4], b[4];
#pragma unroll
                for (int i = 0; i < 4; ++i) { a[i] = As[kk][ty * 4 + i]; b[i] = Bs[kk][tx * 4 + i]; }
#pragma unroll
                for (int i = 0; i < 4; ++i)
#pragma unroll
                    for (int j = 0; j < 4; ++j) acc[i][j] += a[i] * b[j];
            }
            __syncthreads();
        }
        const int c = col0 + tx * 4;
        Route r = route(c);
        if (r.buf >= 0) {
            h16* dst = (h16*)(ws + buf_off(r.buf));
#pragma unroll
            for (int i = 0; i < 4; ++i) {
                int row = row0 + ty * 4 + i; float rs = rstd[row];
#pragma unroll
                for (int j = 0; j < 4; ++j) {
                    float v = acc[i][j] * rs * r.scale;
                    if (r.silu) v = v / (1.f + __expf(-v));
                    dst[(size_t)row * r.pitch + r.dcol + j] = (h16)v;
                }
            }
        }
    }
}

DEVI void ph_mla_naive(const h16* cA, const float* __restrict__ qn, const float* __restrict__ kvn, const float* __restrict__ wuq, const float* __restrict__ wukv,
                       const float* cosT, const float* sinT, h16* qA, h16* kA, h16* kAr, h16* vAT, unsigned char* lds) {
    const int t_ = otid(); const int sub = t_ >> 7, tid = t_ & 127;
    float* cq = (float*)(lds + sub * 3072); float* ckv = cq + 192; float* kr = ckv + 128; float* qout = kr + 32; float* red = qout + 384;
    for (int it = blockIdx.x; it < NT / 4; it += gridDim.x) {
        const int tok = it * 4 + sub, s = tok % SEQ;
        __syncthreads();
        for (int i = tid; i < 192; i += 128) cq[i] = (float)cA[(size_t)tok * 384 + i];
        ckv[tid] = (float)cA[(size_t)tok * 384 + 192 + tid];
        if (tid < 32) kr[tid] = (float)cA[(size_t)tok * 384 + 320 + tid];
        __syncthreads();
        if (tid < 64) {
            float a = 0.f; for (int i = tid; i < 192; i += 64) a += cq[i] * cq[i];
            for (int o = 32; o; o >>= 1) a += __shfl_xor(a, o);
            if (tid == 0) red[0] = rsqrtf(a / 192.f + EPS);
        } else {
            int l = tid - 64; float a = 0.f; for (int i = l; i < 128; i += 64) a += ckv[i] * ckv[i];
            for (int o = 32; o; o >>= 1) a += __shfl_xor(a, o);
            if (l == 0) red[1] = rsqrtf(a / 128.f + EPS);
        }
        __syncthreads();
        for (int i = tid; i < 192; i += 128) cq[i] = cq[i] * red[0] * qn[i];
        ckv[tid] = ckv[tid] * red[1] * kvn[tid];
        __syncthreads();
        for (int n = tid; n < 384; n += 128) { float a = 0.f; for (int k = 0; k < 192; ++k) a += cq[k] * wuq[k * 384 + n]; qout[n] = a; }
        __syncthreads();
        const float qs = 0.10206207261596577f * LOG2E;
        for (int idx = tid; idx < 384; idx += 128) {
            int hh = idx / 96, j = idx % 96; float val;
            if (j < 64) val = qout[idx];
            else { int r = j - 64, i = r & 15; float x1 = qout[hh * 96 + 64 + i], x2 = qout[hh * 96 + 80 + i], c = cosT[s * 16 + i], sn = sinT[s * 16 + i];
                   val = r < 16 ? x1 * c - x2 * sn : x1 * sn + x2 * c; }
            qA[(size_t)tok * 384 + idx] = (h16)(val * qs);
        }
        for (int n = tid; n < 512; n += 128) {
            float a = 0.f; for (int k = 0; k < 128; ++k) a += ckv[k] * wukv[k * 512 + n];
            int hh = n / 128, j = n % 128;
            if (j < 64) kA[(size_t)tok * 256 + hh * 64 + j] = (h16)a; else { vAT[((size_t)((tok / SEQ) * 4 + hh) * 64 + j - 64) * SEQ + s] = (h16)a; }
        }
        if (tid < 32) { int i = tid & 15; float x1 = kr[i], x2 = kr[16 + i], c = cosT[s * 16 + i], sn = sinT[s * 16 + i];
            kAr[(size_t)tok * 32 + tid] = (h16)(tid < 16 ? x1 * c - x2 * sn : x1 * sn + x2 * c); }
    }
}

DEVI void ph_attnA_naive(int vb, const h16* qA, const h16* kA, const h16* vA, const h16* kAr, const h16* gate, h16* mix) {
    const int chunk = 63 - (vb % 64), bh = vb / 64, b = bh / 4, hh = bh % 4, half = (otid() >> 5) & 1;
    const int t = chunk * 32 + (otid() & 31); const size_t tok = (size_t)b * SEQ + t;
    float q[96], o[32];
#pragma unroll
    for (int i = 0; i < 96; ++i) q[i] = (float)qA[tok * 384 + hh * 96 + i];
#pragma unroll
    for (int i = 0; i < 32; ++i) o[i] = 0.f;
    float m = -1e30f, l = 0.f;
    const int smax = chunk * 32 + 31;
    for (int s = 0; s <= smax; ++s) {
        const size_t ks = (size_t)b * SEQ + s;
        const h16* kp = kA + ks * 256 + hh * 64; const h16* kr = kAr + ks * 32; const h16* vp = vA + ks * 256 + hh * 64 + half * 32;
        float sc = 0.f;
#pragma unroll
        for (int i = 0; i < 64; ++i) sc += q[i] * (float)kp[i];
#pragma unroll
        for (int i = 0; i < 32; ++i) sc += q[64 + i] * (float)kr[i];
        if (s <= t) {
            if (sc > m) { float a = exp2f(m - sc); l *= a;
#pragma unroll
                for (int i = 0; i < 32; ++i) o[i] *= a;
                m = sc; }
            float p = exp2f(sc - m); l += p;
#pragma unroll
            for (int i = 0; i < 32; ++i) o[i] += p * (float)vp[i];
        }
    }
    float il = 1.f / l;
#pragma unroll
    for (int i = 0; i < 32; ++i) mix[tok * 1024 + hh * 64 + half * 32 + i] = (h16)(o[i] * il * (float)gate[tok * 1024 + hh * 64 + half * 32 + i]);
}

DEVI void ph_attnB_naive(int vb, const h16* qB, const h16* kB, const h16* vt, const float* biasTab, const h16* gate, h16* mix) {
    const int chunk = vb % 32, bh = vb / 32, b = bh / 4, hh = bh % 4;
    const int t = chunk * 64 + (otid() & 63); const size_t tok = (size_t)b * SEQ + t;
    float q[64], o[64];
#pragma unroll
    for (int i = 0; i < 64; ++i) { q[i] = (float)qB[tok * 256 + hh * 64 + i]; o[i] = 0.f; }
    float m = -1e30f, l = 0.f;
    const float* bt = biasTab + hh * 2048;
    for (int pat = 0; pat < 3; ++pat) {
        const int d = pat == 0 ? 1 : (pat == 1 ? 4 : 16);
        for (int k = 0; k <= 128; ++k) {
            const int s = t - k * d; if (s < 0) break;
            const size_t ks = (size_t)b * SEQ + s;
            const h16* kp = kB + ks * 256 + hh * 64; const h16* vp = vt + ks * 768 + hh * 64;
            float sc = bt[k * d];
#pragma unroll
            for (int i = 0; i < 64; ++i) sc += q[i] * (float)kp[i];
            if (sc > m) { float a = exp2f(m - sc); l *= a;
#pragma unroll
                for (int i = 0; i < 64; ++i) o[i] *= a;
                m = sc; }
            float p = exp2f(sc - m); l += p;
#pragma unroll
            for (int i = 0; i < 64; ++i) o[i] += p * (float)vp[i];
        }
    }
    float il = 1.f / l;
#pragma unroll
    for (int i = 0; i < 64; ++i) mix[tok * 1024 + 256 + hh * 64 + i] = (h16)(o[i] * il * (float)gate[tok * 1024 + 256 + hh * 64 + i]);
}

DEVI void ph_topk_naive(const h16* idx, unsigned* mask, unsigned char* lds) {
    const int t_ = otid(); const int sub = t_ >> 8, tid = t_ & 255;
    float* sc = (float*)(lds + sub * 9728); float* qi = sc + 2048; float* wi = qi + 256; unsigned* msk = (unsigned*)(wi + 8);
    for (int it = blockIdx.x; it < NT / 2; it += gridDim.x) {
        const int tok = (NT / 2 - 1 - it) * 2 + sub, b = tok / SEQ, t = tok % SEQ;
        __syncthreads();
        qi[tid] = (float)idx[(size_t)tok * 320 + tid];
        if (tid < 8) wi[tid] = (float)idx[(size_t)tok * 320 + 288 + tid] * 0.35355339059327373f;
        if (tid < 64) msk[tid] = 0u;
        __syncthreads();
        for (int s = tid; s <= t; s += 256) {
            const h16* kp = idx + ((size_t)b * SEQ + s) * 320 + 256;
            float kk[32];
#pragma unroll
            for (int d = 0; d < 32; ++d) kk[d] = (float)kp[d];
            float score = 0.f;
#pragma unroll 1
            for (int hh = 0; hh < 8; ++hh) { float lg = 0.f;
#pragma unroll
                for (int d = 0; d < 32; ++d) lg += qi[hh * 32 + d] * kk[d];
                score += fmaxf(lg, 0.f) * wi[hh]; }
            sc[s] = score;
        }
        __syncthreads();
        if (t + 1 <= 256) {
            for (int i = tid; i <= t; i += 256) atomicOr(&msk[i >> 5], 1u << (i & 31));
        } else {
            for (int i = tid; i <= t; i += 256) {
                const float si = sc[i]; int rank = 0;
                for (int j = 0; j <= t; ++j) { float sj = sc[j]; rank += (sj > si || (sj == si && j < i)) ? 1 : 0; }
                if (rank < 256) atomicOr(&msk[i >> 5], 1u << (i & 31));
            }
        }
        __syncthreads();
        if (tid < 64) mask[(size_t)tok * 64 + tid] = msk[tid];
    }
}

DEVI void ph_attnC_naive(int vb, const h16* qC, const h16* kC, const h16* vt, const unsigned* mask, const float* biasTab, const h16* gate, h16* mix) {
    const int chunk = 31 - (vb % 32), bh = vb / 32, b = bh / 4, hh = bh % 4;
    const int t = chunk * 64 + (otid() & 63); const size_t tok = (size_t)b * SEQ + t;
    float q[64], o[64];
#pragma unroll
    for (int i = 0; i < 64; ++i) { q[i] = (float)qC[tok * 256 + hh * 64 + i]; o[i] = 0.f; }
    float m = -1e30f, l = 0.f;
    const float* bt = biasTab + (4 + hh) * 2048;
    const int smax = chunk * 64 + 63;
    unsigned mw = 0;
    for (int s = 0; s <= smax; ++s) {
        if ((s & 31) == 0) mw = mask[tok * 64 + (s >> 5)];
        const size_t ks = (size_t)b * SEQ + s;
        const h16* kp = kC + ks * 256 + hh * 64; const h16* vp = vt + ks * 768 + 256 + hh * 64;
        float sc = 0.f;
#pragma unroll
        for (int i = 0; i < 64; ++i) sc += q[i] * (float)kp[i];
        if (s <= t && ((mw >> (s & 31)) & 1u)) {
            sc += bt[t - s];
            if (sc > m) { float a = exp2f(m - sc); l *= a;
#pragma unroll
                for (int i = 0; i < 64; ++i) o[i] *= a;
                m = sc; }
            float p = exp2f(sc - m); l += p;
#pragma unroll
            for (int i = 0; i < 64; ++i) o[i] += p * (float)vp[i];
        }
    }
    float il = 1.f / l;
#pragma unroll
    for (int i = 0; i < 64; ++i) mix[tok * 1024 + 512 + hh * 64 + i] = (h16)(o[i] * il * (float)gate[tok * 1024 + 512 + hh * 64 + i]);
}

DEVI void ph_attnD_naive(int vb, const h16* qD, const h16* kD, const h16* vt, const float* biasTab, const float* __restrict__ lam_p, const float* __restrict__ subln,
                         float lambda_init, const h16* gate, h16* mix) {
    const int t_ = otid();
    const int chunk = 127 - (vb % 128), bh = vb / 128, b = bh / 4, hh = bh % 4, mp = (t_ >> 4) & 1, half = (t_ >> 5) & 1;
    const int t = chunk * 16 + (t_ & 15); const size_t tok = (size_t)b * SEQ + t;
    float q[32], o[32];
#pragma unroll
    for (int i = 0; i < 32; ++i) { q[i] = (float)qD[tok * 256 + hh * 64 + mp * 32 + i]; o[i] = 0.f; }
    float m = -1e30f, l = 0.f;
    float a1 = 0.f, a2 = 0.f;
    for (int i = 0; i < 32; ++i) { a1 += lam_p[i] * lam_p[32 + i]; a2 += lam_p[64 + i] * lam_p[96 + i]; }
    const float lam = expf(a1) - expf(a2) + lambda_init;
    const float* bt = biasTab + (8 + hh) * 2048;
    const int smax = chunk * 16 + 15;
    for (int s = 0; s <= smax; ++s) {
        const size_t ks = (size_t)b * SEQ + s;
        const h16* kp = kD + ks * 256 + hh * 64 + mp * 32; const h16* vp = vt + ks * 768 + 512 + hh * 64 + half * 32;
        float sc = 0.f;
#pragma unroll
        for (int i = 0; i < 32; ++i) sc += q[i] * (float)kp[i];
        if (s <= t) {
            sc += bt[t - s];
            if (sc > m) { float a = exp2f(m - sc); l *= a;
#pragma unroll
                for (int i = 0; i < 32; ++i) o[i] *= a;
                m = sc; }
            float p = exp2f(sc - m); l += p;
#pragma unroll
            for (int i = 0; i < 32; ++i) o[i] += p * (float)vp[i];
        }
    }
    const float sgn = mp ? -lam : 1.f; const float il = sgn / l;
    float ss = 0.f;
#pragma unroll
    for (int i = 0; i < 32; ++i) { float v = o[i] * il; v += __shfl_xor(v, 16); o[i] = v; ss += v * v; }
    ss += __shfl_xor(ss, 32);
    float rs = rsqrtf(ss / 64.f + EPS) * (1.f - lambda_init);
    if (mp == 0) {
        int tt = b * SEQ + t; asm volatile("" : "+v"(tt)); const size_t tok2 = (size_t)tt;
#pragma unroll
        for (int i = 0; i < 32; ++i) mix[tok2 * 1024 + 768 + hh * 64 + half * 32 + i] = (h16)(o[i] * rs * subln[half * 32 + i] * (float)gate[tok2 * 1024 + 768 + hh * 64 + half * 32 + i]);
    }
}

DEVI void ph_out_naive(const h16* mix, const float* __restrict__ w, const float* __restrict__ g, const float* h_in, float* h_out, unsigned char* lds) {
    const int t_ = otid(); const int sub = t_ >> 8, tid = t_ & 255;
    float (*A)[1024] = (float (*)[1024])(lds + sub * 33024); float (*red)[4] = (float (*)[4])(lds + sub * 33024 + 32768);
    for (int it = blockIdx.x; it < NT / 16; it += gridDim.x) {
        const int row0 = (it * 2 + sub) * 8;
        __syncthreads();
        for (int i = tid; i < 8 * 1024; i += 256) A[i >> 10][i & 1023] = (float)mix[(size_t)(row0 + (i >> 10)) * 1024 + (i & 1023)];
        __syncthreads();
        float acc[8][4] = {};
        for (int k = 0; k < 1024; ++k) {
            float wv[4];
#pragma unroll
            for (int j = 0; j < 4; ++j) wv[j] = w[(size_t)k * 1024 + tid + 256 * j];
#pragma unroll
            for (int r = 0; r < 8; ++r) { float a = A[r][k];
#pragma unroll
                for (int j = 0; j < 4; ++j) acc[r][j] += a * wv[j]; }
        }
#pragma unroll
        for (int r = 0; r < 8; ++r) {
            float s = 0.f;
#pragma unroll
            for (int j = 0; j < 4; ++j) s += acc[r][j] * acc[r][j];
            for (int o = 32; o; o >>= 1) s += __shfl_xor(s, o);
            if ((tid & 63) == 0) red[r][tid >> 6] = s;
        }
        __syncthreads();
#pragma unroll
        for (int r = 0; r < 8; ++r) {
            float rs = rsqrtf((red[r][0] + red[r][1] + red[r][2] + red[r][3]) / 1024.f + EPS);
#pragma unroll
            for (int j = 0; j < 4; ++j) { int n = tid + 256 * j; size_t o = (size_t)(row0 + r) * 1024 + n; h_out[o] = h_in[o] + acc[r][j] * rs * g[n]; }
        }
    }
}

extern __shared__ __attribute__((aligned(16))) unsigned char smem[];
constexpr int LDS_BAR_OFF = 131072;

DEVI unsigned char* ows(unsigned char* w) { asm volatile("" : "+s"(w)); return w; }
#define WSP(T, off) ((T*)(w + (off)))

__global__ void __launch_bounds__(NTHR, 2) mega(Params p) {
    if (threadIdx.x == 0) *(uint4*)(smem + LDS_BAR_OFF) = make_uint4(0u, 0u, 0u, 0u);
    __syncthreads();
    XcdBarrier bar = xcd_barrier_post((unsigned*)(p.ws + OFF_CTL), (volatile LAS unsigned*)(smem + LDS_BAR_OFF));
    unsigned char* lds = smem;
    const int nw = gridDim.x * NWAVE;

    {
        unsigned char* w = ows(p.ws);
        ph_tables(p.in[11], WSP(float, OFF_BIAS), WSP(float, OFF_COS), WSP(float, OFF_SIN));
        int base = 0; const int total = 2 * (64 * 16) + 2 * (16 * 16);
        cvt_transpose<true>(p.in[1], INC, p.in[3], WSP(h16, OFF_WINT), MYC, DM, lds, blockIdx.x, total, base);
        cvt_transpose<true>(p.in[1] + (size_t)DM * INC, INC, p.in[3] + DM, WSP(h16, OFF_WINT) + (size_t)MYC * DM, MYC, DM, lds, blockIdx.x, total, base);
        cvt_transpose<false>(p.in[2], DM, nullptr, WSP(h16, OFF_WOUTT), DM, DM, lds, blockIdx.x, total, base);
        cvt_transpose<false>(p.in[2] + (size_t)DM * DM, DM, nullptr, WSP(h16, OFF_WOUTT) + (size_t)DM * DM, DM, DM, lds, blockIdx.x, total, base);
        ph_rowstat_cvt(p.in[0], WSP(float, OFF_RSTD), WSP(h16, OFF_H16));
    }
    xcd_barrier(bar);
    for (int layer = 0; layer < 2; ++layer) {
        const float lambda_init = layer == 0 ? 0.2f : 0.35550906759f;
        {
            unsigned char* w = ows(p.ws);
            pg8::Gemm g{WSP(const pg8::bf16_t, OFF_H16), WSP(const pg8::bf16_t, OFF_WINT) + (size_t)layer * MYC * DM, NT, MYC, DM};
            int bid_ = (int)blockIdx.x; asm volatile("" : "+s"(bid_));
            pg8::StaticOrder S; S.init(NT, MYC, (int)gridDim.x, bid_);
            EpiRoute E{w, WSP(float, OFF_RSTD)};
            pg8::gemm_phase<EpiRoute, pg8::StaticOrder, true, true>((PG8_LAS unsigned char*)lds, g, S, E);
        }
        xcd_barrier(bar);
        {
            unsigned char* w = ows(p.ws);
            ph_mla_naive(WSP(h16, OFF_CA), p.in[5] + layer * 192, p.in[6] + layer * 128, p.in[7] + (size_t)layer * 192 * 384, p.in[8] + (size_t)layer * 128 * 512,
                         WSP(float, OFF_COS), WSP(float, OFF_SIN), WSP(h16, OFF_QA), WSP(h16, OFF_KA), WSP(h16, OFF_KAR), WSP(h16, OFF_VAT), lds);
        }
        {
            unsigned char* w = ows(p.ws);
            ph_topk_naive(WSP(h16, OFF_IDX), WSP(unsigned, OFF_MASK), lds);
        }
        {
            unsigned char* w = ows(p.ws);
            ph_vtrans(WSP(h16, OFF_VTMP), WSP(h16, OFF_VT), lds);
        }
        xcd_barrier(bar);
        {
            unsigned char* w = ows(p.ws);
            constexpr size_t VSZ = (size_t)32 * 64 * SEQ;
            p2_setup(WSP(float, OFF_BIAS), p.in[9] + layer * 128, lambda_init, lds);
            unsigned* ctr = WSP(unsigned, OFF_CTL) + 3600 + 16 * layer;
            for (;;) { const int e = wq_next(ctr); if (e >= 8192) break;
                const int lvl = 63 - (e >> 7), ty = (e >> 5) & 3, bh = e & 31;
                if (ty == 0) flashA_item(bh >> 2, bh & 3, lvl, WSP(h16, OFF_QA), WSP(h16, OFF_KA), WSP(h16, OFF_KAR), WSP(h16, OFF_VAT), WSP(h16, OFF_GATE), WSP(h16, OFF_MIX));
                else if (ty == 1) flashCD_item<2, false>(bh >> 2, bh & 3, lvl, 8 + (bh & 3), WSP(h16, OFF_QD), WSP(h16, OFF_KD), WSP(h16, OFF_VT) + 4 * VSZ, nullptr, WSP(float, OFF_BIAS), lds,
                                                         p.in[10] + layer * 64, lambda_init, WSP(h16, OFF_GATE), WSP(h16, OFF_MIX), 768);
                else if (ty == 2) flashCD_item<1, true>(bh >> 2, bh & 3, lvl, 4 + (bh & 3), WSP(h16, OFF_QC), WSP(h16, OFF_KC), WSP(h16, OFF_VT) + 3 * VSZ, WSP(unsigned, OFF_MASK), WSP(float, OFF_BIAS), lds,
                                                        nullptr, 0.f, WSP(h16, OFF_GATE), WSP(h16, OFF_MIX), 512);
                else flashB_item(bh >> 2, bh & 3, lvl & 15, lvl >> 4, WSP(h16, OFF_QB), WSP(h16, OFF_KB), WSP(h16, OFF_VT), lds, WSP(h16, OFF_GATE), WSP(h16, OFF_MIX));
            }
        }
        xcd_barrier(bar);
        {
            unsigned char* w = ows(p.ws);
            ph_out_naive(WSP(h16, OFF_MIX), p.in[2] + (size_t)layer * DM * DM, p.in[4] + layer * DM, layer == 0 ? p.in[0] : (const float*)p.out, p.out, lds);
        }
        xcd_barrier(bar);
        if (layer == 0) { unsigned char* w = ows(p.ws); ph_rowstat_cvt(p.out, WSP(float, OFF_RSTD), WSP(h16, OFF_H16)); xcd_barrier(bar); }
    }
}

extern "C" void kernel_launch(void* const* d_in, const int* in_sizes, int n_in, void* d_out, int out_size, void* d_ws, size_t ws_size, hipStream_t stream) {
    static int grid = 0;
    if (grid == 0) {
        int dev = 0, cus = 0, per_cu = 0;
        (void)hipGetDevice(&dev);
        (void)hipDeviceGetAttribute(&cus, hipDeviceAttributeMultiprocessorCount, dev);
        (void)hipFuncSetAttribute((const void*)mega, hipFuncAttributeMaxDynamicSharedMemorySize, LDS_BYTES);
        (void)hipOccupancyMaxActiveBlocksPerMultiprocessor(&per_cu, (const void*)mega, NTHR, LDS_BYTES);
        (void)hipGetLastError();
        grid = cus > 0 ? cus : 256;
    }
    (void)hipMemsetAsync((char*)d_ws + OFF_CTL, 0, 16384, stream);
    Params p{};
    for (int i = 0; i < 12; ++i) p.in[i] = (const float*)d_in[i];
    p.out = (float*)d_out; p.ws = (unsigned char*)d_ws;
    hipLaunchKernelGGL(mega, dim3(grid), dim3(NTHR), LDS_BYTES, stream, p);
}
```

```cpp
#include <hip/hip_runtime.h>
#include <stdint.h>
#include <math.h>

typedef _Float16 h16;
#define DEVI __device__ __forceinline__
DEVI int ogw();
DEVI int otid() { int t = threadIdx.x; asm volatile("" : "+v"(t)); return t; }

constexpr int NB = 8, SEQ = 2048, DM = 1024, NT = NB * SEQ, INC = 3976, MYC = 4096;
constexpr float LOG2E = 1.4426950408889634f;
constexpr float EPS = 1e-6f;

DEVI int ogw() { return blockIdx.x * 8 + (otid() >> 6); }
__host__ __device__ constexpr int ref_col(int my) {
    if (my < 352) return my;
    if (my < 384) return -1;
    if (my < 640) return 352 + (my - 384);
    if (my < 896) return 1376 + (my - 640);
    if (my < 1152) return 2696 + (my - 896);
    if (my < 1408) return 3720 + (my - 1152);
    if (my < 1664) return 608 + (my - 1408);
    if (my < 1920) return 864 + (my - 1664);
    if (my < 2176) return 1632 + (my - 1920);
    if (my < 2432) return 1888 + (my - 2176);
    if (my < 2688) return 2952 + (my - 2432);
    if (my < 2944) return 3208 + (my - 2688);
    if (my < 3200) return 1120 + (my - 2944);
    if (my < 3456) return 2144 + (my - 3200);
    if (my < 3712) return 3464 + (my - 3456);
    if (my < 3968) return 2400 + (my - 3712);
    if (my < 4000) return 2656 + (my - 3968);
    if (my < 4008) return 2688 + (my - 4000);
    return -1;
}

constexpr size_t MiB = 1024 * 1024;
constexpr size_t OFF_CTL = 0;
constexpr size_t OFF_RSTD = 64 * 1024;
constexpr size_t OFF_BIAS = 128 * 1024;
constexpr size_t OFF_COS = 256 * 1024;
constexpr size_t OFF_SIN = 384 * 1024;
constexpr size_t OFF_CA = 1 * MiB;
constexpr size_t OFF_GATE = OFF_CA + 12 * MiB;
constexpr size_t OFF_QB = OFF_GATE + 32 * MiB;
constexpr size_t OFF_KB = OFF_QB + 8 * MiB;
constexpr size_t OFF_QC = OFF_KB + 8 * MiB;
constexpr size_t OFF_KC = OFF_QC + 8 * MiB;
constexpr size_t OFF_QD = OFF_KC + 8 * MiB;
constexpr size_t OFF_KD = OFF_QD + 8 * MiB;
constexpr size_t OFF_IDX = OFF_KD + 8 * MiB;
constexpr size_t OFF_MIX = OFF_IDX + 10 * MiB;
constexpr size_t OFF_VTMP = OFF_MIX + 32 * MiB;
constexpr size_t OFF_MASK = OFF_VTMP + 24 * MiB;
constexpr size_t OFF_H16 = OFF_MASK + 4 * MiB;
constexpr size_t OFF_QA = OFF_H16;
constexpr size_t OFF_KA = OFF_QA + 12 * MiB;
constexpr size_t OFF_KAR = OFF_KA + 8 * MiB;
constexpr size_t OFF_VAT = OFF_KAR + 1 * MiB;
constexpr size_t OFF_WINT = OFF_H16 + 32 * MiB;
constexpr size_t OFF_WOUTT = OFF_WINT + 16 * MiB;
constexpr size_t OFF_WUQT = OFF_WOUTT + 4 * MiB;
constexpr size_t OFF_WUKVT = OFF_WUQT + 512 * 1024;
constexpr size_t OFF_VT = OFF_WUKVT + 512 * 1024;
constexpr size_t OFF_END = OFF_VT + 40 * MiB;
static_assert(OFF_END <= 256 * MiB, "ws map");

struct Route { int buf; int dcol; int pitch; float scale; int silu; };
__host__ __device__ inline Route route(int my) {
    Route r{-1, 0, 0, 1.f, 0};
    if (my < 384) { r.buf = 0; r.dcol = my; r.pitch = 384; }
    else if (my < 1408) { r.buf = 1; r.dcol = my - 384; r.pitch = 1024; r.silu = 1; }
    else if (my < 1664) { r.buf = 2; r.dcol = my - 1408; r.pitch = 256; r.scale = 0.125f * LOG2E; }
    else if (my < 1920) { r.buf = 3; r.dcol = my - 1664; r.pitch = 256; }
    else if (my < 2176) { r.buf = 4; r.dcol = my - 1920; r.pitch = 256; r.scale = 0.125f * LOG2E; }
    else if (my < 2432) { r.buf = 5; r.dcol = my - 2176; r.pitch = 256; }
    else if (my < 2688) { r.buf = 6; r.dcol = my - 2432; r.pitch = 256; r.scale = 0.17677669529663687f * LOG2E; }
    else if (my < 2944) { r.buf = 7; r.dcol = my - 2688; r.pitch = 256; }
    else if (my < 3712) { r.buf = 8; r.dcol = my - 2944; r.pitch = 768; }
    else if (my < 4032) { r.buf = 9; r.dcol = my - 3712; r.pitch = 320; r.scale = (my < 3968) ? 0.17677669529663687f : 1.f; }
    return r;
}
DEVI size_t buf_off(int buf) {
    switch (buf) {
        case 0: return OFF_CA; case 1: return OFF_GATE; case 2: return OFF_QB; case 3: return OFF_KB; case 4: return OFF_QC;
        case 5: return OFF_KC; case 6: return OFF_QD; case 7: return OFF_KD; case 8: return OFF_VTMP; default: return OFF_IDX;
    }
}

__device__ __constant__ int kBucketStart[16] = {16, 22, 30, 40, 54, 73, 99, 134, 182, 246, 332, 450, 609, 825, 1117, 1513};
DEVI int t5_bucket(int n) {
    if (n < 16) return n;
    int b = 16;
#pragma unroll
    for (int j = 1; j < 16; ++j) b += (n >= kBucketStart[j]) ? 1 : 0;
    return b;
}


#define XB_TMO      128
#define XB_XCNT(j)  (256  + 64 * (j))
#define XB_XSUB(j)  (1280 + 64 * (j))
#define XB_XGEN(j)  (2304 + 64 * (j))
#define XB_TOP      3328
#define XB_TOPGEN   3392
#define XCD_BAR_WORDS 3456
#define XB_SPIN_CAP (1u << 18)
#define LAS __attribute__((address_space(3)))
__device__ __forceinline__ unsigned xb_ld(unsigned* p)              { return __hip_atomic_load(p, __ATOMIC_RELAXED, __HIP_MEMORY_SCOPE_AGENT); }
__device__ __forceinline__ unsigned xb_add(unsigned* p, unsigned v) { return __hip_atomic_fetch_add(p, v, __ATOMIC_RELAXED, __HIP_MEMORY_SCOPE_AGENT); }
__device__ __forceinline__ unsigned xb_xcc_id() { return (unsigned)__builtin_amdgcn_s_getreg((3 << 11) | 20) & 0xFu; }
#define XB_SPIN(cond, bar) do { unsigned _sp = 0; while (cond) { __builtin_amdgcn_s_sleep(1); \
    if ((++_sp & 255u) == 0u) { if (xb_ld(&(bar)[XB_TMO])) break; if (_sp > XB_SPIN_CAP) { atomicAdd(&(bar)[XB_TMO], 1u); break; } } } } while (0)
struct XcdBarrier { unsigned* bar; unsigned x; volatile LAS unsigned* st; };
__device__ __forceinline__ XcdBarrier xcd_barrier_post(unsigned* bar, volatile LAS unsigned* st) {
    XcdBarrier b; b.bar = bar; b.x = xb_xcc_id(); b.st = st;
    if (threadIdx.x == 0) (void)xb_add(&bar[XB_XCNT(b.x)], 1u);
    return b;
}
__device__ __forceinline__ void xcd_barrier_complete(unsigned* bar, unsigned x, unsigned& nloc, unsigned& nx) {
    const unsigned G = gridDim.x * gridDim.y * gridDim.z;
    unsigned sum, cnt, mine, sp = 0u;
    for (;;) {
        sum = 0u; cnt = 0u; mine = 0u;
#pragma unroll
        for (unsigned j = 0; j < 16; ++j) { const unsigned c = xb_ld(&bar[XB_XCNT(j)]); sum += c; cnt += (c > 0u) ? 1u : 0u; mine = (j == x) ? c : mine; }
        if (sum == G) break;
        __builtin_amdgcn_s_sleep(1);
        if ((++sp & 255u) == 0u) { if (xb_ld(&bar[XB_TMO])) break; if (sp > XB_SPIN_CAP) { atomicAdd(&bar[XB_TMO], 1u); break; } }
    }
    nloc = mine > 0u ? mine : 1u; nx = cnt > 0u ? cnt : 1u;
}
__device__ __forceinline__ void xcd_barrier(const XcdBarrier& b) {
    asm volatile("s_waitcnt vmcnt(0)" ::: "memory");
    __syncthreads();
    if (otid() == 0) {
        unsigned* bar = b.bar; unsigned bx = b.x; asm volatile("" : "+s"(bx));
        __builtin_amdgcn_s_waitcnt(0);
        unsigned nloc = b.st[0], nx = b.st[1];
        if (nloc == 0u) { xcd_barrier_complete(bar, bx, nloc, nx); b.st[0] = nloc; b.st[1] = nx; }
        const unsigned old = xb_add(&bar[XB_XSUB(bx)], 1u);
        const unsigned gen = old / nloc;
        if (old + 1u == (gen + 1u) * nloc) {
            __builtin_amdgcn_fence(__ATOMIC_RELEASE, "agent");
            asm volatile("s_waitcnt vmcnt(0)" ::: "memory");
            const unsigned og = xb_add(&bar[XB_TOP], 1u);
            const unsigned tg = og / nx;
            if (og + 1u == (tg + 1u) * nx) xb_add(&bar[XB_TOPGEN], 1u);
            else XB_SPIN(xb_ld(&bar[XB_TOPGEN]) == tg, bar);
            __builtin_amdgcn_fence(__ATOMIC_ACQUIRE, "agent");
            xb_add(&bar[XB_XGEN(bx)], 1u);
            asm volatile("s_waitcnt vmcnt(0)" ::: "memory");
        } else {
            XB_SPIN(xb_ld(&bar[XB_XGEN(bx)]) == gen, bar);
            __builtin_amdgcn_fence(__ATOMIC_ACQUIRE, "agent");
            asm volatile("s_waitcnt vmcnt(0)" ::: "memory");
        }
    }
    __syncthreads();
}

namespace pg8 {
#define PG8_LAS __attribute__((address_space(3)))
typedef unsigned short bf16_t;
typedef _Float16 f16x8 __attribute__((ext_vector_type(8)));
typedef float f32x4 __attribute__((ext_vector_type(4)));
typedef unsigned u32x4 __attribute__((ext_vector_type(4)));
constexpr int BM = 256, BK = 64, HALF = 128, HTB = HALF * BK * 2  , STAGE_BYTES = 8 * HTB, NXCD = 8, WGM = 8;

__host__ __device__ __forceinline__ int lds_byte(int r, int c) { const int st = (r >> 4) * 2 + (c >> 5), rr = r & 15, cc = c & 31, ob = rr * 64 + cc * 2; return st * 1024 + (ob ^ (((ob >> 9) & 1) << 5)); }
__host__ __device__ __forceinline__ void stage_rc(int b, int& R, int& C) { const int st = b / 1024, sb = b % 1024, swz = sb ^ (((sb >> 9) & 1) << 5); R = (st >> 1) * 16 + swz / 64; C = (st & 1) * 32 + (swz % 64) / 2; }
__host__ __device__ __forceinline__ int perm32(int rho) { const int n = rho >> 4, i = rho & 15; return 8 * (i >> 2) + 4 * n + (i & 3); }

struct Unit { int pm, pn; };
struct Gemm { const bf16_t* A; const bf16_t* Bt; int M, N, K; };

struct StaticOrder {
    int nM, nN, nwg, G, c;
    __host__ __device__ void init(int M, int N, int G_, int c_) { nM = M / BM; nN = N / BM; nwg = nM * nN; G = G_; c = c_; }
    __host__ __device__ bool next(int i, Unit& u) const {
        const long L = (long)i * G + c; if (L >= nwg) return false;
        int wgid = (int)L; { const int q = nwg / NXCD, r = nwg % NXCD, xcd = wgid % NXCD, off = wgid / NXCD; wgid = (xcd < r ? xcd * (q + 1) : r * (q + 1) + (xcd - r) * q) + off; }
        const int nig = WGM * nN, gid = wgid / nig, fm = gid * WGM, gsz = (nM - fm) < WGM ? (nM - fm) : WGM;
        u.pm = fm + ((wgid % nig) % gsz); u.pn = (wgid % nig) / gsz; return true;
    }
    __device__ __forceinline__ void a_ready(const Unit&) const {}
    __device__ __forceinline__ void done(const Unit&) const {}
};

template <class Epi, class Sched, bool ALIGN_EPI = false, bool SP2 = false>
__device__ __forceinline__ void gemm_phase(PG8_LAS unsigned char* lds, const Gemm g, const Sched& S, const Epi& E) {
    const int tid = otid(), wid = __builtin_amdgcn_readfirstlane(tid >> 6), lane = tid & 63, wr = wid >> 2, wc = wid & 3, fr = lane & 15, fq = lane >> 4;
    const int K = g.K, nt = K / BK;
    unsigned voffA[2], voffB[2];
#pragma unroll
    for (int i = 0; i < 2; ++i) { int R, C; stage_rc(tid * 16 + i * 8192, R, C); const int Rb = Epi::PERM ? ((R & ~31) + perm32(R & 31)) : R;
        voffA[i] = (unsigned)(R * K + C) * 2u; voffB[i] = (unsigned)(Rb * K + C) * 2u; }
    const size_t kstep = (size_t)(BK * 2);
    const size_t hstep = (size_t)HALF * K * 2;
    const size_t tstep = 2 * hstep;
    const unsigned ldsw = (unsigned)wid * 1024u;
    const int aoff = lds_byte(wr * 64 + fr, fq * 8), boff = lds_byte(wc * 32 + fr, fq * 8);
#define PG8_SA(b, h) (((b) * 2 + (h)) * HTB)
#define PG8_SB(b, h) ((4 + (b) * 2 + (h)) * HTB)
#define PG8_STAGE(bufoff, gbase, voff) do { _Pragma("unroll") for (int _i = 0; _i < 2; ++_i) \
        __builtin_amdgcn_global_load_lds((const unsigned*)((const char*)(gbase) + (voff)[_i]), (PG8_LAS unsigned*)(lds + (bufoff) + ldsw + _i * 8192), 16, 0, 0); } while (0)
#define PG8_LDA(dst, b, h) do { _Pragma("unroll") for (int m = 0; m < 4; ++m) _Pragma("unroll") for (int k = 0; k < 2; ++k) dst[m][k] = *(const PG8_LAS f16x8*)(lds + PG8_SA(b, h) + aoff + m * 2048 + k * 1024); } while (0)
#define PG8_LDB(dst, b, h) do { _Pragma("unroll") for (int n = 0; n < 2; ++n) _Pragma("unroll") for (int k = 0; k < 2; ++k) dst[n][k] = *(const PG8_LAS f16x8*)(lds + PG8_SB(b, h) + boff + n * 2048 + k * 1024); } while (0)
#define PG8_MMA(ai, bj, At, Bt) do { __builtin_amdgcn_s_setprio(1); _Pragma("unroll") for (int m = 0; m < 4; ++m) _Pragma("unroll") for (int n = 0; n < 2; ++n) _Pragma("unroll") for (int k = 0; k < 2; ++k) \
        acc[ai][bj][m][n] = __builtin_amdgcn_mfma_f32_16x16x32_f16(Bt[n][k], At[m][k], acc[ai][bj][m][n], 0, 0, 0); __builtin_amdgcn_s_setprio(0); } while (0)
#define PG8_WAIT_V(n) asm volatile("s_waitcnt vmcnt(" #n ")" ::: "memory")
#define PG8_WAIT_L(n) asm volatile("s_waitcnt lgkmcnt(" #n ")" ::: "memory")
#define PG8_BAR __builtin_amdgcn_s_barrier()
#define PG8_SCHED __builtin_amdgcn_sched_barrier(0)
    Unit cur, nxt; int ui = 0;
    if (!S.next(0, cur)) return;
    f32x4 acc[2][2][4][2];
#pragma unroll
    for (int a = 0; a < 2; ++a)
#pragma unroll
        for (int b = 0; b < 2; ++b)
#pragma unroll
            for (int m = 0; m < 4; ++m)
#pragma unroll
                for (int n = 0; n < 2; ++n) acc[a][b][m][n] = (f32x4){0.f, 0.f, 0.f, 0.f};
    f16x8 At[4][2], B0[2][2], B1[2][2];
    const char* cA = (const char*)g.A + (size_t)cur.pm * tstep; const char* cB = (const char*)g.Bt + (size_t)cur.pn * tstep;
    S.a_ready(cur);
    if constexpr (SP2) {
        PG8_STAGE(PG8_SB(0, 0), cB, voffB); PG8_STAGE(PG8_SB(0, 1), cB + hstep, voffB); PG8_STAGE(PG8_SA(0, 0), cA, voffA); PG8_STAGE(PG8_SA(0, 1), cA + hstep, voffA);
        if (wr == 1) PG8_BAR;
        PG8_WAIT_V(2); PG8_BAR;
        PG8_STAGE(PG8_SB(1, 0), cB + kstep, voffB); PG8_STAGE(PG8_SA(1, 0), cA + kstep, voffA); PG8_STAGE(PG8_SB(1, 1), cB + hstep + kstep, voffB);
        PG8_WAIT_V(6); PG8_BAR;
    } else {
        PG8_STAGE(PG8_SB(0, 0), cB, voffB); PG8_STAGE(PG8_SA(0, 0), cA, voffA); PG8_STAGE(PG8_SB(0, 1), cB + hstep, voffB); PG8_STAGE(PG8_SA(0, 1), cA + hstep, voffA);
        if (wr == 1) PG8_BAR;
        PG8_WAIT_V(4); PG8_BAR;
        PG8_STAGE(PG8_SB(1, 0), cB + kstep, voffB); PG8_STAGE(PG8_SA(1, 0), cA + kstep, voffA); PG8_STAGE(PG8_SB(1, 1), cB + hstep + kstep, voffB);
        PG8_WAIT_V(6); PG8_BAR;
    }
    for (;;) {
        const bool has_next = S.next(ui + 1, nxt);
        const char* nA = has_next ? (const char*)g.A + (size_t)nxt.pm * tstep : cA; const char* nB = has_next ? (const char*)g.Bt + (size_t)nxt.pn * tstep : cB;
        for (int t = 0; t < nt; t += 2) {
            const bool last = (t == nt - 2);
            const char* a1 = cA + (size_t)(t + 1) * kstep;
            const char* a2 = last ? nA : cA + (size_t)(t + 2) * kstep; const char* b2 = last ? nB : cB + (size_t)(t + 2) * kstep;
            const char* a3 = a2 + kstep; const char* b3 = b2 + kstep;
            if (last && has_next) S.a_ready(nxt);
            if constexpr (SP2) {
            PG8_LDB(B0, 0, 0); PG8_LDB(B1, 0, 1); PG8_SCHED; PG8_LDA(At, 0, 0); PG8_STAGE(PG8_SA(1, 1), a1 + hstep, voffA);
            PG8_WAIT_V(8); PG8_WAIT_L(0); PG8_BAR; PG8_MMA(0, 0, At, B0); PG8_MMA(0, 1, At, B1); PG8_BAR; PG8_SCHED;
            PG8_LDA(At, 0, 1); PG8_STAGE(PG8_SB(0, 0), b2, voffB); PG8_STAGE(PG8_SB(0, 1), b2 + hstep, voffB); PG8_STAGE(PG8_SA(0, 0), a2, voffA);
            PG8_WAIT_V(8); PG8_WAIT_L(0); PG8_BAR; PG8_MMA(1, 0, At, B0); PG8_MMA(1, 1, At, B1); PG8_BAR; PG8_SCHED;
            PG8_LDB(B0, 1, 0); PG8_LDB(B1, 1, 1); PG8_SCHED; PG8_LDA(At, 1, 0); PG8_STAGE(PG8_SA(0, 1), a2 + hstep, voffA);
            PG8_WAIT_V(8); PG8_WAIT_L(0); PG8_BAR; PG8_MMA(0, 0, At, B0); PG8_MMA(0, 1, At, B1); PG8_BAR; PG8_SCHED;
            PG8_LDA(At, 1, 1); PG8_STAGE(PG8_SB(1, 0), b3, voffB); PG8_STAGE(PG8_SB(1, 1), b3 + hstep, voffB); PG8_STAGE(PG8_SA(1, 0), a3, voffA);
            PG8_WAIT_V(8); PG8_WAIT_L(0); PG8_BAR; PG8_MMA(1, 0, At, B0); PG8_MMA(1, 1, At, B1); PG8_BAR; PG8_SCHED;
            } else {
            PG8_LDB(B0, 0, 0); PG8_SCHED; PG8_LDA(At, 0, 0); PG8_STAGE(PG8_SA(1, 1), a1 + hstep, voffA);
            PG8_WAIT_L(8); PG8_BAR; PG8_WAIT_L(0); PG8_MMA(0, 0, At, B0); PG8_BAR; PG8_SCHED;
            PG8_LDB(B1, 0, 1); PG8_STAGE(PG8_SB(0, 0), b2, voffB);
            PG8_BAR; PG8_WAIT_L(0); PG8_MMA(0, 1, At, B1); PG8_BAR;
            PG8_LDA(At, 0, 1); PG8_STAGE(PG8_SA(0, 0), a2, voffA);
            PG8_BAR; PG8_WAIT_L(0); PG8_MMA(1, 0, At, B0); PG8_BAR; PG8_SCHED;
            PG8_STAGE(PG8_SB(0, 1), b2 + hstep, voffB);
            PG8_WAIT_V(6); PG8_BAR; PG8_MMA(1, 1, At, B1); PG8_BAR;
            PG8_LDB(B0, 1, 0); PG8_SCHED; PG8_LDA(At, 1, 0); PG8_STAGE(PG8_SA(0, 1), a2 + hstep, voffA);
            PG8_WAIT_L(8); PG8_BAR; PG8_WAIT_L(0); PG8_MMA(0, 0, At, B0); PG8_BAR; PG8_SCHED;
            PG8_LDB(B1, 1, 1); PG8_STAGE(PG8_SB(1, 0), b3, voffB);
            PG8_BAR; PG8_WAIT_L(0); PG8_MMA(0, 1, At, B1); PG8_BAR;
            PG8_LDA(At, 1, 1); PG8_STAGE(PG8_SA(1, 0), a3, voffA);
            PG8_BAR; PG8_WAIT_L(0); PG8_MMA(1, 0, At, B0); PG8_BAR; PG8_SCHED;
            PG8_STAGE(PG8_SB(1, 1), b3 + hstep, voffB);
            PG8_WAIT_V(6); PG8_BAR; PG8_MMA(1, 1, At, B1); PG8_BAR;
            }
        }
        if constexpr (ALIGN_EPI) { if (wr == 0) PG8_BAR; }
        if constexpr (!Epi::AFTER_DRAIN) { E(acc, cur, wr, wc, fr, fq); S.done(cur); }
        if (!has_next) break;
#pragma unroll
        for (int a = 0; a < 2; ++a)
#pragma unroll
            for (int b = 0; b < 2; ++b)
#pragma unroll
                for (int m = 0; m < 4; ++m)
#pragma unroll
                    for (int n = 0; n < 2; ++n) acc[a][b][m][n] = (f32x4){0.f, 0.f, 0.f, 0.f};
        cur = nxt; cA = nA; cB = nB; ++ui;
        if constexpr (ALIGN_EPI) { if (wr == 1) PG8_BAR; }
    }
    PG8_WAIT_V(0);
    if constexpr (!ALIGN_EPI) { if (wr == 0) PG8_BAR; }
    PG8_BAR;
    if constexpr (Epi::AFTER_DRAIN) { E.fused(acc, cur, wr, wc, fr, fq, lds, wid, lane); S.done(cur); }
#undef PG8_SA
#undef PG8_SB
#undef PG8_STAGE
#undef PG8_LDA
#undef PG8_LDB
#undef PG8_MMA
#undef PG8_WAIT_V
#undef PG8_WAIT_L
#undef PG8_BAR
#undef PG8_SCHED
}
}


typedef float f32x4_t __attribute__((ext_vector_type(4)));
typedef _Float16 h16x8 __attribute__((ext_vector_type(8)));
DEVI float silu_f(float v) { return v / (1.f + __expf(-v)); }
struct EpiRoute {
    static constexpr bool PERM = true, AFTER_DRAIN = false;
    unsigned char* ws; const float* rstd;
    DEVI void operator()(const pg8::f32x4 (&acc)[2][2][4][2], const pg8::Unit& u, int wr, int wc, int fr, int fq) const {
        const int row0 = u.pm * 256 + wr * 64 + fr;
        float rs[2][4];
#pragma unroll
        for (int ai = 0; ai < 2; ++ai)
#pragma unroll
            for (int m = 0; m < 4; ++m) rs[ai][m] = rstd[row0 + ai * 128 + m * 16];
#pragma unroll
        for (int bj = 0; bj < 2; ++bj) {
            const int cg = u.pn * 256 + bj * 128 + wc * 32;
            const Route r = route(cg);
            if (r.buf < 0) continue;
            h16* base = (h16*)(ws + buf_off(r.buf)) + r.dcol + 8 * fq;
#pragma unroll
            for (int ai = 0; ai < 2; ++ai)
#pragma unroll
                for (int m = 0; m < 4; ++m) {
                    const int row = row0 + ai * 128 + m * 16; const float sc = rs[ai][m] * r.scale;
                    float v[8];
#pragma unroll
                    for (int j = 0; j < 4; ++j) { v[j] = acc[ai][bj][m][0][j] * sc; v[4 + j] = acc[ai][bj][m][1][j] * sc; }
                    if (r.silu) {
#pragma unroll
                        for (int j = 0; j < 8; ++j) v[j] = silu_f(v[j]);
                    }
                    h16x8 o;
#pragma unroll
                    for (int j = 0; j < 8; ++j) o[j] = (h16)v[j];
                    *(h16x8*)(base + (size_t)row * r.pitch) = o;
                }
        }
    }
};

constexpr int NTHR = 512, NWAVE = 8;

template <bool REF>
DEVI void cvt_transpose(const float* __restrict__ src, int src_pitch, const float* __restrict__ g, h16* dst, int N, int K, unsigned char* lds, int item0, int nitems_total, int& item_base) {
    const int tid = otid();
    float (*tile)[65] = (float (*)[65])lds;
    const int ntn = N / 64, ntk = K / 64, n_it = ntn * ntk;
    for (int it = item0; it < nitems_total; it += gridDim.x) {
        const int li = it - item_base; if (li < 0 || li >= n_it) continue;
        const int n0 = (li % ntn) * 64, k0 = (li / ntn) * 64;
        __syncthreads();
        const int c = tid & 63; int rc = n0 + c; if (REF) rc = ref_col(rc);
#pragma unroll
        for (int ps = 0; ps < 8; ++ps) { const int k = ps * 8 + (tid >> 6);
            tile[k][c] = rc >= 0 ? src[(size_t)(k0 + k) * src_pitch + rc] * (g ? g[k0 + k] : 1.f) : 0.f; }
        __syncthreads();
        const int cc = tid >> 3, kq = (tid & 7) * 8;
        h16x8 o;
#pragma unroll
        for (int j = 0; j < 8; ++j) o[j] = (h16)tile[kq + j][cc];
        *(h16x8*)(dst + (size_t)(n0 + cc) * K + k0 + kq) = o;
    }
    item_base += n_it;
}

DEVI void ph_rowstat_cvt(const float* h, float* rstd, h16* h16o) {
    const int t_ = otid(); const int lane = t_ & 63, gw = blockIdx.x * NWAVE + (t_ >> 6), nw = gridDim.x * NWAVE;
    for (int row = gw; row < NT; row += nw) {
        const float4* p = (const float4*)(h + (size_t)row * DM);
        float s = 0.f;
#pragma unroll
        for (int i = 0; i < 4; ++i) { float4 v = p[lane + 64 * i]; s += v.x * v.x + v.y * v.y + v.z * v.z + v.w * v.w;
            typedef _Float16 h16x4 __attribute__((ext_vector_type(4)));
            h16x4 o; o[0] = (h16)v.x; o[1] = (h16)v.y; o[2] = (h16)v.z; o[3] = (h16)v.w;
            *(h16x4*)(h16o + (size_t)row * DM + (lane + 64 * i) * 4) = o; }
        for (int o = 32; o; o >>= 1) s += __shfl_xor(s, o);
        if (lane == 0) rstd[row] = rsqrtf(s / DM + EPS);
    }
}

typedef float f32x16 __attribute__((ext_vector_type(16)));
typedef _Float16 h16x4 __attribute__((ext_vector_type(4)));
DEVI f32x16 mfma32(h16x8 a, h16x8 b, f32x16 c) { return __builtin_amdgcn_mfma_f32_32x32x16_f16(a, b, c, 0, 0, 0); }
#define CROW(r) (((r) & 3) + 8 * ((r) >> 2))
DEVI float xh_max(float x) { auto r = __builtin_amdgcn_permlane32_swap(__float_as_uint(x), __float_as_uint(x), false, false); return fmaxf(__uint_as_float(r[0]), __uint_as_float(r[1])); }
DEVI float xh_sum(float x) { auto r = __builtin_amdgcn_permlane32_swap(__float_as_uint(x), __float_as_uint(x), false, false); return __uint_as_float(r[0]) + __uint_as_float(r[1]); }
DEVI unsigned pk2h(float a, float b) { auto v = __builtin_amdgcn_cvt_pkrtz(a, b); return __builtin_bit_cast(unsigned, v); }
DEVI h16x8 pack8(const f32x16& p, int s) {
    typedef unsigned u32x4_t __attribute__((ext_vector_type(4)));
    u32x4_t w;
    w[0] = pk2h(p[8 * s + 0], p[8 * s + 1]); w[1] = pk2h(p[8 * s + 2], p[8 * s + 3]); w[2] = pk2h(p[8 * s + 4], p[8 * s + 5]); w[3] = pk2h(p[8 * s + 6], p[8 * s + 7]);
    return __builtin_bit_cast(h16x8, w);
}
DEVI h16x8 ldv8(const h16* p) {
    h16x4 a = *(const h16x4*)p, b = *(const h16x4*)(p + 8);
    h16x8 r; r[0] = a[0]; r[1] = a[1]; r[2] = a[2]; r[3] = a[3]; r[4] = b[0]; r[5] = b[1]; r[6] = b[2]; r[7] = b[3]; return r;
}
DEVI void softmax_tile(f32x16& S, float& m, float& l, f32x16& O0, f32x16& O1) {
    float mx = S[0];
#pragma unroll
    for (int r = 1; r < 16; ++r) mx = fmaxf(mx, S[r]);
    mx = xh_max(mx);
    if (__any(mx > m)) {
        const float mn = fmaxf(m, mx), al = __builtin_amdgcn_exp2f(m - mn);
        l *= al; O0 *= al; O1 *= al; m = mn;
    }
    float ls = 0.f;
#pragma unroll
    for (int r = 0; r < 16; ++r) { S[r] = __builtin_amdgcn_exp2f(S[r] - m); ls += S[r]; }
    l += ls;
}
DEVI int wq_next(unsigned* ctr) {
    int e = 0;
    if ((otid() & 63) == 0) e = (int)__hip_atomic_fetch_add(ctr, 1u, __ATOMIC_RELAXED, __HIP_MEMORY_SCOPE_AGENT);
    return __builtin_amdgcn_readfirstlane(e);
}

DEVI void flashA_item(int b, int hh, int qt, const h16* qA, const h16* kA, const h16* kAr, const h16* vAT, const h16* gate, h16* mix) {
    const int lane = otid() & 63, q = lane & 31, h = lane >> 5;
    const size_t tokq = (size_t)b * SEQ + qt * 32 + q;
    h16x8 qf[6];
#pragma unroll
    for (int ks = 0; ks < 6; ++ks) qf[ks] = *(const h16x8*)(qA + tokq * 384 + hh * 96 + ks * 16 + 8 * h);
    f32x16 O0 = {}, O1 = {};
    float m = -1e30f, l = 0.f;
    const h16* vbase = vAT + ((size_t)(b * 4 + hh) * 64 + q) * SEQ + 4 * h;
    h16x8 kf[6];
    {
        const size_t tk = (size_t)b * SEQ + q;
#pragma unroll
        for (int ks = 0; ks < 4; ++ks) kf[ks] = *(const h16x8*)(kA + tk * 256 + hh * 64 + ks * 16 + 8 * h);
#pragma unroll
        for (int ks = 0; ks < 2; ++ks) kf[4 + ks] = *(const h16x8*)(kAr + tk * 32 + ks * 16 + 8 * h);
    }
    for (int j = 0; j <= qt; ++j) {
        const int s0 = j * 32;
        h16x8 vf[2][2];
#pragma unroll
        for (int db = 0; db < 2; ++db)
#pragma unroll
            for (int sk = 0; sk < 2; ++sk) vf[db][sk] = ldv8(vbase + (size_t)db * 32 * SEQ + s0 + 16 * sk);
        f32x16 S = {};
#pragma unroll
        for (int ks = 0; ks < 6; ++ks) S = mfma32(kf[ks], qf[ks], S);
        if (j < qt) {
            const size_t tk = (size_t)b * SEQ + s0 + 32 + q;
#pragma unroll
            for (int ks = 0; ks < 4; ++ks) kf[ks] = *(const h16x8*)(kA + tk * 256 + hh * 64 + ks * 16 + 8 * h);
#pragma unroll
            for (int ks = 0; ks < 2; ++ks) kf[4 + ks] = *(const h16x8*)(kAr + tk * 32 + ks * 16 + 8 * h);
        } else {
#pragma unroll
            for (int r = 0; r < 16; ++r) S[r] = (CROW(r) + 4 * h > q) ? -3e38f : S[r];
        }
        softmax_tile(S, m, l, O0, O1);
        const h16x8 p0 = pack8(S, 0), p1 = pack8(S, 1);
        O0 = mfma32(vf[0][0], p0, O0); O0 = mfma32(vf[0][1], p1, O0);
        O1 = mfma32(vf[1][0], p0, O1); O1 = mfma32(vf[1][1], p1, O1);
    }
    const float il = 1.f / xh_sum(l);
    const h16* gp = gate + tokq * 1024 + hh * 64 + 4 * h; h16* op = mix + tokq * 1024 + hh * 64 + 4 * h;
#pragma unroll
    for (int db = 0; db < 2; ++db)
#pragma unroll
        for (int g = 0; g < 4; ++g) {
            const h16x4 gv = *(const h16x4*)(gp + db * 32 + 8 * g); h16x4 o;
#pragma unroll
            for (int e = 0; e < 4; ++e) o[e] = (h16)((db ? O1[4 * g + e] : O0[4 * g + e]) * il * (float)gv[e]);
            *(h16x4*)(op + db * 32 + 8 * g) = o;
        }
}

constexpr int L_NEAR = 0, L_R3 = 12288, L_R2 = 15360, L_R1 = 21504, L_LAM = 39936, L_P2END = 40000;
DEVI void p2_setup(const float* biasTab, const float* lam_p, float lambda_init, unsigned char* lds) {
    const int tid = otid();
    float* nearR = (float*)(lds + L_NEAR);
    for (int i = tid; i < 12 * 256; i += NTHR) { const int hb = i >> 8, u = i & 255, tix = 223 - u; nearR[i] = tix < 0 ? -3e38f : biasTab[hb * 2048 + tix]; }
    float* R3 = (float*)(lds + L_R3); float* R2 = (float*)(lds + L_R2); float* R1 = (float*)(lds + L_R1);
    for (int i = tid; i < 4 * 192; i += NTHR) { const int hb = i / 192, kk = 159 - (i % 192); R3[i] = (kk < 0 || kk > 128) ? -3e38f : biasTab[hb * 2048 + kk * 16]; }
    for (int i = tid; i < 4 * 384; i += NTHR) { const int hb = i / 384, kk = 255 - (i % 384); R2[i] = (kk < 0 || kk > 128) ? -3e38f : biasTab[hb * 2048 + kk * 4]; }
    for (int i = tid; i < 4 * 1152; i += NTHR) { const int hb = i / 1152, kk = 639 - (i % 1152); R1[i] = (kk < 0 || kk > 128) ? -3e38f : biasTab[hb * 2048 + kk]; }
    if (tid == 0) { float a1 = 0.f, a2 = 0.f; for (int i = 0; i < 32; ++i) { a1 += lam_p[i] * lam_p[32 + i]; a2 += lam_p[64 + i] * lam_p[96 + i]; }
        *(float*)(lds + L_LAM) = expf(a1) - expf(a2) + lambda_init; }
    __syncthreads();
}

DEVI void ph_vtrans(const h16* vtmp, h16* VT, unsigned char* lds) {
    const int tid = otid();
    h16 (*tile)[72] = (h16 (*)[72])lds;
    constexpr size_t VSZ = (size_t)32 * 64 * SEQ;
    for (int it = blockIdx.x; it < 3 * 32 * 32; it += gridDim.x) {
        const int src = it / 1024, bh = (it >> 5) & 31, s0 = (it & 31) * 64, b = bh >> 2, hh = bh & 3;
        __syncthreads();
        { const int r = tid >> 3, c8 = tid & 7;
          *(h16x8*)&tile[r][c8 * 8] = *(const h16x8*)(vtmp + ((size_t)b * SEQ + s0 + r) * 768 + src * 256 + hh * 64 + c8 * 8); }
        __syncthreads();
        const int d = tid >> 3;
        h16* rowN = VT + (src == 0 ? 0 : (src == 1 ? 3 * VSZ : 4 * VSZ)) + ((size_t)bh * 64 + d) * SEQ;
        { const int t8 = (tid & 7) * 8; h16x8 o;
#pragma unroll
          for (int j = 0; j < 8; ++j) o[j] = tile[t8 + j][d];
          *(h16x8*)(rowN + s0 + t8) = o; }
        if (src == 0) {
            const int blk = s0 >> 8;
            { const int r4 = (tid & 7) >> 1, half = tid & 1, i0 = (s0 & 255) >> 2; h16x8 o;
#pragma unroll
              for (int j = 0; j < 8; ++j) o[j] = tile[4 * (half * 8 + j) + r4][d];
              *(h16x8*)(rowN + VSZ + blk * 256 + r4 * 64 + i0 + half * 8) = o; }
            { const int i0 = (s0 & 255) >> 4;
#pragma unroll
              for (int rr = 0; rr < 2; ++rr) { const int r16 = 2 * (tid & 7) + rr; h16x4 o;
#pragma unroll
                  for (int j = 0; j < 4; ++j) o[j] = tile[16 * j + r16][d];
                  *(h16x4*)(rowN + 2 * VSZ + blk * 256 + r16 * 16 + i0) = o; } }
        }
    }
}

template <int NMAP, bool MASK>
DEVI void flashCD_item(int b, int hh, int qt, int hb, const h16* Q, const h16* K, const h16* VT, const unsigned* mask, const float* biasTab, const unsigned char* lds,
                       const float* subln, float lambda_init, const h16* gate, h16* mix, int mixcol) {
    constexpr int NKS = 4 / NMAP;
    const int lane = otid() & 63, q = lane & 31, h = lane >> 5;
    const size_t tokq = (size_t)b * SEQ + qt * 32 + q;
    h16x8 qf[NMAP][NKS], kf[NMAP][NKS];
#pragma unroll
    for (int mp = 0; mp < NMAP; ++mp)
#pragma unroll
        for (int ks = 0; ks < NKS; ++ks) {
            qf[mp][ks] = *(const h16x8*)(Q + tokq * 256 + hh * 64 + (mp * NKS + ks) * 16 + 8 * h);
            kf[mp][ks] = *(const h16x8*)(K + ((size_t)b * SEQ + q) * 256 + hh * 64 + (mp * NKS + ks) * 16 + 8 * h);
        }
    f32x16 O[NMAP][2]; float m[NMAP], l[NMAP];
#pragma unroll
    for (int mp = 0; mp < NMAP; ++mp) { O[mp][0] = (f32x16){}; O[mp][1] = (f32x16){}; m[mp] = -1e30f; l[mp] = 0.f; }
    const h16* vbase = VT + ((size_t)(b * 4 + hh) * 64 + q) * SEQ + 4 * h;
    const float* nearR = (const float*)(lds + L_NEAR) + hb * 256;
    const float* bt = biasTab + hb * 2048;
    for (int j = 0; j <= qt; ++j) {
        const int s0 = j * 32;
        h16x8 vf[2][2];
#pragma unroll
        for (int db = 0; db < 2; ++db)
#pragma unroll
            for (int sk = 0; sk < 2; ++sk) vf[db][sk] = ldv8(vbase + (size_t)db * 32 * SEQ + s0 + 16 * sk);
        unsigned mw = 0xffffffffu;
        if (MASK) mw = mask[tokq * 64 + j] >> (4 * h);
        f32x16 S[NMAP];
#pragma unroll
        for (int mp = 0; mp < NMAP; ++mp) { S[mp] = (f32x16){};
#pragma unroll
            for (int ks = 0; ks < NKS; ++ks) S[mp] = mfma32(kf[mp][ks], qf[mp][ks], S[mp]); }
        if (j < qt) {
            const size_t tk = (size_t)b * SEQ + s0 + 32 + q;
#pragma unroll
            for (int mp = 0; mp < NMAP; ++mp)
#pragma unroll
                for (int ks = 0; ks < NKS; ++ks) kf[mp][ks] = *(const h16x8*)(K + tk * 256 + hh * 64 + (mp * NKS + ks) * 16 + 8 * h);
        }
        const int D0 = (qt - j) * 32;
        if (D0 < 192) {
            const float* tp = nearR + (223 - D0 - q + 4 * h);
#pragma unroll
            for (int r = 0; r < 16; ++r) { const float bv = tp[CROW(r)];
#pragma unroll
                for (int mp = 0; mp < NMAP; ++mp) S[mp][r] += bv; }
        } else {
            const float lo = bt[D0 - 31], hi = bt[D0 + 31];
            if (lo == hi) {
#pragma unroll
                for (int mp = 0; mp < NMAP; ++mp) S[mp] += lo;
            } else {
                int bnd = 0;
#pragma unroll
                for (int jj = 8; jj < 16; ++jj) bnd = (D0 + 31 >= kBucketStart[jj]) ? kBucketStart[jj] : bnd;
                const int x = D0 + q - 4 * h - bnd;
#pragma unroll
                for (int r = 0; r < 16; ++r) { const float bv = (x >= CROW(r)) ? hi : lo;
#pragma unroll
                    for (int mp = 0; mp < NMAP; ++mp) S[mp][r] += bv; }
            }
        }
        if (MASK) {
#pragma unroll
            for (int r = 0; r < 16; ++r) S[0][r] = ((mw >> CROW(r)) & 1u) ? S[0][r] : -3e38f;
        }
#pragma unroll
        for (int mp = 0; mp < NMAP; ++mp) {
            softmax_tile(S[mp], m[mp], l[mp], O[mp][0], O[mp][1]);
            const h16x8 p0 = pack8(S[mp], 0), p1 = pack8(S[mp], 1);
            O[mp][0] = mfma32(vf[0][0], p0, O[mp][0]); O[mp][0] = mfma32(vf[0][1], p1, O[mp][0]);
            O[mp][1] = mfma32(vf[1][0], p0, O[mp][1]); O[mp][1] = mfma32(vf[1][1], p1, O[mp][1]);
        }
    }
    f32x16 R0, R1;
    if (NMAP == 2) {
        const float lam = *(const float*)(lds + L_LAM);
        const float i0 = 1.f / xh_sum(l[0]), i1 = lam / xh_sum(l[NMAP - 1]);
        R0 = O[0][0] * i0 - O[NMAP - 1][0] * i1; R1 = O[0][1] * i0 - O[NMAP - 1][1] * i1;
        float ss = 0.f;
#pragma unroll
        for (int r = 0; r < 16; ++r) ss += R0[r] * R0[r] + R1[r] * R1[r];
        ss = xh_sum(ss);
        const float rs = rsqrtf(ss * (1.f / 64.f) + EPS) * (1.f - lambda_init);
        R0 *= rs; R1 *= rs;
    } else {
        const float il = 1.f / xh_sum(l[0]);
        R0 = O[0][0] * il; R1 = O[0][1] * il;
    }
    const h16* gp = gate + tokq * 1024 + mixcol + hh * 64 + 4 * h; h16* op = mix + tokq * 1024 + mixcol + hh * 64 + 4 * h;
#pragma unroll
    for (int db = 0; db < 2; ++db)
#pragma unroll
        for (int g = 0; g < 4; ++g) {
            const h16x4 gv = *(const h16x4*)(gp + db * 32 + 8 * g); h16x4 o;
#pragma unroll
            for (int e = 0; e < 4; ++e) { float v = (db ? R1[4 * g + e] : R0[4 * g + e]) * (float)gv[e];
                if (NMAP == 2) v *= subln[db * 32 + 8 * g + 4 * h + e];
                o[e] = (h16)v; }
            *(h16x4*)(op + db * 32 + 8 * g) = o;
        }
}

DEVI void flashB_tile(const h16x8 (&qf)[4], const h16* krow, const h16* vrow, int vstep, const float* tp, f32x16& O0, f32x16& O1, float& m, float& l, int h) {
    h16x8 vf[2][2];
#pragma unroll
    for (int db = 0; db < 2; ++db)
#pragma unroll
        for (int sk = 0; sk < 2; ++sk) vf[db][sk] = ldv8(vrow + (size_t)db * 32 * SEQ + vstep * sk);
    f32x16 S = {};
#pragma unroll
    for (int ks = 0; ks < 4; ++ks) S = mfma32(*(const h16x8*)(krow + ks * 16 + 8 * h), qf[ks], S);
#pragma unroll
    for (int r = 0; r < 16; ++r) S[r] += tp[CROW(r)];
    softmax_tile(S, m, l, O0, O1);
    const h16x8 p0 = pack8(S, 0), p1 = pack8(S, 1);
    O0 = mfma32(vf[0][0], p0, O0); O0 = mfma32(vf[0][1], p1, O0);
    O1 = mfma32(vf[1][0], p0, O1); O1 = mfma32(vf[1][1], p1, O1);
}
DEVI void flashB_item(int b, int hh, int r, int qg, const h16* Q, const h16* K, const h16* VT, const unsigned char* lds, const h16* gate, h16* mix) {
    constexpr size_t VSZ = (size_t)32 * 64 * SEQ;
    const int lane = otid() & 63, q = lane & 31, h = lane >> 5;
    const size_t tokq = (size_t)b * SEQ + qg * 512 + 16 * q + r;
    h16x8 qf[4];
#pragma unroll
    for (int ks = 0; ks < 4; ++ks) qf[ks] = *(const h16x8*)(Q + tokq * 256 + hh * 64 + ks * 16 + 8 * h);
    f32x16 O0 = {}, O1 = {}; float m = -1e30f, l = 0.f;
    const h16* Kb = K + (size_t)b * SEQ * 256 + hh * 64;
    const h16* Vb = VT + ((size_t)(b * 4 + hh) * 64 + q) * SEQ + 4 * h;
    {
        const float* R3 = (const float*)(lds + L_R3) + hh * 192;
        for (int pk0 = (qg >= 4 ? qg - 4 : 0) * 32; pk0 <= qg * 32; pk0 += 32) {
            const int c = qg * 32 + q - pk0;
            flashB_tile(qf, Kb + (size_t)(16 * (pk0 + q) + r) * 256, Vb + 2 * VSZ + (pk0 >> 4) * 256 + r * 16, 256, R3 + (159 - c + 4 * h), O0, O1, m, l, h);
        }
    }
    {
        const float* R2 = (const float*)(lds + L_R2) + hh * 384; const int r4 = r & 3;
        for (int pk0 = (qg >= 1 ? qg * 128 - 128 : 0); pk0 <= qg * 128 + 96; pk0 += 32) {
            const int c = qg * 128 + 4 * q + (r >> 2) - pk0;
            flashB_tile(qf, Kb + (size_t)(4 * (pk0 + q) + r4) * 256, Vb + VSZ + (pk0 >> 6) * 256 + r4 * 64 + (pk0 & 63), 16, R2 + (255 - c + 4 * h), O0, O1, m, l, h);
        }
    }
    {
        const float* R1 = (const float*)(lds + L_R1) + hh * 1152;
        for (int s0 = (qg >= 1 ? qg * 512 - 128 : 0); s0 <= qg * 512 + 480; s0 += 32) {
            const int c = qg * 512 + 16 * q + r - s0;
            flashB_tile(qf, Kb + (size_t)(s0 + q) * 256, Vb + s0, 16, R1 + (639 - c + 4 * h), O0, O1, m, l, h);
        }
    }
    const float il = 1.f / xh_sum(l);
    const h16* gp = gate + tokq * 1024 + 256 + hh * 64 + 4 * h; h16* op = mix + tokq * 1024 + 256 + hh * 64 + 4 * h;
#pragma unroll
    for (int db = 0; db < 2; ++db)
#pragma unroll
        for (int g = 0; g < 4; ++g) {
            const h16x4 gv = *(const h16x4*)(gp + db * 32 + 8 * g); h16x4 o;
#pragma unroll
            for (int e = 0; e < 4; ++e) o[e] = (h16)((db ? O1[4 * g + e] : O0[4 * g + e]) * il * (float)gv[e]);
            *(h16x4*)(op + db * 32 + 8 * g) = o;
        }
}

DEVI unsigned xh_or(unsigned x) { auto r = __builtin_amdgcn_permlane32_swap(x, x, false, false); return r[0] | r[1]; }
DEVI void idx_tile(const h16* idx, int b, int j, int qt, int q, int h, const h16x8 (&qf)[8][2], const float (&ws)[8], float lo, float scl, unsigned (&kq)[16]) {
    const size_t tk = (size_t)b * SEQ + j * 32 + q;
    const h16x8 k0 = *(const h16x8*)(idx + tk * 320 + 256 + 8 * h), k1 = *(const h16x8*)(idx + tk * 320 + 272 + 8 * h);
    f32x16 sc = {};
#pragma unroll
    for (int hd = 0; hd < 8; ++hd) {
        f32x16 L = {}; L = mfma32(k0, qf[hd][0], L); L = mfma32(k1, qf[hd][1], L);
#pragma unroll
        for (int r = 0; r < 16; ++r) sc[r] += fmaxf(L[r], 0.f) * ws[hd];
    }
#pragma unroll
    for (int r = 0; r < 16; ++r) {
        const float x = fminf(fmaxf((sc[r] - lo) * scl, 0.f), 2097151.f);
        unsigned u = (unsigned)x;
        if (j == qt && CROW(r) + 4 * h > q) u = 0xFFFFFFFFu;
        kq[r] = u;
    }
}
constexpr int TK_HIST = 0, TK_EQC = 8320, TK_END = 10368;
DEVI void topk_item(int b, int qt, const h16* idx, unsigned* mask, unsigned char* lds) {
    const int tid = otid(), lane = tid & 63, q = lane & 31, h = lane >> 5, wv = tid >> 6;
    const size_t tokq = (size_t)b * SEQ + qt * 32 + q;
    LAS unsigned* hist = (LAS unsigned*)(lds + TK_HIST);
    LAS unsigned char* eqc = (LAS unsigned char*)(lds + TK_EQC);
    h16x8 qf[8][2]; float ws[8];
    float P = 0.f, N = 0.f;
#pragma unroll
    for (int hd = 0; hd < 8; ++hd) {
        qf[hd][0] = *(const h16x8*)(idx + tokq * 320 + hd * 32 + 8 * h); qf[hd][1] = *(const h16x8*)(idx + tokq * 320 + hd * 32 + 16 + 8 * h);
        ws[hd] = (float)idx[tokq * 320 + 288 + hd] * 0.35355339059327373f;
        float nn = 0.f;
#pragma unroll
        for (int e = 0; e < 8; ++e) { const float a = (float)qf[hd][0][e], c = (float)qf[hd][1][e]; nn += a * a + c * c; }
        nn = sqrtf(xh_sum(nn)) * 12.f;
        if (ws[hd] > 0.f) P += ws[hd] * nn; else N -= ws[hd] * nn;
    }
    const float lo = -N, scl = 2097151.f / fmaxf(P + N, 1e-20f);
    __syncthreads();
    for (int i = tid; i < 32 * 65; i += NTHR) hist[i] = 0u;
    __syncthreads();
    unsigned R = 256u, pref = 0u;
#pragma unroll 1
    for (int lvl = 0; lvl < 3; ++lvl) {
        const int sh = 14 - 7 * lvl;
        for (int j = wv; j <= qt; j += 8) {
            unsigned kq[16];
            idx_tile(idx, b, j, qt, q, h, qf, ws, lo, scl, kq);
#pragma unroll
            for (int r = 0; r < 16; ++r) {
                if ((kq[r] >> (sh + 7)) == pref) {
                    const unsigned bin = (kq[r] >> sh) & 127u;
                    __hip_atomic_fetch_add(hist + q * 65 + (bin >> 1), 1u << ((bin & 1u) * 16u), __ATOMIC_RELAXED, __HIP_MEMORY_SCOPE_WORKGROUP);
                }
            }
        }
        __syncthreads();
        {
            unsigned cum = 0u, found = 0u, bb = 0u, above = 0u;
#pragma unroll 4
            for (int w = 63; w >= 0; --w) {
                const unsigned v = hist[q * 65 + w];
                unsigned t = cum + (v >> 16);
                if (!found && t >= R) { bb = 2u * w + 1u; above = cum; found = 1u; }
                cum = t; t = cum + (v & 0xffffu);
                if (!found && t >= R) { bb = 2u * w; above = cum; found = 1u; }
                cum = t;
            }
            R -= above; pref = (pref << 7) | bb;
        }
        __syncthreads();
        for (int i = tid; i < 32 * 65; i += NTHR) hist[i] = 0u;
        __syncthreads();
    }
    unsigned GT[8], EQ[8];
#pragma unroll
    for (int n = 0; n < 8; ++n) {
        const int j = wv + 8 * n; GT[n] = 0u; EQ[n] = 0u;
        if (j <= qt) {
            unsigned kq[16];
            idx_tile(idx, b, j, qt, q, h, qf, ws, lo, scl, kq);
            unsigned g = 0u, e = 0u;
#pragma unroll
            for (int r = 0; r < 16; ++r) {
                g |= (kq[r] > pref && (kq[r] >> 21) == 0u) ? (1u << CROW(r)) : 0u;
                e |= (kq[r] == pref) ? (1u << CROW(r)) : 0u;
            }
            GT[n] = xh_or(g << (4 * h)); EQ[n] = xh_or(e << (4 * h));
            if (h == 0) eqc[q * 64 + j] = (unsigned char)__builtin_popcount(EQ[n]);
        }
    }
    __syncthreads();
#pragma unroll
    for (int n = 0; n < 8; ++n) {
        const int j = wv + 8 * n;
        if (j <= qt) {
            unsigned before = 0u;
#pragma unroll
            for (int k = 0; k < 16; ++k) {
                const int nb = j - 4 * k;
                if (nb > 0) { unsigned v = *(const LAS unsigned*)(eqc + q * 64 + 4 * k); if (nb < 4) v &= (1u << (8 * nb)) - 1u; before += (v * 0x01010101u) >> 24; }
            }
            unsigned e = EQ[n]; const unsigned pc = (unsigned)__builtin_popcount(e);
            const unsigned allow = before >= R ? 0u : (R - before < pc ? R - before : pc);
            unsigned keep = e;
            if (allow < pc) { keep = 0u; for (unsigned c = 0; c < allow; ++c) { const unsigned bit = e & (0u - e); keep |= bit; e ^= bit; } }
            if (h == 0) mask[tokq * 64 + j] = GT[n] | keep;
        }
    }
}
DEVI void ph_topk(const h16* idx, unsigned* mask, unsigned char* lds) {
    for (int g = blockIdx.x; g < 256; g += gridDim.x) {
        const int b = g >> 5, k = g & 31;
        if (k < 28) { topk_item(b, 63 - k, idx, mask, lds); topk_item(b, 8 + k, idx, mask, lds); }
        else if (k == 28) { const int tid = otid(); for (int i = tid; i < 256 * 8; i += NTHR) { const int t = i >> 3, j = i & 7; if (j <= (t >> 5)) mask[((size_t)b * SEQ + t) * 64 + j] = 0xffffffffu; } }
    }
}

constexpr int LDS_BYTES = 144 * 1024;
struct Params { const float* in[12]; float* out; unsigned char* ws; };

DEVI void ph_tables(const float* __restrict__ rel_bias, float* biasTab, float* cosT, float* sinT) {
    for (int i = blockIdx.x * NTHR + threadIdx.x; i < 2048 * 16; i += gridDim.x * NTHR) {
        if (i < 12 * 2048) { int hh = i / 2048, n = i % 2048; biasTab[i] = rel_bias[t5_bucket(n) * 12 + hh] * LOG2E; }
        int pos = i / 16, j = i % 16;
        float inv = (float)pow(10000.0, -(double)(2 * j) / 32.0);
        float ang = (float)pos * inv;
        cosT[i] = (float)cos((double)ang); sinT[i] = (float)sin((double)ang);
    }
}

DEVI void ph_rowstat(const float* h, float* rstd) {
    const int lane = threadIdx.x & 63, gw = blockIdx.x * NWAVE + (threadIdx.x >> 6), nw = gridDim.x * NWAVE;
    for (int row = gw; row < NT; row += nw) {
        const float4* p = (const float4*)(h + (size_t)row * DM);
        float s = 0.f;
        for (int i = lane; i < 256; i += 64) { float4 v = p[i]; s += v.x * v.x + v.y * v.y + v.z * v.z + v.w * v.w; }
        for (int o = 32; o; o >>= 1) s += __shfl_xor(s, o);
        if (lane == 0) rstd[row] = rsqrtf(s / DM + EPS);
    }
}

DEVI void ph_gemm_in_naive(const float* h, const float* __restrict__ g, const float* __restrict__ w, const float* rstd, unsigned char* ws, unsigned char* lds) {
    const int t_ = otid(); const int sub = t_ >> 8, tid = t_ & 255, ty = tid >> 4, tx = tid & 15;
    float (*As)[68] = (float (*)[68])(lds + sub * 2 * 16 * 68 * 4);
    float (*Bs)[68] = (float (*)[68])(lds + sub * 2 * 16 * 68 * 4 + 16 * 68 * 4);
    for (int it = blockIdx.x; it < 64 * 256 / 2; it += gridDim.x) {
        const int vb = it * 2 + sub, col0 = (vb & 63) * 64, row0 = (vb >> 6) * 64;
        float acc[4][4] = {};
        const int ar = tid >> 2, ak = (tid & 3) * 4, bk = tid >> 4, bc = (tid & 15) * 4;
        int rc[4];
#pragma unroll
        for (int j = 0; j < 4; ++j) rc[j] = ref_col(col0 + bc + j);
        for (int k0 = 0; k0 < DM; k0 += 16) {
            float4 av = *(const float4*)(h + (size_t)(row0 + ar) * DM + k0 + ak);
            float4 gv = *(const float4*)(g + k0 + ak);
            As[ak + 0][ar] = av.x * gv.x; As[ak + 1][ar] = av.y * gv.y; As[ak + 2][ar] = av.z * gv.z; As[ak + 3][ar] = av.w * gv.w;
#pragma unroll
            for (int j = 0; j < 4; ++j) Bs[bk][bc + j] = rc[j] >= 0 ? w[(size_t)(k0 + bk) * INC + rc[j]] : 0.f;
            __syncthreads();
#pragma unroll
            for (int kk = 0; kk < 16; ++kk) {
                float a[4], b[4];
#pragma unroll
                for (int i = 0; i < 4; ++i) { a[i] = As[kk][ty * 4 + i]; b[i] = Bs[kk][tx * 4 + i]; }
#pragma unroll
                for (int i = 0; i < 4; ++i)
#pragma unroll
                    for (int j = 0; j < 4; ++j) acc[i][j] += a[i] * b[j];
            }
            __syncthreads();
        }
        const int c = col0 + tx * 4;
        Route r = route(c);
        if (r.buf >= 0) {
            h16* dst = (h16*)(ws + buf_off(r.buf));
#pragma unroll
            for (int i = 0; i < 4; ++i) {
                int row = row0 + ty * 4 + i; float rs = rstd[row];
#pragma unroll
                for (int j = 0; j < 4; ++j) {
                    float v = acc[i][j] * rs * r.scale;
                    if (r.silu) v = v / (1.f + __expf(-v));
                    dst[(size_t)row * r.pitch + r.dcol + j] = (h16)v;
                }
            }
        }
    }
}

DEVI void ph_mla_naive(const h16* cA, const float* __restrict__ qn, const float* __restrict__ kvn, const float* __restrict__ wuq, const float* __restrict__ wukv,
                       const float* cosT, const float* sinT, h16* qA, h16* kA, h16* kAr, h16* vAT, unsigned char* lds) {
    const int t_ = otid(); const int sub = t_ >> 7, tid = t_ & 127;
    float* cq = (float*)(lds + sub * 3072); float* ckv = cq + 192; float* kr = ckv + 128; float* qout = kr + 32; float* red = qout + 384;
    for (int it = blockIdx.x; it < NT / 4; it += gridDim.x) {
        const int tok = it * 4 + sub, s = tok % SEQ;
        __syncthreads();
        for (int i = tid; i < 192; i += 128) cq[i] = (float)cA[(size_t)tok * 384 + i];
        ckv[tid] = (float)cA[(size_t)tok * 384 + 192 + tid];
        if (tid < 32) kr[tid] = (float)cA[(size_t)tok * 384 + 320 + tid];
        __syncthreads();
        if (tid < 64) {
            float a = 0.f; for (int i = tid; i < 192; i += 64) a += cq[i] * cq[i];
            for (int o = 32; o; o >>= 1) a += __shfl_xor(a, o);
            if (tid == 0) red[0] = rsqrtf(a / 192.f + EPS);
        } else {
            int l = tid - 64; float a = 0.f; for (int i = l; i < 128; i += 64) a += ckv[i] * ckv[i];
            for (int o = 32; o; o >>= 1) a += __shfl_xor(a, o);
            if (l == 0) red[1] = rsqrtf(a / 128.f + EPS);
        }
        __syncthreads();
        for (int i = tid; i < 192; i += 128) cq[i] = cq[i] * red[0] * qn[i];
        ckv[tid] = ckv[tid] * red[1] * kvn[tid];
        __syncthreads();
        for (int n = tid; n < 384; n += 128) { float a = 0.f; for (int k = 0; k < 192; ++k) a += cq[k] * wuq[k * 384 + n]; qout[n] = a; }
        __syncthreads();
        const float qs = 0.10206207261596577f * LOG2E;
        for (int idx = tid; idx < 384; idx += 128) {
            int hh = idx / 96, j = idx % 96; float val;
            if (j < 64) val = qout[idx];
            else { int r = j - 64, i = r & 15; float x1 = qout[hh * 96 + 64 + i], x2 = qout[hh * 96 + 80 + i], c = cosT[s * 16 + i], sn = sinT[s * 16 + i];
                   val = r < 16 ? x1 * c - x2 * sn : x1 * sn + x2 * c; }
            qA[(size_t)tok * 384 + idx] = (h16)(val * qs);
        }
        for (int n = tid; n < 512; n += 128) {
            float a = 0.f; for (int k = 0; k < 128; ++k) a += ckv[k] * wukv[k * 512 + n];
            int hh = n / 128, j = n % 128;
            if (j < 64) kA[(size_t)tok * 256 + hh * 64 + j] = (h16)a; else { vAT[((size_t)((tok / SEQ) * 4 + hh) * 64 + j - 64) * SEQ + s] = (h16)a; }
        }
        if (tid < 32) { int i = tid & 15; float x1 = kr[i], x2 = kr[16 + i], c = cosT[s * 16 + i], sn = sinT[s * 16 + i];
            kAr[(size_t)tok * 32 + tid] = (h16)(tid < 16 ? x1 * c - x2 * sn : x1 * sn + x2 * c); }
    }
}

DEVI void ph_attnA_naive(int vb, const h16* qA, const h16* kA, const h16* vA, const h16* kAr, const h16* gate, h16* mix) {
    const int chunk = 63 - (vb % 64), bh = vb / 64, b = bh / 4, hh = bh % 4, half = (otid() >> 5) & 1;
    const int t = chunk * 32 + (otid() & 31); const size_t tok = (size_t)b * SEQ + t;
    float q[96], o[32];
#pragma unroll
    for (int i = 0; i < 96; ++i) q[i] = (float)qA[tok * 384 + hh * 96 + i];
#pragma unroll
    for (int i = 0; i < 32; ++i) o[i] = 0.f;
    float m = -1e30f, l = 0.f;
    const int smax = chunk * 32 + 31;
    for (int s = 0; s <= smax; ++s) {
        const size_t ks = (size_t)b * SEQ + s;
        const h16* kp = kA + ks * 256 + hh * 64; const h16* kr = kAr + ks * 32; const h16* vp = vA + ks * 256 + hh * 64 + half * 32;
        float sc = 0.f;
#pragma unroll
        for (int i = 0; i < 64; ++i) sc += q[i] * (float)kp[i];
#pragma unroll
        for (int i = 0; i < 32; ++i) sc += q[64 + i] * (float)kr[i];
        if (s <= t) {
            if (sc > m) { float a = exp2f(m - sc); l *= a;
#pragma unroll
                for (int i = 0; i < 32; ++i) o[i] *= a;
                m = sc; }
            float p = exp2f(sc - m); l += p;
#pragma unroll
            for (int i = 0; i < 32; ++i) o[i] += p * (float)vp[i];
        }
    }
    float il = 1.f / l;
#pragma unroll
    for (int i = 0; i < 32; ++i) mix[tok * 1024 + hh * 64 + half * 32 + i] = (h16)(o[i] * il * (float)gate[tok * 1024 + hh * 64 + half * 32 + i]);
}

DEVI void ph_attnB_naive(int vb, const h16* qB, const h16* kB, const h16* vt, const float* biasTab, const h16* gate, h16* mix) {
    const int chunk = vb % 32, bh = vb / 32, b = bh / 4, hh = bh % 4;
    const int t = chunk * 64 + (otid() & 63); const size_t tok = (size_t)b * SEQ + t;
    float q[64], o[64];
#pragma unroll
    for (int i = 0; i < 64; ++i) { q[i] = (float)qB[tok * 256 + hh * 64 + i]; o[i] = 0.f; }
    float m = -1e30f, l = 0.f;
    const float* bt = biasTab + hh * 2048;
    for (int pat = 0; pat < 3; ++pat) {
        const int d = pat == 0 ? 1 : (pat == 1 ? 4 : 16);
        for (int k = 0; k <= 128; ++k) {
            const int s = t - k * d; if (s < 0) break;
            const size_t ks = (size_t)b * SEQ + s;
            const h16* kp = kB + ks * 256 + hh * 64; const h16* vp = vt + ks * 768 + hh * 64;
            float sc = bt[k * d];
#pragma unroll
            for (int i = 0; i < 64; ++i) sc += q[i] * (float)kp[i];
            if (sc > m) { float a = exp2f(m - sc); l *= a;
#pragma unroll
                for (int i = 0; i < 64; ++i) o[i] *= a;
                m = sc; }
            float p = exp2f(sc - m); l += p;
#pragma unroll
            for (int i = 0; i < 64; ++i) o[i] += p * (float)vp[i];
        }
    }
    float il = 1.f / l;
#pragma unroll
    for (int i = 0; i < 64; ++i) mix[tok * 1024 + 256 + hh * 64 + i] = (h16)(o[i] * il * (float)gate[tok * 1024 + 256 + hh * 64 + i]);
}

DEVI void ph_topk_naive(const h16* idx, unsigned* mask, unsigned char* lds) {
    const int t_ = otid(); const int sub = t_ >> 8, tid = t_ & 255;
    float* sc = (float*)(lds + sub * 9728); float* qi = sc + 2048; float* wi = qi + 256; unsigned* msk = (unsigned*)(wi + 8);
    for (int it = blockIdx.x; it < NT / 2; it += gridDim.x) {
        const int tok = (NT / 2 - 1 - it) * 2 + sub, b = tok / SEQ, t = tok % SEQ;
        __syncthreads();
        qi[tid] = (float)idx[(size_t)tok * 320 + tid];
        if (tid < 8) wi[tid] = (float)idx[(size_t)tok * 320 + 288 + tid] * 0.35355339059327373f;
        if (tid < 64) msk[tid] = 0u;
        __syncthreads();
        for (int s = tid; s <= t; s += 256) {
            const h16* kp = idx + ((size_t)b * SEQ + s) * 320 + 256;
            float kk[32];
#pragma unroll
            for (int d = 0; d < 32; ++d) kk[d] = (float)kp[d];
            float score = 0.f;
#pragma unroll 1
            for (int hh = 0; hh < 8; ++hh) { float lg = 0.f;
#pragma unroll
                for (int d = 0; d < 32; ++d) lg += qi[hh * 32 + d] * kk[d];
                score += fmaxf(lg, 0.f) * wi[hh]; }
            sc[s] = score;
        }
        __syncthreads();
        if (t + 1 <= 256) {
            for (int i = tid; i <= t; i += 256) atomicOr(&msk[i >> 5], 1u << (i & 31));
        } else {
            for (int i = tid; i <= t; i += 256) {
                const float si = sc[i]; int rank = 0;
                for (int j = 0; j <= t; ++j) { float sj = sc[j]; rank += (sj > si || (sj == si && j < i)) ? 1 : 0; }
                if (rank < 256) atomicOr(&msk[i >> 5], 1u << (i & 31));
            }
        }
        __syncthreads();
        if (tid < 64) mask[(size_t)tok * 64 + tid] = msk[tid];
    }
}

DEVI void ph_attnC_naive(int vb, const h16* qC, const h16* kC, const h16* vt, const unsigned* mask, const float* biasTab, const h16* gate, h16* mix) {
    const int chunk = 31 - (vb % 32), bh = vb / 32, b = bh / 4, hh = bh % 4;
    const int t = chunk * 64 + (otid() & 63); const size_t tok = (size_t)b * SEQ + t;
    float q[64], o[64];
#pragma unroll
    for (int i = 0; i < 64; ++i) { q[i] = (float)qC[tok * 256 + hh * 64 + i]; o[i] = 0.f; }
    float m = -1e30f, l = 0.f;
    const float* bt = biasTab + (4 + hh) * 2048;
    const int smax = chunk * 64 + 63;
    unsigned mw = 0;
    for (int s = 0; s <= smax; ++s) {
        if ((s & 31) == 0) mw = mask[tok * 64 + (s >> 5)];
        const size_t ks = (size_t)b * SEQ + s;
        const h16* kp = kC + ks * 256 + hh * 64; const h16* vp = vt + ks * 768 + 256 + hh * 64;
        float sc = 0.f;
#pragma unroll
        for (int i = 0; i < 64; ++i) sc += q[i] * (float)kp[i];
        if (s <= t && ((mw >> (s & 31)) & 1u)) {
            sc += bt[t - s];
            if (sc > m) { float a = exp2f(m - sc); l *= a;
#pragma unroll
                for (int i = 0; i < 64; ++i) o[i] *= a;
                m = sc; }
            float p = exp2f(sc - m); l += p;
#pragma unroll
            for (int i = 0; i < 64; ++i) o[i] += p * (float)vp[i];
        }
    }
    float il = 1.f / l;
#pragma unroll
    for (int i = 0; i < 64; ++i) mix[tok * 1024 + 512 + hh * 64 + i] = (h16)(o[i] * il * (float)gate[tok * 1024 + 512 + hh * 64 + i]);
}

DEVI void ph_attnD_naive(int vb, const h16* qD, const h16* kD, const h16* vt, const float* biasTab, const float* __restrict__ lam_p, const float* __restrict__ subln,
                         float lambda_init, const h16* gate, h16* mix) {
    const int t_ = otid();
    const int chunk = 127 - (vb % 128), bh = vb / 128, b = bh / 4, hh = bh % 4, mp = (t_ >> 4) & 1, half = (t_ >> 5) & 1;
    const int t = chunk * 16 + (t_ & 15); const size_t tok = (size_t)b * SEQ + t;
    float q[32], o[32];
#pragma unroll
    for (int i = 0; i < 32; ++i) { q[i] = (float)qD[tok * 256 + hh * 64 + mp * 32 + i]; o[i] = 0.f; }
    float m = -1e30f, l = 0.f;
    float a1 = 0.f, a2 = 0.f;
    for (int i = 0; i < 32; ++i) { a1 += lam_p[i] * lam_p[32 + i]; a2 += lam_p[64 + i] * lam_p[96 + i]; }
    const float lam = expf(a1) - expf(a2) + lambda_init;
    const float* bt = biasTab + (8 + hh) * 2048;
    const int smax = chunk * 16 + 15;
    for (int s = 0; s <= smax; ++s) {
        const size_t ks = (size_t)b * SEQ + s;
        const h16* kp = kD + ks * 256 + hh * 64 + mp * 32; const h16* vp = vt + ks * 768 + 512 + hh * 64 + half * 32;
        float sc = 0.f;
#pragma unroll
        for (int i = 0; i < 32; ++i) sc += q[i] * (float)kp[i];
        if (s <= t) {
            sc += bt[t - s];
            if (sc > m) { float a = exp2f(m - sc); l *= a;
#pragma unroll
                for (int i = 0; i < 32; ++i) o[i] *= a;
                m = sc; }
            float p = exp2f(sc - m); l += p;
#pragma unroll
            for (int i = 0; i < 32; ++i) o[i] += p * (float)vp[i];
        }
    }
    const float sgn = mp ? -lam : 1.f; const float il = sgn / l;
    float ss = 0.f;
#pragma unroll
    for (int i = 0; i < 32; ++i) { float v = o[i] * il; v += __shfl_xor(v, 16); o[i] = v; ss += v * v; }
    ss += __shfl_xor(ss, 32);
    float rs = rsqrtf(ss / 64.f + EPS) * (1.f - lambda_init);
    if (mp == 0) {
        int tt = b * SEQ + t; asm volatile("" : "+v"(tt)); const size_t tok2 = (size_t)tt;
#pragma unroll
        for (int i = 0; i < 32; ++i) mix[tok2 * 1024 + 768 + hh * 64 + half * 32 + i] = (h16)(o[i] * rs * subln[half * 32 + i] * (float)gate[tok2 * 1024 + 768 + hh * 64 + half * 32 + i]);
    }
}

DEVI void ph_out_naive(const h16* mix, const float* __restrict__ w, const float* __restrict__ g, const float* h_in, float* h_out, unsigned char* lds) {
    const int t_ = otid(); const int sub = t_ >> 8, tid = t_ & 255;
    float (*A)[1024] = (float (*)[1024])(lds + sub * 33024); float (*red)[4] = (float (*)[4])(lds + sub * 33024 + 32768);
    for (int it = blockIdx.x; it < NT / 16; it += gridDim.x) {
        const int row0 = (it * 2 + sub) * 8;
        __syncthreads();
        for (int i = tid; i < 8 * 1024; i += 256) A[i >> 10][i & 1023] = (float)mix[(size_t)(row0 + (i >> 10)) * 1024 + (i & 1023)];
        __syncthreads();
        float acc[8][4] = {};
        for (int k = 0; k < 1024; ++k) {
            float wv[4];
#pragma unroll
            for (int j = 0; j < 4; ++j) wv[j] = w[(size_t)k * 1024 + tid + 256 * j];
#pragma unroll
            for (int r = 0; r < 8; ++r) { float a = A[r][k];
#pragma unroll
                for (int j = 0; j < 4; ++j) acc[r][j] += a * wv[j]; }
        }
#pragma unroll
        for (int r = 0; r < 8; ++r) {
            float s = 0.f;
#pragma unroll
            for (int j = 0; j < 4; ++j) s += acc[r][j] * acc[r][j];
            for (int o = 32; o; o >>= 1) s += __shfl_xor(s, o);
            if ((tid & 63) == 0) red[r][tid >> 6] = s;
        }
        __syncthreads();
#pragma unroll
        for (int r = 0; r < 8; ++r) {
            float rs = rsqrtf((red[r][0] + red[r][1] + red[r][2] + red[r][3]) / 1024.f + EPS);
#pragma unroll
            for (int j = 0; j < 4; ++j) { int n = tid + 256 * j; size_t o = (size_t)(row0 + r) * 1024 + n; h_out[o] = h_in[o] + acc[r][j] * rs * g[n]; }
        }
    }
}

extern __shared__ __attribute__((aligned(16))) unsigned char smem[];
constexpr int LDS_BAR_OFF = 131072;

DEVI unsigned char* ows(unsigned char* w) { asm volatile("" : "+s"(w)); return w; }
#define WSP(T, off) ((T*)(w + (off)))

__global__ void __launch_bounds__(NTHR, 2) mega(Params p) {
    if (threadIdx.x == 0) *(uint4*)(smem + LDS_BAR_OFF) = make_uint4(0u, 0u, 0u, 0u);
    __syncthreads();
    XcdBarrier bar = xcd_barrier_post((unsigned*)(p.ws + OFF_CTL), (volatile LAS unsigned*)(smem + LDS_BAR_OFF));
    unsigned char* lds = smem;
    const int nw = gridDim.x * NWAVE;

    {
        unsigned char* w = ows(p.ws);
        ph_tables(p.in[11], WSP(float, OFF_BIAS), WSP(float, OFF_COS), WSP(float, OFF_SIN));
        int base = 0; const int total = 2 * (64 * 16) + 2 * (16 * 16);
        cvt_transpose<true>(p.in[1], INC, p.in[3], WSP(h16, OFF_WINT), MYC, DM, lds, blockIdx.x, total, base);
        cvt_transpose<true>(p.in[1] + (size_t)DM * INC, INC, p.in[3] + DM, WSP(h16, OFF_WINT) + (size_t)MYC * DM, MYC, DM, lds, blockIdx.x, total, base);
        cvt_transpose<false>(p.in[2], DM, nullptr, WSP(h16, OFF_WOUTT), DM, DM, lds, blockIdx.x, total, base);
        cvt_transpose<false>(p.in[2] + (size_t)DM * DM, DM, nullptr, WSP(h16, OFF_WOUTT) + (size_t)DM * DM, DM, DM, lds, blockIdx.x, total, base);
        ph_rowstat_cvt(p.in[0], WSP(float, OFF_RSTD), WSP(h16, OFF_H16));
    }
    xcd_barrier(bar);
    for (int layer = 0; layer < 2; ++layer) {
        const float lambda_init = layer == 0 ? 0.2f : 0.35550906759f;
        {
            unsigned char* w = ows(p.ws);
            pg8::Gemm g{WSP(const pg8::bf16_t, OFF_H16), WSP(const pg8::bf16_t, OFF_WINT) + (size_t)layer * MYC * DM, NT, MYC, DM};
            int bid_ = (int)blockIdx.x; asm volatile("" : "+s"(bid_));
            pg8::StaticOrder S; S.init(NT, MYC, (int)gridDim.x, bid_);
            EpiRoute E{w, WSP(float, OFF_RSTD)};
            pg8::gemm_phase<EpiRoute, pg8::StaticOrder, true, true>((PG8_LAS unsigned char*)lds, g, S, E);
        }
        xcd_barrier(bar);
        {
            unsigned char* w = ows(p.ws);
            ph_mla_naive(WSP(h16, OFF_CA), p.in[5] + layer * 192, p.in[6] + layer * 128, p.in[7] + (size_t)layer * 192 * 384, p.in[8] + (size_t)layer * 128 * 512,
                         WSP(float, OFF_COS), WSP(float, OFF_SIN), WSP(h16, OFF_QA), WSP(h16, OFF_KA), WSP(h16, OFF_KAR), WSP(h16, OFF_VAT), lds);
        }
        {
            unsigned char* w = ows(p.ws);
            ph_topk(WSP(h16, OFF_IDX), WSP(unsigned, OFF_MASK), lds);
        }
        {
            unsigned char* w = ows(p.ws);
            ph_vtrans(WSP(h16, OFF_VTMP), WSP(h16, OFF_VT), lds);
        }
        xcd_barrier(bar);
        {
            unsigned char* w = ows(p.ws);
            constexpr size_t VSZ = (size_t)32 * 64 * SEQ;
            p2_setup(WSP(float, OFF_BIAS), p.in[9] + layer * 128, lambda_init, lds);
            unsigned* ctr = WSP(unsigned, OFF_CTL) + 3600 + 16 * layer;
            for (;;) { const int e = wq_next(ctr); if (e >= 8192) break;
                const int lvl = 63 - (e >> 7), ty = (e >> 5) & 3, bh = e & 31;
                if (ty == 0) flashA_item(bh >> 2, bh & 3, lvl, WSP(h16, OFF_QA), WSP(h16, OFF_KA), WSP(h16, OFF_KAR), WSP(h16, OFF_VAT), WSP(h16, OFF_GATE), WSP(h16, OFF_MIX));
                else if (ty == 1) flashCD_item<2, false>(bh >> 2, bh & 3, lvl, 8 + (bh & 3), WSP(h16, OFF_QD), WSP(h16, OFF_KD), WSP(h16, OFF_VT) + 4 * VSZ, nullptr, WSP(float, OFF_BIAS), lds,
                                                         p.in[10] + layer * 64, lambda_init, WSP(h16, OFF_GATE), WSP(h16, OFF_MIX), 768);
                else if (ty == 2) flashCD_item<1, true>(bh >> 2, bh & 3, lvl, 4 + (bh & 3), WSP(h16, OFF_QC), WSP(h16, OFF_KC), WSP(h16, OFF_VT) + 3 * VSZ, WSP(unsigned, OFF_MASK), WSP(float, OFF_BIAS), lds,
                                                        nullptr, 0.f, WSP(h16, OFF_GATE), WSP(h16, OFF_MIX), 512);
                else flashB_item(bh >> 2, bh & 3, lvl & 15, lvl >> 4, WSP(h16, OFF_QB), WSP(h16, OFF_KB), WSP(h16, OFF_VT), lds, WSP(h16, OFF_GATE), WSP(h16, OFF_MIX));
            }
        }
        xcd_barrier(bar);
        {
            unsigned char* w = ows(p.ws);
            ph_out_naive(WSP(h16, OFF_MIX), p.in[2] + (size_t)layer * DM * DM, p.in[4] + layer * DM, layer == 0 ? p.in[0] : (const float*)p.out, p.out, lds);
        }
        xcd_barrier(bar);
        if (layer == 0) { unsigned char* w = ows(p.ws); ph_rowstat_cvt(p.out, WSP(float, OFF_RSTD), WSP(h16, OFF_H16)); xcd_barrier(bar); }
    }
}

extern "C" void kernel_launch(void* const* d_in, const int* in_sizes, int n_in, void* d_out, int out_size, void* d_ws, size_t ws_size, hipStream_t stream) {
    static int grid = 0;
    if (grid == 0) {
        int dev = 0, cus = 0, per_cu = 0;
        (void)hipGetDevice(&dev);
        (void)hipDeviceGetAttribute(&cus, hipDeviceAttributeMultiprocessorCount, dev);
        (void)hipFuncSetAttribute((const void*)mega, hipFuncAttributeMaxDynamicSharedMemorySize, LDS_BYTES);
        (void)hipOccupancyMaxActiveBlocksPerMultiprocessor(&per_cu, (const void*)mega, NTHR, LDS_BYTES);
        (void)hipGetLastError();
        grid = cus > 0 ? cus : 256;
    }
    (void)hipMemsetAsync((char*)d_ws + OFF_CTL, 0, 16384, stream);
    Params p{};
    for (int i = 0; i < 12; ++i) p.in[i] = (const float*)d_in[i];
    p.out = (float*)d_out; p.ws = (unsigned char*)d_ws;
    hipLaunchKernelGGL(mega, dim3(grid), dim3(NTHR), LDS_BYTES, stream, p);
}
```

```cpp
#include <hip/hip_runtime.h>
#include <stdint.h>
#include <math.h>

typedef _Float16 h16;
#define DEVI __device__ __forceinline__
DEVI int ogw();
DEVI int otid() { int t = threadIdx.x; asm volatile("" : "+v"(t)); return t; }

constexpr int NB = 8, SEQ = 2048, DM = 1024, NT = NB * SEQ, INC = 3976, MYC = 4096;
constexpr float LOG2E = 1.4426950408889634f;
constexpr float EPS = 1e-6f;

DEVI int ogw() { return blockIdx.x * 8 + (otid() >> 6); }
__host__ __device__ constexpr int ref_col(int my) {
    if (my < 352) return my;
    if (my < 384) return -1;
    if (my < 640) return 352 + (my - 384);
    if (my < 896) return 1376 + (my - 640);
    if (my < 1152) return 2696 + (my - 896);
    if (my < 1408) return 3720 + (my - 1152);
    if (my < 1664) return 608 + (my - 1408);
    if (my < 1920) return 864 + (my - 1664);
    if (my < 2176) return 1632 + (my - 1920);
    if (my < 2432) return 1888 + (my - 2176);
    if (my < 2688) return 2952 + (my - 2432);
    if (my < 2944) return 3208 + (my - 2688);
    if (my < 3200) return 1120 + (my - 2944);
    if (my < 3456) return 2144 + (my - 3200);
    if (my < 3712) return 3464 + (my - 3456);
    if (my < 3968) return 2400 + (my - 3712);
    if (my < 4000) return 2656 + (my - 3968);
    if (my < 4008) return 2688 + (my - 4000);
    return -1;
}

constexpr size_t MiB = 1024 * 1024;
constexpr size_t OFF_CTL = 0;
constexpr size_t OFF_RSTD = 64 * 1024;
constexpr size_t OFF_BIAS = 128 * 1024;
constexpr size_t OFF_COS = 256 * 1024;
constexpr size_t OFF_SIN = 384 * 1024;
constexpr size_t OFF_CA = 1 * MiB;
constexpr size_t OFF_GATE = OFF_CA + 12 * MiB;
constexpr size_t OFF_QB = OFF_GATE + 32 * MiB;
constexpr size_t OFF_KB = OFF_QB + 8 * MiB;
constexpr size_t OFF_QC = OFF_KB + 8 * MiB;
constexpr size_t OFF_KC = OFF_QC + 8 * MiB;
constexpr size_t OFF_QD = OFF_KC + 8 * MiB;
constexpr size_t OFF_KD = OFF_QD + 8 * MiB;
constexpr size_t OFF_IDX = OFF_KD + 8 * MiB;
constexpr size_t OFF_MIX = OFF_IDX + 10 * MiB;
constexpr size_t OFF_VTMP = OFF_MIX + 32 * MiB;
constexpr size_t OFF_MASK = OFF_VTMP + 24 * MiB;
constexpr size_t OFF_H16 = OFF_MASK + 4 * MiB;
constexpr size_t OFF_QA = OFF_H16;
constexpr size_t OFF_KA = OFF_QA + 12 * MiB;
constexpr size_t OFF_KAR = OFF_KA + 8 * MiB;
constexpr size_t OFF_VAT = OFF_KAR + 1 * MiB;
constexpr size_t OFF_WINT = OFF_H16 + 32 * MiB;
constexpr size_t OFF_WOUTT = OFF_WINT + 16 * MiB;
constexpr size_t OFF_WUQT = OFF_WOUTT + 4 * MiB;
constexpr size_t OFF_WUKVT = OFF_WUQT + 512 * 1024;
constexpr size_t OFF_VT = OFF_WUKVT + 512 * 1024;
constexpr size_t OFF_END = OFF_VT + 40 * MiB;
static_assert(OFF_END <= 256 * MiB, "ws map");

struct Route { int buf; int dcol; int pitch; float scale; int silu; };
__host__ __device__ inline Route route(int my) {
    Route r{-1, 0, 0, 1.f, 0};
    if (my < 384) { r.buf = 0; r.dcol = my; r.pitch = 384; }
    else if (my < 1408) { r.buf = 1; r.dcol = my - 384; r.pitch = 1024; r.silu = 1; }
    else if (my < 1664) { r.buf = 2; r.dcol = my - 1408; r.pitch = 256; r.scale = 0.125f * LOG2E; }
    else if (my < 1920) { r.buf = 3; r.dcol = my - 1664; r.pitch = 256; }
    else if (my < 2176) { r.buf = 4; r.dcol = my - 1920; r.pitch = 256; r.scale = 0.125f * LOG2E; }
    else if (my < 2432) { r.buf = 5; r.dcol = my - 2176; r.pitch = 256; }
    else if (my < 2688) { r.buf = 6; r.dcol = my - 2432; r.pitch = 256; r.scale = 0.17677669529663687f * LOG2E; }
    else if (my < 2944) { r.buf = 7; r.dcol = my - 2688; r.pitch = 256; }
    else if (my < 3712) { r.buf = 8; r.dcol = my - 2944; r.pitch = 768; }
    else if (my < 4032) { r.buf = 9; r.dcol = my - 3712; r.pitch = 320; r.scale = (my < 3968) ? 0.17677669529663687f : 1.f; }
    return r;
}
DEVI size_t buf_off(int buf) {
    switch (buf) {
        case 0: return OFF_CA; case 1: return OFF_GATE; case 2: return OFF_QB; case 3: return OFF_KB; case 4: return OFF_QC;
        case 5: return OFF_KC; case 6: return OFF_QD; case 7: return OFF_KD; case 8: return OFF_VTMP; default: return OFF_IDX;
    }
}

__device__ __constant__ int kBucketStart[16] = {16, 22, 30, 40, 54, 73, 99, 134, 182, 246, 332, 450, 609, 825, 1117, 1513};
DEVI int t5_bucket(int n) {
    if (n < 16) return n;
    int b = 16;
#pragma unroll
    for (int j = 1; j < 16; ++j) b += (n >= kBucketStart[j]) ? 1 : 0;
    return b;
}


#define XB_TMO      128
#define XB_XCNT(j)  (256  + 64 * (j))
#define XB_XSUB(j)  (1280 + 64 * (j))
#define XB_XGEN(j)  (2304 + 64 * (j))
#define XB_TOP      3328
#define XB_TOPGEN   3392
#define XCD_BAR_WORDS 3456
#define XB_SPIN_CAP (1u << 18)
#define LAS __attribute__((address_space(3)))
__device__ __forceinline__ unsigned xb_ld(unsigned* p)              { return __hip_atomic_load(p, __ATOMIC_RELAXED, __HIP_MEMORY_SCOPE_AGENT); }
__device__ __forceinline__ unsigned xb_add(unsigned* p, unsigned v) { return __hip_atomic_fetch_add(p, v, __ATOMIC_RELAXED, __HIP_MEMORY_SCOPE_AGENT); }
__device__ __forceinline__ unsigned xb_xcc_id() { return (unsigned)__builtin_amdgcn_s_getreg((3 << 11) | 20) & 0xFu; }
#define XB_SPIN(cond, bar) do { unsigned _sp = 0; while (cond) { __builtin_amdgcn_s_sleep(1); \
    if ((++_sp & 255u) == 0u) { if (xb_ld(&(bar)[XB_TMO])) break; if (_sp > XB_SPIN_CAP) { atomicAdd(&(bar)[XB_TMO], 1u); break; } } } } while (0)
struct XcdBarrier { unsigned* bar; unsigned x; volatile LAS unsigned* st; };
__device__ __forceinline__ XcdBarrier xcd_barrier_post(unsigned* bar, volatile LAS unsigned* st) {
    XcdBarrier b; b.bar = bar; b.x = xb_xcc_id(); b.st = st;
    if (threadIdx.x == 0) (void)xb_add(&bar[XB_XCNT(b.x)], 1u);
    return b;
}
__device__ __forceinline__ void xcd_barrier_complete(unsigned* bar, unsigned x, unsigned& nloc, unsigned& nx) {
    const unsigned G = gridDim.x * gridDim.y * gridDim.z;
    unsigned sum, cnt, mine, sp = 0u;
    for (;;) {
        sum = 0u; cnt = 0u; mine = 0u;
#pragma unroll
        for (unsigned j = 0; j < 16; ++j) { const unsigned c = xb_ld(&bar[XB_XCNT(j)]); sum += c; cnt += (c > 0u) ? 1u : 0u; mine = (j == x) ? c : mine; }
        if (sum == G) break;
        __builtin_amdgcn_s_sleep(1);
        if ((++sp & 255u) == 0u) { if (xb_ld(&bar[XB_TMO])) break; if (sp > XB_SPIN_CAP) { atomicAdd(&bar[XB_TMO], 1u); break; } }
    }
    nloc = mine > 0u ? mine : 1u; nx = cnt > 0u ? cnt : 1u;
}
__device__ __forceinline__ void xcd_barrier(const XcdBarrier& b) {
    asm volatile("s_waitcnt vmcnt(0)" ::: "memory");
    __syncthreads();
    if (otid() == 0) {
        unsigned* bar = b.bar; unsigned bx = b.x; asm volatile("" : "+s"(bx));
        __builtin_amdgcn_s_waitcnt(0);
        unsigned nloc = b.st[0], nx = b.st[1];
        if (nloc == 0u) { xcd_barrier_complete(bar, bx, nloc, nx); b.st[0] = nloc; b.st[1] = nx; }
        const unsigned old = xb_add(&bar[XB_XSUB(bx)], 1u);
        const unsigned gen = old / nloc;
        if (old + 1u == (gen + 1u) * nloc) {
            __builtin_amdgcn_fence(__ATOMIC_RELEASE, "agent");
            asm volatile("s_waitcnt vmcnt(0)" ::: "memory");
            const unsigned og = xb_add(&bar[XB_TOP], 1u);
            const unsigned tg = og / nx;
            if (og + 1u == (tg + 1u) * nx) xb_add(&bar[XB_TOPGEN], 1u);
            else XB_SPIN(xb_ld(&bar[XB_TOPGEN]) == tg, bar);
            __builtin_amdgcn_fence(__ATOMIC_ACQUIRE, "agent");
            xb_add(&bar[XB_XGEN(bx)], 1u);
            asm volatile("s_waitcnt vmcnt(0)" ::: "memory");
        } else {
            XB_SPIN(xb_ld(&bar[XB_XGEN(bx)]) == gen, bar);
            __builtin_amdgcn_fence(__ATOMIC_ACQUIRE, "agent");
            asm volatile("s_waitcnt vmcnt(0)" ::: "memory");
        }
    }
    __syncthreads();
}

namespace pg8 {
#define PG8_LAS __attribute__((address_space(3)))
typedef unsigned short bf16_t;
typedef _Float16 f16x8 __attribute__((ext_vector_type(8)));
typedef float f32x4 __attribute__((ext_vector_type(4)));
typedef unsigned u32x4 __attribute__((ext_vector_type(4)));
constexpr int BM = 256, BK = 64, HALF = 128, HTB = HALF * BK * 2  , STAGE_BYTES = 8 * HTB, NXCD = 8, WGM = 8;

__host__ __device__ __forceinline__ int lds_byte(int r, int c) { const int st = (r >> 4) * 2 + (c >> 5), rr = r & 15, cc = c & 31, ob = rr * 64 + cc * 2; return st * 1024 + (ob ^ (((ob >> 9) & 1) << 5)); }
__host__ __device__ __forceinline__ void stage_rc(int b, int& R, int& C) { const int st = b / 1024, sb = b % 1024, swz = sb ^ (((sb >> 9) & 1) << 5); R = (st >> 1) * 16 + swz / 64; C = (st & 1) * 32 + (swz % 64) / 2; }
__host__ __device__ __forceinline__ int perm32(int rho) { const int n = rho >> 4, i = rho & 15; return 8 * (i >> 2) + 4 * n + (i & 3); }

struct Unit { int pm, pn; };
struct Gemm { const bf16_t* A; const bf16_t* Bt; int M, N, K; };

struct StaticOrder {
    int nM, nN, nwg, G, c;
    __host__ __device__ void init(int M, int N, int G_, int c_) { nM = M / BM; nN = N / BM; nwg = nM * nN; G = G_; c = c_; }
    __host__ __device__ bool next(int i, Unit& u) const {
        const long L = (long)i * G + c; if (L >= nwg) return false;
        int wgid = (int)L; { const int q = nwg / NXCD, r = nwg % NXCD, xcd = wgid % NXCD, off = wgid / NXCD; wgid = (xcd < r ? xcd * (q + 1) : r * (q + 1) + (xcd - r) * q) + off; }
        const int nig = WGM * nN, gid = wgid / nig, fm = gid * WGM, gsz = (nM - fm) < WGM ? (nM - fm) : WGM;
        u.pm = fm + ((wgid % nig) % gsz); u.pn = (wgid % nig) / gsz; return true;
    }
    __device__ __forceinline__ void a_ready(const Unit&) const {}
    __device__ __forceinline__ void done(const Unit&) const {}
};

template <class Epi, class Sched, bool ALIGN_EPI = false, bool SP2 = false>
__device__ __forceinline__ void gemm_phase(PG8_LAS unsigned char* lds, const Gemm g, const Sched& S, const Epi& E) {
    const int tid = otid(), wid = __builtin_amdgcn_readfirstlane(tid >> 6), lane = tid & 63, wr = wid >> 2, wc = wid & 3, fr = lane & 15, fq = lane >> 4;
    const int K = g.K, nt = K / BK;
    unsigned voffA[2], voffB[2];
#pragma unroll
    for (int i = 0; i < 2; ++i) { int R, C; stage_rc(tid * 16 + i * 8192, R, C); const int Rb = Epi::PERM ? ((R & ~31) + perm32(R & 31)) : R;
        voffA[i] = (unsigned)(R * K + C) * 2u; voffB[i] = (unsigned)(Rb * K + C) * 2u; }
    const size_t kstep = (size_t)(BK * 2);
    const size_t hstep = (size_t)HALF * K * 2;
    const size_t tstep = 2 * hstep;
    const unsigned ldsw = (unsigned)wid * 1024u;
    const int aoff = lds_byte(wr * 64 + fr, fq * 8), boff = lds_byte(wc * 32 + fr, fq * 8);
#define PG8_SA(b, h) (((b) * 2 + (h)) * HTB)
#define PG8_SB(b, h) ((4 + (b) * 2 + (h)) * HTB)
#define PG8_STAGE(bufoff, gbase, voff) do { _Pragma("unroll") for (int _i = 0; _i < 2; ++_i) \
        __builtin_amdgcn_global_load_lds((const unsigned*)((const char*)(gbase) + (voff)[_i]), (PG8_LAS unsigned*)(lds + (bufoff) + ldsw + _i * 8192), 16, 0, 0); } while (0)
#define PG8_LDA(dst, b, h) do { _Pragma("unroll") for (int m = 0; m < 4; ++m) _Pragma("unroll") for (int k = 0; k < 2; ++k) dst[m][k] = *(const PG8_LAS f16x8*)(lds + PG8_SA(b, h) + aoff + m * 2048 + k * 1024); } while (0)
#define PG8_LDB(dst, b, h) do { _Pragma("unroll") for (int n = 0; n < 2; ++n) _Pragma("unroll") for (int k = 0; k < 2; ++k) dst[n][k] = *(const PG8_LAS f16x8*)(lds + PG8_SB(b, h) + boff + n * 2048 + k * 1024); } while (0)
#define PG8_MMA(ai, bj, At, Bt) do { __builtin_amdgcn_s_setprio(1); _Pragma("unroll") for (int m = 0; m < 4; ++m) _Pragma("unroll") for (int n = 0; n < 2; ++n) _Pragma("unroll") for (int k = 0; k < 2; ++k) \
        acc[ai][bj][m][n] = __builtin_amdgcn_mfma_f32_16x16x32_f16(Bt[n][k], At[m][k], acc[ai][bj][m][n], 0, 0, 0); __builtin_amdgcn_s_setprio(0); } while (0)
#define PG8_WAIT_V(n) asm volatile("s_waitcnt vmcnt(" #n ")" ::: "memory")
#define PG8_WAIT_L(n) asm volatile("s_waitcnt lgkmcnt(" #n ")" ::: "memory")
#define PG8_BAR __builtin_amdgcn_s_barrier()
#define PG8_SCHED __builtin_amdgcn_sched_barrier(0)
    Unit cur, nxt; int ui = 0;
    if (!S.next(0, cur)) return;
    f32x4 acc[2][2][4][2];
#pragma unroll
    for (int a = 0; a < 2; ++a)
#pragma unroll
        for (int b = 0; b < 2; ++b)
#pragma unroll
            for (int m = 0; m < 4; ++m)
#pragma unroll
                for (int n = 0; n < 2; ++n) acc[a][b][m][n] = (f32x4){0.f, 0.f, 0.f, 0.f};
    f16x8 At[4][2], B0[2][2], B1[2][2];
    const char* cA = (const char*)g.A + (size_t)cur.pm * tstep; const char* cB = (const char*)g.Bt + (size_t)cur.pn * tstep;
    S.a_ready(cur);
    if constexpr (SP2) {
        PG8_STAGE(PG8_SB(0, 0), cB, voffB); PG8_STAGE(PG8_SB(0, 1), cB + hstep, voffB); PG8_STAGE(PG8_SA(0, 0), cA, voffA); PG8_STAGE(PG8_SA(0, 1), cA + hstep, voffA);
        if (wr == 1) PG8_BAR;
        PG8_WAIT_V(2); PG8_BAR;
        PG8_STAGE(PG8_SB(1, 0), cB + kstep, voffB); PG8_STAGE(PG8_SA(1, 0), cA + kstep, voffA); PG8_STAGE(PG8_SB(1, 1), cB + hstep + kstep, voffB);
        PG8_WAIT_V(6); PG8_BAR;
    } else {
        PG8_STAGE(PG8_SB(0, 0), cB, voffB); PG8_STAGE(PG8_SA(0, 0), cA, voffA); PG8_STAGE(PG8_SB(0, 1), cB + hstep, voffB); PG8_STAGE(PG8_SA(0, 1), cA + hstep, voffA);
        if (wr == 1) PG8_BAR;
        PG8_WAIT_V(4); PG8_BAR;
        PG8_STAGE(PG8_SB(1, 0), cB + kstep, voffB); PG8_STAGE(PG8_SA(1, 0), cA + kstep, voffA); PG8_STAGE(PG8_SB(1, 1), cB + hstep + kstep, voffB);
        PG8_WAIT_V(6); PG8_BAR;
    }
    for (;;) {
        const bool has_next = S.next(ui + 1, nxt);
        const char* nA = has_next ? (const char*)g.A + (size_t)nxt.pm * tstep : cA; const char* nB = has_next ? (const char*)g.Bt + (size_t)nxt.pn * tstep : cB;
        for (int t = 0; t < nt; t += 2) {
            const bool last = (t == nt - 2);
            const char* a1 = cA + (size_t)(t + 1) * kstep;
            const char* a2 = last ? nA : cA + (size_t)(t + 2) * kstep; const char* b2 = last ? nB : cB + (size_t)(t + 2) * kstep;
            const char* a3 = a2 + kstep; const char* b3 = b2 + kstep;
            if (last && has_next) S.a_ready(nxt);
            if constexpr (SP2) {
            PG8_LDB(B0, 0, 0); PG8_LDB(B1, 0, 1); PG8_SCHED; PG8_LDA(At, 0, 0); PG8_STAGE(PG8_SA(1, 1), a1 + hstep, voffA);
            PG8_WAIT_V(8); PG8_WAIT_L(0); PG8_BAR; PG8_MMA(0, 0, At, B0); PG8_MMA(0, 1, At, B1); PG8_BAR; PG8_SCHED;
            PG8_LDA(At, 0, 1); PG8_STAGE(PG8_SB(0, 0), b2, voffB); PG8_STAGE(PG8_SB(0, 1), b2 + hstep, voffB); PG8_STAGE(PG8_SA(0, 0), a2, voffA);
            PG8_WAIT_V(8); PG8_WAIT_L(0); PG8_BAR; PG8_MMA(1, 0, At, B0); PG8_MMA(1, 1, At, B1); PG8_BAR; PG8_SCHED;
            PG8_LDB(B0, 1, 0); PG8_LDB(B1, 1, 1); PG8_SCHED; PG8_LDA(At, 1, 0); PG8_STAGE(PG8_SA(0, 1), a2 + hstep, voffA);
            PG8_WAIT_V(8); PG8_WAIT_L(0); PG8_BAR; PG8_MMA(0, 0, At, B0); PG8_MMA(0, 1, At, B1); PG8_BAR; PG8_SCHED;
            PG8_LDA(At, 1, 1); PG8_STAGE(PG8_SB(1, 0), b3, voffB); PG8_STAGE(PG8_SB(1, 1), b3 + hstep, voffB); PG8_STAGE(PG8_SA(1, 0), a3, voffA);
            PG8_WAIT_V(8); PG8_WAIT_L(0); PG8_BAR; PG8_MMA(1, 0, At, B0); PG8_MMA(1, 1, At, B1); PG8_BAR; PG8_SCHED;
            } else {
            PG8_LDB(B0, 0, 0); PG8_SCHED; PG8_LDA(At, 0, 0); PG8_STAGE(PG8_SA(1, 1), a1 + hstep, voffA);
            PG8_WAIT_L(8); PG8_BAR; PG8_WAIT_L(0); PG8_MMA(0, 0, At, B0); PG8_BAR; PG8_SCHED;
            PG8_LDB(B1, 0, 1); PG8_STAGE(PG8_SB(0, 0), b2, voffB);
            PG8_BAR; PG8_WAIT_L(0); PG8_MMA(0, 1, At, B1); PG8_BAR;
            PG8_LDA(At, 0, 1); PG8_STAGE(PG8_SA(0, 0), a2, voffA);
            PG8_BAR; PG8_WAIT_L(0); PG8_MMA(1, 0, At, B0); PG8_BAR; PG8_SCHED;
            PG8_STAGE(PG8_SB(0, 1), b2 + hstep, voffB);
            PG8_WAIT_V(6); PG8_BAR; PG8_MMA(1, 1, At, B1); PG8_BAR;
            PG8_LDB(B0, 1, 0); PG8_SCHED; PG8_LDA(At, 1, 0); PG8_STAGE(PG8_SA(0, 1), a2 + hstep, voffA);
            PG8_WAIT_L(8); PG8_BAR; PG8_WAIT_L(0); PG8_MMA(0, 0, At, B0); PG8_BAR; PG8_SCHED;
            PG8_LDB(B1, 1, 1); PG8_STAGE(PG8_SB(1, 0), b3, voffB);
            PG8_BAR; PG8_WAIT_L(0); PG8_MMA(0, 1, At, B1); PG8_BAR;
            PG8_LDA(At, 1, 1); PG8_STAGE(PG8_SA(1, 0), a3, voffA);
            PG8_BAR; PG8_WAIT_L(0); PG8_MMA(1, 0, At, B0); PG8_BAR; PG8_SCHED;
            PG8_STAGE(PG8_SB(1, 1), b3 + hstep, voffB);
            PG8_WAIT_V(6); PG8_BAR; PG8_MMA(1, 1, At, B1); PG8_BAR;
            }
        }
        if constexpr (ALIGN_EPI) { if (wr == 0) PG8_BAR; }
        if constexpr (!Epi::AFTER_DRAIN) { E(acc, cur, wr, wc, fr, fq); S.done(cur); }
        if (!has_next) break;
#pragma unroll
        for (int a = 0; a < 2; ++a)
#pragma unroll
            for (int b = 0; b < 2; ++b)
#pragma unroll
                for (int m = 0; m < 4; ++m)
#pragma unroll
                    for (int n = 0; n < 2; ++n) acc[a][b][m][n] = (f32x4){0.f, 0.f, 0.f, 0.f};
        cur = nxt; cA = nA; cB = nB; ++ui;
        if constexpr (ALIGN_EPI) { if (wr == 1) PG8_BAR; }
    }
    PG8_WAIT_V(0);
    if constexpr (!ALIGN_EPI) { if (wr == 0) PG8_BAR; }
    PG8_BAR;
    if constexpr (Epi::AFTER_DRAIN) { E.fused(acc, cur, wr, wc, fr, fq, lds, wid, lane); S.done(cur); }
#undef PG8_SA
#undef PG8_SB
#undef PG8_STAGE
#undef PG8_LDA
#undef PG8_LDB
#undef PG8_MMA
#undef PG8_WAIT_V
#undef PG8_WAIT_L
#undef PG8_BAR
#undef PG8_SCHED
}
}


typedef float f32x4_t __attribute__((ext_vector_type(4)));
typedef _Float16 h16x8 __attribute__((ext_vector_type(8)));
DEVI float silu_f(float v) { return v / (1.f + __expf(-v)); }
struct EpiRoute {
    static constexpr bool PERM = true, AFTER_DRAIN = false;
    unsigned char* ws; const float* rstd;
    DEVI void operator()(const pg8::f32x4 (&acc)[2][2][4][2], const pg8::Unit& u, int wr, int wc, int fr, int fq) const {
        const int row0 = u.pm * 256 + wr * 64 + fr;
        float rs[2][4];
#pragma unroll
        for (int ai = 0; ai < 2; ++ai)
#pragma unroll
            for (int m = 0; m < 4; ++m) rs[ai][m] = rstd[row0 + ai * 128 + m * 16];
#pragma unroll
        for (int bj = 0; bj < 2; ++bj) {
            const int cg = u.pn * 256 + bj * 128 + wc * 32;
            const Route r = route(cg);
            if (r.buf < 0) continue;
            h16* base = (h16*)(ws + buf_off(r.buf)) + r.dcol + 8 * fq;
#pragma unroll
            for (int ai = 0; ai < 2; ++ai)
#pragma unroll
                for (int m = 0; m < 4; ++m) {
                    const int row = row0 + ai * 128 + m * 16; const float sc = rs[ai][m] * r.scale;
                    float v[8];
#pragma unroll
                    for (int j = 0; j < 4; ++j) { v[j] = acc[ai][bj][m][0][j] * sc; v[4 + j] = acc[ai][bj][m][1][j] * sc; }
                    if (r.silu) {
#pragma unroll
                        for (int j = 0; j < 8; ++j) v[j] = silu_f(v[j]);
                    }
                    h16x8 o;
#pragma unroll
                    for (int j = 0; j < 8; ++j) o[j] = (h16)v[j];
                    *(h16x8*)(base + (size_t)row * r.pitch) = o;
                }
        }
    }
};

constexpr int NTHR = 512, NWAVE = 8;

template <bool REF>
DEVI void cvt_transpose(const float* __restrict__ src, int src_pitch, const float* __restrict__ g, h16* dst, int N, int K, unsigned char* lds, int item0, int nitems_total, int& item_base) {
    const int tid = otid();
    float (*tile)[65] = (float (*)[65])lds;
    const int ntn = N / 64, ntk = K / 64, n_it = ntn * ntk;
    for (int it = item0; it < nitems_total; it += gridDim.x) {
        const int li = it - item_base; if (li < 0 || li >= n_it) continue;
        const int n0 = (li % ntn) * 64, k0 = (li / ntn) * 64;
        __syncthreads();
        const int c = tid & 63; int rc = n0 + c; if (REF) rc = ref_col(rc);
#pragma unroll
        for (int ps = 0; ps < 8; ++ps) { const int k = ps * 8 + (tid >> 6);
            tile[k][c] = rc >= 0 ? src[(size_t)(k0 + k) * src_pitch + rc] * (g ? g[k0 + k] : 1.f) : 0.f; }
        __syncthreads();
        const int cc = tid >> 3, kq = (tid & 7) * 8;
        h16x8 o;
#pragma unroll
        for (int j = 0; j < 8; ++j) o[j] = (h16)tile[kq + j][cc];
        *(h16x8*)(dst + (size_t)(n0 + cc) * K + k0 + kq) = o;
    }
    item_base += n_it;
}

DEVI void ph_rowstat_cvt(const float* h, float* rstd, h16* h16o) {
    const int t_ = otid(); const int lane = t_ & 63, gw = blockIdx.x * NWAVE + (t_ >> 6), nw = gridDim.x * NWAVE;
    for (int row = gw; row < NT; row += nw) {
        const float4* p = (const float4*)(h + (size_t)row * DM);
        float s = 0.f;
#pragma unroll
        for (int i = 0; i < 4; ++i) { float4 v = p[lane + 64 * i]; s += v.x * v.x + v.y * v.y + v.z * v.z + v.w * v.w;
            typedef _Float16 h16x4 __attribute__((ext_vector_type(4)));
            h16x4 o; o[0] = (h16)v.x; o[1] = (h16)v.y; o[2] = (h16)v.z; o[3] = (h16)v.w;
            *(h16x4*)(h16o + (size_t)row * DM + (lane + 64 * i) * 4) = o; }
        for (int o = 32; o; o >>= 1) s += __shfl_xor(s, o);
        if (lane == 0) rstd[row] = rsqrtf(s / DM + EPS);
    }
}

typedef float f32x16 __attribute__((ext_vector_type(16)));
typedef _Float16 h16x4 __attribute__((ext_vector_type(4)));
DEVI f32x16 mfma32(h16x8 a, h16x8 b, f32x16 c) { return __builtin_amdgcn_mfma_f32_32x32x16_f16(a, b, c, 0, 0, 0); }
#define CROW(r) (((r) & 3) + 8 * ((r) >> 2))
DEVI float xh_max(float x) { auto r = __builtin_amdgcn_permlane32_swap(__float_as_uint(x), __float_as_uint(x), false, false); return fmaxf(__uint_as_float(r[0]), __uint_as_float(r[1])); }
DEVI float xh_sum(float x) { auto r = __builtin_amdgcn_permlane32_swap(__float_as_uint(x), __float_as_uint(x), false, false); return __uint_as_float(r[0]) + __uint_as_float(r[1]); }
DEVI unsigned pk2h(float a, float b) { auto v = __builtin_amdgcn_cvt_pkrtz(a, b); return __builtin_bit_cast(unsigned, v); }
DEVI h16x8 pack8(const f32x16& p, int s) {
    typedef unsigned u32x4_t __attribute__((ext_vector_type(4)));
    u32x4_t w;
    w[0] = pk2h(p[8 * s + 0], p[8 * s + 1]); w[1] = pk2h(p[8 * s + 2], p[8 * s + 3]); w[2] = pk2h(p[8 * s + 4], p[8 * s + 5]); w[3] = pk2h(p[8 * s + 6], p[8 * s + 7]);
    return __builtin_bit_cast(h16x8, w);
}
DEVI h16x8 ldv8(const h16* p) {
    h16x4 a = *(const h16x4*)p, b = *(const h16x4*)(p + 8);
    h16x8 r; r[0] = a[0]; r[1] = a[1]; r[2] = a[2]; r[3] = a[3]; r[4] = b[0]; r[5] = b[1]; r[6] = b[2]; r[7] = b[3]; return r;
}
DEVI void softmax_tile(f32x16& S, float& m, float& l, f32x16& O0, f32x16& O1) {
    float mx = S[0];
#pragma unroll
    for (int r = 1; r < 16; ++r) mx = fmaxf(mx, S[r]);
    mx = xh_max(mx);
    if (__any(mx > m)) {
        const float mn = fmaxf(m, mx), al = __builtin_amdgcn_exp2f(m - mn);
        l *= al; O0 *= al; O1 *= al; m = mn;
    }
    float ls = 0.f;
#pragma unroll
    for (int r = 0; r < 16; ++r) { S[r] = __builtin_amdgcn_exp2f(S[r] - m); ls += S[r]; }
    l += ls;
}
DEVI int wq_next(unsigned* ctr) {
    int e = 0;
    if ((otid() & 63) == 0) e = (int)__hip_atomic_fetch_add(ctr, 1u, __ATOMIC_RELAXED, __HIP_MEMORY_SCOPE_AGENT);
    return __builtin_amdgcn_readfirstlane(e);
}

DEVI void flashA_item(int b, int hh, int qt, const h16* qA, const h16* kA, const h16* kAr, const h16* vAT, const h16* gate, h16* mix) {
    const int lane = otid() & 63, q = lane & 31, h = lane >> 5;
    const size_t tokq = (size_t)b * SEQ + qt * 32 + q;
    h16x8 qf[6];
#pragma unroll
    for (int ks = 0; ks < 6; ++ks) qf[ks] = *(const h16x8*)(qA + tokq * 384 + hh * 96 + ks * 16 + 8 * h);
    f32x16 O0 = {}, O1 = {};
    float m = -1e30f, l = 0.f;
    const h16* vbase = vAT + ((size_t)(b * 4 + hh) * 64 + q) * SEQ + 4 * h;
    h16x8 kf[6];
    {
        const size_t tk = (size_t)b * SEQ + q;
#pragma unroll
        for (int ks = 0; ks < 4; ++ks) kf[ks] = *(const h16x8*)(kA + tk * 256 + hh * 64 + ks * 16 + 8 * h);
#pragma unroll
        for (int ks = 0; ks < 2; ++ks) kf[4 + ks] = *(const h16x8*)(kAr + tk * 32 + ks * 16 + 8 * h);
    }
    for (int j = 0; j <= qt; ++j) {
        const int s0 = j * 32;
        h16x8 vf[2][2];
#pragma unroll
        for (int db = 0; db < 2; ++db)
#pragma unroll
            for (int sk = 0; sk < 2; ++sk) vf[db][sk] = ldv8(vbase + (size_t)db * 32 * SEQ + s0 + 16 * sk);
        f32x16 S = {};
#pragma unroll
        for (int ks = 0; ks < 6; ++ks) S = mfma32(kf[ks], qf[ks], S);
        if (j < qt) {
            const size_t tk = (size_t)b * SEQ + s0 + 32 + q;
#pragma unroll
            for (int ks = 0; ks < 4; ++ks) kf[ks] = *(const h16x8*)(kA + tk * 256 + hh * 64 + ks * 16 + 8 * h);
#pragma unroll
            for (int ks = 0; ks < 2; ++ks) kf[4 + ks] = *(const h16x8*)(kAr + tk * 32 + ks * 16 + 8 * h);
        } else {
#pragma unroll
            for (int r = 0; r < 16; ++r) S[r] = (CROW(r) + 4 * h > q) ? -3e38f : S[r];
        }
        softmax_tile(S, m, l, O0, O1);
        const h16x8 p0 = pack8(S, 0), p1 = pack8(S, 1);
        O0 = mfma32(vf[0][0], p0, O0); O0 = mfma32(vf[0][1], p1, O0);
        O1 = mfma32(vf[1][0], p0, O1); O1 = mfma32(vf[1][1], p1, O1);
    }
    const float il = 1.f / xh_sum(l);
    const h16* gp = gate + tokq * 1024 + hh * 64 + 4 * h; h16* op = mix + tokq * 1024 + hh * 64 + 4 * h;
#pragma unroll
    for (int db = 0; db < 2; ++db)
#pragma unroll
        for (int g = 0; g < 4; ++g) {
            const h16x4 gv = *(const h16x4*)(gp + db * 32 + 8 * g); h16x4 o;
#pragma unroll
            for (int e = 0; e < 4; ++e) o[e] = (h16)((db ? O1[4 * g + e] : O0[4 * g + e]) * il * (float)gv[e]);
            *(h16x4*)(op + db * 32 + 8 * g) = o;
        }
}

constexpr int L_NEAR = 0, L_R3 = 12288, L_R2 = 15360, L_R1 = 21504, L_LAM = 39936, L_P2END = 40000;
DEVI void p2_setup(const float* biasTab, const float* lam_p, float lambda_init, unsigned char* lds) {
    const int tid = otid();
    float* nearR = (float*)(lds + L_NEAR);
    for (int i = tid; i < 12 * 256; i += NTHR) { const int hb = i >> 8, u = i & 255, tix = 223 - u; nearR[i] = tix < 0 ? -3e38f : biasTab[hb * 2048 + tix]; }
    float* R3 = (float*)(lds + L_R3); float* R2 = (float*)(lds + L_R2); float* R1 = (float*)(lds + L_R1);
    for (int i = tid; i < 4 * 192; i += NTHR) { const int hb = i / 192, kk = 159 - (i % 192); R3[i] = (kk < 0 || kk > 128) ? -3e38f : biasTab[hb * 2048 + kk * 16]; }
    for (int i = tid; i < 4 * 384; i += NTHR) { const int hb = i / 384, kk = 255 - (i % 384); R2[i] = (kk < 0 || kk > 128) ? -3e38f : biasTab[hb * 2048 + kk * 4]; }
    for (int i = tid; i < 4 * 1152; i += NTHR) { const int hb = i / 1152, kk = 639 - (i % 1152); R1[i] = (kk < 0 || kk > 128) ? -3e38f : biasTab[hb * 2048 + kk]; }
    if (tid == 0) { float a1 = 0.f, a2 = 0.f; for (int i = 0; i < 32; ++i) { a1 += lam_p[i] * lam_p[32 + i]; a2 += lam_p[64 + i] * lam_p[96 + i]; }
        *(float*)(lds + L_LAM) = expf(a1) - expf(a2) + lambda_init; }
    __syncthreads();
}

DEVI void ph_vtrans(const h16* vtmp, h16* VT, unsigned char* lds) {
    const int tid = otid();
    h16 (*tile)[72] = (h16 (*)[72])lds;
    constexpr size_t VSZ = (size_t)32 * 64 * SEQ;
    for (int it = blockIdx.x; it < 3 * 32 * 32; it += gridDim.x) {
        const int src = it / 1024, bh = (it >> 5) & 31, s0 = (it & 31) * 64, b = bh >> 2, hh = bh & 3;
        __syncthreads();
        { const int r = tid >> 3, c8 = tid & 7;
          *(h16x8*)&tile[r][c8 * 8] = *(const h16x8*)(vtmp + ((size_t)b * SEQ + s0 + r) * 768 + src * 256 + hh * 64 + c8 * 8); }
        __syncthreads();
        const int d = tid >> 3;
        h16* rowN = VT + (src == 0 ? 0 : (src == 1 ? 3 * VSZ : 4 * VSZ)) + ((size_t)bh * 64 + d) * SEQ;
        { const int t8 = (tid & 7) * 8; h16x8 o;
#pragma unroll
          for (int j = 0; j < 8; ++j) o[j] = tile[t8 + j][d];
          *(h16x8*)(rowN + s0 + t8) = o; }
        if (src == 0) {
            const int blk = s0 >> 8;
            { const int r4 = (tid & 7) >> 1, half = tid & 1, i0 = (s0 & 255) >> 2; h16x8 o;
#pragma unroll
              for (int j = 0; j < 8; ++j) o[j] = tile[4 * (half * 8 + j) + r4][d];
              *(h16x8*)(rowN + VSZ + blk * 256 + r4 * 64 + i0 + half * 8) = o; }
            { const int i0 = (s0 & 255) >> 4;
#pragma unroll
              for (int rr = 0; rr < 2; ++rr) { const int r16 = 2 * (tid & 7) + rr; h16x4 o;
#pragma unroll
                  for (int j = 0; j < 4; ++j) o[j] = tile[16 * j + r16][d];
                  *(h16x4*)(rowN + 2 * VSZ + blk * 256 + r16 * 16 + i0) = o; } }
        }
    }
}

template <int NMAP, bool MASK>
DEVI void flashCD_item(int b, int hh, int qt, int hb, const h16* Q, const h16* K, const h16* VT, const unsigned* mask, const float* biasTab, const unsigned char* lds,
                       const float* subln, float lambda_init, const h16* gate, h16* mix, int mixcol) {
    constexpr int NKS = 4 / NMAP;
    const int lane = otid() & 63, q = lane & 31, h = lane >> 5;
    const size_t tokq = (size_t)b * SEQ + qt * 32 + q;
    h16x8 qf[NMAP][NKS], kf[NMAP][NKS];
#pragma unroll
    for (int mp = 0; mp < NMAP; ++mp)
#pragma unroll
        for (int ks = 0; ks < NKS; ++ks) {
            qf[mp][ks] = *(const h16x8*)(Q + tokq * 256 + hh * 64 + (mp * NKS + ks) * 16 + 8 * h);
            kf[mp][ks] = *(const h16x8*)(K + ((size_t)b * SEQ + q) * 256 + hh * 64 + (mp * NKS + ks) * 16 + 8 * h);
        }
    f32x16 O[NMAP][2]; float m[NMAP], l[NMAP];
#pragma unroll
    for (int mp = 0; mp < NMAP; ++mp) { O[mp][0] = (f32x16){}; O[mp][1] = (f32x16){}; m[mp] = -1e30f; l[mp] = 0.f; }
    const h16* vbase = VT + ((size_t)(b * 4 + hh) * 64 + q) * SEQ + 4 * h;
    const float* nearR = (const float*)(lds + L_NEAR) + hb * 256;
    const float* bt = biasTab + hb * 2048;
    for (int j = 0; j <= qt; ++j) {
        const int s0 = j * 32;
        h16x8 vf[2][2];
#pragma unroll
        for (int db = 0; db < 2; ++db)
#pragma unroll
            for (int sk = 0; sk < 2; ++sk) vf[db][sk] = ldv8(vbase + (size_t)db * 32 * SEQ + s0 + 16 * sk);
        unsigned mw = 0xffffffffu;
        if (MASK) mw = mask[tokq * 64 + j] >> (4 * h);
        f32x16 S[NMAP];
#pragma unroll
        for (int mp = 0; mp < NMAP; ++mp) { S[mp] = (f32x16){};
#pragma unroll
            for (int ks = 0; ks < NKS; ++ks) S[mp] = mfma32(kf[mp][ks], qf[mp][ks], S[mp]); }
        if (j < qt) {
            const size_t tk = (size_t)b * SEQ + s0 + 32 + q;
#pragma unroll
            for (int mp = 0; mp < NMAP; ++mp)
#pragma unroll
                for (int ks = 0; ks < NKS; ++ks) kf[mp][ks] = *(const h16x8*)(K + tk * 256 + hh * 64 + (mp * NKS + ks) * 16 + 8 * h);
        }
        const int D0 = (qt - j) * 32;
        if (D0 < 192) {
            const float* tp = nearR + (223 - D0 - q + 4 * h);
#pragma unroll
            for (int r = 0; r < 16; ++r) { const float bv = tp[CROW(r)];
#pragma unroll
                for (int mp = 0; mp < NMAP; ++mp) S[mp][r] += bv; }
        } else {
            const float lo = bt[D0 - 31], hi = bt[D0 + 31];
            if (lo == hi) {
#pragma unroll
                for (int mp = 0; mp < NMAP; ++mp) S[mp] += lo;
            } else {
                int bnd = 0;
#pragma unroll
                for (int jj = 8; jj < 16; ++jj) bnd = (D0 + 31 >= kBucketStart[jj]) ? kBucketStart[jj] : bnd;
                const int x = D0 + q - 4 * h - bnd;
#pragma unroll
                for (int r = 0; r < 16; ++r) { const float bv = (x >= CROW(r)) ? hi : lo;
#pragma unroll
                    for (int mp = 0; mp < NMAP; ++mp) S[mp][r] += bv; }
            }
        }
        if (MASK) {
#pragma unroll
            for (int r = 0; r < 16; ++r) S[0][r] = ((mw >> CROW(r)) & 1u) ? S[0][r] : -3e38f;
        }
#pragma unroll
        for (int mp = 0; mp < NMAP; ++mp) {
            softmax_tile(S[mp], m[mp], l[mp], O[mp][0], O[mp][1]);
            const h16x8 p0 = pack8(S[mp], 0), p1 = pack8(S[mp], 1);
            O[mp][0] = mfma32(vf[0][0], p0, O[mp][0]); O[mp][0] = mfma32(vf[0][1], p1, O[mp][0]);
            O[mp][1] = mfma32(vf[1][0], p0, O[mp][1]); O[mp][1] = mfma32(vf[1][1], p1, O[mp][1]);
        }
    }
    f32x16 R0, R1;
    if (NMAP == 2) {
        const float lam = *(const float*)(lds + L_LAM);
        const float i0 = 1.f / xh_sum(l[0]), i1 = lam / xh_sum(l[NMAP - 1]);
        R0 = O[0][0] * i0 - O[NMAP - 1][0] * i1; R1 = O[0][1] * i0 - O[NMAP - 1][1] * i1;
        float ss = 0.f;
#pragma unroll
        for (int r = 0; r < 16; ++r) ss += R0[r] * R0[r] + R1[r] * R1[r];
        ss = xh_sum(ss);
        const float rs = rsqrtf(ss * (1.f / 64.f) + EPS) * (1.f - lambda_init);
        R0 *= rs; R1 *= rs;
    } else {
        const float il = 1.f / xh_sum(l[0]);
        R0 = O[0][0] * il; R1 = O[0][1] * il;
    }
    const h16* gp = gate + tokq * 1024 + mixcol + hh * 64 + 4 * h; h16* op = mix + tokq * 1024 + mixcol + hh * 64 + 4 * h;
#pragma unroll
    for (int db = 0; db < 2; ++db)
#pragma unroll
        for (int g = 0; g < 4; ++g) {
            const h16x4 gv = *(const h16x4*)(gp + db * 32 + 8 * g); h16x4 o;
#pragma unroll
            for (int e = 0; e < 4; ++e) { float v = (db ? R1[4 * g + e] : R0[4 * g + e]) * (float)gv[e];
                if (NMAP == 2) v *= subln[db * 32 + 8 * g + 4 * h + e];
                o[e] = (h16)v; }
            *(h16x4*)(op + db * 32 + 8 * g) = o;
        }
}

DEVI void flashB_tile(const h16x8 (&qf)[4], const h16* krow, const h16* vrow, int vstep, const float* tp, f32x16& O0, f32x16& O1, float& m, float& l, int h) {
    h16x8 vf[2][2];
#pragma unroll
    for (int db = 0; db < 2; ++db)
#pragma unroll
        for (int sk = 0; sk < 2; ++sk) vf[db][sk] = ldv8(vrow + (size_t)db * 32 * SEQ + vstep * sk);
    f32x16 S = {};
#pragma unroll
    for (int ks = 0; ks < 4; ++ks) S = mfma32(*(const h16x8*)(krow + ks * 16 + 8 * h), qf[ks], S);
#pragma unroll
    for (int r = 0; r < 16; ++r) S[r] += tp[CROW(r)];
    softmax_tile(S, m, l, O0, O1);
    const h16x8 p0 = pack8(S, 0), p1 = pack8(S, 1);
    O0 = mfma32(vf[0][0], p0, O0); O0 = mfma32(vf[0][1], p1, O0);
    O1 = mfma32(vf[1][0], p0, O1); O1 = mfma32(vf[1][1], p1, O1);
}
DEVI void flashB_item(int b, int hh, int r, int qg, const h16* Q, const h16* K, const h16* VT, const unsigned char* lds, const h16* gate, h16* mix) {
    constexpr size_t VSZ = (size_t)32 * 64 * SEQ;
    const int lane = otid() & 63, q = lane & 31, h = lane >> 5;
    const size_t tokq = (size_t)b * SEQ + qg * 512 + 16 * q + r;
    h16x8 qf[4];
#pragma unroll
    for (int ks = 0; ks < 4; ++ks) qf[ks] = *(const h16x8*)(Q + tokq * 256 + hh * 64 + ks * 16 + 8 * h);
    f32x16 O0 = {}, O1 = {}; float m = -1e30f, l = 0.f;
    const h16* Kb = K + (size_t)b * SEQ * 256 + hh * 64;
    const h16* Vb = VT + ((size_t)(b * 4 + hh) * 64 + q) * SEQ + 4 * h;
    {
        const float* R3 = (const float*)(lds + L_R3) + hh * 192;
        for (int pk0 = (qg >= 4 ? qg - 4 : 0) * 32; pk0 <= qg * 32; pk0 += 32) {
            const int c = qg * 32 + q - pk0;
            flashB_tile(qf, Kb + (size_t)(16 * (pk0 + q) + r) * 256, Vb + 2 * VSZ + (pk0 >> 4) * 256 + r * 16, 256, R3 + (159 - c + 4 * h), O0, O1, m, l, h);
        }
    }
    {
        const float* R2 = (const float*)(lds + L_R2) + hh * 384; const int r4 = r & 3;
        for (int pk0 = (qg >= 1 ? qg * 128 - 128 : 0); pk0 <= qg * 128 + 96; pk0 += 32) {
            const int c = qg * 128 + 4 * q + (r >> 2) - pk0;
            flashB_tile(qf, Kb + (size_t)(4 * (pk0 + q) + r4) * 256, Vb + VSZ + (pk0 >> 6) * 256 + r4 * 64 + (pk0 & 63), 16, R2 + (255 - c + 4 * h), O0, O1, m, l, h);
        }
    }
    {
        const float* R1 = (const float*)(lds + L_R1) + hh * 1152;
        for (int s0 = (qg >= 1 ? qg * 512 - 128 : 0); s0 <= qg * 512 + 480; s0 += 32) {
            const int c = qg * 512 + 16 * q + r - s0;
            flashB_tile(qf, Kb + (size_t)(s0 + q) * 256, Vb + s0, 16, R1 + (639 - c + 4 * h), O0, O1, m, l, h);
        }
    }
    const float il = 1.f / xh_sum(l);
    const h16* gp = gate + tokq * 1024 + 256 + hh * 64 + 4 * h; h16* op = mix + tokq * 1024 + 256 + hh * 64 + 4 * h;
#pragma unroll
    for (int db = 0; db < 2; ++db)
#pragma unroll
        for (int g = 0; g < 4; ++g) {
            const h16x4 gv = *(const h16x4*)(gp + db * 32 + 8 * g); h16x4 o;
#pragma unroll
            for (int e = 0; e < 4; ++e) o[e] = (h16)((db ? O1[4 * g + e] : O0[4 * g + e]) * il * (float)gv[e]);
            *(h16x4*)(op + db * 32 + 8 * g) = o;
        }
}

DEVI unsigned xh_or(unsigned x) { auto r = __builtin_amdgcn_permlane32_swap(x, x, false, false); return r[0] | r[1]; }
DEVI void idx_tile(const h16* idx, int b, int j, int qt, int q, int h, const h16x8 (&qf)[8][2], const float (&ws)[8], float lo, float scl, unsigned (&kq)[16]) {
    const size_t tk = (size_t)b * SEQ + j * 32 + q;
    const h16x8 k0 = *(const h16x8*)(idx + tk * 320 + 256 + 8 * h), k1 = *(const h16x8*)(idx + tk * 320 + 272 + 8 * h);
    f32x16 sc = {};
#pragma unroll
    for (int hd = 0; hd < 8; ++hd) {
        f32x16 L = {}; L = mfma32(k0, qf[hd][0], L); L = mfma32(k1, qf[hd][1], L);
#pragma unroll
        for (int r = 0; r < 16; ++r) sc[r] += fmaxf(L[r], 0.f) * ws[hd];
    }
#pragma unroll
    for (int r = 0; r < 16; ++r) {
        const float x = fminf(fmaxf((sc[r] - lo) * scl, 0.f), 2097151.f);
        unsigned u = (unsigned)x;
        if (j == qt && CROW(r) + 4 * h > q) u = 0xFFFFFFFFu;
        kq[r] = u;
    }
}
constexpr int TK_HIST = 0, TK_EQC = 8320, TK_END = 10368;
DEVI void topk_item(int b, int qt, const h16* idx, unsigned* mask, unsigned char* lds) {
    const int tid = otid(), lane = tid & 63, q = lane & 31, h = lane >> 5, wv = tid >> 6;
    const size_t tokq = (size_t)b * SEQ + qt * 32 + q;
    LAS unsigned* hist = (LAS unsigned*)(lds + TK_HIST);
    LAS unsigned char* eqc = (LAS unsigned char*)(lds + TK_EQC);
    h16x8 qf[8][2]; float ws[8];
    float P = 0.f, N = 0.f;
#pragma unroll
    for (int hd = 0; hd < 8; ++hd) {
        qf[hd][0] = *(const h16x8*)(idx + tokq * 320 + hd * 32 + 8 * h); qf[hd][1] = *(const h16x8*)(idx + tokq * 320 + hd * 32 + 16 + 8 * h);
        ws[hd] = (float)idx[tokq * 320 + 288 + hd] * 0.35355339059327373f;
        float nn = 0.f;
#pragma unroll
        for (int e = 0; e < 8; ++e) { const float a = (float)qf[hd][0][e], c = (float)qf[hd][1][e]; nn += a * a + c * c; }
        nn = sqrtf(xh_sum(nn)) * 12.f;
        if (ws[hd] > 0.f) P += ws[hd] * nn; else N -= ws[hd] * nn;
    }
    const float lo = -N, scl = 2097151.f / fmaxf(P + N, 1e-20f);
    __syncthreads();
    for (int i = tid; i < 32 * 65; i += NTHR) hist[i] = 0u;
    __syncthreads();
    unsigned R = 256u, pref = 0u;
#pragma unroll 1
    for (int lvl = 0; lvl < 3; ++lvl) {
        const int sh = 14 - 7 * lvl;
        for (int j = wv; j <= qt; j += 8) {
            unsigned kq[16];
            idx_tile(idx, b, j, qt, q, h, qf, ws, lo, scl, kq);
#pragma unroll
            for (int r = 0; r < 16; ++r) {
                if ((kq[r] >> (sh + 7)) == pref) {
                    const unsigned bin = (kq[r] >> sh) & 127u;
                    __hip_atomic_fetch_add(hist + q * 65 + (bin >> 1), 1u << ((bin & 1u) * 16u), __ATOMIC_RELAXED, __HIP_MEMORY_SCOPE_WORKGROUP);
                }
            }
        }
        __syncthreads();
        {
            unsigned cum = 0u, found = 0u, bb = 0u, above = 0u;
#pragma unroll 4
            for (int w = 63; w >= 0; --w) {
                const unsigned v = hist[q * 65 + w];
                unsigned t = cum + (v >> 16);
                if (!found && t >= R) { bb = 2u * w + 1u; above = cum; found = 1u; }
                cum = t; t = cum + (v & 0xffffu);
                if (!found && t >= R) { bb = 2u * w; above = cum; found = 1u; }
                cum = t;
            }
            R -= above; pref = (pref << 7) | bb;
        }
        __syncthreads();
        for (int i = tid; i < 32 * 65; i += NTHR) hist[i] = 0u;
        __syncthreads();
    }
    unsigned GT[8], EQ[8];
#pragma unroll
    for (int n = 0; n < 8; ++n) {
        const int j = wv + 8 * n; GT[n] = 0u; EQ[n] = 0u;
        if (j <= qt) {
            unsigned kq[16];
            idx_tile(idx, b, j, qt, q, h, qf, ws, lo, scl, kq);
            unsigned g = 0u, e = 0u;
#pragma unroll
            for (int r = 0; r < 16; ++r) {
                g |= (kq[r] > pref && (kq[r] >> 21) == 0u) ? (1u << CROW(r)) : 0u;
                e |= (kq[r] == pref) ? (1u << CROW(r)) : 0u;
            }
            GT[n] = xh_or(g << (4 * h)); EQ[n] = xh_or(e << (4 * h));
            if (h == 0) eqc[q * 64 + j] = (unsigned char)__builtin_popcount(EQ[n]);
        }
    }
    __syncthreads();
#pragma unroll
    for (int n = 0; n < 8; ++n) {
        const int j = wv + 8 * n;
        if (j <= qt) {
            unsigned before = 0u;
#pragma unroll
            for (int k = 0; k < 16; ++k) {
                const int nb = j - 4 * k;
                if (nb > 0) { unsigned v = *(const LAS unsigned*)(eqc + q * 64 + 4 * k); if (nb < 4) v &= (1u << (8 * nb)) - 1u; before += (v * 0x01010101u) >> 24; }
            }
            unsigned e = EQ[n]; const unsigned pc = (unsigned)__builtin_popcount(e);
            const unsigned allow = before >= R ? 0u : (R - before < pc ? R - before : pc);
            unsigned keep = e;
            if (allow < pc) { keep = 0u; for (unsigned c = 0; c < allow; ++c) { const unsigned bit = e & (0u - e); keep |= bit; e ^= bit; } }
            if (h == 0) mask[tokq * 64 + j] = GT[n] | keep;
        }
    }
}
DEVI void ph_topk(const h16* idx, unsigned* mask, unsigned char* lds) {
    for (int g = blockIdx.x; g < 256; g += gridDim.x) {
        const int b = g >> 5, k = g & 31;
        if (k < 28) { topk_item(b, 63 - k, idx, mask, lds); topk_item(b, 8 + k, idx, mask, lds); }
        else if (k == 28) { const int tid = otid(); for (int i = tid; i < 256 * 8; i += NTHR) { const int t = i >> 3, j = i & 7; if (j <= (t >> 5)) mask[((size_t)b * SEQ + t) * 64 + j] = 0xffffffffu; } }
    }
}

DEVI void ph_out(const h16* mix, const h16* WoT, const float* __restrict__ gpost, const float* h_in, float* h_out, h16* h16o, float* rstd_next, bool write_next, unsigned char* lds) {
    const int tid = otid(), lane = tid & 63, q = lane & 31, h = lane >> 5, wv = tid >> 6;
    LAS float* red = (LAS float*)lds;
    for (int u = blockIdx.x; u < NT / 64; u += gridDim.x) {
        f32x16 acc[4][2];
#pragma unroll
        for (int rb = 0; rb < 4; ++rb) { acc[rb][0] = (f32x16){}; acc[rb][1] = (f32x16){}; }
        const h16* ap = WoT + (size_t)(wv * 128 + q) * DM + 8 * h;
        const h16* bp = mix + (size_t)(u * 64 + q) * DM + 8 * h;
        h16x8 af[4], bf[2];
#pragma unroll
        for (int rb = 0; rb < 4; ++rb) af[rb] = *(const h16x8*)(ap + (size_t)rb * 32 * DM);
#pragma unroll
        for (int tb = 0; tb < 2; ++tb) bf[tb] = *(const h16x8*)(bp + (size_t)tb * 32 * DM);
#pragma unroll 2
        for (int ks = 0; ks < 64; ++ks) {
            h16x8 an[4], bn[2];
            const int kn = (ks < 63 ? ks + 1 : ks) * 16;
#pragma unroll
            for (int rb = 0; rb < 4; ++rb) an[rb] = *(const h16x8*)(ap + (size_t)rb * 32 * DM + kn);
#pragma unroll
            for (int tb = 0; tb < 2; ++tb) bn[tb] = *(const h16x8*)(bp + (size_t)tb * 32 * DM + kn);
#pragma unroll
            for (int rb = 0; rb < 4; ++rb)
#pragma unroll
                for (int tb = 0; tb < 2; ++tb) acc[rb][tb] = mfma32(af[rb], bf[tb], acc[rb][tb]);
#pragma unroll
            for (int rb = 0; rb < 4; ++rb) af[rb] = an[rb];
#pragma unroll
            for (int tb = 0; tb < 2; ++tb) bf[tb] = bn[tb];
        }
        __syncthreads();
#pragma unroll
        for (int tb = 0; tb < 2; ++tb) {
            float ss = 0.f;
#pragma unroll
            for (int rb = 0; rb < 4; ++rb)
#pragma unroll
                for (int r = 0; r < 16; ++r) ss += acc[rb][tb][r] * acc[rb][tb][r];
            ss = xh_sum(ss);
            if (h == 0) red[wv * 64 + tb * 32 + q] = ss;
        }
        __syncthreads();
        float ssn[2] = {0.f, 0.f};
#pragma unroll
        for (int tb = 0; tb < 2; ++tb) {
            float tot = 0.f;
#pragma unroll
            for (int w2 = 0; w2 < 8; ++w2) tot += red[w2 * 64 + tb * 32 + q];
            const float rs = rsqrtf(tot * (1.f / DM) + EPS);
            const size_t rowoff = (size_t)(u * 64 + tb * 32 + q) * DM;
#pragma unroll
            for (int rb = 0; rb < 4; ++rb)
#pragma unroll
                for (int g = 0; g < 4; ++g) {
                    const int n = wv * 128 + rb * 32 + 8 * g + 4 * h;
                    const float4 hv = *(const float4*)(h_in + rowoff + n), gv = *(const float4*)(gpost + n);
                    float4 o;
                    o.x = hv.x + acc[rb][tb][4 * g + 0] * rs * gv.x; o.y = hv.y + acc[rb][tb][4 * g + 1] * rs * gv.y;
                    o.z = hv.z + acc[rb][tb][4 * g + 2] * rs * gv.z; o.w = hv.w + acc[rb][tb][4 * g + 3] * rs * gv.w;
                    *(float4*)(h_out + rowoff + n) = o;
                    if (write_next) { h16x4 oh; oh[0] = (h16)o.x; oh[1] = (h16)o.y; oh[2] = (h16)o.z; oh[3] = (h16)o.w; *(h16x4*)(h16o + rowoff + n) = oh;
                        ssn[tb] += o.x * o.x + o.y * o.y + o.z * o.z + o.w * o.w; }
                }
        }
        if (write_next) {
#pragma unroll
            for (int tb = 0; tb < 2; ++tb) { const float v = xh_sum(ssn[tb]); if (h == 0) red[512 + wv * 64 + tb * 32 + q] = v; }
            __syncthreads();
            if (tid < 64) { float tot = 0.f;
#pragma unroll
                for (int w2 = 0; w2 < 8; ++w2) tot += red[512 + w2 * 64 + tid];
                rstd_next[u * 64 + tid] = rsqrtf(tot * (1.f / DM) + EPS); }
        }
    }
}

DEVI void mla_item(int it, const h16* cA, const h16* WuqT, const h16* WukvT, const float* cosT, const float* sinT, h16* qA, h16* kA, h16* kAr, h16* vAT) {
    const int lane = otid() & 63, q = lane & 31, h = lane >> 5;
    const size_t tok = (size_t)it * 32 + q; const int b = (int)(tok / SEQ), s = (int)(tok % SEQ);
    const float qs = 0.10206207261596577f * LOG2E;
    {
        h16x8 cf[12]; float ss = 0.f;
#pragma unroll
        for (int ks = 0; ks < 12; ++ks) { cf[ks] = *(const h16x8*)(cA + tok * 384 + ks * 16 + 8 * h);
#pragma unroll
            for (int e = 0; e < 8; ++e) { const float v = (float)cf[ks][e]; ss += v * v; } }
        const float rs = rsqrtf(xh_sum(ss) * (1.f / 192.f) + EPS) * qs;
#pragma unroll 1
        for (int nb = 0; nb < 12; ++nb) {
            f32x16 acc = {};
            const h16* wp = WuqT + (size_t)(nb * 32 + q) * 192 + 8 * h;
#pragma unroll
            for (int ks = 0; ks < 12; ++ks) acc = mfma32(*(const h16x8*)(wp + ks * 16), cf[ks], acc);
            acc *= rs;
            const int hh = nb / 3, part = nb % 3;
            if (part == 2) {
#pragma unroll
                for (int r = 0; r < 8; ++r) { const int i = CROW(r) + 4 * h; const float c = cosT[s * 16 + i], sn = sinT[s * 16 + i], x1 = acc[r], x2 = acc[r + 8];
                    acc[r] = x1 * c - x2 * sn; acc[r + 8] = x1 * sn + x2 * c; }
            }
            h16* op = qA + tok * 384 + hh * 96 + part * 32 + 4 * h;
#pragma unroll
            for (int g = 0; g < 4; ++g) { h16x4 o; o[0] = (h16)acc[4 * g]; o[1] = (h16)acc[4 * g + 1]; o[2] = (h16)acc[4 * g + 2]; o[3] = (h16)acc[4 * g + 3]; *(h16x4*)(op + 8 * g) = o; }
        }
    }
    {
        h16x8 cf[8]; float ss = 0.f;
#pragma unroll
        for (int ks = 0; ks < 8; ++ks) { cf[ks] = *(const h16x8*)(cA + tok * 384 + 192 + ks * 16 + 8 * h);
#pragma unroll
            for (int e = 0; e < 8; ++e) { const float v = (float)cf[ks][e]; ss += v * v; } }
        const float rs = rsqrtf(xh_sum(ss) * (1.f / 128.f) + EPS);
#pragma unroll 1
        for (int nb = 0; nb < 16; ++nb) {
            f32x16 acc = {};
            const h16* wp = WukvT + (size_t)(nb * 32 + q) * 128 + 8 * h;
#pragma unroll
            for (int ks = 0; ks < 8; ++ks) acc = mfma32(*(const h16x8*)(wp + ks * 16), cf[ks], acc);
            acc *= rs;
            const int hh = nb >> 2, sub = nb & 3;
            if (sub < 2) {
                h16* op = kA + tok * 256 + hh * 64 + sub * 32 + 4 * h;
#pragma unroll
                for (int g = 0; g < 4; ++g) { h16x4 o; o[0] = (h16)acc[4 * g]; o[1] = (h16)acc[4 * g + 1]; o[2] = (h16)acc[4 * g + 2]; o[3] = (h16)acc[4 * g + 3]; *(h16x4*)(op + 8 * g) = o; }
            } else {
                h16* op = vAT + ((size_t)(b * 4 + hh) * 64 + (sub - 2) * 32 + 4 * h) * SEQ + s;
#pragma unroll
                for (int r = 0; r < 16; ++r) op[(size_t)CROW(r) * SEQ] = (h16)acc[r];
            }
        }
    }
    {
        const h16x8 a = *(const h16x8*)(cA + tok * 384 + 320 + 8 * h), c2 = *(const h16x8*)(cA + tok * 384 + 336 + 8 * h);
        h16x8 o1, o2;
#pragma unroll
        for (int e = 0; e < 8; ++e) { const int i = 8 * h + e; const float c = cosT[s * 16 + i], sn = sinT[s * 16 + i], x1 = (float)a[e], x2 = (float)c2[e];
            o1[e] = (h16)(x1 * c - x2 * sn); o2[e] = (h16)(x1 * sn + x2 * c); }
        *(h16x8*)(kAr + tok * 32 + 8 * h) = o1; *(h16x8*)(kAr + tok * 32 + 16 + 8 * h) = o2;
    }
}
DEVI void ph_small_weights(const float* w_uq, const float* qn, const float* w_ukv, const float* kvn, h16* WuqT, h16* WukvT) {
    const int gt = blockIdx.x * NTHR + otid(), nthr = gridDim.x * NTHR;
    for (int i = gt; i < 2 * 384 * 192; i += nthr) { const int l = i / (384 * 192), rem = i % (384 * 192), n = rem / 192, k = rem % 192;
        WuqT[i] = (h16)(w_uq[(size_t)l * 192 * 384 + k * 384 + n] * qn[l * 192 + k]); }
    for (int i = gt; i < 2 * 512 * 128; i += nthr) { const int l = i / (512 * 128), rem = i % (512 * 128), n = rem / 128, k = rem % 128;
        WukvT[i] = (h16)(w_ukv[(size_t)l * 128 * 512 + k * 512 + n] * kvn[l * 128 + k]); }
}

constexpr int LDS_BYTES = 144 * 1024;
struct Params { const float* in[12]; float* out; unsigned char* ws; };

DEVI void ph_tables(const float* __restrict__ rel_bias, float* biasTab, float* cosT, float* sinT) {
    for (int i = blockIdx.x * NTHR + threadIdx.x; i < 2048 * 16; i += gridDim.x * NTHR) {
        if (i < 12 * 2048) { int hh = i / 2048, n = i % 2048; biasTab[i] = rel_bias[t5_bucket(n) * 12 + hh] * LOG2E; }
        int pos = i / 16, j = i % 16;
        float inv = (float)pow(10000.0, -(double)(2 * j) / 32.0);
        float ang = (float)pos * inv;
        cosT[i] = (float)cos((double)ang); sinT[i] = (float)sin((double)ang);
    }
}

DEVI void ph_rowstat(const float* h, float* rstd) {
    const int lane = threadIdx.x & 63, gw = blockIdx.x * NWAVE + (threadIdx.x >> 6), nw = gridDim.x * NWAVE;
    for (int row = gw; row < NT; row += nw) {
        const float4* p = (const float4*)(h + (size_t)row * DM);
        float s = 0.f;
        for (int i = lane; i < 256; i += 64) { float4 v = p[i]; s += v.x * v.x + v.y * v.y + v.z * v.z + v.w * v.w; }
        for (int o = 32; o; o >>= 1) s += __shfl_xor(s, o);
        if (lane == 0) rstd[row] = rsqrtf(s / DM + EPS);
    }
}

DEVI void ph_gemm_in_naive(const float* h, const float* __restrict__ g, const float* __restrict__ w, const float* rstd, unsigned char* ws, unsigned char* lds) {
    const int t_ = otid(); const int sub = t_ >> 8, tid = t_ & 255, ty = tid >> 4, tx = tid & 15;
    float (*As)[68] = (float (*)[68])(lds + sub * 2 * 16 * 68 * 4);
    float (*Bs)[68] = (float (*)[68])(lds + sub * 2 * 16 * 68 * 4 + 16 * 68 * 4);
    for (int it = blockIdx.x; it < 64 * 256 / 2; it += gridDim.x) {
        const int vb = it * 2 + sub, col0 = (vb & 63) * 64, row0 = (vb >> 6) * 64;
        float acc[4][4] = {};
        const int ar = tid >> 2, ak = (tid & 3) * 4, bk = tid >> 4, bc = (tid & 15) * 4;
        int rc[4];
#pragma unroll
        for (int j = 0; j < 4; ++j) rc[j] = ref_col(col0 + bc + j);
        for (int k0 = 0; k0 < DM; k0 += 16) {
            float4 av = *(const float4*)(h + (size_t)(row0 + ar) * DM + k0 + ak);
            float4 gv = *(const float4*)(g + k0 + ak);
            As[ak + 0][ar] = av.x * gv.x; As[ak + 1][ar] = av.y * gv.y; As[ak + 2][ar] = av.z * gv.z; As[ak + 3][ar] = av.w * gv.w;
#pragma unroll
            for (int j = 0; j < 4; ++j) Bs[bk][bc + j] = rc[j] >= 0 ? w[(size_t)(k0 + bk) * INC + rc[j]] : 0.f;
            __syncthreads();
#pragma unroll
            for (int kk = 0; kk < 16; ++kk) {
                float a[4], b[4];
#pragma unroll
                for (int i = 0; i < 4; ++i) { a[i] = As[kk][ty * 4 + i]; b[i] = Bs[kk][tx * 4 + i]; }
#pragma unroll
                for (int i = 0; i < 4; ++i)
#pragma unroll
                    for (int j = 0; j < 4; ++j) acc[i][j] += a[i] * b[j];
            }
            __syncthreads();
        }
        const int c = col0 + tx * 4;
        Route r = route(c);
        if (r.buf >= 0) {
            h16* dst = (h16*)(ws + buf_off(r.buf));
#pragma unroll
            for (int i = 0; i < 4; ++i) {
                int row = row0 + ty * 4 + i; float rs = rstd[row];
#pragma unroll
                for (int j = 0; j < 4; ++j) {
                    float v = acc[i][j] * rs * r.scale;
                    if (r.silu) v = v / (1.f + __expf(-v));
                    dst[(size_t)row * r.pitch + r.dcol + j] = (h16)v;
                }
            }
        }
    }
}

DEVI void ph_mla_naive(const h16* cA, const float* __restrict__ qn, const float* __restrict__ kvn, const float* __restrict__ wuq, const float* __restrict__ wukv,
                       const float* cosT, const float* sinT, h16* qA, h16* kA, h16* kAr, h16* vAT, unsigned char* lds) {
    const int t_ = otid(); const int sub = t_ >> 7, tid = t_ & 127;
    float* cq = (float*)(lds + sub * 3072); float* ckv = cq + 192; float* kr = ckv + 128; float* qout = kr + 32; float* red = qout + 384;
    for (int it = blockIdx.x; it < NT / 4; it += gridDim.x) {
        const int tok = it * 4 + sub, s = tok % SEQ;
        __syncthreads();
        for (int i = tid; i < 192; i += 128) cq[i] = (float)cA[(size_t)tok * 384 + i];
        ckv[tid] = (float)cA[(size_t)tok * 384 + 192 + tid];
        if (tid < 32) kr[tid] = (float)cA[(size_t)tok * 384 + 320 + tid];
        __syncthreads();
        if (tid < 64) {
            float a = 0.f; for (int i = tid; i < 192; i += 64) a += cq[i] * cq[i];
            for (int o = 32; o; o >>= 1) a += __shfl_xor(a, o);
            if (tid == 0) red[0] = rsqrtf(a / 192.f + EPS);
        } else {
            int l = tid - 64; float a = 0.f; for (int i = l; i < 128; i += 64) a += ckv[i] * ckv[i];
            for (int o = 32; o; o >>= 1) a += __shfl_xor(a, o);
            if (l == 0) red[1] = rsqrtf(a / 128.f + EPS);
        }
        __syncthreads();
        for (int i = tid; i < 192; i += 128) cq[i] = cq[i] * red[0] * qn[i];
        ckv[tid] = ckv[tid] * red[1] * kvn[tid];
        __syncthreads();
        for (int n = tid; n < 384; n += 128) { float a = 0.f; for (int k = 0; k < 192; ++k) a += cq[k] * wuq[k * 384 + n]; qout[n] = a; }
        __syncthreads();
        const float qs = 0.10206207261596577f * LOG2E;
        for (int idx = tid; idx < 384; idx += 128) {
            int hh = idx / 96, j = idx % 96; float val;
            if (j < 64) val = qout[idx];
            else { int r = j - 64, i = r & 15; float x1 = qout[hh * 96 + 64 + i], x2 = qout[hh * 96 + 80 + i], c = cosT[s * 16 + i], sn = sinT[s * 16 + i];
                   val = r < 16 ? x1 * c - x2 * sn : x1 * sn + x2 * c; }
            qA[(size_t)tok * 384 + idx] = (h16)(val * qs);
        }
        for (int n = tid; n < 512; n += 128) {
            float a = 0.f; for (int k = 0; k < 128; ++k) a += ckv[k] * wukv[k * 512 + n];
            int hh = n / 128, j = n % 128;
            if (j < 64) kA[(size_t)tok * 256 + hh * 64 + j] = (h16)a; else { vAT[((size_t)((tok / SEQ) * 4 + hh) * 64 + j - 64) * SEQ + s] = (h16)a; }
        }
        if (tid < 32) { int i = tid & 15; float x1 = kr[i], x2 = kr[16 + i], c = cosT[s * 16 + i], sn = sinT[s * 16 + i];
            kAr[(size_t)tok * 32 + tid] = (h16)(tid < 16 ? x1 * c - x2 * sn : x1 * sn + x2 * c); }
    }
}

DEVI void ph_attnA_naive(int vb, const h16* qA, const h16* kA, const h16* vA, const h16* kAr, const h16* gate, h16* mix) {
    const int chunk = 63 - (vb % 64), bh = vb / 64, b = bh / 4, hh = bh % 4, half = (otid() >> 5) & 1;
    const int t = chunk * 32 + (otid() & 31); const size_t tok = (size_t)b * SEQ + t;
    float q[96], o[32];
#pragma unroll
    for (int i = 0; i < 96; ++i) q[i] = (float)qA[tok * 384 + hh * 96 + i];
#pragma unroll
    for (int i = 0; i < 32; ++i) o[i] = 0.f;
    float m = -1e30f, l = 0.f;
    const int smax = chunk * 32 + 31;
    for (int s = 0; s <= smax; ++s) {
        const size_t ks = (size_t)b * SEQ + s;
        const h16* kp = kA + ks * 256 + hh * 64; const h16* kr = kAr + ks * 32; const h16* vp = vA + ks * 256 + hh * 64 + half * 32;
        float sc = 0.f;
#pragma unroll
        for (int i = 0; i < 64; ++i) sc += q[i] * (float)kp[i];
#pragma unroll
        for (int i = 0; i < 32; ++i) sc += q[64 + i] * (float)kr[i];
        if (s <= t) {
            if (sc > m) { float a = exp2f(m - sc); l *= a;
#pragma unroll
                for (int i = 0; i < 32; ++i) o[i] *= a;
                m = sc; }
            float p = exp2f(sc - m); l += p;
#pragma unroll
            for (int i = 0; i < 32; ++i) o[i] += p * (float)vp[i];
        }
    }
    float il = 1.f / l;
#pragma unroll
    for (int i = 0; i < 32; ++i) mix[tok * 1024 + hh * 64 + half * 32 + i] = (h16)(o[i] * il * (float)gate[tok * 1024 + hh * 64 + half * 32 + i]);
}

DEVI void ph_attnB_naive(int vb, const h16* qB, const h16* kB, const h16* vt, const float* biasTab, const h16* gate, h16* mix) {
    const int chunk = vb % 32, bh = vb / 32, b = bh / 4, hh = bh % 4;
    const int t = chunk * 64 + (otid() & 63); const size_t tok = (size_t)b * SEQ + t;
    float q[64], o[64];
#pragma unroll
    for (int i = 0; i < 64; ++i) { q[i] = (float)qB[tok * 256 + hh * 64 + i]; o[i] = 0.f; }
    float m = -1e30f, l = 0.f;
    const float* bt = biasTab + hh * 2048;
    for (int pat = 0; pat < 3; ++pat) {
        const int d = pat == 0 ? 1 : (pat == 1 ? 4 : 16);
        for (int k = 0; k <= 128; ++k) {
            const int s = t - k * d; if (s < 0) break;
            const size_t ks = (size_t)b * SEQ + s;
            const h16* kp = kB + ks * 256 + hh * 64; const h16* vp = vt + ks * 768 + hh * 64;
            float sc = bt[k * d];
#pragma unroll
            for (int i = 0; i < 64; ++i) sc += q[i] * (float)kp[i];
            if (sc > m) { float a = exp2f(m - sc); l *= a;
#pragma unroll
                for (int i = 0; i < 64; ++i) o[i] *= a;
                m = sc; }
            float p = exp2f(sc - m); l += p;
#pragma unroll
            for (int i = 0; i < 64; ++i) o[i] += p * (float)vp[i];
        }
    }
    float il = 1.f / l;
#pragma unroll
    for (int i = 0; i < 64; ++i) mix[tok * 1024 + 256 + hh * 64 + i] = (h16)(o[i] * il * (float)gate[tok * 1024 + 256 + hh * 64 + i]);
}

DEVI void ph_topk_naive(const h16* idx, unsigned* mask, unsigned char* lds) {
    const int t_ = otid(); const int sub = t_ >> 8, tid = t_ & 255;
    float* sc = (float*)(lds + sub * 9728); float* qi = sc + 2048; float* wi = qi + 256; unsigned* msk = (unsigned*)(wi + 8);
    for (int it = blockIdx.x; it < NT / 2; it += gridDim.x) {
        const int tok = (NT / 2 - 1 - it) * 2 + sub, b = tok / SEQ, t = tok % SEQ;
        __syncthreads();
        qi[tid] = (float)idx[(size_t)tok * 320 + tid];
        if (tid < 8) wi[tid] = (float)idx[(size_t)tok * 320 + 288 + tid] * 0.35355339059327373f;
        if (tid < 64) msk[tid] = 0u;
        __syncthreads();
        for (int s = tid; s <= t; s += 256) {
            const h16* kp = idx + ((size_t)b * SEQ + s) * 320 + 256;
            float kk[32];
#pragma unroll
            for (int d = 0; d < 32; ++d) kk[d] = (float)kp[d];
            float score = 0.f;
#pragma unroll 1
            for (int hh = 0; hh < 8; ++hh) { float lg = 0.f;
#pragma unroll
                for (int d = 0; d < 32; ++d) lg += qi[hh * 32 + d] * kk[d];
                score += fmaxf(lg, 0.f) * wi[hh]; }
            sc[s] = score;
        }
        __syncthreads();
        if (t + 1 <= 256) {
            for (int i = tid; i <= t; i += 256) atomicOr(&msk[i >> 5], 1u << (i & 31));
        } else {
            for (int i = tid; i <= t; i += 256) {
                const float si = sc[i]; int rank = 0;
                for (int j = 0; j <= t; ++j) { float sj = sc[j]; rank += (sj > si || (sj == si && j < i)) ? 1 : 0; }
                if (rank < 256) atomicOr(&msk[i >> 5], 1u << (i & 31));
            }
        }
        __syncthreads();
        if (tid < 64) mask[(size_t)tok * 64 + tid] = msk[tid];
    }
}

DEVI void ph_attnC_naive(int vb, const h16* qC, const h16* kC, const h16* vt, const unsigned* mask, const float* biasTab, const h16* gate, h16* mix) {
    const int chunk = 31 - (vb % 32), bh = vb / 32, b = bh / 4, hh = bh % 4;
    const int t = chunk * 64 + (otid() & 63); const size_t tok = (size_t)b * SEQ + t;
    float q[64], o[64];
#pragma unroll
    for (int i = 0; i < 64; ++i) { q[i] = (float)qC[tok * 256 + hh * 64 + i]; o[i] = 0.f; }
    float m = -1e30f, l = 0.f;
    const float* bt = biasTab + (4 + hh) * 2048;
    const int smax = chunk * 64 + 63;
    unsigned mw = 0;
    for (int s = 0; s <= smax; ++s) {
        if ((s & 31) == 0) mw = mask[tok * 64 + (s >> 5)];
        const size_t ks = (size_t)b * SEQ + s;
        const h16* kp = kC + ks * 256 + hh * 64; const h16* vp = vt + ks * 768 + 256 + hh * 64;
        float sc = 0.f;
#pragma unroll
        for (int i = 0; i < 64; ++i) sc += q[i] * (float)kp[i];
        if (s <= t && ((mw >> (s & 31)) & 1u)) {
            sc += bt[t - s];
            if (sc > m) { float a = exp2f(m - sc); l *= a;
#pragma unroll
                for (int i = 0; i < 64; ++i) o[i] *= a;
                m = sc; }
            float p = exp2f(sc - m); l += p;
#pragma unroll
            for (int i = 0; i < 64; ++i) o[i] += p * (float)vp[i];
        }
    }
    float il = 1.f / l;
#pragma unroll
    for (int i = 0; i < 64; ++i) mix[tok * 1024 + 512 + hh * 64 + i] = (h16)(o[i] * il * (float)gate[tok * 1024 + 512 + hh * 64 + i]);
}

DEVI void ph_attnD_naive(int vb, const h16* qD, const h16* kD, const h16* vt, const float* biasTab, const float* __restrict__ lam_p, const float* __restrict__ subln,
                         float lambda_init, const h16* gate, h16* mix) {
    const int t_ = otid();
    const int chunk = 127 - (vb % 128), bh = vb / 128, b = bh / 4, hh = bh % 4, mp = (t_ >> 4) & 1, half = (t_ >> 5) & 1;
    const int t = chunk * 16 + (t_ & 15); const size_t tok = (size_t)b * SEQ + t;
    float q[32], o[32];
#pragma unroll
    for (int i = 0; i < 32; ++i) { q[i] = (float)qD[tok * 256 + hh * 64 + mp * 32 + i]; o[i] = 0.f; }
    float m = -1e30f, l = 0.f;
    float a1 = 0.f, a2 = 0.f;
    for (int i = 0; i < 32; ++i) { a1 += lam_p[i] * lam_p[32 + i]; a2 += lam_p[64 + i] * lam_p[96 + i]; }
    const float lam = expf(a1) - expf(a2) + lambda_init;
    const float* bt = biasTab + (8 + hh) * 2048;
    const int smax = chunk * 16 + 15;
    for (int s = 0; s <= smax; ++s) {
        const size_t ks = (size_t)b * SEQ + s;
        const h16* kp = kD + ks * 256 + hh * 64 + mp * 32; const h16* vp = vt + ks * 768 + 512 + hh * 64 + half * 32;
        float sc = 0.f;
#pragma unroll
        for (int i = 0; i < 32; ++i) sc += q[i] * (float)kp[i];
        if (s <= t) {
            sc += bt[t - s];
            if (sc > m) { float a = exp2f(m - sc); l *= a;
#pragma unroll
                for (int i = 0; i < 32; ++i) o[i] *= a;
                m = sc; }
            float p = exp2f(sc - m); l += p;
#pragma unroll
            for (int i = 0; i < 32; ++i) o[i] += p * (float)vp[i];
        }
    }
    const float sgn = mp ? -lam : 1.f; const float il = sgn / l;
    float ss = 0.f;
#pragma unroll
    for (int i = 0; i < 32; ++i) { float v = o[i] * il; v += __shfl_xor(v, 16); o[i] = v; ss += v * v; }
    ss += __shfl_xor(ss, 32);
    float rs = rsqrtf(ss / 64.f + EPS) * (1.f - lambda_init);
    if (mp == 0) {
        int tt = b * SEQ + t; asm volatile("" : "+v"(tt)); const size_t tok2 = (size_t)tt;
#pragma unroll
        for (int i = 0; i < 32; ++i) mix[tok2 * 1024 + 768 + hh * 64 + half * 32 + i] = (h16)(o[i] * rs * subln[half * 32 + i] * (float)gate[tok2 * 1024 + 768 + hh * 64 + half * 32 + i]);
    }
}

DEVI void ph_out_naive(const h16* mix, const float* __restrict__ w, const float* __restrict__ g, const float* h_in, float* h_out, unsigned char* lds) {
    const int t_ = otid(); const int sub = t_ >> 8, tid = t_ & 255;
    float (*A)[1024] = (float (*)[1024])(lds + sub * 33024); float (*red)[4] = (float (*)[4])(lds + sub * 33024 + 32768);
    for (int it = blockIdx.x; it < NT / 16; it += gridDim.x) {
        const int row0 = (it * 2 + sub) * 8;
        __syncthreads();
        for (int i = tid; i < 8 * 1024; i += 256) A[i >> 10][i & 1023] = (float)mix[(size_t)(row0 + (i >> 10)) * 1024 + (i & 1023)];
        __syncthreads();
        float acc[8][4] = {};
        for (int k = 0; k < 1024; ++k) {
            float wv[4];
#pragma unroll
            for (int j = 0; j < 4; ++j) wv[j] = w[(size_t)k * 1024 + tid + 256 * j];
#pragma unroll
            for (int r = 0; r < 8; ++r) { float a = A[r][k];
#pragma unroll
                for (int j = 0; j < 4; ++j) acc[r][j] += a * wv[j]; }
        }
#pragma unroll
        for (int r = 0; r < 8; ++r) {
            float s = 0.f;
#pragma unroll
            for (int j = 0; j < 4; ++j) s += acc[r][j] * acc[r][j];
            for (int o = 32; o; o >>= 1) s += __shfl_xor(s, o);
            if ((tid & 63) == 0) red[r][tid >> 6] = s;
        }
        __syncthreads();
#pragma unroll
        for (int r = 0; r < 8; ++r) {
            float rs = rsqrtf((red[r][0] + red[r][1] + red[r][2] + red[r][3]) / 1024.f + EPS);
#pragma unroll
            for (int j = 0; j < 4; ++j) { int n = tid + 256 * j; size_t o = (size_t)(row0 + r) * 1024 + n; h_out[o] = h_in[o] + acc[r][j] * rs * g[n]; }
        }
    }
}

extern __shared__ __attribute__((aligned(16))) unsigned char smem[];
constexpr int LDS_BAR_OFF = 131072;

DEVI unsigned char* ows(unsigned char* w) { asm volatile("" : "+s"(w)); return w; }
#define WSP(T, off) ((T*)(w + (off)))

__global__ void __launch_bounds__(NTHR, 2) mega(Params p) {
    if (threadIdx.x == 0) *(uint4*)(smem + LDS_BAR_OFF) = make_uint4(0u, 0u, 0u, 0u);
    __syncthreads();
    XcdBarrier bar = xcd_barrier_post((unsigned*)(p.ws + OFF_CTL), (volatile LAS unsigned*)(smem + LDS_BAR_OFF));
    unsigned char* lds = smem;
    const int nw = gridDim.x * NWAVE;

    {
        unsigned char* w = ows(p.ws);
        ph_tables(p.in[11], WSP(float, OFF_BIAS), WSP(float, OFF_COS), WSP(float, OFF_SIN));
        int base = 0; const int total = 2 * (64 * 16) + 2 * (16 * 16);
        cvt_transpose<true>(p.in[1], INC, p.in[3], WSP(h16, OFF_WINT), MYC, DM, lds, blockIdx.x, total, base);
        cvt_transpose<true>(p.in[1] + (size_t)DM * INC, INC, p.in[3] + DM, WSP(h16, OFF_WINT) + (size_t)MYC * DM, MYC, DM, lds, blockIdx.x, total, base);
        cvt_transpose<false>(p.in[2], DM, nullptr, WSP(h16, OFF_WOUTT), DM, DM, lds, blockIdx.x, total, base);
        cvt_transpose<false>(p.in[2] + (size_t)DM * DM, DM, nullptr, WSP(h16, OFF_WOUTT) + (size_t)DM * DM, DM, DM, lds, blockIdx.x, total, base);
        ph_small_weights(p.in[7], p.in[5], p.in[8], p.in[6], WSP(h16, OFF_WUQT), WSP(h16, OFF_WUKVT));
        ph_rowstat_cvt(p.in[0], WSP(float, OFF_RSTD), WSP(h16, OFF_H16));
    }
    xcd_barrier(bar);
    for (int layer = 0; layer < 2; ++layer) {
        const float lambda_init = layer == 0 ? 0.2f : 0.35550906759f;
        {
            unsigned char* w = ows(p.ws);
            pg8::Gemm g{WSP(const pg8::bf16_t, OFF_H16), WSP(const pg8::bf16_t, OFF_WINT) + (size_t)layer * MYC * DM, NT, MYC, DM};
            int bid_ = (int)blockIdx.x; asm volatile("" : "+s"(bid_));
            pg8::StaticOrder S; S.init(NT, MYC, (int)gridDim.x, bid_);
            EpiRoute E{w, WSP(float, OFF_RSTD)};
            pg8::gemm_phase<EpiRoute, pg8::StaticOrder, true, true>((PG8_LAS unsigned char*)lds, g, S, E);
        }
        xcd_barrier(bar);
        {
            unsigned char* w = ows(p.ws);
            for (int it = ogw(); it < NT / 32; it += nw) mla_item(it, WSP(h16, OFF_CA), WSP(h16, OFF_WUQT) + (size_t)layer * 384 * 192, WSP(h16, OFF_WUKVT) + (size_t)layer * 512 * 128, WSP(float, OFF_COS), WSP(float, OFF_SIN), WSP(h16, OFF_QA), WSP(h16, OFF_KA), WSP(h16, OFF_KAR), WSP(h16, OFF_VAT));
        }
        {
            unsigned char* w = ows(p.ws);
            ph_topk(WSP(h16, OFF_IDX), WSP(unsigned, OFF_MASK), lds);
        }
        {
            unsigned char* w = ows(p.ws);
            ph_vtrans(WSP(h16, OFF_VTMP), WSP(h16, OFF_VT), lds);
        }
        xcd_barrier(bar);
        {
            unsigned char* w = ows(p.ws);
            constexpr size_t VSZ = (size_t)32 * 64 * SEQ;
            p2_setup(WSP(float, OFF_BIAS), p.in[9] + layer * 128, lambda_init, lds);
            unsigned* ctr = WSP(unsigned, OFF_CTL) + 3600 + 16 * layer;
            for (;;) { const int e = wq_next(ctr); if (e >= 8192) break;
                const int lvl = 63 - (e >> 7), ty = (e >> 5) & 3, bh = e & 31;
                if (ty == 0) flashA_item(bh >> 2, bh & 3, lvl, WSP(h16, OFF_QA), WSP(h16, OFF_KA), WSP(h16, OFF_KAR), WSP(h16, OFF_VAT), WSP(h16, OFF_GATE), WSP(h16, OFF_MIX));
                else if (ty == 1) flashCD_item<2, false>(bh >> 2, bh & 3, lvl, 8 + (bh & 3), WSP(h16, OFF_QD), WSP(h16, OFF_KD), WSP(h16, OFF_VT) + 4 * VSZ, nullptr, WSP(float, OFF_BIAS), lds,
                                                         p.in[10] + layer * 64, lambda_init, WSP(h16, OFF_GATE), WSP(h16, OFF_MIX), 768);
                else if (ty == 2) flashCD_item<1, true>(bh >> 2, bh & 3, lvl, 4 + (bh & 3), WSP(h16, OFF_QC), WSP(h16, OFF_KC), WSP(h16, OFF_VT) + 3 * VSZ, WSP(unsigned, OFF_MASK), WSP(float, OFF_BIAS), lds,
                                                        nullptr, 0.f, WSP(h16, OFF_GATE), WSP(h16, OFF_MIX), 512);
                else flashB_item(bh >> 2, bh & 3, lvl & 15, lvl >> 4, WSP(h16, OFF_QB), WSP(h16, OFF_KB), WSP(h16, OFF_VT), lds, WSP(h16, OFF_GATE), WSP(h16, OFF_MIX));
            }
        }
        xcd_barrier(bar);
        {
            unsigned char* w = ows(p.ws);
            ph_out(WSP(h16, OFF_MIX), WSP(h16, OFF_WOUTT) + (size_t)layer * DM * DM, p.in[4] + layer * DM, layer == 0 ? p.in[0] : (const float*)p.out, p.out, WSP(h16, OFF_H16), WSP(float, OFF_RSTD), layer == 0, lds);
        }
        xcd_barrier(bar);
    }
}

extern "C" void kernel_launch(void* const* d_in, const int* in_sizes, int n_in, void* d_out, int out_size, void* d_ws, size_t ws_size, hipStream_t stream) {
    static int grid = 0;
    if (grid == 0) {
        int dev = 0, cus = 0, per_cu = 0;
        (void)hipGetDevice(&dev);
        (void)hipDeviceGetAttribute(&cus, hipDeviceAttributeMultiprocessorCount, dev);
        (void)hipFuncSetAttribute((const void*)mega, hipFuncAttributeMaxDynamicSharedMemorySize, LDS_BYTES);
        (void)hipOccupancyMaxActiveBlocksPerMultiprocessor(&per_cu, (const void*)mega, NTHR, LDS_BYTES);
        (void)hipGetLastError();
        grid = cus > 0 ? cus : 256;
    }
    (void)hipMemsetAsync((char*)d_ws + OFF_CTL, 0, 16384, stream);
    Params p{};
    for (int i = 0; i < 12; ++i) p.in[i] = (const float*)d_in[i];
    p.out = (float*)d_out; p.ws = (unsigned char*)d_ws;
    hipLaunchKernelGGL(mega, dim3(grid), dim3(NTHR), LDS_BYTES, stream, p);
}
```

```cpp
#include <hip/hip_runtime.h>
#include <stdint.h>
#include <math.h>

typedef _Float16 h16;
#define GAS __attribute__((address_space(1)))
#define LAS __attribute__((address_space(3)))
typedef GAS h16 gh16; typedef GAS float gf32; typedef GAS unsigned gu32; typedef GAS unsigned char gu8;
typedef LAS h16 lh16; typedef LAS float lf32; typedef LAS unsigned lu32; typedef LAS unsigned char lu8;
#define DEVI __device__ __forceinline__
DEVI int ogw();
DEVI int otid() { int t = threadIdx.x; asm volatile("" : "+v"(t)); return t; }

constexpr int NB = 8, SEQ = 2048, DM = 1024, NT = NB * SEQ, INC = 3976, MYC = 4096;
constexpr float LOG2E = 1.4426950408889634f;
constexpr float EPS = 1e-6f;

DEVI int ogw() { return blockIdx.x * 8 + (otid() >> 6); }
__host__ __device__ constexpr int ref_col(int my) {
    if (my < 352) return my;
    if (my < 384) return -1;
    if (my < 640) return 352 + (my - 384);
    if (my < 896) return 1376 + (my - 640);
    if (my < 1152) return 2696 + (my - 896);
    if (my < 1408) return 3720 + (my - 1152);
    if (my < 1664) return 608 + (my - 1408);
    if (my < 1920) return 864 + (my - 1664);
    if (my < 2176) return 1632 + (my - 1920);
    if (my < 2432) return 1888 + (my - 2176);
    if (my < 2688) return 2952 + (my - 2432);
    if (my < 2944) return 3208 + (my - 2688);
    if (my < 3200) return 1120 + (my - 2944);
    if (my < 3456) return 2144 + (my - 3200);
    if (my < 3712) return 3464 + (my - 3456);
    if (my < 3968) return 2400 + (my - 3712);
    if (my < 4000) return 2656 + (my - 3968);
    if (my < 4008) return 2688 + (my - 4000);
    return -1;
}

constexpr size_t MiB = 1024 * 1024;
constexpr size_t OFF_CTL = 0;
constexpr size_t OFF_RSTD = 64 * 1024;
constexpr size_t OFF_BIAS = 128 * 1024;
constexpr size_t OFF_COS = 256 * 1024;
constexpr size_t OFF_SIN = 384 * 1024;
constexpr size_t OFF_CA = 1 * MiB;
constexpr size_t OFF_GATE = OFF_CA + 12 * MiB;
constexpr size_t OFF_QB = OFF_GATE + 32 * MiB;
constexpr size_t OFF_QC = OFF_QB + 8 * MiB;
constexpr size_t OFF_QD = OFF_QC + 8 * MiB;
constexpr size_t OFF_KFB = OFF_QD + 8 * MiB;
constexpr size_t OFF_KFC = OFF_KFB + 24 * MiB;
constexpr size_t OFF_KFD = OFF_KFC + 8 * MiB;
constexpr size_t OFF_IDX = OFF_KFD + 8 * MiB;
constexpr size_t OFF_KIF = OFF_IDX + 10 * MiB;
constexpr size_t OFF_MIX = OFF_KIF + 1 * MiB;
constexpr size_t OFF_VTMP = OFF_MIX;
constexpr size_t OFF_MASK = OFF_MIX + 32 * MiB;
constexpr size_t OFF_H16 = OFF_MASK + 4 * MiB;
constexpr size_t OFF_QA = OFF_H16;
constexpr size_t OFF_KFA = OFF_QA + 12 * MiB;
constexpr size_t OFF_KRF = OFF_KFA + 8 * MiB;
constexpr size_t OFF_VFA = OFF_KRF + 1 * MiB;
constexpr size_t OFF_WINT = OFF_H16 + 32 * MiB;
constexpr size_t OFF_WOUTT = OFF_WINT + 16 * MiB;
constexpr size_t OFF_WUQT = OFF_WOUTT + 4 * MiB;
constexpr size_t OFF_WUKVT = OFF_WUQT + 512 * 1024;
constexpr size_t OFF_VF = OFF_WUKVT + 512 * 1024;
constexpr size_t OFF_END = OFF_VF + 40 * MiB;
static_assert(OFF_END <= 256 * MiB, "ws map");

struct Route { int kind; size_t off; int dcol; int pitch; float scale; int silu; };
__host__ __device__ inline Route route(int my) {
    Route r{-1, 0, 0, 0, 1.f, 0};
    if (my < 384) { r.kind = 0; r.off = OFF_CA; r.dcol = my; r.pitch = 384; }
    else if (my < 1408) { r.kind = 0; r.off = OFF_GATE; r.dcol = my - 384; r.pitch = 1024; r.silu = 1; }
    else if (my < 1664) { r.kind = 0; r.off = OFF_QB; r.dcol = my - 1408; r.pitch = 256; r.scale = 0.125f * LOG2E; }
    else if (my < 1920) { r.kind = 2; r.off = OFF_KFB; r.dcol = my - 1664; }
    else if (my < 2176) { r.kind = 0; r.off = OFF_QC; r.dcol = my - 1920; r.pitch = 256; r.scale = 0.125f * LOG2E; }
    else if (my < 2432) { r.kind = 1; r.off = OFF_KFC; r.dcol = my - 2176; }
    else if (my < 2688) { r.kind = 0; r.off = OFF_QD; r.dcol = my - 2432; r.pitch = 256; r.scale = 0.17677669529663687f * LOG2E; }
    else if (my < 2944) { r.kind = 1; r.off = OFF_KFD; r.dcol = my - 2688; }
    else if (my < 3712) { r.kind = 0; r.off = OFF_VTMP; r.dcol = my - 2944; r.pitch = 768; }
    else if (my < 3968) { r.kind = 0; r.off = OFF_IDX; r.dcol = my - 3712; r.pitch = 320; r.scale = 0.17677669529663687f; }
    else if (my < 4000) { r.kind = 3; r.off = OFF_KIF; r.dcol = my - 3968; }
    else if (my < 4032) { r.kind = 0; r.off = OFF_IDX; r.dcol = my - 3712; r.pitch = 320; }
    return r;
}
DEVI size_t kf_off(int bh, int s, int d0) { return ((((size_t)bh * 64 + (s >> 5)) * 4 + (d0 >> 4)) * 64 + (s & 31) + 32 * ((d0 >> 3) & 1)) * 8; }
DEVI size_t kf4_off(int bh, int s, int d0) { const int pp = s >> 2, r4 = s & 3; return (((((size_t)bh * 4 + r4) * 16 + (pp >> 5)) * 4 + (d0 >> 4)) * 64 + (pp & 31) + 32 * ((d0 >> 3) & 1)) * 8; }
DEVI size_t kf16_off(int bh, int s, int d0) { const int pp = s >> 4, r = s & 15; return (((((size_t)bh * 16 + r) * 4 + (pp >> 5)) * 4 + (d0 >> 4)) * 64 + (pp & 31) + 32 * ((d0 >> 3) & 1)) * 8; }
DEVI size_t mixf_off(size_t tok, int c0) { return ((((tok >> 5) * 64 + (size_t)(c0 >> 4)) * 64 + (tok & 31) + 32 * ((c0 >> 3) & 1)) * 8) + (c0 & 7); }
constexpr size_t FSZ = (size_t)32 * 64 * 4 * 64 * 8;

__device__ __constant__ int kBucketStart[16] = {16, 22, 30, 40, 54, 73, 99, 134, 182, 246, 332, 450, 609, 825, 1117, 1513};
DEVI int t5_bucket(int n) {
    if (n < 16) return n;
    int b = 16;
#pragma unroll
    for (int j = 1; j < 16; ++j) b += (n >= kBucketStart[j]) ? 1 : 0;
    return b;
}


#define XB_TMO      128
#define XB_XCNT(j)  (256  + 64 * (j))
#define XB_XSUB(j)  (1280 + 64 * (j))
#define XB_XGEN(j)  (2304 + 64 * (j))
#define XB_TOP      3328
#define XB_TOPGEN   3392
#define XCD_BAR_WORDS 3456
#define XB_SPIN_CAP (1u << 18)
__device__ __forceinline__ unsigned xb_ld(unsigned* p)              { return __hip_atomic_load(p, __ATOMIC_RELAXED, __HIP_MEMORY_SCOPE_AGENT); }
__device__ __forceinline__ unsigned xb_add(unsigned* p, unsigned v) { return __hip_atomic_fetch_add(p, v, __ATOMIC_RELAXED, __HIP_MEMORY_SCOPE_AGENT); }
__device__ __forceinline__ unsigned xb_xcc_id() { return (unsigned)__builtin_amdgcn_s_getreg((3 << 11) | 20) & 0xFu; }
#define XB_SPIN(cond, bar) do { unsigned _sp = 0; while (cond) { __builtin_amdgcn_s_sleep(1); \
    if ((++_sp & 255u) == 0u) { if (xb_ld(&(bar)[XB_TMO])) break; if (_sp > XB_SPIN_CAP) { atomicAdd(&(bar)[XB_TMO], 1u); break; } } } } while (0)
struct XcdBarrier { unsigned* bar; unsigned x; volatile LAS unsigned* st; };
__device__ __forceinline__ XcdBarrier xcd_barrier_post(unsigned* bar, volatile LAS unsigned* st) {
    XcdBarrier b; b.bar = bar; b.x = xb_xcc_id(); b.st = st;
    if (threadIdx.x == 0) (void)xb_add(&bar[XB_XCNT(b.x)], 1u);
    return b;
}
__device__ __forceinline__ void xcd_barrier_complete(unsigned* bar, unsigned x, unsigned& nloc, unsigned& nx) {
    const unsigned G = gridDim.x * gridDim.y * gridDim.z;
    unsigned sum, cnt, mine, sp = 0u;
    for (;;) {
        sum = 0u; cnt = 0u; mine = 0u;
#pragma unroll
        for (unsigned j = 0; j < 16; ++j) { const unsigned c = xb_ld(&bar[XB_XCNT(j)]); sum += c; cnt += (c > 0u) ? 1u : 0u; mine = (j == x) ? c : mine; }
        if (sum == G) break;
        __builtin_amdgcn_s_sleep(1);
        if ((++sp & 255u) == 0u) { if (xb_ld(&bar[XB_TMO])) break; if (sp > XB_SPIN_CAP) { atomicAdd(&bar[XB_TMO], 1u); break; } }
    }
    nloc = mine > 0u ? mine : 1u; nx = cnt > 0u ? cnt : 1u;
}
__device__ __forceinline__ void xcd_barrier(const XcdBarrier& b) {
    asm volatile("s_waitcnt vmcnt(0)" ::: "memory");
    __syncthreads();
    if (otid() == 0) {
        unsigned* bar = b.bar; unsigned bx = b.x; asm volatile("" : "+s"(bx));
        __builtin_amdgcn_s_waitcnt(0);
        unsigned nloc = b.st[0], nx = b.st[1];
        if (nloc == 0u) { xcd_barrier_complete(bar, bx, nloc, nx); b.st[0] = nloc; b.st[1] = nx; }
        const unsigned old = xb_add(&bar[XB_XSUB(bx)], 1u);
        const unsigned gen = old / nloc;
        if (old + 1u == (gen + 1u) * nloc) {
            __builtin_amdgcn_fence(__ATOMIC_RELEASE, "agent");
            asm volatile("s_waitcnt vmcnt(0)" ::: "memory");
            const unsigned og = xb_add(&bar[XB_TOP], 1u);
            const unsigned tg = og / nx;
            if (og + 1u == (tg + 1u) * nx) xb_add(&bar[XB_TOPGEN], 1u);
            else XB_SPIN(xb_ld(&bar[XB_TOPGEN]) == tg, bar);
            __builtin_amdgcn_fence(__ATOMIC_ACQUIRE, "agent");
            xb_add(&bar[XB_XGEN(bx)], 1u);
            asm volatile("s_waitcnt vmcnt(0)" ::: "memory");
        } else {
            XB_SPIN(xb_ld(&bar[XB_XGEN(bx)]) == gen, bar);
            __builtin_amdgcn_fence(__ATOMIC_ACQUIRE, "agent");
            asm volatile("s_waitcnt vmcnt(0)" ::: "memory");
        }
    }
    __syncthreads();
}

namespace pg8 {
#define PG8_LAS __attribute__((address_space(3)))
typedef unsigned short bf16_t;
typedef _Float16 f16x8 __attribute__((ext_vector_type(8)));
typedef float f32x4 __attribute__((ext_vector_type(4)));
typedef unsigned u32x4 __attribute__((ext_vector_type(4)));
constexpr int BM = 256, BK = 64, HALF = 128, HTB = HALF * BK * 2  , STAGE_BYTES = 8 * HTB, NXCD = 8, WGM = 8;

__host__ __device__ __forceinline__ int lds_byte(int r, int c) { const int st = (r >> 4) * 2 + (c >> 5), rr = r & 15, cc = c & 31, ob = rr * 64 + cc * 2; return st * 1024 + (ob ^ (((ob >> 9) & 1) << 5)); }
__host__ __device__ __forceinline__ void stage_rc(int b, int& R, int& C) { const int st = b / 1024, sb = b % 1024, swz = sb ^ (((sb >> 9) & 1) << 5); R = (st >> 1) * 16 + swz / 64; C = (st & 1) * 32 + (swz % 64) / 2; }
__host__ __device__ __forceinline__ int perm32(int rho) { const int n = rho >> 4, i = rho & 15; return 8 * (i >> 2) + 4 * n + (i & 3); }

struct Unit { int pm, pn; };
struct Gemm { const bf16_t* A; const bf16_t* Bt; int M, N, K; };

struct StaticOrder {
    int nM, nN, nwg, G, c;
    __host__ __device__ void init(int M, int N, int G_, int c_) { nM = M / BM; nN = N / BM; nwg = nM * nN; G = G_; c = c_; }
    __host__ __device__ bool next(int i, Unit& u) const {
        const long L = (long)i * G + c; if (L >= nwg) return false;
        int wgid = (int)L; { const int q = nwg / NXCD, r = nwg % NXCD, xcd = wgid % NXCD, off = wgid / NXCD; wgid = (xcd < r ? xcd * (q + 1) : r * (q + 1) + (xcd - r) * q) + off; }
        const int nig = WGM * nN, gid = wgid / nig, fm = gid * WGM, gsz = (nM - fm) < WGM ? (nM - fm) : WGM;
        u.pm = fm + ((wgid % nig) % gsz); u.pn = (wgid % nig) / gsz; return true;
    }
    __device__ __forceinline__ void a_ready(const Unit&) const {}
    __device__ __forceinline__ void done(const Unit&) const {}
};

template <class Epi, class Sched, bool ALIGN_EPI = false, bool SP2 = false>
__device__ __forceinline__ void gemm_phase(PG8_LAS unsigned char* lds, const Gemm g, const Sched& S, const Epi& E) {
    const int tid = otid(), wid = __builtin_amdgcn_readfirstlane(tid >> 6), lane = tid & 63, wr = wid >> 2, wc = wid & 3, fr = lane & 15, fq = lane >> 4;
    const int K = g.K, nt = K / BK;
    unsigned voffA[2], voffB[2];
#pragma unroll
    for (int i = 0; i < 2; ++i) { int R, C; stage_rc(tid * 16 + i * 8192, R, C); const int Rb = Epi::PERM ? ((R & ~31) + perm32(R & 31)) : R;
        voffA[i] = (unsigned)(R * K + C) * 2u; voffB[i] = (unsigned)(Rb * K + C) * 2u; }
    const size_t kstep = (size_t)(BK * 2);
    const size_t hstep = (size_t)HALF * K * 2;
    const size_t tstep = 2 * hstep;
    const unsigned ldsw = (unsigned)wid * 1024u;
    const int aoff = lds_byte(wr * 64 + fr, fq * 8), boff = lds_byte(wc * 32 + fr, fq * 8);
#define PG8_SA(b, h) (((b) * 2 + (h)) * HTB)
#define PG8_SB(b, h) ((4 + (b) * 2 + (h)) * HTB)
#define PG8_STAGE(bufoff, gbase, voff) do { _Pragma("unroll") for (int _i = 0; _i < 2; ++_i) \
        __builtin_amdgcn_global_load_lds((const unsigned*)((const char*)(gbase) + (voff)[_i]), (PG8_LAS unsigned*)(lds + (bufoff) + ldsw + _i * 8192), 16, 0, 0); } while (0)
#define PG8_LDA(dst, b, h) do { _Pragma("unroll") for (int m = 0; m < 4; ++m) _Pragma("unroll") for (int k = 0; k < 2; ++k) dst[m][k] = *(const PG8_LAS f16x8*)(lds + PG8_SA(b, h) + aoff + m * 2048 + k * 1024); } while (0)
#define PG8_LDB(dst, b, h) do { _Pragma("unroll") for (int n = 0; n < 2; ++n) _Pragma("unroll") for (int k = 0; k < 2; ++k) dst[n][k] = *(const PG8_LAS f16x8*)(lds + PG8_SB(b, h) + boff + n * 2048 + k * 1024); } while (0)
#define PG8_MMA(ai, bj, At, Bt) do { __builtin_amdgcn_s_setprio(1); _Pragma("unroll") for (int m = 0; m < 4; ++m) _Pragma("unroll") for (int n = 0; n < 2; ++n) _Pragma("unroll") for (int k = 0; k < 2; ++k) \
        acc[ai][bj][m][n] = __builtin_amdgcn_mfma_f32_16x16x32_f16(Bt[n][k], At[m][k], acc[ai][bj][m][n], 0, 0, 0); __builtin_amdgcn_s_setprio(0); } while (0)
#define PG8_WAIT_V(n) asm volatile("s_waitcnt vmcnt(" #n ")" ::: "memory")
#define PG8_WAIT_L(n) asm volatile("s_waitcnt lgkmcnt(" #n ")" ::: "memory")
#define PG8_BAR __builtin_amdgcn_s_barrier()
#define PG8_SCHED __builtin_amdgcn_sched_barrier(0)
    Unit cur, nxt; int ui = 0;
    if (!S.next(0, cur)) return;
    f32x4 acc[2][2][4][2];
#pragma unroll
    for (int a = 0; a < 2; ++a)
#pragma unroll
        for (int b = 0; b < 2; ++b)
#pragma unroll
            for (int m = 0; m < 4; ++m)
#pragma unroll
                for (int n = 0; n < 2; ++n) acc[a][b][m][n] = (f32x4){0.f, 0.f, 0.f, 0.f};
    f16x8 At[4][2], B0[2][2], B1[2][2];
    const char* cA = (const char*)g.A + (size_t)cur.pm * tstep; const char* cB = (const char*)g.Bt + (size_t)cur.pn * tstep;
    S.a_ready(cur);
    if constexpr (SP2) {
        PG8_STAGE(PG8_SB(0, 0), cB, voffB); PG8_STAGE(PG8_SB(0, 1), cB + hstep, voffB); PG8_STAGE(PG8_SA(0, 0), cA, voffA); PG8_STAGE(PG8_SA(0, 1), cA + hstep, voffA);
        if (wr == 1) PG8_BAR;
        PG8_WAIT_V(2); PG8_BAR;
        PG8_STAGE(PG8_SB(1, 0), cB + kstep, voffB); PG8_STAGE(PG8_SA(1, 0), cA + kstep, voffA); PG8_STAGE(PG8_SB(1, 1), cB + hstep + kstep, voffB);
        PG8_WAIT_V(6); PG8_BAR;
    } else {
        PG8_STAGE(PG8_SB(0, 0), cB, voffB); PG8_STAGE(PG8_SA(0, 0), cA, voffA); PG8_STAGE(PG8_SB(0, 1), cB + hstep, voffB); PG8_STAGE(PG8_SA(0, 1), cA + hstep, voffA);
        if (wr == 1) PG8_BAR;
        PG8_WAIT_V(4); PG8_BAR;
        PG8_STAGE(PG8_SB(1, 0), cB + kstep, voffB); PG8_STAGE(PG8_SA(1, 0), cA + kstep, voffA); PG8_STAGE(PG8_SB(1, 1), cB + hstep + kstep, voffB);
        PG8_WAIT_V(6); PG8_BAR;
    }
    for (;;) {
        const bool has_next = S.next(ui + 1, nxt);
        const char* nA = has_next ? (const char*)g.A + (size_t)nxt.pm * tstep : cA; const char* nB = has_next ? (const char*)g.Bt + (size_t)nxt.pn * tstep : cB;
        for (int t = 0; t < nt; t += 2) {
            const bool last = (t == nt - 2);
            const char* a1 = cA + (size_t)(t + 1) * kstep;
            const char* a2 = last ? nA : cA + (size_t)(t + 2) * kstep; const char* b2 = last ? nB : cB + (size_t)(t + 2) * kstep;
            const char* a3 = a2 + kstep; const char* b3 = b2 + kstep;
            if (last && has_next) S.a_ready(nxt);
            if constexpr (SP2) {
            PG8_LDB(B0, 0, 0); PG8_LDB(B1, 0, 1); PG8_SCHED; PG8_LDA(At, 0, 0); PG8_STAGE(PG8_SA(1, 1), a1 + hstep, voffA);
            PG8_WAIT_V(8); PG8_WAIT_L(0); PG8_BAR; PG8_MMA(0, 0, At, B0); PG8_MMA(0, 1, At, B1); PG8_BAR; PG8_SCHED;
            PG8_LDA(At, 0, 1); PG8_STAGE(PG8_SB(0, 0), b2, voffB); PG8_STAGE(PG8_SB(0, 1), b2 + hstep, voffB); PG8_STAGE(PG8_SA(0, 0), a2, voffA);
            PG8_WAIT_V(8); PG8_WAIT_L(0); PG8_BAR; PG8_MMA(1, 0, At, B0); PG8_MMA(1, 1, At, B1); PG8_BAR; PG8_SCHED;
            PG8_LDB(B0, 1, 0); PG8_LDB(B1, 1, 1); PG8_SCHED; PG8_LDA(At, 1, 0); PG8_STAGE(PG8_SA(0, 1), a2 + hstep, voffA);
            PG8_WAIT_V(8); PG8_WAIT_L(0); PG8_BAR; PG8_MMA(0, 0, At, B0); PG8_MMA(0, 1, At, B1); PG8_BAR; PG8_SCHED;
            PG8_LDA(At, 1, 1); PG8_STAGE(PG8_SB(1, 0), b3, voffB); PG8_STAGE(PG8_SB(1, 1), b3 + hstep, voffB); PG8_STAGE(PG8_SA(1, 0), a3, voffA);
            PG8_WAIT_V(8); PG8_WAIT_L(0); PG8_BAR; PG8_MMA(1, 0, At, B0); PG8_MMA(1, 1, At, B1); PG8_BAR; PG8_SCHED;
            } else {
            PG8_LDB(B0, 0, 0); PG8_SCHED; PG8_LDA(At, 0, 0); PG8_STAGE(PG8_SA(1, 1), a1 + hstep, voffA);
            PG8_WAIT_L(8); PG8_BAR; PG8_WAIT_L(0); PG8_MMA(0, 0, At, B0); PG8_BAR; PG8_SCHED;
            PG8_LDB(B1, 0, 1); PG8_STAGE(PG8_SB(0, 0), b2, voffB);
            PG8_BAR; PG8_WAIT_L(0); PG8_MMA(0, 1, At, B1); PG8_BAR;
            PG8_LDA(At, 0, 1); PG8_STAGE(PG8_SA(0, 0), a2, voffA);
            PG8_BAR; PG8_WAIT_L(0); PG8_MMA(1, 0, At, B0); PG8_BAR; PG8_SCHED;
            PG8_STAGE(PG8_SB(0, 1), b2 + hstep, voffB);
            PG8_WAIT_V(6); PG8_BAR; PG8_MMA(1, 1, At, B1); PG8_BAR;
            PG8_LDB(B0, 1, 0); PG8_SCHED; PG8_LDA(At, 1, 0); PG8_STAGE(PG8_SA(0, 1), a2 + hstep, voffA);
            PG8_WAIT_L(8); PG8_BAR; PG8_WAIT_L(0); PG8_MMA(0, 0, At, B0); PG8_BAR; PG8_SCHED;
            PG8_LDB(B1, 1, 1); PG8_STAGE(PG8_SB(1, 0), b3, voffB);
            PG8_BAR; PG8_WAIT_L(0); PG8_MMA(0, 1, At, B1); PG8_BAR;
            PG8_LDA(At, 1, 1); PG8_STAGE(PG8_SA(1, 0), a3, voffA);
            PG8_BAR; PG8_WAIT_L(0); PG8_MMA(1, 0, At, B0); PG8_BAR; PG8_SCHED;
            PG8_STAGE(PG8_SB(1, 1), b3 + hstep, voffB);
            PG8_WAIT_V(6); PG8_BAR; PG8_MMA(1, 1, At, B1); PG8_BAR;
            }
        }
        if constexpr (ALIGN_EPI) { if (wr == 0) PG8_BAR; }
        if constexpr (!Epi::AFTER_DRAIN) { E(acc, cur, wr, wc, fr, fq); S.done(cur); }
        if (!has_next) break;
#pragma unroll
        for (int a = 0; a < 2; ++a)
#pragma unroll
            for (int b = 0; b < 2; ++b)
#pragma unroll
                for (int m = 0; m < 4; ++m)
#pragma unroll
                    for (int n = 0; n < 2; ++n) acc[a][b][m][n] = (f32x4){0.f, 0.f, 0.f, 0.f};
        cur = nxt; cA = nA; cB = nB; ++ui;
        if constexpr (ALIGN_EPI) { if (wr == 1) PG8_BAR; }
    }
    PG8_WAIT_V(0);
    if constexpr (!ALIGN_EPI) { if (wr == 0) PG8_BAR; }
    PG8_BAR;
    if constexpr (Epi::AFTER_DRAIN) { E.fused(acc, cur, wr, wc, fr, fq, lds, wid, lane); S.done(cur); }
#undef PG8_SA
#undef PG8_SB
#undef PG8_STAGE
#undef PG8_LDA
#undef PG8_LDB
#undef PG8_MMA
#undef PG8_WAIT_V
#undef PG8_WAIT_L
#undef PG8_BAR
#undef PG8_SCHED
}
}


typedef float f32x4_t __attribute__((ext_vector_type(4)));
typedef _Float16 h16x8 __attribute__((ext_vector_type(8)));
DEVI float silu_f(float v) { return v / (1.f + __expf(-v)); }
struct EpiRoute {
    static constexpr bool PERM = true, AFTER_DRAIN = false;
    gu8* ws; const gf32* rstd;
    DEVI void operator()(const pg8::f32x4 (&acc)[2][2][4][2], const pg8::Unit& u, int wr, int wc, int fr, int fq) const {
        const int row0 = u.pm * 256 + wr * 64 + fr;
        float rs[2][4];
#pragma unroll
        for (int ai = 0; ai < 2; ++ai)
#pragma unroll
            for (int m = 0; m < 4; ++m) rs[ai][m] = rstd[row0 + ai * 128 + m * 16];
#pragma unroll
        for (int bj = 0; bj < 2; ++bj) {
            const int cg = u.pn * 256 + bj * 128 + wc * 32;
            const Route r = route(cg);
            if (r.kind < 0) continue;
            gh16* base = (gh16*)(ws + r.off);
            const int c = r.dcol + 8 * fq;
#pragma unroll
            for (int ai = 0; ai < 2; ++ai)
#pragma unroll
                for (int m = 0; m < 4; ++m) {
                    const int row = row0 + ai * 128 + m * 16; const float sc = rs[ai][m] * r.scale;
                    float v[8];
#pragma unroll
                    for (int j = 0; j < 4; ++j) { v[j] = acc[ai][bj][m][0][j] * sc; v[4 + j] = acc[ai][bj][m][1][j] * sc; }
                    if (r.silu) {
#pragma unroll
                        for (int j = 0; j < 8; ++j) v[j] = silu_f(v[j]);
                    }
                    h16x8 o;
#pragma unroll
                    for (int j = 0; j < 8; ++j) o[j] = (h16)v[j];
                    if (r.kind == 0) *(GAS h16x8*)(base + (size_t)row * r.pitch + c) = o;
                    else {
                        const int b = row >> 11, sq = row & 2047;
                        if (r.kind == 3) *(GAS h16x8*)(base + ((((size_t)b * 64 + (sq >> 5)) * 2 + (c >> 4)) * 64 + (sq & 31) + 32 * ((c >> 3) & 1)) * 8) = o;
                        else {
                            const int bh = b * 4 + (c >> 6), d0 = c & 63;
                            *(GAS h16x8*)(base + kf_off(bh, sq, d0)) = o;
                            if (r.kind == 2) { *(GAS h16x8*)(base + FSZ + kf4_off(bh, sq, d0)) = o; *(GAS h16x8*)(base + 2 * FSZ + kf16_off(bh, sq, d0)) = o; }
                        }
                    }
                }
        }
    }
};

constexpr int NTHR = 512, NWAVE = 8;

template <bool REF>
DEVI void cvt_transpose(const gf32* __restrict__ src, int src_pitch, const gf32* __restrict__ g, gh16* dst, int N, int K, lu8* lds, int item0, int nitems_total, int& item_base) {
    const int tid = otid();
    LAS float (*tile)[65] = (LAS float (*)[65])lds;
    const int ntn = N / 64, ntk = K / 64, n_it = ntn * ntk;
    for (int it = item0; it < nitems_total; it += gridDim.x) {
        const int li = it - item_base; if (li < 0 || li >= n_it) continue;
        const int n0 = (li % ntn) * 64, k0 = (li / ntn) * 64;
        __syncthreads();
        const int c = tid & 63; int rc = n0 + c; if (REF) rc = ref_col(rc);
#pragma unroll
        for (int ps = 0; ps < 8; ++ps) { const int k = ps * 8 + (tid >> 6);
            tile[k][c] = rc >= 0 ? src[(size_t)(k0 + k) * src_pitch + rc] * (g ? g[k0 + k] : 1.f) : 0.f; }
        __syncthreads();
        const int cc = tid >> 3, kq = (tid & 7) * 8;
        h16x8 o;
#pragma unroll
        for (int j = 0; j < 8; ++j) o[j] = (h16)tile[kq + j][cc];
        *(GAS h16x8*)(dst + (size_t)(n0 + cc) * K + k0 + kq) = o;
    }
    item_base += n_it;
}

DEVI void ph_rowstat_cvt(const gf32* h, gf32* rstd, gh16* h16o) {
    const int t_ = otid(); const int lane = t_ & 63, gw = blockIdx.x * NWAVE + (t_ >> 6), nw = gridDim.x * NWAVE;
    for (int row = gw; row < NT; row += nw) {
        const GAS f32x4_t* p = (const GAS f32x4_t*)(h + (size_t)row * DM);
        float s = 0.f;
#pragma unroll
        for (int i = 0; i < 4; ++i) { f32x4_t v = p[lane + 64 * i]; s += v[0] * v[0] + v[1] * v[1] + v[2] * v[2] + v[3] * v[3];
            typedef _Float16 h16x4 __attribute__((ext_vector_type(4)));
            h16x4 o; o[0] = (h16)v[0]; o[1] = (h16)v[1]; o[2] = (h16)v[2]; o[3] = (h16)v[3];
            *(GAS h16x4*)(h16o + (size_t)row * DM + (lane + 64 * i) * 4) = o; }
        for (int o = 32; o; o >>= 1) s += __shfl_xor(s, o);
        if (lane == 0) rstd[row] = rsqrtf(s / DM + EPS);
    }
}

typedef float f32x16 __attribute__((ext_vector_type(16)));
typedef _Float16 h16x4 __attribute__((ext_vector_type(4)));
DEVI f32x16 mfma32(h16x8 a, h16x8 b, f32x16 c) { return __builtin_amdgcn_mfma_f32_32x32x16_f16(a, b, c, 0, 0, 0); }
#define CROW(r) (((r) & 3) + 8 * ((r) >> 2))
DEVI float xh_max(float x) { auto r = __builtin_amdgcn_permlane32_swap(__float_as_uint(x), __float_as_uint(x), false, false); return fmaxf(__uint_as_float(r[0]), __uint_as_float(r[1])); }
DEVI float xh_sum(float x) { auto r = __builtin_amdgcn_permlane32_swap(__float_as_uint(x), __float_as_uint(x), false, false); return __uint_as_float(r[0]) + __uint_as_float(r[1]); }
DEVI unsigned pk2h(float a, float b) { auto v = __builtin_amdgcn_cvt_pkrtz(a, b); return __builtin_bit_cast(unsigned, v); }
DEVI h16x8 pack8(const f32x16& p, int s) {
    typedef unsigned u32x4_t __attribute__((ext_vector_type(4)));
    u32x4_t w;
    w[0] = pk2h(p[8 * s + 0], p[8 * s + 1]); w[1] = pk2h(p[8 * s + 2], p[8 * s + 3]); w[2] = pk2h(p[8 * s + 4], p[8 * s + 5]); w[3] = pk2h(p[8 * s + 6], p[8 * s + 7]);
    return __builtin_bit_cast(h16x8, w);
}
DEVI h16x8 ldv8(const gh16* p) {
    h16x4 a = *(const GAS h16x4*)p, b = *(const GAS h16x4*)(p + 8);
    h16x8 r; r[0] = a[0]; r[1] = a[1]; r[2] = a[2]; r[3] = a[3]; r[4] = b[0]; r[5] = b[1]; r[6] = b[2]; r[7] = b[3]; return r;
}
DEVI void softmax_tile(f32x16& S, float& m, float& l, f32x16& O0, f32x16& O1) {
    float mx = S[0];
#pragma unroll
    for (int r = 1; r < 16; ++r) mx = fmaxf(mx, S[r]);
    mx = xh_max(mx);
    if (__any(mx > m)) {
        const float mn = fmaxf(m, mx), al = __builtin_amdgcn_exp2f(m - mn);
        l *= al; O0 *= al; O1 *= al; m = mn;
    }
    float ls = 0.f;
#pragma unroll
    for (int r = 0; r < 16; ++r) { S[r] = __builtin_amdgcn_exp2f(S[r] - m); ls += S[r]; }
    l += ls;
}
DEVI int wq_next(gu32* ctr) {
    int e = 0;
    if ((otid() & 63) == 0) e = (int)__hip_atomic_fetch_add(ctr, 1u, __ATOMIC_RELAXED, __HIP_MEMORY_SCOPE_AGENT);
    return __builtin_amdgcn_readfirstlane(e);
}

DEVI void flashA_item(int b, int hh, int qt, const gh16* qA, const gh16* KF, const gh16* KRF, const gh16* VF, const gh16* gate, gh16* mix) {
    const int lane = otid() & 63, q = lane & 31, h = lane >> 5;
    const size_t tokq = (size_t)b * SEQ + qt * 32 + q;
    h16x8 qf[6];
#pragma unroll
    for (int ks = 0; ks < 6; ++ks) qf[ks] = *(const GAS h16x8*)(qA + tokq * 384 + hh * 96 + ks * 16 + 8 * h);
    f32x16 O0 = {}, O1 = {};
    float m = -1e30f, l = 0.f;
    const gh16* kp = KF + (size_t)(b * 4 + hh) * 64 * 2048 + lane * 8;
    const gh16* rp = KRF + (size_t)b * 64 * 1024 + lane * 8;
    const gh16* vp = VF + (size_t)(b * 4 + hh) * 64 * 2048 + lane * 8;
    h16x8 kf[6];
#pragma unroll
    for (int ks = 0; ks < 4; ++ks) kf[ks] = *(const GAS h16x8*)(kp + ks * 512);
#pragma unroll
    for (int ks = 0; ks < 2; ++ks) kf[4 + ks] = *(const GAS h16x8*)(rp + ks * 512);
    for (int j = 0; j <= qt; ++j) {
        h16x8 vf[4];
#pragma unroll
        for (int f = 0; f < 4; ++f) vf[f] = *(const GAS h16x8*)(vp + (size_t)j * 2048 + f * 512);
        f32x16 S = {};
#pragma unroll
        for (int ks = 0; ks < 6; ++ks) S = mfma32(kf[ks], qf[ks], S);
        if (j < qt) {
#pragma unroll
            for (int ks = 0; ks < 4; ++ks) kf[ks] = *(const GAS h16x8*)(kp + (size_t)(j + 1) * 2048 + ks * 512);
#pragma unroll
            for (int ks = 0; ks < 2; ++ks) kf[4 + ks] = *(const GAS h16x8*)(rp + (size_t)(j + 1) * 1024 + ks * 512);
        } else {
#pragma unroll
            for (int r = 0; r < 16; ++r) S[r] = (CROW(r) + 4 * h > q) ? -3e38f : S[r];
        }
        softmax_tile(S, m, l, O0, O1);
        const h16x8 p0 = pack8(S, 0), p1 = pack8(S, 1);
        O0 = mfma32(vf[0], p0, O0); O0 = mfma32(vf[1], p1, O0);
        O1 = mfma32(vf[2], p0, O1); O1 = mfma32(vf[3], p1, O1);
    }
    const float il = 1.f / xh_sum(l);
    const gh16* gp = gate + tokq * 1024 + hh * 64 + 4 * h;
#pragma unroll
    for (int db = 0; db < 2; ++db)
#pragma unroll
        for (int g = 0; g < 4; ++g) {
            const h16x4 gv = *(const GAS h16x4*)(gp + db * 32 + 8 * g); h16x4 o;
#pragma unroll
            for (int e = 0; e < 4; ++e) o[e] = (h16)((db ? O1[4 * g + e] : O0[4 * g + e]) * il * (float)gv[e]);
            *(GAS h16x4*)(mix + mixf_off(tokq, hh * 64 + db * 32 + 8 * g + 4 * h)) = o;
        }
}

constexpr int L_NEAR = 0, L_R3 = 12288, L_R2 = 15360, L_R1 = 21504, L_LAM = 39936, L_P2END = 40000;
DEVI void p2_setup(const gf32* biasTab, const gf32* lam_p, float lambda_init, lu8* lds) {
    const int tid = otid();
    lf32* nearR = (lf32*)(lds + L_NEAR);
    for (int i = tid; i < 12 * 256; i += NTHR) { const int hb = i >> 8, u = i & 255, tix = 223 - u; nearR[i] = tix < 0 ? -3e38f : biasTab[hb * 2048 + tix]; }
    lf32* R3 = (lf32*)(lds + L_R3); lf32* R2 = (lf32*)(lds + L_R2); lf32* R1 = (lf32*)(lds + L_R1);
    for (int i = tid; i < 4 * 192; i += NTHR) { const int hb = i / 192, kk = 159 - (i % 192); R3[i] = (kk < 0 || kk > 128) ? -3e38f : biasTab[hb * 2048 + kk * 16]; }
    for (int i = tid; i < 4 * 384; i += NTHR) { const int hb = i / 384, kk = 255 - (i % 384); R2[i] = (kk < 0 || kk > 128) ? -3e38f : biasTab[hb * 2048 + kk * 4]; }
    for (int i = tid; i < 4 * 1152; i += NTHR) { const int hb = i / 1152, kk = 639 - (i % 1152); R1[i] = (kk < 0 || kk > 128) ? -3e38f : biasTab[hb * 2048 + kk]; }
    if (tid == 0) { float a1 = 0.f, a2 = 0.f; for (int i = 0; i < 32; ++i) { a1 += lam_p[i] * lam_p[32 + i]; a2 += lam_p[64 + i] * lam_p[96 + i]; }
        *(lf32*)(lds + L_LAM) = expf(a1) - expf(a2) + lambda_init; }
    __syncthreads();
}

DEVI void ph_vtrans(const gh16* vtmp, gh16* VF, lu8* lds) {
    const int tid = otid();
    LAS h16 (*tile)[72] = (LAS h16 (*)[72])lds;
    for (int it = blockIdx.x; it < 3 * 32 * 4; it += gridDim.x) {
        const int src = it >> 7, bh = (it >> 2) & 31, blk = it & 3, b = bh >> 2, hh = bh & 3;
        __syncthreads();
#pragma unroll
        for (int k = 0; k < 8; ++k) { const int idx = k * NTHR + tid, row = idx >> 3, c8 = idx & 7;
            *(LAS h16x8*)&tile[row][c8 * 8] = *(const GAS h16x8*)(vtmp + ((size_t)b * SEQ + blk * 512 + row) * 768 + src * 256 + hh * 64 + c8 * 8); }
        __syncthreads();
        gh16* out0 = VF + (src == 0 ? 0 : (src == 1 ? 3 * FSZ : 4 * FSZ));
#pragma unroll 1
        for (int k = 0; k < 8; ++k) {
            const int fl = k * NTHR + tid, lane = fl & 63, frag = (fl >> 6) & 3, dl = lane & 31, hp = lane >> 5, db = frag >> 1, sk = frag & 1;
            {
                const int tl = fl >> 8; h16x8 o;
#pragma unroll
                for (int e = 0; e < 8; ++e) o[e] = tile[tl * 32 + 16 * sk + 8 * (e >> 2) + 4 * hp + (e & 3)][db * 32 + dl];
                *(GAS h16x8*)(out0 + ((((size_t)bh * 64 + blk * 16 + tl) * 4 + frag) * 64 + lane) * 8) = o;
            }
            if (src == 0) {
                {
                    const int r4 = fl >> 10, tl = (fl >> 8) & 3; h16x8 o;
#pragma unroll
                    for (int e = 0; e < 8; ++e) o[e] = tile[4 * (tl * 32 + 16 * sk + 8 * (e >> 2) + 4 * hp + (e & 3)) + r4][db * 32 + dl];
                    *(GAS h16x8*)(out0 + FSZ + (((((size_t)bh * 4 + r4) * 16 + blk * 4 + tl) * 4 + frag) * 64 + lane) * 8) = o;
                }
                {
                    const int r = fl >> 8; h16x8 o;
#pragma unroll
                    for (int e = 0; e < 8; ++e) o[e] = tile[16 * (16 * sk + 8 * (e >> 2) + 4 * hp + (e & 3)) + r][db * 32 + dl];
                    *(GAS h16x8*)(out0 + 2 * FSZ + (((((size_t)bh * 16 + r) * 4 + blk) * 4 + frag) * 64 + lane) * 8) = o;
                }
            }
        }
    }
}

template <int NMAP, bool MASK>
DEVI void flashCD_item(int b, int hh, int qt, int hb, const gh16* Q, const gh16* KF, const gh16* VF, const gu32* mask, const gf32* biasTab, const lu8* lds,
                       const gf32* subln, float lambda_init, const gh16* gate, gh16* mix, int mixcol) {
    constexpr int NKS = 4 / NMAP;
    const int lane = otid() & 63, q = lane & 31, h = lane >> 5;
    const size_t tokq = (size_t)b * SEQ + qt * 32 + q;
    const gh16* kp = KF + (size_t)(b * 4 + hh) * 64 * 2048 + lane * 8;
    const gh16* vp = VF + (size_t)(b * 4 + hh) * 64 * 2048 + lane * 8;
    h16x8 qf[NMAP][NKS], kf[NMAP][NKS];
#pragma unroll
    for (int mp = 0; mp < NMAP; ++mp)
#pragma unroll
        for (int ks = 0; ks < NKS; ++ks) {
            qf[mp][ks] = *(const GAS h16x8*)(Q + tokq * 256 + hh * 64 + (mp * NKS + ks) * 16 + 8 * h);
            kf[mp][ks] = *(const GAS h16x8*)(kp + (mp * NKS + ks) * 512);
        }
    f32x16 O[NMAP][2]; float m[NMAP], l[NMAP];
#pragma unroll
    for (int mp = 0; mp < NMAP; ++mp) { O[mp][0] = (f32x16){}; O[mp][1] = (f32x16){}; m[mp] = -1e30f; l[mp] = 0.f; }
    const lf32* nearR = (const lf32*)(lds + L_NEAR) + hb * 256;
    const gf32* bt = biasTab + hb * 2048;
    for (int j = 0; j <= qt; ++j) {
        h16x8 vf[2][2];
#pragma unroll
        for (int db = 0; db < 2; ++db)
#pragma unroll
            for (int sk = 0; sk < 2; ++sk) vf[db][sk] = *(const GAS h16x8*)(vp + (size_t)j * 2048 + (db * 2 + sk) * 512);
        unsigned mw = 0xffffffffu;
        if (MASK) mw = mask[tokq * 64 + j] >> (4 * h);
        f32x16 S[NMAP];
#pragma unroll
        for (int mp = 0; mp < NMAP; ++mp) { S[mp] = (f32x16){};
#pragma unroll
            for (int ks = 0; ks < NKS; ++ks) S[mp] = mfma32(kf[mp][ks], qf[mp][ks], S[mp]); }
        if (j < qt) {
#pragma unroll
            for (int mp = 0; mp < NMAP; ++mp)
#pragma unroll
                for (int ks = 0; ks < NKS; ++ks) kf[mp][ks] = *(const GAS h16x8*)(kp + (size_t)(j + 1) * 2048 + (mp * NKS + ks) * 512);
        }
        const int D0 = (qt - j) * 32;
        if (D0 < 192) {
            const lf32* tp = nearR + (223 - D0 - q + 4 * h);
#pragma unroll
            for (int r = 0; r < 16; ++r) { const float bv = tp[CROW(r)];
#pragma unroll
                for (int mp = 0; mp < NMAP; ++mp) S[mp][r] += bv; }
        } else {
            const float lo = bt[D0 - 31], hi = bt[D0 + 31];
            if (lo == hi) {
#pragma unroll
                for (int mp = 0; mp < NMAP; ++mp) S[mp] += lo;
            } else {
                int bnd = 0;
#pragma unroll
                for (int jj = 8; jj < 16; ++jj) bnd = (D0 + 31 >= kBucketStart[jj]) ? kBucketStart[jj] : bnd;
                const int x = D0 + q - 4 * h - bnd;
#pragma unroll
                for (int r = 0; r < 16; ++r) { const float bv = (x >= CROW(r)) ? hi : lo;
#pragma unroll
                    for (int mp = 0; mp < NMAP; ++mp) S[mp][r] += bv; }
            }
        }
        if (MASK) {
#pragma unroll
            for (int r = 0; r < 16; ++r) S[0][r] = ((mw >> CROW(r)) & 1u) ? S[0][r] : -3e38f;
        }
#pragma unroll
        for (int mp = 0; mp < NMAP; ++mp) {
            softmax_tile(S[mp], m[mp], l[mp], O[mp][0], O[mp][1]);
            const h16x8 p0 = pack8(S[mp], 0), p1 = pack8(S[mp], 1);
            O[mp][0] = mfma32(vf[0][0], p0, O[mp][0]); O[mp][0] = mfma32(vf[0][1], p1, O[mp][0]);
            O[mp][1] = mfma32(vf[1][0], p0, O[mp][1]); O[mp][1] = mfma32(vf[1][1], p1, O[mp][1]);
        }
    }
    f32x16 R0, R1;
    if (NMAP == 2) {
        const float lam = *(const lf32*)(lds + L_LAM);
        const float i0 = 1.f / xh_sum(l[0]), i1 = lam / xh_sum(l[NMAP - 1]);
        R0 = O[0][0] * i0 - O[NMAP - 1][0] * i1; R1 = O[0][1] * i0 - O[NMAP - 1][1] * i1;
        float ss = 0.f;
#pragma unroll
        for (int r = 0; r < 16; ++r) ss += R0[r] * R0[r] + R1[r] * R1[r];
        ss = xh_sum(ss);
        const float rs = rsqrtf(ss * (1.f / 64.f) + EPS) * (1.f - lambda_init);
        R0 *= rs; R1 *= rs;
    } else {
        const float il = 1.f / xh_sum(l[0]);
        R0 = O[0][0] * il; R1 = O[0][1] * il;
    }
    const gh16* gp = gate + tokq * 1024 + mixcol + hh * 64 + 4 * h;
#pragma unroll
    for (int db = 0; db < 2; ++db)
#pragma unroll
        for (int g = 0; g < 4; ++g) {
            const h16x4 gv = *(const GAS h16x4*)(gp + db * 32 + 8 * g); h16x4 o;
#pragma unroll
            for (int e = 0; e < 4; ++e) { float v = (db ? R1[4 * g + e] : R0[4 * g + e]) * (float)gv[e];
                if (NMAP == 2) v *= subln[db * 32 + 8 * g + 4 * h + e];
                o[e] = (h16)v; }
            *(GAS h16x4*)(mix + mixf_off(tokq, mixcol + hh * 64 + db * 32 + 8 * g + 4 * h)) = o;
        }
}

DEVI void flashB_tile(const h16x8 (&qf)[4], const gh16* kfr, const gh16* vfr, const lf32* tp, f32x16& O0, f32x16& O1, float& m, float& l) {
    h16x8 vf[4], kf[4];
#pragma unroll
    for (int f = 0; f < 4; ++f) { kf[f] = *(const GAS h16x8*)(kfr + f * 512); vf[f] = *(const GAS h16x8*)(vfr + f * 512); }
    f32x16 S = {};
#pragma unroll
    for (int ks = 0; ks < 4; ++ks) S = mfma32(kf[ks], qf[ks], S);
#pragma unroll
    for (int r = 0; r < 16; ++r) S[r] += tp[CROW(r)];
    softmax_tile(S, m, l, O0, O1);
    const h16x8 p0 = pack8(S, 0), p1 = pack8(S, 1);
    O0 = mfma32(vf[0], p0, O0); O0 = mfma32(vf[1], p1, O0);
    O1 = mfma32(vf[2], p0, O1); O1 = mfma32(vf[3], p1, O1);
}
DEVI void flashB_item(int b, int hh, int r, int qg, const gh16* Q, const gh16* KF, const gh16* VF, const lu8* lds, const gh16* gate, gh16* mix) {
    const int lane = otid() & 63, q = lane & 31, h = lane >> 5, bh = b * 4 + hh;
    const size_t tokq = (size_t)b * SEQ + qg * 512 + 16 * q + r;
    h16x8 qf[4];
#pragma unroll
    for (int ks = 0; ks < 4; ++ks) qf[ks] = *(const GAS h16x8*)(Q + tokq * 256 + hh * 64 + ks * 16 + 8 * h);
    f32x16 O0 = {}, O1 = {}; float m = -1e30f, l = 0.f;
    {
        const lf32* R3 = (const lf32*)(lds + L_R3) + hh * 192;
        const size_t base = 2 * FSZ + ((size_t)bh * 16 + r) * 4 * 2048 + lane * 8;
        for (int tl = (qg >= 4 ? qg - 4 : 0); tl <= qg; ++tl) {
            const int c = qg * 32 + q - tl * 32;
            flashB_tile(qf, KF + base + (size_t)tl * 2048, VF + base + (size_t)tl * 2048, R3 + (159 - c + 4 * h), O0, O1, m, l);
        }
    }
    {
        const lf32* R2 = (const lf32*)(lds + L_R2) + hh * 384;
        const size_t base = FSZ + ((size_t)bh * 4 + (r & 3)) * 16 * 2048 + lane * 8;
        for (int tl = (qg >= 1 ? qg * 4 - 4 : 0); tl <= qg * 4 + 3; ++tl) {
            const int c = qg * 128 + 4 * q + (r >> 2) - tl * 32;
            flashB_tile(qf, KF + base + (size_t)tl * 2048, VF + base + (size_t)tl * 2048, R2 + (255 - c + 4 * h), O0, O1, m, l);
        }
    }
    {
        const lf32* R1 = (const lf32*)(lds + L_R1) + hh * 1152;
        const size_t base = (size_t)bh * 64 * 2048 + lane * 8;
        for (int tl = (qg >= 1 ? qg * 16 - 4 : 0); tl <= qg * 16 + 15; ++tl) {
            const int c = qg * 512 + 16 * q + r - tl * 32;
            flashB_tile(qf, KF + base + (size_t)tl * 2048, VF + base + (size_t)tl * 2048, R1 + (639 - c + 4 * h), O0, O1, m, l);
        }
    }
    const float il = 1.f / xh_sum(l);
    const gh16* gp = gate + tokq * 1024 + 256 + hh * 64 + 4 * h;
#pragma unroll
    for (int db = 0; db < 2; ++db)
#pragma unroll
        for (int g = 0; g < 4; ++g) {
            const h16x4 gv = *(const GAS h16x4*)(gp + db * 32 + 8 * g); h16x4 o;
#pragma unroll
            for (int e = 0; e < 4; ++e) o[e] = (h16)((db ? O1[4 * g + e] : O0[4 * g + e]) * il * (float)gv[e]);
            *(GAS h16x4*)(mix + mixf_off(tokq, 256 + hh * 64 + db * 32 + 8 * g + 4 * h)) = o;
        }
}

DEVI unsigned xh_or(unsigned x) { auto r = __builtin_amdgcn_permlane32_swap(x, x, false, false); return r[0] | r[1]; }
DEVI void idx_tile(const gh16* KIF, int b, int j, int qt, int q, int h, const h16x8 (&qf)[8][2], const float (&ws)[8], float lo, float scl, unsigned (&kq)[16]) {
    const gh16* kp = KIF + ((size_t)b * 64 + j) * 1024 + (q + 32 * h) * 8;
    const h16x8 k0 = *(const GAS h16x8*)kp, k1 = *(const GAS h16x8*)(kp + 512);
    f32x16 sc = {};
#pragma unroll
    for (int hd = 0; hd < 8; ++hd) {
        f32x16 L = {}; L = mfma32(k0, qf[hd][0], L); L = mfma32(k1, qf[hd][1], L);
#pragma unroll
        for (int r = 0; r < 16; ++r) sc[r] += fmaxf(L[r], 0.f) * ws[hd];
    }
#pragma unroll
    for (int r = 0; r < 16; ++r) {
        const float x = fminf(fmaxf((sc[r] - lo) * scl, 0.f), 2097151.f);
        unsigned u = (unsigned)x;
        if (j == qt && CROW(r) + 4 * h > q) u = 0xFFFFFFFFu;
        kq[r] = u;
    }
}
constexpr int TK_HIST = 0, TK_EQC = 8320, TK_END = 10368;
DEVI void topk_item(int b, int qt, const gh16* idx, const gh16* KIF, gu32* mask, lu8* lds) {
    const int tid = otid(), lane = tid & 63, q = lane & 31, h = lane >> 5, wv = tid >> 6;
    const size_t tokq = (size_t)b * SEQ + qt * 32 + q;
    lu32* hist = (lu32*)(lds + TK_HIST);
    lu8* eqc = lds + TK_EQC;
    h16x8 qf[8][2]; float ws[8];
    float P = 0.f, N = 0.f;
#pragma unroll
    for (int hd = 0; hd < 8; ++hd) {
        qf[hd][0] = *(const GAS h16x8*)(idx + tokq * 320 + hd * 32 + 8 * h); qf[hd][1] = *(const GAS h16x8*)(idx + tokq * 320 + hd * 32 + 16 + 8 * h);
        ws[hd] = (float)idx[tokq * 320 + 288 + hd] * 0.35355339059327373f;
        float nn = 0.f;
#pragma unroll
        for (int e = 0; e < 8; ++e) { const float a = (float)qf[hd][0][e], c = (float)qf[hd][1][e]; nn += a * a + c * c; }
        nn = sqrtf(xh_sum(nn)) * 12.f;
        if (ws[hd] > 0.f) P += ws[hd] * nn; else N -= ws[hd] * nn;
    }
    const float lo = -N, scl = 2097151.f / fmaxf(P + N, 1e-20f);
    __syncthreads();
    for (int i = tid; i < 32 * 65; i += NTHR) hist[i] = 0u;
    __syncthreads();
    unsigned R = 256u, pref = 0u;
#pragma unroll 1
    for (int lvl = 0; lvl < 3; ++lvl) {
        const int sh = 14 - 7 * lvl;
        for (int j = wv; j <= qt; j += 8) {
            unsigned kq[16];
            idx_tile(KIF, b, j, qt, q, h, qf, ws, lo, scl, kq);
#pragma unroll
            for (int r = 0; r < 16; ++r) {
                if ((kq[r] >> (sh + 7)) == pref) {
                    const unsigned bin = (kq[r] >> sh) & 127u;
                    __hip_atomic_fetch_add(hist + q * 65 + (bin >> 1), 1u << ((bin & 1u) * 16u), __ATOMIC_RELAXED, __HIP_MEMORY_SCOPE_WORKGROUP);
                }
            }
        }
        __syncthreads();
        {
            unsigned cum = 0u, found = 0u, bb = 0u, above = 0u;
#pragma unroll 4
            for (int w = 63; w >= 0; --w) {
                const unsigned v = hist[q * 65 + w];
                unsigned t = cum + (v >> 16);
                if (!found && t >= R) { bb = 2u * w + 1u; above = cum; found = 1u; }
                cum = t; t = cum + (v & 0xffffu);
                if (!found && t >= R) { bb = 2u * w; above = cum; found = 1u; }
                cum = t;
            }
            R -= above; pref = (pref << 7) | bb;
        }
        __syncthreads();
        for (int i = tid; i < 32 * 65; i += NTHR) hist[i] = 0u;
        __syncthreads();
    }
    unsigned GT[8], EQ[8];
#pragma unroll
    for (int n = 0; n < 8; ++n) {
        const int j = wv + 8 * n; GT[n] = 0u; EQ[n] = 0u;
        if (j <= qt) {
            unsigned kq[16];
            idx_tile(KIF, b, j, qt, q, h, qf, ws, lo, scl, kq);
            unsigned g = 0u, e = 0u;
#pragma unroll
            for (int r = 0; r < 16; ++r) {
                g |= (kq[r] > pref && (kq[r] >> 21) == 0u) ? (1u << CROW(r)) : 0u;
                e |= (kq[r] == pref) ? (1u << CROW(r)) : 0u;
            }
            GT[n] = xh_or(g << (4 * h)); EQ[n] = xh_or(e << (4 * h));
            if (h == 0) eqc[q * 64 + j] = (unsigned char)__builtin_popcount(EQ[n]);
        }
    }
    __syncthreads();
#pragma unroll
    for (int n = 0; n < 8; ++n) {
        const int j = wv + 8 * n;
        if (j <= qt) {
            unsigned before = 0u;
#pragma unroll
            for (int k = 0; k < 16; ++k) {
                const int nb = j - 4 * k;
                if (nb > 0) { unsigned v = *(const LAS unsigned*)(eqc + q * 64 + 4 * k); if (nb < 4) v &= (1u << (8 * nb)) - 1u; before += (v * 0x01010101u) >> 24; }
            }
            unsigned e = EQ[n]; const unsigned pc = (unsigned)__builtin_popcount(e);
            const unsigned allow = before >= R ? 0u : (R - before < pc ? R - before : pc);
            unsigned keep = e;
            if (allow < pc) { keep = 0u; for (unsigned c = 0; c < allow; ++c) { const unsigned bit = e & (0u - e); keep |= bit; e ^= bit; } }
            if (h == 0) mask[tokq * 64 + j] = GT[n] | keep;
        }
    }
}
DEVI void ph_topk(const gh16* idx, const gh16* KIF, gu32* mask, lu8* lds, int nrep) {
#pragma unroll 1
    for (int rp = 0; rp < nrep; ++rp)
    for (int g = blockIdx.x; g < 256; g += gridDim.x) {
        const int b = g >> 5, k = g & 31;
        if (k < 28) { topk_item(b, 63 - k, idx, KIF, mask, lds); topk_item(b, 8 + k, idx, KIF, mask, lds); }
        else if (k == 28) { const int tid = otid(); for (int i = tid; i < 256 * 8; i += NTHR) { const int t = i >> 3, j = i & 7; if (j <= (t >> 5)) mask[((size_t)b * SEQ + t) * 64 + j] = 0xffffffffu; } }
    }
}

DEVI void ph_out(const gh16* mix, const gh16* WoT, const gf32* __restrict__ gpost, const gf32* h_in, gf32* h_out, gh16* h16o, gf32* rstd_next, bool write_next, lu8* lds) {
    const int tid = otid(), lane = tid & 63, q = lane & 31, h = lane >> 5, wv = __builtin_amdgcn_readfirstlane(tid >> 6);
    lf32* red = (lf32*)lds;
    for (int u = blockIdx.x; u < NT / 64; u += gridDim.x) {
        f32x16 acc[4][2];
#pragma unroll
        for (int rb = 0; rb < 4; ++rb) { acc[rb][0] = (f32x16){}; acc[rb][1] = (f32x16){}; }
        const gh16* apu = WoT + (size_t)(wv * 4) * 64 * 512;
        const gh16* bpu = mix + (size_t)(u * 2) * 64 * 512;
        const unsigned lo8 = lane * 8;
#define ap(off) (apu + (off) + lo8)
#define bp(off) (bpu + (off) + lo8)
        h16x8 a0[4], b0[2], a1[4], b1[2];
#pragma unroll
        for (int rb = 0; rb < 4; ++rb) a0[rb] = *(const GAS h16x8*)(ap(rb * 64 * 512));
#pragma unroll
        for (int tb = 0; tb < 2; ++tb) b0[tb] = *(const GAS h16x8*)(bp(tb * 64 * 512));
#pragma unroll 1
        for (int ks = 0; ks < 64; ks += 2) {
#pragma unroll
            for (int rb = 0; rb < 4; ++rb) a1[rb] = *(const GAS h16x8*)(ap(rb * 64 * 512 + (ks + 1) * 512));
#pragma unroll
            for (int tb = 0; tb < 2; ++tb) b1[tb] = *(const GAS h16x8*)(bp(tb * 64 * 512 + (ks + 1) * 512));
            __builtin_amdgcn_sched_barrier(0);
#pragma unroll
            for (int rb = 0; rb < 4; ++rb)
#pragma unroll
                for (int tb = 0; tb < 2; ++tb) acc[rb][tb] = mfma32(a0[rb], b0[tb], acc[rb][tb]);
            __builtin_amdgcn_sched_barrier(0);
            const int k2 = (ks + 2 < 64 ? ks + 2 : ks) * 512;
#pragma unroll
            for (int rb = 0; rb < 4; ++rb) a0[rb] = *(const GAS h16x8*)(ap(rb * 64 * 512 + k2));
#pragma unroll
            for (int tb = 0; tb < 2; ++tb) b0[tb] = *(const GAS h16x8*)(bp(tb * 64 * 512 + k2));
            __builtin_amdgcn_sched_barrier(0);
#pragma unroll
            for (int rb = 0; rb < 4; ++rb)
#pragma unroll
                for (int tb = 0; tb < 2; ++tb) acc[rb][tb] = mfma32(a1[rb], b1[tb], acc[rb][tb]);
            __builtin_amdgcn_sched_barrier(0);
        }
#undef ap
#undef bp
        int qe = q, he = h; asm volatile("" : "+v"(qe), "+v"(he));
        __syncthreads();
#pragma unroll
        for (int tb = 0; tb < 2; ++tb) {
            float ss = 0.f;
#pragma unroll
            for (int rb = 0; rb < 4; ++rb)
#pragma unroll
                for (int r = 0; r < 16; ++r) ss += acc[rb][tb][r] * acc[rb][tb][r];
            ss = xh_sum(ss);
            if (he == 0) red[wv * 64 + tb * 32 + qe] = ss;
        }
        __syncthreads();
        float ssn[2] = {0.f, 0.f};
#pragma unroll
        for (int tb = 0; tb < 2; ++tb) {
            float tot = 0.f;
#pragma unroll
            for (int w2 = 0; w2 < 8; ++w2) tot += red[w2 * 64 + tb * 32 + qe];
            const float rs = rsqrtf(tot * (1.f / DM) + EPS);
            const size_t rowoff = (size_t)(u * 64 + tb * 32 + qe) * DM;
#pragma unroll
            for (int rb = 0; rb < 4; ++rb)
#pragma unroll
                for (int g = 0; g < 4; ++g) {
                    const int n = wv * 128 + rb * 32 + 8 * g + 4 * he;
                    const f32x4_t hv = *(const GAS f32x4_t*)(h_in + rowoff + n), gv = *(const GAS f32x4_t*)(gpost + n);
                    f32x4_t o;
                    o[0] = hv[0] + acc[rb][tb][4 * g + 0] * rs * gv[0]; o[1] = hv[1] + acc[rb][tb][4 * g + 1] * rs * gv[1];
                    o[2] = hv[2] + acc[rb][tb][4 * g + 2] * rs * gv[2]; o[3] = hv[3] + acc[rb][tb][4 * g + 3] * rs * gv[3];
                    *(GAS f32x4_t*)(h_out + rowoff + n) = o;
                    if (write_next) { h16x4 oh; oh[0] = (h16)o[0]; oh[1] = (h16)o[1]; oh[2] = (h16)o[2]; oh[3] = (h16)o[3]; *(GAS h16x4*)(h16o + rowoff + n) = oh;
                        ssn[tb] += o[0] * o[0] + o[1] * o[1] + o[2] * o[2] + o[3] * o[3]; }
                }
        }
        if (write_next) {
#pragma unroll
            for (int tb = 0; tb < 2; ++tb) { const float v = xh_sum(ssn[tb]); if (he == 0) red[512 + wv * 64 + tb * 32 + qe] = v; }
            __syncthreads();
            if (tid < 64) { float tot = 0.f;
#pragma unroll
                for (int w2 = 0; w2 < 8; ++w2) tot += red[512 + w2 * 64 + tid];
                rstd_next[u * 64 + tid] = rsqrtf(tot * (1.f / DM) + EPS); }
        }
    }
}

DEVI void mla_item(int it, const gh16* cA, const gh16* WuqT, const gh16* WukvT, const gf32* cosT, const gf32* sinT, gh16* qA, gh16* KFA, gh16* KRF, gh16* VFA) {
    const int lane = otid() & 63, q = lane & 31, h = lane >> 5;
    const size_t tok = (size_t)it * 32 + q; const int b = it >> 6, j = it & 63, s = j * 32 + q;
    const float qs = 0.10206207261596577f * LOG2E;
    {
        h16x8 cf[12]; float ss = 0.f;
#pragma unroll
        for (int ks = 0; ks < 12; ++ks) { cf[ks] = *(const GAS h16x8*)(cA + tok * 384 + ks * 16 + 8 * h);
#pragma unroll
            for (int e = 0; e < 8; ++e) { const float v = (float)cf[ks][e]; ss += v * v; } }
        const float rs = rsqrtf(xh_sum(ss) * (1.f / 192.f) + EPS) * qs;
#pragma unroll 1
        for (int nb = 0; nb < 12; ++nb) {
            f32x16 acc = {};
            const gh16* wp = WuqT + (size_t)nb * 12 * 512 + lane * 8;
#pragma unroll
            for (int ks = 0; ks < 12; ++ks) acc = mfma32(*(const GAS h16x8*)(wp + ks * 512), cf[ks], acc);
            acc *= rs;
            const int hh = nb / 3, part = nb % 3;
            if (part == 2) {
#pragma unroll
                for (int r = 0; r < 8; ++r) { const int i = CROW(r) + 4 * h; const float c = cosT[s * 16 + i], sn = sinT[s * 16 + i], x1 = acc[r], x2 = acc[r + 8];
                    acc[r] = x1 * c - x2 * sn; acc[r + 8] = x1 * sn + x2 * c; }
            }
            gh16* op = qA + tok * 384 + hh * 96 + part * 32 + 4 * h;
#pragma unroll
            for (int g = 0; g < 4; ++g) { h16x4 o; o[0] = (h16)acc[4 * g]; o[1] = (h16)acc[4 * g + 1]; o[2] = (h16)acc[4 * g + 2]; o[3] = (h16)acc[4 * g + 3]; *(GAS h16x4*)(op + 8 * g) = o; }
        }
    }
    {
        h16x8 cf[8]; float ss = 0.f;
#pragma unroll
        for (int ks = 0; ks < 8; ++ks) { cf[ks] = *(const GAS h16x8*)(cA + tok * 384 + 192 + ks * 16 + 8 * h);
#pragma unroll
            for (int e = 0; e < 8; ++e) { const float v = (float)cf[ks][e]; ss += v * v; } }
        const float rs = rsqrtf(xh_sum(ss) * (1.f / 128.f) + EPS);
#pragma unroll
        for (int ks = 0; ks < 8; ++ks)
#pragma unroll
            for (int e = 0; e < 8; ++e) cf[ks][e] = (h16)((float)cf[ks][e] * rs);
#pragma unroll 1
        for (int nb = 0; nb < 16; ++nb) {
            const int hh = nb >> 2, sub = nb & 3, bh = b * 4 + hh;
            const gh16* wp = WukvT + (size_t)nb * 8 * 512 + lane * 8;
            f32x16 acc = {};
            if (sub < 2) {
#pragma unroll
                for (int ks = 0; ks < 8; ++ks) acc = mfma32(*(const GAS h16x8*)(wp + ks * 512), cf[ks], acc);
#pragma unroll
                for (int g = 0; g < 4; ++g) { h16x4 o; o[0] = (h16)acc[4 * g]; o[1] = (h16)acc[4 * g + 1]; o[2] = (h16)acc[4 * g + 2]; o[3] = (h16)acc[4 * g + 3];
                    *(GAS h16x4*)(KFA + ((((size_t)bh * 64 + j) * 4 + 2 * sub + (g >> 1)) * 64 + q + 32 * (g & 1)) * 8 + 4 * h) = o; }
            } else {
#pragma unroll
                for (int ks = 0; ks < 8; ++ks) acc = mfma32(cf[ks], *(const GAS h16x8*)(wp + ks * 512), acc);
#pragma unroll
                for (int sk = 0; sk < 2; ++sk) { h16x8 o;
#pragma unroll
                    for (int e = 0; e < 8; ++e) o[e] = (h16)acc[8 * sk + e];
                    *(GAS h16x8*)(VFA + ((((size_t)bh * 64 + j) * 4 + (sub - 2) * 2 + sk) * 64 + lane) * 8) = o; }
            }
        }
    }
    {
        const h16x8 a = *(const GAS h16x8*)(cA + tok * 384 + 320 + 8 * h), c2 = *(const GAS h16x8*)(cA + tok * 384 + 336 + 8 * h);
        h16x8 o1, o2;
#pragma unroll
        for (int e = 0; e < 8; ++e) { const int i = 8 * h + e; const float c = cosT[s * 16 + i], sn = sinT[s * 16 + i], x1 = (float)a[e], x2 = (float)c2[e];
            o1[e] = (h16)(x1 * c - x2 * sn); o2[e] = (h16)(x1 * sn + x2 * c); }
        *(GAS h16x8*)(KRF + (((size_t)b * 64 + j) * 2 + 0) * 512 + lane * 8) = o1; *(GAS h16x8*)(KRF + (((size_t)b * 64 + j) * 2 + 1) * 512 + lane * 8) = o2;
    }
}
DEVI void ph_small_weights(const gf32* w_uq, const gf32* qn, const gf32* w_ukv, const gf32* kvn, const gf32* w_out, gh16* WuqF, gh16* WukvF, gh16* WoF) {
    const int gt = blockIdx.x * NTHR + otid(), nthr = gridDim.x * NTHR;
    for (int i = gt; i < 2 * 12 * 12 * 64; i += nthr) { const int lane = i & 63, ks = (i >> 6) % 12, nb = (i / (64 * 12)) % 12, l = i / (64 * 144);
        h16x8 o;
#pragma unroll
        for (int e = 0; e < 8; ++e) { const int k = 16 * ks + 8 * (lane >> 5) + e; o[e] = (h16)(w_uq[(size_t)l * 192 * 384 + k * 384 + nb * 32 + (lane & 31)] * qn[l * 192 + k]); }
        *(GAS h16x8*)(WuqF + (size_t)i * 8) = o; }
    for (int i = gt; i < 2 * 16 * 8 * 64; i += nthr) { const int lane = i & 63, ks = (i >> 6) & 7, nb = (i >> 9) & 15, l = i >> 13;
        h16x8 o;
#pragma unroll
        for (int e = 0; e < 8; ++e) { const int k = 16 * ks + 8 * (lane >> 5) + e; o[e] = (h16)(w_ukv[(size_t)l * 128 * 512 + k * 512 + nb * 32 + (lane & 31)] * kvn[l * 128 + k]); }
        *(GAS h16x8*)(WukvF + (size_t)i * 8) = o; }
    for (int i = gt; i < 2 * 32 * 64 * 64; i += nthr) { const int lane = i & 63, ks = (i >> 6) & 63, nb = (i >> 12) & 31, l = i >> 17;
        h16x8 o;
#pragma unroll
        for (int e = 0; e < 8; ++e) { const int k = 16 * ks + 8 * (lane >> 5) + e; o[e] = (h16)w_out[(size_t)l * DM * DM + (size_t)k * DM + nb * 32 + (lane & 31)]; }
        *(GAS h16x8*)(WoF + (size_t)i * 8) = o; }
}

constexpr int LDS_BYTES = 144 * 1024;
struct Params { const float* in[12]; float* out; unsigned char* ws; };

DEVI void ph_tables(const gf32* __restrict__ rel_bias, gf32* biasTab, gf32* cosT, gf32* sinT) {
    for (int i = blockIdx.x * NTHR + threadIdx.x; i < 2048 * 16; i += gridDim.x * NTHR) {
        if (i < 12 * 2048) { int hh = i / 2048, n = i % 2048; biasTab[i] = rel_bias[t5_bucket(n) * 12 + hh] * LOG2E; }
        int pos = i / 16, j = i % 16;
        float inv = (float)pow(10000.0, -(double)(2 * j) / 32.0);
        float ang = (float)pos * inv;
        cosT[i] = (float)cos((double)ang); sinT[i] = (float)sin((double)ang);
    }
}

extern __shared__ __attribute__((aligned(16))) unsigned char smem[];
constexpr int LDS_BAR_OFF = 131072;

#ifndef DUP_PHASE
#define DUP_PHASE 0
#endif
#define REP(k) for (int rep_ = 0; rep_ < ((DUP_PHASE == (k)) ? 2 : 1); ++rep_)
DEVI gu8* ows(unsigned char* w0) { gu8* w = (gu8*)w0; asm volatile("" : "+s"(w)); return w; }
#define WSP(T, off) ((GAS T*)(w + (off)))
#define GIN(k) ((const gf32*)p.in[k])

__global__ void __launch_bounds__(NTHR, 2) mega(Params p) {
    if (threadIdx.x == 0) *(uint4*)(smem + LDS_BAR_OFF) = make_uint4(0u, 0u, 0u, 0u);
    __syncthreads();
    XcdBarrier bar = xcd_barrier_post((unsigned*)(p.ws + OFF_CTL), (volatile LAS unsigned*)(smem + LDS_BAR_OFF));
    lu8* lds = (lu8*)smem;
    const int nw = gridDim.x * NWAVE;

    REP(1) {
        gu8* w = ows(p.ws);
        ph_tables(GIN(11), WSP(float, OFF_BIAS), WSP(float, OFF_COS), WSP(float, OFF_SIN));
        int base = 0; const int total = 2 * (64 * 16);
        cvt_transpose<true>(GIN(1), INC, GIN(3), WSP(h16, OFF_WINT), MYC, DM, lds, blockIdx.x, total, base);
        cvt_transpose<true>(GIN(1) + (size_t)DM * INC, INC, GIN(3) + DM, WSP(h16, OFF_WINT) + (size_t)MYC * DM, MYC, DM, lds, blockIdx.x, total, base);
        ph_small_weights(GIN(7), GIN(5), GIN(8), GIN(6), GIN(2), WSP(h16, OFF_WUQT), WSP(h16, OFF_WUKVT), WSP(h16, OFF_WOUTT));
        ph_rowstat_cvt(GIN(0), WSP(float, OFF_RSTD), WSP(h16, OFF_H16));
    }
    xcd_barrier(bar);
    for (int layer = 0; layer < 2; ++layer) {
        const float lambda_init = layer == 0 ? 0.2f : 0.35550906759f;
        REP(2) {
            if (rep_) xcd_barrier(bar);
            gu8* w = ows(p.ws);
            pg8::Gemm g{(const pg8::bf16_t*)(p.ws + OFF_H16), (const pg8::bf16_t*)(p.ws + OFF_WINT) + (size_t)layer * MYC * DM, NT, MYC, DM};
            int bid_ = (int)blockIdx.x; asm volatile("" : "+s"(bid_));
            pg8::StaticOrder S; S.init(NT, MYC, (int)gridDim.x, bid_);
            EpiRoute E{w, WSP(float, OFF_RSTD)};
            pg8::gemm_phase<EpiRoute, pg8::StaticOrder, true, true>(lds, g, S, E);
        }
        xcd_barrier(bar);
        REP(3) {
            gu8* w = ows(p.ws);
            for (int it = ogw(); it < NT / 32; it += nw) mla_item(it, WSP(h16, OFF_CA), WSP(h16, OFF_WUQT) + (size_t)layer * 384 * 192, WSP(h16, OFF_WUKVT) + (size_t)layer * 512 * 128, WSP(float, OFF_COS), WSP(float, OFF_SIN), WSP(h16, OFF_QA), WSP(h16, OFF_KFA), WSP(h16, OFF_KRF), WSP(h16, OFF_VFA));
        }
        {
            gu8* w = ows(p.ws);
            ph_topk(WSP(h16, OFF_IDX), WSP(h16, OFF_KIF), WSP(unsigned, OFF_MASK), lds, DUP_PHASE == 4 ? 2 : 1);
        }
        REP(3) {
            gu8* w = ows(p.ws);
            ph_vtrans(WSP(h16, OFF_VTMP), WSP(h16, OFF_VF), lds);
        }
        xcd_barrier(bar);
        REP(5) {
            if (rep_) xcd_barrier(bar);
            gu8* w = ows(p.ws);
            p2_setup(WSP(float, OFF_BIAS), GIN(9) + layer * 128, lambda_init, lds);
            const int xcc = (int)(xb_xcc_id() & 7u);
            for (int dq = 0; dq < 8; ++dq) {
                const int bq = (xcc + dq) & 7;
                gu32* ctr = WSP(unsigned, OFF_CTL) + 3600 + 16 * (bq + 8 * layer + 16 * rep_);
                for (;;) { const int e = wq_next(ctr); if (e >= 1024) break;
                    const int grp = e >> 6, lvl = 63 - (e & 63), ty = grp >> 2, hh = grp & 3;
                    if (ty == 2) flashA_item(bq, hh, lvl, WSP(h16, OFF_QA), WSP(h16, OFF_KFA), WSP(h16, OFF_KRF), WSP(h16, OFF_VFA), WSP(h16, OFF_GATE), WSP(h16, OFF_MIX));
                    else if (ty == 0) flashCD_item<2, false>(bq, hh, lvl, 8 + hh, WSP(h16, OFF_QD), WSP(h16, OFF_KFD), WSP(h16, OFF_VF) + 4 * FSZ, nullptr, WSP(float, OFF_BIAS), lds,
                                                             GIN(10) + layer * 64, lambda_init, WSP(h16, OFF_GATE), WSP(h16, OFF_MIX), 768);
                    else if (ty == 1) flashCD_item<1, true>(bq, hh, lvl, 4 + hh, WSP(h16, OFF_QC), WSP(h16, OFF_KFC), WSP(h16, OFF_VF) + 3 * FSZ, WSP(unsigned, OFF_MASK), WSP(float, OFF_BIAS), lds,
                                                            nullptr, 0.f, WSP(h16, OFF_GATE), WSP(h16, OFF_MIX), 512);
                    else flashB_item(bq, hh, lvl & 15, lvl >> 4, WSP(h16, OFF_QB), WSP(h16, OFF_KFB), WSP(h16, OFF_VF), lds, WSP(h16, OFF_GATE), WSP(h16, OFF_MIX));
                }
            }
        }
        xcd_barrier(bar);
        for (int rep_ = 0; rep_ < ((DUP_PHASE == 6 && layer == 0) ? 2 : 1); ++rep_) {
            if (rep_) xcd_barrier(bar);
            gu8* w = ows(p.ws);
            ph_out(WSP(h16, OFF_MIX), WSP(h16, OFF_WOUTT) + (size_t)layer * DM * DM, GIN(4) + layer * DM, layer == 0 ? GIN(0) : (const gf32*)p.out, (gf32*)p.out, WSP(h16, OFF_H16), WSP(float, OFF_RSTD), layer == 0, lds);
        }
        xcd_barrier(bar);
    }
}

extern "C" void kernel_launch(void* const* d_in, const int* in_sizes, int n_in, void* d_out, int out_size, void* d_ws, size_t ws_size, hipStream_t stream) {
    static int grid = 0;
    if (grid == 0) {
        int dev = 0, cus = 0, per_cu = 0;
        (void)hipGetDevice(&dev);
        (void)hipDeviceGetAttribute(&cus, hipDeviceAttributeMultiprocessorCount, dev);
        (void)hipFuncSetAttribute((const void*)mega, hipFuncAttributeMaxDynamicSharedMemorySize, LDS_BYTES);
        (void)hipOccupancyMaxActiveBlocksPerMultiprocessor(&per_cu, (const void*)mega, NTHR, LDS_BYTES);
        (void)hipGetLastError();
        grid = cus > 0 ? cus : 256;
    }
    (void)hipMemsetAsync((char*)d_ws + OFF_CTL, 0, 32768, stream);
    Params p{};
    for (int i = 0; i < 12; ++i) p.in[i] = (const float*)d_in[i];
    p.out = (float*)d_out; p.ws = (unsigned char*)d_ws;
    hipLaunchKernelGGL(mega, dim3(grid), dim3(NTHR), LDS_BYTES, stream, p);
}
```

```cpp
#include <hip/hip_runtime.h>
#include <stdint.h>
#include <math.h>

#ifndef DUP_PHASE
#define DUP_PHASE 0
#endif
typedef _Float16 h16;
#define GAS __attribute__((address_space(1)))
#define LAS __attribute__((address_space(3)))
typedef GAS h16 gh16; typedef GAS float gf32; typedef GAS unsigned gu32; typedef GAS unsigned char gu8;
typedef LAS h16 lh16; typedef LAS float lf32; typedef LAS unsigned lu32; typedef LAS unsigned char lu8;
#define DEVI __device__ __forceinline__
DEVI int ogw();
DEVI int otid() { int t = threadIdx.x; asm volatile("" : "+v"(t)); return t; }

constexpr int NB = 8, SEQ = 2048, DM = 1024, NT = NB * SEQ, INC = 3976, MYC = 4096;
constexpr float LOG2E = 1.4426950408889634f;
constexpr float EPS = 1e-6f;

DEVI int ogw() { return blockIdx.x * 8 + (otid() >> 6); }
__host__ __device__ constexpr int ref_col(int my) {
    if (my < 352) return my;
    if (my < 384) return -1;
    if (my < 640) return 352 + (my - 384);
    if (my < 896) return 1376 + (my - 640);
    if (my < 1152) return 2696 + (my - 896);
    if (my < 1408) return 3720 + (my - 1152);
    if (my < 1664) return 608 + (my - 1408);
    if (my < 1920) return 864 + (my - 1664);
    if (my < 2176) return 1632 + (my - 1920);
    if (my < 2432) return 1888 + (my - 2176);
    if (my < 2688) return 2952 + (my - 2432);
    if (my < 2944) return 3208 + (my - 2688);
    if (my < 3200) return 1120 + (my - 2944);
    if (my < 3456) return 2144 + (my - 3200);
    if (my < 3712) return 3464 + (my - 3456);
    if (my < 3968) return 2400 + (my - 3712);
    if (my < 4000) return 2656 + (my - 3968);
    if (my < 4008) return 2688 + (my - 4000);
    return -1;
}

constexpr size_t MiB = 1024 * 1024;
constexpr size_t OFF_CTL = 0;
constexpr size_t OFF_RSTD = 64 * 1024;
constexpr size_t OFF_BIAS = 128 * 1024;
constexpr size_t OFF_COS = 256 * 1024;
constexpr size_t OFF_SIN = 384 * 1024;
constexpr size_t OFF_SSQY = 512 * 1024;
constexpr size_t OFF_SSQH = 768 * 1024;
constexpr size_t OFF_CA = 1 * MiB;
constexpr size_t OFF_GATE = OFF_CA + 12 * MiB;
constexpr size_t OFF_QB = OFF_GATE + 32 * MiB;
constexpr size_t OFF_QC = OFF_QB + 8 * MiB;
constexpr size_t OFF_QD = OFF_QC + 8 * MiB;
constexpr size_t OFF_KFB = OFF_QD + 8 * MiB;
constexpr size_t OFF_KFC = OFF_KFB + 24 * MiB;
constexpr size_t OFF_KFD = OFF_KFC + 8 * MiB;
constexpr size_t OFF_IDX = OFF_KFD + 8 * MiB;
constexpr size_t OFF_KIF = OFF_IDX + 10 * MiB;
constexpr size_t OFF_MIX = OFF_KIF + 1 * MiB;
constexpr size_t OFF_VTMP = OFF_MIX;
constexpr size_t OFF_MASK = OFF_MIX + 32 * MiB;
constexpr size_t OFF_H16 = OFF_MASK + 4 * MiB;
constexpr size_t OFF_QA = OFF_H16;
constexpr size_t OFF_KFA = OFF_QA + 12 * MiB;
constexpr size_t OFF_KRF = OFF_KFA + 8 * MiB;
constexpr size_t OFF_VFA = OFF_KRF + 1 * MiB;
constexpr size_t OFF_WINT = OFF_H16 + 32 * MiB;
constexpr size_t OFF_WOUTT = OFF_WINT + 16 * MiB;
constexpr size_t OFF_WUQT = OFF_WOUTT + 4 * MiB;
constexpr size_t OFF_WUKVT = OFF_WUQT + 512 * 1024;
constexpr size_t OFF_VF = OFF_WUKVT + 512 * 1024;
constexpr size_t OFF_END = OFF_VF + 40 * MiB;
static_assert(OFF_END <= 256 * MiB, "ws map");

struct Route { int kind; size_t off; int dcol; int pitch; float scale; int silu; };
__host__ __device__ inline Route route(int my) {
    Route r{-1, 0, 0, 0, 1.f, 0};
    if (my < 384) { r.kind = 0; r.off = OFF_CA; r.dcol = my; r.pitch = 384; }
    else if (my < 1408) { r.kind = 0; r.off = OFF_GATE; r.dcol = my - 384; r.pitch = 1024; r.silu = 1; }
    else if (my < 1664) { r.kind = 0; r.off = OFF_QB; r.dcol = my - 1408; r.pitch = 256; r.scale = 0.125f * LOG2E; }
    else if (my < 1920) { r.kind = 2; r.off = OFF_KFB; r.dcol = my - 1664; }
    else if (my < 2176) { r.kind = 0; r.off = OFF_QC; r.dcol = my - 1920; r.pitch = 256; r.scale = 0.125f * LOG2E; }
    else if (my < 2432) { r.kind = 1; r.off = OFF_KFC; r.dcol = my - 2176; }
    else if (my < 2688) { r.kind = 0; r.off = OFF_QD; r.dcol = my - 2432; r.pitch = 256; r.scale = 0.17677669529663687f * LOG2E; }
    else if (my < 2944) { r.kind = 1; r.off = OFF_KFD; r.dcol = my - 2688; }
    else if (my < 3712) { r.kind = 0; r.off = OFF_VTMP; r.dcol = my - 2944; r.pitch = 768; }
    else if (my < 3968) { r.kind = 0; r.off = OFF_IDX; r.dcol = my - 3712; r.pitch = 320; r.scale = 0.17677669529663687f; }
    else if (my < 4000) { r.kind = 3; r.off = OFF_KIF; r.dcol = my - 3968; }
    else if (my < 4032) { r.kind = 0; r.off = OFF_IDX; r.dcol = my - 3712; r.pitch = 320; }
    return r;
}
DEVI size_t kf_off(int bh, int s, int d0) { return ((((size_t)bh * 64 + (s >> 5)) * 4 + (d0 >> 4)) * 64 + (s & 31) + 32 * ((d0 >> 3) & 1)) * 8; }
DEVI size_t kf4_off(int bh, int s, int d0) { const int pp = s >> 2, r4 = s & 3; return (((((size_t)bh * 4 + r4) * 16 + (pp >> 5)) * 4 + (d0 >> 4)) * 64 + (pp & 31) + 32 * ((d0 >> 3) & 1)) * 8; }
DEVI size_t kf16_off(int bh, int s, int d0) { const int pp = s >> 4, r = s & 15; return (((((size_t)bh * 16 + r) * 4 + (pp >> 5)) * 4 + (d0 >> 4)) * 64 + (pp & 31) + 32 * ((d0 >> 3) & 1)) * 8; }
DEVI size_t mixf_off(size_t tok, int c0) { return tok * 1024 + (size_t)c0; }
constexpr size_t FSZ = (size_t)32 * 64 * 4 * 64 * 8;

__device__ __constant__ unsigned short kP2Order[1024] = {63, 127, 191, 255, 62, 126, 190, 254, 61, 125, 189, 253, 60, 124, 188, 252, 59, 123, 187, 251, 58, 122, 186, 250, 57, 121, 185, 249, 56, 120, 184, 248, 55, 119, 183, 247, 54, 118, 182, 246, 53, 117, 181, 245, 52, 116, 180, 244, 51, 115, 179, 243, 50, 114, 178, 242, 49, 113, 177, 241, 48, 112, 176, 240, 47, 111, 175, 239, 46, 110, 174, 238, 45, 109, 173, 237, 44, 108, 172, 236, 43, 107, 171, 235, 42, 106, 170, 234, 41, 105, 169, 233, 40, 104, 168, 232, 39, 103, 167, 231, 319, 383, 447, 511, 318, 382, 446, 510, 38, 102, 166, 230, 317, 381, 445, 509, 316, 380, 444, 508, 37, 101, 165, 229, 315, 379, 443, 507, 36, 100, 164, 228, 314, 378, 442, 506, 313, 377, 441, 505, 35, 99, 163, 227, 312, 376, 440, 504, 34, 98, 162, 226, 311, 375, 439, 503, 310, 374, 438, 502, 33, 97, 161, 225, 309, 373, 437, 501, 308, 372, 436, 500, 32, 96, 160, 224, 307, 371, 435, 499, 31, 95, 159, 223, 306, 370, 434, 498, 305, 369, 433, 497, 30, 94, 158, 222, 304, 368, 432, 496, 29, 93, 157, 221, 303, 367, 431, 495, 302, 366, 430, 494, 28, 92, 156, 220, 301, 365, 429, 493, 300, 364, 428, 492, 27, 91, 155, 219, 299, 363, 427, 491, 26, 90, 154, 218, 298, 362, 426, 490, 575, 639, 703, 767, 297, 361, 425, 489, 574, 638, 702, 766, 25, 89, 153, 217, 573, 637, 701, 765, 296, 360, 424, 488, 572, 636, 700, 764, 24, 88, 152, 216, 295, 359, 423, 487, 571, 635, 699, 763, 570, 634, 698, 762, 294, 358, 422, 486, 569, 633, 697, 761, 23, 87, 151, 215, 293, 357, 421, 485, 568, 632, 696, 760, 567, 631, 695, 759, 292, 356, 420, 484, 22, 86, 150, 214, 566, 630, 694, 758, 291, 355, 419, 483, 565, 629, 693, 757, 564, 628, 692, 756, 21, 85, 149, 213, 290, 354, 418, 482, 563, 627, 691, 755, 289, 353, 417, 481, 562, 626, 690, 754, 20, 84, 148, 212, 561, 625, 689, 753, 288, 352, 416, 480, 560, 624, 688, 752, 19, 83, 147, 211, 287, 351, 415, 479, 559, 623, 687, 751, 558, 622, 686, 750, 286, 350, 414, 478, 557, 621, 685, 749, 18, 82, 146, 210, 285, 349, 413, 477, 556, 620, 684, 748, 555, 619, 683, 747, 284, 348, 412, 476, 17, 81, 145, 209, 554, 618, 682, 746, 283, 347, 411, 475, 553, 617, 681, 745, 552, 616, 680, 744, 16, 80, 144, 208, 282, 346, 410, 474, 551, 615, 679, 743, 281, 345, 409, 473, 550, 614, 678, 742, 15, 79, 143, 207, 549, 613, 677, 741, 280, 344, 408, 472, 548, 612, 676, 740, 14, 78, 142, 206, 279, 343, 407, 471, 547, 611, 675, 739, 546, 610, 674, 738, 278, 342, 406, 470, 545, 609, 673, 737, 13, 77, 141, 205, 277, 341, 405, 469, 544, 608, 672, 736, 543, 607, 671, 735, 276, 340, 404, 468, 12, 76, 140, 204, 542, 606, 670, 734, 275, 339, 403, 467, 541, 605, 669, 733, 768, 769, 770, 771, 772, 773, 774, 775, 776, 777, 778, 779, 780, 781, 782, 783, 784, 785, 786, 787, 788, 789, 790, 791, 792, 793, 794, 795, 796, 797, 798, 799, 800, 801, 802, 803, 804, 805, 806, 807, 808, 809, 810, 811, 812, 813, 814, 815, 816, 817, 818, 819, 820, 821, 822, 823, 824, 825, 826, 827, 828, 829, 830, 831, 832, 833, 834, 835, 836, 837, 838, 839, 840, 841, 842, 843, 844, 845, 846, 847, 848, 849, 850, 851, 852, 853, 854, 855, 856, 857, 858, 859, 860, 861, 862, 863, 864, 865, 866, 867, 868, 869, 870, 871, 872, 873, 874, 875, 876, 877, 878, 879, 880, 881, 882, 883, 884, 885, 886, 887, 888, 889, 890, 891, 892, 893, 894, 895, 896, 897, 898, 899, 900, 901, 902, 903, 904, 905, 906, 907, 908, 909, 910, 911, 912, 913, 914, 915, 916, 917, 918, 919, 920, 921, 922, 923, 924, 925, 926, 927, 928, 929, 930, 931, 932, 933, 934, 935, 936, 937, 938, 939, 940, 941, 942, 943, 944, 945, 946, 947, 948, 949, 950, 951, 952, 953, 954, 955, 956, 957, 958, 959, 960, 961, 962, 963, 964, 965, 966, 967, 968, 969, 970, 971, 972, 973, 974, 975, 976, 977, 978, 979, 980, 981, 982, 983, 984, 985, 986, 987, 988, 989, 990, 991, 992, 993, 994, 995, 996, 997, 998, 999, 1000, 1001, 1002, 1003, 1004, 1005, 1006, 1007, 1008, 1009, 1010, 1011, 1012, 1013, 1014, 1015, 1016, 1017, 1018, 1019, 1020, 1021, 1022, 1023, 540, 604, 668, 732, 11, 75, 139, 203, 274, 338, 402, 466, 539, 603, 667, 731, 273, 337, 401, 465, 538, 602, 666, 730, 10, 74, 138, 202, 537, 601, 665, 729, 272, 336, 400, 464, 536, 600, 664, 728, 9, 73, 137, 201, 271, 335, 399, 463, 535, 599, 663, 727, 534, 598, 662, 726, 270, 334, 398, 462, 533, 597, 661, 725, 8, 72, 136, 200, 269, 333, 397, 461, 532, 596, 660, 724, 531, 595, 659, 723, 268, 332, 396, 460, 7, 71, 135, 199, 530, 594, 658, 722, 267, 331, 395, 459, 529, 593, 657, 721, 528, 592, 656, 720, 6, 70, 134, 198, 266, 330, 394, 458, 527, 591, 655, 719, 265, 329, 393, 457, 526, 590, 654, 718, 5, 69, 133, 197, 525, 589, 653, 717, 264, 328, 392, 456, 524, 588, 652, 716, 4, 68, 132, 196, 263, 327, 391, 455, 523, 587, 651, 715, 522, 586, 650, 714, 262, 326, 390, 454, 521, 585, 649, 713, 3, 67, 131, 195, 261, 325, 389, 453, 520, 584, 648, 712, 519, 583, 647, 711, 260, 324, 388, 452, 2, 66, 130, 194, 518, 582, 646, 710, 259, 323, 387, 451, 517, 581, 645, 709, 516, 580, 644, 708, 1, 65, 129, 193, 258, 322, 386, 450, 515, 579, 643, 707, 257, 321, 385, 449, 514, 578, 642, 706, 0, 64, 128, 192, 513, 577, 641, 705, 256, 320, 384, 448, 512, 576, 640, 704};
__device__ __constant__ unsigned char kWgOrder[96] = {7, 15, 23, 31, 6, 14, 22, 30, 39, 47, 55, 63, 5, 13, 21, 29, 38, 46, 54, 62, 4, 12, 20, 28, 71, 79, 87, 95, 37, 45, 53, 61, 70, 78, 86, 94, 3, 11, 19, 27, 36, 44, 52, 60, 69, 77, 85, 93, 35, 43, 51, 59, 68, 76, 84, 92, 2, 10, 18, 26, 67, 75, 83, 91, 34, 42, 50, 58, 1, 9, 17, 25, 66, 74, 82, 90, 33, 41, 49, 57, 65, 73, 81, 89, 0, 8, 16, 24, 32, 40, 48, 56, 64, 72, 80, 88};
__device__ __constant__ int kBucketStart[16] = {16, 22, 30, 40, 54, 73, 99, 134, 182, 246, 332, 450, 609, 825, 1117, 1513};
DEVI int t5_bucket(int n) {
    if (n < 16) return n;
    int b = 16;
#pragma unroll
    for (int j = 1; j < 16; ++j) b += (n >= kBucketStart[j]) ? 1 : 0;
    return b;
}


#define XB_TMO      128
#define XB_XCNT(j)  (256  + 64 * (j))
#define XB_XSUB(j)  (1280 + 64 * (j))
#define XB_XGEN(j)  (2304 + 64 * (j))
#define XB_TOP      3328
#define XB_TOPGEN   3392
#define XCD_BAR_WORDS 3456
#define XB_SPIN_CAP (1u << 18)
__device__ __forceinline__ unsigned xb_ld(unsigned* p)              { return __hip_atomic_load(p, __ATOMIC_RELAXED, __HIP_MEMORY_SCOPE_AGENT); }
__device__ __forceinline__ unsigned xb_add(unsigned* p, unsigned v) { return __hip_atomic_fetch_add(p, v, __ATOMIC_RELAXED, __HIP_MEMORY_SCOPE_AGENT); }
__device__ __forceinline__ unsigned xb_xcc_id() { return (unsigned)__builtin_amdgcn_s_getreg((3 << 11) | 20) & 0xFu; }
#define XB_SPIN(cond, bar) do { unsigned _sp = 0; while (cond) { __builtin_amdgcn_s_sleep(1); \
    if ((++_sp & 255u) == 0u) { if (xb_ld(&(bar)[XB_TMO])) break; if (_sp > XB_SPIN_CAP) { atomicAdd(&(bar)[XB_TMO], 1u); break; } } } } while (0)
struct XcdBarrier { unsigned* bar; unsigned x; volatile LAS unsigned* st; };
__device__ __forceinline__ XcdBarrier xcd_barrier_post(unsigned* bar, volatile LAS unsigned* st) {
    XcdBarrier b; b.bar = bar; b.x = xb_xcc_id(); b.st = st;
    if (threadIdx.x == 0) (void)xb_add(&bar[XB_XCNT(b.x)], 1u);
    return b;
}
__device__ __forceinline__ void xcd_barrier_complete(unsigned* bar, unsigned x, unsigned& nloc, unsigned& nx) {
    const unsigned G = gridDim.x * gridDim.y * gridDim.z;
    unsigned sum, cnt, mine, sp = 0u;
    for (;;) {
        sum = 0u; cnt = 0u; mine = 0u;
#pragma unroll
        for (unsigned j = 0; j < 16; ++j) { const unsigned c = xb_ld(&bar[XB_XCNT(j)]); sum += c; cnt += (c > 0u) ? 1u : 0u; mine = (j == x) ? c : mine; }
        if (sum == G) break;
        __builtin_amdgcn_s_sleep(1);
        if ((++sp & 255u) == 0u) { if (xb_ld(&bar[XB_TMO])) break; if (sp > XB_SPIN_CAP) { atomicAdd(&bar[XB_TMO], 1u); break; } }
    }
    nloc = mine > 0u ? mine : 1u; nx = cnt > 0u ? cnt : 1u;
}
__device__ __forceinline__ void xcd_barrier(const XcdBarrier& b) {
    asm volatile("s_waitcnt vmcnt(0)" ::: "memory");
    __syncthreads();
    if (otid() == 0) {
        unsigned* bar = b.bar; unsigned bx = b.x; asm volatile("" : "+s"(bx));
        __builtin_amdgcn_s_waitcnt(0);
        unsigned nloc = b.st[0], nx = b.st[1];
        if (nloc == 0u) { xcd_barrier_complete(bar, bx, nloc, nx); b.st[0] = nloc; b.st[1] = nx; }
        const unsigned old = xb_add(&bar[XB_XSUB(bx)], 1u);
        const unsigned gen = old / nloc;
        if (old + 1u == (gen + 1u) * nloc) {
            __builtin_amdgcn_fence(__ATOMIC_RELEASE, "agent");
            asm volatile("s_waitcnt vmcnt(0)" ::: "memory");
            const unsigned og = xb_add(&bar[XB_TOP], 1u);
            const unsigned tg = og / nx;
            if (og + 1u == (tg + 1u) * nx) xb_add(&bar[XB_TOPGEN], 1u);
            else XB_SPIN(xb_ld(&bar[XB_TOPGEN]) == tg, bar);
            __builtin_amdgcn_fence(__ATOMIC_ACQUIRE, "agent");
            xb_add(&bar[XB_XGEN(bx)], 1u);
            asm volatile("s_waitcnt vmcnt(0)" ::: "memory");
        } else {
            XB_SPIN(xb_ld(&bar[XB_XGEN(bx)]) == gen, bar);
            __builtin_amdgcn_fence(__ATOMIC_ACQUIRE, "agent");
            asm volatile("s_waitcnt vmcnt(0)" ::: "memory");
        }
    }
    __syncthreads();
}

namespace pg8 {
#define PG8_LAS __attribute__((address_space(3)))
typedef unsigned short bf16_t;
typedef _Float16 f16x8 __attribute__((ext_vector_type(8)));
typedef float f32x4 __attribute__((ext_vector_type(4)));
typedef unsigned u32x4 __attribute__((ext_vector_type(4)));
constexpr int BM = 256, BK = 64, HALF = 128, HTB = HALF * BK * 2  , STAGE_BYTES = 8 * HTB, NXCD = 8, WGM = 8;

__host__ __device__ __forceinline__ int lds_byte(int r, int c) { const int st = (r >> 4) * 2 + (c >> 5), rr = r & 15, cc = c & 31, ob = rr * 64 + cc * 2; return st * 1024 + (ob ^ (((ob >> 9) & 1) << 5)); }
__host__ __device__ __forceinline__ void stage_rc(int b, int& R, int& C) { const int st = b / 1024, sb = b % 1024, swz = sb ^ (((sb >> 9) & 1) << 5); R = (st >> 1) * 16 + swz / 64; C = (st & 1) * 32 + (swz % 64) / 2; }
__host__ __device__ __forceinline__ int perm32(int rho) { const int n = rho >> 4, i = rho & 15; return 8 * (i >> 2) + 4 * n + (i & 3); }

struct Unit { int pm, pn; };
struct Gemm { const bf16_t* A; const bf16_t* Bt; int M, N, K; };

struct StaticOrder {
    int nM, nN, nwg, G, c;
    __host__ __device__ void init(int M, int N, int G_, int c_) { nM = M / BM; nN = N / BM; nwg = nM * nN; G = G_; c = c_; }
    __host__ __device__ bool next(int i, Unit& u) const {
        const long L = (long)i * G + c; if (L >= nwg) return false;
        int wgid = (int)L; { const int q = nwg / NXCD, r = nwg % NXCD, xcd = wgid % NXCD, off = wgid / NXCD; wgid = (xcd < r ? xcd * (q + 1) : r * (q + 1) + (xcd - r) * q) + off; }
        const int nig = WGM * nN, gid = wgid / nig, fm = gid * WGM, gsz = (nM - fm) < WGM ? (nM - fm) : WGM;
        u.pm = fm + ((wgid % nig) % gsz); u.pn = (wgid % nig) / gsz; return true;
    }
    __device__ __forceinline__ void a_ready(const Unit&) const {}
    __device__ __forceinline__ void done(const Unit&) const {}
};

template <class Epi, class Sched, bool ALIGN_EPI = false, bool SP2 = false>
__device__ __forceinline__ void gemm_phase(PG8_LAS unsigned char* lds, const Gemm g, const Sched& S, const Epi& E) {
    const int tid = otid(), wid = __builtin_amdgcn_readfirstlane(tid >> 6), lane = tid & 63, wr = wid >> 2, wc = wid & 3, fr = lane & 15, fq = lane >> 4;
    const int K = g.K, nt = K / BK;
    unsigned voffA[2], voffB[2];
#pragma unroll
    for (int i = 0; i < 2; ++i) { int R, C; stage_rc(tid * 16 + i * 8192, R, C); const int Rb = Epi::PERM ? ((R & ~31) + perm32(R & 31)) : R;
        voffA[i] = (unsigned)(R * K + C) * 2u; voffB[i] = (unsigned)(Rb * K + C) * 2u; }
    const size_t kstep = (size_t)(BK * 2);
    const size_t hstep = (size_t)HALF * K * 2;
    const size_t tstep = 2 * hstep;
    const unsigned ldsw = (unsigned)wid * 1024u;
    const int aoff = lds_byte(wr * 64 + fr, fq * 8), boff = lds_byte(wc * 32 + fr, fq * 8);
#define PG8_SA(b, h) (((b) * 2 + (h)) * HTB)
#define PG8_SB(b, h) ((4 + (b) * 2 + (h)) * HTB)
#define PG8_STAGE(bufoff, gbase, voff) do { _Pragma("unroll") for (int _i = 0; _i < 2; ++_i) \
        __builtin_amdgcn_global_load_lds((const unsigned*)((const char*)(gbase) + (voff)[_i]), (PG8_LAS unsigned*)(lds + (bufoff) + ldsw + _i * 8192), 16, 0, 0); } while (0)
#define PG8_LDA(dst, b, h) do { _Pragma("unroll") for (int m = 0; m < 4; ++m) _Pragma("unroll") for (int k = 0; k < 2; ++k) dst[m][k] = *(const PG8_LAS f16x8*)(lds + PG8_SA(b, h) + aoff + m * 2048 + k * 1024); } while (0)
#define PG8_LDB(dst, b, h) do { _Pragma("unroll") for (int n = 0; n < 2; ++n) _Pragma("unroll") for (int k = 0; k < 2; ++k) dst[n][k] = *(const PG8_LAS f16x8*)(lds + PG8_SB(b, h) + boff + n * 2048 + k * 1024); } while (0)
#define PG8_MMA(ai, bj, At, Bt) do { __builtin_amdgcn_s_setprio(1); _Pragma("unroll") for (int m = 0; m < 4; ++m) _Pragma("unroll") for (int n = 0; n < 2; ++n) _Pragma("unroll") for (int k = 0; k < 2; ++k) \
        acc[ai][bj][m][n] = __builtin_amdgcn_mfma_f32_16x16x32_f16(Bt[n][k], At[m][k], acc[ai][bj][m][n], 0, 0, 0); __builtin_amdgcn_s_setprio(0); } while (0)
#define PG8_WAIT_V(n) asm volatile("s_waitcnt vmcnt(" #n ")" ::: "memory")
#define PG8_WAIT_L(n) asm volatile("s_waitcnt lgkmcnt(" #n ")" ::: "memory")
#define PG8_BAR __builtin_amdgcn_s_barrier()
#define PG8_SCHED __builtin_amdgcn_sched_barrier(0)
    Unit cur, nxt; int ui = 0;
    if (!S.next(0, cur)) return;
    f32x4 acc[2][2][4][2];
#pragma unroll
    for (int a = 0; a < 2; ++a)
#pragma unroll
        for (int b = 0; b < 2; ++b)
#pragma unroll
            for (int m = 0; m < 4; ++m)
#pragma unroll
                for (int n = 0; n < 2; ++n) acc[a][b][m][n] = (f32x4){0.f, 0.f, 0.f, 0.f};
    f16x8 At[4][2], B0[2][2], B1[2][2];
    const char* cA = (const char*)g.A + (size_t)cur.pm * tstep; const char* cB = (const char*)g.Bt + (size_t)cur.pn * tstep;
    S.a_ready(cur);
    if constexpr (SP2) {
        PG8_STAGE(PG8_SB(0, 0), cB, voffB); PG8_STAGE(PG8_SB(0, 1), cB + hstep, voffB); PG8_STAGE(PG8_SA(0, 0), cA, voffA); PG8_STAGE(PG8_SA(0, 1), cA + hstep, voffA);
        if (wr == 1) PG8_BAR;
        PG8_WAIT_V(2); PG8_BAR;
        PG8_STAGE(PG8_SB(1, 0), cB + kstep, voffB); PG8_STAGE(PG8_SA(1, 0), cA + kstep, voffA); PG8_STAGE(PG8_SB(1, 1), cB + hstep + kstep, voffB);
        PG8_WAIT_V(6); PG8_BAR;
    } else {
        PG8_STAGE(PG8_SB(0, 0), cB, voffB); PG8_STAGE(PG8_SA(0, 0), cA, voffA); PG8_STAGE(PG8_SB(0, 1), cB + hstep, voffB); PG8_STAGE(PG8_SA(0, 1), cA + hstep, voffA);
        if (wr == 1) PG8_BAR;
        PG8_WAIT_V(4); PG8_BAR;
        PG8_STAGE(PG8_SB(1, 0), cB + kstep, voffB); PG8_STAGE(PG8_SA(1, 0), cA + kstep, voffA); PG8_STAGE(PG8_SB(1, 1), cB + hstep + kstep, voffB);
        PG8_WAIT_V(6); PG8_BAR;
    }
    for (;;) {
        const bool has_next = S.next(ui + 1, nxt);
        const char* nA = has_next ? (const char*)g.A + (size_t)nxt.pm * tstep : cA; const char* nB = has_next ? (const char*)g.Bt + (size_t)nxt.pn * tstep : cB;
        for (int t = 0; t < nt; t += 2) {
            const bool last = (t == nt - 2);
            const char* a1 = cA + (size_t)(t + 1) * kstep;
            const char* a2 = last ? nA : cA + (size_t)(t + 2) * kstep; const char* b2 = last ? nB : cB + (size_t)(t + 2) * kstep;
            const char* a3 = a2 + kstep; const char* b3 = b2 + kstep;
            if (last && has_next) S.a_ready(nxt);
            if constexpr (SP2) {
            PG8_LDB(B0, 0, 0); PG8_LDB(B1, 0, 1); PG8_SCHED; PG8_LDA(At, 0, 0); PG8_STAGE(PG8_SA(1, 1), a1 + hstep, voffA);
            PG8_WAIT_V(8); PG8_WAIT_L(0); PG8_BAR; PG8_MMA(0, 0, At, B0); PG8_MMA(0, 1, At, B1); PG8_BAR; PG8_SCHED;
            PG8_LDA(At, 0, 1); PG8_STAGE(PG8_SB(0, 0), b2, voffB); PG8_STAGE(PG8_SB(0, 1), b2 + hstep, voffB); PG8_STAGE(PG8_SA(0, 0), a2, voffA);
            PG8_WAIT_V(8); PG8_WAIT_L(0); PG8_BAR; PG8_MMA(1, 0, At, B0); PG8_MMA(1, 1, At, B1); PG8_BAR; PG8_SCHED;
            PG8_LDB(B0, 1, 0); PG8_LDB(B1, 1, 1); PG8_SCHED; PG8_LDA(At, 1, 0); PG8_STAGE(PG8_SA(0, 1), a2 + hstep, voffA);
            PG8_WAIT_V(8); PG8_WAIT_L(0); PG8_BAR; PG8_MMA(0, 0, At, B0); PG8_MMA(0, 1, At, B1); PG8_BAR; PG8_SCHED;
            PG8_LDA(At, 1, 1); PG8_STAGE(PG8_SB(1, 0), b3, voffB); PG8_STAGE(PG8_SB(1, 1), b3 + hstep, voffB); PG8_STAGE(PG8_SA(1, 0), a3, voffA);
            PG8_WAIT_V(8); PG8_WAIT_L(0); PG8_BAR; PG8_MMA(1, 0, At, B0); PG8_MMA(1, 1, At, B1); PG8_BAR; PG8_SCHED;
            } else {
            PG8_LDB(B0, 0, 0); PG8_SCHED; PG8_LDA(At, 0, 0); PG8_STAGE(PG8_SA(1, 1), a1 + hstep, voffA);
            PG8_WAIT_L(8); PG8_BAR; PG8_WAIT_L(0); PG8_MMA(0, 0, At, B0); PG8_BAR; PG8_SCHED;
            PG8_LDB(B1, 0, 1); PG8_STAGE(PG8_SB(0, 0), b2, voffB);
            PG8_BAR; PG8_WAIT_L(0); PG8_MMA(0, 1, At, B1); PG8_BAR;
            PG8_LDA(At, 0, 1); PG8_STAGE(PG8_SA(0, 0), a2, voffA);
            PG8_BAR; PG8_WAIT_L(0); PG8_MMA(1, 0, At, B0); PG8_BAR; PG8_SCHED;
            PG8_STAGE(PG8_SB(0, 1), b2 + hstep, voffB);
            PG8_WAIT_V(6); PG8_BAR; PG8_MMA(1, 1, At, B1); PG8_BAR;
            PG8_LDB(B0, 1, 0); PG8_SCHED; PG8_LDA(At, 1, 0); PG8_STAGE(PG8_SA(0, 1), a2 + hstep, voffA);
            PG8_WAIT_L(8); PG8_BAR; PG8_WAIT_L(0); PG8_MMA(0, 0, At, B0); PG8_BAR; PG8_SCHED;
            PG8_LDB(B1, 1, 1); PG8_STAGE(PG8_SB(1, 0), b3, voffB);
            PG8_BAR; PG8_WAIT_L(0); PG8_MMA(0, 1, At, B1); PG8_BAR;
            PG8_LDA(At, 1, 1); PG8_STAGE(PG8_SA(1, 0), a3, voffA);
            PG8_BAR; PG8_WAIT_L(0); PG8_MMA(1, 0, At, B0); PG8_BAR; PG8_SCHED;
            PG8_STAGE(PG8_SB(1, 1), b3 + hstep, voffB);
            PG8_WAIT_V(6); PG8_BAR; PG8_MMA(1, 1, At, B1); PG8_BAR;
            }
        }
        if constexpr (ALIGN_EPI) { if (wr == 0) PG8_BAR; }
        if constexpr (!Epi::AFTER_DRAIN) { E(acc, cur, wr, wc, fr, fq); S.done(cur); }
        if (!has_next) break;
#pragma unroll
        for (int a = 0; a < 2; ++a)
#pragma unroll
            for (int b = 0; b < 2; ++b)
#pragma unroll
                for (int m = 0; m < 4; ++m)
#pragma unroll
                    for (int n = 0; n < 2; ++n) acc[a][b][m][n] = (f32x4){0.f, 0.f, 0.f, 0.f};
        cur = nxt; cA = nA; cB = nB; ++ui;
        if constexpr (ALIGN_EPI) { if (wr == 1) PG8_BAR; }
    }
    PG8_WAIT_V(0);
    if constexpr (!ALIGN_EPI) { if (wr == 0) PG8_BAR; }
    PG8_BAR;
    if constexpr (Epi::AFTER_DRAIN) { E.fused(acc, cur, wr, wc, fr, fq, lds, wid, lane); S.done(cur); }
#undef PG8_SA
#undef PG8_SB
#undef PG8_STAGE
#undef PG8_LDA
#undef PG8_LDB
#undef PG8_MMA
#undef PG8_WAIT_V
#undef PG8_WAIT_L
#undef PG8_BAR
#undef PG8_SCHED
}
}


typedef float f32x4_t __attribute__((ext_vector_type(4)));
typedef _Float16 h16x8 __attribute__((ext_vector_type(8)));
DEVI float silu_f(float v) { return v / (1.f + __expf(-v)); }
struct EpiRoute {
    static constexpr bool PERM = true, AFTER_DRAIN = false;
    gu8* ws; const gf32* ssq;
    DEVI void operator()(const pg8::f32x4 (&acc)[2][2][4][2], const pg8::Unit& u, int wr, int wc, int fr, int fq) const {
        const int row0 = u.pm * 256 + wr * 64 + fr;
        float rs[2][4];
#pragma unroll
        for (int ai = 0; ai < 2; ++ai)
#pragma unroll
            for (int m = 0; m < 4; ++m) { const int rw = row0 + ai * 128 + m * 16; rs[ai][m] = rsqrtf((ssq[rw] + ssq[NT + rw] + ssq[2 * NT + rw] + ssq[3 * NT + rw]) * (1.f / DM) + EPS); }
#pragma unroll
        for (int bj = 0; bj < 2; ++bj) {
            const int cg = u.pn * 256 + bj * 128 + wc * 32;
            const Route r = route(cg);
            if (r.kind < 0) continue;
            gh16* base = (gh16*)(ws + r.off);
            const int c = r.dcol + 8 * fq;
#pragma unroll
            for (int ai = 0; ai < 2; ++ai)
#pragma unroll
                for (int m = 0; m < 4; ++m) {
                    const int row = row0 + ai * 128 + m * 16; const float sc = rs[ai][m] * r.scale;
                    float v[8];
#pragma unroll
                    for (int j = 0; j < 4; ++j) { v[j] = acc[ai][bj][m][0][j] * sc; v[4 + j] = acc[ai][bj][m][1][j] * sc; }
                    if (r.silu) {
#pragma unroll
                        for (int j = 0; j < 8; ++j) v[j] = silu_f(v[j]);
                    }
                    h16x8 o;
#pragma unroll
                    for (int j = 0; j < 8; ++j) o[j] = (h16)v[j];
                    if (r.kind == 0) *(GAS h16x8*)(base + (size_t)row * r.pitch + c) = o;
                    else {
                        const int b = row >> 11, sq = row & 2047;
                        if (r.kind == 3) *(GAS h16x8*)(base + (((size_t)b * 128 + (sq >> 4)) * 64 + (sq & 15) + 16 * (c >> 3)) * 8) = o;
                        else {
                            const int bh = b * 4 + (c >> 6), d0 = c & 63;
                            *(GAS h16x8*)(base + kf_off(bh, sq, d0)) = o;
                            if (r.kind == 2) { *(GAS h16x8*)(base + FSZ + kf4_off(bh, sq, d0)) = o; *(GAS h16x8*)(base + 2 * FSZ + kf16_off(bh, sq, d0)) = o; }
                        }
                    }
                }
        }
    }
};

struct EpiOut {
    static constexpr bool PERM = true, AFTER_DRAIN = true;
    const gf32* h_in; gf32* h_out; gh16* h16o; const gf32* gpost; gf32* ssqy; gf32* ssqh; const XcdBarrier* bar; bool write_next;
    DEVI void rowsum_publish(const float (&ps)[2][4], gf32* dst, const pg8::Unit& u, int wr, int wc, int fr, int fq, PG8_LAS unsigned char* lds) const {
        lf32* red = (lf32*)lds;
        __syncthreads();
#pragma unroll
        for (int ai = 0; ai < 2; ++ai)
#pragma unroll
            for (int m = 0; m < 4; ++m) { float v = ps[ai][m]; v += __shfl_xor(v, 16); v += __shfl_xor(v, 32); if (fq == 0) red[wc * 256 + ai * 128 + wr * 64 + m * 16 + fr] = v; }
        __syncthreads();
        const int t = otid();
        if (t < 256) dst[(size_t)u.pn * NT + u.pm * 256 + t] = red[t] + red[256 + t] + red[512 + t] + red[768 + t];
    }
    DEVI void fused(pg8::f32x4 (&acc)[2][2][4][2], const pg8::Unit& u, int wr, int wc, int fr, int fq, PG8_LAS unsigned char* lds, int wid, int lane) const {
        float ps[2][4];
#pragma unroll
        for (int ai = 0; ai < 2; ++ai)
#pragma unroll
            for (int m = 0; m < 4; ++m) { float v = 0.f;
#pragma unroll
                for (int bj = 0; bj < 2; ++bj)
#pragma unroll
                    for (int n = 0; n < 2; ++n)
#pragma unroll
                        for (int e = 0; e < 4; ++e) v += acc[ai][bj][m][n][e] * acc[ai][bj][m][n][e];
                ps[ai][m] = v; }
        rowsum_publish(ps, ssqy, u, wr, wc, fr, fq, lds);
        xcd_barrier(*bar);
        const int row0 = u.pm * 256 + wr * 64 + fr;
#pragma unroll
        for (int ai = 0; ai < 2; ++ai)
#pragma unroll
            for (int m = 0; m < 4; ++m) {
                const int row = row0 + ai * 128 + m * 16;
                const float rs = rsqrtf((ssqy[row] + ssqy[NT + row] + ssqy[2 * NT + row] + ssqy[3 * NT + row]) * (1.f / DM) + EPS);
                float v2 = 0.f;
#pragma unroll
                for (int bj = 0; bj < 2; ++bj) {
                    const int col = u.pn * 256 + bj * 128 + wc * 32 + 8 * fq;
                    const size_t off = (size_t)row * DM + col;
                    h16x8 oh;
#pragma unroll
                    for (int n = 0; n < 2; ++n) {
                        const f32x4_t hv = *(const GAS f32x4_t*)(h_in + off + 4 * n), gv = *(const GAS f32x4_t*)(gpost + col + 4 * n);
                        f32x4_t o;
#pragma unroll
                        for (int e = 0; e < 4; ++e) { o[e] = hv[e] + acc[ai][bj][m][n][e] * rs * gv[e]; v2 += o[e] * o[e]; oh[4 * n + e] = (h16)o[e]; }
                        *(GAS f32x4_t*)(h_out + off + 4 * n) = o;
                    }
                    if (write_next) *(GAS h16x8*)(h16o + off) = oh;
                }
                ps[ai][m] = v2;
            }
        if (write_next) rowsum_publish(ps, ssqh, u, wr, wc, fr, fq, lds);
    }
    DEVI void operator()(const pg8::f32x4 (&)[2][2][4][2], const pg8::Unit&, int, int, int, int) const {}
};

constexpr int NTHR = 512, NWAVE = 8;

template <bool REF>
DEVI void cvt_transpose(const gf32* __restrict__ src, int src_pitch, const gf32* __restrict__ g, gh16* dst, int N, int K, lu8* lds, int item0, int nitems_total, int& item_base) {
    const int tid = otid();
    LAS float (*tile)[65] = (LAS float (*)[65])lds;
    const int ntn = N / 64, ntk = K / 64, n_it = ntn * ntk;
    for (int it = item0; it < nitems_total; it += gridDim.x) {
        const int li = it - item_base; if (li < 0 || li >= n_it) continue;
        const int n0 = (li % ntn) * 64, k0 = (li / ntn) * 64;
        __syncthreads();
        const int c = tid & 63; int rc = n0 + c; if (REF) rc = ref_col(rc);
#pragma unroll
        for (int ps = 0; ps < 8; ++ps) { const int k = ps * 8 + (tid >> 6);
            tile[k][c] = rc >= 0 ? src[(size_t)(k0 + k) * src_pitch + rc] * (g ? g[k0 + k] : 1.f) : 0.f; }
        __syncthreads();
        const int cc = tid >> 3, kq = (tid & 7) * 8;
        h16x8 o;
#pragma unroll
        for (int j = 0; j < 8; ++j) o[j] = (h16)tile[kq + j][cc];
        *(GAS h16x8*)(dst + (size_t)(n0 + cc) * K + k0 + kq) = o;
    }
    item_base += n_it;
}

DEVI void ph_rowstat_cvt(const gf32* h, gf32* ssq, gh16* h16o) {
    const int t_ = otid(); const int lane = t_ & 63, gw = blockIdx.x * NWAVE + (t_ >> 6), nw = gridDim.x * NWAVE;
    for (int row = gw; row < NT; row += nw) {
        const GAS f32x4_t* p = (const GAS f32x4_t*)(h + (size_t)row * DM);
        float s = 0.f;
#pragma unroll
        for (int i = 0; i < 4; ++i) { f32x4_t v = p[lane + 64 * i]; s += v[0] * v[0] + v[1] * v[1] + v[2] * v[2] + v[3] * v[3];
            typedef _Float16 h16x4 __attribute__((ext_vector_type(4)));
            h16x4 o; o[0] = (h16)v[0]; o[1] = (h16)v[1]; o[2] = (h16)v[2]; o[3] = (h16)v[3];
            *(GAS h16x4*)(h16o + (size_t)row * DM + (lane + 64 * i) * 4) = o; }
        for (int o = 32; o; o >>= 1) s += __shfl_xor(s, o);
        if (lane == 0) { ssq[row] = s; ssq[NT + row] = 0.f; ssq[2 * NT + row] = 0.f; ssq[3 * NT + row] = 0.f; }
    }
}

typedef float f32x16 __attribute__((ext_vector_type(16)));
typedef _Float16 h16x4 __attribute__((ext_vector_type(4)));
DEVI f32x16 mfma32(h16x8 a, h16x8 b, f32x16 c) { return __builtin_amdgcn_mfma_f32_32x32x16_f16(a, b, c, 0, 0, 0); }
#define CROW(r) (((r) & 3) + 8 * ((r) >> 2))
DEVI float xh_max(float x) { auto r = __builtin_amdgcn_permlane32_swap(__float_as_uint(x), __float_as_uint(x), false, false); return fmaxf(__uint_as_float(r[0]), __uint_as_float(r[1])); }
DEVI float xh_sum(float x) { auto r = __builtin_amdgcn_permlane32_swap(__float_as_uint(x), __float_as_uint(x), false, false); return __uint_as_float(r[0]) + __uint_as_float(r[1]); }
DEVI unsigned pk2h(float a, float b) { auto v = __builtin_amdgcn_cvt_pkrtz(a, b); return __builtin_bit_cast(unsigned, v); }
DEVI h16x8 pack8(const f32x16& p, int s) {
    typedef unsigned u32x4_t __attribute__((ext_vector_type(4)));
    u32x4_t w;
    w[0] = pk2h(p[8 * s + 0], p[8 * s + 1]); w[1] = pk2h(p[8 * s + 2], p[8 * s + 3]); w[2] = pk2h(p[8 * s + 4], p[8 * s + 5]); w[3] = pk2h(p[8 * s + 6], p[8 * s + 7]);
    return __builtin_bit_cast(h16x8, w);
}
DEVI h16x8 ldv8(const gh16* p) {
    h16x4 a = *(const GAS h16x4*)p, b = *(const GAS h16x4*)(p + 8);
    h16x8 r; r[0] = a[0]; r[1] = a[1]; r[2] = a[2]; r[3] = a[3]; r[4] = b[0]; r[5] = b[1]; r[6] = b[2]; r[7] = b[3]; return r;
}
DEVI void softmax_tile(f32x16& S, float& m, float& l, f32x16& O0, f32x16& O1) {
    float mx = S[0];
#pragma unroll
    for (int r = 1; r < 16; ++r) mx = fmaxf(mx, S[r]);
    mx = xh_max(mx);
    if (__any(mx > m)) {
        const float mn = fmaxf(m, mx), al = __builtin_amdgcn_exp2f(m - mn);
        l *= al; O0 *= al; O1 *= al; m = mn;
    }
#pragma unroll
    for (int r = 0; r < 16; ++r) S[r] = __builtin_amdgcn_exp2f(S[r] - m);
    l += ((S[0] + S[1]) + (S[2] + S[3])) + ((S[4] + S[5]) + (S[6] + S[7])) + (((S[8] + S[9]) + (S[10] + S[11])) + ((S[12] + S[13]) + (S[14] + S[15])));
}
DEVI int wq_next(gu32* ctr) {
    int e = 0;
    if ((otid() & 63) == 0) e = (int)__hip_atomic_fetch_add(ctr, 1u, __ATOMIC_RELAXED, __HIP_MEMORY_SCOPE_AGENT);
    return __builtin_amdgcn_readfirstlane(e);
}

DEVI void flashA_item(int b, int hh, int qt, const gh16* qA, const gh16* KF, const gh16* KRF, const gh16* VF, const gh16* gate, gh16* mix) {
    const int lane = otid() & 63, q = lane & 31, h = lane >> 5;
    const size_t tokq = (size_t)b * SEQ + qt * 32 + q;
    h16x8 qf[6];
#pragma unroll
    for (int ks = 0; ks < 6; ++ks) qf[ks] = *(const GAS h16x8*)(qA + tokq * 384 + hh * 96 + ks * 16 + 8 * h);
    f32x16 O0 = {}, O1 = {};
    float m = -1e30f, l = 0.f;
    const gh16* kp = KF + (size_t)(b * 4 + hh) * 64 * 2048 + lane * 8;
    const gh16* rp = KRF + (size_t)b * 64 * 1024 + lane * 8;
    const gh16* vp = VF + (size_t)(b * 4 + hh) * 64 * 2048 + lane * 8;
    h16x8 kf[6];
#pragma unroll
    for (int ks = 0; ks < 4; ++ks) kf[ks] = *(const GAS h16x8*)(kp + ks * 512);
#pragma unroll
    for (int ks = 0; ks < 2; ++ks) kf[4 + ks] = *(const GAS h16x8*)(rp + ks * 512);
    h16x8 vf[4], vn[4];
#pragma unroll
    for (int f = 0; f < 4; ++f) vf[f] = *(const GAS h16x8*)(vp + f * 512);
    for (int j = 0; j <= qt; ++j) {
        f32x16 S = {};
#pragma unroll
        for (int ks = 0; ks < 6; ++ks) S = mfma32(kf[ks], qf[ks], S);
        if (j < qt) {
#pragma unroll
            for (int ks = 0; ks < 4; ++ks) kf[ks] = *(const GAS h16x8*)(kp + (size_t)(j + 1) * 2048 + ks * 512);
#pragma unroll
            for (int ks = 0; ks < 2; ++ks) kf[4 + ks] = *(const GAS h16x8*)(rp + (size_t)(j + 1) * 1024 + ks * 512);
#pragma unroll
            for (int f = 0; f < 4; ++f) vn[f] = *(const GAS h16x8*)(vp + (size_t)(j + 1) * 2048 + f * 512);
        } else {
#pragma unroll
            for (int r = 0; r < 16; ++r) S[r] = (CROW(r) + 4 * h > q) ? -3e38f : S[r];
        }
        softmax_tile(S, m, l, O0, O1);
        const h16x8 p0 = pack8(S, 0), p1 = pack8(S, 1);
        O0 = mfma32(vf[0], p0, O0); O0 = mfma32(vf[1], p1, O0);
        O1 = mfma32(vf[2], p0, O1); O1 = mfma32(vf[3], p1, O1);
#pragma unroll
        for (int f = 0; f < 4; ++f) vf[f] = vn[f];
    }
    const float il = 1.f / xh_sum(l);
    const gh16* gp = gate + tokq * 1024 + hh * 64 + 4 * h;
#pragma unroll
    for (int db = 0; db < 2; ++db)
#pragma unroll
        for (int g = 0; g < 4; ++g) {
            const h16x4 gv = *(const GAS h16x4*)(gp + db * 32 + 8 * g); h16x4 o;
#pragma unroll
            for (int e = 0; e < 4; ++e) o[e] = (h16)((db ? O1[4 * g + e] : O0[4 * g + e]) * il * (float)gv[e]);
            *(GAS h16x4*)(mix + mixf_off(tokq, hh * 64 + db * 32 + 8 * g + 4 * h)) = o;
        }
}

constexpr int L_NEAR = 0, L_R3 = 12288, L_R2 = 15360, L_R1 = 21504, L_LAM = 39936, L_P2END = 40000;
constexpr int L_BIASL = 40000, L_RING = 41984, L_MRING = L_RING + 4 * 10240, L_WQ = L_MRING + 8192;
DEVI void p2_setup(const gf32* biasTab, const gf32* lam_p, float lambda_init, lu8* lds) {
    const int tid = otid();
    lf32* nearR = (lf32*)(lds + L_NEAR);
    for (int i = tid; i < 12 * 256; i += NTHR) { const int hb = i >> 8, u = i & 255, tix = 223 - u; nearR[i] = tix < 0 ? -3e38f : biasTab[hb * 2048 + tix]; }
    lf32* R3 = (lf32*)(lds + L_R3); lf32* R2 = (lf32*)(lds + L_R2); lf32* R1 = (lf32*)(lds + L_R1);
    for (int i = tid; i < 4 * 192; i += NTHR) { const int hb = i / 192, kk = 159 - (i % 192); R3[i] = (kk < 0 || kk > 128) ? -3e38f : biasTab[hb * 2048 + kk * 16]; }
    for (int i = tid; i < 4 * 384; i += NTHR) { const int hb = i / 384, kk = 255 - (i % 384); R2[i] = (kk < 0 || kk > 128) ? -3e38f : biasTab[hb * 2048 + kk * 4]; }
    for (int i = tid; i < 4 * 1152; i += NTHR) { const int hb = i / 1152, kk = 639 - (i % 1152); R1[i] = (kk < 0 || kk > 128) ? -3e38f : biasTab[hb * 2048 + kk]; }
    { lf32* bl = (lf32*)(lds + L_BIASL); for (int i = tid; i < 12 * 32; i += NTHR) { const int hb = i >> 5, k = i & 31; bl[i] = biasTab[hb * 2048 + (k < 16 ? k : kBucketStart[k - 16])]; } }
    if (tid == 0) { float a1 = 0.f, a2 = 0.f; for (int i = 0; i < 32; ++i) { a1 += lam_p[i] * lam_p[32 + i]; a2 += lam_p[64 + i] * lam_p[96 + i]; }
        *(lf32*)(lds + L_LAM) = expf(a1) - expf(a2) + lambda_init; }
    __syncthreads();
}

DEVI void ph_vtrans(const gh16* vtmp, gh16* VF, lu8* lds) {
    const int tid = otid();
    LAS h16 (*tile)[72] = (LAS h16 (*)[72])lds;
    for (int it = blockIdx.x; it < 3 * 32 * 4; it += gridDim.x) {
        const int src = it >> 7, bh = (it >> 2) & 31, blk = it & 3, b = bh >> 2, hh = bh & 3;
        __syncthreads();
#pragma unroll
        for (int k = 0; k < 8; ++k) { const int idx = k * NTHR + tid, row = idx >> 3, c8 = idx & 7;
            *(LAS h16x8*)&tile[row][c8 * 8] = *(const GAS h16x8*)(vtmp + ((size_t)b * SEQ + blk * 512 + row) * 768 + src * 256 + hh * 64 + c8 * 8); }
        __syncthreads();
        gh16* out0 = VF + (src == 0 ? 0 : (src == 1 ? 3 * FSZ : 4 * FSZ));
#pragma unroll 1
        for (int k = 0; k < 8; ++k) {
            const int fl = k * NTHR + tid, lane = fl & 63, frag = (fl >> 6) & 3, dl = lane & 31, hp = lane >> 5, db = frag >> 1, sk = frag & 1;
            {
                const int tl = fl >> 8; h16x8 o;
#pragma unroll
                for (int e = 0; e < 8; ++e) o[e] = tile[tl * 32 + 16 * sk + 8 * (e >> 2) + 4 * hp + (e & 3)][db * 32 + dl];
                *(GAS h16x8*)(out0 + ((((size_t)bh * 64 + blk * 16 + tl) * 4 + frag) * 64 + lane) * 8) = o;
            }
            if (src == 0) {
                {
                    const int r4 = fl >> 10, tl = (fl >> 8) & 3; h16x8 o;
#pragma unroll
                    for (int e = 0; e < 8; ++e) o[e] = tile[4 * (tl * 32 + 16 * sk + 8 * (e >> 2) + 4 * hp + (e & 3)) + r4][db * 32 + dl];
                    *(GAS h16x8*)(out0 + FSZ + (((((size_t)bh * 4 + r4) * 16 + blk * 4 + tl) * 4 + frag) * 64 + lane) * 8) = o;
                }
                {
                    const int r = fl >> 8; h16x8 o;
#pragma unroll
                    for (int e = 0; e < 8; ++e) o[e] = tile[16 * (16 * sk + 8 * (e >> 2) + 4 * hp + (e & 3)) + r][db * 32 + dl];
                    *(GAS h16x8*)(out0 + 2 * FSZ + (((((size_t)bh * 16 + r) * 4 + blk) * 4 + frag) * 64 + lane) * 8) = o;
                }
            }
        }
    }
}

template <int NMAP, bool MASK>
DEVI void flashCD_item(int b, int hh, int qt, int hb, const gh16* Q, const gh16* KF, const gh16* VF, const gu32* mask, const gf32* biasTab, const lu8* lds,
                       const gf32* subln, float lambda_init, const gh16* gate, gh16* mix, int mixcol) {
    constexpr int NKS = 4 / NMAP;
    const int lane = otid() & 63, q = lane & 31, h = lane >> 5;
    const size_t tokq = (size_t)b * SEQ + qt * 32 + q;
    const gh16* kp = KF + (size_t)(b * 4 + hh) * 64 * 2048 + lane * 8;
    const gh16* vp = VF + (size_t)(b * 4 + hh) * 64 * 2048 + lane * 8;
    h16x8 qf[NMAP][NKS], kf[NMAP][NKS];
#pragma unroll
    for (int mp = 0; mp < NMAP; ++mp)
#pragma unroll
        for (int ks = 0; ks < NKS; ++ks) {
            qf[mp][ks] = *(const GAS h16x8*)(Q + tokq * 256 + hh * 64 + (mp * NKS + ks) * 16 + 8 * h);
            kf[mp][ks] = *(const GAS h16x8*)(kp + (mp * NKS + ks) * 512);
        }
    f32x16 O[NMAP][2]; float m[NMAP], l[NMAP];
#pragma unroll
    for (int mp = 0; mp < NMAP; ++mp) { O[mp][0] = (f32x16){}; O[mp][1] = (f32x16){}; m[mp] = -1e30f; l[mp] = 0.f; }
    const lf32* nearR = (const lf32*)(lds + L_NEAR) + hb * 256;
    const gf32* bt = biasTab + hb * 2048;
    h16x8 vf[2][2], vn[2][2];
#pragma unroll
    for (int db = 0; db < 2; ++db)
#pragma unroll
        for (int sk = 0; sk < 2; ++sk) vf[db][sk] = *(const GAS h16x8*)(vp + (db * 2 + sk) * 512);
    unsigned mw = 0xffffffffu, mwn = 0xffffffffu;
    if (MASK) mw = mask[tokq * 64];
    for (int j = 0; j <= qt; ++j) {
        f32x16 S[NMAP];
#pragma unroll
        for (int mp = 0; mp < NMAP; ++mp) { S[mp] = (f32x16){};
#pragma unroll
            for (int ks = 0; ks < NKS; ++ks) S[mp] = mfma32(kf[mp][ks], qf[mp][ks], S[mp]); }
        if (j < qt) {
#pragma unroll
            for (int mp = 0; mp < NMAP; ++mp)
#pragma unroll
                for (int ks = 0; ks < NKS; ++ks) kf[mp][ks] = *(const GAS h16x8*)(kp + (size_t)(j + 1) * 2048 + (mp * NKS + ks) * 512);
#pragma unroll
            for (int db = 0; db < 2; ++db)
#pragma unroll
                for (int sk = 0; sk < 2; ++sk) vn[db][sk] = *(const GAS h16x8*)(vp + (size_t)(j + 1) * 2048 + (db * 2 + sk) * 512);
            if (MASK) mwn = mask[tokq * 64 + j + 1];
        }
        const int D0 = (qt - j) * 32;
        if (D0 < 192) {
            const lf32* tp = nearR + (223 - D0 - q + 4 * h);
#pragma unroll
            for (int r = 0; r < 16; ++r) { const float bv = tp[CROW(r)];
#pragma unroll
                for (int mp = 0; mp < NMAP; ++mp) S[mp][r] += bv; }
        } else {
            const float lo = bt[D0 - 31], hi = bt[D0 + 31];
            if (lo == hi) {
#pragma unroll
                for (int mp = 0; mp < NMAP; ++mp) S[mp] += lo;
            } else {
                int bnd = 0;
#pragma unroll
                for (int jj = 8; jj < 16; ++jj) bnd = (D0 + 31 >= kBucketStart[jj]) ? kBucketStart[jj] : bnd;
                const int x = D0 + q - 4 * h - bnd;
#pragma unroll
                for (int r = 0; r < 16; ++r) { const float bv = (x >= CROW(r)) ? hi : lo;
#pragma unroll
                    for (int mp = 0; mp < NMAP; ++mp) S[mp][r] += bv; }
            }
        }
        if (MASK) {
#pragma unroll
            for (int r = 0; r < 16; ++r) S[0][r] = (((mw >> (4 * h)) >> CROW(r)) & 1u) ? S[0][r] : -3e38f;
        }
#pragma unroll
        for (int mp = 0; mp < NMAP; ++mp) {
            softmax_tile(S[mp], m[mp], l[mp], O[mp][0], O[mp][1]);
            const h16x8 p0 = pack8(S[mp], 0), p1 = pack8(S[mp], 1);
            O[mp][0] = mfma32(vf[0][0], p0, O[mp][0]); O[mp][0] = mfma32(vf[0][1], p1, O[mp][0]);
            O[mp][1] = mfma32(vf[1][0], p0, O[mp][1]); O[mp][1] = mfma32(vf[1][1], p1, O[mp][1]);
        }
#pragma unroll
        for (int db = 0; db < 2; ++db)
#pragma unroll
            for (int sk = 0; sk < 2; ++sk) vf[db][sk] = vn[db][sk];
        mw = mwn;
    }
    f32x16 R0, R1;
    if (NMAP == 2) {
        const float lam = *(const lf32*)(lds + L_LAM);
        const float i0 = 1.f / xh_sum(l[0]), i1 = lam / xh_sum(l[NMAP - 1]);
        R0 = O[0][0] * i0 - O[NMAP - 1][0] * i1; R1 = O[0][1] * i0 - O[NMAP - 1][1] * i1;
        float ss = 0.f;
#pragma unroll
        for (int r = 0; r < 16; ++r) ss += R0[r] * R0[r] + R1[r] * R1[r];
        ss = xh_sum(ss);
        const float rs = rsqrtf(ss * (1.f / 64.f) + EPS) * (1.f - lambda_init);
        R0 *= rs; R1 *= rs;
    } else {
        const float il = 1.f / xh_sum(l[0]);
        R0 = O[0][0] * il; R1 = O[0][1] * il;
    }
    const gh16* gp = gate + tokq * 1024 + mixcol + hh * 64 + 4 * h;
#pragma unroll
    for (int db = 0; db < 2; ++db)
#pragma unroll
        for (int g = 0; g < 4; ++g) {
            const h16x4 gv = *(const GAS h16x4*)(gp + db * 32 + 8 * g); h16x4 o;
#pragma unroll
            for (int e = 0; e < 4; ++e) { float v = (db ? R1[4 * g + e] : R0[4 * g + e]) * (float)gv[e];
                if (NMAP == 2) v *= subln[db * 32 + 8 * g + 4 * h + e];
                o[e] = (h16)v; }
            *(GAS h16x4*)(mix + mixf_off(tokq, mixcol + hh * 64 + db * 32 + 8 * g + 4 * h)) = o;
        }
}

template <int BR>
DEVI void flashQ2_item(int b, int hh, int pr, const gh16* Q, const gh16* KF, const gh16* KRF, const gh16* VF, const gu32* mask, const gf32* biasTab, const lu8* lds,
                       const gh16* gate, gh16* mix, int mixcol, int hb) {
    constexpr int NQK = BR == 0 ? 6 : 4;
    const int lane = otid() & 63, q = lane & 31, h = lane >> 5, bh = b * 4 + hh;
    const int qt1 = 2 * pr + 1;
    size_t tokq[2]; h16x8 qf[2][NQK];
#pragma unroll
    for (int qi = 0; qi < 2; ++qi) { tokq[qi] = (size_t)b * SEQ + (2 * pr + qi) * 32 + q;
#pragma unroll
        for (int ks = 0; ks < NQK; ++ks) qf[qi][ks] = *(const GAS h16x8*)(Q + tokq[qi] * (BR == 0 ? 384 : 256) + hh * (BR == 0 ? 96 : 64) + ks * 16 + 8 * h); }
    f32x16 O[2][2]; float m[2], l[2];
#pragma unroll
    for (int qi = 0; qi < 2; ++qi) { O[qi][0] = (f32x16){}; O[qi][1] = (f32x16){}; m[qi] = -1e30f; l[qi] = 0.f; }
    const gh16* kp = KF + (size_t)bh * 64 * 2048 + lane * 8;
    const gh16* rp = KRF + (size_t)b * 64 * 1024 + lane * 8;
    const gh16* vp = VF + (size_t)bh * 64 * 2048 + lane * 8;
    const lf32* nearR = (const lf32*)(lds + L_NEAR) + hb * 256;
    const gf32* bt = biasTab + hb * 2048;
    h16x8 kf[NQK], vf[4];
#pragma unroll
    for (int ks = 0; ks < NQK; ++ks) kf[ks] = (BR == 0 && ks >= 4) ? *(const GAS h16x8*)(rp + (ks - 4) * 512) : *(const GAS h16x8*)(kp + ks * 512);
    unsigned mw[2] = {0xffffffffu, 0xffffffffu}, mwn[2] = {0xffffffffu, 0xffffffffu};
    if (BR == 1) { mw[0] = mask[tokq[0] * 64]; mw[1] = mask[tokq[1] * 64]; }
#pragma unroll 1
    for (int j = 0; j <= qt1; ++j) {
#pragma unroll
        for (int f = 0; f < 4; ++f) vf[f] = *(const GAS h16x8*)(vp + (size_t)j * 2048 + f * 512);
        f32x16 S[2];
#pragma unroll
        for (int qi = 0; qi < 2; ++qi) { S[qi] = (f32x16){};
#pragma unroll
            for (int ks = 0; ks < NQK; ++ks) S[qi] = mfma32(kf[ks], qf[qi][ks], S[qi]); }
        if (j < qt1) {
#pragma unroll
            for (int ks = 0; ks < NQK; ++ks) kf[ks] = (BR == 0 && ks >= 4) ? *(const GAS h16x8*)(rp + (size_t)(j + 1) * 1024 + (ks - 4) * 512) : *(const GAS h16x8*)(kp + (size_t)(j + 1) * 2048 + ks * 512);
            if (BR == 1) { mwn[0] = mask[tokq[0] * 64 + (j + 1 < qt1 ? j + 1 : j)]; mwn[1] = mask[tokq[1] * 64 + j + 1]; }
        }
#pragma unroll
        for (int qi = 0; qi < 2; ++qi) {
            const int qt = 2 * pr + qi;
            if (j <= qt) {
                const int D0 = (qt - j) * 32;
                if (BR == 0) {
                    if (D0 == 0) {
#pragma unroll
                        for (int r = 0; r < 16; ++r) S[qi][r] = (CROW(r) + 4 * h > q) ? -3e38f : S[qi][r];
                    }
                } else {
                    if (D0 < 192) {
                        const lf32* tp = nearR + (223 - D0 - q + 4 * h);
#pragma unroll
                        for (int r = 0; r < 16; ++r) S[qi][r] += tp[CROW(r)];
                    } else {
                        const float lo = bt[D0 - 31], hi = bt[D0 + 31];
                        if (lo == hi) S[qi] += lo;
                        else {
                            int bnd = 0;
#pragma unroll
                            for (int jj = 8; jj < 16; ++jj) bnd = (D0 + 31 >= kBucketStart[jj]) ? kBucketStart[jj] : bnd;
                            const int x = D0 + q - 4 * h - bnd;
#pragma unroll
                            for (int r = 0; r < 16; ++r) S[qi][r] += (x >= CROW(r)) ? hi : lo;
                        }
                    }
                    const unsigned mm = mw[qi] >> (4 * h);
#pragma unroll
                    for (int r = 0; r < 16; ++r) S[qi][r] = ((mm >> CROW(r)) & 1u) ? S[qi][r] : -3e38f;
                }
                softmax_tile(S[qi], m[qi], l[qi], O[qi][0], O[qi][1]);
                const h16x8 p0 = pack8(S[qi], 0), p1 = pack8(S[qi], 1);
                O[qi][0] = mfma32(vf[0], p0, O[qi][0]); O[qi][0] = mfma32(vf[1], p1, O[qi][0]);
                O[qi][1] = mfma32(vf[2], p0, O[qi][1]); O[qi][1] = mfma32(vf[3], p1, O[qi][1]);
            }
        }
        mw[0] = mwn[0]; mw[1] = mwn[1];
    }
#pragma unroll
    for (int qi = 0; qi < 2; ++qi) {
        const float il = 1.f / xh_sum(l[qi]);
        const gh16* gp = gate + tokq[qi] * 1024 + mixcol + hh * 64 + 4 * h;
#pragma unroll
        for (int db = 0; db < 2; ++db)
#pragma unroll
            for (int g = 0; g < 4; ++g) {
                const h16x4 gv = *(const GAS h16x4*)(gp + db * 32 + 8 * g); h16x4 o;
#pragma unroll
                for (int e = 0; e < 4; ++e) o[e] = (h16)(O[qi][db][4 * g + e] * il * (float)gv[e]);
                *(GAS h16x4*)(mix + mixf_off(tokq[qi], mixcol + hh * 64 + db * 32 + 8 * g + 4 * h)) = o;
            }
    }
}

template <int BR>
DEVI void flashWG_item(int b, int hh, int Qb, const gh16* Q, const gh16* KF, const gh16* KRF, const gh16* VF, const gu32* mask, lu8* lds,
                       const gf32* subln, float lambda_init, const gh16* gate, gh16* mix, int mixcol, int hb) {
    constexpr int NMAP = BR == 2 ? 2 : 1, NQK = BR == 0 ? 6 : 4, NKS = NQK / NMAP, NP = NQK + 4, TB = NP * 1024, NDMA = BR == 2 ? 1 : 2, DD = 3;
    const int tid = otid(), lane = tid & 63, q = lane & 31, h = lane >> 5, wv = __builtin_amdgcn_readfirstlane(tid >> 6);
    const int qt = 8 * Qb + wv, last = 8 * Qb + 7, bh = b * 4 + hh;
    const size_t tokq = (size_t)b * SEQ + qt * 32 + q;
    h16x8 qf[NQK];
#pragma unroll
    for (int ks = 0; ks < NQK; ++ks) qf[ks] = *(const GAS h16x8*)(Q + tokq * (BR == 0 ? 384 : 256) + hh * (BR == 0 ? 96 : 64) + ks * 16 + 8 * h);
    f32x16 O[NMAP][2]; float m[NMAP], l[NMAP];
#pragma unroll
    for (int mp = 0; mp < NMAP; ++mp) { O[mp][0] = (f32x16){}; O[mp][1] = (f32x16){}; m[mp] = -1e30f; l[mp] = 0.f; }
    asm volatile("s_waitcnt vmcnt(0)" ::: "memory");
    __syncthreads();
    lu8* ring = lds + L_RING; lu8* mring = lds + L_MRING;
    auto issue = [&](int jt) {
        const int jc = jt < last ? jt : last, slot = jt & 3;
        {
            const int pc = wv;
            const gh16* src = pc < 4 ? KF + ((size_t)bh * 64 + jc) * 2048 + pc * 512
                            : (BR == 0 && pc < 6) ? KRF + ((size_t)b * 64 + jc) * 1024 + (pc - 4) * 512
                            : VF + ((size_t)bh * 64 + jc) * 2048 + (pc - NQK) * 512;
            __builtin_amdgcn_global_load_lds((const GAS unsigned*)(src + lane * 8), (LAS unsigned*)(ring + slot * TB + pc * 1024), 16, 0, 0);
        }
        if (BR == 0) {
            const int pc = 8 + (wv & 1);
            const gh16* src = VF + ((size_t)bh * 64 + jc) * 2048 + (pc - NQK) * 512;
            __builtin_amdgcn_global_load_lds((const GAS unsigned*)(src + lane * 8), (LAS unsigned*)(ring + slot * TB + pc * 1024), 16, 0, 0);
        }
        if (BR == 1) __builtin_amdgcn_global_load_lds((const GAS unsigned*)(mask + tokq * 64 + (jc <= qt ? jc : qt)), (LAS unsigned*)(mring + (slot * 8 + wv) * 256), 4, 0, 0);
    };
#pragma unroll
    for (int jt = 0; jt < DD; ++jt) issue(jt);
    const lf32* nearR = (const lf32*)(lds + L_NEAR) + hb * 256;
    const lf32* biasL = (const lf32*)(lds + L_BIASL) + hb * 32;
    f32x16 S[NMAP], Sn[NMAP];
    asm volatile("s_waitcnt vmcnt(%0)" :: "n"((DD - 1) * NDMA) : "memory");
    __builtin_amdgcn_s_barrier();
#pragma unroll
    for (int mp = 0; mp < NMAP; ++mp) { S[mp] = (f32x16){};
#pragma unroll
        for (int ks = 0; ks < NKS; ++ks) S[mp] = mfma32(*(const LAS h16x8*)(ring + lane * 16 + (mp * NKS + ks) * 1024), qf[mp * NKS + ks], S[mp]); }
#pragma unroll 1
    for (int j = 0; j <= last; ++j) {
        asm volatile("s_waitcnt vmcnt(%0)" :: "n"((DD - 2) * NDMA) : "memory");
        __builtin_amdgcn_s_barrier();
        issue(j + DD);
        if (j <= qt) {
            const lu8* sl = ring + (j & 3) * TB + lane * 16;
            if (j + 1 <= qt) {
                const lu8* sn = ring + ((j + 1) & 3) * TB + lane * 16;
#pragma unroll
                for (int mp = 0; mp < NMAP; ++mp) { Sn[mp] = (f32x16){};
#pragma unroll
                    for (int ks = 0; ks < NKS; ++ks) Sn[mp] = mfma32(*(const LAS h16x8*)(sn + (mp * NKS + ks) * 1024), qf[mp * NKS + ks], Sn[mp]); }
            }
            h16x8 vf[4];
#pragma unroll
            for (int f = 0; f < 4; ++f) vf[f] = *(const LAS h16x8*)(sl + (NQK + f) * 1024);
            const int D0 = (qt - j) * 32;
            if (BR == 0) {
                if (D0 == 0) {
#pragma unroll
                    for (int r = 0; r < 16; ++r) S[0][r] = (CROW(r) + 4 * h > q) ? -3e38f : S[0][r];
                }
            } else if (D0 < 192) {
                const lf32* tp = nearR + (223 - D0 - q + 4 * h);
#pragma unroll
                for (int r = 0; r < 16; ++r) { const float bv = tp[CROW(r)];
#pragma unroll
                    for (int mp = 0; mp < NMAP; ++mp) S[mp][r] += bv; }
            } else {
                int blo = 23, bhi = 23;
#pragma unroll
                for (int jj = 8; jj < 16; ++jj) { blo += (D0 - 31 >= kBucketStart[jj]) ? 1 : 0; bhi += (D0 + 31 >= kBucketStart[jj]) ? 1 : 0; }
                const float lo = biasL[blo], hi = biasL[bhi];
                if (blo == bhi) {
#pragma unroll
                    for (int mp = 0; mp < NMAP; ++mp) S[mp] += lo;
                } else {
                    const int x = D0 + q - 4 * h - kBucketStart[bhi - 16];
#pragma unroll
                    for (int r = 0; r < 16; ++r) { const float bv = (x >= CROW(r)) ? hi : lo;
#pragma unroll
                        for (int mp = 0; mp < NMAP; ++mp) S[mp][r] += bv; }
                }
            }
            if (BR == 1) {
                const unsigned mw = *(const LAS unsigned*)(mring + ((j & 3) * 8 + wv) * 256 + lane * 4) >> (4 * h);
#pragma unroll
                for (int r = 0; r < 16; ++r) S[0][r] = ((mw >> CROW(r)) & 1u) ? S[0][r] : -3e38f;
            }
#pragma unroll
            for (int mp = 0; mp < NMAP; ++mp) {
                softmax_tile(S[mp], m[mp], l[mp], O[mp][0], O[mp][1]);
                const h16x8 p0 = pack8(S[mp], 0), p1 = pack8(S[mp], 1);
                O[mp][0] = mfma32(vf[0], p0, O[mp][0]); O[mp][0] = mfma32(vf[1], p1, O[mp][0]);
                O[mp][1] = mfma32(vf[2], p0, O[mp][1]); O[mp][1] = mfma32(vf[3], p1, O[mp][1]);
            }
#pragma unroll
            for (int mp = 0; mp < NMAP; ++mp) S[mp] = Sn[mp];
        }
    }
    asm volatile("s_waitcnt vmcnt(0)" ::: "memory");
    f32x16 R0, R1;
    if (NMAP == 2) {
        const float lam = *(const lf32*)(lds + L_LAM);
        const float i0 = 1.f / xh_sum(l[0]), i1 = lam / xh_sum(l[NMAP - 1]);
        R0 = O[0][0] * i0 - O[NMAP - 1][0] * i1; R1 = O[0][1] * i0 - O[NMAP - 1][1] * i1;
        float ss = 0.f;
#pragma unroll
        for (int r = 0; r < 16; ++r) ss += R0[r] * R0[r] + R1[r] * R1[r];
        ss = xh_sum(ss);
        const float rs = rsqrtf(ss * (1.f / 64.f) + EPS) * (1.f - lambda_init);
        R0 *= rs; R1 *= rs;
    } else {
        const float il = 1.f / xh_sum(l[0]);
        R0 = O[0][0] * il; R1 = O[0][1] * il;
    }
    const gh16* gp = gate + tokq * 1024 + mixcol + hh * 64 + 4 * h;
#pragma unroll
    for (int db = 0; db < 2; ++db)
#pragma unroll
        for (int g = 0; g < 4; ++g) {
            const h16x4 gv = *(const GAS h16x4*)(gp + db * 32 + 8 * g); h16x4 o;
#pragma unroll
            for (int e = 0; e < 4; ++e) { float v = (db ? R1[4 * g + e] : R0[4 * g + e]) * (float)gv[e];
                if (NMAP == 2) v *= subln[db * 32 + 8 * g + 4 * h + e];
                o[e] = (h16)v; }
            *(GAS h16x4*)(mix + mixf_off(tokq, mixcol + hh * 64 + db * 32 + 8 * g + 4 * h)) = o;
        }
}

DEVI void flashB_tile(const h16x8 (&qf)[4], const gh16* kfr, const gh16* vfr, const lf32* tp, f32x16& O0, f32x16& O1, float& m, float& l) {
    h16x8 vf[4], kf[4];
#pragma unroll
    for (int f = 0; f < 4; ++f) { kf[f] = *(const GAS h16x8*)(kfr + f * 512); vf[f] = *(const GAS h16x8*)(vfr + f * 512); }
    f32x16 S = {};
#pragma unroll
    for (int ks = 0; ks < 4; ++ks) S = mfma32(kf[ks], qf[ks], S);
#pragma unroll
    for (int r = 0; r < 16; ++r) S[r] += tp[CROW(r)];
    softmax_tile(S, m, l, O0, O1);
    const h16x8 p0 = pack8(S, 0), p1 = pack8(S, 1);
    O0 = mfma32(vf[0], p0, O0); O0 = mfma32(vf[1], p1, O0);
    O1 = mfma32(vf[2], p0, O1); O1 = mfma32(vf[3], p1, O1);
}
DEVI void flashB_item(int b, int hh, int r, int qg, const gh16* Q, const gh16* KF, const gh16* VF, const lu8* lds, const gh16* gate, gh16* mix) {
    const int lane = otid() & 63, q = lane & 31, h = lane >> 5, bh = b * 4 + hh;
    const size_t tokq = (size_t)b * SEQ + qg * 512 + 16 * q + r;
    h16x8 qf[4];
#pragma unroll
    for (int ks = 0; ks < 4; ++ks) qf[ks] = *(const GAS h16x8*)(Q + tokq * 256 + hh * 64 + ks * 16 + 8 * h);
    f32x16 O0 = {}, O1 = {}; float m = -1e30f, l = 0.f;
    {
        const lf32* R3 = (const lf32*)(lds + L_R3) + hh * 192;
        const size_t base = 2 * FSZ + ((size_t)bh * 16 + r) * 4 * 2048 + lane * 8;
        for (int tl = (qg >= 4 ? qg - 4 : 0); tl <= qg; ++tl) {
            const int c = qg * 32 + q - tl * 32;
            flashB_tile(qf, KF + base + (size_t)tl * 2048, VF + base + (size_t)tl * 2048, R3 + (159 - c + 4 * h), O0, O1, m, l);
        }
    }
    {
        const lf32* R2 = (const lf32*)(lds + L_R2) + hh * 384;
        const size_t base = FSZ + ((size_t)bh * 4 + (r & 3)) * 16 * 2048 + lane * 8;
        for (int tl = (qg >= 1 ? qg * 4 - 4 : 0); tl <= qg * 4 + 3; ++tl) {
            const int c = qg * 128 + 4 * q + (r >> 2) - tl * 32;
            flashB_tile(qf, KF + base + (size_t)tl * 2048, VF + base + (size_t)tl * 2048, R2 + (255 - c + 4 * h), O0, O1, m, l);
        }
    }
    {
        const lf32* R1 = (const lf32*)(lds + L_R1) + hh * 1152;
        const size_t base = (size_t)bh * 64 * 2048 + lane * 8;
        for (int tl = (qg >= 1 ? qg * 16 - 4 : 0); tl <= qg * 16 + 15; ++tl) {
            const int c = qg * 512 + 16 * q + r - tl * 32;
            flashB_tile(qf, KF + base + (size_t)tl * 2048, VF + base + (size_t)tl * 2048, R1 + (639 - c + 4 * h), O0, O1, m, l);
        }
    }
    const float il = 1.f / xh_sum(l);
    const gh16* gp = gate + tokq * 1024 + 256 + hh * 64 + 4 * h;
#pragma unroll
    for (int db = 0; db < 2; ++db)
#pragma unroll
        for (int g = 0; g < 4; ++g) {
            const h16x4 gv = *(const GAS h16x4*)(gp + db * 32 + 8 * g); h16x4 o;
#pragma unroll
            for (int e = 0; e < 4; ++e) o[e] = (h16)((db ? O1[4 * g + e] : O0[4 * g + e]) * il * (float)gv[e]);
            *(GAS h16x4*)(mix + mixf_off(tokq, 256 + hh * 64 + db * 32 + 8 * g + 4 * h)) = o;
        }
}

typedef float f32x4v __attribute__((ext_vector_type(4)));
typedef unsigned u32x4v __attribute__((ext_vector_type(4)));
DEVI f32x4v mfma16(h16x8 a, h16x8 b, f32x4v c) { return __builtin_amdgcn_mfma_f32_16x16x32_f16(a, b, c, 0, 0, 0); }
constexpr int TK_KSTRIDE = 2308;
constexpr int TK_KEYS = 0, TK_MISC = 16 * TK_KSTRIDE * 4, TK_END = TK_MISC + 64;
DEVI void topk_item(int b, int T16, const gh16* idx, const gh16* KIF, gu32* mask, lu8* lds) {
    const int tid = otid(), lane = tid & 63, wv = __builtin_amdgcn_readfirstlane(tid >> 6);
    const int t0 = T16 * 16;
    lu32* keys = (lu32*)(lds + TK_KEYS);
    if (T16 < 16) {
        const int sq = tid & 15, sc_ = tid >> 4;
        const unsigned tk = (unsigned)(b * SEQ + t0 + sq) * 64u + 2u * sc_;
        unsigned ones = 0xffffffffu; asm volatile("" : "+v"(ones));
        if (sc_ < 4) { mask[tk] = ones; mask[tk + 1] = ones; }
        return;
    }
    __syncthreads();
    {
        const int q = lane & 15, kq = lane >> 4;
        const size_t tokq = (size_t)b * SEQ + t0 + q;
        h16x8 qf[8], ql; float sg[8]; float P = 0.f, N = 0.f; float lin[8];
#pragma unroll
        for (int e = 0; e < 8; ++e) lin[e] = 0.f;
#pragma unroll
        for (int hd = 0; hd < 8; ++hd) {
            const h16x8 raw = *(const GAS h16x8*)(idx + tokq * 320 + hd * 32 + 8 * kq);
            const float c = (float)idx[tokq * 320 + 288 + hd] * (0.5f * 0.35355339059327373f), ac = fabsf(c);
            float nn = 0.f;
#pragma unroll
            for (int e = 0; e < 8; ++e) { const float v = (float)raw[e]; nn += v * v; lin[e] += c * v; qf[hd][e] = (h16)(ac * v); }
            nn += __shfl_xor(nn, 16); nn += __shfl_xor(nn, 32);
            const float bd = 2.f * ac * sqrtf(nn) * 12.f;
            if (c > 0.f) P += bd; else N += bd;
            sg[hd] = c >= 0.f ? 1.f : -1.f;
        }
#pragma unroll
        for (int e = 0; e < 8; ++e) ql[e] = (h16)lin[e];
        const float lo = -N, scl = 2097151.f / fmaxf(P + N, 1e-20f);
        const int nblk = T16 + 1, nblk2 = (nblk + 1) & ~1;
#pragma unroll 1
        for (int rpS = 0; rpS < (DUP_PHASE == 7 ? 2 : 1); ++rpS)
        for (int kb0 = wv; kb0 < nblk2; kb0 += 32) {
            h16x8 kf4[4];
#pragma unroll
            for (int u = 0; u < 4; ++u) { const int kb = kb0 + 8 * u < nblk ? kb0 + 8 * u : 0; kf4[u] = *(const GAS h16x8*)(KIF + ((size_t)(b * 128 + kb) * 64 + lane) * 8); }
#pragma unroll
            for (int u = 0; u < 4; ++u) {
                const int kb = kb0 + 8 * u;
                if (kb < nblk2) {
                    const h16x8 kf = kf4[u];
                    f32x4v sc = mfma16(kf, ql, (f32x4v){0.f, 0.f, 0.f, 0.f});
#pragma unroll
                    for (int hd = 0; hd < 8; ++hd) { const f32x4v x = mfma16(kf, qf[hd], (f32x4v){0.f, 0.f, 0.f, 0.f});
#pragma unroll
                        for (int r = 0; r < 4; ++r) sc[r] = __builtin_fmaf(__builtin_fabsf(x[r]), sg[hd], sc[r]); }
                    u32x4v kv;
#pragma unroll
                    for (int r = 0; r < 4; ++r) { const float x = fminf(fmaxf((sc[r] - lo) * scl, 0.f), 2097151.f); unsigned uu = (unsigned)x + 1u;
                        if (16 * kb + 4 * kq + r > t0 + q) uu = 0u; kv[r] = uu; }
                    const int k = 16 * kb + 4 * kq;
                    *(LAS u32x4v*)(keys + q * TK_KSTRIDE + k + 4 * (k >> 5)) = kv;
                }
            }
        }
    }
    __syncthreads();
    const int nw32 = (t0 + 16 + 31) >> 5;
    unsigned ka[32], kc[32];
    {
        const lu32* ra = keys + (2 * wv) * TK_KSTRIDE + 36 * lane, * rc = keys + (2 * wv + 1) * TK_KSTRIDE + 36 * lane;
        const bool have = lane < nw32;
#pragma unroll
        for (int i = 0; i < 8; ++i) {
            u32x4v va = {0u, 0u, 0u, 0u}, vc = {0u, 0u, 0u, 0u};
            if (have) { va = *(const LAS u32x4v*)(ra + 4 * i); vc = *(const LAS u32x4v*)(rc + 4 * i); }
#pragma unroll
            for (int r = 0; r < 4; ++r) { ka[4 * i + r] = va[r]; kc[4 * i + r] = vc[r]; }
        }
    }
    unsigned Ta = 0u, Tc = 0u;
#pragma unroll 1
    for (int rpL = 0; rpL < (DUP_PHASE == 8 ? 2 : 1); ++rpL) { Ta = 0u; Tc = 0u;
#pragma unroll 1
    for (int bit = 21; bit >= 0; --bit) {
        const unsigned pa = Ta | (1u << bit), pc = Tc | (1u << bit);
        unsigned la = 0u, lc = 0u;
#pragma unroll
        for (int i = 0; i < 32; ++i) { la += (ka[i] >= pa) ? 1u : 0u; lc += (kc[i] >= pc) ? 1u : 0u; }
        int ca = 0, cc = 0;
#pragma unroll
        for (int bp = 0; bp < 6; ++bp) { ca += __builtin_popcountll(__ballot((la >> bp) & 1u)) << bp; cc += __builtin_popcountll(__ballot((lc >> bp) & 1u)) << bp; }
        if (ca >= 256) Ta = pa;
        if (cc >= 256) Tc = pc;
    }
    }
#pragma unroll
    for (int qq = 0; qq < 2; ++qq) {
        const unsigned T = qq ? Tc : Ta;
        unsigned gt = 0u, eq = 0u;
#pragma unroll
        for (int i = 31; i >= 0; --i) { const unsigned k = qq ? kc[i] : ka[i]; gt = (gt << 1) | (k > T ? 1u : 0u); eq = (eq << 1) | (k == T ? 1u : 0u); }
        int pcg = __builtin_popcount(gt), pce = __builtin_popcount(eq);
        int totg = pcg, pre = pce;
#pragma unroll
        for (int o = 1; o < 64; o <<= 1) { totg += __shfl_xor(totg, o); const int t = __shfl_up(pre, o); if (lane >= o) pre += t; }
        const int before = pre - pce, R = 256 - totg;
        int allow = R - before; allow = allow < 0 ? 0 : (allow > pce ? pce : allow);
        unsigned keep = eq;
        if (allow < pce) { keep = 0u; unsigned e = eq; for (int c = 0; c < allow; ++c) { const unsigned bit = e & (0u - e); keep |= bit; e ^= bit; } }
        if (lane < nw32) mask[((size_t)b * SEQ + t0 + 2 * wv + qq) * 64 + lane] = gt | keep;
    }
}
DEVI void ph_topk(const gh16* idx, const gh16* KIF, gu32* mask, gu32* ctr, lu8* lds, int nrep) {
    lu32* slot = (lu32*)(lds + TK_MISC);
#pragma unroll 1
    for (;;) {
        __syncthreads();
        if (otid() == 0) *slot = __hip_atomic_fetch_add(ctr, 1u, __ATOMIC_RELAXED, __HIP_MEMORY_SCOPE_AGENT);
        __syncthreads();
        const int e = (int)*slot;
        if (e >= 1024 * nrep) break;
        const int e2 = e & 1023;
        topk_item(e2 & 7, 127 - (e2 >> 3), idx, KIF, mask, lds);
    }
}

DEVI void ph_out(const gh16* mix, const gh16* WoT, const gf32* __restrict__ gpost, const gf32* h_in, gf32* h_out, gh16* h16o, gf32* rstd_next, bool write_next, lu8* lds) {
    const int tid = otid(), lane = tid & 63, q = lane & 31, h = lane >> 5, wv = __builtin_amdgcn_readfirstlane(tid >> 6);
    lf32* red = (lf32*)lds;
    for (int u = blockIdx.x; u < NT / 64; u += gridDim.x) {
        f32x16 acc[4][2];
#pragma unroll
        for (int rb = 0; rb < 4; ++rb) { acc[rb][0] = (f32x16){}; acc[rb][1] = (f32x16){}; }
        const gh16* apu = WoT + (size_t)(wv * 4) * 64 * 512;
        const gh16* bpu = mix + (size_t)(u * 2) * 64 * 512;
        const unsigned lo8 = lane * 8;
#define ap(off) (apu + (off) + lo8)
#define bp(off) (bpu + (off) + lo8)
        h16x8 a0[4], b0[2], a1[4], b1[2], a2[4], b2[2];
#define P3_LOAD(A, B, ks_) do { const int ko_ = ((ks_) < 64 ? (ks_) : 63) * 512; _Pragma("unroll") for (int rb = 0; rb < 4; ++rb) A[rb] = *(const GAS h16x8*)(ap(rb * 64 * 512 + ko_)); \
        _Pragma("unroll") for (int tb = 0; tb < 2; ++tb) B[tb] = *(const GAS h16x8*)(bp(tb * 64 * 512 + ko_)); } while (0)
#define P3_MMA(A, B) do { _Pragma("unroll") for (int rb = 0; rb < 4; ++rb) _Pragma("unroll") for (int tb = 0; tb < 2; ++tb) acc[rb][tb] = mfma32(A[rb], B[tb], acc[rb][tb]); } while (0)
        P3_LOAD(a0, b0, 0); P3_LOAD(a1, b1, 1);
#pragma unroll 1
        for (int ks = 0; ks < 63; ks += 3) {
            P3_LOAD(a2, b2, ks + 2); __builtin_amdgcn_sched_barrier(0); P3_MMA(a0, b0); __builtin_amdgcn_sched_barrier(0);
            P3_LOAD(a0, b0, ks + 3); __builtin_amdgcn_sched_barrier(0); P3_MMA(a1, b1); __builtin_amdgcn_sched_barrier(0);
            P3_LOAD(a1, b1, ks + 4); __builtin_amdgcn_sched_barrier(0); P3_MMA(a2, b2); __builtin_amdgcn_sched_barrier(0);
        }
        P3_MMA(a0, b0);
#undef P3_LOAD
#undef P3_MMA
#undef ap
#undef bp
        int qe = q, he = h; asm volatile("" : "+v"(qe), "+v"(he));
        __syncthreads();
#pragma unroll
        for (int tb = 0; tb < 2; ++tb) {
            float ss = 0.f;
#pragma unroll
            for (int rb = 0; rb < 4; ++rb)
#pragma unroll
                for (int r = 0; r < 16; ++r) ss += acc[rb][tb][r] * acc[rb][tb][r];
            ss = xh_sum(ss);
            if (he == 0) red[wv * 64 + tb * 32 + qe] = ss;
        }
        __syncthreads();
        float ssn[2] = {0.f, 0.f};
#pragma unroll
        for (int tb = 0; tb < 2; ++tb) {
            float tot = 0.f;
#pragma unroll
            for (int w2 = 0; w2 < 8; ++w2) tot += red[w2 * 64 + tb * 32 + qe];
            const float rs = rsqrtf(tot * (1.f / DM) + EPS);
            const size_t rowoff = (size_t)(u * 64 + tb * 32 + qe) * DM;
#pragma unroll
            for (int rb = 0; rb < 4; ++rb)
#pragma unroll
                for (int g = 0; g < 4; ++g) {
                    const int n = wv * 128 + rb * 32 + 8 * g + 4 * he;
                    const f32x4_t hv = *(const GAS f32x4_t*)(h_in + rowoff + n), gv = *(const GAS f32x4_t*)(gpost + n);
                    f32x4_t o;
                    o[0] = hv[0] + acc[rb][tb][4 * g + 0] * rs * gv[0]; o[1] = hv[1] + acc[rb][tb][4 * g + 1] * rs * gv[1];
                    o[2] = hv[2] + acc[rb][tb][4 * g + 2] * rs * gv[2]; o[3] = hv[3] + acc[rb][tb][4 * g + 3] * rs * gv[3];
                    *(GAS f32x4_t*)(h_out + rowoff + n) = o;
                    if (write_next) { h16x4 oh; oh[0] = (h16)o[0]; oh[1] = (h16)o[1]; oh[2] = (h16)o[2]; oh[3] = (h16)o[3]; *(GAS h16x4*)(h16o + rowoff + n) = oh;
                        ssn[tb] += o[0] * o[0] + o[1] * o[1] + o[2] * o[2] + o[3] * o[3]; }
                }
        }
        if (write_next) {
#pragma unroll
            for (int tb = 0; tb < 2; ++tb) { const float v = xh_sum(ssn[tb]); if (he == 0) red[512 + wv * 64 + tb * 32 + qe] = v; }
            __syncthreads();
            if (tid < 64) { float tot = 0.f;
#pragma unroll
                for (int w2 = 0; w2 < 8; ++w2) tot += red[512 + w2 * 64 + tid];
                rstd_next[u * 64 + tid] = rsqrtf(tot * (1.f / DM) + EPS); }
        }
    }
}

DEVI void mla_item(int it, const gh16* cA, const gh16* WuqT, const gh16* WukvT, const gf32* cosT, const gf32* sinT, gh16* qA, gh16* KFA, gh16* KRF, gh16* VFA) {
    const int lane = otid() & 63, q = lane & 31, h = lane >> 5;
    const size_t tok = (size_t)it * 32 + q; const int b = it >> 6, j = it & 63, s = j * 32 + q;
    const float qs = 0.10206207261596577f * LOG2E;
    {
        h16x8 cf[12]; float ss = 0.f;
#pragma unroll
        for (int ks = 0; ks < 12; ++ks) { cf[ks] = *(const GAS h16x8*)(cA + tok * 384 + ks * 16 + 8 * h);
#pragma unroll
            for (int e = 0; e < 8; ++e) { const float v = (float)cf[ks][e]; ss += v * v; } }
        const float rs = rsqrtf(xh_sum(ss) * (1.f / 192.f) + EPS) * qs;
#pragma unroll 1
        for (int nb = 0; nb < 12; ++nb) {
            f32x16 acc = {};
            const gh16* wp = WuqT + (size_t)nb * 12 * 512 + lane * 8;
#pragma unroll
            for (int ks = 0; ks < 12; ++ks) acc = mfma32(*(const GAS h16x8*)(wp + ks * 512), cf[ks], acc);
            acc *= rs;
            const int hh = nb / 3, part = nb % 3;
            if (part == 2) {
#pragma unroll
                for (int r = 0; r < 8; ++r) { const int i = CROW(r) + 4 * h; const float c = cosT[s * 16 + i], sn = sinT[s * 16 + i], x1 = acc[r], x2 = acc[r + 8];
                    acc[r] = x1 * c - x2 * sn; acc[r + 8] = x1 * sn + x2 * c; }
            }
            gh16* op = qA + tok * 384 + hh * 96 + part * 32 + 4 * h;
#pragma unroll
            for (int g = 0; g < 4; ++g) { h16x4 o; o[0] = (h16)acc[4 * g]; o[1] = (h16)acc[4 * g + 1]; o[2] = (h16)acc[4 * g + 2]; o[3] = (h16)acc[4 * g + 3]; *(GAS h16x4*)(op + 8 * g) = o; }
        }
    }
    {
        h16x8 cf[8]; float ss = 0.f;
#pragma unroll
        for (int ks = 0; ks < 8; ++ks) { cf[ks] = *(const GAS h16x8*)(cA + tok * 384 + 192 + ks * 16 + 8 * h);
#pragma unroll
            for (int e = 0; e < 8; ++e) { const float v = (float)cf[ks][e]; ss += v * v; } }
        const float rs = rsqrtf(xh_sum(ss) * (1.f / 128.f) + EPS);
#pragma unroll
        for (int ks = 0; ks < 8; ++ks)
#pragma unroll
            for (int e = 0; e < 8; ++e) cf[ks][e] = (h16)((float)cf[ks][e] * rs);
#pragma unroll 1
        for (int nb = 0; nb < 16; ++nb) {
            const int hh = nb >> 2, sub = nb & 3, bh = b * 4 + hh;
            const gh16* wp = WukvT + (size_t)nb * 8 * 512 + lane * 8;
            f32x16 acc = {};
            if (sub < 2) {
#pragma unroll
                for (int ks = 0; ks < 8; ++ks) acc = mfma32(*(const GAS h16x8*)(wp + ks * 512), cf[ks], acc);
#pragma unroll
                for (int g = 0; g < 4; ++g) { h16x4 o; o[0] = (h16)acc[4 * g]; o[1] = (h16)acc[4 * g + 1]; o[2] = (h16)acc[4 * g + 2]; o[3] = (h16)acc[4 * g + 3];
                    *(GAS h16x4*)(KFA + ((((size_t)bh * 64 + j) * 4 + 2 * sub + (g >> 1)) * 64 + q + 32 * (g & 1)) * 8 + 4 * h) = o; }
            } else {
#pragma unroll
                for (int ks = 0; ks < 8; ++ks) acc = mfma32(cf[ks], *(const GAS h16x8*)(wp + ks * 512), acc);
#pragma unroll
                for (int sk = 0; sk < 2; ++sk) { h16x8 o;
#pragma unroll
                    for (int e = 0; e < 8; ++e) o[e] = (h16)acc[8 * sk + e];
                    *(GAS h16x8*)(VFA + ((((size_t)bh * 64 + j) * 4 + (sub - 2) * 2 + sk) * 64 + lane) * 8) = o; }
            }
        }
    }
    {
        const h16x8 a = *(const GAS h16x8*)(cA + tok * 384 + 320 + 8 * h), c2 = *(const GAS h16x8*)(cA + tok * 384 + 336 + 8 * h);
        h16x8 o1, o2;
#pragma unroll
        for (int e = 0; e < 8; ++e) { const int i = 8 * h + e; const float c = cosT[s * 16 + i], sn = sinT[s * 16 + i], x1 = (float)a[e], x2 = (float)c2[e];
            o1[e] = (h16)(x1 * c - x2 * sn); o2[e] = (h16)(x1 * sn + x2 * c); }
        *(GAS h16x8*)(KRF + (((size_t)b * 64 + j) * 2 + 0) * 512 + lane * 8) = o1; *(GAS h16x8*)(KRF + (((size_t)b * 64 + j) * 2 + 1) * 512 + lane * 8) = o2;
    }
}
DEVI void ph_small_weights(const gf32* w_uq, const gf32* qn, const gf32* w_ukv, const gf32* kvn, gh16* WuqF, gh16* WukvF) {
    const int gt = blockIdx.x * NTHR + otid(), nthr = gridDim.x * NTHR;
    for (int i = gt; i < 2 * 12 * 12 * 64; i += nthr) { const int lane = i & 63, ks = (i >> 6) % 12, nb = (i / (64 * 12)) % 12, l = i / (64 * 144);
        h16x8 o;
#pragma unroll
        for (int e = 0; e < 8; ++e) { const int k = 16 * ks + 8 * (lane >> 5) + e; o[e] = (h16)(w_uq[(size_t)l * 192 * 384 + k * 384 + nb * 32 + (lane & 31)] * qn[l * 192 + k]); }
        *(GAS h16x8*)(WuqF + (size_t)i * 8) = o; }
    for (int i = gt; i < 2 * 16 * 8 * 64; i += nthr) { const int lane = i & 63, ks = (i >> 6) & 7, nb = (i >> 9) & 15, l = i >> 13;
        h16x8 o;
#pragma unroll
        for (int e = 0; e < 8; ++e) { const int k = 16 * ks + 8 * (lane >> 5) + e; o[e] = (h16)(w_ukv[(size_t)l * 128 * 512 + k * 512 + nb * 32 + (lane & 31)] * kvn[l * 128 + k]); }
        *(GAS h16x8*)(WukvF + (size_t)i * 8) = o; }
}

constexpr int LDS_BYTES = 160 * 1024;
struct Params { const float* in[12]; float* out; unsigned char* ws; };

DEVI void ph_tables(const gf32* __restrict__ rel_bias, gf32* biasTab, gf32* cosT, gf32* sinT) {
    for (int i = blockIdx.x * NTHR + threadIdx.x; i < 2048 * 16; i += gridDim.x * NTHR) {
        if (i < 12 * 2048) { int hh = i / 2048, n = i % 2048; biasTab[i] = rel_bias[t5_bucket(n) * 12 + hh] * LOG2E; }
        int pos = i / 16, j = i % 16;
        float inv = (float)pow(10000.0, -(double)(2 * j) / 32.0);
        float ang = (float)pos * inv;
        cosT[i] = (float)cos((double)ang); sinT[i] = (float)sin((double)ang);
    }
}

extern __shared__ __attribute__((aligned(16))) unsigned char smem[];
constexpr int LDS_BAR_OFF = 160 * 1024 - 16;

#define REP(k) for (int rep_ = 0; rep_ < ((DUP_PHASE == (k)) ? 2 : 1); ++rep_)
DEVI gu8* ows(unsigned char* w0) { gu8* w = (gu8*)w0; asm volatile("" : "+s"(w)); return w; }
#define WSP(T, off) ((GAS T*)(w + (off)))
#define GIN(k) ((const gf32*)p.in[k])

__global__ void __launch_bounds__(NTHR, 2) mega(Params p) {
    if (threadIdx.x == 0) *(uint4*)(smem + LDS_BAR_OFF) = make_uint4(0u, 0u, 0u, 0u);
    __syncthreads();
    XcdBarrier bar = xcd_barrier_post((unsigned*)(p.ws + OFF_CTL), (volatile LAS unsigned*)(smem + LDS_BAR_OFF));
    lu8* lds = (lu8*)smem;
    const int nw = gridDim.x * NWAVE;

    REP(1) {
        gu8* w = ows(p.ws);
        ph_tables(GIN(11), WSP(float, OFF_BIAS), WSP(float, OFF_COS), WSP(float, OFF_SIN));
        int base = 0; const int total = 2 * (64 * 16) + 2 * (16 * 16);
        cvt_transpose<true>(GIN(1), INC, GIN(3), WSP(h16, OFF_WINT), MYC, DM, lds, blockIdx.x, total, base);
        cvt_transpose<true>(GIN(1) + (size_t)DM * INC, INC, GIN(3) + DM, WSP(h16, OFF_WINT) + (size_t)MYC * DM, MYC, DM, lds, blockIdx.x, total, base);
        cvt_transpose<false>(GIN(2), DM, nullptr, WSP(h16, OFF_WOUTT), DM, DM, lds, blockIdx.x, total, base);
        cvt_transpose<false>(GIN(2) + (size_t)DM * DM, DM, nullptr, WSP(h16, OFF_WOUTT) + (size_t)DM * DM, DM, DM, lds, blockIdx.x, total, base);
        ph_small_weights(GIN(7), GIN(5), GIN(8), GIN(6), WSP(h16, OFF_WUQT), WSP(h16, OFF_WUKVT));
        ph_rowstat_cvt(GIN(0), WSP(float, OFF_SSQH), WSP(h16, OFF_H16));
    }
    xcd_barrier(bar);
    for (int layer = 0; layer < 2; ++layer) {
        const float lambda_init = layer == 0 ? 0.2f : 0.35550906759f;
        REP(2) {
            if (rep_) xcd_barrier(bar);
            gu8* w = ows(p.ws);
            pg8::Gemm g{(const pg8::bf16_t*)(p.ws + OFF_H16), (const pg8::bf16_t*)(p.ws + OFF_WINT) + (size_t)layer * MYC * DM, NT, MYC, DM};
            int bid_ = (int)blockIdx.x; asm volatile("" : "+s"(bid_));
            pg8::StaticOrder S; S.init(NT, MYC, (int)gridDim.x, bid_);
            EpiRoute E{w, WSP(float, OFF_SSQH)};
            pg8::gemm_phase<EpiRoute, pg8::StaticOrder, true, true>(lds, g, S, E);
        }
        xcd_barrier(bar);
        REP(3) {
            gu8* w = ows(p.ws);
            for (int it = ogw(); it < NT / 32; it += nw) mla_item(it, WSP(h16, OFF_CA), WSP(h16, OFF_WUQT) + (size_t)layer * 384 * 192, WSP(h16, OFF_WUKVT) + (size_t)layer * 512 * 128, WSP(float, OFF_COS), WSP(float, OFF_SIN), WSP(h16, OFF_QA), WSP(h16, OFF_KFA), WSP(h16, OFF_KRF), WSP(h16, OFF_VFA));
        }
        {
            gu8* w = ows(p.ws);
            ph_topk(WSP(h16, OFF_IDX), WSP(h16, OFF_KIF), WSP(unsigned, OFF_MASK), WSP(unsigned, OFF_CTL) + 3600 + 16 * (40 + layer), lds, DUP_PHASE == 4 ? 2 : 1);
        }
        REP(3) {
            gu8* w = ows(p.ws);
            ph_vtrans(WSP(h16, OFF_VTMP), WSP(h16, OFF_VF), lds);
        }
        xcd_barrier(bar);
        REP(5) {
            if (rep_) xcd_barrier(bar);
            gu8* w = ows(p.ws);
            p2_setup(WSP(float, OFF_BIAS), GIN(9) + layer * 128, lambda_init, lds);
            const int xcc = (int)(xb_xcc_id() & 7u);
            for (int dq = 0; dq < 8; ++dq) {
                const int bq = (xcc + dq) & 7;
                gu32* ctr = WSP(unsigned, OFF_CTL) + 3600 + 16 * (bq + 8 * layer + 16 * rep_);
                for (;;) { const int e = wq_next(ctr); if (e >= 768) break;
                    if (e < 256) { const int hh = e >> 6, lvl = 63 - (e & 63);
                        flashCD_item<2, false>(bq, hh, lvl, 8 + hh, WSP(h16, OFF_QD), WSP(h16, OFF_KFD), WSP(h16, OFF_VF) + 4 * FSZ, nullptr, WSP(float, OFF_BIAS), lds,
                                               GIN(10) + layer * 64, lambda_init, WSP(h16, OFF_GATE), WSP(h16, OFF_MIX), 768); }
                    else if (e < 384) { const int e2 = e - 256, hh = e2 >> 5, pr = 31 - (e2 & 31);
                        flashQ2_item<1>(bq, hh, pr, WSP(h16, OFF_QC), WSP(h16, OFF_KFC), nullptr, WSP(h16, OFF_VF) + 3 * FSZ, WSP(unsigned, OFF_MASK), WSP(float, OFF_BIAS), lds, WSP(h16, OFF_GATE), WSP(h16, OFF_MIX), 512, 4 + hh); }
                    else if (e < 512) { const int e2 = e - 384, hh = e2 >> 5, pr = 31 - (e2 & 31);
                        flashQ2_item<0>(bq, hh, pr, WSP(h16, OFF_QA), WSP(h16, OFF_KFA), WSP(h16, OFF_KRF), WSP(h16, OFF_VFA), nullptr, WSP(float, OFF_BIAS), lds, WSP(h16, OFF_GATE), WSP(h16, OFF_MIX), 0, 0); }
                    else { const int e2 = e - 512, hh = e2 >> 6, lvl = e2 & 63;
                        flashB_item(bq, hh, lvl & 15, lvl >> 4, WSP(h16, OFF_QB), WSP(h16, OFF_KFB), WSP(h16, OFF_VF), lds, WSP(h16, OFF_GATE), WSP(h16, OFF_MIX)); }
                }
            }
        }
        xcd_barrier(bar);
        for (int rep_ = 0; rep_ < ((DUP_PHASE == 6 && layer == 0) ? 2 : 1); ++rep_) {
            if (rep_) xcd_barrier(bar);
            gu8* w = ows(p.ws);
int bid_ = (int)blockIdx.x; asm volatile("" : "+s"(bid_));
            pg8::Gemm g{(const pg8::bf16_t*)(p.ws + OFF_MIX), (const pg8::bf16_t*)(p.ws + OFF_WOUTT) + (size_t)layer * DM * DM, NT, DM, DM};
            pg8::StaticOrder S; S.init(NT, DM, (int)gridDim.x, bid_);
            EpiOut E{layer == 0 ? GIN(0) : (const gf32*)p.out, (gf32*)p.out, WSP(h16, OFF_H16), GIN(4) + layer * DM, WSP(float, OFF_SSQY), WSP(float, OFF_SSQH), &bar, layer == 0};
            pg8::gemm_phase<EpiOut, pg8::StaticOrder, false, true>(lds, g, S, E);
        }
        xcd_barrier(bar);
    }
}

extern "C" void kernel_launch(void* const* d_in, const int* in_sizes, int n_in, void* d_out, int out_size, void* d_ws, size_t ws_size, hipStream_t stream) {
    static int grid = 0;
    if (grid == 0) {
        int dev = 0, cus = 0, per_cu = 0;
        (void)hipGetDevice(&dev);
        (void)hipDeviceGetAttribute(&cus, hipDeviceAttributeMultiprocessorCount, dev);
        (void)hipFuncSetAttribute((const void*)mega, hipFuncAttributeMaxDynamicSharedMemorySize, LDS_BYTES);
        (void)hipOccupancyMaxActiveBlocksPerMultiprocessor(&per_cu, (const void*)mega, NTHR, LDS_BYTES);
        (void)hipGetLastError();
        grid = cus > 0 ? cus : 256;
    }
    (void)hipMemsetAsync((char*)d_ws + OFF_CTL, 0, 32768, stream);
    Params p{};
    for (int i = 0; i < 12; ++i) p.in[i] = (const float*)d_in[i];
    p.out = (float*)d_out; p.ws = (unsigned char*)d_ws;
    hipLaunchKernelGGL(mega, dim3(grid), dim3(NTHR), LDS_BYTES, stream, p);
}
```

```cpp
#include <hip/hip_runtime.h>
#include <stdint.h>
#include <math.h>

#ifndef DUP_PHASE
#define DUP_PHASE 0
#endif
typedef _Float16 h16;
#define GAS __attribute__((address_space(1)))
#define LAS __attribute__((address_space(3)))
typedef GAS h16 gh16; typedef GAS float gf32; typedef GAS unsigned gu32; typedef GAS unsigned char gu8;
typedef LAS h16 lh16; typedef LAS float lf32; typedef LAS unsigned lu32; typedef LAS unsigned char lu8;
#define DEVI __device__ __forceinline__
DEVI int ogw();
DEVI int otid() { int t = threadIdx.x; asm volatile("" : "+v"(t)); return t; }

constexpr int NB = 8, SEQ = 2048, DM = 1024, NT = NB * SEQ, INC = 3976, MYC = 4096;
constexpr float LOG2E = 1.4426950408889634f;
constexpr float EPS = 1e-6f;

DEVI int ogw() { return blockIdx.x * 8 + (otid() >> 6); }
__host__ __device__ constexpr int ref_col(int my) {
    if (my < 352) return my;
    if (my < 384) return -1;
    if (my < 640) return 352 + (my - 384);
    if (my < 896) return 1376 + (my - 640);
    if (my < 1152) return 2696 + (my - 896);
    if (my < 1408) return 3720 + (my - 1152);
    if (my < 1664) return 608 + (my - 1408);
    if (my < 1920) return 864 + (my - 1664);
    if (my < 2176) return 1632 + (my - 1920);
    if (my < 2432) return 1888 + (my - 2176);
    if (my < 2688) return 2952 + (my - 2432);
    if (my < 2944) return 3208 + (my - 2688);
    if (my < 3200) return 1120 + (my - 2944);
    if (my < 3456) return 2144 + (my - 3200);
    if (my < 3712) return 3464 + (my - 3456);
    if (my < 3968) return 2400 + (my - 3712);
    if (my < 4000) return 2656 + (my - 3968);
    if (my < 4008) return 2688 + (my - 4000);
    return -1;
}

constexpr size_t MiB = 1024 * 1024;
constexpr size_t OFF_CTL = 0;
constexpr size_t OFF_RSTD = 64 * 1024;
constexpr size_t OFF_BIAS = 128 * 1024;
constexpr size_t OFF_COS = 256 * 1024;
constexpr size_t OFF_SIN = 384 * 1024;
constexpr size_t OFF_SSQY = 512 * 1024;
constexpr size_t OFF_SSQH = 768 * 1024;
constexpr size_t OFF_CA = 1 * MiB;
constexpr size_t OFF_GATE = OFF_CA + 12 * MiB;
constexpr size_t OFF_QB = OFF_GATE + 32 * MiB;
constexpr size_t OFF_QC = OFF_QB + 8 * MiB;
constexpr size_t OFF_QD = OFF_QC + 8 * MiB;
constexpr size_t OFF_KFB = OFF_QD + 8 * MiB;
constexpr size_t OFF_KFC = OFF_KFB + 24 * MiB;
constexpr size_t OFF_KFD = OFF_KFC + 8 * MiB;
constexpr size_t OFF_IDX = OFF_KFD + 8 * MiB;
constexpr size_t OFF_KIF = OFF_IDX + 10 * MiB;
constexpr size_t OFF_MIX = OFF_KIF + 1 * MiB;
constexpr size_t OFF_VTMP = OFF_MIX;
constexpr size_t OFF_MASK = OFF_MIX + 32 * MiB;
constexpr size_t OFF_H16 = OFF_MASK + 4 * MiB;
constexpr size_t OFF_QA = OFF_H16;
constexpr size_t OFF_KFA = OFF_QA + 12 * MiB;
constexpr size_t OFF_KRF = OFF_KFA + 8 * MiB;
constexpr size_t OFF_VFA = OFF_KRF + 1 * MiB;
constexpr size_t OFF_WINT = OFF_H16 + 32 * MiB;
constexpr size_t OFF_WOUTT = OFF_WINT + 16 * MiB;
constexpr size_t OFF_WUQT = OFF_WOUTT + 4 * MiB;
constexpr size_t OFF_WUKVT = OFF_WUQT + 512 * 1024;
constexpr size_t OFF_VF = OFF_WUKVT + 512 * 1024;
constexpr size_t OFF_END = OFF_VF + 40 * MiB;
static_assert(OFF_END <= 256 * MiB, "ws map");

struct Route { int kind; size_t off; int dcol; int pitch; float scale; int silu; };
__host__ __device__ inline Route route(int my) {
    Route r{-1, 0, 0, 0, 1.f, 0};
    if (my < 384) { r.kind = 0; r.off = OFF_CA; r.dcol = my; r.pitch = 384; }
    else if (my < 1408) { r.kind = 0; r.off = OFF_GATE; r.dcol = my - 384; r.pitch = 1024; r.silu = 1; }
    else if (my < 1664) { r.kind = 0; r.off = OFF_QB; r.dcol = my - 1408; r.pitch = 256; r.scale = 0.125f * LOG2E; }
    else if (my < 1920) { r.kind = 2; r.off = OFF_KFB; r.dcol = my - 1664; }
    else if (my < 2176) { r.kind = 0; r.off = OFF_QC; r.dcol = my - 1920; r.pitch = 256; r.scale = 0.125f * LOG2E; }
    else if (my < 2432) { r.kind = 1; r.off = OFF_KFC; r.dcol = my - 2176; }
    else if (my < 2688) { r.kind = 0; r.off = OFF_QD; r.dcol = my - 2432; r.pitch = 256; r.scale = 0.17677669529663687f * LOG2E; }
    else if (my < 2944) { r.kind = 1; r.off = OFF_KFD; r.dcol = my - 2688; }
    else if (my < 3712) { r.kind = 0; r.off = OFF_VTMP; r.dcol = my - 2944; r.pitch = 768; }
    else if (my < 3968) { r.kind = 0; r.off = OFF_IDX; r.dcol = my - 3712; r.pitch = 320; r.scale = 0.17677669529663687f; }
    else if (my < 4000) { r.kind = 3; r.off = OFF_KIF; r.dcol = my - 3968; }
    else if (my < 4032) { r.kind = 0; r.off = OFF_IDX; r.dcol = my - 3712; r.pitch = 320; }
    return r;
}
DEVI size_t kf_off(int bh, int s, int d0) { return ((((size_t)bh * 64 + (s >> 5)) * 4 + (d0 >> 4)) * 64 + (s & 31) + 32 * ((d0 >> 3) & 1)) * 8; }
DEVI size_t kf4_off(int bh, int s, int d0) { const int pp = s >> 2, r4 = s & 3; return (((((size_t)bh * 4 + r4) * 16 + (pp >> 5)) * 4 + (d0 >> 4)) * 64 + (pp & 31) + 32 * ((d0 >> 3) & 1)) * 8; }
DEVI size_t kf16_off(int bh, int s, int d0) { const int pp = s >> 4, r = s & 15; return (((((size_t)bh * 16 + r) * 4 + (pp >> 5)) * 4 + (d0 >> 4)) * 64 + (pp & 31) + 32 * ((d0 >> 3) & 1)) * 8; }
DEVI size_t mixf_off(size_t tok, int c0) { return tok * 1024 + (size_t)c0; }
constexpr size_t FSZ = (size_t)32 * 64 * 4 * 64 * 8;

__device__ __constant__ unsigned short kP2Order[1024] = {63, 127, 191, 255, 62, 126, 190, 254, 61, 125, 189, 253, 60, 124, 188, 252, 59, 123, 187, 251, 58, 122, 186, 250, 57, 121, 185, 249, 56, 120, 184, 248, 55, 119, 183, 247, 54, 118, 182, 246, 53, 117, 181, 245, 52, 116, 180, 244, 51, 115, 179, 243, 50, 114, 178, 242, 49, 113, 177, 241, 48, 112, 176, 240, 47, 111, 175, 239, 46, 110, 174, 238, 45, 109, 173, 237, 44, 108, 172, 236, 43, 107, 171, 235, 42, 106, 170, 234, 41, 105, 169, 233, 40, 104, 168, 232, 39, 103, 167, 231, 319, 383, 447, 511, 318, 382, 446, 510, 38, 102, 166, 230, 317, 381, 445, 509, 316, 380, 444, 508, 37, 101, 165, 229, 315, 379, 443, 507, 36, 100, 164, 228, 314, 378, 442, 506, 313, 377, 441, 505, 35, 99, 163, 227, 312, 376, 440, 504, 34, 98, 162, 226, 311, 375, 439, 503, 310, 374, 438, 502, 33, 97, 161, 225, 309, 373, 437, 501, 308, 372, 436, 500, 32, 96, 160, 224, 307, 371, 435, 499, 31, 95, 159, 223, 306, 370, 434, 498, 305, 369, 433, 497, 30, 94, 158, 222, 304, 368, 432, 496, 29, 93, 157, 221, 303, 367, 431, 495, 302, 366, 430, 494, 28, 92, 156, 220, 301, 365, 429, 493, 300, 364, 428, 492, 27, 91, 155, 219, 299, 363, 427, 491, 26, 90, 154, 218, 298, 362, 426, 490, 575, 639, 703, 767, 297, 361, 425, 489, 574, 638, 702, 766, 25, 89, 153, 217, 573, 637, 701, 765, 296, 360, 424, 488, 572, 636, 700, 764, 24, 88, 152, 216, 295, 359, 423, 487, 571, 635, 699, 763, 570, 634, 698, 762, 294, 358, 422, 486, 569, 633, 697, 761, 23, 87, 151, 215, 293, 357, 421, 485, 568, 632, 696, 760, 567, 631, 695, 759, 292, 356, 420, 484, 22, 86, 150, 214, 566, 630, 694, 758, 291, 355, 419, 483, 565, 629, 693, 757, 564, 628, 692, 756, 21, 85, 149, 213, 290, 354, 418, 482, 563, 627, 691, 755, 289, 353, 417, 481, 562, 626, 690, 754, 20, 84, 148, 212, 561, 625, 689, 753, 288, 352, 416, 480, 560, 624, 688, 752, 19, 83, 147, 211, 287, 351, 415, 479, 559, 623, 687, 751, 558, 622, 686, 750, 286, 350, 414, 478, 557, 621, 685, 749, 18, 82, 146, 210, 285, 349, 413, 477, 556, 620, 684, 748, 555, 619, 683, 747, 284, 348, 412, 476, 17, 81, 145, 209, 554, 618, 682, 746, 283, 347, 411, 475, 553, 617, 681, 745, 552, 616, 680, 744, 16, 80, 144, 208, 282, 346, 410, 474, 551, 615, 679, 743, 281, 345, 409, 473, 550, 614, 678, 742, 15, 79, 143, 207, 549, 613, 677, 741, 280, 344, 408, 472, 548, 612, 676, 740, 14, 78, 142, 206, 279, 343, 407, 471, 547, 611, 675, 739, 546, 610, 674, 738, 278, 342, 406, 470, 545, 609, 673, 737, 13, 77, 141, 205, 277, 341, 405, 469, 544, 608, 672, 736, 543, 607, 671, 735, 276, 340, 404, 468, 12, 76, 140, 204, 542, 606, 670, 734, 275, 339, 403, 467, 541, 605, 669, 733, 768, 769, 770, 771, 772, 773, 774, 775, 776, 777, 778, 779, 780, 781, 782, 783, 784, 785, 786, 787, 788, 789, 790, 791, 792, 793, 794, 795, 796, 797, 798, 799, 800, 801, 802, 803, 804, 805, 806, 807, 808, 809, 810, 811, 812, 813, 814, 815, 816, 817, 818, 819, 820, 821, 822, 823, 824, 825, 826, 827, 828, 829, 830, 831, 832, 833, 834, 835, 836, 837, 838, 839, 840, 841, 842, 843, 844, 845, 846, 847, 848, 849, 850, 851, 852, 853, 854, 855, 856, 857, 858, 859, 860, 861, 862, 863, 864, 865, 866, 867, 868, 869, 870, 871, 872, 873, 874, 875, 876, 877, 878, 879, 880, 881, 882, 883, 884, 885, 886, 887, 888, 889, 890, 891, 892, 893, 894, 895, 896, 897, 898, 899, 900, 901, 902, 903, 904, 905, 906, 907, 908, 909, 910, 911, 912, 913, 914, 915, 916, 917, 918, 919, 920, 921, 922, 923, 924, 925, 926, 927, 928, 929, 930, 931, 932, 933, 934, 935, 936, 937, 938, 939, 940, 941, 942, 943, 944, 945, 946, 947, 948, 949, 950, 951, 952, 953, 954, 955, 956, 957, 958, 959, 960, 961, 962, 963, 964, 965, 966, 967, 968, 969, 970, 971, 972, 973, 974, 975, 976, 977, 978, 979, 980, 981, 982, 983, 984, 985, 986, 987, 988, 989, 990, 991, 992, 993, 994, 995, 996, 997, 998, 999, 1000, 1001, 1002, 1003, 1004, 1005, 1006, 1007, 1008, 1009, 1010, 1011, 1012, 1013, 1014, 1015, 1016, 1017, 1018, 1019, 1020, 1021, 1022, 1023, 540, 604, 668, 732, 11, 75, 139, 203, 274, 338, 402, 466, 539, 603, 667, 731, 273, 337, 401, 465, 538, 602, 666, 730, 10, 74, 138, 202, 537, 601, 665, 729, 272, 336, 400, 464, 536, 600, 664, 728, 9, 73, 137, 201, 271, 335, 399, 463, 535, 599, 663, 727, 534, 598, 662, 726, 270, 334, 398, 462, 533, 597, 661, 725, 8, 72, 136, 200, 269, 333, 397, 461, 532, 596, 660, 724, 531, 595, 659, 723, 268, 332, 396, 460, 7, 71, 135, 199, 530, 594, 658, 722, 267, 331, 395, 459, 529, 593, 657, 721, 528, 592, 656, 720, 6, 70, 134, 198, 266, 330, 394, 458, 527, 591, 655, 719, 265, 329, 393, 457, 526, 590, 654, 718, 5, 69, 133, 197, 525, 589, 653, 717, 264, 328, 392, 456, 524, 588, 652, 716, 4, 68, 132, 196, 263, 327, 391, 455, 523, 587, 651, 715, 522, 586, 650, 714, 262, 326, 390, 454, 521, 585, 649, 713, 3, 67, 131, 195, 261, 325, 389, 453, 520, 584, 648, 712, 519, 583, 647, 711, 260, 324, 388, 452, 2, 66, 130, 194, 518, 582, 646, 710, 259, 323, 387, 451, 517, 581, 645, 709, 516, 580, 644, 708, 1, 65, 129, 193, 258, 322, 386, 450, 515, 579, 643, 707, 257, 321, 385, 449, 514, 578, 642, 706, 0, 64, 128, 192, 513, 577, 641, 705, 256, 320, 384, 448, 512, 576, 640, 704};
__device__ __constant__ unsigned char kWgOrder[96] = {7, 15, 23, 31, 6, 14, 22, 30, 39, 47, 55, 63, 5, 13, 21, 29, 38, 46, 54, 62, 4, 12, 20, 28, 71, 79, 87, 95, 37, 45, 53, 61, 70, 78, 86, 94, 3, 11, 19, 27, 36, 44, 52, 60, 69, 77, 85, 93, 35, 43, 51, 59, 68, 76, 84, 92, 2, 10, 18, 26, 67, 75, 83, 91, 34, 42, 50, 58, 1, 9, 17, 25, 66, 74, 82, 90, 33, 41, 49, 57, 65, 73, 81, 89, 0, 8, 16, 24, 32, 40, 48, 56, 64, 72, 80, 88};
__device__ __constant__ int kBucketStart[16] = {16, 22, 30, 40, 54, 73, 99, 134, 182, 246, 332, 450, 609, 825, 1117, 1513};
DEVI int t5_bucket(int n) {
    if (n < 16) return n;
    int b = 16;
#pragma unroll
    for (int j = 1; j < 16; ++j) b += (n >= kBucketStart[j]) ? 1 : 0;
    return b;
}


#define XB_TMO      128
#define XB_XCNT(j)  (256  + 64 * (j))
#define XB_XSUB(j)  (1280 + 64 * (j))
#define XB_XGEN(j)  (2304 + 64 * (j))
#define XB_TOP      3328
#define XB_TOPGEN   3392
#define XCD_BAR_WORDS 3456
#define XB_SPIN_CAP (1u << 18)
__device__ __forceinline__ unsigned xb_ld(unsigned* p)              { return __hip_atomic_load(p, __ATOMIC_RELAXED, __HIP_MEMORY_SCOPE_AGENT); }
__device__ __forceinline__ unsigned xb_add(unsigned* p, unsigned v) { return __hip_atomic_fetch_add(p, v, __ATOMIC_RELAXED, __HIP_MEMORY_SCOPE_AGENT); }
__device__ __forceinline__ unsigned xb_xcc_id() { return (unsigned)__builtin_amdgcn_s_getreg((3 << 11) | 20) & 0xFu; }
#define XB_SPIN(cond, bar) do { unsigned _sp = 0; while (cond) { __builtin_amdgcn_s_sleep(1); \
    if ((++_sp & 255u) == 0u) { if (xb_ld(&(bar)[XB_TMO])) break; if (_sp > XB_SPIN_CAP) { atomicAdd(&(bar)[XB_TMO], 1u); break; } } } } while (0)
struct XcdBarrier { unsigned* bar; unsigned x; volatile LAS unsigned* st; };
__device__ __forceinline__ XcdBarrier xcd_barrier_post(unsigned* bar, volatile LAS unsigned* st) {
    XcdBarrier b; b.bar = bar; b.x = xb_xcc_id(); b.st = st;
    if (threadIdx.x == 0) (void)xb_add(&bar[XB_XCNT(b.x)], 1u);
    return b;
}
__device__ __forceinline__ void xcd_barrier_complete(unsigned* bar, unsigned x, unsigned& nloc, unsigned& nx) {
    const unsigned G = gridDim.x * gridDim.y * gridDim.z;
    unsigned sum, cnt, mine, sp = 0u;
    for (;;) {
        sum = 0u; cnt = 0u; mine = 0u;
#pragma unroll
        for (unsigned j = 0; j < 16; ++j) { const unsigned c = xb_ld(&bar[XB_XCNT(j)]); sum += c; cnt += (c > 0u) ? 1u : 0u; mine = (j == x) ? c : mine; }
        if (sum == G) break;
        __builtin_amdgcn_s_sleep(1);
        if ((++sp & 255u) == 0u) { if (xb_ld(&bar[XB_TMO])) break; if (sp > XB_SPIN_CAP) { atomicAdd(&bar[XB_TMO], 1u); break; } }
    }
    nloc = mine > 0u ? mine : 1u; nx = cnt > 0u ? cnt : 1u;
}
__device__ __forceinline__ void xcd_barrier(const XcdBarrier& b) {
    asm volatile("s_waitcnt vmcnt(0)" ::: "memory");
    __syncthreads();
    if (otid() == 0) {
        unsigned* bar = b.bar; unsigned bx = b.x; asm volatile("" : "+s"(bx));
        __builtin_amdgcn_s_waitcnt(0);
        unsigned nloc = b.st[0], nx = b.st[1];
        if (nloc == 0u) { xcd_barrier_complete(bar, bx, nloc, nx); b.st[0] = nloc; b.st[1] = nx; }
        const unsigned old = xb_add(&bar[XB_XSUB(bx)], 1u);
        const unsigned gen = old / nloc;
        if (old + 1u == (gen + 1u) * nloc) {
            __builtin_amdgcn_fence(__ATOMIC_RELEASE, "agent");
            asm volatile("s_waitcnt vmcnt(0)" ::: "memory");
            const unsigned og = xb_add(&bar[XB_TOP], 1u);
            const unsigned tg = og / nx;
            if (og + 1u == (tg + 1u) * nx) xb_add(&bar[XB_TOPGEN], 1u);
            else XB_SPIN(xb_ld(&bar[XB_TOPGEN]) == tg, bar);
            __builtin_amdgcn_fence(__ATOMIC_ACQUIRE, "agent");
            xb_add(&bar[XB_XGEN(bx)], 1u);
            asm volatile("s_waitcnt vmcnt(0)" ::: "memory");
        } else {
            XB_SPIN(xb_ld(&bar[XB_XGEN(bx)]) == gen, bar);
            __builtin_amdgcn_fence(__ATOMIC_ACQUIRE, "agent");
            asm volatile("s_waitcnt vmcnt(0)" ::: "memory");
        }
    }
    __syncthreads();
}

namespace pg8 {
#define PG8_LAS __attribute__((address_space(3)))
typedef unsigned short bf16_t;
typedef _Float16 f16x8 __attribute__((ext_vector_type(8)));
typedef float f32x4 __attribute__((ext_vector_type(4)));
typedef unsigned u32x4 __attribute__((ext_vector_type(4)));
constexpr int BM = 256, BK = 64, HALF = 128, HTB = HALF * BK * 2  , STAGE_BYTES = 8 * HTB, NXCD = 8, WGM = 8;

__host__ __device__ __forceinline__ int lds_byte(int r, int c) { const int st = (r >> 4) * 2 + (c >> 5), rr = r & 15, cc = c & 31, ob = rr * 64 + cc * 2; return st * 1024 + (ob ^ (((ob >> 9) & 1) << 5)); }
__host__ __device__ __forceinline__ void stage_rc(int b, int& R, int& C) { const int st = b / 1024, sb = b % 1024, swz = sb ^ (((sb >> 9) & 1) << 5); R = (st >> 1) * 16 + swz / 64; C = (st & 1) * 32 + (swz % 64) / 2; }
__host__ __device__ __forceinline__ int perm32(int rho) { const int n = rho >> 4, i = rho & 15; return 8 * (i >> 2) + 4 * n + (i & 3); }

struct Unit { int pm, pn; };
struct Gemm { const bf16_t* A; const bf16_t* Bt; int M, N, K; };

struct StaticOrder {
    int nM, nN, nwg, G, c;
    __host__ __device__ void init(int M, int N, int G_, int c_) { nM = M / BM; nN = N / BM; nwg = nM * nN; G = G_; c = c_; }
    __host__ __device__ bool next(int i, Unit& u) const {
        const long L = (long)i * G + c; if (L >= nwg) return false;
        int wgid = (int)L; { const int q = nwg / NXCD, r = nwg % NXCD, xcd = wgid % NXCD, off = wgid / NXCD; wgid = (xcd < r ? xcd * (q + 1) : r * (q + 1) + (xcd - r) * q) + off; }
        const int nig = WGM * nN, gid = wgid / nig, fm = gid * WGM, gsz = (nM - fm) < WGM ? (nM - fm) : WGM;
        u.pm = fm + ((wgid % nig) % gsz); u.pn = (wgid % nig) / gsz; return true;
    }
    __device__ __forceinline__ void a_ready(const Unit&) const {}
    __device__ __forceinline__ void done(const Unit&) const {}
};

template <class Epi, class Sched, bool ALIGN_EPI = false, bool SP2 = false>
__device__ __forceinline__ void gemm_phase(PG8_LAS unsigned char* lds, const Gemm g, const Sched& S, const Epi& E) {
    const int tid = otid(), wid = __builtin_amdgcn_readfirstlane(tid >> 6), lane = tid & 63, wr = wid >> 2, wc = wid & 3, fr = lane & 15, fq = lane >> 4;
    const int K = g.K, nt = K / BK;
    unsigned voffA[2], voffB[2];
#pragma unroll
    for (int i = 0; i < 2; ++i) { int R, C; stage_rc(tid * 16 + i * 8192, R, C); const int Rb = Epi::PERM ? ((R & ~31) + perm32(R & 31)) : R;
        voffA[i] = (unsigned)(R * K + C) * 2u; voffB[i] = (unsigned)(Rb * K + C) * 2u; }
    const size_t kstep = (size_t)(BK * 2);
    const size_t hstep = (size_t)HALF * K * 2;
    const size_t tstep = 2 * hstep;
    const unsigned ldsw = (unsigned)wid * 1024u;
    const int aoff = lds_byte(wr * 64 + fr, fq * 8), boff = lds_byte(wc * 32 + fr, fq * 8);
#define PG8_SA(b, h) (((b) * 2 + (h)) * HTB)
#define PG8_SB(b, h) ((4 + (b) * 2 + (h)) * HTB)
#define PG8_STAGE(bufoff, gbase, voff) do { _Pragma("unroll") for (int _i = 0; _i < 2; ++_i) \
        __builtin_amdgcn_global_load_lds((const unsigned*)((const char*)(gbase) + (voff)[_i]), (PG8_LAS unsigned*)(lds + (bufoff) + ldsw + _i * 8192), 16, 0, 0); } while (0)
#define PG8_LDA(dst, b, h) do { _Pragma("unroll") for (int m = 0; m < 4; ++m) _Pragma("unroll") for (int k = 0; k < 2; ++k) dst[m][k] = *(const PG8_LAS f16x8*)(lds + PG8_SA(b, h) + aoff + m * 2048 + k * 1024); } while (0)
#define PG8_LDB(dst, b, h) do { _Pragma("unroll") for (int n = 0; n < 2; ++n) _Pragma("unroll") for (int k = 0; k < 2; ++k) dst[n][k] = *(const PG8_LAS f16x8*)(lds + PG8_SB(b, h) + boff + n * 2048 + k * 1024); } while (0)
#define PG8_MMA(ai, bj, At, Bt) do { __builtin_amdgcn_s_setprio(1); _Pragma("unroll") for (int m = 0; m < 4; ++m) _Pragma("unroll") for (int n = 0; n < 2; ++n) _Pragma("unroll") for (int k = 0; k < 2; ++k) \
        acc[ai][bj][m][n] = __builtin_amdgcn_mfma_f32_16x16x32_f16(Bt[n][k], At[m][k], acc[ai][bj][m][n], 0, 0, 0); __builtin_amdgcn_s_setprio(0); } while (0)
#define PG8_WAIT_V(n) asm volatile("s_waitcnt vmcnt(" #n ")" ::: "memory")
#define PG8_WAIT_L(n) asm volatile("s_waitcnt lgkmcnt(" #n ")" ::: "memory")
#define PG8_BAR __builtin_amdgcn_s_barrier()
#define PG8_SCHED __builtin_amdgcn_sched_barrier(0)
    Unit cur, nxt; int ui = 0;
    if (!S.next(0, cur)) return;
    f32x4 acc[2][2][4][2];
#pragma unroll
    for (int a = 0; a < 2; ++a)
#pragma unroll
        for (int b = 0; b < 2; ++b)
#pragma unroll
            for (int m = 0; m < 4; ++m)
#pragma unroll
                for (int n = 0; n < 2; ++n) acc[a][b][m][n] = (f32x4){0.f, 0.f, 0.f, 0.f};
    f16x8 At[4][2], B0[2][2], B1[2][2];
    const char* cA = (const char*)g.A + (size_t)cur.pm * tstep; const char* cB = (const char*)g.Bt + (size_t)cur.pn * tstep;
    S.a_ready(cur);
    if constexpr (SP2) {
        PG8_STAGE(PG8_SB(0, 0), cB, voffB); PG8_STAGE(PG8_SB(0, 1), cB + hstep, voffB); PG8_STAGE(PG8_SA(0, 0), cA, voffA); PG8_STAGE(PG8_SA(0, 1), cA + hstep, voffA);
        if (wr == 1) PG8_BAR;
        PG8_WAIT_V(2); PG8_BAR;
        PG8_STAGE(PG8_SB(1, 0), cB + kstep, voffB); PG8_STAGE(PG8_SA(1, 0), cA + kstep, voffA); PG8_STAGE(PG8_SB(1, 1), cB + hstep + kstep, voffB);
        PG8_WAIT_V(6); PG8_BAR;
    } else {
        PG8_STAGE(PG8_SB(0, 0), cB, voffB); PG8_STAGE(PG8_SA(0, 0), cA, voffA); PG8_STAGE(PG8_SB(0, 1), cB + hstep, voffB); PG8_STAGE(PG8_SA(0, 1), cA + hstep, voffA);
        if (wr == 1) PG8_BAR;
        PG8_WAIT_V(4); PG8_BAR;
        PG8_STAGE(PG8_SB(1, 0), cB + kstep, voffB); PG8_STAGE(PG8_SA(1, 0), cA + kstep, voffA); PG8_STAGE(PG8_SB(1, 1), cB + hstep + kstep, voffB);
        PG8_WAIT_V(6); PG8_BAR;
    }
    for (;;) {
        const bool has_next = S.next(ui + 1, nxt);
        const char* nA = has_next ? (const char*)g.A + (size_t)nxt.pm * tstep : cA; const char* nB = has_next ? (const char*)g.Bt + (size_t)nxt.pn * tstep : cB;
        for (int t = 0; t < nt; t += 2) {
            const bool last = (t == nt - 2);
            const char* a1 = cA + (size_t)(t + 1) * kstep;
            const char* a2 = last ? nA : cA + (size_t)(t + 2) * kstep; const char* b2 = last ? nB : cB + (size_t)(t + 2) * kstep;
            const char* a3 = a2 + kstep; const char* b3 = b2 + kstep;
            if (last && has_next) S.a_ready(nxt);
            if constexpr (SP2) {
            PG8_LDB(B0, 0, 0); PG8_LDB(B1, 0, 1); PG8_SCHED; PG8_LDA(At, 0, 0); PG8_STAGE(PG8_SA(1, 1), a1 + hstep, voffA);
            PG8_WAIT_V(8); PG8_WAIT_L(0); PG8_BAR; PG8_MMA(0, 0, At, B0); PG8_MMA(0, 1, At, B1); PG8_BAR; PG8_SCHED;
            PG8_LDA(At, 0, 1); PG8_STAGE(PG8_SB(0, 0), b2, voffB); PG8_STAGE(PG8_SB(0, 1), b2 + hstep, voffB); PG8_STAGE(PG8_SA(0, 0), a2, voffA);
            PG8_WAIT_V(8); PG8_WAIT_L(0); PG8_BAR; PG8_MMA(1, 0, At, B0); PG8_MMA(1, 1, At, B1); PG8_BAR; PG8_SCHED;
            PG8_LDB(B0, 1, 0); PG8_LDB(B1, 1, 1); PG8_SCHED; PG8_LDA(At, 1, 0); PG8_STAGE(PG8_SA(0, 1), a2 + hstep, voffA);
            PG8_WAIT_V(8); PG8_WAIT_L(0); PG8_BAR; PG8_MMA(0, 0, At, B0); PG8_MMA(0, 1, At, B1); PG8_BAR; PG8_SCHED;
            PG8_LDA(At, 1, 1); PG8_STAGE(PG8_SB(1, 0), b3, voffB); PG8_STAGE(PG8_SB(1, 1), b3 + hstep, voffB); PG8_STAGE(PG8_SA(1, 0), a3, voffA);
            PG8_WAIT_V(8); PG8_WAIT_L(0); PG8_BAR; PG8_MMA(1, 0, At, B0); PG8_MMA(1, 1, At, B1); PG8_BAR; PG8_SCHED;
            } else {
            PG8_LDB(B0, 0, 0); PG8_SCHED; PG8_LDA(At, 0, 0); PG8_STAGE(PG8_SA(1, 1), a1 + hstep, voffA);
            PG8_WAIT_L(8); PG8_BAR; PG8_WAIT_L(0); PG8_MMA(0, 0, At, B0); PG8_BAR; PG8_SCHED;
            PG8_LDB(B1, 0, 1); PG8_STAGE(PG8_SB(0, 0), b2, voffB);
            PG8_BAR; PG8_WAIT_L(0); PG8_MMA(0, 1, At, B1); PG8_BAR;
            PG8_LDA(At, 0, 1); PG8_STAGE(PG8_SA(0, 0), a2, voffA);
            PG8_BAR; PG8_WAIT_L(0); PG8_MMA(1, 0, At, B0); PG8_BAR; PG8_SCHED;
            PG8_STAGE(PG8_SB(0, 1), b2 + hstep, voffB);
            PG8_WAIT_V(6); PG8_BAR; PG8_MMA(1, 1, At, B1); PG8_BAR;
            PG8_LDB(B0, 1, 0); PG8_SCHED; PG8_LDA(At, 1, 0); PG8_STAGE(PG8_SA(0, 1), a2 + hstep, voffA);
            PG8_WAIT_L(8); PG8_BAR; PG8_WAIT_L(0); PG8_MMA(0, 0, At, B0); PG8_BAR; PG8_SCHED;
            PG8_LDB(B1, 1, 1); PG8_STAGE(PG8_SB(1, 0), b3, voffB);
            PG8_BAR; PG8_WAIT_L(0); PG8_MMA(0, 1, At, B1); PG8_BAR;
            PG8_LDA(At, 1, 1); PG8_STAGE(PG8_SA(1, 0), a3, voffA);
            PG8_BAR; PG8_WAIT_L(0); PG8_MMA(1, 0, At, B0); PG8_BAR; PG8_SCHED;
            PG8_STAGE(PG8_SB(1, 1), b3 + hstep, voffB);
            PG8_WAIT_V(6); PG8_BAR; PG8_MMA(1, 1, At, B1); PG8_BAR;
            }
        }
        if constexpr (ALIGN_EPI) { if (wr == 0) PG8_BAR; }
        if constexpr (!Epi::AFTER_DRAIN) { E(acc, cur, wr, wc, fr, fq); S.done(cur); }
        if (!has_next) break;
#pragma unroll
        for (int a = 0; a < 2; ++a)
#pragma unroll
            for (int b = 0; b < 2; ++b)
#pragma unroll
                for (int m = 0; m < 4; ++m)
#pragma unroll
                    for (int n = 0; n < 2; ++n) acc[a][b][m][n] = (f32x4){0.f, 0.f, 0.f, 0.f};
        cur = nxt; cA = nA; cB = nB; ++ui;
        if constexpr (ALIGN_EPI) { if (wr == 1) PG8_BAR; }
    }
    PG8_WAIT_V(0);
    if constexpr (!ALIGN_EPI) { if (wr == 0) PG8_BAR; }
    PG8_BAR;
    if constexpr (Epi::AFTER_DRAIN) { E.fused(acc, cur, wr, wc, fr, fq, lds, wid, lane); S.done(cur); }
#undef PG8_SA
#undef PG8_SB
#undef PG8_STAGE
#undef PG8_LDA
#undef PG8_LDB
#undef PG8_MMA
#undef PG8_WAIT_V
#undef PG8_WAIT_L
#undef PG8_BAR
#undef PG8_SCHED
}
}


typedef float f32x4_t __attribute__((ext_vector_type(4)));
typedef _Float16 h16x8 __attribute__((ext_vector_type(8)));
DEVI float silu_f(float v) { return v / (1.f + __expf(-v)); }
struct EpiRoute {
    static constexpr bool PERM = true, AFTER_DRAIN = false;
    gu8* ws; const gf32* ssq;
    DEVI void operator()(const pg8::f32x4 (&acc)[2][2][4][2], const pg8::Unit& u, int wr, int wc, int fr, int fq) const {
        const int row0 = u.pm * 256 + wr * 64 + fr;
        float rs[2][4];
#pragma unroll
        for (int ai = 0; ai < 2; ++ai)
#pragma unroll
            for (int m = 0; m < 4; ++m) { const int rw = row0 + ai * 128 + m * 16; rs[ai][m] = rsqrtf((ssq[rw] + ssq[NT + rw] + ssq[2 * NT + rw] + ssq[3 * NT + rw]) * (1.f / DM) + EPS); }
#pragma unroll
        for (int bj = 0; bj < 2; ++bj) {
            const int cg = u.pn * 256 + bj * 128 + wc * 32;
            const Route r = route(cg);
            if (r.kind < 0) continue;
            gh16* base = (gh16*)(ws + r.off);
            const int c = r.dcol + 8 * fq;
#pragma unroll
            for (int ai = 0; ai < 2; ++ai)
#pragma unroll
                for (int m = 0; m < 4; ++m) {
                    const int row = row0 + ai * 128 + m * 16; const float sc = rs[ai][m] * r.scale;
                    float v[8];
#pragma unroll
                    for (int j = 0; j < 4; ++j) { v[j] = acc[ai][bj][m][0][j] * sc; v[4 + j] = acc[ai][bj][m][1][j] * sc; }
                    if (r.silu) {
#pragma unroll
                        for (int j = 0; j < 8; ++j) v[j] = silu_f(v[j]);
                    }
                    h16x8 o;
#pragma unroll
                    for (int j = 0; j < 8; ++j) o[j] = (h16)v[j];
                    if (r.kind == 0) *(GAS h16x8*)(base + (size_t)row * r.pitch + c) = o;
                    else {
                        const int b = row >> 11, sq = row & 2047;
                        if (r.kind == 3) *(GAS h16x8*)(base + (((size_t)b * 128 + (sq >> 4)) * 64 + (sq & 15) + 16 * (c >> 3)) * 8) = o;
                        else {
                            const int bh = b * 4 + (c >> 6), d0 = c & 63;
                            *(GAS h16x8*)(base + kf_off(bh, sq, d0)) = o;
                            if (r.kind == 2) { *(GAS h16x8*)(base + FSZ + kf4_off(bh, sq, d0)) = o; *(GAS h16x8*)(base + 2 * FSZ + kf16_off(bh, sq, d0)) = o; }
                        }
                    }
                }
        }
    }
};

struct EpiOut {
    static constexpr bool PERM = true, AFTER_DRAIN = true;
    const gf32* h_in; gf32* h_out; gh16* h16o; const gf32* gpost; gf32* ssqy; gf32* ssqh; const XcdBarrier* bar; bool write_next;
    DEVI void rowsum_publish(const float (&ps)[2][4], gf32* dst, const pg8::Unit& u, int wr, int wc, int fr, int fq, PG8_LAS unsigned char* lds) const {
        lf32* red = (lf32*)lds;
        __syncthreads();
#pragma unroll
        for (int ai = 0; ai < 2; ++ai)
#pragma unroll
            for (int m = 0; m < 4; ++m) { float v = ps[ai][m]; v += __shfl_xor(v, 16); v += __shfl_xor(v, 32); if (fq == 0) red[wc * 256 + ai * 128 + wr * 64 + m * 16 + fr] = v; }
        __syncthreads();
        const int t = otid();
        if (t < 256) dst[(size_t)u.pn * NT + u.pm * 256 + t] = red[t] + red[256 + t] + red[512 + t] + red[768 + t];
    }
    DEVI void fused(pg8::f32x4 (&acc)[2][2][4][2], const pg8::Unit& u, int wr, int wc, int fr, int fq, PG8_LAS unsigned char* lds, int wid, int lane) const {
        float ps[2][4];
#pragma unroll
        for (int ai = 0; ai < 2; ++ai)
#pragma unroll
            for (int m = 0; m < 4; ++m) { float v = 0.f;
#pragma unroll
                for (int bj = 0; bj < 2; ++bj)
#pragma unroll
                    for (int n = 0; n < 2; ++n)
#pragma unroll
                        for (int e = 0; e < 4; ++e) v += acc[ai][bj][m][n][e] * acc[ai][bj][m][n][e];
                ps[ai][m] = v; }
        rowsum_publish(ps, ssqy, u, wr, wc, fr, fq, lds);
        xcd_barrier(*bar);
        const int row0 = u.pm * 256 + wr * 64 + fr;
#pragma unroll
        for (int ai = 0; ai < 2; ++ai)
#pragma unroll
            for (int m = 0; m < 4; ++m) {
                const int row = row0 + ai * 128 + m * 16;
                const float rs = rsqrtf((ssqy[row] + ssqy[NT + row] + ssqy[2 * NT + row] + ssqy[3 * NT + row]) * (1.f / DM) + EPS);
                float v2 = 0.f;
#pragma unroll
                for (int bj = 0; bj < 2; ++bj) {
                    const int col = u.pn * 256 + bj * 128 + wc * 32 + 8 * fq;
                    const size_t off = (size_t)row * DM + col;
                    h16x8 oh;
#pragma unroll
                    for (int n = 0; n < 2; ++n) {
                        const f32x4_t hv = *(const GAS f32x4_t*)(h_in + off + 4 * n), gv = *(const GAS f32x4_t*)(gpost + col + 4 * n);
                        f32x4_t o;
#pragma unroll
                        for (int e = 0; e < 4; ++e) { o[e] = hv[e] + acc[ai][bj][m][n][e] * rs * gv[e]; v2 += o[e] * o[e]; oh[4 * n + e] = (h16)o[e]; }
                        *(GAS f32x4_t*)(h_out + off + 4 * n) = o;
                    }
                    if (write_next) *(GAS h16x8*)(h16o + off) = oh;
                }
                ps[ai][m] = v2;
            }
        if (write_next) rowsum_publish(ps, ssqh, u, wr, wc, fr, fq, lds);
    }
    DEVI void operator()(const pg8::f32x4 (&)[2][2][4][2], const pg8::Unit&, int, int, int, int) const {}
};

constexpr int NTHR = 512, NWAVE = 8;

template <bool REF>
DEVI void cvt_transpose(const gf32* __restrict__ src, int src_pitch, const gf32* __restrict__ g, gh16* dst, int N, int K, lu8* lds, int item0, int nitems_total, int& item_base) {
    const int tid = otid();
    LAS float (*tile)[65] = (LAS float (*)[65])lds;
    const int ntn = N / 64, ntk = K / 64, n_it = ntn * ntk;
    for (int it = item0; it < nitems_total; it += gridDim.x) {
        const int li = it - item_base; if (li < 0 || li >= n_it) continue;
        const int n0 = (li % ntn) * 64, k0 = (li / ntn) * 64;
        __syncthreads();
        const int c = tid & 63; int rc = n0 + c; if (REF) rc = ref_col(rc);
#pragma unroll
        for (int ps = 0; ps < 8; ++ps) { const int k = ps * 8 + (tid >> 6);
            tile[k][c] = rc >= 0 ? src[(size_t)(k0 + k) * src_pitch + rc] * (g ? g[k0 + k] : 1.f) : 0.f; }
        __syncthreads();
        const int cc = tid >> 3, kq = (tid & 7) * 8;
        h16x8 o;
#pragma unroll
        for (int j = 0; j < 8; ++j) o[j] = (h16)tile[kq + j][cc];
        *(GAS h16x8*)(dst + (size_t)(n0 + cc) * K + k0 + kq) = o;
    }
    item_base += n_it;
}

DEVI void ph_rowstat_cvt(const gf32* h, gf32* ssq, gh16* h16o) {
    const int t_ = otid(); const int lane = t_ & 63, gw = blockIdx.x * NWAVE + (t_ >> 6), nw = gridDim.x * NWAVE;
    for (int row = gw; row < NT; row += nw) {
        const GAS f32x4_t* p = (const GAS f32x4_t*)(h + (size_t)row * DM);
        float s = 0.f;
#pragma unroll
        for (int i = 0; i < 4; ++i) { f32x4_t v = p[lane + 64 * i]; s += v[0] * v[0] + v[1] * v[1] + v[2] * v[2] + v[3] * v[3];
            typedef _Float16 h16x4 __attribute__((ext_vector_type(4)));
            h16x4 o; o[0] = (h16)v[0]; o[1] = (h16)v[1]; o[2] = (h16)v[2]; o[3] = (h16)v[3];
            *(GAS h16x4*)(h16o + (size_t)row * DM + (lane + 64 * i) * 4) = o; }
        for (int o = 32; o; o >>= 1) s += __shfl_xor(s, o);
        if (lane == 0) { ssq[row] = s; ssq[NT + row] = 0.f; ssq[2 * NT + row] = 0.f; ssq[3 * NT + row] = 0.f; }
    }
}

typedef float f32x16 __attribute__((ext_vector_type(16)));
typedef _Float16 h16x4 __attribute__((ext_vector_type(4)));
DEVI f32x16 mfma32(h16x8 a, h16x8 b, f32x16 c) { return __builtin_amdgcn_mfma_f32_32x32x16_f16(a, b, c, 0, 0, 0); }
#define CROW(r) (((r) & 3) + 8 * ((r) >> 2))
DEVI float xh_max(float x) { auto r = __builtin_amdgcn_permlane32_swap(__float_as_uint(x), __float_as_uint(x), false, false); return fmaxf(__uint_as_float(r[0]), __uint_as_float(r[1])); }
DEVI float xh_sum(float x) { auto r = __builtin_amdgcn_permlane32_swap(__float_as_uint(x), __float_as_uint(x), false, false); return __uint_as_float(r[0]) + __uint_as_float(r[1]); }
DEVI unsigned pk2h(float a, float b) { auto v = __builtin_amdgcn_cvt_pkrtz(a, b); return __builtin_bit_cast(unsigned, v); }
DEVI h16x8 pack8(const f32x16& p, int s) {
    typedef unsigned u32x4_t __attribute__((ext_vector_type(4)));
    u32x4_t w;
    w[0] = pk2h(p[8 * s + 0], p[8 * s + 1]); w[1] = pk2h(p[8 * s + 2], p[8 * s + 3]); w[2] = pk2h(p[8 * s + 4], p[8 * s + 5]); w[3] = pk2h(p[8 * s + 6], p[8 * s + 7]);
    return __builtin_bit_cast(h16x8, w);
}
DEVI h16x8 ldv8(const gh16* p) {
    h16x4 a = *(const GAS h16x4*)p, b = *(const GAS h16x4*)(p + 8);
    h16x8 r; r[0] = a[0]; r[1] = a[1]; r[2] = a[2]; r[3] = a[3]; r[4] = b[0]; r[5] = b[1]; r[6] = b[2]; r[7] = b[3]; return r;
}
DEVI void softmax_tile(f32x16& S, float& m, float& l, f32x16& O0, f32x16& O1) {
    float mx = S[0];
#pragma unroll
    for (int r = 1; r < 16; ++r) mx = fmaxf(mx, S[r]);
    mx = xh_max(mx);
    if (__any(mx > m)) {
        const float mn = fmaxf(m, mx), al = __builtin_amdgcn_exp2f(m - mn);
        l *= al; O0 *= al; O1 *= al; m = mn;
    }
#pragma unroll
    for (int r = 0; r < 16; ++r) S[r] = __builtin_amdgcn_exp2f(S[r] - m);
    l += ((S[0] + S[1]) + (S[2] + S[3])) + ((S[4] + S[5]) + (S[6] + S[7])) + (((S[8] + S[9]) + (S[10] + S[11])) + ((S[12] + S[13]) + (S[14] + S[15])));
}
DEVI void softmax_tile_h(f32x16& S, float& m, float& l, f32x16& O0, f32x16& O1, int hot) { if (hot < 2) softmax_tile(S, m, l, O0, O1); else l += S[0]; }
DEVI int wq_next(gu32* ctr) {
    int e = 0;
    if ((otid() & 63) == 0) e = (int)__hip_atomic_fetch_add(ctr, 1u, __ATOMIC_RELAXED, __HIP_MEMORY_SCOPE_AGENT);
    return __builtin_amdgcn_readfirstlane(e);
}

DEVI void flashA_item(int b, int hh, int qt, const gh16* qA, const gh16* KF, const gh16* KRF, const gh16* VF, const gh16* gate, gh16* mix) {
    const int lane = otid() & 63, q = lane & 31, h = lane >> 5;
    const size_t tokq = (size_t)b * SEQ + qt * 32 + q;
    h16x8 qf[6];
#pragma unroll
    for (int ks = 0; ks < 6; ++ks) qf[ks] = *(const GAS h16x8*)(qA + tokq * 384 + hh * 96 + ks * 16 + 8 * h);
    f32x16 O0 = {}, O1 = {};
    float m = -1e30f, l = 0.f;
    const gh16* kp = KF + (size_t)(b * 4 + hh) * 64 * 2048 + lane * 8;
    const gh16* rp = KRF + (size_t)b * 64 * 1024 + lane * 8;
    const gh16* vp = VF + (size_t)(b * 4 + hh) * 64 * 2048 + lane * 8;
    h16x8 kf[6];
#pragma unroll
    for (int ks = 0; ks < 4; ++ks) kf[ks] = *(const GAS h16x8*)(kp + ks * 512);
#pragma unroll
    for (int ks = 0; ks < 2; ++ks) kf[4 + ks] = *(const GAS h16x8*)(rp + ks * 512);
    h16x8 vf[4], vn[4];
#pragma unroll
    for (int f = 0; f < 4; ++f) vf[f] = *(const GAS h16x8*)(vp + f * 512);
    for (int j = 0; j <= qt; ++j) {
        f32x16 S = {};
#pragma unroll
        for (int ks = 0; ks < 6; ++ks) S = mfma32(kf[ks], qf[ks], S);
        if (j < qt) {
#pragma unroll
            for (int ks = 0; ks < 4; ++ks) kf[ks] = *(const GAS h16x8*)(kp + (size_t)(j + 1) * 2048 + ks * 512);
#pragma unroll
            for (int ks = 0; ks < 2; ++ks) kf[4 + ks] = *(const GAS h16x8*)(rp + (size_t)(j + 1) * 1024 + ks * 512);
#pragma unroll
            for (int f = 0; f < 4; ++f) vn[f] = *(const GAS h16x8*)(vp + (size_t)(j + 1) * 2048 + f * 512);
        } else {
#pragma unroll
            for (int r = 0; r < 16; ++r) S[r] = (CROW(r) + 4 * h > q) ? -3e38f : S[r];
        }
        softmax_tile(S, m, l, O0, O1);
        const h16x8 p0 = pack8(S, 0), p1 = pack8(S, 1);
        O0 = mfma32(vf[0], p0, O0); O0 = mfma32(vf[1], p1, O0);
        O1 = mfma32(vf[2], p0, O1); O1 = mfma32(vf[3], p1, O1);
#pragma unroll
        for (int f = 0; f < 4; ++f) vf[f] = vn[f];
    }
    const float il = 1.f / xh_sum(l);
    const gh16* gp = gate + tokq * 1024 + hh * 64 + 4 * h;
#pragma unroll
    for (int db = 0; db < 2; ++db)
#pragma unroll
        for (int g = 0; g < 4; ++g) {
            const h16x4 gv = *(const GAS h16x4*)(gp + db * 32 + 8 * g); h16x4 o;
#pragma unroll
            for (int e = 0; e < 4; ++e) o[e] = (h16)((db ? O1[4 * g + e] : O0[4 * g + e]) * il * (float)gv[e]);
            *(GAS h16x4*)(mix + mixf_off(tokq, hh * 64 + db * 32 + 8 * g + 4 * h)) = o;
        }
}

DEVI int far_bucket(int n) { return 23 + (n >= 182 ? 1 : 0) + (n >= 246 ? 1 : 0) + (n >= 332 ? 1 : 0) + (n >= 450 ? 1 : 0) + (n >= 609 ? 1 : 0) + (n >= 825 ? 1 : 0) + (n >= 1117 ? 1 : 0) + (n >= 1513 ? 1 : 0); }
DEVI int far_start(int bk) { return bk == 24 ? 182 : bk == 25 ? 246 : bk == 26 ? 332 : bk == 27 ? 450 : bk == 28 ? 609 : bk == 29 ? 825 : bk == 30 ? 1117 : 1513; }
constexpr int L_NEAR = 0, L_R3 = 12288, L_R2 = 15360, L_R1 = 21504, L_LAM = 39936, L_P2END = 40000;
constexpr int L_BIASL = 40000, L_RING = 41984, L_MRING = L_RING + 4 * 10240, L_WQ = L_MRING + 8192;
DEVI void p2_setup(const gf32* biasTab, const gf32* lam_p, float lambda_init, lu8* lds) {
    const int tid = otid();
    lf32* nearR = (lf32*)(lds + L_NEAR);
    for (int i = tid; i < 12 * 256; i += NTHR) { const int hb = i >> 8, u = i & 255, tix = 223 - u; nearR[i] = tix < 0 ? -3e38f : biasTab[hb * 2048 + tix]; }
    lf32* R3 = (lf32*)(lds + L_R3); lf32* R2 = (lf32*)(lds + L_R2); lf32* R1 = (lf32*)(lds + L_R1);
    for (int i = tid; i < 4 * 192; i += NTHR) { const int hb = i / 192, kk = 159 - (i % 192); R3[i] = (kk < 0 || kk > 128) ? -3e38f : biasTab[hb * 2048 + kk * 16]; }
    for (int i = tid; i < 4 * 384; i += NTHR) { const int hb = i / 384, kk = 255 - (i % 384); R2[i] = (kk < 0 || kk > 128) ? -3e38f : biasTab[hb * 2048 + kk * 4]; }
    for (int i = tid; i < 4 * 1152; i += NTHR) { const int hb = i / 1152, kk = 639 - (i % 1152); R1[i] = (kk < 0 || kk > 128) ? -3e38f : biasTab[hb * 2048 + kk]; }
    { lf32* bl = (lf32*)(lds + L_BIASL); for (int i = tid; i < 12 * 32; i += NTHR) { const int hb = i >> 5, k = i & 31; bl[i] = biasTab[hb * 2048 + (k < 16 ? k : kBucketStart[k - 16])]; } }
    if (tid == 0) { float a1 = 0.f, a2 = 0.f; for (int i = 0; i < 32; ++i) { a1 += lam_p[i] * lam_p[32 + i]; a2 += lam_p[64 + i] * lam_p[96 + i]; }
        *(lf32*)(lds + L_LAM) = expf(a1) - expf(a2) + lambda_init; }
    __syncthreads();
}

DEVI void ph_vtrans(const gh16* vtmp, gh16* VF, lu8* lds) {
    const int tid = otid();
    LAS h16 (*tile)[72] = (LAS h16 (*)[72])lds;
    for (int it = blockIdx.x; it < 3 * 32 * 4; it += gridDim.x) {
        const int src = it >> 7, bh = (it >> 2) & 31, blk = it & 3, b = bh >> 2, hh = bh & 3;
        __syncthreads();
#pragma unroll
        for (int k = 0; k < 8; ++k) { const int idx = k * NTHR + tid, row = idx >> 3, c8 = idx & 7;
            *(LAS h16x8*)&tile[row][c8 * 8] = *(const GAS h16x8*)(vtmp + ((size_t)b * SEQ + blk * 512 + row) * 768 + src * 256 + hh * 64 + c8 * 8); }
        __syncthreads();
        gh16* out0 = VF + (src == 0 ? 0 : (src == 1 ? 3 * FSZ : 4 * FSZ));
#pragma unroll 1
        for (int k = 0; k < 8; ++k) {
            const int fl = k * NTHR + tid, lane = fl & 63, frag = (fl >> 6) & 3, dl = lane & 31, hp = lane >> 5, db = frag >> 1, sk = frag & 1;
            {
                const int tl = fl >> 8; h16x8 o;
#pragma unroll
                for (int e = 0; e < 8; ++e) o[e] = tile[tl * 32 + 16 * sk + 8 * (e >> 2) + 4 * hp + (e & 3)][db * 32 + dl];
                *(GAS h16x8*)(out0 + ((((size_t)bh * 64 + blk * 16 + tl) * 4 + frag) * 64 + lane) * 8) = o;
            }
            if (src == 0) {
                {
                    const int r4 = fl >> 10, tl = (fl >> 8) & 3; h16x8 o;
#pragma unroll
                    for (int e = 0; e < 8; ++e) o[e] = tile[4 * (tl * 32 + 16 * sk + 8 * (e >> 2) + 4 * hp + (e & 3)) + r4][db * 32 + dl];
                    *(GAS h16x8*)(out0 + FSZ + (((((size_t)bh * 4 + r4) * 16 + blk * 4 + tl) * 4 + frag) * 64 + lane) * 8) = o;
                }
                {
                    const int r = fl >> 8; h16x8 o;
#pragma unroll
                    for (int e = 0; e < 8; ++e) o[e] = tile[16 * (16 * sk + 8 * (e >> 2) + 4 * hp + (e & 3)) + r][db * 32 + dl];
                    *(GAS h16x8*)(out0 + 2 * FSZ + (((((size_t)bh * 16 + r) * 4 + blk) * 4 + frag) * 64 + lane) * 8) = o;
                }
            }
        }
    }
}

template <int NMAP, bool MASK>
DEVI void flashCD_item(int b, int hh, int qt, int hb, const gh16* Q, const gh16* KF, const gh16* VF, const gu32* mask, const gf32* biasTab, const lu8* lds,
                       const gf32* subln, float lambda_init, const gh16* gate, gh16* mix, int mixcol, int hot = 0) {
    constexpr int NKS = 4 / NMAP;
    const int lane = otid() & 63, q = lane & 31, h = lane >> 5;
    const size_t tokq = (size_t)b * SEQ + qt * 32 + q;
    const gh16* kp = KF + (size_t)(b * 4 + hh) * 64 * 2048 + lane * 8;
    const gh16* vp = VF + (size_t)(b * 4 + hh) * 64 * 2048 + lane * 8;
    h16x8 qf[NMAP][NKS], kf[NMAP][NKS];
#pragma unroll
    for (int mp = 0; mp < NMAP; ++mp)
#pragma unroll
        for (int ks = 0; ks < NKS; ++ks) {
            qf[mp][ks] = *(const GAS h16x8*)(Q + tokq * 256 + hh * 64 + (mp * NKS + ks) * 16 + 8 * h);
            kf[mp][ks] = *(const GAS h16x8*)(kp + (mp * NKS + ks) * 512);
        }
    f32x16 O[NMAP][2]; float m[NMAP], l[NMAP];
#pragma unroll
    for (int mp = 0; mp < NMAP; ++mp) { O[mp][0] = (f32x16){}; O[mp][1] = (f32x16){}; m[mp] = -1e30f; l[mp] = 0.f; }
    const lf32* nearR = (const lf32*)(lds + L_NEAR) + hb * 256;
    const gf32* bt = biasTab + hb * 2048;
    h16x8 vf[2][2], vn[2][2];
#pragma unroll
    for (int db = 0; db < 2; ++db)
#pragma unroll
        for (int sk = 0; sk < 2; ++sk) vf[db][sk] = *(const GAS h16x8*)(vp + (db * 2 + sk) * 512);
    unsigned mw = 0xffffffffu, mwn = 0xffffffffu;
    if (MASK) mw = mask[tokq * 64];
    for (int j = 0; j <= qt; ++j) {
        f32x16 S[NMAP];
#pragma unroll
        for (int mp = 0; mp < NMAP; ++mp) { S[mp] = (f32x16){};
#pragma unroll
            for (int ks = 0; ks < NKS; ++ks) S[mp] = mfma32(kf[mp][ks], qf[mp][ks], S[mp]); }
        if (j < qt && hot < 5) {
#pragma unroll
            for (int mp = 0; mp < NMAP; ++mp)
#pragma unroll
                for (int ks = 0; ks < NKS; ++ks) kf[mp][ks] = *(const GAS h16x8*)(kp + (size_t)(hot ? 0 : j + 1) * 2048 + (mp * NKS + ks) * 512);
#pragma unroll
            for (int db = 0; db < 2; ++db)
#pragma unroll
                for (int sk = 0; sk < 2; ++sk) vn[db][sk] = *(const GAS h16x8*)(vp + (size_t)(hot ? 0 : j + 1) * 2048 + (db * 2 + sk) * 512);
            if (MASK) mwn = mask[tokq * 64 + j + 1];
        }
        const int D0 = (qt - j) * 32;
        if (hot >= 3) {} else
        if (D0 < 192) {
            const lf32* tp = nearR + (223 - D0 - q + 4 * h);
#pragma unroll
            for (int r = 0; r < 16; ++r) { const float bv = tp[CROW(r)];
#pragma unroll
                for (int mp = 0; mp < NMAP; ++mp) S[mp][r] += bv; }
        } else {
            const int blo = far_bucket(D0 - 31), bhi = far_bucket(D0 + 31);
            const lf32* biasL = (const lf32*)(lds + L_BIASL) + hb * 32;
            const float lo = biasL[blo], hi = biasL[bhi];
            if (blo == bhi) {
#pragma unroll
                for (int mp = 0; mp < NMAP; ++mp) S[mp] += lo;
            } else {
                const int x = D0 + q - 4 * h - far_start(bhi);
#pragma unroll
                for (int r = 0; r < 16; ++r) { const float bv = (x >= CROW(r)) ? hi : lo;
#pragma unroll
                    for (int mp = 0; mp < NMAP; ++mp) S[mp][r] += bv; }
            }
        }
        if (MASK && hot < 3) {
#pragma unroll
            for (int r = 0; r < 16; ++r) S[0][r] = (((mw >> (4 * h)) >> CROW(r)) & 1u) ? S[0][r] : -3e38f;
        }
#pragma unroll
        for (int mp = 0; mp < NMAP; ++mp) {
            softmax_tile_h(S[mp], m[mp], l[mp], O[mp][0], O[mp][1], hot);
            const h16x8 p0 = pack8(S[mp], 0), p1 = pack8(S[mp], 1);
            if (hot < 4) {
            O[mp][0] = mfma32(vf[0][0], p0, O[mp][0]); O[mp][0] = mfma32(vf[0][1], p1, O[mp][0]);
            O[mp][1] = mfma32(vf[1][0], p0, O[mp][1]); O[mp][1] = mfma32(vf[1][1], p1, O[mp][1]);
            } else { O[mp][0][0] += (float)p0[0] + (float)p1[0]; }
        }
#pragma unroll
        for (int db = 0; db < 2; ++db)
#pragma unroll
            for (int sk = 0; sk < 2; ++sk) vf[db][sk] = vn[db][sk];
        mw = mwn;
    }
    f32x16 R0, R1;
    if (NMAP == 2) {
        const float lam = *(const lf32*)(lds + L_LAM);
        const float i0 = 1.f / xh_sum(l[0]), i1 = lam / xh_sum(l[NMAP - 1]);
        R0 = O[0][0] * i0 - O[NMAP - 1][0] * i1; R1 = O[0][1] * i0 - O[NMAP - 1][1] * i1;
        float ss = 0.f;
#pragma unroll
        for (int r = 0; r < 16; ++r) ss += R0[r] * R0[r] + R1[r] * R1[r];
        ss = xh_sum(ss);
        const float rs = rsqrtf(ss * (1.f / 64.f) + EPS) * (1.f - lambda_init);
        R0 *= rs; R1 *= rs;
    } else {
        const float il = 1.f / xh_sum(l[0]);
        R0 = O[0][0] * il; R1 = O[0][1] * il;
    }
    const gh16* gp = gate + tokq * 1024 + mixcol + hh * 64 + 4 * h;
#pragma unroll
    for (int db = 0; db < 2; ++db)
#pragma unroll
        for (int g = 0; g < 4; ++g) {
            const h16x4 gv = *(const GAS h16x4*)(gp + db * 32 + 8 * g); h16x4 o;
#pragma unroll
            for (int e = 0; e < 4; ++e) { float v = (db ? R1[4 * g + e] : R0[4 * g + e]) * (float)gv[e];
                if (NMAP == 2) v *= subln[db * 32 + 8 * g + 4 * h + e];
                o[e] = (h16)v; }
            if (!hot) *(GAS h16x4*)(mix + mixf_off(tokq, mixcol + hh * 64 + db * 32 + 8 * g + 4 * h)) = o; else asm volatile("" :: "v"(o));
        }
}

template <int BR>
DEVI void flashQ2_item(int b, int hh, int pr, const gh16* Q, const gh16* KF, const gh16* KRF, const gh16* VF, const gu32* mask, const gf32* biasTab, const lu8* lds,
                       const gh16* gate, gh16* mix, int mixcol, int hb, int hot = 0) {
    constexpr int NQK = BR == 0 ? 6 : 4;
    const int lane = otid() & 63, q = lane & 31, h = lane >> 5, bh = b * 4 + hh;
    const int qt1 = 2 * pr + 1;
    size_t tokq[2]; h16x8 qf[2][NQK];
#pragma unroll
    for (int qi = 0; qi < 2; ++qi) { tokq[qi] = (size_t)b * SEQ + (2 * pr + qi) * 32 + q;
#pragma unroll
        for (int ks = 0; ks < NQK; ++ks) qf[qi][ks] = *(const GAS h16x8*)(Q + tokq[qi] * (BR == 0 ? 384 : 256) + hh * (BR == 0 ? 96 : 64) + ks * 16 + 8 * h); }
    f32x16 O[2][2]; float m[2], l[2];
#pragma unroll
    for (int qi = 0; qi < 2; ++qi) { O[qi][0] = (f32x16){}; O[qi][1] = (f32x16){}; m[qi] = -1e30f; l[qi] = 0.f; }
    const gh16* kp = KF + (size_t)bh * 64 * 2048 + lane * 8;
    const gh16* rp = KRF + (size_t)b * 64 * 1024 + lane * 8;
    const gh16* vp = VF + (size_t)bh * 64 * 2048 + lane * 8;
    const lf32* nearR = (const lf32*)(lds + L_NEAR) + hb * 256;
    const gf32* bt = biasTab + hb * 2048;
    h16x8 kf[NQK], vf[4];
#pragma unroll
    for (int ks = 0; ks < NQK; ++ks) kf[ks] = (BR == 0 && ks >= 4) ? *(const GAS h16x8*)(rp + (ks - 4) * 512) : *(const GAS h16x8*)(kp + ks * 512);
    unsigned mw[2] = {0xffffffffu, 0xffffffffu}, mwn[2] = {0xffffffffu, 0xffffffffu};
    if (BR == 1) { mw[0] = mask[tokq[0] * 64]; mw[1] = mask[tokq[1] * 64]; }
#pragma unroll 1
    for (int j = 0; j <= qt1; ++j) {
#pragma unroll
        for (int f = 0; f < 4; ++f) vf[f] = *(const GAS h16x8*)(vp + (size_t)(hot ? 0 : j) * 2048 + f * 512);
        f32x16 S[2];
#pragma unroll
        for (int qi = 0; qi < 2; ++qi) { S[qi] = (f32x16){};
#pragma unroll
            for (int ks = 0; ks < NQK; ++ks) S[qi] = mfma32(kf[ks], qf[qi][ks], S[qi]); }
        if (j < qt1 && hot < 5) {
#pragma unroll
            for (int ks = 0; ks < NQK; ++ks) kf[ks] = (BR == 0 && ks >= 4) ? *(const GAS h16x8*)(rp + (size_t)(hot ? 0 : j + 1) * 1024 + (ks - 4) * 512) : *(const GAS h16x8*)(kp + (size_t)(hot ? 0 : j + 1) * 2048 + ks * 512);
            if (BR == 1) { mwn[0] = mask[tokq[0] * 64 + (j + 1 < qt1 ? j + 1 : j)]; mwn[1] = mask[tokq[1] * 64 + j + 1]; }
        }
#pragma unroll
        for (int qi = 0; qi < 2; ++qi) {
            const int qt = 2 * pr + qi;
            if (j <= qt) {
                const int D0 = (qt - j) * 32;
                if (hot >= 3) {} else
                if (BR == 0) {
                    if (D0 == 0) {
#pragma unroll
                        for (int r = 0; r < 16; ++r) S[qi][r] = (CROW(r) + 4 * h > q) ? -3e38f : S[qi][r];
                    }
                } else {
                    if (D0 < 192) {
                        const lf32* tp = nearR + (223 - D0 - q + 4 * h);
#pragma unroll
                        for (int r = 0; r < 16; ++r) S[qi][r] += tp[CROW(r)];
                    } else {
                        const int blo = far_bucket(D0 - 31), bhi = far_bucket(D0 + 31);
                        const lf32* biasL = (const lf32*)(lds + L_BIASL) + hb * 32;
                        const float lo = biasL[blo], hi = biasL[bhi];
                        if (blo == bhi) S[qi] += lo;
                        else {
                            const int x = D0 + q - 4 * h - far_start(bhi);
#pragma unroll
                            for (int r = 0; r < 16; ++r) S[qi][r] += (x >= CROW(r)) ? hi : lo;
                        }
                    }
                    const unsigned mm = mw[qi] >> (4 * h);
#pragma unroll
                    for (int r = 0; r < 16; ++r) S[qi][r] = ((mm >> CROW(r)) & 1u) ? S[qi][r] : -3e38f;
                }
                softmax_tile_h(S[qi], m[qi], l[qi], O[qi][0], O[qi][1], hot);
                const h16x8 p0 = pack8(S[qi], 0), p1 = pack8(S[qi], 1);
                if (hot < 4) {
                O[qi][0] = mfma32(vf[0], p0, O[qi][0]); O[qi][0] = mfma32(vf[1], p1, O[qi][0]);
                O[qi][1] = mfma32(vf[2], p0, O[qi][1]); O[qi][1] = mfma32(vf[3], p1, O[qi][1]);
                } else { O[qi][0][0] += (float)p0[0] + (float)p1[0]; }
            }
        }
        mw[0] = mwn[0]; mw[1] = mwn[1];
    }
#pragma unroll
    for (int qi = 0; qi < 2; ++qi) {
        const float il = 1.f / xh_sum(l[qi]);
        const gh16* gp = gate + tokq[qi] * 1024 + mixcol + hh * 64 + 4 * h;
#pragma unroll
        for (int db = 0; db < 2; ++db)
#pragma unroll
            for (int g = 0; g < 4; ++g) {
                const h16x4 gv = *(const GAS h16x4*)(gp + db * 32 + 8 * g); h16x4 o;
#pragma unroll
                for (int e = 0; e < 4; ++e) o[e] = (h16)(O[qi][db][4 * g + e] * il * (float)gv[e]);
                if (!hot) *(GAS h16x4*)(mix + mixf_off(tokq[qi], mixcol + hh * 64 + db * 32 + 8 * g + 4 * h)) = o; else asm volatile("" :: "v"(o));
            }
    }
}

template <int BR>
DEVI void flashWG_item(int b, int hh, int Qb, const gh16* Q, const gh16* KF, const gh16* KRF, const gh16* VF, const gu32* mask, lu8* lds,
                       const gf32* subln, float lambda_init, const gh16* gate, gh16* mix, int mixcol, int hb) {
    constexpr int NMAP = BR == 2 ? 2 : 1, NQK = BR == 0 ? 6 : 4, NKS = NQK / NMAP, NP = NQK + 4, TB = NP * 1024, NDMA = BR == 2 ? 1 : 2, DD = 3;
    const int tid = otid(), lane = tid & 63, q = lane & 31, h = lane >> 5, wv = __builtin_amdgcn_readfirstlane(tid >> 6);
    const int qt = 8 * Qb + wv, last = 8 * Qb + 7, bh = b * 4 + hh;
    const size_t tokq = (size_t)b * SEQ + qt * 32 + q;
    h16x8 qf[NQK];
#pragma unroll
    for (int ks = 0; ks < NQK; ++ks) qf[ks] = *(const GAS h16x8*)(Q + tokq * (BR == 0 ? 384 : 256) + hh * (BR == 0 ? 96 : 64) + ks * 16 + 8 * h);
    f32x16 O[NMAP][2]; float m[NMAP], l[NMAP];
#pragma unroll
    for (int mp = 0; mp < NMAP; ++mp) { O[mp][0] = (f32x16){}; O[mp][1] = (f32x16){}; m[mp] = -1e30f; l[mp] = 0.f; }
    asm volatile("s_waitcnt vmcnt(0)" ::: "memory");
    __syncthreads();
    lu8* ring = lds + L_RING; lu8* mring = lds + L_MRING;
    auto issue = [&](int jt) {
        const int jc = jt < last ? jt : last, slot = jt & 3;
        {
            const int pc = wv;
            const gh16* src = pc < 4 ? KF + ((size_t)bh * 64 + jc) * 2048 + pc * 512
                            : (BR == 0 && pc < 6) ? KRF + ((size_t)b * 64 + jc) * 1024 + (pc - 4) * 512
                            : VF + ((size_t)bh * 64 + jc) * 2048 + (pc - NQK) * 512;
            __builtin_amdgcn_global_load_lds((const GAS unsigned*)(src + lane * 8), (LAS unsigned*)(ring + slot * TB + pc * 1024), 16, 0, 0);
        }
        if (BR == 0) {
            const int pc = 8 + (wv & 1);
            const gh16* src = VF + ((size_t)bh * 64 + jc) * 2048 + (pc - NQK) * 512;
            __builtin_amdgcn_global_load_lds((const GAS unsigned*)(src + lane * 8), (LAS unsigned*)(ring + slot * TB + pc * 1024), 16, 0, 0);
        }
        if (BR == 1) __builtin_amdgcn_global_load_lds((const GAS unsigned*)(mask + tokq * 64 + (jc <= qt ? jc : qt)), (LAS unsigned*)(mring + (slot * 8 + wv) * 256), 4, 0, 0);
    };
#pragma unroll
    for (int jt = 0; jt < DD; ++jt) issue(jt);
    const lf32* nearR = (const lf32*)(lds + L_NEAR) + hb * 256;
    const lf32* biasL = (const lf32*)(lds + L_BIASL) + hb * 32;
    f32x16 S[NMAP], Sn[NMAP];
    asm volatile("s_waitcnt vmcnt(%0)" :: "n"((DD - 1) * NDMA) : "memory");
    __builtin_amdgcn_s_barrier();
#pragma unroll
    for (int mp = 0; mp < NMAP; ++mp) { S[mp] = (f32x16){};
#pragma unroll
        for (int ks = 0; ks < NKS; ++ks) S[mp] = mfma32(*(const LAS h16x8*)(ring + lane * 16 + (mp * NKS + ks) * 1024), qf[mp * NKS + ks], S[mp]); }
#pragma unroll 1
    for (int j = 0; j <= last; ++j) {
        asm volatile("s_waitcnt vmcnt(%0)" :: "n"((DD - 2) * NDMA) : "memory");
        __builtin_amdgcn_s_barrier();
        issue(j + DD);
        if (j <= qt) {
            const lu8* sl = ring + (j & 3) * TB + lane * 16;
            if (j + 1 <= qt) {
                const lu8* sn = ring + ((j + 1) & 3) * TB + lane * 16;
#pragma unroll
                for (int mp = 0; mp < NMAP; ++mp) { Sn[mp] = (f32x16){};
#pragma unroll
                    for (int ks = 0; ks < NKS; ++ks) Sn[mp] = mfma32(*(const LAS h16x8*)(sn + (mp * NKS + ks) * 1024), qf[mp * NKS + ks], Sn[mp]); }
            }
            h16x8 vf[4];
#pragma unroll
            for (int f = 0; f < 4; ++f) vf[f] = *(const LAS h16x8*)(sl + (NQK + f) * 1024);
            const int D0 = (qt - j) * 32;
            if (BR == 0) {
                if (D0 == 0) {
#pragma unroll
                    for (int r = 0; r < 16; ++r) S[0][r] = (CROW(r) + 4 * h > q) ? -3e38f : S[0][r];
                }
            } else if (D0 < 192) {
                const lf32* tp = nearR + (223 - D0 - q + 4 * h);
#pragma unroll
                for (int r = 0; r < 16; ++r) { const float bv = tp[CROW(r)];
#pragma unroll
                    for (int mp = 0; mp < NMAP; ++mp) S[mp][r] += bv; }
            } else {
                int blo = 23, bhi = 23;
#pragma unroll
                for (int jj = 8; jj < 16; ++jj) { blo += (D0 - 31 >= kBucketStart[jj]) ? 1 : 0; bhi += (D0 + 31 >= kBucketStart[jj]) ? 1 : 0; }
                const float lo = biasL[blo], hi = biasL[bhi];
                if (blo == bhi) {
#pragma unroll
                    for (int mp = 0; mp < NMAP; ++mp) S[mp] += lo;
                } else {
                    const int x = D0 + q - 4 * h - kBucketStart[bhi - 16];
#pragma unroll
                    for (int r = 0; r < 16; ++r) { const float bv = (x >= CROW(r)) ? hi : lo;
#pragma unroll
                        for (int mp = 0; mp < NMAP; ++mp) S[mp][r] += bv; }
                }
            }
            if (BR == 1) {
                const unsigned mw = *(const LAS unsigned*)(mring + ((j & 3) * 8 + wv) * 256 + lane * 4) >> (4 * h);
#pragma unroll
                for (int r = 0; r < 16; ++r) S[0][r] = ((mw >> CROW(r)) & 1u) ? S[0][r] : -3e38f;
            }
#pragma unroll
            for (int mp = 0; mp < NMAP; ++mp) {
                softmax_tile(S[mp], m[mp], l[mp], O[mp][0], O[mp][1]);
                const h16x8 p0 = pack8(S[mp], 0), p1 = pack8(S[mp], 1);
                O[mp][0] = mfma32(vf[0], p0, O[mp][0]); O[mp][0] = mfma32(vf[1], p1, O[mp][0]);
                O[mp][1] = mfma32(vf[2], p0, O[mp][1]); O[mp][1] = mfma32(vf[3], p1, O[mp][1]);
            }
#pragma unroll
            for (int mp = 0; mp < NMAP; ++mp) S[mp] = Sn[mp];
        }
    }
    asm volatile("s_waitcnt vmcnt(0)" ::: "memory");
    f32x16 R0, R1;
    if (NMAP == 2) {
        const float lam = *(const lf32*)(lds + L_LAM);
        const float i0 = 1.f / xh_sum(l[0]), i1 = lam / xh_sum(l[NMAP - 1]);
        R0 = O[0][0] * i0 - O[NMAP - 1][0] * i1; R1 = O[0][1] * i0 - O[NMAP - 1][1] * i1;
        float ss = 0.f;
#pragma unroll
        for (int r = 0; r < 16; ++r) ss += R0[r] * R0[r] + R1[r] * R1[r];
        ss = xh_sum(ss);
        const float rs = rsqrtf(ss * (1.f / 64.f) + EPS) * (1.f - lambda_init);
        R0 *= rs; R1 *= rs;
    } else {
        const float il = 1.f / xh_sum(l[0]);
        R0 = O[0][0] * il; R1 = O[0][1] * il;
    }
    const gh16* gp = gate + tokq * 1024 + mixcol + hh * 64 + 4 * h;
#pragma unroll
    for (int db = 0; db < 2; ++db)
#pragma unroll
        for (int g = 0; g < 4; ++g) {
            const h16x4 gv = *(const GAS h16x4*)(gp + db * 32 + 8 * g); h16x4 o;
#pragma unroll
            for (int e = 0; e < 4; ++e) { float v = (db ? R1[4 * g + e] : R0[4 * g + e]) * (float)gv[e];
                if (NMAP == 2) v *= subln[db * 32 + 8 * g + 4 * h + e];
                o[e] = (h16)v; }
            *(GAS h16x4*)(mix + mixf_off(tokq, mixcol + hh * 64 + db * 32 + 8 * g + 4 * h)) = o;
        }
}

constexpr int L_RING2 = 41984, L_MRING2 = L_RING2 + 8 * 10240, L_WQ2 = L_MRING2 + 8 * 8 * 256;
template <int BR>
DEVI void flashWG2_item(int b, int hh, int Qb, const gh16* Q, const gh16* KF, const gh16* KRF, const gh16* VF, const gu32* mask, lu8* lds,
                        const gf32* subln, float lambda_init, const gh16* gate, gh16* mix, int mixcol, int hb) {
    constexpr int NMAP = BR == 2 ? 2 : 1, NQK = BR == 0 ? 6 : 4, NKS = NQK / NMAP, NP = NQK + 4, TB = NP * 1024;
    const int tid = otid(), lane = tid & 63, q = lane & 31, h = lane >> 5, wv = __builtin_amdgcn_readfirstlane(tid >> 6);
    const int qt = 8 * Qb + wv, NS = 2 * Qb + 2, bh = b * 4 + hh;
    const size_t tokq = (size_t)b * SEQ + qt * 32 + q;
    h16x8 qf[NQK];
#pragma unroll
    for (int ks = 0; ks < NQK; ++ks) qf[ks] = *(const GAS h16x8*)(Q + tokq * (BR == 0 ? 384 : 256) + hh * (BR == 0 ? 96 : 64) + ks * 16 + 8 * h);
    f32x16 O[NMAP][2]; float m[NMAP], l[NMAP];
#pragma unroll
    for (int mp = 0; mp < NMAP; ++mp) { O[mp][0] = (f32x16){}; O[mp][1] = (f32x16){}; m[mp] = -1e30f; l[mp] = 0.f; }
    lu8* ring = lds + L_RING2; lu8* mring = lds + L_MRING2;
    auto issue = [&](int st) {
#pragma unroll
        for (int u = 0; u < (4 * NP + 7) / 8; ++u) {
            const int id = wv + 8 * u;
            if (id < 4 * NP) {
                const int ti = id / NP, pc = id % NP, jt = 4 * st + ti, slot = jt & 7;
                const gh16* src = pc < 4 ? KF + ((size_t)bh * 64 + jt) * 2048 + pc * 512
                                : (BR == 0 && pc < 6) ? KRF + ((size_t)b * 64 + jt) * 1024 + (pc - 4) * 512
                                : VF + ((size_t)bh * 64 + jt) * 2048 + (pc - NQK) * 512;
                __builtin_amdgcn_global_load_lds((const GAS unsigned*)(src + lane * 8), (LAS unsigned*)(ring + slot * TB + pc * 1024), 16, 0, 0);
            }
        }
        if (BR == 1) {
#pragma unroll
            for (int ti = 0; ti < 4; ++ti) { const int jt = 4 * st + ti;
                __builtin_amdgcn_global_load_lds((const GAS unsigned*)(mask + tokq * 64 + (jt <= qt ? jt : qt)), (LAS unsigned*)(mring + ((jt & 7) * 8 + wv) * 256), 4, 0, 0); }
        }
    };
    asm volatile("s_waitcnt vmcnt(0)" ::: "memory");
    __syncthreads();
    issue(0);
    const lf32* nearR = (const lf32*)(lds + L_NEAR) + hb * 256;
    const lf32* biasL = (const lf32*)(lds + L_BIASL) + hb * 32;
#pragma unroll 1
    for (int st = 0; st < NS; ++st) {
        asm volatile("s_waitcnt vmcnt(0)" ::: "memory");
        __builtin_amdgcn_s_barrier();
        if (st + 1 < NS) issue(st + 1);
#pragma unroll 1
        for (int j = 4 * st; j < 4 * st + 4; ++j) {
            if (j > qt) break;
            const lu8* sl = ring + (j & 7) * TB + lane * 16;
            f32x16 S[NMAP];
#pragma unroll
            for (int mp = 0; mp < NMAP; ++mp) { S[mp] = (f32x16){};
#pragma unroll
                for (int ks = 0; ks < NKS; ++ks) S[mp] = mfma32(*(const LAS h16x8*)(sl + (mp * NKS + ks) * 1024), qf[mp * NKS + ks], S[mp]); }
            h16x8 vf[4];
#pragma unroll
            for (int f = 0; f < 4; ++f) vf[f] = *(const LAS h16x8*)(sl + (NQK + f) * 1024);
            const int D0 = (qt - j) * 32;
            if (BR == 0) {
                if (D0 == 0) {
#pragma unroll
                    for (int r = 0; r < 16; ++r) S[0][r] = (CROW(r) + 4 * h > q) ? -3e38f : S[0][r];
                }
            } else if (D0 < 192) {
                const lf32* tp = nearR + (223 - D0 - q + 4 * h);
#pragma unroll
                for (int r = 0; r < 16; ++r) { const float bv = tp[CROW(r)];
#pragma unroll
                    for (int mp = 0; mp < NMAP; ++mp) S[mp][r] += bv; }
            } else {
                const int blo = far_bucket(D0 - 31), bhi = far_bucket(D0 + 31);
                const float lo = biasL[blo], hi = biasL[bhi];
                if (blo == bhi) {
#pragma unroll
                    for (int mp = 0; mp < NMAP; ++mp) S[mp] += lo;
                } else {
                    const int x = D0 + q - 4 * h - far_start(bhi);
#pragma unroll
                    for (int r = 0; r < 16; ++r) { const float bv = (x >= CROW(r)) ? hi : lo;
#pragma unroll
                        for (int mp = 0; mp < NMAP; ++mp) S[mp][r] += bv; }
                }
            }
            if (BR == 1) {
                const unsigned mw = *(const LAS unsigned*)(mring + ((j & 7) * 8 + wv) * 256 + lane * 4) >> (4 * h);
#pragma unroll
                for (int r = 0; r < 16; ++r) S[0][r] = ((mw >> CROW(r)) & 1u) ? S[0][r] : -3e38f;
            }
#pragma unroll
            for (int mp = 0; mp < NMAP; ++mp) {
                softmax_tile(S[mp], m[mp], l[mp], O[mp][0], O[mp][1]);
                const h16x8 p0 = pack8(S[mp], 0), p1 = pack8(S[mp], 1);
                O[mp][0] = mfma32(vf[0], p0, O[mp][0]); O[mp][0] = mfma32(vf[1], p1, O[mp][0]);
                O[mp][1] = mfma32(vf[2], p0, O[mp][1]); O[mp][1] = mfma32(vf[3], p1, O[mp][1]);
            }
        }
    }
    asm volatile("s_waitcnt vmcnt(0)" ::: "memory");
    f32x16 R0, R1;
    if (NMAP == 2) {
        const float lam = *(const lf32*)(lds + L_LAM);
        const float i0 = 1.f / xh_sum(l[0]), i1 = lam / xh_sum(l[NMAP - 1]);
        R0 = O[0][0] * i0 - O[NMAP - 1][0] * i1; R1 = O[0][1] * i0 - O[NMAP - 1][1] * i1;
        float ss = 0.f;
#pragma unroll
        for (int r = 0; r < 16; ++r) ss += R0[r] * R0[r] + R1[r] * R1[r];
        ss = xh_sum(ss);
        const float rs = rsqrtf(ss * (1.f / 64.f) + EPS) * (1.f - lambda_init);
        R0 *= rs; R1 *= rs;
    } else {
        const float il = 1.f / xh_sum(l[0]);
        R0 = O[0][0] * il; R1 = O[0][1] * il;
    }
    const gh16* gp = gate + tokq * 1024 + mixcol + hh * 64 + 4 * h;
#pragma unroll
    for (int db = 0; db < 2; ++db)
#pragma unroll
        for (int g = 0; g < 4; ++g) {
            const h16x4 gv = *(const GAS h16x4*)(gp + db * 32 + 8 * g); h16x4 o;
#pragma unroll
            for (int e = 0; e < 4; ++e) { float v = (db ? R1[4 * g + e] : R0[4 * g + e]) * (float)gv[e];
                if (NMAP == 2) v *= subln[db * 32 + 8 * g + 4 * h + e];
                o[e] = (h16)v; }
            *(GAS h16x4*)(mix + mixf_off(tokq, mixcol + hh * 64 + db * 32 + 8 * g + 4 * h)) = o;
        }
}


DEVI void probe_item(int ntile, int mode) {
    const int lane = otid() & 63;
    h16x8 a, bq;
#pragma unroll
    for (int e = 0; e < 8; ++e) { a[e] = (h16)(lane * 0.001f + e); bq[e] = (h16)(e * 0.01f); }
    f32x16 O0 = {}, O1 = {}; float m = -1e30f, l = 0.f;
#pragma unroll 1
    for (int j = 0; j < ntile; ++j) {
        f32x16 S = {};
#pragma unroll
        for (int ks = 0; ks < 6; ++ks) S = mfma32(a, bq, S);
        if (mode >= 1) softmax_tile(S, m, l, O0, O1);
        const h16x8 p0 = pack8(S, 0), p1 = pack8(S, 1);
        O0 = mfma32(a, p0, O0); O0 = mfma32(a, p1, O0);
        O1 = mfma32(a, p0, O1); O1 = mfma32(a, p1, O1);
    }
    asm volatile("" :: "v"(O0), "v"(O1), "v"(l));
}
DEVI void flashB_tile(const h16x8 (&qf)[4], const gh16* kfr, const gh16* vfr, const lf32* tp, f32x16& O0, f32x16& O1, float& m, float& l, int hot) {
    h16x8 vf[4], kf[4];
#pragma unroll
    for (int f = 0; f < 4; ++f) { kf[f] = *(const GAS h16x8*)(kfr + f * 512); vf[f] = *(const GAS h16x8*)(vfr + f * 512); }
    f32x16 S = {};
#pragma unroll
    for (int ks = 0; ks < 4; ++ks) S = mfma32(kf[ks], qf[ks], S);
    if (hot < 3) {
#pragma unroll
    for (int r = 0; r < 16; ++r) S[r] += tp[CROW(r)];
    }
    softmax_tile_h(S, m, l, O0, O1, hot);
    const h16x8 p0 = pack8(S, 0), p1 = pack8(S, 1);
    if (hot < 4) {
    O0 = mfma32(vf[0], p0, O0); O0 = mfma32(vf[1], p1, O0);
    O1 = mfma32(vf[2], p0, O1); O1 = mfma32(vf[3], p1, O1);
    } else { O0[0] += (float)p0[0] + (float)p1[0]; }
}
DEVI void flashB_item(int b, int hh, int r, int qg, const gh16* Q, const gh16* KF, const gh16* VF, const lu8* lds, const gh16* gate, gh16* mix, int hot = 0) {
    const int lane = otid() & 63, q = lane & 31, h = lane >> 5, bh = b * 4 + hh;
    const size_t tokq = (size_t)b * SEQ + qg * 512 + 16 * q + r;
    h16x8 qf[4];
#pragma unroll
    for (int ks = 0; ks < 4; ++ks) qf[ks] = *(const GAS h16x8*)(Q + tokq * 256 + hh * 64 + ks * 16 + 8 * h);
    f32x16 O0 = {}, O1 = {}; float m = -1e30f, l = 0.f;
    {
        const lf32* R3 = (const lf32*)(lds + L_R3) + hh * 192;
        const size_t base = 2 * FSZ + ((size_t)bh * 16 + r) * 4 * 2048 + lane * 8;
        for (int tl = (qg >= 4 ? qg - 4 : 0); tl <= qg; ++tl) {
            const int c = qg * 32 + q - tl * 32;
            flashB_tile(qf, KF + base + (size_t)(hot ? 0 : tl) * 2048, VF + base + (size_t)(hot ? 0 : tl) * 2048, R3 + (159 - c + 4 * h), O0, O1, m, l, hot);
        }
    }
    {
        const lf32* R2 = (const lf32*)(lds + L_R2) + hh * 384;
        const size_t base = FSZ + ((size_t)bh * 4 + (r & 3)) * 16 * 2048 + lane * 8;
        for (int tl = (qg >= 1 ? qg * 4 - 4 : 0); tl <= qg * 4 + 3; ++tl) {
            const int c = qg * 128 + 4 * q + (r >> 2) - tl * 32;
            flashB_tile(qf, KF + base + (size_t)(hot ? 0 : tl) * 2048, VF + base + (size_t)(hot ? 0 : tl) * 2048, R2 + (255 - c + 4 * h), O0, O1, m, l, hot);
        }
    }
    {
        const lf32* R1 = (const lf32*)(lds + L_R1) + hh * 1152;
        const size_t base = (size_t)bh * 64 * 2048 + lane * 8;
        for (int tl = (qg >= 1 ? qg * 16 - 4 : 0); tl <= qg * 16 + 15; ++tl) {
            const int c = qg * 512 + 16 * q + r - tl * 32;
            flashB_tile(qf, KF + base + (size_t)(hot ? 0 : tl) * 2048, VF + base + (size_t)(hot ? 0 : tl) * 2048, R1 + (639 - c + 4 * h), O0, O1, m, l, hot);
        }
    }
    const float il = 1.f / xh_sum(l);
    const gh16* gp = gate + tokq * 1024 + 256 + hh * 64 + 4 * h;
#pragma unroll
    for (int db = 0; db < 2; ++db)
#pragma unroll
        for (int g = 0; g < 4; ++g) {
            const h16x4 gv = *(const GAS h16x4*)(gp + db * 32 + 8 * g); h16x4 o;
#pragma unroll
            for (int e = 0; e < 4; ++e) o[e] = (h16)((db ? O1[4 * g + e] : O0[4 * g + e]) * il * (float)gv[e]);
            if (!hot) *(GAS h16x4*)(mix + mixf_off(tokq, 256 + hh * 64 + db * 32 + 8 * g + 4 * h)) = o; else asm volatile("" :: "v"(o));
        }
}

typedef float f32x4v __attribute__((ext_vector_type(4)));
typedef unsigned u32x4v __attribute__((ext_vector_type(4)));
DEVI f32x4v mfma16(h16x8 a, h16x8 b, f32x4v c) { return __builtin_amdgcn_mfma_f32_16x16x32_f16(a, b, c, 0, 0, 0); }
constexpr int TK_KSTRIDE = 2308;
constexpr int TK_KEYS = 0, TK_MISC = 16 * TK_KSTRIDE * 4, TK_END = TK_MISC + 64;
DEVI void topk_item(int b, int T16, const gh16* idx, const gh16* KIF, gu32* mask, lu8* lds) {
    const int tid = otid(), lane = tid & 63, wv = __builtin_amdgcn_readfirstlane(tid >> 6);
    const int t0 = T16 * 16;
    lu32* keys = (lu32*)(lds + TK_KEYS);
    if (T16 < 16) {
        const int sq = tid & 15, sc_ = tid >> 4;
        const unsigned tk = (unsigned)(b * SEQ + t0 + sq) * 64u + 2u * sc_;
        unsigned ones = 0xffffffffu; asm volatile("" : "+v"(ones));
        if (sc_ < 4) { mask[tk] = ones; mask[tk + 1] = ones; }
        return;
    }
    __syncthreads();
    {
        const int q = lane & 15, kq = lane >> 4;
        const size_t tokq = (size_t)b * SEQ + t0 + q;
        h16x8 qf[8], ql; float sg[8]; float P = 0.f, N = 0.f; float lin[8];
#pragma unroll
        for (int e = 0; e < 8; ++e) lin[e] = 0.f;
#pragma unroll
        for (int hd = 0; hd < 8; ++hd) {
            const h16x8 raw = *(const GAS h16x8*)(idx + tokq * 320 + hd * 32 + 8 * kq);
            const float c = (float)idx[tokq * 320 + 288 + hd] * (0.5f * 0.35355339059327373f), ac = fabsf(c);
            float nn = 0.f;
#pragma unroll
            for (int e = 0; e < 8; ++e) { const float v = (float)raw[e]; nn += v * v; lin[e] += c * v; qf[hd][e] = (h16)(ac * v); }
            nn += __shfl_xor(nn, 16); nn += __shfl_xor(nn, 32);
            const float bd = 2.f * ac * sqrtf(nn) * 12.f;
            if (c > 0.f) P += bd; else N += bd;
            sg[hd] = c >= 0.f ? 1.f : -1.f;
        }
#pragma unroll
        for (int e = 0; e < 8; ++e) ql[e] = (h16)lin[e];
        const float lo = -N, scl = 2097151.f / fmaxf(P + N, 1e-20f);
        const int nblk = T16 + 1, nblk2 = (nblk + 1) & ~1;
#pragma unroll 1
        for (int rpS = 0; rpS < (DUP_PHASE == 7 ? 2 : 1); ++rpS)
        for (int kb0 = wv; kb0 < nblk2; kb0 += 32) {
            h16x8 kf4[4];
#pragma unroll
            for (int u = 0; u < 4; ++u) { const int kb = kb0 + 8 * u < nblk ? kb0 + 8 * u : 0; kf4[u] = *(const GAS h16x8*)(KIF + ((size_t)(b * 128 + kb) * 64 + lane) * 8); }
#pragma unroll
            for (int u = 0; u < 4; ++u) {
                const int kb = kb0 + 8 * u;
                if (kb < nblk2) {
                    const h16x8 kf = kf4[u];
                    f32x4v sc = mfma16(kf, ql, (f32x4v){0.f, 0.f, 0.f, 0.f});
#pragma unroll
                    for (int hd = 0; hd < 8; ++hd) { const f32x4v x = mfma16(kf, qf[hd], (f32x4v){0.f, 0.f, 0.f, 0.f});
#pragma unroll
                        for (int r = 0; r < 4; ++r) sc[r] = __builtin_fmaf(__builtin_fabsf(x[r]), sg[hd], sc[r]); }
                    u32x4v kv;
#pragma unroll
                    for (int r = 0; r < 4; ++r) { const float x = fminf(fmaxf((sc[r] - lo) * scl, 0.f), 2097151.f); unsigned uu = (unsigned)x + 1u;
                        if (16 * kb + 4 * kq + r > t0 + q) uu = 0u; kv[r] = uu; }
                    const int k = 16 * kb + 4 * kq;
                    *(LAS u32x4v*)(keys + q * TK_KSTRIDE + k + 4 * (k >> 5)) = kv;
                }
            }
        }
    }
    __syncthreads();
    const int nw32 = (t0 + 16 + 31) >> 5;
    unsigned ka[32], kc[32];
    {
        const lu32* ra = keys + (2 * wv) * TK_KSTRIDE + 36 * lane, * rc = keys + (2 * wv + 1) * TK_KSTRIDE + 36 * lane;
        const bool have = lane < nw32;
#pragma unroll
        for (int i = 0; i < 8; ++i) {
            u32x4v va = {0u, 0u, 0u, 0u}, vc = {0u, 0u, 0u, 0u};
            if (have) { va = *(const LAS u32x4v*)(ra + 4 * i); vc = *(const LAS u32x4v*)(rc + 4 * i); }
#pragma unroll
            for (int r = 0; r < 4; ++r) { ka[4 * i + r] = va[r]; kc[4 * i + r] = vc[r]; }
        }
    }
    unsigned Ta = 0u, Tc = 0u;
#pragma unroll 1
    for (int rpL = 0; rpL < (DUP_PHASE == 8 ? 2 : 1); ++rpL) { Ta = 0u; Tc = 0u;
#pragma unroll 1
    for (int bit = 21; bit >= 0; --bit) {
        const unsigned pa = Ta | (1u << bit), pc = Tc | (1u << bit);
        unsigned la = 0u, lc = 0u;
#pragma unroll
        for (int i = 0; i < 32; ++i) { la += (ka[i] >= pa) ? 1u : 0u; lc += (kc[i] >= pc) ? 1u : 0u; }
        int ca = 0, cc = 0;
#pragma unroll
        for (int bp = 0; bp < 6; ++bp) { ca += __builtin_popcountll(__ballot((la >> bp) & 1u)) << bp; cc += __builtin_popcountll(__ballot((lc >> bp) & 1u)) << bp; }
        if (ca >= 256) Ta = pa;
        if (cc >= 256) Tc = pc;
    }
    }
#pragma unroll
    for (int qq = 0; qq < 2; ++qq) {
        const unsigned T = qq ? Tc : Ta;
        unsigned gt = 0u, eq = 0u;
#pragma unroll
        for (int i = 31; i >= 0; --i) { const unsigned k = qq ? kc[i] : ka[i]; gt = (gt << 1) | (k > T ? 1u : 0u); eq = (eq << 1) | (k == T ? 1u : 0u); }
        int pcg = __builtin_popcount(gt), pce = __builtin_popcount(eq);
        int totg = pcg, pre = pce;
#pragma unroll
        for (int o = 1; o < 64; o <<= 1) { totg += __shfl_xor(totg, o); const int t = __shfl_up(pre, o); if (lane >= o) pre += t; }
        const int before = pre - pce, R = 256 - totg;
        int allow = R - before; allow = allow < 0 ? 0 : (allow > pce ? pce : allow);
        unsigned keep = eq;
        if (allow < pce) { keep = 0u; unsigned e = eq; for (int c = 0; c < allow; ++c) { const unsigned bit = e & (0u - e); keep |= bit; e ^= bit; } }
        if (lane < nw32) mask[((size_t)b * SEQ + t0 + 2 * wv + qq) * 64 + lane] = gt | keep;
    }
}
DEVI void ph_topk(const gh16* idx, const gh16* KIF, gu32* mask, gu32* ctr, lu8* lds, int nrep) {
    lu32* slot = (lu32*)(lds + TK_MISC);
#pragma unroll 1
    for (;;) {
        __syncthreads();
        if (otid() == 0) *slot = __hip_atomic_fetch_add(ctr, 1u, __ATOMIC_RELAXED, __HIP_MEMORY_SCOPE_AGENT);
        __syncthreads();
        const int e = (int)*slot;
        if (e >= 1024 * nrep) break;
        const int e2 = e & 1023;
        topk_item(e2 & 7, 127 - (e2 >> 3), idx, KIF, mask, lds);
    }
}

DEVI void ph_out(const gh16* mix, const gh16* WoT, const gf32* __restrict__ gpost, const gf32* h_in, gf32* h_out, gh16* h16o, gf32* rstd_next, bool write_next, lu8* lds) {
    const int tid = otid(), lane = tid & 63, q = lane & 31, h = lane >> 5, wv = __builtin_amdgcn_readfirstlane(tid >> 6);
    lf32* red = (lf32*)lds;
    for (int u = blockIdx.x; u < NT / 64; u += gridDim.x) {
        f32x16 acc[4][2];
#pragma unroll
        for (int rb = 0; rb < 4; ++rb) { acc[rb][0] = (f32x16){}; acc[rb][1] = (f32x16){}; }
        const gh16* apu = WoT + (size_t)(wv * 4) * 64 * 512;
        const gh16* bpu = mix + (size_t)(u * 2) * 64 * 512;
        const unsigned lo8 = lane * 8;
#define ap(off) (apu + (off) + lo8)
#define bp(off) (bpu + (off) + lo8)
        h16x8 a0[4], b0[2], a1[4], b1[2], a2[4], b2[2];
#define P3_LOAD(A, B, ks_) do { const int ko_ = ((ks_) < 64 ? (ks_) : 63) * 512; _Pragma("unroll") for (int rb = 0; rb < 4; ++rb) A[rb] = *(const GAS h16x8*)(ap(rb * 64 * 512 + ko_)); \
        _Pragma("unroll") for (int tb = 0; tb < 2; ++tb) B[tb] = *(const GAS h16x8*)(bp(tb * 64 * 512 + ko_)); } while (0)
#define P3_MMA(A, B) do { _Pragma("unroll") for (int rb = 0; rb < 4; ++rb) _Pragma("unroll") for (int tb = 0; tb < 2; ++tb) acc[rb][tb] = mfma32(A[rb], B[tb], acc[rb][tb]); } while (0)
        P3_LOAD(a0, b0, 0); P3_LOAD(a1, b1, 1);
#pragma unroll 1
        for (int ks = 0; ks < 63; ks += 3) {
            P3_LOAD(a2, b2, ks + 2); __builtin_amdgcn_sched_barrier(0); P3_MMA(a0, b0); __builtin_amdgcn_sched_barrier(0);
            P3_LOAD(a0, b0, ks + 3); __builtin_amdgcn_sched_barrier(0); P3_MMA(a1, b1); __builtin_amdgcn_sched_barrier(0);
            P3_LOAD(a1, b1, ks + 4); __builtin_amdgcn_sched_barrier(0); P3_MMA(a2, b2); __builtin_amdgcn_sched_barrier(0);
        }
        P3_MMA(a0, b0);
#undef P3_LOAD
#undef P3_MMA
#undef ap
#undef bp
        int qe = q, he = h; asm volatile("" : "+v"(qe), "+v"(he));
        __syncthreads();
#pragma unroll
        for (int tb = 0; tb < 2; ++tb) {
            float ss = 0.f;
#pragma unroll
            for (int rb = 0; rb < 4; ++rb)
#pragma unroll
                for (int r = 0; r < 16; ++r) ss += acc[rb][tb][r] * acc[rb][tb][r];
            ss = xh_sum(ss);
            if (he == 0) red[wv * 64 + tb * 32 + qe] = ss;
        }
        __syncthreads();
        float ssn[2] = {0.f, 0.f};
#pragma unroll
        for (int tb = 0; tb < 2; ++tb) {
            float tot = 0.f;
#pragma unroll
            for (int w2 = 0; w2 < 8; ++w2) tot += red[w2 * 64 + tb * 32 + qe];
            const float rs = rsqrtf(tot * (1.f / DM) + EPS);
            const size_t rowoff = (size_t)(u * 64 + tb * 32 + qe) * DM;
#pragma unroll
            for (int rb = 0; rb < 4; ++rb)
#pragma unroll
                for (int g = 0; g < 4; ++g) {
                    const int n = wv * 128 + rb * 32 + 8 * g + 4 * he;
                    const f32x4_t hv = *(const GAS f32x4_t*)(h_in + rowoff + n), gv = *(const GAS f32x4_t*)(gpost + n);
                    f32x4_t o;
                    o[0] = hv[0] + acc[rb][tb][4 * g + 0] * rs * gv[0]; o[1] = hv[1] + acc[rb][tb][4 * g + 1] * rs * gv[1];
                    o[2] = hv[2] + acc[rb][tb][4 * g + 2] * rs * gv[2]; o[3] = hv[3] + acc[rb][tb][4 * g + 3] * rs * gv[3];
                    *(GAS f32x4_t*)(h_out + rowoff + n) = o;
                    if (write_next) { h16x4 oh; oh[0] = (h16)o[0]; oh[1] = (h16)o[1]; oh[2] = (h16)o[2]; oh[3] = (h16)o[3]; *(GAS h16x4*)(h16o + rowoff + n) = oh;
                        ssn[tb] += o[0] * o[0] + o[1] * o[1] + o[2] * o[2] + o[3] * o[3]; }
                }
        }
        if (write_next) {
#pragma unroll
            for (int tb = 0; tb < 2; ++tb) { const float v = xh_sum(ssn[tb]); if (he == 0) red[512 + wv * 64 + tb * 32 + qe] = v; }
            __syncthreads();
            if (tid < 64) { float tot = 0.f;
#pragma unroll
                for (int w2 = 0; w2 < 8; ++w2) tot += red[512 + w2 * 64 + tid];
                rstd_next[u * 64 + tid] = rsqrtf(tot * (1.f / DM) + EPS); }
        }
    }
}

DEVI void mla_item(int it, const gh16* cA, const gh16* WuqT, const gh16* WukvT, const gf32* cosT, const gf32* sinT, gh16* qA, gh16* KFA, gh16* KRF, gh16* VFA) {
    const int lane = otid() & 63, q = lane & 31, h = lane >> 5;
    const size_t tok = (size_t)it * 32 + q; const int b = it >> 6, j = it & 63, s = j * 32 + q;
    const float qs = 0.10206207261596577f * LOG2E;
    {
        h16x8 cf[12]; float ss = 0.f;
#pragma unroll
        for (int ks = 0; ks < 12; ++ks) { cf[ks] = *(const GAS h16x8*)(cA + tok * 384 + ks * 16 + 8 * h);
#pragma unroll
            for (int e = 0; e < 8; ++e) { const float v = (float)cf[ks][e]; ss += v * v; } }
        const float rs = rsqrtf(xh_sum(ss) * (1.f / 192.f) + EPS) * qs;
#pragma unroll 1
        for (int nb = 0; nb < 12; ++nb) {
            f32x16 acc = {};
            const gh16* wp = WuqT + (size_t)nb * 12 * 512 + lane * 8;
#pragma unroll
            for (int ks = 0; ks < 12; ++ks) acc = mfma32(*(const GAS h16x8*)(wp + ks * 512), cf[ks], acc);
            acc *= rs;
            const int hh = nb / 3, part = nb % 3;
            if (part == 2) {
#pragma unroll
                for (int r = 0; r < 8; ++r) { const int i = CROW(r) + 4 * h; const float c = cosT[s * 16 + i], sn = sinT[s * 16 + i], x1 = acc[r], x2 = acc[r + 8];
                    acc[r] = x1 * c - x2 * sn; acc[r + 8] = x1 * sn + x2 * c; }
            }
            gh16* op = qA + tok * 384 + hh * 96 + part * 32 + 4 * h;
#pragma unroll
            for (int g = 0; g < 4; ++g) { h16x4 o; o[0] = (h16)acc[4 * g]; o[1] = (h16)acc[4 * g + 1]; o[2] = (h16)acc[4 * g + 2]; o[3] = (h16)acc[4 * g + 3]; *(GAS h16x4*)(op + 8 * g) = o; }
        }
    }
    {
        h16x8 cf[8]; float ss = 0.f;
#pragma unroll
        for (int ks = 0; ks < 8; ++ks) { cf[ks] = *(const GAS h16x8*)(cA + tok * 384 + 192 + ks * 16 + 8 * h);
#pragma unroll
            for (int e = 0; e < 8; ++e) { const float v = (float)cf[ks][e]; ss += v * v; } }
        const float rs = rsqrtf(xh_sum(ss) * (1.f / 128.f) + EPS);
#pragma unroll
        for (int ks = 0; ks < 8; ++ks)
#pragma unroll
            for (int e = 0; e < 8; ++e) cf[ks][e] = (h16)((float)cf[ks][e] * rs);
#pragma unroll 1
        for (int nb = 0; nb < 16; ++nb) {
            const int hh = nb >> 2, sub = nb & 3, bh = b * 4 + hh;
            const gh16* wp = WukvT + (size_t)nb * 8 * 512 + lane * 8;
            f32x16 acc = {};
            if (sub < 2) {
#pragma unroll
                for (int ks = 0; ks < 8; ++ks) acc = mfma32(*(const GAS h16x8*)(wp + ks * 512), cf[ks], acc);
#pragma unroll
                for (int g = 0; g < 4; ++g) { h16x4 o; o[0] = (h16)acc[4 * g]; o[1] = (h16)acc[4 * g + 1]; o[2] = (h16)acc[4 * g + 2]; o[3] = (h16)acc[4 * g + 3];
                    *(GAS h16x4*)(KFA + ((((size_t)bh * 64 + j) * 4 + 2 * sub + (g >> 1)) * 64 + q + 32 * (g & 1)) * 8 + 4 * h) = o; }
            } else {
#pragma unroll
                for (int ks = 0; ks < 8; ++ks) acc = mfma32(cf[ks], *(const GAS h16x8*)(wp + ks * 512), acc);
#pragma unroll
                for (int sk = 0; sk < 2; ++sk) { h16x8 o;
#pragma unroll
                    for (int e = 0; e < 8; ++e) o[e] = (h16)acc[8 * sk + e];
                    *(GAS h16x8*)(VFA + ((((size_t)bh * 64 + j) * 4 + (sub - 2) * 2 + sk) * 64 + lane) * 8) = o; }
            }
        }
    }
    {
        const h16x8 a = *(const GAS h16x8*)(cA + tok * 384 + 320 + 8 * h), c2 = *(const GAS h16x8*)(cA + tok * 384 + 336 + 8 * h);
        h16x8 o1, o2;
#pragma unroll
        for (int e = 0; e < 8; ++e) { const int i = 8 * h + e; const float c = cosT[s * 16 + i], sn = sinT[s * 16 + i], x1 = (float)a[e], x2 = (float)c2[e];
            o1[e] = (h16)(x1 * c - x2 * sn); o2[e] = (h16)(x1 * sn + x2 * c); }
        *(GAS h16x8*)(KRF + (((size_t)b * 64 + j) * 2 + 0) * 512 + lane * 8) = o1; *(GAS h16x8*)(KRF + (((size_t)b * 64 + j) * 2 + 1) * 512 + lane * 8) = o2;
    }
}
DEVI void ph_small_weights(const gf32* w_uq, const gf32* qn, const gf32* w_ukv, const gf32* kvn, gh16* WuqF, gh16* WukvF) {
    const int gt = blockIdx.x * NTHR + otid(), nthr = gridDim.x * NTHR;
    for (int i = gt; i < 2 * 12 * 12 * 64; i += nthr) { const int lane = i & 63, ks = (i >> 6) % 12, nb = (i / (64 * 12)) % 12, l = i / (64 * 144);
        h16x8 o;
#pragma unroll
        for (int e = 0; e < 8; ++e) { const int k = 16 * ks + 8 * (lane >> 5) + e; o[e] = (h16)(w_uq[(size_t)l * 192 * 384 + k * 384 + nb * 32 + (lane & 31)] * qn[l * 192 + k]); }
        *(GAS h16x8*)(WuqF + (size_t)i * 8) = o; }
    for (int i = gt; i < 2 * 16 * 8 * 64; i += nthr) { const int lane = i & 63, ks = (i >> 6) & 7, nb = (i >> 9) & 15, l = i >> 13;
        h16x8 o;
#pragma unroll
        for (int e = 0; e < 8; ++e) { const int k = 16 * ks + 8 * (lane >> 5) + e; o[e] = (h16)(w_ukv[(size_t)l * 128 * 512 + k * 512 + nb * 32 + (lane & 31)] * kvn[l * 128 + k]); }
        *(GAS h16x8*)(WukvF + (size_t)i * 8) = o; }
}

constexpr int LDS_BYTES = 160 * 1024;
struct Params { const float* in[12]; float* out; unsigned char* ws; };

DEVI void ph_tables(const gf32* __restrict__ rel_bias, gf32* biasTab, gf32* cosT, gf32* sinT) {
    for (int i = blockIdx.x * NTHR + threadIdx.x; i < 2048 * 16; i += gridDim.x * NTHR) {
        if (i < 12 * 2048) { int hh = i / 2048, n = i % 2048; biasTab[i] = rel_bias[t5_bucket(n) * 12 + hh] * LOG2E; }
        int pos = i / 16, j = i % 16;
        float inv = (float)pow(10000.0, -(double)(2 * j) / 32.0);
        float ang = (float)pos * inv;
        cosT[i] = (float)cos((double)ang); sinT[i] = (float)sin((double)ang);
    }
}

extern __shared__ __attribute__((aligned(16))) unsigned char smem[];
constexpr int LDS_BAR_OFF = 160 * 1024 - 16;

#define REP(k) for (int rep_ = 0; rep_ < ((DUP_PHASE == (k)) ? 2 : 1); ++rep_)
DEVI gu8* ows(unsigned char* w0) { gu8* w = (gu8*)w0; asm volatile("" : "+s"(w)); return w; }
#define WSP(T, off) ((GAS T*)(w + (off)))
#define GIN(k) ((const gf32*)p.in[k])

__global__ void __launch_bounds__(NTHR, 2) mega(Params p) {
    if (threadIdx.x == 0) *(uint4*)(smem + LDS_BAR_OFF) = make_uint4(0u, 0u, 0u, 0u);
    __syncthreads();
    XcdBarrier bar = xcd_barrier_post((unsigned*)(p.ws + OFF_CTL), (volatile LAS unsigned*)(smem + LDS_BAR_OFF));
    lu8* lds = (lu8*)smem;
    const int nw = gridDim.x * NWAVE;

    REP(1) {
        gu8* w = ows(p.ws);
        ph_tables(GIN(11), WSP(float, OFF_BIAS), WSP(float, OFF_COS), WSP(float, OFF_SIN));
        int base = 0; const int total = 2 * (64 * 16) + 2 * (16 * 16);
        cvt_transpose<true>(GIN(1), INC, GIN(3), WSP(h16, OFF_WINT), MYC, DM, lds, blockIdx.x, total, base);
        cvt_transpose<true>(GIN(1) + (size_t)DM * INC, INC, GIN(3) + DM, WSP(h16, OFF_WINT) + (size_t)MYC * DM, MYC, DM, lds, blockIdx.x, total, base);
        cvt_transpose<false>(GIN(2), DM, nullptr, WSP(h16, OFF_WOUTT), DM, DM, lds, blockIdx.x, total, base);
        cvt_transpose<false>(GIN(2) + (size_t)DM * DM, DM, nullptr, WSP(h16, OFF_WOUTT) + (size_t)DM * DM, DM, DM, lds, blockIdx.x, total, base);
        ph_small_weights(GIN(7), GIN(5), GIN(8), GIN(6), WSP(h16, OFF_WUQT), WSP(h16, OFF_WUKVT));
        ph_rowstat_cvt(GIN(0), WSP(float, OFF_SSQH), WSP(h16, OFF_H16));
    }
    xcd_barrier(bar);
    for (int layer = 0; layer < 2; ++layer) {
        const float lambda_init = layer == 0 ? 0.2f : 0.35550906759f;
        REP(2) {
            if (rep_) xcd_barrier(bar);
            gu8* w = ows(p.ws);
            pg8::Gemm g{(const pg8::bf16_t*)(p.ws + OFF_H16), (const pg8::bf16_t*)(p.ws + OFF_WINT) + (size_t)layer * MYC * DM, NT, MYC, DM};
            int bid_ = (int)blockIdx.x; asm volatile("" : "+s"(bid_));
            pg8::StaticOrder S; S.init(NT, MYC, (int)gridDim.x, bid_);
            EpiRoute E{w, WSP(float, OFF_SSQH)};
            pg8::gemm_phase<EpiRoute, pg8::StaticOrder, true, true>(lds, g, S, E);
        }
        xcd_barrier(bar);
        REP(3) {
            gu8* w = ows(p.ws);
            for (int it = ogw(); it < NT / 32; it += nw) mla_item(it, WSP(h16, OFF_CA), WSP(h16, OFF_WUQT) + (size_t)layer * 384 * 192, WSP(h16, OFF_WUKVT) + (size_t)layer * 512 * 128, WSP(float, OFF_COS), WSP(float, OFF_SIN), WSP(h16, OFF_QA), WSP(h16, OFF_KFA), WSP(h16, OFF_KRF), WSP(h16, OFF_VFA));
        }
        {
            gu8* w = ows(p.ws);
            ph_topk(WSP(h16, OFF_IDX), WSP(h16, OFF_KIF), WSP(unsigned, OFF_MASK), WSP(unsigned, OFF_CTL) + 3600 + 16 * (40 + layer), lds, DUP_PHASE == 4 ? 2 : 1);
        }
        REP(3) {
            gu8* w = ows(p.ws);
            ph_vtrans(WSP(h16, OFF_VTMP), WSP(h16, OFF_VF), lds);
        }
        xcd_barrier(bar);
        for (int rep_ = 0; rep_ < ((DUP_PHASE == 5 || DUP_PHASE >= 10) ? 2 : 1); ++rep_) {
            if (rep_) xcd_barrier(bar);
            const int hot_ = (DUP_PHASE >= 10 && rep_) ? DUP_PHASE - 9 : 0;
            gu8* w = ows(p.ws);
            p2_setup(WSP(float, OFF_BIAS), GIN(9) + layer * 128, lambda_init, lds);
            if (DUP_PHASE >= 20 && rep_) { probe_item(130, DUP_PHASE - 20); continue; }
            const int xcc = (int)(xb_xcc_id() & 7u);
            for (int dq = 0; dq < 8; ++dq) {
                const int bq = (xcc + dq) & 7;
                gu32* ctr = WSP(unsigned, OFF_CTL) + 3600 + 16 * (bq + 8 * layer + 16 * rep_);
                for (;;) { const int e = wq_next(ctr); if (e >= 768) break;
                    if (e < 256) { const int hh = e >> 6, lvl = 63 - (e & 63);
                        flashCD_item<2, false>(bq, hh, lvl, 8 + hh, WSP(h16, OFF_QD), WSP(h16, OFF_KFD), WSP(h16, OFF_VF) + 4 * FSZ, nullptr, WSP(float, OFF_BIAS), lds,
                                               GIN(10) + layer * 64, lambda_init, WSP(h16, OFF_GATE), WSP(h16, OFF_MIX), 768, hot_); }
                    else if (e < 384) { const int e2 = e - 256, hh = e2 >> 5, pr = 31 - (e2 & 31);
                        flashQ2_item<1>(bq, hh, pr, WSP(h16, OFF_QC), WSP(h16, OFF_KFC), nullptr, WSP(h16, OFF_VF) + 3 * FSZ, WSP(unsigned, OFF_MASK), WSP(float, OFF_BIAS), lds, WSP(h16, OFF_GATE), WSP(h16, OFF_MIX), 512, 4 + hh, hot_); }
                    else if (e < 512) { const int e2 = e - 384, hh = e2 >> 5, pr = 31 - (e2 & 31);
                        flashQ2_item<0>(bq, hh, pr, WSP(h16, OFF_QA), WSP(h16, OFF_KFA), WSP(h16, OFF_KRF), WSP(h16, OFF_VFA), nullptr, WSP(float, OFF_BIAS), lds, WSP(h16, OFF_GATE), WSP(h16, OFF_MIX), 0, 0, hot_); }
                    else { const int e2 = e - 512, hh = e2 >> 6, lvl = e2 & 63;
                        flashB_item(bq, hh, lvl & 15, lvl >> 4, WSP(h16, OFF_QB), WSP(h16, OFF_KFB), WSP(h16, OFF_VF), lds, WSP(h16, OFF_GATE), WSP(h16, OFF_MIX), hot_); }
                }
            }
        }
        xcd_barrier(bar);
        for (int rep_ = 0; rep_ < ((DUP_PHASE == 6 && layer == 0) ? 2 : 1); ++rep_) {
            if (rep_) xcd_barrier(bar);
            gu8* w = ows(p.ws);
int bid_ = (int)blockIdx.x; asm volatile("" : "+s"(bid_));
            pg8::Gemm g{(const pg8::bf16_t*)(p.ws + OFF_MIX), (const pg8::bf16_t*)(p.ws + OFF_WOUTT) + (size_t)layer * DM * DM, NT, DM, DM};
            pg8::StaticOrder S; S.init(NT, DM, (int)gridDim.x, bid_);
            EpiOut E{layer == 0 ? GIN(0) : (const gf32*)p.out, (gf32*)p.out, WSP(h16, OFF_H16), GIN(4) + layer * DM, WSP(float, OFF_SSQY), WSP(float, OFF_SSQH), &bar, layer == 0};
            pg8::gemm_phase<EpiOut, pg8::StaticOrder, false, true>(lds, g, S, E);
        }
        xcd_barrier(bar);
    }
}

extern "C" void kernel_launch(void* const* d_in, const int* in_sizes, int n_in, void* d_out, int out_size, void* d_ws, size_t ws_size, hipStream_t stream) {
    static int grid = 0;
    if (grid == 0) {
        int dev = 0, cus = 0, per_cu = 0;
        (void)hipGetDevice(&dev);
        (void)hipDeviceGetAttribute(&cus, hipDeviceAttributeMultiprocessorCount, dev);
        (void)hipFuncSetAttribute((const void*)mega, hipFuncAttributeMaxDynamicSharedMemorySize, LDS_BYTES);
        (void)hipOccupancyMaxActiveBlocksPerMultiprocessor(&per_cu, (const void*)mega, NTHR, LDS_BYTES);
        (void)hipGetLastError();
        grid = cus > 0 ? cus : 256;
    }
    (void)hipMemsetAsync((char*)d_ws + OFF_CTL, 0, 32768, stream);
    Params p{};
    for (int i = 0; i < 12; ++i) p.in[i] = (const float*)d_in[i];
    p.out = (float*)d_out; p.ws = (unsigned char*)d_ws;
    hipLaunchKernelGGL(mega, dim3(grid), dim3(NTHR), LDS_BYTES, stream, p);
}
```

```cpp
#include <hip/hip_runtime.h>
#include <stdint.h>
#include <math.h>

#ifndef DUP_PHASE
#define DUP_PHASE 0
#endif
typedef _Float16 h16;
#define GAS __attribute__((address_space(1)))
#define LAS __attribute__((address_space(3)))
typedef GAS h16 gh16; typedef GAS float gf32; typedef GAS unsigned gu32; typedef GAS unsigned char gu8;
typedef LAS h16 lh16; typedef LAS float lf32; typedef LAS unsigned lu32; typedef LAS unsigned char lu8;
#define DEVI __device__ __forceinline__
DEVI int ogw();
DEVI int otid() { int t = threadIdx.x; asm volatile("" : "+v"(t)); return t; }

constexpr int NB = 8, SEQ = 2048, DM = 1024, NT = NB * SEQ, INC = 3976, MYC = 4096;
constexpr float LOG2E = 1.4426950408889634f;
constexpr float EPS = 1e-6f;

DEVI int ogw() { return blockIdx.x * 8 + (otid() >> 6); }
__host__ __device__ constexpr int ref_col(int my) {
    if (my < 352) return my;
    if (my < 384) return -1;
    if (my < 640) return 352 + (my - 384);
    if (my < 896) return 1376 + (my - 640);
    if (my < 1152) return 2696 + (my - 896);
    if (my < 1408) return 3720 + (my - 1152);
    if (my < 1664) return 608 + (my - 1408);
    if (my < 1920) return 864 + (my - 1664);
    if (my < 2176) return 1632 + (my - 1920);
    if (my < 2432) return 1888 + (my - 2176);
    if (my < 2688) return 2952 + (my - 2432);
    if (my < 2944) return 3208 + (my - 2688);
    if (my < 3200) return 1120 + (my - 2944);
    if (my < 3456) return 2144 + (my - 3200);
    if (my < 3712) return 3464 + (my - 3456);
    if (my < 3968) return 2400 + (my - 3712);
    if (my < 4000) return 2656 + (my - 3968);
    if (my < 4008) return 2688 + (my - 4000);
    return -1;
}

constexpr size_t MiB = 1024 * 1024;
constexpr size_t OFF_CTL = 0;
constexpr size_t OFF_RSTD = 64 * 1024;
constexpr size_t OFF_BIAS = 128 * 1024;
constexpr size_t OFF_COS = 256 * 1024;
constexpr size_t OFF_SIN = 384 * 1024;
constexpr size_t OFF_SSQY = 512 * 1024;
constexpr size_t OFF_SSQH = 768 * 1024;
constexpr size_t OFF_CA = 1 * MiB;
constexpr size_t OFF_GATE = OFF_CA + 12 * MiB;
constexpr size_t OFF_QB = OFF_GATE + 32 * MiB;
constexpr size_t OFF_QC = OFF_QB + 8 * MiB;
constexpr size_t OFF_QD = OFF_QC + 8 * MiB;
constexpr size_t OFF_KFB = OFF_QD + 8 * MiB;
constexpr size_t OFF_KFC = OFF_KFB + 24 * MiB;
constexpr size_t OFF_KFD = OFF_KFC + 8 * MiB;
constexpr size_t OFF_IDX = OFF_KFD + 8 * MiB;
constexpr size_t OFF_KIF = OFF_IDX + 10 * MiB;
constexpr size_t OFF_MIX = OFF_KIF + 1 * MiB;
constexpr size_t OFF_VTMP = OFF_MIX;
constexpr size_t OFF_MASK = OFF_MIX + 32 * MiB;
constexpr size_t OFF_H16 = OFF_MASK + 4 * MiB;
constexpr size_t OFF_QA = OFF_H16;
constexpr size_t OFF_KFA = OFF_QA + 12 * MiB;
constexpr size_t OFF_KRF = OFF_KFA + 8 * MiB;
constexpr size_t OFF_VFA = OFF_KRF + 1 * MiB;
constexpr size_t OFF_WINT = OFF_H16 + 32 * MiB;
constexpr size_t OFF_WOUTT = OFF_WINT + 16 * MiB;
constexpr size_t OFF_WUQT = OFF_WOUTT + 4 * MiB;
constexpr size_t OFF_WUKVT = OFF_WUQT + 512 * 1024;
constexpr size_t OFF_VF = OFF_WUKVT + 512 * 1024;
constexpr size_t OFF_END = OFF_VF + 40 * MiB;
static_assert(OFF_END <= 256 * MiB, "ws map");

struct Route { int kind; size_t off; int dcol; int pitch; float scale; int silu; };
__host__ __device__ inline Route route(int my) {
    Route r{-1, 0, 0, 0, 1.f, 0};
    if (my < 384) { r.kind = 0; r.off = OFF_CA; r.dcol = my; r.pitch = 384; }
    else if (my < 1408) { r.kind = 0; r.off = OFF_GATE; r.dcol = my - 384; r.pitch = 1024; r.silu = 1; }
    else if (my < 1664) { r.kind = 0; r.off = OFF_QB; r.dcol = my - 1408; r.pitch = 256; r.scale = 0.125f * LOG2E; }
    else if (my < 1920) { r.kind = 2; r.off = OFF_KFB; r.dcol = my - 1664; }
    else if (my < 2176) { r.kind = 0; r.off = OFF_QC; r.dcol = my - 1920; r.pitch = 256; r.scale = 0.125f * LOG2E; }
    else if (my < 2432) { r.kind = 1; r.off = OFF_KFC; r.dcol = my - 2176; }
    else if (my < 2688) { r.kind = 0; r.off = OFF_QD; r.dcol = my - 2432; r.pitch = 256; r.scale = 0.17677669529663687f * LOG2E; }
    else if (my < 2944) { r.kind = 1; r.off = OFF_KFD; r.dcol = my - 2688; }
    else if (my < 3712) { r.kind = 0; r.off = OFF_VTMP; r.dcol = my - 2944; r.pitch = 768; }
    else if (my < 3968) { r.kind = 0; r.off = OFF_IDX; r.dcol = my - 3712; r.pitch = 320; r.scale = 0.17677669529663687f; }
    else if (my < 4000) { r.kind = 3; r.off = OFF_KIF; r.dcol = my - 3968; }
    else if (my < 4032) { r.kind = 0; r.off = OFF_IDX; r.dcol = my - 3712; r.pitch = 320; }
    return r;
}
DEVI size_t kf_off(int bh, int s, int d0) { return ((((size_t)bh * 64 + (s >> 5)) * 4 + (d0 >> 4)) * 64 + (s & 31) + 32 * ((d0 >> 3) & 1)) * 8; }
DEVI size_t kf4_off(int bh, int s, int d0) { const int pp = s >> 2, r4 = s & 3; return (((((size_t)bh * 4 + r4) * 16 + (pp >> 5)) * 4 + (d0 >> 4)) * 64 + (pp & 31) + 32 * ((d0 >> 3) & 1)) * 8; }
DEVI size_t kf16_off(int bh, int s, int d0) { const int pp = s >> 4, r = s & 15; return (((((size_t)bh * 16 + r) * 4 + (pp >> 5)) * 4 + (d0 >> 4)) * 64 + (pp & 31) + 32 * ((d0 >> 3) & 1)) * 8; }
DEVI size_t mixf_off(size_t tok, int c0) { return tok * 1024 + (size_t)c0; }
constexpr size_t FSZ = (size_t)32 * 64 * 4 * 64 * 8;

__device__ __constant__ unsigned short kP2Order[1024] = {63, 127, 191, 255, 62, 126, 190, 254, 61, 125, 189, 253, 60, 124, 188, 252, 59, 123, 187, 251, 58, 122, 186, 250, 57, 121, 185, 249, 56, 120, 184, 248, 55, 119, 183, 247, 54, 118, 182, 246, 53, 117, 181, 245, 52, 116, 180, 244, 51, 115, 179, 243, 50, 114, 178, 242, 49, 113, 177, 241, 48, 112, 176, 240, 47, 111, 175, 239, 46, 110, 174, 238, 45, 109, 173, 237, 44, 108, 172, 236, 43, 107, 171, 235, 42, 106, 170, 234, 41, 105, 169, 233, 40, 104, 168, 232, 39, 103, 167, 231, 319, 383, 447, 511, 318, 382, 446, 510, 38, 102, 166, 230, 317, 381, 445, 509, 316, 380, 444, 508, 37, 101, 165, 229, 315, 379, 443, 507, 36, 100, 164, 228, 314, 378, 442, 506, 313, 377, 441, 505, 35, 99, 163, 227, 312, 376, 440, 504, 34, 98, 162, 226, 311, 375, 439, 503, 310, 374, 438, 502, 33, 97, 161, 225, 309, 373, 437, 501, 308, 372, 436, 500, 32, 96, 160, 224, 307, 371, 435, 499, 31, 95, 159, 223, 306, 370, 434, 498, 305, 369, 433, 497, 30, 94, 158, 222, 304, 368, 432, 496, 29, 93, 157, 221, 303, 367, 431, 495, 302, 366, 430, 494, 28, 92, 156, 220, 301, 365, 429, 493, 300, 364, 428, 492, 27, 91, 155, 219, 299, 363, 427, 491, 26, 90, 154, 218, 298, 362, 426, 490, 575, 639, 703, 767, 297, 361, 425, 489, 574, 638, 702, 766, 25, 89, 153, 217, 573, 637, 701, 765, 296, 360, 424, 488, 572, 636, 700, 764, 24, 88, 152, 216, 295, 359, 423, 487, 571, 635, 699, 763, 570, 634, 698, 762, 294, 358, 422, 486, 569, 633, 697, 761, 23, 87, 151, 215, 293, 357, 421, 485, 568, 632, 696, 760, 567, 631, 695, 759, 292, 356, 420, 484, 22, 86, 150, 214, 566, 630, 694, 758, 291, 355, 419, 483, 565, 629, 693, 757, 564, 628, 692, 756, 21, 85, 149, 213, 290, 354, 418, 482, 563, 627, 691, 755, 289, 353, 417, 481, 562, 626, 690, 754, 20, 84, 148, 212, 561, 625, 689, 753, 288, 352, 416, 480, 560, 624, 688, 752, 19, 83, 147, 211, 287, 351, 415, 479, 559, 623, 687, 751, 558, 622, 686, 750, 286, 350, 414, 478, 557, 621, 685, 749, 18, 82, 146, 210, 285, 349, 413, 477, 556, 620, 684, 748, 555, 619, 683, 747, 284, 348, 412, 476, 17, 81, 145, 209, 554, 618, 682, 746, 283, 347, 411, 475, 553, 617, 681, 745, 552, 616, 680, 744, 16, 80, 144, 208, 282, 346, 410, 474, 551, 615, 679, 743, 281, 345, 409, 473, 550, 614, 678, 742, 15, 79, 143, 207, 549, 613, 677, 741, 280, 344, 408, 472, 548, 612, 676, 740, 14, 78, 142, 206, 279, 343, 407, 471, 547, 611, 675, 739, 546, 610, 674, 738, 278, 342, 406, 470, 545, 609, 673, 737, 13, 77, 141, 205, 277, 341, 405, 469, 544, 608, 672, 736, 543, 607, 671, 735, 276, 340, 404, 468, 12, 76, 140, 204, 542, 606, 670, 734, 275, 339, 403, 467, 541, 605, 669, 733, 768, 769, 770, 771, 772, 773, 774, 775, 776, 777, 778, 779, 780, 781, 782, 783, 784, 785, 786, 787, 788, 789, 790, 791, 792, 793, 794, 795, 796, 797, 798, 799, 800, 801, 802, 803, 804, 805, 806, 807, 808, 809, 810, 811, 812, 813, 814, 815, 816, 817, 818, 819, 820, 821, 822, 823, 824, 825, 826, 827, 828, 829, 830, 831, 832, 833, 834, 835, 836, 837, 838, 839, 840, 841, 842, 843, 844, 845, 846, 847, 848, 849, 850, 851, 852, 853, 854, 855, 856, 857, 858, 859, 860, 861, 862, 863, 864, 865, 866, 867, 868, 869, 870, 871, 872, 873, 874, 875, 876, 877, 878, 879, 880, 881, 882, 883, 884, 885, 886, 887, 888, 889, 890, 891, 892, 893, 894, 895, 896, 897, 898, 899, 900, 901, 902, 903, 904, 905, 906, 907, 908, 909, 910, 911, 912, 913, 914, 915, 916, 917, 918, 919, 920, 921, 922, 923, 924, 925, 926, 927, 928, 929, 930, 931, 932, 933, 934, 935, 936, 937, 938, 939, 940, 941, 942, 943, 944, 945, 946, 947, 948, 949, 950, 951, 952, 953, 954, 955, 956, 957, 958, 959, 960, 961, 962, 963, 964, 965, 966, 967, 968, 969, 970, 971, 972, 973, 974, 975, 976, 977, 978, 979, 980, 981, 982, 983, 984, 985, 986, 987, 988, 989, 990, 991, 992, 993, 994, 995, 996, 997, 998, 999, 1000, 1001, 1002, 1003, 1004, 1005, 1006, 1007, 1008, 1009, 1010, 1011, 1012, 1013, 1014, 1015, 1016, 1017, 1018, 1019, 1020, 1021, 1022, 1023, 540, 604, 668, 732, 11, 75, 139, 203, 274, 338, 402, 466, 539, 603, 667, 731, 273, 337, 401, 465, 538, 602, 666, 730, 10, 74, 138, 202, 537, 601, 665, 729, 272, 336, 400, 464, 536, 600, 664, 728, 9, 73, 137, 201, 271, 335, 399, 463, 535, 599, 663, 727, 534, 598, 662, 726, 270, 334, 398, 462, 533, 597, 661, 725, 8, 72, 136, 200, 269, 333, 397, 461, 532, 596, 660, 724, 531, 595, 659, 723, 268, 332, 396, 460, 7, 71, 135, 199, 530, 594, 658, 722, 267, 331, 395, 459, 529, 593, 657, 721, 528, 592, 656, 720, 6, 70, 134, 198, 266, 330, 394, 458, 527, 591, 655, 719, 265, 329, 393, 457, 526, 590, 654, 718, 5, 69, 133, 197, 525, 589, 653, 717, 264, 328, 392, 456, 524, 588, 652, 716, 4, 68, 132, 196, 263, 327, 391, 455, 523, 587, 651, 715, 522, 586, 650, 714, 262, 326, 390, 454, 521, 585, 649, 713, 3, 67, 131, 195, 261, 325, 389, 453, 520, 584, 648, 712, 519, 583, 647, 711, 260, 324, 388, 452, 2, 66, 130, 194, 518, 582, 646, 710, 259, 323, 387, 451, 517, 581, 645, 709, 516, 580, 644, 708, 1, 65, 129, 193, 258, 322, 386, 450, 515, 579, 643, 707, 257, 321, 385, 449, 514, 578, 642, 706, 0, 64, 128, 192, 513, 577, 641, 705, 256, 320, 384, 448, 512, 576, 640, 704};
__device__ __constant__ unsigned char kWgOrder[96] = {7, 15, 23, 31, 6, 14, 22, 30, 39, 47, 55, 63, 5, 13, 21, 29, 38, 46, 54, 62, 4, 12, 20, 28, 71, 79, 87, 95, 37, 45, 53, 61, 70, 78, 86, 94, 3, 11, 19, 27, 36, 44, 52, 60, 69, 77, 85, 93, 35, 43, 51, 59, 68, 76, 84, 92, 2, 10, 18, 26, 67, 75, 83, 91, 34, 42, 50, 58, 1, 9, 17, 25, 66, 74, 82, 90, 33, 41, 49, 57, 65, 73, 81, 89, 0, 8, 16, 24, 32, 40, 48, 56, 64, 72, 80, 88};
__device__ __constant__ int kBucketStart[16] = {16, 22, 30, 40, 54, 73, 99, 134, 182, 246, 332, 450, 609, 825, 1117, 1513};
DEVI int t5_bucket(int n) {
    if (n < 16) return n;
    int b = 16;
#pragma unroll
    for (int j = 1; j < 16; ++j) b += (n >= kBucketStart[j]) ? 1 : 0;
    return b;
}


#define XB_TMO      128
#define XB_XCNT(j)  (256  + 64 * (j))
#define XB_XSUB(j)  (1280 + 64 * (j))
#define XB_XGEN(j)  (2304 + 64 * (j))
#define XB_TOP      3328
#define XB_TOPGEN   3392
#define XCD_BAR_WORDS 3456
#define XB_SPIN_CAP (1u << 18)
__device__ __forceinline__ unsigned xb_ld(unsigned* p)              { return __hip_atomic_load(p, __ATOMIC_RELAXED, __HIP_MEMORY_SCOPE_AGENT); }
__device__ __forceinline__ unsigned xb_add(unsigned* p, unsigned v) { return __hip_atomic_fetch_add(p, v, __ATOMIC_RELAXED, __HIP_MEMORY_SCOPE_AGENT); }
__device__ __forceinline__ unsigned xb_xcc_id() { return (unsigned)__builtin_amdgcn_s_getreg((3 << 11) | 20) & 0xFu; }
#define XB_SPIN(cond, bar) do { unsigned _sp = 0; while (cond) { __builtin_amdgcn_s_sleep(1); \
    if ((++_sp & 255u) == 0u) { if (xb_ld(&(bar)[XB_TMO])) break; if (_sp > XB_SPIN_CAP) { atomicAdd(&(bar)[XB_TMO], 1u); break; } } } } while (0)
struct XcdBarrier { unsigned* bar; unsigned x; volatile LAS unsigned* st; };
__device__ __forceinline__ XcdBarrier xcd_barrier_post(unsigned* bar, volatile LAS unsigned* st) {
    XcdBarrier b; b.bar = bar; b.x = xb_xcc_id(); b.st = st;
    if (threadIdx.x == 0) (void)xb_add(&bar[XB_XCNT(b.x)], 1u);
    return b;
}
__device__ __forceinline__ void xcd_barrier_complete(unsigned* bar, unsigned x, unsigned& nloc, unsigned& nx) {
    const unsigned G = gridDim.x * gridDim.y * gridDim.z;
    unsigned sum, cnt, mine, sp = 0u;
    for (;;) {
        sum = 0u; cnt = 0u; mine = 0u;
#pragma unroll
        for (unsigned j = 0; j < 16; ++j) { const unsigned c = xb_ld(&bar[XB_XCNT(j)]); sum += c; cnt += (c > 0u) ? 1u : 0u; mine = (j == x) ? c : mine; }
        if (sum == G) break;
        __builtin_amdgcn_s_sleep(1);
        if ((++sp & 255u) == 0u) { if (xb_ld(&bar[XB_TMO])) break; if (sp > XB_SPIN_CAP) { atomicAdd(&bar[XB_TMO], 1u); break; } }
    }
    nloc = mine > 0u ? mine : 1u; nx = cnt > 0u ? cnt : 1u;
}
__device__ __forceinline__ void xcd_barrier(const XcdBarrier& b) {
    asm volatile("s_waitcnt vmcnt(0)" ::: "memory");
    __syncthreads();
    if (otid() == 0) {
        unsigned* bar = b.bar; unsigned bx = b.x; asm volatile("" : "+s"(bx));
        __builtin_amdgcn_s_waitcnt(0);
        unsigned nloc = b.st[0], nx = b.st[1];
        if (nloc == 0u) { xcd_barrier_complete(bar, bx, nloc, nx); b.st[0] = nloc; b.st[1] = nx; }
        const unsigned old = xb_add(&bar[XB_XSUB(bx)], 1u);
        const unsigned gen = old / nloc;
        if (old + 1u == (gen + 1u) * nloc) {
            __builtin_amdgcn_fence(__ATOMIC_RELEASE, "agent");
            asm volatile("s_waitcnt vmcnt(0)" ::: "memory");
            const unsigned og = xb_add(&bar[XB_TOP], 1u);
            const unsigned tg = og / nx;
            if (og + 1u == (tg + 1u) * nx) xb_add(&bar[XB_TOPGEN], 1u);
            else XB_SPIN(xb_ld(&bar[XB_TOPGEN]) == tg, bar);
            __builtin_amdgcn_fence(__ATOMIC_ACQUIRE, "agent");
            xb_add(&bar[XB_XGEN(bx)], 1u);
            asm volatile("s_waitcnt vmcnt(0)" ::: "memory");
        } else {
            XB_SPIN(xb_ld(&bar[XB_XGEN(bx)]) == gen, bar);
            __builtin_amdgcn_fence(__ATOMIC_ACQUIRE, "agent");
            asm volatile("s_waitcnt vmcnt(0)" ::: "memory");
        }
    }
    __syncthreads();
}

namespace pg8 {
#define PG8_LAS __attribute__((address_space(3)))
typedef unsigned short bf16_t;
typedef _Float16 f16x8 __attribute__((ext_vector_type(8)));
typedef float f32x4 __attribute__((ext_vector_type(4)));
typedef unsigned u32x4 __attribute__((ext_vector_type(4)));
constexpr int BM = 256, BK = 64, HALF = 128, HTB = HALF * BK * 2  , STAGE_BYTES = 8 * HTB, NXCD = 8, WGM = 8;

__host__ __device__ __forceinline__ int lds_byte(int r, int c) { const int st = (r >> 4) * 2 + (c >> 5), rr = r & 15, cc = c & 31, ob = rr * 64 + cc * 2; return st * 1024 + (ob ^ (((ob >> 9) & 1) << 5)); }
__host__ __device__ __forceinline__ void stage_rc(int b, int& R, int& C) { const int st = b / 1024, sb = b % 1024, swz = sb ^ (((sb >> 9) & 1) << 5); R = (st >> 1) * 16 + swz / 64; C = (st & 1) * 32 + (swz % 64) / 2; }
__host__ __device__ __forceinline__ int perm32(int rho) { const int n = rho >> 4, i = rho & 15; return 8 * (i >> 2) + 4 * n + (i & 3); }

struct Unit { int pm, pn; };
struct Gemm { const bf16_t* A; const bf16_t* Bt; int M, N, K; };

struct StaticOrder {
    int nM, nN, nwg, G, c;
    __host__ __device__ void init(int M, int N, int G_, int c_) { nM = M / BM; nN = N / BM; nwg = nM * nN; G = G_; c = c_; }
    __host__ __device__ bool next(int i, Unit& u) const {
        const long L = (long)i * G + c; if (L >= nwg) return false;
        int wgid = (int)L; { const int q = nwg / NXCD, r = nwg % NXCD, xcd = wgid % NXCD, off = wgid / NXCD; wgid = (xcd < r ? xcd * (q + 1) : r * (q + 1) + (xcd - r) * q) + off; }
        const int nig = WGM * nN, gid = wgid / nig, fm = gid * WGM, gsz = (nM - fm) < WGM ? (nM - fm) : WGM;
        u.pm = fm + ((wgid % nig) % gsz); u.pn = (wgid % nig) / gsz; return true;
    }
    __device__ __forceinline__ void a_ready(const Unit&) const {}
    __device__ __forceinline__ void done(const Unit&) const {}
};

template <class Epi, class Sched, bool ALIGN_EPI = false, bool SP2 = false>
__device__ __forceinline__ void gemm_phase(PG8_LAS unsigned char* lds, const Gemm g, const Sched& S, const Epi& E) {
    const int tid = otid(), wid = __builtin_amdgcn_readfirstlane(tid >> 6), lane = tid & 63, wr = wid >> 2, wc = wid & 3, fr = lane & 15, fq = lane >> 4;
    const int K = g.K, nt = K / BK;
    unsigned voffA[2], voffB[2];
#pragma unroll
    for (int i = 0; i < 2; ++i) { int R, C; stage_rc(tid * 16 + i * 8192, R, C); const int Rb = Epi::PERM ? ((R & ~31) + perm32(R & 31)) : R;
        voffA[i] = (unsigned)(R * K + C) * 2u; voffB[i] = (unsigned)(Rb * K + C) * 2u; }
    const size_t kstep = (size_t)(BK * 2);
    const size_t hstep = (size_t)HALF * K * 2;
    const size_t tstep = 2 * hstep;
    const unsigned ldsw = (unsigned)wid * 1024u;
    const int aoff = lds_byte(wr * 64 + fr, fq * 8), boff = lds_byte(wc * 32 + fr, fq * 8);
#define PG8_SA(b, h) (((b) * 2 + (h)) * HTB)
#define PG8_SB(b, h) ((4 + (b) * 2 + (h)) * HTB)
#define PG8_STAGE(bufoff, gbase, voff) do { _Pragma("unroll") for (int _i = 0; _i < 2; ++_i) \
        __builtin_amdgcn_global_load_lds((const unsigned*)((const char*)(gbase) + (voff)[_i]), (PG8_LAS unsigned*)(lds + (bufoff) + ldsw + _i * 8192), 16, 0, 0); } while (0)
#define PG8_LDA(dst, b, h) do { _Pragma("unroll") for (int m = 0; m < 4; ++m) _Pragma("unroll") for (int k = 0; k < 2; ++k) dst[m][k] = *(const PG8_LAS f16x8*)(lds + PG8_SA(b, h) + aoff + m * 2048 + k * 1024); } while (0)
#define PG8_LDB(dst, b, h) do { _Pragma("unroll") for (int n = 0; n < 2; ++n) _Pragma("unroll") for (int k = 0; k < 2; ++k) dst[n][k] = *(const PG8_LAS f16x8*)(lds + PG8_SB(b, h) + boff + n * 2048 + k * 1024); } while (0)
#define PG8_MMA(ai, bj, At, Bt) do { __builtin_amdgcn_s_setprio(1); _Pragma("unroll") for (int m = 0; m < 4; ++m) _Pragma("unroll") for (int n = 0; n < 2; ++n) _Pragma("unroll") for (int k = 0; k < 2; ++k) \
        acc[ai][bj][m][n] = __builtin_amdgcn_mfma_f32_16x16x32_f16(Bt[n][k], At[m][k], acc[ai][bj][m][n], 0, 0, 0); __builtin_amdgcn_s_setprio(0); } while (0)
#define PG8_WAIT_V(n) asm volatile("s_waitcnt vmcnt(" #n ")" ::: "memory")
#define PG8_WAIT_L(n) asm volatile("s_waitcnt lgkmcnt(" #n ")" ::: "memory")
#define PG8_BAR __builtin_amdgcn_s_barrier()
#define PG8_SCHED __builtin_amdgcn_sched_barrier(0)
    Unit cur, nxt; int ui = 0;
    if (!S.next(0, cur)) return;
    f32x4 acc[2][2][4][2];
#pragma unroll
    for (int a = 0; a < 2; ++a)
#pragma unroll
        for (int b = 0; b < 2; ++b)
#pragma unroll
            for (int m = 0; m < 4; ++m)
#pragma unroll
                for (int n = 0; n < 2; ++n) acc[a][b][m][n] = (f32x4){0.f, 0.f, 0.f, 0.f};
    f16x8 At[4][2], B0[2][2], B1[2][2];
    const char* cA = (const char*)g.A + (size_t)cur.pm * tstep; const char* cB = (const char*)g.Bt + (size_t)cur.pn * tstep;
    S.a_ready(cur);
    if constexpr (SP2) {
        PG8_STAGE(PG8_SB(0, 0), cB, voffB); PG8_STAGE(PG8_SB(0, 1), cB + hstep, voffB); PG8_STAGE(PG8_SA(0, 0), cA, voffA); PG8_STAGE(PG8_SA(0, 1), cA + hstep, voffA);
        if (wr == 1) PG8_BAR;
        PG8_WAIT_V(2); PG8_BAR;
        PG8_STAGE(PG8_SB(1, 0), cB + kstep, voffB); PG8_STAGE(PG8_SA(1, 0), cA + kstep, voffA); PG8_STAGE(PG8_SB(1, 1), cB + hstep + kstep, voffB);
        PG8_WAIT_V(6); PG8_BAR;
    } else {
        PG8_STAGE(PG8_SB(0, 0), cB, voffB); PG8_STAGE(PG8_SA(0, 0), cA, voffA); PG8_STAGE(PG8_SB(0, 1), cB + hstep, voffB); PG8_STAGE(PG8_SA(0, 1), cA + hstep, voffA);
        if (wr == 1) PG8_BAR;
        PG8_WAIT_V(4); PG8_BAR;
        PG8_STAGE(PG8_SB(1, 0), cB + kstep, voffB); PG8_STAGE(PG8_SA(1, 0), cA + kstep, voffA); PG8_STAGE(PG8_SB(1, 1), cB + hstep + kstep, voffB);
        PG8_WAIT_V(6); PG8_BAR;
    }
    for (;;) {
        const bool has_next = S.next(ui + 1, nxt);
        const char* nA = has_next ? (const char*)g.A + (size_t)nxt.pm * tstep : cA; const char* nB = has_next ? (const char*)g.Bt + (size_t)nxt.pn * tstep : cB;
        for (int t = 0; t < nt; t += 2) {
            const bool last = (t == nt - 2);
            const char* a1 = cA + (size_t)(t + 1) * kstep;
            const char* a2 = last ? nA : cA + (size_t)(t + 2) * kstep; const char* b2 = last ? nB : cB + (size_t)(t + 2) * kstep;
            const char* a3 = a2 + kstep; const char* b3 = b2 + kstep;
            if (last && has_next) S.a_ready(nxt);
            if constexpr (SP2) {
            PG8_LDB(B0, 0, 0); PG8_LDB(B1, 0, 1); PG8_SCHED; PG8_LDA(At, 0, 0); PG8_STAGE(PG8_SA(1, 1), a1 + hstep, voffA);
            PG8_WAIT_V(8); PG8_WAIT_L(0); PG8_BAR; PG8_MMA(0, 0, At, B0); PG8_MMA(0, 1, At, B1); PG8_BAR; PG8_SCHED;
            PG8_LDA(At, 0, 1); PG8_STAGE(PG8_SB(0, 0), b2, voffB); PG8_STAGE(PG8_SB(0, 1), b2 + hstep, voffB); PG8_STAGE(PG8_SA(0, 0), a2, voffA);
            PG8_WAIT_V(8); PG8_WAIT_L(0); PG8_BAR; PG8_MMA(1, 0, At, B0); PG8_MMA(1, 1, At, B1); PG8_BAR; PG8_SCHED;
            PG8_LDB(B0, 1, 0); PG8_LDB(B1, 1, 1); PG8_SCHED; PG8_LDA(At, 1, 0); PG8_STAGE(PG8_SA(0, 1), a2 + hstep, voffA);
            PG8_WAIT_V(8); PG8_WAIT_L(0); PG8_BAR; PG8_MMA(0, 0, At, B0); PG8_MMA(0, 1, At, B1); PG8_BAR; PG8_SCHED;
            PG8_LDA(At, 1, 1); PG8_STAGE(PG8_SB(1, 0), b3, voffB); PG8_STAGE(PG8_SB(1, 1), b3 + hstep, voffB); PG8_STAGE(PG8_SA(1, 0), a3, voffA);
            PG8_WAIT_V(8); PG8_WAIT_L(0); PG8_BAR; PG8_MMA(1, 0, At, B0); PG8_MMA(1, 1, At, B1); PG8_BAR; PG8_SCHED;
            } else {
            PG8_LDB(B0, 0, 0); PG8_SCHED; PG8_LDA(At, 0, 0); PG8_STAGE(PG8_SA(1, 1), a1 + hstep, voffA);
            PG8_WAIT_L(8); PG8_BAR; PG8_WAIT_L(0); PG8_MMA(0, 0, At, B0); PG8_BAR; PG8_SCHED;
            PG8_LDB(B1, 0, 1); PG8_STAGE(PG8_SB(0, 0), b2, voffB);
            PG8_BAR; PG8_WAIT_L(0); PG8_MMA(0, 1, At, B1); PG8_BAR;
            PG8_LDA(At, 0, 1); PG8_STAGE(PG8_SA(0, 0), a2, voffA);
            PG8_BAR; PG8_WAIT_L(0); PG8_MMA(1, 0, At, B0); PG8_BAR; PG8_SCHED;
            PG8_STAGE(PG8_SB(0, 1), b2 + hstep, voffB);
            PG8_WAIT_V(6); PG8_BAR; PG8_MMA(1, 1, At, B1); PG8_BAR;
            PG8_LDB(B0, 1, 0); PG8_SCHED; PG8_LDA(At, 1, 0); PG8_STAGE(PG8_SA(0, 1), a2 + hstep, voffA);
            PG8_WAIT_L(8); PG8_BAR; PG8_WAIT_L(0); PG8_MMA(0, 0, At, B0); PG8_BAR; PG8_SCHED;
            PG8_LDB(B1, 1, 1); PG8_STAGE(PG8_SB(1, 0), b3, voffB);
            PG8_BAR; PG8_WAIT_L(0); PG8_MMA(0, 1, At, B1); PG8_BAR;
            PG8_LDA(At, 1, 1); PG8_STAGE(PG8_SA(1, 0), a3, voffA);
            PG8_BAR; PG8_WAIT_L(0); PG8_MMA(1, 0, At, B0); PG8_BAR; PG8_SCHED;
            PG8_STAGE(PG8_SB(1, 1), b3 + hstep, voffB);
            PG8_WAIT_V(6); PG8_BAR; PG8_MMA(1, 1, At, B1); PG8_BAR;
            }
        }
        if constexpr (ALIGN_EPI) { if (wr == 0) PG8_BAR; }
        if constexpr (!Epi::AFTER_DRAIN) { E(acc, cur, wr, wc, fr, fq); S.done(cur); }
        if (!has_next) break;
#pragma unroll
        for (int a = 0; a < 2; ++a)
#pragma unroll
            for (int b = 0; b < 2; ++b)
#pragma unroll
                for (int m = 0; m < 4; ++m)
#pragma unroll
                    for (int n = 0; n < 2; ++n) acc[a][b][m][n] = (f32x4){0.f, 0.f, 0.f, 0.f};
        cur = nxt; cA = nA; cB = nB; ++ui;
        if constexpr (ALIGN_EPI) { if (wr == 1) PG8_BAR; }
    }
    PG8_WAIT_V(0);
    if constexpr (!ALIGN_EPI) { if (wr == 0) PG8_BAR; }
    PG8_BAR;
    if constexpr (Epi::AFTER_DRAIN) { E.fused(acc, cur, wr, wc, fr, fq, lds, wid, lane); S.done(cur); }
#undef PG8_SA
#undef PG8_SB
#undef PG8_STAGE
#undef PG8_LDA
#undef PG8_LDB
#undef PG8_MMA
#undef PG8_WAIT_V
#undef PG8_WAIT_L
#undef PG8_BAR
#undef PG8_SCHED
}
}


typedef float f32x4_t __attribute__((ext_vector_type(4)));
typedef _Float16 h16x8 __attribute__((ext_vector_type(8)));
DEVI float silu_f(float v) { return v / (1.f + __expf(-v)); }
struct EpiRoute {
    static constexpr bool PERM = true, AFTER_DRAIN = false;
    gu8* ws; const gf32* ssq;
    DEVI void operator()(const pg8::f32x4 (&acc)[2][2][4][2], const pg8::Unit& u, int wr, int wc, int fr, int fq) const {
        const int row0 = u.pm * 256 + wr * 64 + fr;
        float rs[2][4];
#pragma unroll
        for (int ai = 0; ai < 2; ++ai)
#pragma unroll
            for (int m = 0; m < 4; ++m) { const int rw = row0 + ai * 128 + m * 16; rs[ai][m] = rsqrtf((ssq[rw] + ssq[NT + rw] + ssq[2 * NT + rw] + ssq[3 * NT + rw]) * (1.f / DM) + EPS); }
#pragma unroll
        for (int bj = 0; bj < 2; ++bj) {
            const int cg = u.pn * 256 + bj * 128 + wc * 32;
            const Route r = route(cg);
            if (r.kind < 0) continue;
            gh16* base = (gh16*)(ws + r.off);
            const int c = r.dcol + 8 * fq;
#pragma unroll
            for (int ai = 0; ai < 2; ++ai)
#pragma unroll
                for (int m = 0; m < 4; ++m) {
                    const int row = row0 + ai * 128 + m * 16; const float sc = rs[ai][m] * r.scale;
                    float v[8];
#pragma unroll
                    for (int j = 0; j < 4; ++j) { v[j] = acc[ai][bj][m][0][j] * sc; v[4 + j] = acc[ai][bj][m][1][j] * sc; }
                    if (r.silu) {
#pragma unroll
                        for (int j = 0; j < 8; ++j) v[j] = silu_f(v[j]);
                    }
                    h16x8 o;
#pragma unroll
                    for (int j = 0; j < 8; ++j) o[j] = (h16)v[j];
                    if (r.kind == 0) *(GAS h16x8*)(base + (size_t)row * r.pitch + c) = o;
                    else {
                        const int b = row >> 11, sq = row & 2047;
                        if (r.kind == 3) *(GAS h16x8*)(base + (((size_t)b * 128 + (sq >> 4)) * 64 + (sq & 15) + 16 * (c >> 3)) * 8) = o;
                        else {
                            const int bh = b * 4 + (c >> 6), d0 = c & 63;
                            *(GAS h16x8*)(base + kf_off(bh, sq, d0)) = o;
                            if (r.kind == 2) { *(GAS h16x8*)(base + FSZ + kf4_off(bh, sq, d0)) = o; *(GAS h16x8*)(base + 2 * FSZ + kf16_off(bh, sq, d0)) = o; }
                        }
                    }
                }
        }
    }
};

struct EpiOut {
    static constexpr bool PERM = true, AFTER_DRAIN = true;
    const gf32* h_in; gf32* h_out; gh16* h16o; const gf32* gpost; gf32* ssqy; gf32* ssqh; const XcdBarrier* bar; bool write_next;
    DEVI void rowsum_publish(const float (&ps)[2][4], gf32* dst, const pg8::Unit& u, int wr, int wc, int fr, int fq, PG8_LAS unsigned char* lds) const {
        lf32* red = (lf32*)lds;
        __syncthreads();
#pragma unroll
        for (int ai = 0; ai < 2; ++ai)
#pragma unroll
            for (int m = 0; m < 4; ++m) { float v = ps[ai][m]; v += __shfl_xor(v, 16); v += __shfl_xor(v, 32); if (fq == 0) red[wc * 256 + ai * 128 + wr * 64 + m * 16 + fr] = v; }
        __syncthreads();
        const int t = otid();
        if (t < 256) dst[(size_t)u.pn * NT + u.pm * 256 + t] = red[t] + red[256 + t] + red[512 + t] + red[768 + t];
    }
    DEVI void fused(pg8::f32x4 (&acc)[2][2][4][2], const pg8::Unit& u, int wr, int wc, int fr, int fq, PG8_LAS unsigned char* lds, int wid, int lane) const {
        float ps[2][4];
#pragma unroll
        for (int ai = 0; ai < 2; ++ai)
#pragma unroll
            for (int m = 0; m < 4; ++m) { float v = 0.f;
#pragma unroll
                for (int bj = 0; bj < 2; ++bj)
#pragma unroll
                    for (int n = 0; n < 2; ++n)
#pragma unroll
                        for (int e = 0; e < 4; ++e) v += acc[ai][bj][m][n][e] * acc[ai][bj][m][n][e];
                ps[ai][m] = v; }
        rowsum_publish(ps, ssqy, u, wr, wc, fr, fq, lds);
        xcd_barrier(*bar);
        const int row0 = u.pm * 256 + wr * 64 + fr;
#pragma unroll
        for (int ai = 0; ai < 2; ++ai)
#pragma unroll
            for (int m = 0; m < 4; ++m) {
                const int row = row0 + ai * 128 + m * 16;
                const float rs = rsqrtf((ssqy[row] + ssqy[NT + row] + ssqy[2 * NT + row] + ssqy[3 * NT + row]) * (1.f / DM) + EPS);
                float v2 = 0.f;
#pragma unroll
                for (int bj = 0; bj < 2; ++bj) {
                    const int col = u.pn * 256 + bj * 128 + wc * 32 + 8 * fq;
                    const size_t off = (size_t)row * DM + col;
                    h16x8 oh;
#pragma unroll
                    for (int n = 0; n < 2; ++n) {
                        const f32x4_t hv = *(const GAS f32x4_t*)(h_in + off + 4 * n), gv = *(const GAS f32x4_t*)(gpost + col + 4 * n);
                        f32x4_t o;
#pragma unroll
                        for (int e = 0; e < 4; ++e) { o[e] = hv[e] + acc[ai][bj][m][n][e] * rs * gv[e]; v2 += o[e] * o[e]; oh[4 * n + e] = (h16)o[e]; }
                        *(GAS f32x4_t*)(h_out + off + 4 * n) = o;
                    }
                    if (write_next) *(GAS h16x8*)(h16o + off) = oh;
                }
                ps[ai][m] = v2;
            }
        if (write_next) rowsum_publish(ps, ssqh, u, wr, wc, fr, fq, lds);
    }
    DEVI void operator()(const pg8::f32x4 (&)[2][2][4][2], const pg8::Unit&, int, int, int, int) const {}
};

constexpr int NTHR = 512, NWAVE = 8;

template <bool REF>
DEVI void cvt_transpose(const gf32* __restrict__ src, int src_pitch, const gf32* __restrict__ g, gh16* dst, int N, int K, lu8* lds, int item0, int nitems_total, int& item_base) {
    const int tid = otid();
    LAS float (*tile)[65] = (LAS float (*)[65])lds;
    const int ntn = N / 64, ntk = K / 64, n_it = ntn * ntk;
    for (int it = item0; it < nitems_total; it += gridDim.x) {
        const int li = it - item_base; if (li < 0 || li >= n_it) continue;
        const int n0 = (li % ntn) * 64, k0 = (li / ntn) * 64;
        __syncthreads();
        const int c = tid & 63; int rc = n0 + c; if (REF) rc = ref_col(rc);
#pragma unroll
        for (int ps = 0; ps < 8; ++ps) { const int k = ps * 8 + (tid >> 6);
            tile[k][c] = rc >= 0 ? src[(size_t)(k0 + k) * src_pitch + rc] * (g ? g[k0 + k] : 1.f) : 0.f; }
        __syncthreads();
        const int cc = tid >> 3, kq = (tid & 7) * 8;
        h16x8 o;
#pragma unroll
        for (int j = 0; j < 8; ++j) o[j] = (h16)tile[kq + j][cc];
        *(GAS h16x8*)(dst + (size_t)(n0 + cc) * K + k0 + kq) = o;
    }
    item_base += n_it;
}

DEVI void ph_rowstat_cvt(const gf32* h, gf32* ssq, gh16* h16o) {
    const int t_ = otid(); const int lane = t_ & 63, gw = blockIdx.x * NWAVE + (t_ >> 6), nw = gridDim.x * NWAVE;
    for (int row = gw; row < NT; row += nw) {
        const GAS f32x4_t* p = (const GAS f32x4_t*)(h + (size_t)row * DM);
        float s = 0.f;
#pragma unroll
        for (int i = 0; i < 4; ++i) { f32x4_t v = p[lane + 64 * i]; s += v[0] * v[0] + v[1] * v[1] + v[2] * v[2] + v[3] * v[3];
            typedef _Float16 h16x4 __attribute__((ext_vector_type(4)));
            h16x4 o; o[0] = (h16)v[0]; o[1] = (h16)v[1]; o[2] = (h16)v[2]; o[3] = (h16)v[3];
            *(GAS h16x4*)(h16o + (size_t)row * DM + (lane + 64 * i) * 4) = o; }
        for (int o = 32; o; o >>= 1) s += __shfl_xor(s, o);
        if (lane == 0) { ssq[row] = s; ssq[NT + row] = 0.f; ssq[2 * NT + row] = 0.f; ssq[3 * NT + row] = 0.f; }
    }
}

typedef float f32x16 __attribute__((ext_vector_type(16)));
typedef _Float16 h16x4 __attribute__((ext_vector_type(4)));
DEVI f32x16 mfma32(h16x8 a, h16x8 b, f32x16 c) { return __builtin_amdgcn_mfma_f32_32x32x16_f16(a, b, c, 0, 0, 0); }
#define CROW(r) (((r) & 3) + 8 * ((r) >> 2))
DEVI float xh_max(float x) { auto r = __builtin_amdgcn_permlane32_swap(__float_as_uint(x), __float_as_uint(x), false, false); return fmaxf(__uint_as_float(r[0]), __uint_as_float(r[1])); }
DEVI float xh_sum(float x) { auto r = __builtin_amdgcn_permlane32_swap(__float_as_uint(x), __float_as_uint(x), false, false); return __uint_as_float(r[0]) + __uint_as_float(r[1]); }
DEVI unsigned pk2h(float a, float b) { auto v = __builtin_amdgcn_cvt_pkrtz(a, b); return __builtin_bit_cast(unsigned, v); }
DEVI h16x8 pack8(const f32x16& p, int s) {
    typedef unsigned u32x4_t __attribute__((ext_vector_type(4)));
    u32x4_t w;
    w[0] = pk2h(p[8 * s + 0], p[8 * s + 1]); w[1] = pk2h(p[8 * s + 2], p[8 * s + 3]); w[2] = pk2h(p[8 * s + 4], p[8 * s + 5]); w[3] = pk2h(p[8 * s + 6], p[8 * s + 7]);
    return __builtin_bit_cast(h16x8, w);
}
DEVI h16x8 ldv8(const gh16* p) {
    h16x4 a = *(const GAS h16x4*)p, b = *(const GAS h16x4*)(p + 8);
    h16x8 r; r[0] = a[0]; r[1] = a[1]; r[2] = a[2]; r[3] = a[3]; r[4] = b[0]; r[5] = b[1]; r[6] = b[2]; r[7] = b[3]; return r;
}
DEVI void softmax_tile(f32x16& S, float& m, float& l, f32x16& O0, f32x16& O1) {
    float mx = S[0];
#pragma unroll
    for (int r = 1; r < 16; ++r) mx = fmaxf(mx, S[r]);
    mx = xh_max(mx);
    if (__any(mx > m)) {
        const float mn = fmaxf(m, mx), al = __builtin_amdgcn_exp2f(m - mn);
        l *= al; O0 *= al; O1 *= al; m = mn;
    }
#pragma unroll
    for (int r = 0; r < 16; ++r) S[r] = __builtin_amdgcn_exp2f(S[r] - m);
    l += ((S[0] + S[1]) + (S[2] + S[3])) + ((S[4] + S[5]) + (S[6] + S[7])) + (((S[8] + S[9]) + (S[10] + S[11])) + ((S[12] + S[13]) + (S[14] + S[15])));
}
DEVI void softmax_tile_h(f32x16& S, float& m, float& l, f32x16& O0, f32x16& O1, int hot) { if (hot < 2) softmax_tile(S, m, l, O0, O1); else l += S[0]; }
DEVI int wq_next(gu32* ctr) {
    int e = 0;
    if ((otid() & 63) == 0) e = (int)__hip_atomic_fetch_add(ctr, 1u, __ATOMIC_RELAXED, __HIP_MEMORY_SCOPE_AGENT);
    return __builtin_amdgcn_readfirstlane(e);
}

DEVI void flashA_item(int b, int hh, int qt, const gh16* qA, const gh16* KF, const gh16* KRF, const gh16* VF, const gh16* gate, gh16* mix) {
    const int lane = otid() & 63, q = lane & 31, h = lane >> 5;
    const size_t tokq = (size_t)b * SEQ + qt * 32 + q;
    h16x8 qf[6];
#pragma unroll
    for (int ks = 0; ks < 6; ++ks) qf[ks] = *(const GAS h16x8*)(qA + tokq * 384 + hh * 96 + ks * 16 + 8 * h);
    f32x16 O0 = {}, O1 = {};
    float m = -1e30f, l = 0.f;
    const gh16* kp = KF + (size_t)(b * 4 + hh) * 64 * 2048 + lane * 8;
    const gh16* rp = KRF + (size_t)b * 64 * 1024 + lane * 8;
    const gh16* vp = VF + (size_t)(b * 4 + hh) * 64 * 2048 + lane * 8;
    h16x8 kf[6];
#pragma unroll
    for (int ks = 0; ks < 4; ++ks) kf[ks] = *(const GAS h16x8*)(kp + ks * 512);
#pragma unroll
    for (int ks = 0; ks < 2; ++ks) kf[4 + ks] = *(const GAS h16x8*)(rp + ks * 512);
    h16x8 vf[4], vn[4];
#pragma unroll
    for (int f = 0; f < 4; ++f) vf[f] = *(const GAS h16x8*)(vp + f * 512);
    for (int j = 0; j <= qt; ++j) {
        f32x16 S = {};
#pragma unroll
        for (int ks = 0; ks < 6; ++ks) S = mfma32(kf[ks], qf[ks], S);
        if (j < qt) {
#pragma unroll
            for (int ks = 0; ks < 4; ++ks) kf[ks] = *(const GAS h16x8*)(kp + (size_t)(j + 1) * 2048 + ks * 512);
#pragma unroll
            for (int ks = 0; ks < 2; ++ks) kf[4 + ks] = *(const GAS h16x8*)(rp + (size_t)(j + 1) * 1024 + ks * 512);
#pragma unroll
            for (int f = 0; f < 4; ++f) vn[f] = *(const GAS h16x8*)(vp + (size_t)(j + 1) * 2048 + f * 512);
        } else {
#pragma unroll
            for (int r = 0; r < 16; ++r) S[r] = (CROW(r) + 4 * h > q) ? -3e38f : S[r];
        }
        softmax_tile(S, m, l, O0, O1);
        const h16x8 p0 = pack8(S, 0), p1 = pack8(S, 1);
        O0 = mfma32(vf[0], p0, O0); O0 = mfma32(vf[1], p1, O0);
        O1 = mfma32(vf[2], p0, O1); O1 = mfma32(vf[3], p1, O1);
#pragma unroll
        for (int f = 0; f < 4; ++f) vf[f] = vn[f];
    }
    const float il = 1.f / xh_sum(l);
    const gh16* gp = gate + tokq * 1024 + hh * 64 + 4 * h;
#pragma unroll
    for (int db = 0; db < 2; ++db)
#pragma unroll
        for (int g = 0; g < 4; ++g) {
            const h16x4 gv = *(const GAS h16x4*)(gp + db * 32 + 8 * g); h16x4 o;
#pragma unroll
            for (int e = 0; e < 4; ++e) o[e] = (h16)((db ? O1[4 * g + e] : O0[4 * g + e]) * il * (float)gv[e]);
            *(GAS h16x4*)(mix + mixf_off(tokq, hh * 64 + db * 32 + 8 * g + 4 * h)) = o;
        }
}

DEVI int far_bucket(int n) { return 23 + (n >= 182 ? 1 : 0) + (n >= 246 ? 1 : 0) + (n >= 332 ? 1 : 0) + (n >= 450 ? 1 : 0) + (n >= 609 ? 1 : 0) + (n >= 825 ? 1 : 0) + (n >= 1117 ? 1 : 0) + (n >= 1513 ? 1 : 0); }
DEVI int far_start(int bk) { return bk == 24 ? 182 : bk == 25 ? 246 : bk == 26 ? 332 : bk == 27 ? 450 : bk == 28 ? 609 : bk == 29 ? 825 : bk == 30 ? 1117 : 1513; }
constexpr int L_NEAR = 0, L_R3 = 12288, L_R2 = 15360, L_R1 = 21504, L_LAM = 39936, L_P2END = 40000;
constexpr int L_BIASL = 40000, L_RING = 41984, L_MRING = L_RING + 4 * 10240, L_WQ = L_MRING + 8192;
DEVI void p2_setup(const gf32* biasTab, const gf32* lam_p, float lambda_init, lu8* lds) {
    const int tid = otid();
    lf32* nearR = (lf32*)(lds + L_NEAR);
    for (int i = tid; i < 12 * 256; i += NTHR) { const int hb = i >> 8, u = i & 255, tix = 223 - u; nearR[i] = tix < 0 ? -3e38f : biasTab[hb * 2048 + tix]; }
    lf32* R3 = (lf32*)(lds + L_R3); lf32* R2 = (lf32*)(lds + L_R2); lf32* R1 = (lf32*)(lds + L_R1);
    for (int i = tid; i < 4 * 192; i += NTHR) { const int hb = i / 192, kk = 159 - (i % 192); R3[i] = (kk < 0 || kk > 128) ? -3e38f : biasTab[hb * 2048 + kk * 16]; }
    for (int i = tid; i < 4 * 384; i += NTHR) { const int hb = i / 384, kk = 255 - (i % 384); R2[i] = (kk < 0 || kk > 128) ? -3e38f : biasTab[hb * 2048 + kk * 4]; }
    for (int i = tid; i < 4 * 1152; i += NTHR) { const int hb = i / 1152, kk = 639 - (i % 1152); R1[i] = (kk < 0 || kk > 128) ? -3e38f : biasTab[hb * 2048 + kk]; }
    { lf32* bl = (lf32*)(lds + L_BIASL); for (int i = tid; i < 12 * 32; i += NTHR) { const int hb = i >> 5, k = i & 31; bl[i] = biasTab[hb * 2048 + (k < 16 ? k : kBucketStart[k - 16])]; } }
    if (tid == 0) { float a1 = 0.f, a2 = 0.f; for (int i = 0; i < 32; ++i) { a1 += lam_p[i] * lam_p[32 + i]; a2 += lam_p[64 + i] * lam_p[96 + i]; }
        *(lf32*)(lds + L_LAM) = expf(a1) - expf(a2) + lambda_init; }
    __syncthreads();
}

DEVI void ph_vtrans(const gh16* vtmp, gh16* VF, lu8* lds) {
    const int tid = otid();
    LAS h16 (*tile)[72] = (LAS h16 (*)[72])lds;
    for (int it = blockIdx.x; it < 3 * 32 * 4; it += gridDim.x) {
        const int src = it >> 7, bh = (it >> 2) & 31, blk = it & 3, b = bh >> 2, hh = bh & 3;
        __syncthreads();
#pragma unroll
        for (int k = 0; k < 8; ++k) { const int idx = k * NTHR + tid, row = idx >> 3, c8 = idx & 7;
            *(LAS h16x8*)&tile[row][c8 * 8] = *(const GAS h16x8*)(vtmp + ((size_t)b * SEQ + blk * 512 + row) * 768 + src * 256 + hh * 64 + c8 * 8); }
        __syncthreads();
        gh16* out0 = VF + (src == 0 ? 0 : (src == 1 ? 3 * FSZ : 4 * FSZ));
#pragma unroll 1
        for (int k = 0; k < 8; ++k) {
            const int fl = k * NTHR + tid, lane = fl & 63, frag = (fl >> 6) & 3, dl = lane & 31, hp = lane >> 5, db = frag >> 1, sk = frag & 1;
            {
                const int tl = fl >> 8; h16x8 o;
#pragma unroll
                for (int e = 0; e < 8; ++e) o[e] = tile[tl * 32 + 16 * sk + 8 * (e >> 2) + 4 * hp + (e & 3)][db * 32 + dl];
                *(GAS h16x8*)(out0 + ((((size_t)bh * 64 + blk * 16 + tl) * 4 + frag) * 64 + lane) * 8) = o;
            }
            if (src == 0) {
                {
                    const int r4 = fl >> 10, tl = (fl >> 8) & 3; h16x8 o;
#pragma unroll
                    for (int e = 0; e < 8; ++e) o[e] = tile[4 * (tl * 32 + 16 * sk + 8 * (e >> 2) + 4 * hp + (e & 3)) + r4][db * 32 + dl];
                    *(GAS h16x8*)(out0 + FSZ + (((((size_t)bh * 4 + r4) * 16 + blk * 4 + tl) * 4 + frag) * 64 + lane) * 8) = o;
                }
                {
                    const int r = fl >> 8; h16x8 o;
#pragma unroll
                    for (int e = 0; e < 8; ++e) o[e] = tile[16 * (16 * sk + 8 * (e >> 2) + 4 * hp + (e & 3)) + r][db * 32 + dl];
                    *(GAS h16x8*)(out0 + 2 * FSZ + (((((size_t)bh * 16 + r) * 4 + blk) * 4 + frag) * 64 + lane) * 8) = o;
                }
            }
        }
    }
}

template <int NMAP, bool MASK>
DEVI void flashCD_item(int b, int hh, int qt, int hb, const gh16* Q, const gh16* KF, const gh16* VF, const gu32* mask, const gf32* biasTab, const lu8* lds,
                       const gf32* subln, float lambda_init, const gh16* gate, gh16* mix, int mixcol, int hot = 0) {
    constexpr int NKS = 4 / NMAP;
    const int lane = otid() & 63, q = lane & 31, h = lane >> 5;
    const size_t tokq = (size_t)b * SEQ + qt * 32 + q;
    const gh16* kp = KF + (size_t)(b * 4 + hh) * 64 * 2048 + lane * 8;
    const gh16* vp = VF + (size_t)(b * 4 + hh) * 64 * 2048 + lane * 8;
    h16x8 qf[NMAP][NKS], kf[NMAP][NKS];
#pragma unroll
    for (int mp = 0; mp < NMAP; ++mp)
#pragma unroll
        for (int ks = 0; ks < NKS; ++ks) {
            qf[mp][ks] = *(const GAS h16x8*)(Q + tokq * 256 + hh * 64 + (mp * NKS + ks) * 16 + 8 * h);
            kf[mp][ks] = *(const GAS h16x8*)(kp + (mp * NKS + ks) * 512);
        }
    f32x16 O[NMAP][2]; float m[NMAP], l[NMAP];
#pragma unroll
    for (int mp = 0; mp < NMAP; ++mp) { O[mp][0] = (f32x16){}; O[mp][1] = (f32x16){}; m[mp] = -1e30f; l[mp] = 0.f; }
    const lf32* nearR = (const lf32*)(lds + L_NEAR) + hb * 256;
    const gf32* bt = biasTab + hb * 2048;
    h16x8 vf[2][2], vn[2][2];
#pragma unroll
    for (int db = 0; db < 2; ++db)
#pragma unroll
        for (int sk = 0; sk < 2; ++sk) vf[db][sk] = *(const GAS h16x8*)(vp + (db * 2 + sk) * 512);
    unsigned mw = 0xffffffffu, mwn = 0xffffffffu;
    if (MASK) mw = mask[tokq * 64];
    for (int j = 0; j <= qt; ++j) {
        f32x16 S[NMAP];
#pragma unroll
        for (int mp = 0; mp < NMAP; ++mp) { S[mp] = (f32x16){};
#pragma unroll
            for (int ks = 0; ks < NKS; ++ks) S[mp] = mfma32(kf[mp][ks], qf[mp][ks], S[mp]); }
        if (j < qt && hot < 5) {
#pragma unroll
            for (int mp = 0; mp < NMAP; ++mp)
#pragma unroll
                for (int ks = 0; ks < NKS; ++ks) kf[mp][ks] = *(const GAS h16x8*)(kp + (size_t)(hot ? 0 : j + 1) * 2048 + (mp * NKS + ks) * 512);
#pragma unroll
            for (int db = 0; db < 2; ++db)
#pragma unroll
                for (int sk = 0; sk < 2; ++sk) vn[db][sk] = *(const GAS h16x8*)(vp + (size_t)(hot ? 0 : j + 1) * 2048 + (db * 2 + sk) * 512);
            if (MASK) mwn = mask[tokq * 64 + j + 1];
        }
        const int D0 = (qt - j) * 32;
        if (hot >= 3) {} else
        if (D0 < 192) {
            const lf32* tp = nearR + (223 - D0 - q + 4 * h);
#pragma unroll
            for (int r = 0; r < 16; ++r) { const float bv = tp[CROW(r)];
#pragma unroll
                for (int mp = 0; mp < NMAP; ++mp) S[mp][r] += bv; }
        } else {
            const int blo = far_bucket(D0 - 31), bhi = far_bucket(D0 + 31);
            const lf32* biasL = (const lf32*)(lds + L_BIASL) + hb * 32;
            const float lo = biasL[blo], hi = biasL[bhi];
            if (blo == bhi) {
#pragma unroll
                for (int mp = 0; mp < NMAP; ++mp) S[mp] += lo;
            } else {
                const int x = D0 + q - 4 * h - far_start(bhi);
#pragma unroll
                for (int r = 0; r < 16; ++r) { const float bv = (x >= CROW(r)) ? hi : lo;
#pragma unroll
                    for (int mp = 0; mp < NMAP; ++mp) S[mp][r] += bv; }
            }
        }
        if (MASK && hot < 3) {
#pragma unroll
            for (int r = 0; r < 16; ++r) S[0][r] = (((mw >> (4 * h)) >> CROW(r)) & 1u) ? S[0][r] : -3e38f;
        }
#pragma unroll
        for (int mp = 0; mp < NMAP; ++mp) {
            softmax_tile_h(S[mp], m[mp], l[mp], O[mp][0], O[mp][1], hot);
            const h16x8 p0 = pack8(S[mp], 0), p1 = pack8(S[mp], 1);
            if (hot < 4) {
            O[mp][0] = mfma32(vf[0][0], p0, O[mp][0]); O[mp][0] = mfma32(vf[0][1], p1, O[mp][0]);
            O[mp][1] = mfma32(vf[1][0], p0, O[mp][1]); O[mp][1] = mfma32(vf[1][1], p1, O[mp][1]);
            } else { O[mp][0][0] += (float)p0[0] + (float)p1[0]; }
        }
#pragma unroll
        for (int db = 0; db < 2; ++db)
#pragma unroll
            for (int sk = 0; sk < 2; ++sk) vf[db][sk] = vn[db][sk];
        mw = mwn;
    }
    f32x16 R0, R1;
    if (NMAP == 2) {
        const float lam = *(const lf32*)(lds + L_LAM);
        const float i0 = 1.f / xh_sum(l[0]), i1 = lam / xh_sum(l[NMAP - 1]);
        R0 = O[0][0] * i0 - O[NMAP - 1][0] * i1; R1 = O[0][1] * i0 - O[NMAP - 1][1] * i1;
        float ss = 0.f;
#pragma unroll
        for (int r = 0; r < 16; ++r) ss += R0[r] * R0[r] + R1[r] * R1[r];
        ss = xh_sum(ss);
        const float rs = rsqrtf(ss * (1.f / 64.f) + EPS) * (1.f - lambda_init);
        R0 *= rs; R1 *= rs;
    } else {
        const float il = 1.f / xh_sum(l[0]);
        R0 = O[0][0] * il; R1 = O[0][1] * il;
    }
    const gh16* gp = gate + tokq * 1024 + mixcol + hh * 64 + 4 * h;
#pragma unroll
    for (int db = 0; db < 2; ++db)
#pragma unroll
        for (int g = 0; g < 4; ++g) {
            const h16x4 gv = *(const GAS h16x4*)(gp + db * 32 + 8 * g); h16x4 o;
#pragma unroll
            for (int e = 0; e < 4; ++e) { float v = (db ? R1[4 * g + e] : R0[4 * g + e]) * (float)gv[e];
                if (NMAP == 2) v *= subln[db * 32 + 8 * g + 4 * h + e];
                o[e] = (h16)v; }
            if (!hot) *(GAS h16x4*)(mix + mixf_off(tokq, mixcol + hh * 64 + db * 32 + 8 * g + 4 * h)) = o; else asm volatile("" :: "v"(o));
        }
}

template <int BR>
DEVI void flashQ2_item(int b, int hh, int pr, const gh16* Q, const gh16* KF, const gh16* KRF, const gh16* VF, const gu32* mask, const gf32* biasTab, const lu8* lds,
                       const gh16* gate, gh16* mix, int mixcol, int hb, int hot = 0) {
    constexpr int NQK = BR == 0 ? 6 : 4;
    const int lane = otid() & 63, q = lane & 31, h = lane >> 5, bh = b * 4 + hh;
    const int qt1 = 2 * pr + 1;
    size_t tokq[2]; h16x8 qf[2][NQK];
#pragma unroll
    for (int qi = 0; qi < 2; ++qi) { tokq[qi] = (size_t)b * SEQ + (2 * pr + qi) * 32 + q;
#pragma unroll
        for (int ks = 0; ks < NQK; ++ks) qf[qi][ks] = *(const GAS h16x8*)(Q + tokq[qi] * (BR == 0 ? 384 : 256) + hh * (BR == 0 ? 96 : 64) + ks * 16 + 8 * h); }
    f32x16 O[2][2]; float m[2], l[2];
#pragma unroll
    for (int qi = 0; qi < 2; ++qi) { O[qi][0] = (f32x16){}; O[qi][1] = (f32x16){}; m[qi] = -1e30f; l[qi] = 0.f; }
    const gh16* kp = KF + (size_t)bh * 64 * 2048 + lane * 8;
    const gh16* rp = KRF + (size_t)b * 64 * 1024 + lane * 8;
    const gh16* vp = VF + (size_t)bh * 64 * 2048 + lane * 8;
    const lf32* nearR = (const lf32*)(lds + L_NEAR) + hb * 256;
    const gf32* bt = biasTab + hb * 2048;
    h16x8 kf[NQK], vf[4];
#pragma unroll
    for (int ks = 0; ks < NQK; ++ks) kf[ks] = (BR == 0 && ks >= 4) ? *(const GAS h16x8*)(rp + (ks - 4) * 512) : *(const GAS h16x8*)(kp + ks * 512);
    unsigned mw[2] = {0xffffffffu, 0xffffffffu}, mwn[2] = {0xffffffffu, 0xffffffffu};
    if (BR == 1) { mw[0] = mask[tokq[0] * 64]; mw[1] = mask[tokq[1] * 64]; }
#pragma unroll 1
    for (int j = 0; j <= qt1; ++j) {
#pragma unroll
        for (int f = 0; f < 4; ++f) vf[f] = *(const GAS h16x8*)(vp + (size_t)(hot ? 0 : j) * 2048 + f * 512);
        f32x16 S[2];
#pragma unroll
        for (int qi = 0; qi < 2; ++qi) { S[qi] = (f32x16){};
#pragma unroll
            for (int ks = 0; ks < NQK; ++ks) S[qi] = mfma32(kf[ks], qf[qi][ks], S[qi]); }
        if (j < qt1 && hot < 5) {
#pragma unroll
            for (int ks = 0; ks < NQK; ++ks) kf[ks] = (BR == 0 && ks >= 4) ? *(const GAS h16x8*)(rp + (size_t)(hot ? 0 : j + 1) * 1024 + (ks - 4) * 512) : *(const GAS h16x8*)(kp + (size_t)(hot ? 0 : j + 1) * 2048 + ks * 512);
            if (BR == 1) { mwn[0] = mask[tokq[0] * 64 + (j + 1 < qt1 ? j + 1 : j)]; mwn[1] = mask[tokq[1] * 64 + j + 1]; }
        }
#pragma unroll
        for (int qi = 0; qi < 2; ++qi) {
            const int qt = 2 * pr + qi;
            if (j <= qt) {
                const int D0 = (qt - j) * 32;
                if (hot >= 3) {} else
                if (BR == 0) {
                    if (D0 == 0) {
#pragma unroll
                        for (int r = 0; r < 16; ++r) S[qi][r] = (CROW(r) + 4 * h > q) ? -3e38f : S[qi][r];
                    }
                } else {
                    if (D0 < 192) {
                        const lf32* tp = nearR + (223 - D0 - q + 4 * h);
#pragma unroll
                        for (int r = 0; r < 16; ++r) S[qi][r] += tp[CROW(r)];
                    } else {
                        const int blo = far_bucket(D0 - 31), bhi = far_bucket(D0 + 31);
                        const lf32* biasL = (const lf32*)(lds + L_BIASL) + hb * 32;
                        const float lo = biasL[blo], hi = biasL[bhi];
                        if (blo == bhi) S[qi] += lo;
                        else {
                            const int x = D0 + q - 4 * h - far_start(bhi);
#pragma unroll
                            for (int r = 0; r < 16; ++r) S[qi][r] += (x >= CROW(r)) ? hi : lo;
                        }
                    }
                    const unsigned mm = mw[qi] >> (4 * h);
#pragma unroll
                    for (int r = 0; r < 16; ++r) S[qi][r] = ((mm >> CROW(r)) & 1u) ? S[qi][r] : -3e38f;
                }
                softmax_tile_h(S[qi], m[qi], l[qi], O[qi][0], O[qi][1], hot);
                const h16x8 p0 = pack8(S[qi], 0), p1 = pack8(S[qi], 1);
                if (hot < 4) {
                O[qi][0] = mfma32(vf[0], p0, O[qi][0]); O[qi][0] = mfma32(vf[1], p1, O[qi][0]);
                O[qi][1] = mfma32(vf[2], p0, O[qi][1]); O[qi][1] = mfma32(vf[3], p1, O[qi][1]);
                } else { O[qi][0][0] += (float)p0[0] + (float)p1[0]; }
            }
        }
        mw[0] = mwn[0]; mw[1] = mwn[1];
    }
#pragma unroll
    for (int qi = 0; qi < 2; ++qi) {
        const float il = 1.f / xh_sum(l[qi]);
        const gh16* gp = gate + tokq[qi] * 1024 + mixcol + hh * 64 + 4 * h;
#pragma unroll
        for (int db = 0; db < 2; ++db)
#pragma unroll
            for (int g = 0; g < 4; ++g) {
                const h16x4 gv = *(const GAS h16x4*)(gp + db * 32 + 8 * g); h16x4 o;
#pragma unroll
                for (int e = 0; e < 4; ++e) o[e] = (h16)(O[qi][db][4 * g + e] * il * (float)gv[e]);
                if (!hot) *(GAS h16x4*)(mix + mixf_off(tokq[qi], mixcol + hh * 64 + db * 32 + 8 * g + 4 * h)) = o; else asm volatile("" :: "v"(o));
            }
    }
}

template <int BR>
DEVI void flashWG_item(int b, int hh, int Qb, const gh16* Q, const gh16* KF, const gh16* KRF, const gh16* VF, const gu32* mask, lu8* lds,
                       const gf32* subln, float lambda_init, const gh16* gate, gh16* mix, int mixcol, int hb) {
    constexpr int NMAP = BR == 2 ? 2 : 1, NQK = BR == 0 ? 6 : 4, NKS = NQK / NMAP, NP = NQK + 4, TB = NP * 1024, NDMA = BR == 2 ? 1 : 2, DD = 3;
    const int tid = otid(), lane = tid & 63, q = lane & 31, h = lane >> 5, wv = __builtin_amdgcn_readfirstlane(tid >> 6);
    const int qt = 8 * Qb + wv, last = 8 * Qb + 7, bh = b * 4 + hh;
    const size_t tokq = (size_t)b * SEQ + qt * 32 + q;
    h16x8 qf[NQK];
#pragma unroll
    for (int ks = 0; ks < NQK; ++ks) qf[ks] = *(const GAS h16x8*)(Q + tokq * (BR == 0 ? 384 : 256) + hh * (BR == 0 ? 96 : 64) + ks * 16 + 8 * h);
    f32x16 O[NMAP][2]; float m[NMAP], l[NMAP];
#pragma unroll
    for (int mp = 0; mp < NMAP; ++mp) { O[mp][0] = (f32x16){}; O[mp][1] = (f32x16){}; m[mp] = -1e30f; l[mp] = 0.f; }
    asm volatile("s_waitcnt vmcnt(0)" ::: "memory");
    __syncthreads();
    lu8* ring = lds + L_RING; lu8* mring = lds + L_MRING;
    auto issue = [&](int jt) {
        const int jc = jt < last ? jt : last, slot = jt & 3;
        {
            const int pc = wv;
            const gh16* src = pc < 4 ? KF + ((size_t)bh * 64 + jc) * 2048 + pc * 512
                            : (BR == 0 && pc < 6) ? KRF + ((size_t)b * 64 + jc) * 1024 + (pc - 4) * 512
                            : VF + ((size_t)bh * 64 + jc) * 2048 + (pc - NQK) * 512;
            __builtin_amdgcn_global_load_lds((const GAS unsigned*)(src + lane * 8), (LAS unsigned*)(ring + slot * TB + pc * 1024), 16, 0, 0);
        }
        if (BR == 0) {
            const int pc = 8 + (wv & 1);
            const gh16* src = VF + ((size_t)bh * 64 + jc) * 2048 + (pc - NQK) * 512;
            __builtin_amdgcn_global_load_lds((const GAS unsigned*)(src + lane * 8), (LAS unsigned*)(ring + slot * TB + pc * 1024), 16, 0, 0);
        }
        if (BR == 1) __builtin_amdgcn_global_load_lds((const GAS unsigned*)(mask + tokq * 64 + (jc <= qt ? jc : qt)), (LAS unsigned*)(mring + (slot * 8 + wv) * 256), 4, 0, 0);
    };
#pragma unroll
    for (int jt = 0; jt < DD; ++jt) issue(jt);
    const lf32* nearR = (const lf32*)(lds + L_NEAR) + hb * 256;
    const lf32* biasL = (const lf32*)(lds + L_BIASL) + hb * 32;
    f32x16 S[NMAP], Sn[NMAP];
    asm volatile("s_waitcnt vmcnt(%0)" :: "n"((DD - 1) * NDMA) : "memory");
    __builtin_amdgcn_s_barrier();
#pragma unroll
    for (int mp = 0; mp < NMAP; ++mp) { S[mp] = (f32x16){};
#pragma unroll
        for (int ks = 0; ks < NKS; ++ks) S[mp] = mfma32(*(const LAS h16x8*)(ring + lane * 16 + (mp * NKS + ks) * 1024), qf[mp * NKS + ks], S[mp]); }
#pragma unroll 1
    for (int j = 0; j <= last; ++j) {
        asm volatile("s_waitcnt vmcnt(%0)" :: "n"((DD - 2) * NDMA) : "memory");
        __builtin_amdgcn_s_barrier();
        issue(j + DD);
        if (j <= qt) {
            const lu8* sl = ring + (j & 3) * TB + lane * 16;
            if (j + 1 <= qt) {
                const lu8* sn = ring + ((j + 1) & 3) * TB + lane * 16;
#pragma unroll
                for (int mp = 0; mp < NMAP; ++mp) { Sn[mp] = (f32x16){};
#pragma unroll
                    for (int ks = 0; ks < NKS; ++ks) Sn[mp] = mfma32(*(const LAS h16x8*)(sn + (mp * NKS + ks) * 1024), qf[mp * NKS + ks], Sn[mp]); }
            }
            h16x8 vf[4];
#pragma unroll
            for (int f = 0; f < 4; ++f) vf[f] = *(const LAS h16x8*)(sl + (NQK + f) * 1024);
            const int D0 = (qt - j) * 32;
            if (BR == 0) {
                if (D0 == 0) {
#pragma unroll
                    for (int r = 0; r < 16; ++r) S[0][r] = (CROW(r) + 4 * h > q) ? -3e38f : S[0][r];
                }
            } else if (D0 < 192) {
                const lf32* tp = nearR + (223 - D0 - q + 4 * h);
#pragma unroll
                for (int r = 0; r < 16; ++r) { const float bv = tp[CROW(r)];
#pragma unroll
                    for (int mp = 0; mp < NMAP; ++mp) S[mp][r] += bv; }
            } else {
                int blo = 23, bhi = 23;
#pragma unroll
                for (int jj = 8; jj < 16; ++jj) { blo += (D0 - 31 >= kBucketStart[jj]) ? 1 : 0; bhi += (D0 + 31 >= kBucketStart[jj]) ? 1 : 0; }
                const float lo = biasL[blo], hi = biasL[bhi];
                if (blo == bhi) {
#pragma unroll
                    for (int mp = 0; mp < NMAP; ++mp) S[mp] += lo;
                } else {
                    const int x = D0 + q - 4 * h - kBucketStart[bhi - 16];
#pragma unroll
                    for (int r = 0; r < 16; ++r) { const float bv = (x >= CROW(r)) ? hi : lo;
#pragma unroll
                        for (int mp = 0; mp < NMAP; ++mp) S[mp][r] += bv; }
                }
            }
            if (BR == 1) {
                const unsigned mw = *(const LAS unsigned*)(mring + ((j & 3) * 8 + wv) * 256 + lane * 4) >> (4 * h);
#pragma unroll
                for (int r = 0; r < 16; ++r) S[0][r] = ((mw >> CROW(r)) & 1u) ? S[0][r] : -3e38f;
            }
#pragma unroll
            for (int mp = 0; mp < NMAP; ++mp) {
                softmax_tile(S[mp], m[mp], l[mp], O[mp][0], O[mp][1]);
                const h16x8 p0 = pack8(S[mp], 0), p1 = pack8(S[mp], 1);
                O[mp][0] = mfma32(vf[0], p0, O[mp][0]); O[mp][0] = mfma32(vf[1], p1, O[mp][0]);
                O[mp][1] = mfma32(vf[2], p0, O[mp][1]); O[mp][1] = mfma32(vf[3], p1, O[mp][1]);
            }
#pragma unroll
            for (int mp = 0; mp < NMAP; ++mp) S[mp] = Sn[mp];
        }
    }
    asm volatile("s_waitcnt vmcnt(0)" ::: "memory");
    f32x16 R0, R1;
    if (NMAP == 2) {
        const float lam = *(const lf32*)(lds + L_LAM);
        const float i0 = 1.f / xh_sum(l[0]), i1 = lam / xh_sum(l[NMAP - 1]);
        R0 = O[0][0] * i0 - O[NMAP - 1][0] * i1; R1 = O[0][1] * i0 - O[NMAP - 1][1] * i1;
        float ss = 0.f;
#pragma unroll
        for (int r = 0; r < 16; ++r) ss += R0[r] * R0[r] + R1[r] * R1[r];
        ss = xh_sum(ss);
        const float rs = rsqrtf(ss * (1.f / 64.f) + EPS) * (1.f - lambda_init);
        R0 *= rs; R1 *= rs;
    } else {
        const float il = 1.f / xh_sum(l[0]);
        R0 = O[0][0] * il; R1 = O[0][1] * il;
    }
    const gh16* gp = gate + tokq * 1024 + mixcol + hh * 64 + 4 * h;
#pragma unroll
    for (int db = 0; db < 2; ++db)
#pragma unroll
        for (int g = 0; g < 4; ++g) {
            const h16x4 gv = *(const GAS h16x4*)(gp + db * 32 + 8 * g); h16x4 o;
#pragma unroll
            for (int e = 0; e < 4; ++e) { float v = (db ? R1[4 * g + e] : R0[4 * g + e]) * (float)gv[e];
                if (NMAP == 2) v *= subln[db * 32 + 8 * g + 4 * h + e];
                o[e] = (h16)v; }
            *(GAS h16x4*)(mix + mixf_off(tokq, mixcol + hh * 64 + db * 32 + 8 * g + 4 * h)) = o;
        }
}

constexpr int L_RING2 = 41984, L_MRING2 = L_RING2 + 8 * 10240, L_WQ2 = L_MRING2 + 8 * 8 * 256;
template <int BR>
DEVI void flashWG2_item(int b, int hh, int Qb, const gh16* Q, const gh16* KF, const gh16* KRF, const gh16* VF, const gu32* mask, lu8* lds,
                        const gf32* subln, float lambda_init, const gh16* gate, gh16* mix, int mixcol, int hb) {
    constexpr int NMAP = BR == 2 ? 2 : 1, NQK = BR == 0 ? 6 : 4, NKS = NQK / NMAP, NP = NQK + 4, TB = NP * 1024;
    const int tid = otid(), lane = tid & 63, q = lane & 31, h = lane >> 5, wv = __builtin_amdgcn_readfirstlane(tid >> 6);
    const int qt = 8 * Qb + wv, NS = 2 * Qb + 2, bh = b * 4 + hh;
    const size_t tokq = (size_t)b * SEQ + qt * 32 + q;
    h16x8 qf[NQK];
#pragma unroll
    for (int ks = 0; ks < NQK; ++ks) qf[ks] = *(const GAS h16x8*)(Q + tokq * (BR == 0 ? 384 : 256) + hh * (BR == 0 ? 96 : 64) + ks * 16 + 8 * h);
    f32x16 O[NMAP][2]; float m[NMAP], l[NMAP];
#pragma unroll
    for (int mp = 0; mp < NMAP; ++mp) { O[mp][0] = (f32x16){}; O[mp][1] = (f32x16){}; m[mp] = -1e30f; l[mp] = 0.f; }
    lu8* ring = lds + L_RING2; lu8* mring = lds + L_MRING2;
    auto issue = [&](int st) {
#pragma unroll
        for (int u = 0; u < (4 * NP + 7) / 8; ++u) {
            const int id = wv + 8 * u;
            if (id < 4 * NP) {
                const int ti = id / NP, pc = id % NP, jt = 4 * st + ti, slot = jt & 7;
                const gh16* src = pc < 4 ? KF + ((size_t)bh * 64 + jt) * 2048 + pc * 512
                                : (BR == 0 && pc < 6) ? KRF + ((size_t)b * 64 + jt) * 1024 + (pc - 4) * 512
                                : VF + ((size_t)bh * 64 + jt) * 2048 + (pc - NQK) * 512;
                __builtin_amdgcn_global_load_lds((const GAS unsigned*)(src + lane * 8), (LAS unsigned*)(ring + slot * TB + pc * 1024), 16, 0, 0);
            }
        }
        if (BR == 1) {
#pragma unroll
            for (int ti = 0; ti < 4; ++ti) { const int jt = 4 * st + ti;
                __builtin_amdgcn_global_load_lds((const GAS unsigned*)(mask + tokq * 64 + (jt <= qt ? jt : qt)), (LAS unsigned*)(mring + ((jt & 7) * 8 + wv) * 256), 4, 0, 0); }
        }
    };
    asm volatile("s_waitcnt vmcnt(0)" ::: "memory");
    __syncthreads();
    issue(0);
    const lf32* nearR = (const lf32*)(lds + L_NEAR) + hb * 256;
    const lf32* biasL = (const lf32*)(lds + L_BIASL) + hb * 32;
#pragma unroll 1
    for (int st = 0; st < NS; ++st) {
        asm volatile("s_waitcnt vmcnt(0)" ::: "memory");
        __builtin_amdgcn_s_barrier();
        if (st + 1 < NS) issue(st + 1);
#pragma unroll 1
        for (int j = 4 * st; j < 4 * st + 4; ++j) {
            if (j > qt) break;
            const lu8* sl = ring + (j & 7) * TB + lane * 16;
            f32x16 S[NMAP];
#pragma unroll
            for (int mp = 0; mp < NMAP; ++mp) { S[mp] = (f32x16){};
#pragma unroll
                for (int ks = 0; ks < NKS; ++ks) S[mp] = mfma32(*(const LAS h16x8*)(sl + (mp * NKS + ks) * 1024), qf[mp * NKS + ks], S[mp]); }
            h16x8 vf[4];
#pragma unroll
            for (int f = 0; f < 4; ++f) vf[f] = *(const LAS h16x8*)(sl + (NQK + f) * 1024);
            const int D0 = (qt - j) * 32;
            if (BR == 0) {
                if (D0 == 0) {
#pragma unroll
                    for (int r = 0; r < 16; ++r) S[0][r] = (CROW(r) + 4 * h > q) ? -3e38f : S[0][r];
                }
            } else if (D0 < 192) {
                const lf32* tp = nearR + (223 - D0 - q + 4 * h);
#pragma unroll
                for (int r = 0; r < 16; ++r) { const float bv = tp[CROW(r)];
#pragma unroll
                    for (int mp = 0; mp < NMAP; ++mp) S[mp][r] += bv; }
            } else {
                const int blo = far_bucket(D0 - 31), bhi = far_bucket(D0 + 31);
                const float lo = biasL[blo], hi = biasL[bhi];
                if (blo == bhi) {
#pragma unroll
                    for (int mp = 0; mp < NMAP; ++mp) S[mp] += lo;
                } else {
                    const int x = D0 + q - 4 * h - far_start(bhi);
#pragma unroll
                    for (int r = 0; r < 16; ++r) { const float bv = (x >= CROW(r)) ? hi : lo;
#pragma unroll
                        for (int mp = 0; mp < NMAP; ++mp) S[mp][r] += bv; }
                }
            }
            if (BR == 1) {
                const unsigned mw = *(const LAS unsigned*)(mring + ((j & 7) * 8 + wv) * 256 + lane * 4) >> (4 * h);
#pragma unroll
                for (int r = 0; r < 16; ++r) S[0][r] = ((mw >> CROW(r)) & 1u) ? S[0][r] : -3e38f;
            }
#pragma unroll
            for (int mp = 0; mp < NMAP; ++mp) {
                softmax_tile(S[mp], m[mp], l[mp], O[mp][0], O[mp][1]);
                const h16x8 p0 = pack8(S[mp], 0), p1 = pack8(S[mp], 1);
                O[mp][0] = mfma32(vf[0], p0, O[mp][0]); O[mp][0] = mfma32(vf[1], p1, O[mp][0]);
                O[mp][1] = mfma32(vf[2], p0, O[mp][1]); O[mp][1] = mfma32(vf[3], p1, O[mp][1]);
            }
        }
    }
    asm volatile("s_waitcnt vmcnt(0)" ::: "memory");
    f32x16 R0, R1;
    if (NMAP == 2) {
        const float lam = *(const lf32*)(lds + L_LAM);
        const float i0 = 1.f / xh_sum(l[0]), i1 = lam / xh_sum(l[NMAP - 1]);
        R0 = O[0][0] * i0 - O[NMAP - 1][0] * i1; R1 = O[0][1] * i0 - O[NMAP - 1][1] * i1;
        float ss = 0.f;
#pragma unroll
        for (int r = 0; r < 16; ++r) ss += R0[r] * R0[r] + R1[r] * R1[r];
        ss = xh_sum(ss);
        const float rs = rsqrtf(ss * (1.f / 64.f) + EPS) * (1.f - lambda_init);
        R0 *= rs; R1 *= rs;
    } else {
        const float il = 1.f / xh_sum(l[0]);
        R0 = O[0][0] * il; R1 = O[0][1] * il;
    }
    const gh16* gp = gate + tokq * 1024 + mixcol + hh * 64 + 4 * h;
#pragma unroll
    for (int db = 0; db < 2; ++db)
#pragma unroll
        for (int g = 0; g < 4; ++g) {
            const h16x4 gv = *(const GAS h16x4*)(gp + db * 32 + 8 * g); h16x4 o;
#pragma unroll
            for (int e = 0; e < 4; ++e) { float v = (db ? R1[4 * g + e] : R0[4 * g + e]) * (float)gv[e];
                if (NMAP == 2) v *= subln[db * 32 + 8 * g + 4 * h + e];
                o[e] = (h16)v; }
            *(GAS h16x4*)(mix + mixf_off(tokq, mixcol + hh * 64 + db * 32 + 8 * g + 4 * h)) = o;
        }
}


DEVI void probe_item(int ntile, int mode) {
    const int lane = otid() & 63;
    h16x8 a, bq;
#pragma unroll
    for (int e = 0; e < 8; ++e) { a[e] = (h16)(lane * 0.001f + e); bq[e] = (h16)(e * 0.01f); }
    f32x16 O0 = {}, O1 = {}; float m = -1e30f, l = 0.f;
#pragma unroll 1
    for (int j = 0; j < ntile; ++j) {
        f32x16 S = {};
#pragma unroll
        for (int ks = 0; ks < 6; ++ks) S = mfma32(a, bq, S);
        if (mode >= 1) softmax_tile(S, m, l, O0, O1);
        const h16x8 p0 = pack8(S, 0), p1 = pack8(S, 1);
        O0 = mfma32(a, p0, O0); O0 = mfma32(a, p1, O0);
        O1 = mfma32(a, p0, O1); O1 = mfma32(a, p1, O1);
    }
    asm volatile("" :: "v"(O0), "v"(O1), "v"(l));
}
DEVI void flashB_tile(const h16x8 (&qf)[4], const gh16* kfr, const gh16* vfr, const lf32* tp, f32x16& O0, f32x16& O1, float& m, float& l, int hot) {
    h16x8 vf[4], kf[4];
#pragma unroll
    for (int f = 0; f < 4; ++f) { kf[f] = *(const GAS h16x8*)(kfr + f * 512); vf[f] = *(const GAS h16x8*)(vfr + f * 512); }
    f32x16 S = {};
#pragma unroll
    for (int ks = 0; ks < 4; ++ks) S = mfma32(kf[ks], qf[ks], S);
    if (hot < 3) {
#pragma unroll
    for (int r = 0; r < 16; ++r) S[r] += tp[CROW(r)];
    }
    softmax_tile_h(S, m, l, O0, O1, hot);
    const h16x8 p0 = pack8(S, 0), p1 = pack8(S, 1);
    if (hot < 4) {
    O0 = mfma32(vf[0], p0, O0); O0 = mfma32(vf[1], p1, O0);
    O1 = mfma32(vf[2], p0, O1); O1 = mfma32(vf[3], p1, O1);
    } else { O0[0] += (float)p0[0] + (float)p1[0]; }
}
DEVI void flashB_item(int b, int hh, int r, int qg, const gh16* Q, const gh16* KF, const gh16* VF, const lu8* lds, const gh16* gate, gh16* mix, int hot = 0) {
    const int lane = otid() & 63, q = lane & 31, h = lane >> 5, bh = b * 4 + hh;
    const size_t tokq = (size_t)b * SEQ + qg * 512 + 16 * q + r;
    h16x8 qf[4];
#pragma unroll
    for (int ks = 0; ks < 4; ++ks) qf[ks] = *(const GAS h16x8*)(Q + tokq * 256 + hh * 64 + ks * 16 + 8 * h);
    f32x16 O0 = {}, O1 = {}; float m = -1e30f, l = 0.f;
    {
        const lf32* R3 = (const lf32*)(lds + L_R3) + hh * 192;
        const size_t base = 2 * FSZ + ((size_t)bh * 16 + r) * 4 * 2048 + lane * 8;
        for (int tl = (qg >= 4 ? qg - 4 : 0); tl <= qg; ++tl) {
            const int c = qg * 32 + q - tl * 32;
            flashB_tile(qf, KF + base + (size_t)(hot ? 0 : tl) * 2048, VF + base + (size_t)(hot ? 0 : tl) * 2048, R3 + (159 - c + 4 * h), O0, O1, m, l, hot);
        }
    }
    {
        const lf32* R2 = (const lf32*)(lds + L_R2) + hh * 384;
        const size_t base = FSZ + ((size_t)bh * 4 + (r & 3)) * 16 * 2048 + lane * 8;
        for (int tl = (qg >= 1 ? qg * 4 - 4 : 0); tl <= qg * 4 + 3; ++tl) {
            const int c = qg * 128 + 4 * q + (r >> 2) - tl * 32;
            flashB_tile(qf, KF + base + (size_t)(hot ? 0 : tl) * 2048, VF + base + (size_t)(hot ? 0 : tl) * 2048, R2 + (255 - c + 4 * h), O0, O1, m, l, hot);
        }
    }
    {
        const lf32* R1 = (const lf32*)(lds + L_R1) + hh * 1152;
        const size_t base = (size_t)bh * 64 * 2048 + lane * 8;
        for (int tl = (qg >= 1 ? qg * 16 - 4 : 0); tl <= qg * 16 + 15; ++tl) {
            const int c = qg * 512 + 16 * q + r - tl * 32;
            flashB_tile(qf, KF + base + (size_t)(hot ? 0 : tl) * 2048, VF + base + (size_t)(hot ? 0 : tl) * 2048, R1 + (639 - c + 4 * h), O0, O1, m, l, hot);
        }
    }
    const float il = 1.f / xh_sum(l);
    const gh16* gp = gate + tokq * 1024 + 256 + hh * 64 + 4 * h;
#pragma unroll
    for (int db = 0; db < 2; ++db)
#pragma unroll
        for (int g = 0; g < 4; ++g) {
            const h16x4 gv = *(const GAS h16x4*)(gp + db * 32 + 8 * g); h16x4 o;
#pragma unroll
            for (int e = 0; e < 4; ++e) o[e] = (h16)((db ? O1[4 * g + e] : O0[4 * g + e]) * il * (float)gv[e]);
            if (!hot) *(GAS h16x4*)(mix + mixf_off(tokq, 256 + hh * 64 + db * 32 + 8 * g + 4 * h)) = o; else asm volatile("" :: "v"(o));
        }
}

typedef float f32x4v __attribute__((ext_vector_type(4)));
typedef unsigned u32x4v __attribute__((ext_vector_type(4)));
DEVI f32x4v mfma16(h16x8 a, h16x8 b, f32x4v c) { return __builtin_amdgcn_mfma_f32_16x16x32_f16(a, b, c, 0, 0, 0); }
constexpr int TK_KSTRIDE = 2308;
constexpr int TK_KEYS = 0, TK_MISC = 16 * TK_KSTRIDE * 4, TK_END = TK_MISC + 64;
DEVI void topk_item(int b, int T16, const gh16* idx, const gh16* KIF, gu32* mask, lu8* lds, int skip = 0) {
    const int tid = otid(), lane = tid & 63, wv = __builtin_amdgcn_readfirstlane(tid >> 6);
    const int t0 = T16 * 16;
    lu32* keys = (lu32*)(lds + TK_KEYS);
    if (T16 < 16) {
        const int sq = tid & 15, sc_ = tid >> 4;
        const unsigned tk = (unsigned)(b * SEQ + t0 + sq) * 64u + 2u * sc_;
        unsigned ones = 0xffffffffu; asm volatile("" : "+v"(ones));
        if (sc_ < 4) { mask[tk] = ones; mask[tk + 1] = ones; }
        return;
    }
    __syncthreads();
    if (skip == 2) return;
    {
        const int q = lane & 15, kq = lane >> 4;
        const size_t tokq = (size_t)b * SEQ + t0 + q;
        h16x8 qf[8], ql; float sg[8]; float P = 0.f, N = 0.f; float lin[8];
#pragma unroll
        for (int e = 0; e < 8; ++e) lin[e] = 0.f;
#pragma unroll
        for (int hd = 0; hd < 8; ++hd) {
            const h16x8 raw = *(const GAS h16x8*)(idx + tokq * 320 + hd * 32 + 8 * kq);
            const float c = (float)idx[tokq * 320 + 288 + hd] * (0.5f * 0.35355339059327373f), ac = fabsf(c);
            float nn = 0.f;
#pragma unroll
            for (int e = 0; e < 8; ++e) { const float v = (float)raw[e]; nn += v * v; lin[e] += c * v; qf[hd][e] = (h16)(ac * v); }
            nn += __shfl_xor(nn, 16); nn += __shfl_xor(nn, 32);
            const float bd = 2.f * ac * sqrtf(nn) * 12.f;
            if (c > 0.f) P += bd; else N += bd;
            sg[hd] = c >= 0.f ? 1.f : -1.f;
        }
#pragma unroll
        for (int e = 0; e < 8; ++e) ql[e] = (h16)lin[e];
        const float lo = -N, scl = 2097151.f / fmaxf(P + N, 1e-20f);
        const int nblk = T16 + 1, nblk2 = (nblk + 1) & ~1;
#pragma unroll 1
        for (int rpS = 0; rpS < (DUP_PHASE == 7 ? 2 : 1); ++rpS)
        for (int kb0 = wv; kb0 < nblk2; kb0 += 32) {
            h16x8 kf4[4];
#pragma unroll
            for (int u = 0; u < 4; ++u) { const int kb = kb0 + 8 * u < nblk ? kb0 + 8 * u : 0; kf4[u] = *(const GAS h16x8*)(KIF + ((size_t)(b * 128 + kb) * 64 + lane) * 8); }
#pragma unroll
            for (int u = 0; u < 4; ++u) {
                const int kb = kb0 + 8 * u;
                if (kb < nblk2) {
                    const h16x8 kf = kf4[u];
                    f32x4v sc = mfma16(kf, ql, (f32x4v){0.f, 0.f, 0.f, 0.f});
#pragma unroll
                    for (int hd = 0; hd < 8; ++hd) { const f32x4v x = mfma16(kf, qf[hd], (f32x4v){0.f, 0.f, 0.f, 0.f});
#pragma unroll
                        for (int r = 0; r < 4; ++r) sc[r] = __builtin_fmaf(__builtin_fabsf(x[r]), sg[hd], sc[r]); }
                    u32x4v kv;
#pragma unroll
                    for (int r = 0; r < 4; ++r) { const float x = fminf(fmaxf((sc[r] - lo) * scl, 0.f), 2097151.f); unsigned uu = (unsigned)x + 1u;
                        if (16 * kb + 4 * kq + r > t0 + q) uu = 0u; kv[r] = uu; }
                    const int k = 16 * kb + 4 * kq;
                    *(LAS u32x4v*)(keys + q * TK_KSTRIDE + k + 4 * (k >> 5)) = kv;
                }
            }
        }
    }
    __syncthreads();
    if (skip == 1) return;
    const int nw32 = (t0 + 16 + 31) >> 5;
    unsigned ka[32], kc[32];
    {
        const lu32* ra = keys + (2 * wv) * TK_KSTRIDE + 36 * lane, * rc = keys + (2 * wv + 1) * TK_KSTRIDE + 36 * lane;
        const bool have = lane < nw32;
#pragma unroll
        for (int i = 0; i < 8; ++i) {
            u32x4v va = {0u, 0u, 0u, 0u}, vc = {0u, 0u, 0u, 0u};
            if (have) { va = *(const LAS u32x4v*)(ra + 4 * i); vc = *(const LAS u32x4v*)(rc + 4 * i); }
#pragma unroll
            for (int r = 0; r < 4; ++r) { ka[4 * i + r] = va[r]; kc[4 * i + r] = vc[r]; }
        }
    }
    typedef unsigned short u16x2 __attribute__((ext_vector_type(2)));
    unsigned Tq[2];
#pragma unroll
    for (int qq = 0; qq < 2; ++qq) {
        u16x2 kh[16];
#pragma unroll
        for (int i = 0; i < 16; ++i) { const unsigned k0 = qq ? kc[2 * i] : ka[2 * i], k1 = qq ? kc[2 * i + 1] : ka[2 * i + 1]; kh[i] = (u16x2){(unsigned short)(k0 >> 7), (unsigned short)(k1 >> 7)}; }
        auto count_ge = [&](unsigned P15) -> int {
            const unsigned short pm1 = (unsigned short)(P15 - 1u);
            u16x2 acc = {0, 0};
#pragma unroll
            for (int i = 0; i < 16; ++i) { const u16x2 t = (u16x2){pm1, pm1} - kh[i]; acc += t >> 15; }
            const unsigned lc = (unsigned)acc[0] + (unsigned)acc[1];
            int c = 0;
#pragma unroll
            for (int bp = 0; bp < 6; ++bp) c += __builtin_popcountll(__ballot((lc >> bp) & 1u)) << bp;
            return c;
        };
        unsigned T15 = 0u;
#pragma unroll 1
        for (int bit = 14; bit >= 0; --bit) { const unsigned P = T15 | (1u << bit); if (count_ge(P) >= 256) T15 = P; }
        const int above = T15 < 32767u ? count_ge(T15 + 1u) : 0;
        unsigned c0 = 0u, c1 = 0u, nc = 0u;
#pragma unroll
        for (int i = 0; i < 32; ++i) { const unsigned k = qq ? kc[i] : ka[i]; const bool is = (k >> 7) == T15 && k != 0u; const unsigned v = (k & 127u) + 1u;
            c1 = (is && nc == 1u) ? v : c1; c0 = (is && nc == 0u) ? v : c0; nc += is ? 1u : 0u; }
        unsigned low = 0u;
        if (__ballot(nc > 2u) == 0ull) {
#pragma unroll 1
            for (int bit = 6; bit >= 0; --bit) { const unsigned P = low | (1u << bit);
                const unsigned lc = (c0 > P ? 1u : 0u) + (c1 > P ? 1u : 0u);
                const int c = above + __builtin_popcountll(__ballot(lc & 1u)) + 2 * __builtin_popcountll(__ballot(lc >> 1));
                if (c >= 256) low = P; }
        } else {
#pragma unroll 1
            for (int bit = 6; bit >= 0; --bit) { const unsigned P = (T15 << 7) | low | (1u << bit);
                unsigned lc = 0u;
#pragma unroll
                for (int i = 0; i < 32; ++i) lc += ((qq ? kc[i] : ka[i]) >= P) ? 1u : 0u;
                int c = 0;
#pragma unroll
                for (int bp = 0; bp < 6; ++bp) c += __builtin_popcountll(__ballot((lc >> bp) & 1u)) << bp;
                if (c >= 256) low |= (1u << bit); }
        }
        Tq[qq] = (T15 << 7) | low;
    }
    const unsigned Ta = Tq[0], Tc = Tq[1];
#pragma unroll
    for (int qq = 0; qq < 2; ++qq) {
        const unsigned T = qq ? Tc : Ta;
        unsigned gt = 0u, eq = 0u;
#pragma unroll
        for (int i = 31; i >= 0; --i) { const unsigned k = qq ? kc[i] : ka[i]; gt = (gt << 1) | (k > T ? 1u : 0u); eq = (eq << 1) | (k == T ? 1u : 0u); }
        const unsigned pcg = (unsigned)__builtin_popcount(gt), pce = (unsigned)__builtin_popcount(eq);
        int totg = 0, before = 0;
#pragma unroll
        for (int bp = 0; bp < 6; ++bp) {
            totg += __builtin_popcountll(__ballot((pcg >> bp) & 1u)) << bp;
            const unsigned long long mk = __ballot((pce >> bp) & 1u);
            before += (int)__builtin_amdgcn_mbcnt_hi((unsigned)(mk >> 32), __builtin_amdgcn_mbcnt_lo((unsigned)mk, 0u)) << bp;
        }
        const int R = 256 - totg;
        int allow = R - before; allow = allow < 0 ? 0 : (allow > pce ? pce : allow);
        unsigned keep = eq;
        if (allow < pce) { keep = 0u; unsigned e = eq; for (int c = 0; c < allow; ++c) { const unsigned bit = e & (0u - e); keep |= bit; e ^= bit; } }
        if (lane < nw32) mask[((size_t)b * SEQ + t0 + 2 * wv + qq) * 64 + lane] = gt | keep;
    }
}
DEVI void ph_topk(const gh16* idx, const gh16* KIF, gu32* mask, gu32* ctr, lu8* lds, int nrep) {
    lu32* slot = (lu32*)(lds + TK_MISC);
    const bool lead = otid() == 0;
    __syncthreads();
    if (lead) *slot = __hip_atomic_fetch_add(ctr, 1u, __ATOMIC_RELAXED, __HIP_MEMORY_SCOPE_AGENT);
    __syncthreads();
    int e = (int)*slot;
#pragma unroll 1
    while (e < 1024 * nrep) {
        unsigned nxt = 0u;
        if (lead) nxt = __hip_atomic_fetch_add(ctr, 1u, __ATOMIC_RELAXED, __HIP_MEMORY_SCOPE_AGENT);
        const int e2 = e & 1023;
        topk_item(e2 & 7, 127 - (e2 >> 3), idx, KIF, mask, lds, (DUP_PHASE >= 30 && e >= 1024) ? DUP_PHASE - 29 : 0);
        __syncthreads();
        if (lead) *slot = nxt;
        __syncthreads();
        e = (int)*slot;
    }
}

DEVI void ph_out(const gh16* mix, const gh16* WoT, const gf32* __restrict__ gpost, const gf32* h_in, gf32* h_out, gh16* h16o, gf32* rstd_next, bool write_next, lu8* lds) {
    const int tid = otid(), lane = tid & 63, q = lane & 31, h = lane >> 5, wv = __builtin_amdgcn_readfirstlane(tid >> 6);
    lf32* red = (lf32*)lds;
    for (int u = blockIdx.x; u < NT / 64; u += gridDim.x) {
        f32x16 acc[4][2];
#pragma unroll
        for (int rb = 0; rb < 4; ++rb) { acc[rb][0] = (f32x16){}; acc[rb][1] = (f32x16){}; }
        const gh16* apu = WoT + (size_t)(wv * 4) * 64 * 512;
        const gh16* bpu = mix + (size_t)(u * 2) * 64 * 512;
        const unsigned lo8 = lane * 8;
#define ap(off) (apu + (off) + lo8)
#define bp(off) (bpu + (off) + lo8)
        h16x8 a0[4], b0[2], a1[4], b1[2], a2[4], b2[2];
#define P3_LOAD(A, B, ks_) do { const int ko_ = ((ks_) < 64 ? (ks_) : 63) * 512; _Pragma("unroll") for (int rb = 0; rb < 4; ++rb) A[rb] = *(const GAS h16x8*)(ap(rb * 64 * 512 + ko_)); \
        _Pragma("unroll") for (int tb = 0; tb < 2; ++tb) B[tb] = *(const GAS h16x8*)(bp(tb * 64 * 512 + ko_)); } while (0)
#define P3_MMA(A, B) do { _Pragma("unroll") for (int rb = 0; rb < 4; ++rb) _Pragma("unroll") for (int tb = 0; tb < 2; ++tb) acc[rb][tb] = mfma32(A[rb], B[tb], acc[rb][tb]); } while (0)
        P3_LOAD(a0, b0, 0); P3_LOAD(a1, b1, 1);
#pragma unroll 1
        for (int ks = 0; ks < 63; ks += 3) {
            P3_LOAD(a2, b2, ks + 2); __builtin_amdgcn_sched_barrier(0); P3_MMA(a0, b0); __builtin_amdgcn_sched_barrier(0);
            P3_LOAD(a0, b0, ks + 3); __builtin_amdgcn_sched_barrier(0); P3_MMA(a1, b1); __builtin_amdgcn_sched_barrier(0);
            P3_LOAD(a1, b1, ks + 4); __builtin_amdgcn_sched_barrier(0); P3_MMA(a2, b2); __builtin_amdgcn_sched_barrier(0);
        }
        P3_MMA(a0, b0);
#undef P3_LOAD
#undef P3_MMA
#undef ap
#undef bp
        int qe = q, he = h; asm volatile("" : "+v"(qe), "+v"(he));
        __syncthreads();
#pragma unroll
        for (int tb = 0; tb < 2; ++tb) {
            float ss = 0.f;
#pragma unroll
            for (int rb = 0; rb < 4; ++rb)
#pragma unroll
                for (int r = 0; r < 16; ++r) ss += acc[rb][tb][r] * acc[rb][tb][r];
            ss = xh_sum(ss);
            if (he == 0) red[wv * 64 + tb * 32 + qe] = ss;
        }
        __syncthreads();
        float ssn[2] = {0.f, 0.f};
#pragma unroll
        for (int tb = 0; tb < 2; ++tb) {
            float tot = 0.f;
#pragma unroll
            for (int w2 = 0; w2 < 8; ++w2) tot += red[w2 * 64 + tb * 32 + qe];
            const float rs = rsqrtf(tot * (1.f / DM) + EPS);
            const size_t rowoff = (size_t)(u * 64 + tb * 32 + qe) * DM;
#pragma unroll
            for (int rb = 0; rb < 4; ++rb)
#pragma unroll
                for (int g = 0; g < 4; ++g) {
                    const int n = wv * 128 + rb * 32 + 8 * g + 4 * he;
                    const f32x4_t hv = *(const GAS f32x4_t*)(h_in + rowoff + n), gv = *(const GAS f32x4_t*)(gpost + n);
                    f32x4_t o;
                    o[0] = hv[0] + acc[rb][tb][4 * g + 0] * rs * gv[0]; o[1] = hv[1] + acc[rb][tb][4 * g + 1] * rs * gv[1];
                    o[2] = hv[2] + acc[rb][tb][4 * g + 2] * rs * gv[2]; o[3] = hv[3] + acc[rb][tb][4 * g + 3] * rs * gv[3];
                    *(GAS f32x4_t*)(h_out + rowoff + n) = o;
                    if (write_next) { h16x4 oh; oh[0] = (h16)o[0]; oh[1] = (h16)o[1]; oh[2] = (h16)o[2]; oh[3] = (h16)o[3]; *(GAS h16x4*)(h16o + rowoff + n) = oh;
                        ssn[tb] += o[0] * o[0] + o[1] * o[1] + o[2] * o[2] + o[3] * o[3]; }
                }
        }
        if (write_next) {
#pragma unroll
            for (int tb = 0; tb < 2; ++tb) { const float v = xh_sum(ssn[tb]); if (he == 0) red[512 + wv * 64 + tb * 32 + qe] = v; }
            __syncthreads();
            if (tid < 64) { float tot = 0.f;
#pragma unroll
                for (int w2 = 0; w2 < 8; ++w2) tot += red[512 + w2 * 64 + tid];
                rstd_next[u * 64 + tid] = rsqrtf(tot * (1.f / DM) + EPS); }
        }
    }
}

DEVI void mla_item(int it, const gh16* cA, const gh16* WuqT, const gh16* WukvT, const gf32* cosT, const gf32* sinT, gh16* qA, gh16* KFA, gh16* KRF, gh16* VFA) {
    const int lane = otid() & 63, q = lane & 31, h = lane >> 5;
    const size_t tok = (size_t)it * 32 + q; const int b = it >> 6, j = it & 63, s = j * 32 + q;
    const float qs = 0.10206207261596577f * LOG2E;
    {
        h16x8 cf[12]; float ss = 0.f;
#pragma unroll
        for (int ks = 0; ks < 12; ++ks) { cf[ks] = *(const GAS h16x8*)(cA + tok * 384 + ks * 16 + 8 * h);
#pragma unroll
            for (int e = 0; e < 8; ++e) { const float v = (float)cf[ks][e]; ss += v * v; } }
        const float rs = rsqrtf(xh_sum(ss) * (1.f / 192.f) + EPS) * qs;
#pragma unroll 1
        for (int nb = 0; nb < 12; ++nb) {
            f32x16 acc = {};
            const gh16* wp = WuqT + (size_t)nb * 12 * 512 + lane * 8;
#pragma unroll
            for (int ks = 0; ks < 12; ++ks) acc = mfma32(*(const GAS h16x8*)(wp + ks * 512), cf[ks], acc);
            acc *= rs;
            const int hh = nb / 3, part = nb % 3;
            if (part == 2) {
#pragma unroll
                for (int r = 0; r < 8; ++r) { const int i = CROW(r) + 4 * h; const float c = cosT[s * 16 + i], sn = sinT[s * 16 + i], x1 = acc[r], x2 = acc[r + 8];
                    acc[r] = x1 * c - x2 * sn; acc[r + 8] = x1 * sn + x2 * c; }
            }
            gh16* op = qA + tok * 384 + hh * 96 + part * 32 + 4 * h;
#pragma unroll
            for (int g = 0; g < 4; ++g) { h16x4 o; o[0] = (h16)acc[4 * g]; o[1] = (h16)acc[4 * g + 1]; o[2] = (h16)acc[4 * g + 2]; o[3] = (h16)acc[4 * g + 3]; *(GAS h16x4*)(op + 8 * g) = o; }
        }
    }
    {
        h16x8 cf[8]; float ss = 0.f;
#pragma unroll
        for (int ks = 0; ks < 8; ++ks) { cf[ks] = *(const GAS h16x8*)(cA + tok * 384 + 192 + ks * 16 + 8 * h);
#pragma unroll
            for (int e = 0; e < 8; ++e) { const float v = (float)cf[ks][e]; ss += v * v; } }
        const float rs = rsqrtf(xh_sum(ss) * (1.f / 128.f) + EPS);
#pragma unroll
        for (int ks = 0; ks < 8; ++ks)
#pragma unroll
            for (int e = 0; e < 8; ++e) cf[ks][e] = (h16)((float)cf[ks][e] * rs);
#pragma unroll 1
        for (int nb = 0; nb < 16; ++nb) {
            const int hh = nb >> 2, sub = nb & 3, bh = b * 4 + hh;
            const gh16* wp = WukvT + (size_t)nb * 8 * 512 + lane * 8;
            f32x16 acc = {};
            if (sub < 2) {
#pragma unroll
                for (int ks = 0; ks < 8; ++ks) acc = mfma32(*(const GAS h16x8*)(wp + ks * 512), cf[ks], acc);
#pragma unroll
                for (int g = 0; g < 4; ++g) { h16x4 o; o[0] = (h16)acc[4 * g]; o[1] = (h16)acc[4 * g + 1]; o[2] = (h16)acc[4 * g + 2]; o[3] = (h16)acc[4 * g + 3];
                    *(GAS h16x4*)(KFA + ((((size_t)bh * 64 + j) * 4 + 2 * sub + (g >> 1)) * 64 + q + 32 * (g & 1)) * 8 + 4 * h) = o; }
            } else {
#pragma unroll
                for (int ks = 0; ks < 8; ++ks) acc = mfma32(cf[ks], *(const GAS h16x8*)(wp + ks * 512), acc);
#pragma unroll
                for (int sk = 0; sk < 2; ++sk) { h16x8 o;
#pragma unroll
                    for (int e = 0; e < 8; ++e) o[e] = (h16)acc[8 * sk + e];
                    *(GAS h16x8*)(VFA + ((((size_t)bh * 64 + j) * 4 + (sub - 2) * 2 + sk) * 64 + lane) * 8) = o; }
            }
        }
    }
    {
        const h16x8 a = *(const GAS h16x8*)(cA + tok * 384 + 320 + 8 * h), c2 = *(const GAS h16x8*)(cA + tok * 384 + 336 + 8 * h);
        h16x8 o1, o2;
#pragma unroll
        for (int e = 0; e < 8; ++e) { const int i = 8 * h + e; const float c = cosT[s * 16 + i], sn = sinT[s * 16 + i], x1 = (float)a[e], x2 = (float)c2[e];
            o1[e] = (h16)(x1 * c - x2 * sn); o2[e] = (h16)(x1 * sn + x2 * c); }
        *(GAS h16x8*)(KRF + (((size_t)b * 64 + j) * 2 + 0) * 512 + lane * 8) = o1; *(GAS h16x8*)(KRF + (((size_t)b * 64 + j) * 2 + 1) * 512 + lane * 8) = o2;
    }
}
DEVI void ph_small_weights(const gf32* w_uq, const gf32* qn, const gf32* w_ukv, const gf32* kvn, gh16* WuqF, gh16* WukvF) {
    const int gt = blockIdx.x * NTHR + otid(), nthr = gridDim.x * NTHR;
    for (int i = gt; i < 2 * 12 * 12 * 64; i += nthr) { const int lane = i & 63, ks = (i >> 6) % 12, nb = (i / (64 * 12)) % 12, l = i / (64 * 144);
        h16x8 o;
#pragma unroll
        for (int e = 0; e < 8; ++e) { const int k = 16 * ks + 8 * (lane >> 5) + e; o[e] = (h16)(w_uq[(size_t)l * 192 * 384 + k * 384 + nb * 32 + (lane & 31)] * qn[l * 192 + k]); }
        *(GAS h16x8*)(WuqF + (size_t)i * 8) = o; }
    for (int i = gt; i < 2 * 16 * 8 * 64; i += nthr) { const int lane = i & 63, ks = (i >> 6) & 7, nb = (i >> 9) & 15, l = i >> 13;
        h16x8 o;
#pragma unroll
        for (int e = 0; e < 8; ++e) { const int k = 16 * ks + 8 * (lane >> 5) + e; o[e] = (h16)(w_ukv[(size_t)l * 128 * 512 + k * 512 + nb * 32 + (lane & 31)] * kvn[l * 128 + k]); }
        *(GAS h16x8*)(WukvF + (size_t)i * 8) = o; }
}

constexpr int LDS_BYTES = 160 * 1024;
struct Params { const float* in[12]; float* out; unsigned char* ws; };

DEVI void ph_tables(const gf32* __restrict__ rel_bias, gf32* biasTab, gf32* cosT, gf32* sinT) {
    for (int i = blockIdx.x * NTHR + threadIdx.x; i < 2048 * 16; i += gridDim.x * NTHR) {
        if (i < 12 * 2048) { int hh = i / 2048, n = i % 2048; biasTab[i] = rel_bias[t5_bucket(n) * 12 + hh] * LOG2E; }
        int pos = i / 16, j = i % 16;
        float inv = (float)pow(10000.0, -(double)(2 * j) / 32.0);
        float ang = (float)pos * inv;
        cosT[i] = (float)cos((double)ang); sinT[i] = (float)sin((double)ang);
    }
}

extern __shared__ __attribute__((aligned(16))) unsigned char smem[];
constexpr int LDS_BAR_OFF = 160 * 1024 - 16;

#define REP(k) for (int rep_ = 0; rep_ < ((DUP_PHASE == (k)) ? 2 : 1); ++rep_)
DEVI gu8* ows(unsigned char* w0) { gu8* w = (gu8*)w0; asm volatile("" : "+s"(w)); return w; }
#define WSP(T, off) ((GAS T*)(w + (off)))
#define GIN(k) ((const gf32*)p.in[k])

__global__ void __launch_bounds__(NTHR, 2) mega(Params p) {
    if (threadIdx.x == 0) *(uint4*)(smem + LDS_BAR_OFF) = make_uint4(0u, 0u, 0u, 0u);
    __syncthreads();
    XcdBarrier bar = xcd_barrier_post((unsigned*)(p.ws + OFF_CTL), (volatile LAS unsigned*)(smem + LDS_BAR_OFF));
    lu8* lds = (lu8*)smem;
    const int nw = gridDim.x * NWAVE;

    REP(1) {
        gu8* w = ows(p.ws);
        ph_tables(GIN(11), WSP(float, OFF_BIAS), WSP(float, OFF_COS), WSP(float, OFF_SIN));
        int base = 0; const int total = 2 * (64 * 16) + 2 * (16 * 16);
        cvt_transpose<true>(GIN(1), INC, GIN(3), WSP(h16, OFF_WINT), MYC, DM, lds, blockIdx.x, total, base);
        cvt_transpose<true>(GIN(1) + (size_t)DM * INC, INC, GIN(3) + DM, WSP(h16, OFF_WINT) + (size_t)MYC * DM, MYC, DM, lds, blockIdx.x, total, base);
        cvt_transpose<false>(GIN(2), DM, nullptr, WSP(h16, OFF_WOUTT), DM, DM, lds, blockIdx.x, total, base);
        cvt_transpose<false>(GIN(2) + (size_t)DM * DM, DM, nullptr, WSP(h16, OFF_WOUTT) + (size_t)DM * DM, DM, DM, lds, blockIdx.x, total, base);
        ph_small_weights(GIN(7), GIN(5), GIN(8), GIN(6), WSP(h16, OFF_WUQT), WSP(h16, OFF_WUKVT));
        ph_rowstat_cvt(GIN(0), WSP(float, OFF_SSQH), WSP(h16, OFF_H16));
    }
    xcd_barrier(bar);
    for (int layer = 0; layer < 2; ++layer) {
        const float lambda_init = layer == 0 ? 0.2f : 0.35550906759f;
        REP(2) {
            if (rep_) xcd_barrier(bar);
            gu8* w = ows(p.ws);
            pg8::Gemm g{(const pg8::bf16_t*)(p.ws + OFF_H16), (const pg8::bf16_t*)(p.ws + OFF_WINT) + (size_t)layer * MYC * DM, NT, MYC, DM};
            int bid_ = (int)blockIdx.x; asm volatile("" : "+s"(bid_));
            pg8::StaticOrder S; S.init(NT, MYC, (int)gridDim.x, bid_);
            EpiRoute E{w, WSP(float, OFF_SSQH)};
            pg8::gemm_phase<EpiRoute, pg8::StaticOrder, true, true>(lds, g, S, E);
        }
        xcd_barrier(bar);
        REP(3) {
            gu8* w = ows(p.ws);
            for (int it = ogw(); it < NT / 32; it += nw) mla_item(it, WSP(h16, OFF_CA), WSP(h16, OFF_WUQT) + (size_t)layer * 384 * 192, WSP(h16, OFF_WUKVT) + (size_t)layer * 512 * 128, WSP(float, OFF_COS), WSP(float, OFF_SIN), WSP(h16, OFF_QA), WSP(h16, OFF_KFA), WSP(h16, OFF_KRF), WSP(h16, OFF_VFA));
        }
        {
            gu8* w = ows(p.ws);
            ph_topk(WSP(h16, OFF_IDX), WSP(h16, OFF_KIF), WSP(unsigned, OFF_MASK), WSP(unsigned, OFF_CTL) + 3600 + 16 * (40 + layer), lds, (DUP_PHASE == 4 || DUP_PHASE >= 30) ? 2 : 1);
        }
        REP(3) {
            gu8* w = ows(p.ws);
            ph_vtrans(WSP(h16, OFF_VTMP), WSP(h16, OFF_VF), lds);
        }
        xcd_barrier(bar);
        for (int rep_ = 0; rep_ < ((DUP_PHASE == 5 || DUP_PHASE >= 10) ? 2 : 1); ++rep_) {
            if (rep_) xcd_barrier(bar);
            const int hot_ = (DUP_PHASE >= 10 && rep_) ? DUP_PHASE - 9 : 0;
            gu8* w = ows(p.ws);
            p2_setup(WSP(float, OFF_BIAS), GIN(9) + layer * 128, lambda_init, lds);
            if (DUP_PHASE >= 20 && rep_) { probe_item(130, DUP_PHASE - 20); continue; }
            const int xcc = (int)(xb_xcc_id() & 7u);
            for (int dq = 0; dq < 8; ++dq) {
                const int bq = (xcc + dq) & 7;
                gu32* ctr = WSP(unsigned, OFF_CTL) + 3600 + 16 * (bq + 8 * layer + 16 * rep_);
                for (;;) { const int e = wq_next(ctr); if (e >= 768) break;
                    if (e < 256) { const int hh = e >> 6, lvl = 63 - (e & 63);
                        flashCD_item<2, false>(bq, hh, lvl, 8 + hh, WSP(h16, OFF_QD), WSP(h16, OFF_KFD), WSP(h16, OFF_VF) + 4 * FSZ, nullptr, WSP(float, OFF_BIAS), lds,
                                               GIN(10) + layer * 64, lambda_init, WSP(h16, OFF_GATE), WSP(h16, OFF_MIX), 768, hot_); }
                    else if (e < 384) { const int e2 = e - 256, hh = e2 >> 5, pr = 31 - (e2 & 31);
                        flashQ2_item<1>(bq, hh, pr, WSP(h16, OFF_QC), WSP(h16, OFF_KFC), nullptr, WSP(h16, OFF_VF) + 3 * FSZ, WSP(unsigned, OFF_MASK), WSP(float, OFF_BIAS), lds, WSP(h16, OFF_GATE), WSP(h16, OFF_MIX), 512, 4 + hh, hot_); }
                    else if (e < 512) { const int e2 = e - 384, hh = e2 >> 5, pr = 31 - (e2 & 31);
                        flashQ2_item<0>(bq, hh, pr, WSP(h16, OFF_QA), WSP(h16, OFF_KFA), WSP(h16, OFF_KRF), WSP(h16, OFF_VFA), nullptr, WSP(float, OFF_BIAS), lds, WSP(h16, OFF_GATE), WSP(h16, OFF_MIX), 0, 0, hot_); }
                    else { const int e2 = e - 512, hh = e2 >> 6, lvl = e2 & 63;
                        flashB_item(bq, hh, lvl & 15, lvl >> 4, WSP(h16, OFF_QB), WSP(h16, OFF_KFB), WSP(h16, OFF_VF), lds, WSP(h16, OFF_GATE), WSP(h16, OFF_MIX), hot_); }
                }
            }
        }
        xcd_barrier(bar);
        for (int rep_ = 0; rep_ < ((DUP_PHASE == 6 && layer == 0) ? 2 : 1); ++rep_) {
            if (rep_) xcd_barrier(bar);
            gu8* w = ows(p.ws);
int bid_ = (int)blockIdx.x; asm volatile("" : "+s"(bid_));
            pg8::Gemm g{(const pg8::bf16_t*)(p.ws + OFF_MIX), (const pg8::bf16_t*)(p.ws + OFF_WOUTT) + (size_t)layer * DM * DM, NT, DM, DM};
            pg8::StaticOrder S; S.init(NT, DM, (int)gridDim.x, bid_);
            EpiOut E{layer == 0 ? GIN(0) : (const gf32*)p.out, (gf32*)p.out, WSP(h16, OFF_H16), GIN(4) + layer * DM, WSP(float, OFF_SSQY), WSP(float, OFF_SSQH), &bar, layer == 0};
            pg8::gemm_phase<EpiOut, pg8::StaticOrder, false, true>(lds, g, S, E);
        }
        xcd_barrier(bar);
    }
}

extern "C" void kernel_launch(void* const* d_in, const int* in_sizes, int n_in, void* d_out, int out_size, void* d_ws, size_t ws_size, hipStream_t stream) {
    static int grid = 0;
    if (grid == 0) {
        int dev = 0, cus = 0, per_cu = 0;
        (void)hipGetDevice(&dev);
        (void)hipDeviceGetAttribute(&cus, hipDeviceAttributeMultiprocessorCount, dev);
        (void)hipFuncSetAttribute((const void*)mega, hipFuncAttributeMaxDynamicSharedMemorySize, LDS_BYTES);
        (void)hipOccupancyMaxActiveBlocksPerMultiprocessor(&per_cu, (const void*)mega, NTHR, LDS_BYTES);
        (void)hipGetLastError();
        grid = (cus > 0 && cus < 256) ? cus : 256;
    }
    (void)hipMemsetAsync((char*)d_ws + OFF_CTL, 0, 32768, stream);
    Params p{};
    for (int i = 0; i < 12; ++i) p.in[i] = (const float*)d_in[i];
    p.out = (float*)d_out; p.ws = (unsigned char*)d_ws;
    hipLaunchKernelGGL(mega, dim3(grid), dim3(NTHR), LDS_BYTES, stream, p);
}
```

```cpp
#include <hip/hip_runtime.h>
#include <stdint.h>
#include <math.h>

#ifndef DUP_PHASE
#define DUP_PHASE 0
#endif
typedef _Float16 h16;
#define GAS __attribute__((address_space(1)))
#define LAS __attribute__((address_space(3)))
typedef GAS h16 gh16; typedef GAS float gf32; typedef GAS unsigned gu32; typedef GAS unsigned char gu8;
typedef LAS h16 lh16; typedef LAS float lf32; typedef LAS unsigned lu32; typedef LAS unsigned char lu8;
#define DEVI __device__ __forceinline__
DEVI int ogw();
DEVI int otid() { int t = threadIdx.x; asm volatile("" : "+v"(t)); return t; }

constexpr int NB = 8, SEQ = 2048, DM = 1024, NT = NB * SEQ, INC = 3976, MYC = 4096;
constexpr float LOG2E = 1.4426950408889634f;
constexpr float EPS = 1e-6f;

DEVI int ogw() { return blockIdx.x * 8 + (otid() >> 6); }
__host__ __device__ constexpr int ref_col(int my) {
    if (my < 352) return my;
    if (my < 384) return -1;
    if (my < 640) return 352 + (my - 384);
    if (my < 896) return 1376 + (my - 640);
    if (my < 1152) return 2696 + (my - 896);
    if (my < 1408) return 3720 + (my - 1152);
    if (my < 1664) return 608 + (my - 1408);
    if (my < 1920) return 864 + (my - 1664);
    if (my < 2176) return 1632 + (my - 1920);
    if (my < 2432) return 1888 + (my - 2176);
    if (my < 2688) return 2952 + (my - 2432);
    if (my < 2944) return 3208 + (my - 2688);
    if (my < 3200) return 1120 + (my - 2944);
    if (my < 3456) return 2144 + (my - 3200);
    if (my < 3712) return 3464 + (my - 3456);
    if (my < 3968) return 2400 + (my - 3712);
    if (my < 4000) return 2656 + (my - 3968);
    if (my < 4008) return 2688 + (my - 4000);
    return -1;
}

constexpr size_t MiB = 1024 * 1024;
constexpr size_t OFF_CTL = 0;
constexpr size_t OFF_RSTD = 64 * 1024;
constexpr size_t OFF_BIAS = 128 * 1024;
constexpr size_t OFF_COS = 256 * 1024;
constexpr size_t OFF_SIN = 384 * 1024;
constexpr size_t OFF_SSQY = 512 * 1024;
constexpr size_t OFF_SSQH = 768 * 1024;
constexpr size_t OFF_CA = 1 * MiB;
constexpr size_t OFF_GATE = OFF_CA + 12 * MiB;
constexpr size_t OFF_QB = OFF_GATE + 32 * MiB;
constexpr size_t OFF_QC = OFF_QB + 8 * MiB;
constexpr size_t OFF_QD = OFF_QC + 8 * MiB;
constexpr size_t OFF_KFB = OFF_QD + 8 * MiB;
constexpr size_t OFF_KFC = OFF_KFB + 24 * MiB;
constexpr size_t OFF_KFD = OFF_KFC + 8 * MiB;
constexpr size_t OFF_IDX = OFF_KFD + 8 * MiB;
constexpr size_t OFF_KIF = OFF_IDX + 10 * MiB;
constexpr size_t OFF_MIX = OFF_KIF + 1 * MiB;
constexpr size_t OFF_VTMP = OFF_MIX;
constexpr size_t OFF_MASK = OFF_MIX + 32 * MiB;
constexpr size_t OFF_H16 = OFF_MASK + 4 * MiB;
constexpr size_t OFF_QA = OFF_H16;
constexpr size_t OFF_KFA = OFF_QA + 12 * MiB;
constexpr size_t OFF_KRF = OFF_KFA + 8 * MiB;
constexpr size_t OFF_VFA = OFF_KRF + 1 * MiB;
constexpr size_t OFF_WINT = OFF_H16 + 32 * MiB;
constexpr size_t OFF_WOUTT = OFF_WINT + 16 * MiB;
constexpr size_t OFF_WUQT = OFF_WOUTT + 4 * MiB;
constexpr size_t OFF_WUKVT = OFF_WUQT + 512 * 1024;
constexpr size_t OFF_VF = OFF_WUKVT + 512 * 1024;
constexpr size_t OFF_END = OFF_VF + 40 * MiB;
static_assert(OFF_END <= 256 * MiB, "ws map");

struct Route { int kind; size_t off; int dcol; int pitch; float scale; int silu; };
__host__ __device__ inline Route route(int my) {
    Route r{-1, 0, 0, 0, 1.f, 0};
    if (my < 384) { r.kind = 0; r.off = OFF_CA; r.dcol = my; r.pitch = 384; }
    else if (my < 1408) { r.kind = 0; r.off = OFF_GATE; r.dcol = my - 384; r.pitch = 1024; r.silu = 1; }
    else if (my < 1664) { r.kind = 0; r.off = OFF_QB; r.dcol = my - 1408; r.pitch = 256; r.scale = 0.125f * LOG2E; }
    else if (my < 1920) { r.kind = 2; r.off = OFF_KFB; r.dcol = my - 1664; }
    else if (my < 2176) { r.kind = 0; r.off = OFF_QC; r.dcol = my - 1920; r.pitch = 256; r.scale = 0.125f * LOG2E; }
    else if (my < 2432) { r.kind = 1; r.off = OFF_KFC; r.dcol = my - 2176; }
    else if (my < 2688) { r.kind = 0; r.off = OFF_QD; r.dcol = my - 2432; r.pitch = 256; r.scale = 0.17677669529663687f * LOG2E; }
    else if (my < 2944) { r.kind = 1; r.off = OFF_KFD; r.dcol = my - 2688; }
    else if (my < 3712) { r.kind = 0; r.off = OFF_VTMP; r.dcol = my - 2944; r.pitch = 768; }
    else if (my < 3968) { r.kind = 0; r.off = OFF_IDX; r.dcol = my - 3712; r.pitch = 320; r.scale = 0.17677669529663687f; }
    else if (my < 4000) { r.kind = 3; r.off = OFF_KIF; r.dcol = my - 3968; }
    else if (my < 4032) { r.kind = 0; r.off = OFF_IDX; r.dcol = my - 3712; r.pitch = 320; }
    return r;
}
DEVI size_t kf_off(int bh, int s, int d0) { return ((((size_t)bh * 64 + (s >> 5)) * 4 + (d0 >> 4)) * 64 + (s & 31) + 32 * ((d0 >> 3) & 1)) * 8; }
DEVI size_t kf4_off(int bh, int s, int d0) { const int pp = s >> 2, r4 = s & 3; return (((((size_t)bh * 4 + r4) * 16 + (pp >> 5)) * 4 + (d0 >> 4)) * 64 + (pp & 31) + 32 * ((d0 >> 3) & 1)) * 8; }
DEVI size_t kf16_off(int bh, int s, int d0) { const int pp = s >> 4, r = s & 15; return (((((size_t)bh * 16 + r) * 4 + (pp >> 5)) * 4 + (d0 >> 4)) * 64 + (pp & 31) + 32 * ((d0 >> 3) & 1)) * 8; }
DEVI size_t mixf_off(size_t tok, int c0) { return tok * 1024 + (size_t)c0; }
constexpr size_t FSZ = (size_t)32 * 64 * 4 * 64 * 8;

__device__ __constant__ unsigned short kP2Order[1024] = {63, 127, 191, 255, 62, 126, 190, 254, 61, 125, 189, 253, 60, 124, 188, 252, 59, 123, 187, 251, 58, 122, 186, 250, 57, 121, 185, 249, 56, 120, 184, 248, 55, 119, 183, 247, 54, 118, 182, 246, 53, 117, 181, 245, 52, 116, 180, 244, 51, 115, 179, 243, 50, 114, 178, 242, 49, 113, 177, 241, 48, 112, 176, 240, 47, 111, 175, 239, 46, 110, 174, 238, 45, 109, 173, 237, 44, 108, 172, 236, 43, 107, 171, 235, 42, 106, 170, 234, 41, 105, 169, 233, 40, 104, 168, 232, 39, 103, 167, 231, 319, 383, 447, 511, 318, 382, 446, 510, 38, 102, 166, 230, 317, 381, 445, 509, 316, 380, 444, 508, 37, 101, 165, 229, 315, 379, 443, 507, 36, 100, 164, 228, 314, 378, 442, 506, 313, 377, 441, 505, 35, 99, 163, 227, 312, 376, 440, 504, 34, 98, 162, 226, 311, 375, 439, 503, 310, 374, 438, 502, 33, 97, 161, 225, 309, 373, 437, 501, 308, 372, 436, 500, 32, 96, 160, 224, 307, 371, 435, 499, 31, 95, 159, 223, 306, 370, 434, 498, 305, 369, 433, 497, 30, 94, 158, 222, 304, 368, 432, 496, 29, 93, 157, 221, 303, 367, 431, 495, 302, 366, 430, 494, 28, 92, 156, 220, 301, 365, 429, 493, 300, 364, 428, 492, 27, 91, 155, 219, 299, 363, 427, 491, 26, 90, 154, 218, 298, 362, 426, 490, 575, 639, 703, 767, 297, 361, 425, 489, 574, 638, 702, 766, 25, 89, 153, 217, 573, 637, 701, 765, 296, 360, 424, 488, 572, 636, 700, 764, 24, 88, 152, 216, 295, 359, 423, 487, 571, 635, 699, 763, 570, 634, 698, 762, 294, 358, 422, 486, 569, 633, 697, 761, 23, 87, 151, 215, 293, 357, 421, 485, 568, 632, 696, 760, 567, 631, 695, 759, 292, 356, 420, 484, 22, 86, 150, 214, 566, 630, 694, 758, 291, 355, 419, 483, 565, 629, 693, 757, 564, 628, 692, 756, 21, 85, 149, 213, 290, 354, 418, 482, 563, 627, 691, 755, 289, 353, 417, 481, 562, 626, 690, 754, 20, 84, 148, 212, 561, 625, 689, 753, 288, 352, 416, 480, 560, 624, 688, 752, 19, 83, 147, 211, 287, 351, 415, 479, 559, 623, 687, 751, 558, 622, 686, 750, 286, 350, 414, 478, 557, 621, 685, 749, 18, 82, 146, 210, 285, 349, 413, 477, 556, 620, 684, 748, 555, 619, 683, 747, 284, 348, 412, 476, 17, 81, 145, 209, 554, 618, 682, 746, 283, 347, 411, 475, 553, 617, 681, 745, 552, 616, 680, 744, 16, 80, 144, 208, 282, 346, 410, 474, 551, 615, 679, 743, 281, 345, 409, 473, 550, 614, 678, 742, 15, 79, 143, 207, 549, 613, 677, 741, 280, 344, 408, 472, 548, 612, 676, 740, 14, 78, 142, 206, 279, 343, 407, 471, 547, 611, 675, 739, 546, 610, 674, 738, 278, 342, 406, 470, 545, 609, 673, 737, 13, 77, 141, 205, 277, 341, 405, 469, 544, 608, 672, 736, 543, 607, 671, 735, 276, 340, 404, 468, 12, 76, 140, 204, 542, 606, 670, 734, 275, 339, 403, 467, 541, 605, 669, 733, 768, 769, 770, 771, 772, 773, 774, 775, 776, 777, 778, 779, 780, 781, 782, 783, 784, 785, 786, 787, 788, 789, 790, 791, 792, 793, 794, 795, 796, 797, 798, 799, 800, 801, 802, 803, 804, 805, 806, 807, 808, 809, 810, 811, 812, 813, 814, 815, 816, 817, 818, 819, 820, 821, 822, 823, 824, 825, 826, 827, 828, 829, 830, 831, 832, 833, 834, 835, 836, 837, 838, 839, 840, 841, 842, 843, 844, 845, 846, 847, 848, 849, 850, 851, 852, 853, 854, 855, 856, 857, 858, 859, 860, 861, 862, 863, 864, 865, 866, 867, 868, 869, 870, 871, 872, 873, 874, 875, 876, 877, 878, 879, 880, 881, 882, 883, 884, 885, 886, 887, 888, 889, 890, 891, 892, 893, 894, 895, 896, 897, 898, 899, 900, 901, 902, 903, 904, 905, 906, 907, 908, 909, 910, 911, 912, 913, 914, 915, 916, 917, 918, 919, 920, 921, 922, 923, 924, 925, 926, 927, 928, 929, 930, 931, 932, 933, 934, 935, 936, 937, 938, 939, 940, 941, 942, 943, 944, 945, 946, 947, 948, 949, 950, 951, 952, 953, 954, 955, 956, 957, 958, 959, 960, 961, 962, 963, 964, 965, 966, 967, 968, 969, 970, 971, 972, 973, 974, 975, 976, 977, 978, 979, 980, 981, 982, 983, 984, 985, 986, 987, 988, 989, 990, 991, 992, 993, 994, 995, 996, 997, 998, 999, 1000, 1001, 1002, 1003, 1004, 1005, 1006, 1007, 1008, 1009, 1010, 1011, 1012, 1013, 1014, 1015, 1016, 1017, 1018, 1019, 1020, 1021, 1022, 1023, 540, 604, 668, 732, 11, 75, 139, 203, 274, 338, 402, 466, 539, 603, 667, 731, 273, 337, 401, 465, 538, 602, 666, 730, 10, 74, 138, 202, 537, 601, 665, 729, 272, 336, 400, 464, 536, 600, 664, 728, 9, 73, 137, 201, 271, 335, 399, 463, 535, 599, 663, 727, 534, 598, 662, 726, 270, 334, 398, 462, 533, 597, 661, 725, 8, 72, 136, 200, 269, 333, 397, 461, 532, 596, 660, 724, 531, 595, 659, 723, 268, 332, 396, 460, 7, 71, 135, 199, 530, 594, 658, 722, 267, 331, 395, 459, 529, 593, 657, 721, 528, 592, 656, 720, 6, 70, 134, 198, 266, 330, 394, 458, 527, 591, 655, 719, 265, 329, 393, 457, 526, 590, 654, 718, 5, 69, 133, 197, 525, 589, 653, 717, 264, 328, 392, 456, 524, 588, 652, 716, 4, 68, 132, 196, 263, 327, 391, 455, 523, 587, 651, 715, 522, 586, 650, 714, 262, 326, 390, 454, 521, 585, 649, 713, 3, 67, 131, 195, 261, 325, 389, 453, 520, 584, 648, 712, 519, 583, 647, 711, 260, 324, 388, 452, 2, 66, 130, 194, 518, 582, 646, 710, 259, 323, 387, 451, 517, 581, 645, 709, 516, 580, 644, 708, 1, 65, 129, 193, 258, 322, 386, 450, 515, 579, 643, 707, 257, 321, 385, 449, 514, 578, 642, 706, 0, 64, 128, 192, 513, 577, 641, 705, 256, 320, 384, 448, 512, 576, 640, 704};
__device__ __constant__ unsigned char kWgOrder[96] = {7, 15, 23, 31, 6, 14, 22, 30, 39, 47, 55, 63, 5, 13, 21, 29, 38, 46, 54, 62, 4, 12, 20, 28, 71, 79, 87, 95, 37, 45, 53, 61, 70, 78, 86, 94, 3, 11, 19, 27, 36, 44, 52, 60, 69, 77, 85, 93, 35, 43, 51, 59, 68, 76, 84, 92, 2, 10, 18, 26, 67, 75, 83, 91, 34, 42, 50, 58, 1, 9, 17, 25, 66, 74, 82, 90, 33, 41, 49, 57, 65, 73, 81, 89, 0, 8, 16, 24, 32, 40, 48, 56, 64, 72, 80, 88};
__device__ __constant__ int kBucketStart[16] = {16, 22, 30, 40, 54, 73, 99, 134, 182, 246, 332, 450, 609, 825, 1117, 1513};
DEVI int t5_bucket(int n) {
    if (n < 16) return n;
    int b = 16;
#pragma unroll
    for (int j = 1; j < 16; ++j) b += (n >= kBucketStart[j]) ? 1 : 0;
    return b;
}


#define XB_TMO      128
#define XB_XCNT(j)  (256  + 64 * (j))
#define XB_XSUB(j)  (1280 + 64 * (j))
#define XB_XGEN(j)  (2304 + 64 * (j))
#define XB_TOP      3328
#define XB_TOPGEN   3392
#define XCD_BAR_WORDS 3456
#define XB_SPIN_CAP (1u << 18)
__device__ __forceinline__ unsigned xb_ld(unsigned* p)              { return __hip_atomic_load(p, __ATOMIC_RELAXED, __HIP_MEMORY_SCOPE_AGENT); }
__device__ __forceinline__ unsigned xb_add(unsigned* p, unsigned v) { return __hip_atomic_fetch_add(p, v, __ATOMIC_RELAXED, __HIP_MEMORY_SCOPE_AGENT); }
__device__ __forceinline__ unsigned xb_xcc_id() { return (unsigned)__builtin_amdgcn_s_getreg((3 << 11) | 20) & 0xFu; }
#define XB_SPIN(cond, bar) do { unsigned _sp = 0; while (cond) { __builtin_amdgcn_s_sleep(1); \
    if ((++_sp & 255u) == 0u) { if (xb_ld(&(bar)[XB_TMO])) break; if (_sp > XB_SPIN_CAP) { atomicAdd(&(bar)[XB_TMO], 1u); break; } } } } while (0)
struct XcdBarrier { unsigned* bar; unsigned x; volatile LAS unsigned* st; };
__device__ __forceinline__ XcdBarrier xcd_barrier_post(unsigned* bar, volatile LAS unsigned* st) {
    XcdBarrier b; b.bar = bar; b.x = xb_xcc_id(); b.st = st;
    if (threadIdx.x == 0) (void)xb_add(&bar[XB_XCNT(b.x)], 1u);
    return b;
}
__device__ __forceinline__ void xcd_barrier_complete(unsigned* bar, unsigned x, unsigned& nloc, unsigned& nx) {
    const unsigned G = gridDim.x * gridDim.y * gridDim.z;
    unsigned sum, cnt, mine, sp = 0u;
    for (;;) {
        sum = 0u; cnt = 0u; mine = 0u;
#pragma unroll
        for (unsigned j = 0; j < 16; ++j) { const unsigned c = xb_ld(&bar[XB_XCNT(j)]); sum += c; cnt += (c > 0u) ? 1u : 0u; mine = (j == x) ? c : mine; }
        if (sum == G) break;
        __builtin_amdgcn_s_sleep(1);
        if ((++sp & 255u) == 0u) { if (xb_ld(&bar[XB_TMO])) break; if (sp > XB_SPIN_CAP) { atomicAdd(&bar[XB_TMO], 1u); break; } }
    }
    nloc = mine > 0u ? mine : 1u; nx = cnt > 0u ? cnt : 1u;
}
__device__ __forceinline__ void xcd_barrier(const XcdBarrier& b) {
    asm volatile("s_waitcnt vmcnt(0)" ::: "memory");
    __syncthreads();
    if (otid() == 0) {
        unsigned* bar = b.bar; unsigned bx = b.x; asm volatile("" : "+s"(bx));
        __builtin_amdgcn_s_waitcnt(0);
        unsigned nloc = b.st[0], nx = b.st[1];
        if (nloc == 0u) { xcd_barrier_complete(bar, bx, nloc, nx); b.st[0] = nloc; b.st[1] = nx; }
        const unsigned old = xb_add(&bar[XB_XSUB(bx)], 1u);
        const unsigned gen = old / nloc;
        if (old + 1u == (gen + 1u) * nloc) {
            __builtin_amdgcn_fence(__ATOMIC_RELEASE, "agent");
            asm volatile("s_waitcnt vmcnt(0)" ::: "memory");
            const unsigned og = xb_add(&bar[XB_TOP], 1u);
            const unsigned tg = og / nx;
            if (og + 1u == (tg + 1u) * nx) xb_add(&bar[XB_TOPGEN], 1u);
            else XB_SPIN(xb_ld(&bar[XB_TOPGEN]) == tg, bar);
            __builtin_amdgcn_fence(__ATOMIC_ACQUIRE, "agent");
            xb_add(&bar[XB_XGEN(bx)], 1u);
            asm volatile("s_waitcnt vmcnt(0)" ::: "memory");
        } else {
            XB_SPIN(xb_ld(&bar[XB_XGEN(bx)]) == gen, bar);
            __builtin_amdgcn_fence(__ATOMIC_ACQUIRE, "agent");
            asm volatile("s_waitcnt vmcnt(0)" ::: "memory");
        }
    }
    __syncthreads();
}

namespace pg8 {
#define PG8_LAS __attribute__((address_space(3)))
typedef unsigned short bf16_t;
typedef _Float16 f16x8 __attribute__((ext_vector_type(8)));
typedef float f32x4 __attribute__((ext_vector_type(4)));
typedef unsigned u32x4 __attribute__((ext_vector_type(4)));
constexpr int BM = 256, BK = 64, HALF = 128, HTB = HALF * BK * 2  , STAGE_BYTES = 8 * HTB, NXCD = 8, WGM = 8;

__host__ __device__ __forceinline__ int lds_byte(int r, int c) { const int st = (r >> 4) * 2 + (c >> 5), rr = r & 15, cc = c & 31, ob = rr * 64 + cc * 2; return st * 1024 + (ob ^ (((ob >> 9) & 1) << 5)); }
__host__ __device__ __forceinline__ void stage_rc(int b, int& R, int& C) { const int st = b / 1024, sb = b % 1024, swz = sb ^ (((sb >> 9) & 1) << 5); R = (st >> 1) * 16 + swz / 64; C = (st & 1) * 32 + (swz % 64) / 2; }
__host__ __device__ __forceinline__ int perm32(int rho) { const int n = rho >> 4, i = rho & 15; return 8 * (i >> 2) + 4 * n + (i & 3); }

struct Unit { int pm, pn; };
struct Gemm { const bf16_t* A; const bf16_t* Bt; int M, N, K; };

struct StaticOrder {
    int nM, nN, nwg, G, c;
    __host__ __device__ void init(int M, int N, int G_, int c_) { nM = M / BM; nN = N / BM; nwg = nM * nN; G = G_; c = c_; }
    __host__ __device__ bool next(int i, Unit& u) const {
        const long L = (long)i * G + c; if (L >= nwg) return false;
        int wgid = (int)L; { const int q = nwg / NXCD, r = nwg % NXCD, xcd = wgid % NXCD, off = wgid / NXCD; wgid = (xcd < r ? xcd * (q + 1) : r * (q + 1) + (xcd - r) * q) + off; }
        const int nig = WGM * nN, gid = wgid / nig, fm = gid * WGM, gsz = (nM - fm) < WGM ? (nM - fm) : WGM;
        u.pm = fm + ((wgid % nig) % gsz); u.pn = (wgid % nig) / gsz; return true;
    }
    __device__ __forceinline__ void a_ready(const Unit&) const {}
    __device__ __forceinline__ void done(const Unit&) const {}
};

template <class Epi, class Sched, bool ALIGN_EPI = false, bool SP2 = false>
__device__ __forceinline__ void gemm_phase(PG8_LAS unsigned char* lds, const Gemm g, const Sched& S, const Epi& E) {
    const int tid = otid(), wid = __builtin_amdgcn_readfirstlane(tid >> 6), lane = tid & 63, wr = wid >> 2, wc = wid & 3, fr = lane & 15, fq = lane >> 4;
    const int K = g.K, nt = K / BK;
    unsigned voffA[2], voffB[2];
#pragma unroll
    for (int i = 0; i < 2; ++i) { int R, C; stage_rc(tid * 16 + i * 8192, R, C); const int Rb = Epi::PERM ? ((R & ~31) + perm32(R & 31)) : R;
        voffA[i] = (unsigned)(R * K + C) * 2u; voffB[i] = (unsigned)(Rb * K + C) * 2u; }
    const size_t kstep = (size_t)(BK * 2);
    const size_t hstep = (size_t)HALF * K * 2;
    const size_t tstep = 2 * hstep;
    const unsigned ldsw = (unsigned)wid * 1024u;
    const int aoff = lds_byte(wr * 64 + fr, fq * 8), boff = lds_byte(wc * 32 + fr, fq * 8);
#define PG8_SA(b, h) (((b) * 2 + (h)) * HTB)
#define PG8_SB(b, h) ((4 + (b) * 2 + (h)) * HTB)
#define PG8_STAGE(bufoff, gbase, voff) do { _Pragma("unroll") for (int _i = 0; _i < 2; ++_i) \
        __builtin_amdgcn_global_load_lds((const unsigned*)((const char*)(gbase) + (voff)[_i]), (PG8_LAS unsigned*)(lds + (bufoff) + ldsw + _i * 8192), 16, 0, 0); } while (0)
#define PG8_LDA(dst, b, h) do { _Pragma("unroll") for (int m = 0; m < 4; ++m) _Pragma("unroll") for (int k = 0; k < 2; ++k) dst[m][k] = *(const PG8_LAS f16x8*)(lds + PG8_SA(b, h) + aoff + m * 2048 + k * 1024); } while (0)
#define PG8_LDB(dst, b, h) do { _Pragma("unroll") for (int n = 0; n < 2; ++n) _Pragma("unroll") for (int k = 0; k < 2; ++k) dst[n][k] = *(const PG8_LAS f16x8*)(lds + PG8_SB(b, h) + boff + n * 2048 + k * 1024); } while (0)
#define PG8_MMA(ai, bj, At, Bt) do { __builtin_amdgcn_s_setprio(1); _Pragma("unroll") for (int m = 0; m < 4; ++m) _Pragma("unroll") for (int n = 0; n < 2; ++n) _Pragma("unroll") for (int k = 0; k < 2; ++k) \
        acc[ai][bj][m][n] = __builtin_amdgcn_mfma_f32_16x16x32_f16(Bt[n][k], At[m][k], acc[ai][bj][m][n], 0, 0, 0); __builtin_amdgcn_s_setprio(0); } while (0)
#define PG8_WAIT_V(n) asm volatile("s_waitcnt vmcnt(" #n ")" ::: "memory")
#define PG8_WAIT_L(n) asm volatile("s_waitcnt lgkmcnt(" #n ")" ::: "memory")
#define PG8_BAR __builtin_amdgcn_s_barrier()
#define PG8_SCHED __builtin_amdgcn_sched_barrier(0)
    Unit cur, nxt; int ui = 0;
    if (!S.next(0, cur)) return;
    f32x4 acc[2][2][4][2];
#pragma unroll
    for (int a = 0; a < 2; ++a)
#pragma unroll
        for (int b = 0; b < 2; ++b)
#pragma unroll
            for (int m = 0; m < 4; ++m)
#pragma unroll
                for (int n = 0; n < 2; ++n) acc[a][b][m][n] = (f32x4){0.f, 0.f, 0.f, 0.f};
    f16x8 At[4][2], B0[2][2], B1[2][2];
    const char* cA = (const char*)g.A + (size_t)cur.pm * tstep; const char* cB = (const char*)g.Bt + (size_t)cur.pn * tstep;
    S.a_ready(cur);
    if constexpr (SP2) {
        PG8_STAGE(PG8_SB(0, 0), cB, voffB); PG8_STAGE(PG8_SB(0, 1), cB + hstep, voffB); PG8_STAGE(PG8_SA(0, 0), cA, voffA); PG8_STAGE(PG8_SA(0, 1), cA + hstep, voffA);
        if (wr == 1) PG8_BAR;
        PG8_WAIT_V(2); PG8_BAR;
        PG8_STAGE(PG8_SB(1, 0), cB + kstep, voffB); PG8_STAGE(PG8_SA(1, 0), cA + kstep, voffA); PG8_STAGE(PG8_SB(1, 1), cB + hstep + kstep, voffB);
        PG8_WAIT_V(6); PG8_BAR;
    } else {
        PG8_STAGE(PG8_SB(0, 0), cB, voffB); PG8_STAGE(PG8_SA(0, 0), cA, voffA); PG8_STAGE(PG8_SB(0, 1), cB + hstep, voffB); PG8_STAGE(PG8_SA(0, 1), cA + hstep, voffA);
        if (wr == 1) PG8_BAR;
        PG8_WAIT_V(4); PG8_BAR;
        PG8_STAGE(PG8_SB(1, 0), cB + kstep, voffB); PG8_STAGE(PG8_SA(1, 0), cA + kstep, voffA); PG8_STAGE(PG8_SB(1, 1), cB + hstep + kstep, voffB);
        PG8_WAIT_V(6); PG8_BAR;
    }
    for (;;) {
        const bool has_next = S.next(ui + 1, nxt);
        const char* nA = has_next ? (const char*)g.A + (size_t)nxt.pm * tstep : cA; const char* nB = has_next ? (const char*)g.Bt + (size_t)nxt.pn * tstep : cB;
        for (int t = 0; t < nt; t += 2) {
            const bool last = (t == nt - 2);
            const char* a1 = cA + (size_t)(t + 1) * kstep;
            const char* a2 = last ? nA : cA + (size_t)(t + 2) * kstep; const char* b2 = last ? nB : cB + (size_t)(t + 2) * kstep;
            const char* a3 = a2 + kstep; const char* b3 = b2 + kstep;
            if (last && has_next) S.a_ready(nxt);
            if constexpr (SP2) {
            PG8_LDB(B0, 0, 0); PG8_LDB(B1, 0, 1); PG8_SCHED; PG8_LDA(At, 0, 0); PG8_STAGE(PG8_SA(1, 1), a1 + hstep, voffA);
            PG8_WAIT_V(8); PG8_WAIT_L(0); PG8_BAR; PG8_MMA(0, 0, At, B0); PG8_MMA(0, 1, At, B1); PG8_BAR; PG8_SCHED;
            PG8_LDA(At, 0, 1); PG8_STAGE(PG8_SB(0, 0), b2, voffB); PG8_STAGE(PG8_SB(0, 1), b2 + hstep, voffB); PG8_STAGE(PG8_SA(0, 0), a2, voffA);
            PG8_WAIT_V(8); PG8_WAIT_L(0); PG8_BAR; PG8_MMA(1, 0, At, B0); PG8_MMA(1, 1, At, B1); PG8_BAR; PG8_SCHED;
            PG8_LDB(B0, 1, 0); PG8_LDB(B1, 1, 1); PG8_SCHED; PG8_LDA(At, 1, 0); PG8_STAGE(PG8_SA(0, 1), a2 + hstep, voffA);
            PG8_WAIT_V(8); PG8_WAIT_L(0); PG8_BAR; PG8_MMA(0, 0, At, B0); PG8_MMA(0, 1, At, B1); PG8_BAR; PG8_SCHED;
            PG8_LDA(At, 1, 1); PG8_STAGE(PG8_SB(1, 0), b3, voffB); PG8_STAGE(PG8_SB(1, 1), b3 + hstep, voffB); PG8_STAGE(PG8_SA(1, 0), a3, voffA);
            PG8_WAIT_V(8); PG8_WAIT_L(0); PG8_BAR; PG8_MMA(1, 0, At, B0); PG8_MMA(1, 1, At, B1); PG8_BAR; PG8_SCHED;
            } else {
            PG8_LDB(B0, 0, 0); PG8_SCHED; PG8_LDA(At, 0, 0); PG8_STAGE(PG8_SA(1, 1), a1 + hstep, voffA);
            PG8_WAIT_L(8); PG8_BAR; PG8_WAIT_L(0); PG8_MMA(0, 0, At, B0); PG8_BAR; PG8_SCHED;
            PG8_LDB(B1, 0, 1); PG8_STAGE(PG8_SB(0, 0), b2, voffB);
            PG8_BAR; PG8_WAIT_L(0); PG8_MMA(0, 1, At, B1); PG8_BAR;
            PG8_LDA(At, 0, 1); PG8_STAGE(PG8_SA(0, 0), a2, voffA);
            PG8_BAR; PG8_WAIT_L(0); PG8_MMA(1, 0, At, B0); PG8_BAR; PG8_SCHED;
            PG8_STAGE(PG8_SB(0, 1), b2 + hstep, voffB);
            PG8_WAIT_V(6); PG8_BAR; PG8_MMA(1, 1, At, B1); PG8_BAR;
            PG8_LDB(B0, 1, 0); PG8_SCHED; PG8_LDA(At, 1, 0); PG8_STAGE(PG8_SA(0, 1), a2 + hstep, voffA);
            PG8_WAIT_L(8); PG8_BAR; PG8_WAIT_L(0); PG8_MMA(0, 0, At, B0); PG8_BAR; PG8_SCHED;
            PG8_LDB(B1, 1, 1); PG8_STAGE(PG8_SB(1, 0), b3, voffB);
            PG8_BAR; PG8_WAIT_L(0); PG8_MMA(0, 1, At, B1); PG8_BAR;
            PG8_LDA(At, 1, 1); PG8_STAGE(PG8_SA(1, 0), a3, voffA);
            PG8_BAR; PG8_WAIT_L(0); PG8_MMA(1, 0, At, B0); PG8_BAR; PG8_SCHED;
            PG8_STAGE(PG8_SB(1, 1), b3 + hstep, voffB);
            PG8_WAIT_V(6); PG8_BAR; PG8_MMA(1, 1, At, B1); PG8_BAR;
            }
        }
        if constexpr (ALIGN_EPI) { if (wr == 0) PG8_BAR; }
        if constexpr (!Epi::AFTER_DRAIN) { E(acc, cur, wr, wc, fr, fq); S.done(cur); }
        if (!has_next) break;
#pragma unroll
        for (int a = 0; a < 2; ++a)
#pragma unroll
            for (int b = 0; b < 2; ++b)
#pragma unroll
                for (int m = 0; m < 4; ++m)
#pragma unroll
                    for (int n = 0; n < 2; ++n) acc[a][b][m][n] = (f32x4){0.f, 0.f, 0.f, 0.f};
        cur = nxt; cA = nA; cB = nB; ++ui;
        if constexpr (ALIGN_EPI) { if (wr == 1) PG8_BAR; }
    }
    PG8_WAIT_V(0);
    if constexpr (!ALIGN_EPI) { if (wr == 0) PG8_BAR; }
    PG8_BAR;
    if constexpr (Epi::AFTER_DRAIN) { E.fused(acc, cur, wr, wc, fr, fq, lds, wid, lane); S.done(cur); }
#undef PG8_SA
#undef PG8_SB
#undef PG8_STAGE
#undef PG8_LDA
#undef PG8_LDB
#undef PG8_MMA
#undef PG8_WAIT_V
#undef PG8_WAIT_L
#undef PG8_BAR
#undef PG8_SCHED
}
}


typedef float f32x4_t __attribute__((ext_vector_type(4)));
typedef _Float16 h16x8 __attribute__((ext_vector_type(8)));
DEVI float silu_f(float v) { return v / (1.f + __expf(-v)); }
struct EpiRoute {
    static constexpr bool PERM = true, AFTER_DRAIN = false;
    gu8* ws; const gf32* ssq;
    DEVI void operator()(const pg8::f32x4 (&acc)[2][2][4][2], const pg8::Unit& u, int wr, int wc, int fr, int fq) const {
        const int row0 = u.pm * 256 + wr * 64 + fr;
        float rs[2][4];
#pragma unroll
        for (int ai = 0; ai < 2; ++ai)
#pragma unroll
            for (int m = 0; m < 4; ++m) { const int rw = row0 + ai * 128 + m * 16; rs[ai][m] = rsqrtf((ssq[rw] + ssq[NT + rw] + ssq[2 * NT + rw] + ssq[3 * NT + rw]) * (1.f / DM) + EPS); }
#pragma unroll
        for (int bj = 0; bj < 2; ++bj) {
            const int cg = u.pn * 256 + bj * 128 + wc * 32;
            const Route r = route(cg);
            if (r.kind < 0) continue;
            gh16* base = (gh16*)(ws + r.off);
            const int c = r.dcol + 8 * fq;
#pragma unroll
            for (int ai = 0; ai < 2; ++ai)
#pragma unroll
                for (int m = 0; m < 4; ++m) {
                    const int row = row0 + ai * 128 + m * 16; const float sc = rs[ai][m] * r.scale;
                    float v[8];
#pragma unroll
                    for (int j = 0; j < 4; ++j) { v[j] = acc[ai][bj][m][0][j] * sc; v[4 + j] = acc[ai][bj][m][1][j] * sc; }
                    if (r.silu) {
#pragma unroll
                        for (int j = 0; j < 8; ++j) v[j] = silu_f(v[j]);
                    }
                    h16x8 o;
#pragma unroll
                    for (int j = 0; j < 8; ++j) o[j] = (h16)v[j];
                    if (r.kind == 0) *(GAS h16x8*)(base + (size_t)row * r.pitch + c) = o;
                    else {
                        const int b = row >> 11, sq = row & 2047;
                        if (r.kind == 3) *(GAS h16x8*)(base + (((size_t)b * 128 + (sq >> 4)) * 64 + (sq & 15) + 16 * (c >> 3)) * 8) = o;
                        else {
                            const int bh = b * 4 + (c >> 6), d0 = c & 63;
                            *(GAS h16x8*)(base + kf_off(bh, sq, d0)) = o;
                            if (r.kind == 2) { *(GAS h16x8*)(base + FSZ + kf4_off(bh, sq, d0)) = o; *(GAS h16x8*)(base + 2 * FSZ + kf16_off(bh, sq, d0)) = o; }
                        }
                    }
                }
        }
    }
};

struct EpiOut {
    static constexpr bool PERM = true, AFTER_DRAIN = true;
    const gf32* h_in; gf32* h_out; gh16* h16o; const gf32* gpost; gf32* ssqy; gf32* ssqh; const XcdBarrier* bar; bool write_next;
    DEVI void rowsum_publish(const float (&ps)[2][4], gf32* dst, const pg8::Unit& u, int wr, int wc, int fr, int fq, PG8_LAS unsigned char* lds) const {
        lf32* red = (lf32*)lds;
        __syncthreads();
#pragma unroll
        for (int ai = 0; ai < 2; ++ai)
#pragma unroll
            for (int m = 0; m < 4; ++m) { float v = ps[ai][m]; v += __shfl_xor(v, 16); v += __shfl_xor(v, 32); if (fq == 0) red[wc * 256 + ai * 128 + wr * 64 + m * 16 + fr] = v; }
        __syncthreads();
        const int t = otid();
        if (t < 256) dst[(size_t)u.pn * NT + u.pm * 256 + t] = red[t] + red[256 + t] + red[512 + t] + red[768 + t];
    }
    DEVI void fused(pg8::f32x4 (&acc)[2][2][4][2], const pg8::Unit& u, int wr, int wc, int fr, int fq, PG8_LAS unsigned char* lds, int wid, int lane) const {
        float ps[2][4];
#pragma unroll
        for (int ai = 0; ai < 2; ++ai)
#pragma unroll
            for (int m = 0; m < 4; ++m) { float v = 0.f;
#pragma unroll
                for (int bj = 0; bj < 2; ++bj)
#pragma unroll
                    for (int n = 0; n < 2; ++n)
#pragma unroll
                        for (int e = 0; e < 4; ++e) v += acc[ai][bj][m][n][e] * acc[ai][bj][m][n][e];
                ps[ai][m] = v; }
        rowsum_publish(ps, ssqy, u, wr, wc, fr, fq, lds);
        xcd_barrier(*bar);
        const int row0 = u.pm * 256 + wr * 64 + fr;
#pragma unroll
        for (int ai = 0; ai < 2; ++ai)
#pragma unroll
            for (int m = 0; m < 4; ++m) {
                const int row = row0 + ai * 128 + m * 16;
                const float rs = rsqrtf((ssqy[row] + ssqy[NT + row] + ssqy[2 * NT + row] + ssqy[3 * NT + row]) * (1.f / DM) + EPS);
                float v2 = 0.f;
#pragma unroll
                for (int bj = 0; bj < 2; ++bj) {
                    const int col = u.pn * 256 + bj * 128 + wc * 32 + 8 * fq;
                    const size_t off = (size_t)row * DM + col;
                    h16x8 oh;
#pragma unroll
                    for (int n = 0; n < 2; ++n) {
                        const f32x4_t hv = *(const GAS f32x4_t*)(h_in + off + 4 * n), gv = *(const GAS f32x4_t*)(gpost + col + 4 * n);
                        f32x4_t o;
#pragma unroll
                        for (int e = 0; e < 4; ++e) { o[e] = hv[e] + acc[ai][bj][m][n][e] * rs * gv[e]; v2 += o[e] * o[e]; oh[4 * n + e] = (h16)o[e]; }
                        *(GAS f32x4_t*)(h_out + off + 4 * n) = o;
                    }
                    if (write_next) *(GAS h16x8*)(h16o + off) = oh;
                }
                ps[ai][m] = v2;
            }
        if (write_next) rowsum_publish(ps, ssqh, u, wr, wc, fr, fq, lds);
    }
    DEVI void operator()(const pg8::f32x4 (&)[2][2][4][2], const pg8::Unit&, int, int, int, int) const {}
};

constexpr int NTHR = 512, NWAVE = 8;

template <bool REF>
DEVI void cvt_transpose(const gf32* __restrict__ src, int src_pitch, const gf32* __restrict__ g, gh16* dst, int N, int K, lu8* lds, int item0, int nitems_total, int& item_base) {
    const int tid = otid();
    LAS float (*tile)[65] = (LAS float (*)[65])lds;
    const int ntn = N / 64, ntk = K / 64, n_it = ntn * ntk;
    for (int it = item0; it < nitems_total; it += gridDim.x) {
        const int li = it - item_base; if (li < 0 || li >= n_it) continue;
        const int n0 = (li % ntn) * 64, k0 = (li / ntn) * 64;
        __syncthreads();
        const int c = tid & 63; int rc = n0 + c; if (REF) rc = ref_col(rc);
#pragma unroll
        for (int ps = 0; ps < 8; ++ps) { const int k = ps * 8 + (tid >> 6);
            tile[k][c] = rc >= 0 ? src[(size_t)(k0 + k) * src_pitch + rc] * (g ? g[k0 + k] : 1.f) : 0.f; }
        __syncthreads();
        const int cc = tid >> 3, kq = (tid & 7) * 8;
        h16x8 o;
#pragma unroll
        for (int j = 0; j < 8; ++j) o[j] = (h16)tile[kq + j][cc];
        *(GAS h16x8*)(dst + (size_t)(n0 + cc) * K + k0 + kq) = o;
    }
    item_base += n_it;
}

DEVI void ph_rowstat_cvt(const gf32* h, gf32* ssq, gh16* h16o) {
    const int t_ = otid(); const int lane = t_ & 63, gw = blockIdx.x * NWAVE + (t_ >> 6), nw = gridDim.x * NWAVE;
    for (int row = gw; row < NT; row += nw) {
        const GAS f32x4_t* p = (const GAS f32x4_t*)(h + (size_t)row * DM);
        float s = 0.f;
#pragma unroll
        for (int i = 0; i < 4; ++i) { f32x4_t v = p[lane + 64 * i]; s += v[0] * v[0] + v[1] * v[1] + v[2] * v[2] + v[3] * v[3];
            typedef _Float16 h16x4 __attribute__((ext_vector_type(4)));
            h16x4 o; o[0] = (h16)v[0]; o[1] = (h16)v[1]; o[2] = (h16)v[2]; o[3] = (h16)v[3];
            *(GAS h16x4*)(h16o + (size_t)row * DM + (lane + 64 * i) * 4) = o; }
        for (int o = 32; o; o >>= 1) s += __shfl_xor(s, o);
        if (lane == 0) { ssq[row] = s; ssq[NT + row] = 0.f; ssq[2 * NT + row] = 0.f; ssq[3 * NT + row] = 0.f; }
    }
}

typedef float f32x16 __attribute__((ext_vector_type(16)));
typedef _Float16 h16x4 __attribute__((ext_vector_type(4)));
DEVI f32x16 mfma32(h16x8 a, h16x8 b, f32x16 c) { return __builtin_amdgcn_mfma_f32_32x32x16_f16(a, b, c, 0, 0, 0); }
#define CROW(r) (((r) & 3) + 8 * ((r) >> 2))
DEVI float xh_max(float x) { auto r = __builtin_amdgcn_permlane32_swap(__float_as_uint(x), __float_as_uint(x), false, false); return fmaxf(__uint_as_float(r[0]), __uint_as_float(r[1])); }
DEVI float xh_sum(float x) { auto r = __builtin_amdgcn_permlane32_swap(__float_as_uint(x), __float_as_uint(x), false, false); return __uint_as_float(r[0]) + __uint_as_float(r[1]); }
DEVI unsigned pk2h(float a, float b) { auto v = __builtin_amdgcn_cvt_pkrtz(a, b); return __builtin_bit_cast(unsigned, v); }
DEVI h16x8 pack8(const f32x16& p, int s) {
    typedef unsigned u32x4_t __attribute__((ext_vector_type(4)));
    u32x4_t w;
    w[0] = pk2h(p[8 * s + 0], p[8 * s + 1]); w[1] = pk2h(p[8 * s + 2], p[8 * s + 3]); w[2] = pk2h(p[8 * s + 4], p[8 * s + 5]); w[3] = pk2h(p[8 * s + 6], p[8 * s + 7]);
    return __builtin_bit_cast(h16x8, w);
}
DEVI h16x8 ldv8(const gh16* p) {
    h16x4 a = *(const GAS h16x4*)p, b = *(const GAS h16x4*)(p + 8);
    h16x8 r; r[0] = a[0]; r[1] = a[1]; r[2] = a[2]; r[3] = a[3]; r[4] = b[0]; r[5] = b[1]; r[6] = b[2]; r[7] = b[3]; return r;
}
DEVI void softmax_tile(f32x16& S, float& m, float& l, f32x16& O0, f32x16& O1) {
    float mx = S[0];
#pragma unroll
    for (int r = 1; r < 16; ++r) mx = fmaxf(mx, S[r]);
    mx = xh_max(mx);
    if (__any(mx > m)) {
        const float mn = fmaxf(m, mx), al = __builtin_amdgcn_exp2f(m - mn);
        l *= al; O0 *= al; O1 *= al; m = mn;
    }
#pragma unroll
    for (int r = 0; r < 16; ++r) S[r] = __builtin_amdgcn_exp2f(S[r] - m);
    l += ((S[0] + S[1]) + (S[2] + S[3])) + ((S[4] + S[5]) + (S[6] + S[7])) + (((S[8] + S[9]) + (S[10] + S[11])) + ((S[12] + S[13]) + (S[14] + S[15])));
}
DEVI void softmax_tile_h(f32x16& S, float& m, float& l, f32x16& O0, f32x16& O1, int hot) { if (hot < 2) softmax_tile(S, m, l, O0, O1); else l += S[0]; }
DEVI int wq_next(gu32* ctr) {
    int e = 0;
    if ((otid() & 63) == 0) e = (int)__hip_atomic_fetch_add(ctr, 1u, __ATOMIC_RELAXED, __HIP_MEMORY_SCOPE_AGENT);
    return __builtin_amdgcn_readfirstlane(e);
}

DEVI void flashA_item(int b, int hh, int qt, const gh16* qA, const gh16* KF, const gh16* KRF, const gh16* VF, const gh16* gate, gh16* mix) {
    const int lane = otid() & 63, q = lane & 31, h = lane >> 5;
    const size_t tokq = (size_t)b * SEQ + qt * 32 + q;
    h16x8 qf[6];
#pragma unroll
    for (int ks = 0; ks < 6; ++ks) qf[ks] = *(const GAS h16x8*)(qA + tokq * 384 + hh * 96 + ks * 16 + 8 * h);
    f32x16 O0 = {}, O1 = {};
    float m = -1e30f, l = 0.f;
    const gh16* kp = KF + (size_t)(b * 4 + hh) * 64 * 2048 + lane * 8;
    const gh16* rp = KRF + (size_t)b * 64 * 1024 + lane * 8;
    const gh16* vp = VF + (size_t)(b * 4 + hh) * 64 * 2048 + lane * 8;
    h16x8 kf[6];
#pragma unroll
    for (int ks = 0; ks < 4; ++ks) kf[ks] = *(const GAS h16x8*)(kp + ks * 512);
#pragma unroll
    for (int ks = 0; ks < 2; ++ks) kf[4 + ks] = *(const GAS h16x8*)(rp + ks * 512);
    h16x8 vf[4], vn[4];
#pragma unroll
    for (int f = 0; f < 4; ++f) vf[f] = *(const GAS h16x8*)(vp + f * 512);
    for (int j = 0; j <= qt; ++j) {
        f32x16 S = {};
#pragma unroll
        for (int ks = 0; ks < 6; ++ks) S = mfma32(kf[ks], qf[ks], S);
        if (j < qt) {
#pragma unroll
            for (int ks = 0; ks < 4; ++ks) kf[ks] = *(const GAS h16x8*)(kp + (size_t)(j + 1) * 2048 + ks * 512);
#pragma unroll
            for (int ks = 0; ks < 2; ++ks) kf[4 + ks] = *(const GAS h16x8*)(rp + (size_t)(j + 1) * 1024 + ks * 512);
#pragma unroll
            for (int f = 0; f < 4; ++f) vn[f] = *(const GAS h16x8*)(vp + (size_t)(j + 1) * 2048 + f * 512);
        } else {
#pragma unroll
            for (int r = 0; r < 16; ++r) S[r] = (CROW(r) + 4 * h > q) ? -3e38f : S[r];
        }
        softmax_tile(S, m, l, O0, O1);
        const h16x8 p0 = pack8(S, 0), p1 = pack8(S, 1);
        O0 = mfma32(vf[0], p0, O0); O0 = mfma32(vf[1], p1, O0);
        O1 = mfma32(vf[2], p0, O1); O1 = mfma32(vf[3], p1, O1);
#pragma unroll
        for (int f = 0; f < 4; ++f) vf[f] = vn[f];
    }
    const float il = 1.f / xh_sum(l);
    const gh16* gp = gate + tokq * 1024 + hh * 64 + 4 * h;
#pragma unroll
    for (int db = 0; db < 2; ++db)
#pragma unroll
        for (int g = 0; g < 4; ++g) {
            const h16x4 gv = *(const GAS h16x4*)(gp + db * 32 + 8 * g); h16x4 o;
#pragma unroll
            for (int e = 0; e < 4; ++e) o[e] = (h16)((db ? O1[4 * g + e] : O0[4 * g + e]) * il * (float)gv[e]);
            *(GAS h16x4*)(mix + mixf_off(tokq, hh * 64 + db * 32 + 8 * g + 4 * h)) = o;
        }
}

DEVI int far_bucket(int n) { return 23 + (n >= 182 ? 1 : 0) + (n >= 246 ? 1 : 0) + (n >= 332 ? 1 : 0) + (n >= 450 ? 1 : 0) + (n >= 609 ? 1 : 0) + (n >= 825 ? 1 : 0) + (n >= 1117 ? 1 : 0) + (n >= 1513 ? 1 : 0); }
DEVI int far_start(int bk) { return bk == 24 ? 182 : bk == 25 ? 246 : bk == 26 ? 332 : bk == 27 ? 450 : bk == 28 ? 609 : bk == 29 ? 825 : bk == 30 ? 1117 : 1513; }
constexpr int L_NEAR = 0, L_R3 = 12288, L_R2 = 15360, L_R1 = 21504, L_LAM = 39936, L_P2END = 40000;
constexpr int L_BIASL = 40000, L_RING = 41984, L_MRING = L_RING + 4 * 10240, L_WQ = L_MRING + 8192;
DEVI void p2_setup(const gf32* biasTab, const gf32* lam_p, float lambda_init, lu8* lds) {
    const int tid = otid();
    lf32* nearR = (lf32*)(lds + L_NEAR);
    for (int i = tid; i < 12 * 256; i += NTHR) { const int hb = i >> 8, u = i & 255, tix = 223 - u; nearR[i] = tix < 0 ? -3e38f : biasTab[hb * 2048 + tix]; }
    lf32* R3 = (lf32*)(lds + L_R3); lf32* R2 = (lf32*)(lds + L_R2); lf32* R1 = (lf32*)(lds + L_R1);
    for (int i = tid; i < 4 * 192; i += NTHR) { const int hb = i / 192, kk = 159 - (i % 192); R3[i] = (kk < 0 || kk > 128) ? -3e38f : biasTab[hb * 2048 + kk * 16]; }
    for (int i = tid; i < 4 * 384; i += NTHR) { const int hb = i / 384, kk = 255 - (i % 384); R2[i] = (kk < 0 || kk > 128) ? -3e38f : biasTab[hb * 2048 + kk * 4]; }
    for (int i = tid; i < 4 * 1152; i += NTHR) { const int hb = i / 1152, kk = 639 - (i % 1152); R1[i] = (kk < 0 || kk > 128) ? -3e38f : biasTab[hb * 2048 + kk]; }
    { lf32* bl = (lf32*)(lds + L_BIASL); for (int i = tid; i < 12 * 32; i += NTHR) { const int hb = i >> 5, k = i & 31; bl[i] = biasTab[hb * 2048 + (k < 16 ? k : kBucketStart[k - 16])]; } }
    if (tid == 0) { float a1 = 0.f, a2 = 0.f; for (int i = 0; i < 32; ++i) { a1 += lam_p[i] * lam_p[32 + i]; a2 += lam_p[64 + i] * lam_p[96 + i]; }
        *(lf32*)(lds + L_LAM) = expf(a1) - expf(a2) + lambda_init; }
    __syncthreads();
}

DEVI void ph_vtrans(const gh16* vtmp, gh16* VF, lu8* lds) {
    const int tid = otid();
    LAS h16 (*tile)[72] = (LAS h16 (*)[72])lds;
    for (int it = blockIdx.x; it < 3 * 32 * 4; it += gridDim.x) {
        const int src = it >> 7, bh = (it >> 2) & 31, blk = it & 3, b = bh >> 2, hh = bh & 3;
        __syncthreads();
#pragma unroll
        for (int k = 0; k < 8; ++k) { const int idx = k * NTHR + tid, row = idx >> 3, c8 = idx & 7;
            *(LAS h16x8*)&tile[row][c8 * 8] = *(const GAS h16x8*)(vtmp + ((size_t)b * SEQ + blk * 512 + row) * 768 + src * 256 + hh * 64 + c8 * 8); }
        __syncthreads();
        gh16* out0 = VF + (src == 0 ? 0 : (src == 1 ? 3 * FSZ : 4 * FSZ));
#pragma unroll 1
        for (int k = 0; k < 8; ++k) {
            const int fl = k * NTHR + tid, lane = fl & 63, frag = (fl >> 6) & 3, dl = lane & 31, hp = lane >> 5, db = frag >> 1, sk = frag & 1;
            {
                const int tl = fl >> 8; h16x8 o;
#pragma unroll
                for (int e = 0; e < 8; ++e) o[e] = tile[tl * 32 + 16 * sk + 8 * (e >> 2) + 4 * hp + (e & 3)][db * 32 + dl];
                *(GAS h16x8*)(out0 + ((((size_t)bh * 64 + blk * 16 + tl) * 4 + frag) * 64 + lane) * 8) = o;
            }
            if (src == 0) {
                {
                    const int r4 = fl >> 10, tl = (fl >> 8) & 3; h16x8 o;
#pragma unroll
                    for (int e = 0; e < 8; ++e) o[e] = tile[4 * (tl * 32 + 16 * sk + 8 * (e >> 2) + 4 * hp + (e & 3)) + r4][db * 32 + dl];
                    *(GAS h16x8*)(out0 + FSZ + (((((size_t)bh * 4 + r4) * 16 + blk * 4 + tl) * 4 + frag) * 64 + lane) * 8) = o;
                }
                {
                    const int r = fl >> 8; h16x8 o;
#pragma unroll
                    for (int e = 0; e < 8; ++e) o[e] = tile[16 * (16 * sk + 8 * (e >> 2) + 4 * hp + (e & 3)) + r][db * 32 + dl];
                    *(GAS h16x8*)(out0 + 2 * FSZ + (((((size_t)bh * 16 + r) * 4 + blk) * 4 + frag) * 64 + lane) * 8) = o;
                }
            }
        }
    }
}

template <int NMAP, bool MASK>
DEVI void flashCD_item(int b, int hh, int qt, int hb, const gh16* Q, const gh16* KF, const gh16* VF, const gu32* mask, const gf32* biasTab, const lu8* lds,
                       const gf32* subln, float lambda_init, const gh16* gate, gh16* mix, int mixcol, int hot = 0) {
    constexpr int NKS = 4 / NMAP;
    const int lane = otid() & 63, q = lane & 31, h = lane >> 5;
    const size_t tokq = (size_t)b * SEQ + qt * 32 + q;
    const gh16* kp = KF + (size_t)(b * 4 + hh) * 64 * 2048 + lane * 8;
    const gh16* vp = VF + (size_t)(b * 4 + hh) * 64 * 2048 + lane * 8;
    h16x8 qf[NMAP][NKS], kf[NMAP][NKS];
#pragma unroll
    for (int mp = 0; mp < NMAP; ++mp)
#pragma unroll
        for (int ks = 0; ks < NKS; ++ks) {
            qf[mp][ks] = *(const GAS h16x8*)(Q + tokq * 256 + hh * 64 + (mp * NKS + ks) * 16 + 8 * h);
            kf[mp][ks] = *(const GAS h16x8*)(kp + (mp * NKS + ks) * 512);
        }
    f32x16 O[NMAP][2]; float m[NMAP], l[NMAP];
#pragma unroll
    for (int mp = 0; mp < NMAP; ++mp) { O[mp][0] = (f32x16){}; O[mp][1] = (f32x16){}; m[mp] = -1e30f; l[mp] = 0.f; }
    const lf32* nearR = (const lf32*)(lds + L_NEAR) + hb * 256;
    const gf32* bt = biasTab + hb * 2048;
    h16x8 vf[2][2], vn[2][2];
#pragma unroll
    for (int db = 0; db < 2; ++db)
#pragma unroll
        for (int sk = 0; sk < 2; ++sk) vf[db][sk] = *(const GAS h16x8*)(vp + (db * 2 + sk) * 512);
    unsigned mw = 0xffffffffu, mwn = 0xffffffffu;
    if (MASK) mw = mask[tokq * 64];
    for (int j = 0; j <= qt; ++j) {
        f32x16 S[NMAP];
#pragma unroll
        for (int mp = 0; mp < NMAP; ++mp) { S[mp] = (f32x16){};
#pragma unroll
            for (int ks = 0; ks < NKS; ++ks) S[mp] = mfma32(kf[mp][ks], qf[mp][ks], S[mp]); }
        if (j < qt && hot < 5) {
#pragma unroll
            for (int mp = 0; mp < NMAP; ++mp)
#pragma unroll
                for (int ks = 0; ks < NKS; ++ks) kf[mp][ks] = *(const GAS h16x8*)(kp + (size_t)(hot ? 0 : j + 1) * 2048 + (mp * NKS + ks) * 512);
#pragma unroll
            for (int db = 0; db < 2; ++db)
#pragma unroll
                for (int sk = 0; sk < 2; ++sk) vn[db][sk] = *(const GAS h16x8*)(vp + (size_t)(hot ? 0 : j + 1) * 2048 + (db * 2 + sk) * 512);
            if (MASK) mwn = mask[tokq * 64 + j + 1];
        }
        const int D0 = (qt - j) * 32;
        if (hot >= 3) {} else
        if (D0 < 192) {
            const lf32* tp = nearR + (223 - D0 - q + 4 * h);
#pragma unroll
            for (int r = 0; r < 16; ++r) { const float bv = tp[CROW(r)];
#pragma unroll
                for (int mp = 0; mp < NMAP; ++mp) S[mp][r] += bv; }
        } else {
            const int blo = far_bucket(D0 - 31), bhi = far_bucket(D0 + 31);
            const lf32* biasL = (const lf32*)(lds + L_BIASL) + hb * 32;
            const float lo = biasL[blo], hi = biasL[bhi];
            if (blo == bhi) {
#pragma unroll
                for (int mp = 0; mp < NMAP; ++mp) S[mp] += lo;
            } else {
                const int x = D0 + q - 4 * h - far_start(bhi);
#pragma unroll
                for (int r = 0; r < 16; ++r) { const float bv = (x >= CROW(r)) ? hi : lo;
#pragma unroll
                    for (int mp = 0; mp < NMAP; ++mp) S[mp][r] += bv; }
            }
        }
        if (MASK && hot < 3) {
#pragma unroll
            for (int r = 0; r < 16; ++r) S[0][r] = (((mw >> (4 * h)) >> CROW(r)) & 1u) ? S[0][r] : -3e38f;
        }
#pragma unroll
        for (int mp = 0; mp < NMAP; ++mp) {
            softmax_tile_h(S[mp], m[mp], l[mp], O[mp][0], O[mp][1], hot);
            const h16x8 p0 = pack8(S[mp], 0), p1 = pack8(S[mp], 1);
            if (hot < 4) {
            O[mp][0] = mfma32(vf[0][0], p0, O[mp][0]); O[mp][0] = mfma32(vf[0][1], p1, O[mp][0]);
            O[mp][1] = mfma32(vf[1][0], p0, O[mp][1]); O[mp][1] = mfma32(vf[1][1], p1, O[mp][1]);
            } else { O[mp][0][0] += (float)p0[0] + (float)p1[0]; }
        }
#pragma unroll
        for (int db = 0; db < 2; ++db)
#pragma unroll
            for (int sk = 0; sk < 2; ++sk) vf[db][sk] = vn[db][sk];
        mw = mwn;
    }
    f32x16 R0, R1;
    if (NMAP == 2) {
        const float lam = *(const lf32*)(lds + L_LAM);
        const float i0 = 1.f / xh_sum(l[0]), i1 = lam / xh_sum(l[NMAP - 1]);
        R0 = O[0][0] * i0 - O[NMAP - 1][0] * i1; R1 = O[0][1] * i0 - O[NMAP - 1][1] * i1;
        float ss = 0.f;
#pragma unroll
        for (int r = 0; r < 16; ++r) ss += R0[r] * R0[r] + R1[r] * R1[r];
        ss = xh_sum(ss);
        const float rs = rsqrtf(ss * (1.f / 64.f) + EPS) * (1.f - lambda_init);
        R0 *= rs; R1 *= rs;
    } else {
        const float il = 1.f / xh_sum(l[0]);
        R0 = O[0][0] * il; R1 = O[0][1] * il;
    }
    const gh16* gp = gate + tokq * 1024 + mixcol + hh * 64 + 4 * h;
#pragma unroll
    for (int db = 0; db < 2; ++db)
#pragma unroll
        for (int g = 0; g < 4; ++g) {
            const h16x4 gv = *(const GAS h16x4*)(gp + db * 32 + 8 * g); h16x4 o;
#pragma unroll
            for (int e = 0; e < 4; ++e) { float v = (db ? R1[4 * g + e] : R0[4 * g + e]) * (float)gv[e];
                if (NMAP == 2) v *= subln[db * 32 + 8 * g + 4 * h + e];
                o[e] = (h16)v; }
            if (!hot) *(GAS h16x4*)(mix + mixf_off(tokq, mixcol + hh * 64 + db * 32 + 8 * g + 4 * h)) = o; else asm volatile("" :: "v"(o));
        }
}

template <int BR>
DEVI void flashQ2_item(int b, int hh, int pr, const gh16* Q, const gh16* KF, const gh16* KRF, const gh16* VF, const gu32* mask, const gf32* biasTab, const lu8* lds,
                       const gh16* gate, gh16* mix, int mixcol, int hb, int hot = 0) {
    constexpr int NQK = BR == 0 ? 6 : 4;
    const int lane = otid() & 63, q = lane & 31, h = lane >> 5, bh = b * 4 + hh;
    const int qt1 = 2 * pr + 1;
    size_t tokq[2]; h16x8 qf[2][NQK];
#pragma unroll
    for (int qi = 0; qi < 2; ++qi) { tokq[qi] = (size_t)b * SEQ + (2 * pr + qi) * 32 + q;
#pragma unroll
        for (int ks = 0; ks < NQK; ++ks) qf[qi][ks] = *(const GAS h16x8*)(Q + tokq[qi] * (BR == 0 ? 384 : 256) + hh * (BR == 0 ? 96 : 64) + ks * 16 + 8 * h); }
    f32x16 O[2][2]; float m[2], l[2];
#pragma unroll
    for (int qi = 0; qi < 2; ++qi) { O[qi][0] = (f32x16){}; O[qi][1] = (f32x16){}; m[qi] = -1e30f; l[qi] = 0.f; }
    const gh16* kp = KF + (size_t)bh * 64 * 2048 + lane * 8;
    const gh16* rp = KRF + (size_t)b * 64 * 1024 + lane * 8;
    const gh16* vp = VF + (size_t)bh * 64 * 2048 + lane * 8;
    const lf32* nearR = (const lf32*)(lds + L_NEAR) + hb * 256;
    const gf32* bt = biasTab + hb * 2048;
    h16x8 kf[NQK], vf[4];
#pragma unroll
    for (int ks = 0; ks < NQK; ++ks) kf[ks] = (BR == 0 && ks >= 4) ? *(const GAS h16x8*)(rp + (ks - 4) * 512) : *(const GAS h16x8*)(kp + ks * 512);
    unsigned mw[2] = {0xffffffffu, 0xffffffffu}, mwn[2] = {0xffffffffu, 0xffffffffu};
    if (BR == 1) { mw[0] = mask[tokq[0] * 64]; mw[1] = mask[tokq[1] * 64]; }
#pragma unroll 1
    for (int j = 0; j <= qt1; ++j) {
#pragma unroll
        for (int f = 0; f < 4; ++f) vf[f] = *(const GAS h16x8*)(vp + (size_t)(hot ? 0 : j) * 2048 + f * 512);
        f32x16 S[2];
#pragma unroll
        for (int qi = 0; qi < 2; ++qi) { S[qi] = (f32x16){};
#pragma unroll
            for (int ks = 0; ks < NQK; ++ks) S[qi] = mfma32(kf[ks], qf[qi][ks], S[qi]); }
        if (j < qt1 && hot < 5) {
#pragma unroll
            for (int ks = 0; ks < NQK; ++ks) kf[ks] = (BR == 0 && ks >= 4) ? *(const GAS h16x8*)(rp + (size_t)(hot ? 0 : j + 1) * 1024 + (ks - 4) * 512) : *(const GAS h16x8*)(kp + (size_t)(hot ? 0 : j + 1) * 2048 + ks * 512);
            if (BR == 1) { mwn[0] = mask[tokq[0] * 64 + (j + 1 < qt1 ? j + 1 : j)]; mwn[1] = mask[tokq[1] * 64 + j + 1]; }
        }
#pragma unroll
        for (int qi = 0; qi < 2; ++qi) {
            const int qt = 2 * pr + qi;
            if (j <= qt) {
                const int D0 = (qt - j) * 32;
                if (hot >= 3) {} else
                if (BR == 0) {
                    if (D0 == 0) {
#pragma unroll
                        for (int r = 0; r < 16; ++r) S[qi][r] = (CROW(r) + 4 * h > q) ? -3e38f : S[qi][r];
                    }
                } else {
                    if (D0 < 192) {
                        const lf32* tp = nearR + (223 - D0 - q + 4 * h);
#pragma unroll
                        for (int r = 0; r < 16; ++r) S[qi][r] += tp[CROW(r)];
                    } else {
                        const int blo = far_bucket(D0 - 31), bhi = far_bucket(D0 + 31);
                        const lf32* biasL = (const lf32*)(lds + L_BIASL) + hb * 32;
                        const float lo = biasL[blo], hi = biasL[bhi];
                        if (blo == bhi) S[qi] += lo;
                        else {
                            const int x = D0 + q - 4 * h - far_start(bhi);
#pragma unroll
                            for (int r = 0; r < 16; ++r) S[qi][r] += (x >= CROW(r)) ? hi : lo;
                        }
                    }
                    const unsigned mm = mw[qi] >> (4 * h);
#pragma unroll
                    for (int r = 0; r < 16; ++r) S[qi][r] = ((mm >> CROW(r)) & 1u) ? S[qi][r] : -3e38f;
                }
                softmax_tile_h(S[qi], m[qi], l[qi], O[qi][0], O[qi][1], hot);
                const h16x8 p0 = pack8(S[qi], 0), p1 = pack8(S[qi], 1);
                if (hot < 4) {
                O[qi][0] = mfma32(vf[0], p0, O[qi][0]); O[qi][0] = mfma32(vf[1], p1, O[qi][0]);
                O[qi][1] = mfma32(vf[2], p0, O[qi][1]); O[qi][1] = mfma32(vf[3], p1, O[qi][1]);
                } else { O[qi][0][0] += (float)p0[0] + (float)p1[0]; }
            }
        }
        mw[0] = mwn[0]; mw[1] = mwn[1];
    }
#pragma unroll
    for (int qi = 0; qi < 2; ++qi) {
        const float il = 1.f / xh_sum(l[qi]);
        const gh16* gp = gate + tokq[qi] * 1024 + mixcol + hh * 64 + 4 * h;
#pragma unroll
        for (int db = 0; db < 2; ++db)
#pragma unroll
            for (int g = 0; g < 4; ++g) {
                const h16x4 gv = *(const GAS h16x4*)(gp + db * 32 + 8 * g); h16x4 o;
#pragma unroll
                for (int e = 0; e < 4; ++e) o[e] = (h16)(O[qi][db][4 * g + e] * il * (float)gv[e]);
                if (!hot) *(GAS h16x4*)(mix + mixf_off(tokq[qi], mixcol + hh * 64 + db * 32 + 8 * g + 4 * h)) = o; else asm volatile("" :: "v"(o));
            }
    }
}

template <int BR>
DEVI void flashWG_item(int b, int hh, int Qb, const gh16* Q, const gh16* KF, const gh16* KRF, const gh16* VF, const gu32* mask, lu8* lds,
                       const gf32* subln, float lambda_init, const gh16* gate, gh16* mix, int mixcol, int hb) {
    constexpr int NMAP = BR == 2 ? 2 : 1, NQK = BR == 0 ? 6 : 4, NKS = NQK / NMAP, NP = NQK + 4, TB = NP * 1024, NDMA = BR == 2 ? 1 : 2, DD = 3;
    const int tid = otid(), lane = tid & 63, q = lane & 31, h = lane >> 5, wv = __builtin_amdgcn_readfirstlane(tid >> 6);
    const int qt = 8 * Qb + wv, last = 8 * Qb + 7, bh = b * 4 + hh;
    const size_t tokq = (size_t)b * SEQ + qt * 32 + q;
    h16x8 qf[NQK];
#pragma unroll
    for (int ks = 0; ks < NQK; ++ks) qf[ks] = *(const GAS h16x8*)(Q + tokq * (BR == 0 ? 384 : 256) + hh * (BR == 0 ? 96 : 64) + ks * 16 + 8 * h);
    f32x16 O[NMAP][2]; float m[NMAP], l[NMAP];
#pragma unroll
    for (int mp = 0; mp < NMAP; ++mp) { O[mp][0] = (f32x16){}; O[mp][1] = (f32x16){}; m[mp] = -1e30f; l[mp] = 0.f; }
    asm volatile("s_waitcnt vmcnt(0)" ::: "memory");
    __syncthreads();
    lu8* ring = lds + L_RING; lu8* mring = lds + L_MRING;
    auto issue = [&](int jt) {
        const int jc = jt < last ? jt : last, slot = jt & 3;
        {
            const int pc = wv;
            const gh16* src = pc < 4 ? KF + ((size_t)bh * 64 + jc) * 2048 + pc * 512
                            : (BR == 0 && pc < 6) ? KRF + ((size_t)b * 64 + jc) * 1024 + (pc - 4) * 512
                            : VF + ((size_t)bh * 64 + jc) * 2048 + (pc - NQK) * 512;
            __builtin_amdgcn_global_load_lds((const GAS unsigned*)(src + lane * 8), (LAS unsigned*)(ring + slot * TB + pc * 1024), 16, 0, 0);
        }
        if (BR == 0) {
            const int pc = 8 + (wv & 1);
            const gh16* src = VF + ((size_t)bh * 64 + jc) * 2048 + (pc - NQK) * 512;
            __builtin_amdgcn_global_load_lds((const GAS unsigned*)(src + lane * 8), (LAS unsigned*)(ring + slot * TB + pc * 1024), 16, 0, 0);
        }
        if (BR == 1) __builtin_amdgcn_global_load_lds((const GAS unsigned*)(mask + tokq * 64 + (jc <= qt ? jc : qt)), (LAS unsigned*)(mring + (slot * 8 + wv) * 256), 4, 0, 0);
    };
#pragma unroll
    for (int jt = 0; jt < DD; ++jt) issue(jt);
    const lf32* nearR = (const lf32*)(lds + L_NEAR) + hb * 256;
    const lf32* biasL = (const lf32*)(lds + L_BIASL) + hb * 32;
    f32x16 S[NMAP], Sn[NMAP];
    asm volatile("s_waitcnt vmcnt(%0)" :: "n"((DD - 1) * NDMA) : "memory");
    __builtin_amdgcn_s_barrier();
#pragma unroll
    for (int mp = 0; mp < NMAP; ++mp) { S[mp] = (f32x16){};
#pragma unroll
        for (int ks = 0; ks < NKS; ++ks) S[mp] = mfma32(*(const LAS h16x8*)(ring + lane * 16 + (mp * NKS + ks) * 1024), qf[mp * NKS + ks], S[mp]); }
#pragma unroll 1
    for (int j = 0; j <= last; ++j) {
        asm volatile("s_waitcnt vmcnt(%0)" :: "n"((DD - 2) * NDMA) : "memory");
        __builtin_amdgcn_s_barrier();
        issue(j + DD);
        if (j <= qt) {
            const lu8* sl = ring + (j & 3) * TB + lane * 16;
            if (j + 1 <= qt) {
                const lu8* sn = ring + ((j + 1) & 3) * TB + lane * 16;
#pragma unroll
                for (int mp = 0; mp < NMAP; ++mp) { Sn[mp] = (f32x16){};
#pragma unroll
                    for (int ks = 0; ks < NKS; ++ks) Sn[mp] = mfma32(*(const LAS h16x8*)(sn + (mp * NKS + ks) * 1024), qf[mp * NKS + ks], Sn[mp]); }
            }
            h16x8 vf[4];
#pragma unroll
            for (int f = 0; f < 4; ++f) vf[f] = *(const LAS h16x8*)(sl + (NQK + f) * 1024);
            const int D0 = (qt - j) * 32;
            if (BR == 0) {
                if (D0 == 0) {
#pragma unroll
                    for (int r = 0; r < 16; ++r) S[0][r] = (CROW(r) + 4 * h > q) ? -3e38f : S[0][r];
                }
            } else if (D0 < 192) {
                const lf32* tp = nearR + (223 - D0 - q + 4 * h);
#pragma unroll
                for (int r = 0; r < 16; ++r) { const float bv = tp[CROW(r)];
#pragma unroll
                    for (int mp = 0; mp < NMAP; ++mp) S[mp][r] += bv; }
            } else {
                int blo = 23, bhi = 23;
#pragma unroll
                for (int jj = 8; jj < 16; ++jj) { blo += (D0 - 31 >= kBucketStart[jj]) ? 1 : 0; bhi += (D0 + 31 >= kBucketStart[jj]) ? 1 : 0; }
                const float lo = biasL[blo], hi = biasL[bhi];
                if (blo == bhi) {
#pragma unroll
                    for (int mp = 0; mp < NMAP; ++mp) S[mp] += lo;
                } else {
                    const int x = D0 + q - 4 * h - kBucketStart[bhi - 16];
#pragma unroll
                    for (int r = 0; r < 16; ++r) { const float bv = (x >= CROW(r)) ? hi : lo;
#pragma unroll
                        for (int mp = 0; mp < NMAP; ++mp) S[mp][r] += bv; }
                }
            }
            if (BR == 1) {
                const unsigned mw = *(const LAS unsigned*)(mring + ((j & 3) * 8 + wv) * 256 + lane * 4) >> (4 * h);
#pragma unroll
                for (int r = 0; r < 16; ++r) S[0][r] = ((mw >> CROW(r)) & 1u) ? S[0][r] : -3e38f;
            }
#pragma unroll
            for (int mp = 0; mp < NMAP; ++mp) {
                softmax_tile(S[mp], m[mp], l[mp], O[mp][0], O[mp][1]);
                const h16x8 p0 = pack8(S[mp], 0), p1 = pack8(S[mp], 1);
                O[mp][0] = mfma32(vf[0], p0, O[mp][0]); O[mp][0] = mfma32(vf[1], p1, O[mp][0]);
                O[mp][1] = mfma32(vf[2], p0, O[mp][1]); O[mp][1] = mfma32(vf[3], p1, O[mp][1]);
            }
#pragma unroll
            for (int mp = 0; mp < NMAP; ++mp) S[mp] = Sn[mp];
        }
    }
    asm volatile("s_waitcnt vmcnt(0)" ::: "memory");
    f32x16 R0, R1;
    if (NMAP == 2) {
        const float lam = *(const lf32*)(lds + L_LAM);
        const float i0 = 1.f / xh_sum(l[0]), i1 = lam / xh_sum(l[NMAP - 1]);
        R0 = O[0][0] * i0 - O[NMAP - 1][0] * i1; R1 = O[0][1] * i0 - O[NMAP - 1][1] * i1;
        float ss = 0.f;
#pragma unroll
        for (int r = 0; r < 16; ++r) ss += R0[r] * R0[r] + R1[r] * R1[r];
        ss = xh_sum(ss);
        const float rs = rsqrtf(ss * (1.f / 64.f) + EPS) * (1.f - lambda_init);
        R0 *= rs; R1 *= rs;
    } else {
        const float il = 1.f / xh_sum(l[0]);
        R0 = O[0][0] * il; R1 = O[0][1] * il;
    }
    const gh16* gp = gate + tokq * 1024 + mixcol + hh * 64 + 4 * h;
#pragma unroll
    for (int db = 0; db < 2; ++db)
#pragma unroll
        for (int g = 0; g < 4; ++g) {
            const h16x4 gv = *(const GAS h16x4*)(gp + db * 32 + 8 * g); h16x4 o;
#pragma unroll
            for (int e = 0; e < 4; ++e) { float v = (db ? R1[4 * g + e] : R0[4 * g + e]) * (float)gv[e];
                if (NMAP == 2) v *= subln[db * 32 + 8 * g + 4 * h + e];
                o[e] = (h16)v; }
            *(GAS h16x4*)(mix + mixf_off(tokq, mixcol + hh * 64 + db * 32 + 8 * g + 4 * h)) = o;
        }
}

constexpr int L_RING2 = 41984, L_MRING2 = L_RING2 + 8 * 10240, L_WQ2 = L_MRING2 + 8 * 8 * 256;
template <int BR>
DEVI void flashWG2_item(int b, int hh, int Qb, const gh16* Q, const gh16* KF, const gh16* KRF, const gh16* VF, const gu32* mask, lu8* lds,
                        const gf32* subln, float lambda_init, const gh16* gate, gh16* mix, int mixcol, int hb) {
    constexpr int NMAP = BR == 2 ? 2 : 1, NQK = BR == 0 ? 6 : 4, NKS = NQK / NMAP, NP = NQK + 4, TB = NP * 1024;
    const int tid = otid(), lane = tid & 63, q = lane & 31, h = lane >> 5, wv = __builtin_amdgcn_readfirstlane(tid >> 6);
    const int qt = 8 * Qb + wv, NS = 2 * Qb + 2, bh = b * 4 + hh;
    const size_t tokq = (size_t)b * SEQ + qt * 32 + q;
    h16x8 qf[NQK];
#pragma unroll
    for (int ks = 0; ks < NQK; ++ks) qf[ks] = *(const GAS h16x8*)(Q + tokq * (BR == 0 ? 384 : 256) + hh * (BR == 0 ? 96 : 64) + ks * 16 + 8 * h);
    f32x16 O[NMAP][2]; float m[NMAP], l[NMAP];
#pragma unroll
    for (int mp = 0; mp < NMAP; ++mp) { O[mp][0] = (f32x16){}; O[mp][1] = (f32x16){}; m[mp] = -1e30f; l[mp] = 0.f; }
    lu8* ring = lds + L_RING2; lu8* mring = lds + L_MRING2;
    auto issue = [&](int st) {
#pragma unroll
        for (int u = 0; u < (4 * NP + 7) / 8; ++u) {
            const int id = wv + 8 * u;
            if (id < 4 * NP) {
                const int ti = id / NP, pc = id % NP, jt = 4 * st + ti, slot = jt & 7;
                const gh16* src = pc < 4 ? KF + ((size_t)bh * 64 + jt) * 2048 + pc * 512
                                : (BR == 0 && pc < 6) ? KRF + ((size_t)b * 64 + jt) * 1024 + (pc - 4) * 512
                                : VF + ((size_t)bh * 64 + jt) * 2048 + (pc - NQK) * 512;
                __builtin_amdgcn_global_load_lds((const GAS unsigned*)(src + lane * 8), (LAS unsigned*)(ring + slot * TB + pc * 1024), 16, 0, 0);
            }
        }
        if (BR == 1) {
#pragma unroll
            for (int ti = 0; ti < 4; ++ti) { const int jt = 4 * st + ti;
                __builtin_amdgcn_global_load_lds((const GAS unsigned*)(mask + tokq * 64 + (jt <= qt ? jt : qt)), (LAS unsigned*)(mring + ((jt & 7) * 8 + wv) * 256), 4, 0, 0); }
        }
    };
    asm volatile("s_waitcnt vmcnt(0)" ::: "memory");
    __syncthreads();
    issue(0);
    const lf32* nearR = (const lf32*)(lds + L_NEAR) + hb * 256;
    const lf32* biasL = (const lf32*)(lds + L_BIASL) + hb * 32;
#pragma unroll 1
    for (int st = 0; st < NS; ++st) {
        asm volatile("s_waitcnt vmcnt(0)" ::: "memory");
        __builtin_amdgcn_s_barrier();
        if (st + 1 < NS) issue(st + 1);
#pragma unroll 1
        for (int j = 4 * st; j < 4 * st + 4; ++j) {
            if (j > qt) break;
            const lu8* sl = ring + (j & 7) * TB + lane * 16;
            f32x16 S[NMAP];
#pragma unroll
            for (int mp = 0; mp < NMAP; ++mp) { S[mp] = (f32x16){};
#pragma unroll
                for (int ks = 0; ks < NKS; ++ks) S[mp] = mfma32(*(const LAS h16x8*)(sl + (mp * NKS + ks) * 1024), qf[mp * NKS + ks], S[mp]); }
            h16x8 vf[4];
#pragma unroll
            for (int f = 0; f < 4; ++f) vf[f] = *(const LAS h16x8*)(sl + (NQK + f) * 1024);
            const int D0 = (qt - j) * 32;
            if (BR == 0) {
                if (D0 == 0) {
#pragma unroll
                    for (int r = 0; r < 16; ++r) S[0][r] = (CROW(r) + 4 * h > q) ? -3e38f : S[0][r];
                }
            } else if (D0 < 192) {
                const lf32* tp = nearR + (223 - D0 - q + 4 * h);
#pragma unroll
                for (int r = 0; r < 16; ++r) { const float bv = tp[CROW(r)];
#pragma unroll
                    for (int mp = 0; mp < NMAP; ++mp) S[mp][r] += bv; }
            } else {
                const int blo = far_bucket(D0 - 31), bhi = far_bucket(D0 + 31);
                const float lo = biasL[blo], hi = biasL[bhi];
                if (blo == bhi) {
#pragma unroll
                    for (int mp = 0; mp < NMAP; ++mp) S[mp] += lo;
                } else {
                    const int x = D0 + q - 4 * h - far_start(bhi);
#pragma unroll
                    for (int r = 0; r < 16; ++r) { const float bv = (x >= CROW(r)) ? hi : lo;
#pragma unroll
                        for (int mp = 0; mp < NMAP; ++mp) S[mp][r] += bv; }
                }
            }
            if (BR == 1) {
                const unsigned mw = *(const LAS unsigned*)(mring + ((j & 7) * 8 + wv) * 256 + lane * 4) >> (4 * h);
#pragma unroll
                for (int r = 0; r < 16; ++r) S[0][r] = ((mw >> CROW(r)) & 1u) ? S[0][r] : -3e38f;
            }
#pragma unroll
            for (int mp = 0; mp < NMAP; ++mp) {
                softmax_tile(S[mp], m[mp], l[mp], O[mp][0], O[mp][1]);
                const h16x8 p0 = pack8(S[mp], 0), p1 = pack8(S[mp], 1);
                O[mp][0] = mfma32(vf[0], p0, O[mp][0]); O[mp][0] = mfma32(vf[1], p1, O[mp][0]);
                O[mp][1] = mfma32(vf[2], p0, O[mp][1]); O[mp][1] = mfma32(vf[3], p1, O[mp][1]);
            }
        }
    }
    asm volatile("s_waitcnt vmcnt(0)" ::: "memory");
    f32x16 R0, R1;
    if (NMAP == 2) {
        const float lam = *(const lf32*)(lds + L_LAM);
        const float i0 = 1.f / xh_sum(l[0]), i1 = lam / xh_sum(l[NMAP - 1]);
        R0 = O[0][0] * i0 - O[NMAP - 1][0] * i1; R1 = O[0][1] * i0 - O[NMAP - 1][1] * i1;
        float ss = 0.f;
#pragma unroll
        for (int r = 0; r < 16; ++r) ss += R0[r] * R0[r] + R1[r] * R1[r];
        ss = xh_sum(ss);
        const float rs = rsqrtf(ss * (1.f / 64.f) + EPS) * (1.f - lambda_init);
        R0 *= rs; R1 *= rs;
    } else {
        const float il = 1.f / xh_sum(l[0]);
        R0 = O[0][0] * il; R1 = O[0][1] * il;
    }
    const gh16* gp = gate + tokq * 1024 + mixcol + hh * 64 + 4 * h;
#pragma unroll
    for (int db = 0; db < 2; ++db)
#pragma unroll
        for (int g = 0; g < 4; ++g) {
            const h16x4 gv = *(const GAS h16x4*)(gp + db * 32 + 8 * g); h16x4 o;
#pragma unroll
            for (int e = 0; e < 4; ++e) { float v = (db ? R1[4 * g + e] : R0[4 * g + e]) * (float)gv[e];
                if (NMAP == 2) v *= subln[db * 32 + 8 * g + 4 * h + e];
                o[e] = (h16)v; }
            *(GAS h16x4*)(mix + mixf_off(tokq, mixcol + hh * 64 + db * 32 + 8 * g + 4 * h)) = o;
        }
}


DEVI void probe_item(int ntile, int mode) {
    const int lane = otid() & 63;
    h16x8 a, bq;
#pragma unroll
    for (int e = 0; e < 8; ++e) { a[e] = (h16)(lane * 0.001f + e); bq[e] = (h16)(e * 0.01f); }
    f32x16 O0 = {}, O1 = {}; float m = -1e30f, l = 0.f;
#pragma unroll 1
    for (int j = 0; j < ntile; ++j) {
        f32x16 S = {};
#pragma unroll
        for (int ks = 0; ks < 6; ++ks) S = mfma32(a, bq, S);
        if (mode >= 1) softmax_tile(S, m, l, O0, O1);
        const h16x8 p0 = pack8(S, 0), p1 = pack8(S, 1);
        O0 = mfma32(a, p0, O0); O0 = mfma32(a, p1, O0);
        O1 = mfma32(a, p0, O1); O1 = mfma32(a, p1, O1);
    }
    asm volatile("" :: "v"(O0), "v"(O1), "v"(l));
}
DEVI void flashB_tile(const h16x8 (&qf)[4], const gh16* kfr, const gh16* vfr, const lf32* tp, f32x16& O0, f32x16& O1, float& m, float& l, int hot) {
    h16x8 vf[4], kf[4];
#pragma unroll
    for (int f = 0; f < 4; ++f) { kf[f] = *(const GAS h16x8*)(kfr + f * 512); vf[f] = *(const GAS h16x8*)(vfr + f * 512); }
    f32x16 S = {};
#pragma unroll
    for (int ks = 0; ks < 4; ++ks) S = mfma32(kf[ks], qf[ks], S);
    if (hot < 3) {
#pragma unroll
    for (int r = 0; r < 16; ++r) S[r] += tp[CROW(r)];
    }
    softmax_tile_h(S, m, l, O0, O1, hot);
    const h16x8 p0 = pack8(S, 0), p1 = pack8(S, 1);
    if (hot < 4) {
    O0 = mfma32(vf[0], p0, O0); O0 = mfma32(vf[1], p1, O0);
    O1 = mfma32(vf[2], p0, O1); O1 = mfma32(vf[3], p1, O1);
    } else { O0[0] += (float)p0[0] + (float)p1[0]; }
}
DEVI void flashB_item(int b, int hh, int r, int qg, const gh16* Q, const gh16* KF, const gh16* VF, const lu8* lds, const gh16* gate, gh16* mix, int hot = 0) {
    const int lane = otid() & 63, q = lane & 31, h = lane >> 5, bh = b * 4 + hh;
    const size_t tokq = (size_t)b * SEQ + qg * 512 + 16 * q + r;
    h16x8 qf[4];
#pragma unroll
    for (int ks = 0; ks < 4; ++ks) qf[ks] = *(const GAS h16x8*)(Q + tokq * 256 + hh * 64 + ks * 16 + 8 * h);
    f32x16 O0 = {}, O1 = {}; float m = -1e30f, l = 0.f;
    {
        const lf32* R3 = (const lf32*)(lds + L_R3) + hh * 192;
        const size_t base = 2 * FSZ + ((size_t)bh * 16 + r) * 4 * 2048 + lane * 8;
        for (int tl = (qg >= 4 ? qg - 4 : 0); tl <= qg; ++tl) {
            const int c = qg * 32 + q - tl * 32;
            flashB_tile(qf, KF + base + (size_t)(hot ? 0 : tl) * 2048, VF + base + (size_t)(hot ? 0 : tl) * 2048, R3 + (159 - c + 4 * h), O0, O1, m, l, hot);
        }
    }
    {
        const lf32* R2 = (const lf32*)(lds + L_R2) + hh * 384;
        const size_t base = FSZ + ((size_t)bh * 4 + (r & 3)) * 16 * 2048 + lane * 8;
        for (int tl = (qg >= 1 ? qg * 4 - 4 : 0); tl <= qg * 4 + 3; ++tl) {
            const int c = qg * 128 + 4 * q + (r >> 2) - tl * 32;
            flashB_tile(qf, KF + base + (size_t)(hot ? 0 : tl) * 2048, VF + base + (size_t)(hot ? 0 : tl) * 2048, R2 + (255 - c + 4 * h), O0, O1, m, l, hot);
        }
    }
    {
        const lf32* R1 = (const lf32*)(lds + L_R1) + hh * 1152;
        const size_t base = (size_t)bh * 64 * 2048 + lane * 8;
        for (int tl = (qg >= 1 ? qg * 16 - 4 : 0); tl <= qg * 16 + 15; ++tl) {
            const int c = qg * 512 + 16 * q + r - tl * 32;
            flashB_tile(qf, KF + base + (size_t)(hot ? 0 : tl) * 2048, VF + base + (size_t)(hot ? 0 : tl) * 2048, R1 + (639 - c + 4 * h), O0, O1, m, l, hot);
        }
    }
    const float il = 1.f / xh_sum(l);
    const gh16* gp = gate + tokq * 1024 + 256 + hh * 64 + 4 * h;
#pragma unroll
    for (int db = 0; db < 2; ++db)
#pragma unroll
        for (int g = 0; g < 4; ++g) {
            const h16x4 gv = *(const GAS h16x4*)(gp + db * 32 + 8 * g); h16x4 o;
#pragma unroll
            for (int e = 0; e < 4; ++e) o[e] = (h16)((db ? O1[4 * g + e] : O0[4 * g + e]) * il * (float)gv[e]);
            if (!hot) *(GAS h16x4*)(mix + mixf_off(tokq, 256 + hh * 64 + db * 32 + 8 * g + 4 * h)) = o; else asm volatile("" :: "v"(o));
        }
}

typedef float f32x4v __attribute__((ext_vector_type(4)));
typedef unsigned u32x4v __attribute__((ext_vector_type(4)));
DEVI f32x4v mfma16(h16x8 a, h16x8 b, f32x4v c) { return __builtin_amdgcn_mfma_f32_16x16x32_f16(a, b, c, 0, 0, 0); }
constexpr int TK_KSTRIDE = 2308;
constexpr int TK_KEYS = 0, TK_MISC = 16 * TK_KSTRIDE * 4, TK_END = TK_MISC + 64;
DEVI void topk_item(int b, int T16, const gh16* idx, const gh16* KIF, gu32* mask, lu8* lds, int skip = 0) {
    const int tid = otid(), lane = tid & 63, wv = __builtin_amdgcn_readfirstlane(tid >> 6);
    const int t0 = T16 * 16;
    lu32* keys = (lu32*)(lds + TK_KEYS);
    if (T16 < 16) {
        const int sq = tid & 15, sc_ = tid >> 4;
        const unsigned tk = (unsigned)(b * SEQ + t0 + sq) * 64u + 2u * sc_;
        unsigned ones = 0xffffffffu; asm volatile("" : "+v"(ones));
        if (sc_ < 4) { mask[tk] = ones; mask[tk + 1] = ones; }
        return;
    }
    __syncthreads();
    if (skip == 2) return;
    {
        const int q = lane & 15, kq = lane >> 4;
        const size_t tokq = (size_t)b * SEQ + t0 + q;
        h16x8 qf[8], ql; float sg[8]; float P = 0.f, N = 0.f; float lin[8];
#pragma unroll
        for (int e = 0; e < 8; ++e) lin[e] = 0.f;
#pragma unroll
        for (int hd = 0; hd < 8; ++hd) {
            const h16x8 raw = *(const GAS h16x8*)(idx + tokq * 320 + hd * 32 + 8 * kq);
            const float c = (float)idx[tokq * 320 + 288 + hd] * (0.5f * 0.35355339059327373f), ac = fabsf(c);
            float nn = 0.f;
#pragma unroll
            for (int e = 0; e < 8; ++e) { const float v = (float)raw[e]; nn += v * v; lin[e] += c * v; qf[hd][e] = (h16)(ac * v); }
            nn += __shfl_xor(nn, 16); nn += __shfl_xor(nn, 32);
            const float bd = 2.f * ac * sqrtf(nn) * 12.f;
            if (c > 0.f) P += bd; else N += bd;
            sg[hd] = c >= 0.f ? 1.f : -1.f;
        }
#pragma unroll
        for (int e = 0; e < 8; ++e) ql[e] = (h16)lin[e];
        const float lo = -N, scl = 2097151.f / fmaxf(P + N, 1e-20f);
        const int nblk = T16 + 1, nblk2 = (nblk + 1) & ~1;
#pragma unroll 1
        for (int rpS = 0; rpS < (DUP_PHASE == 7 ? 2 : 1); ++rpS)
        for (int kb0 = wv; kb0 < nblk2; kb0 += 32) {
            h16x8 kf4[4];
#pragma unroll
            for (int u = 0; u < 4; ++u) { const int kb = kb0 + 8 * u < nblk ? kb0 + 8 * u : 0; kf4[u] = *(const GAS h16x8*)(KIF + ((size_t)(b * 128 + kb) * 64 + lane) * 8); }
#pragma unroll
            for (int u = 0; u < 4; ++u) {
                const int kb = kb0 + 8 * u;
                if (kb < nblk2) {
                    const h16x8 kf = kf4[u];
                    f32x4v sc = mfma16(kf, ql, (f32x4v){0.f, 0.f, 0.f, 0.f});
#pragma unroll
                    for (int hd = 0; hd < 8; ++hd) { const f32x4v x = mfma16(kf, qf[hd], (f32x4v){0.f, 0.f, 0.f, 0.f});
#pragma unroll
                        for (int r = 0; r < 4; ++r) sc[r] = __builtin_fmaf(__builtin_fabsf(x[r]), sg[hd], sc[r]); }
                    u32x4v kv;
#pragma unroll
                    for (int r = 0; r < 4; ++r) { const float x = fminf(fmaxf((sc[r] - lo) * scl, 0.f), 2097151.f); unsigned uu = (unsigned)x + 1u;
                        if (16 * kb + 4 * kq + r > t0 + q) uu = 0u; kv[r] = uu; }
                    const int k = 16 * kb + 4 * kq;
                    *(LAS u32x4v*)(keys + q * TK_KSTRIDE + k + 4 * (k >> 5)) = kv;
                }
            }
        }
    }
    __syncthreads();
    if (skip == 1) return;
    const int nw32 = (t0 + 16 + 31) >> 5;
    unsigned ka[32], kc[32];
    {
        const lu32* ra = keys + (2 * wv) * TK_KSTRIDE + 36 * lane, * rc = keys + (2 * wv + 1) * TK_KSTRIDE + 36 * lane;
        const bool have = lane < nw32;
#pragma unroll
        for (int i = 0; i < 8; ++i) {
            u32x4v va = {0u, 0u, 0u, 0u}, vc = {0u, 0u, 0u, 0u};
            if (have) { va = *(const LAS u32x4v*)(ra + 4 * i); vc = *(const LAS u32x4v*)(rc + 4 * i); }
#pragma unroll
            for (int r = 0; r < 4; ++r) { ka[4 * i + r] = va[r]; kc[4 * i + r] = vc[r]; }
        }
    }
    typedef unsigned short u16x2 __attribute__((ext_vector_type(2)));
    u16x2 kha[16], khc[16];
#pragma unroll
    for (int i = 0; i < 16; ++i) { kha[i] = (u16x2){(unsigned short)(ka[2 * i] >> 7), (unsigned short)(ka[2 * i + 1] >> 7)}; khc[i] = (u16x2){(unsigned short)(kc[2 * i] >> 7), (unsigned short)(kc[2 * i + 1] >> 7)}; }
    auto wave_sum2 = [&](unsigned v) -> unsigned {
        v += (unsigned)__builtin_amdgcn_update_dpp(0, (int)v, 0x111, 0xf, 0xf, false);
        v += (unsigned)__builtin_amdgcn_update_dpp(0, (int)v, 0x112, 0xf, 0xf, false);
        v += (unsigned)__builtin_amdgcn_update_dpp(0, (int)v, 0x114, 0xf, 0xf, false);
        v += (unsigned)__builtin_amdgcn_update_dpp(0, (int)v, 0x118, 0xf, 0xf, false);
        v += (unsigned)__builtin_amdgcn_update_dpp(0, (int)v, 0x142, 0xa, 0xf, false);
        v += (unsigned)__builtin_amdgcn_update_dpp(0, (int)v, 0x143, 0xc, 0xf, false);
        return (unsigned)__builtin_amdgcn_readlane((int)v, 63);
    };
    auto count2 = [&](unsigned Pa, unsigned Pc) -> unsigned {
        const unsigned short pa1 = (unsigned short)(Pa - 1u), pc1 = (unsigned short)(Pc - 1u);
        u16x2 aa = {0, 0}, ac = {0, 0};
#pragma unroll
        for (int i = 0; i < 16; ++i) { aa += ((u16x2){pa1, pa1} - kha[i]) >> 15; ac += ((u16x2){pc1, pc1} - khc[i]) >> 15; }
        return wave_sum2(((unsigned)aa[0] + (unsigned)aa[1]) | (((unsigned)ac[0] + (unsigned)ac[1]) << 16));
    };
    unsigned T15a = 0u, T15c = 0u;
#pragma unroll 1
    for (int bit = 14; bit >= 0; --bit) { const unsigned Pa = T15a | (1u << bit), Pc = T15c | (1u << bit); const unsigned c = count2(Pa, Pc);
        if ((c & 0xffffu) >= 256u) T15a = Pa;
        if ((c >> 16) >= 256u) T15c = Pc; }
    const unsigned cab = count2(T15a + 1u, T15c + 1u);
    unsigned Tq[2];
#pragma unroll
    for (int qq = 0; qq < 2; ++qq) {
        const unsigned T15 = qq ? T15c : T15a; const int above = (int)(qq ? (cab >> 16) : (cab & 0xffffu));
        unsigned c0 = 0u, c1 = 0u, nc = 0u;
#pragma unroll
        for (int i = 0; i < 32; ++i) { const unsigned k = qq ? kc[i] : ka[i]; const bool is = (k >> 7) == T15 && k != 0u; const unsigned v = (k & 127u) + 1u;
            c1 = (is && nc == 1u) ? v : c1; c0 = (is && nc == 0u) ? v : c0; nc += is ? 1u : 0u; }
        unsigned low = 0u;
        if (__ballot(nc > 2u) == 0ull) {
#pragma unroll 1
            for (int bit = 6; bit >= 0; --bit) { const unsigned P = low | (1u << bit);
                const unsigned lc = (c0 > P ? 1u : 0u) + (c1 > P ? 1u : 0u);
                const int c = above + __builtin_popcountll(__ballot(lc & 1u)) + 2 * __builtin_popcountll(__ballot(lc >> 1));
                if (c >= 256) low = P; }
        } else {
#pragma unroll 1
            for (int bit = 6; bit >= 0; --bit) { const unsigned P = (T15 << 7) | low | (1u << bit);
                unsigned lc = 0u;
#pragma unroll
                for (int i = 0; i < 32; ++i) lc += ((qq ? kc[i] : ka[i]) >= P) ? 1u : 0u;
                int c = 0;
#pragma unroll
                for (int bp = 0; bp < 6; ++bp) c += __builtin_popcountll(__ballot((lc >> bp) & 1u)) << bp;
                if (c >= 256) low |= (1u << bit); }
        }
        Tq[qq] = (T15 << 7) | low;
    }
    const unsigned Ta = Tq[0], Tc = Tq[1];
#pragma unroll
    for (int qq = 0; qq < 2; ++qq) {
        const unsigned T = qq ? Tc : Ta;
        unsigned gt = 0u, eq = 0u;
#pragma unroll
        for (int i = 31; i >= 0; --i) { const unsigned k = qq ? kc[i] : ka[i]; gt = (gt << 1) | (k > T ? 1u : 0u); eq = (eq << 1) | (k == T ? 1u : 0u); }
        const unsigned pcg = (unsigned)__builtin_popcount(gt), pce = (unsigned)__builtin_popcount(eq);
        int totg = 0, before = 0;
#pragma unroll
        for (int bp = 0; bp < 6; ++bp) {
            totg += __builtin_popcountll(__ballot((pcg >> bp) & 1u)) << bp;
            const unsigned long long mk = __ballot((pce >> bp) & 1u);
            before += (int)__builtin_amdgcn_mbcnt_hi((unsigned)(mk >> 32), __builtin_amdgcn_mbcnt_lo((unsigned)mk, 0u)) << bp;
        }
        const int R = 256 - totg;
        int allow = R - before; allow = allow < 0 ? 0 : (allow > pce ? pce : allow);
        unsigned keep = eq;
        if (allow < pce) { keep = 0u; unsigned e = eq; for (int c = 0; c < allow; ++c) { const unsigned bit = e & (0u - e); keep |= bit; e ^= bit; } }
        if (lane < nw32) mask[((size_t)b * SEQ + t0 + 2 * wv + qq) * 64 + lane] = gt | keep;
    }
}
DEVI void ph_topk(const gh16* idx, const gh16* KIF, gu32* mask, gu32* ctr, lu8* lds, int nrep) {
    lu32* slot = (lu32*)(lds + TK_MISC);
    const bool lead = otid() == 0;
    __syncthreads();
    if (lead) *slot = __hip_atomic_fetch_add(ctr, 1u, __ATOMIC_RELAXED, __HIP_MEMORY_SCOPE_AGENT);
    __syncthreads();
    int e = (int)*slot;
#pragma unroll 1
    while (e < 1024 * nrep) {
        unsigned nxt = 0u;
        if (lead) nxt = __hip_atomic_fetch_add(ctr, 1u, __ATOMIC_RELAXED, __HIP_MEMORY_SCOPE_AGENT);
        const int e2 = e & 1023;
        topk_item(e2 & 7, 127 - (e2 >> 3), idx, KIF, mask, lds, (DUP_PHASE >= 30 && e >= 1024) ? DUP_PHASE - 29 : 0);
        __syncthreads();
        if (lead) *slot = nxt;
        __syncthreads();
        e = (int)*slot;
    }
}

DEVI void ph_out(const gh16* mix, const gh16* WoT, const gf32* __restrict__ gpost, const gf32* h_in, gf32* h_out, gh16* h16o, gf32* rstd_next, bool write_next, lu8* lds) {
    const int tid = otid(), lane = tid & 63, q = lane & 31, h = lane >> 5, wv = __builtin_amdgcn_readfirstlane(tid >> 6);
    lf32* red = (lf32*)lds;
    for (int u = blockIdx.x; u < NT / 64; u += gridDim.x) {
        f32x16 acc[4][2];
#pragma unroll
        for (int rb = 0; rb < 4; ++rb) { acc[rb][0] = (f32x16){}; acc[rb][1] = (f32x16){}; }
        const gh16* apu = WoT + (size_t)(wv * 4) * 64 * 512;
        const gh16* bpu = mix + (size_t)(u * 2) * 64 * 512;
        const unsigned lo8 = lane * 8;
#define ap(off) (apu + (off) + lo8)
#define bp(off) (bpu + (off) + lo8)
        h16x8 a0[4], b0[2], a1[4], b1[2], a2[4], b2[2];
#define P3_LOAD(A, B, ks_) do { const int ko_ = ((ks_) < 64 ? (ks_) : 63) * 512; _Pragma("unroll") for (int rb = 0; rb < 4; ++rb) A[rb] = *(const GAS h16x8*)(ap(rb * 64 * 512 + ko_)); \
        _Pragma("unroll") for (int tb = 0; tb < 2; ++tb) B[tb] = *(const GAS h16x8*)(bp(tb * 64 * 512 + ko_)); } while (0)
#define P3_MMA(A, B) do { _Pragma("unroll") for (int rb = 0; rb < 4; ++rb) _Pragma("unroll") for (int tb = 0; tb < 2; ++tb) acc[rb][tb] = mfma32(A[rb], B[tb], acc[rb][tb]); } while (0)
        P3_LOAD(a0, b0, 0); P3_LOAD(a1, b1, 1);
#pragma unroll 1
        for (int ks = 0; ks < 63; ks += 3) {
            P3_LOAD(a2, b2, ks + 2); __builtin_amdgcn_sched_barrier(0); P3_MMA(a0, b0); __builtin_amdgcn_sched_barrier(0);
            P3_LOAD(a0, b0, ks + 3); __builtin_amdgcn_sched_barrier(0); P3_MMA(a1, b1); __builtin_amdgcn_sched_barrier(0);
            P3_LOAD(a1, b1, ks + 4); __builtin_amdgcn_sched_barrier(0); P3_MMA(a2, b2); __builtin_amdgcn_sched_barrier(0);
        }
        P3_MMA(a0, b0);
#undef P3_LOAD
#undef P3_MMA
#undef ap
#undef bp
        int qe = q, he = h; asm volatile("" : "+v"(qe), "+v"(he));
        __syncthreads();
#pragma unroll
        for (int tb = 0; tb < 2; ++tb) {
            float ss = 0.f;
#pragma unroll
            for (int rb = 0; rb < 4; ++rb)
#pragma unroll
                for (int r = 0; r < 16; ++r) ss += acc[rb][tb][r] * acc[rb][tb][r];
            ss = xh_sum(ss);
            if (he == 0) red[wv * 64 + tb * 32 + qe] = ss;
        }
        __syncthreads();
        float ssn[2] = {0.f, 0.f};
#pragma unroll
        for (int tb = 0; tb < 2; ++tb) {
            float tot = 0.f;
#pragma unroll
            for (int w2 = 0; w2 < 8; ++w2) tot += red[w2 * 64 + tb * 32 + qe];
            const float rs = rsqrtf(tot * (1.f / DM) + EPS);
            const size_t rowoff = (size_t)(u * 64 + tb * 32 + qe) * DM;
#pragma unroll
            for (int rb = 0; rb < 4; ++rb)
#pragma unroll
                for (int g = 0; g < 4; ++g) {
                    const int n = wv * 128 + rb * 32 + 8 * g + 4 * he;
                    const f32x4_t hv = *(const GAS f32x4_t*)(h_in + rowoff + n), gv = *(const GAS f32x4_t*)(gpost + n);
                    f32x4_t o;
                    o[0] = hv[0] + acc[rb][tb][4 * g + 0] * rs * gv[0]; o[1] = hv[1] + acc[rb][tb][4 * g + 1] * rs * gv[1];
                    o[2] = hv[2] + acc[rb][tb][4 * g + 2] * rs * gv[2]; o[3] = hv[3] + acc[rb][tb][4 * g + 3] * rs * gv[3];
                    *(GAS f32x4_t*)(h_out + rowoff + n) = o;
                    if (write_next) { h16x4 oh; oh[0] = (h16)o[0]; oh[1] = (h16)o[1]; oh[2] = (h16)o[2]; oh[3] = (h16)o[3]; *(GAS h16x4*)(h16o + rowoff + n) = oh;
                        ssn[tb] += o[0] * o[0] + o[1] * o[1] + o[2] * o[2] + o[3] * o[3]; }
                }
        }
        if (write_next) {
#pragma unroll
            for (int tb = 0; tb < 2; ++tb) { const float v = xh_sum(ssn[tb]); if (he == 0) red[512 + wv * 64 + tb * 32 + qe] = v; }
            __syncthreads();
            if (tid < 64) { float tot = 0.f;
#pragma unroll
                for (int w2 = 0; w2 < 8; ++w2) tot += red[512 + w2 * 64 + tid];
                rstd_next[u * 64 + tid] = rsqrtf(tot * (1.f / DM) + EPS); }
        }
    }
}

DEVI void mla_item(int it, const gh16* cA, const gh16* WuqT, const gh16* WukvT, const gf32* cosT, const gf32* sinT, gh16* qA, gh16* KFA, gh16* KRF, gh16* VFA) {
    const int lane = otid() & 63, q = lane & 31, h = lane >> 5;
    const size_t tok = (size_t)it * 32 + q; const int b = it >> 6, j = it & 63, s = j * 32 + q;
    const float qs = 0.10206207261596577f * LOG2E;
    {
        h16x8 cf[12]; float ss = 0.f;
#pragma unroll
        for (int ks = 0; ks < 12; ++ks) { cf[ks] = *(const GAS h16x8*)(cA + tok * 384 + ks * 16 + 8 * h);
#pragma unroll
            for (int e = 0; e < 8; ++e) { const float v = (float)cf[ks][e]; ss += v * v; } }
        const float rs = rsqrtf(xh_sum(ss) * (1.f / 192.f) + EPS) * qs;
#pragma unroll 1
        for (int nb = 0; nb < 12; ++nb) {
            f32x16 acc = {};
            const gh16* wp = WuqT + (size_t)nb * 12 * 512 + lane * 8;
#pragma unroll
            for (int ks = 0; ks < 12; ++ks) acc = mfma32(*(const GAS h16x8*)(wp + ks * 512), cf[ks], acc);
            acc *= rs;
            const int hh = nb / 3, part = nb % 3;
            if (part == 2) {
#pragma unroll
                for (int r = 0; r < 8; ++r) { const int i = CROW(r) + 4 * h; const float c = cosT[s * 16 + i], sn = sinT[s * 16 + i], x1 = acc[r], x2 = acc[r + 8];
                    acc[r] = x1 * c - x2 * sn; acc[r + 8] = x1 * sn + x2 * c; }
            }
            gh16* op = qA + tok * 384 + hh * 96 + part * 32 + 4 * h;
#pragma unroll
            for (int g = 0; g < 4; ++g) { h16x4 o; o[0] = (h16)acc[4 * g]; o[1] = (h16)acc[4 * g + 1]; o[2] = (h16)acc[4 * g + 2]; o[3] = (h16)acc[4 * g + 3]; *(GAS h16x4*)(op + 8 * g) = o; }
        }
    }
    {
        h16x8 cf[8]; float ss = 0.f;
#pragma unroll
        for (int ks = 0; ks < 8; ++ks) { cf[ks] = *(const GAS h16x8*)(cA + tok * 384 + 192 + ks * 16 + 8 * h);
#pragma unroll
            for (int e = 0; e < 8; ++e) { const float v = (float)cf[ks][e]; ss += v * v; } }
        const float rs = rsqrtf(xh_sum(ss) * (1.f / 128.f) + EPS);
#pragma unroll
        for (int ks = 0; ks < 8; ++ks)
#pragma unroll
            for (int e = 0; e < 8; ++e) cf[ks][e] = (h16)((float)cf[ks][e] * rs);
#pragma unroll 1
        for (int nb = 0; nb < 16; ++nb) {
            const int hh = nb >> 2, sub = nb & 3, bh = b * 4 + hh;
            const gh16* wp = WukvT + (size_t)nb * 8 * 512 + lane * 8;
            f32x16 acc = {};
            if (sub < 2) {
#pragma unroll
                for (int ks = 0; ks < 8; ++ks) acc = mfma32(*(const GAS h16x8*)(wp + ks * 512), cf[ks], acc);
#pragma unroll
                for (int g = 0; g < 4; ++g) { h16x4 o; o[0] = (h16)acc[4 * g]; o[1] = (h16)acc[4 * g + 1]; o[2] = (h16)acc[4 * g + 2]; o[3] = (h16)acc[4 * g + 3];
                    *(GAS h16x4*)(KFA + ((((size_t)bh * 64 + j) * 4 + 2 * sub + (g >> 1)) * 64 + q + 32 * (g & 1)) * 8 + 4 * h) = o; }
            } else {
#pragma unroll
                for (int ks = 0; ks < 8; ++ks) acc = mfma32(cf[ks], *(const GAS h16x8*)(wp + ks * 512), acc);
#pragma unroll
                for (int sk = 0; sk < 2; ++sk) { h16x8 o;
#pragma unroll
                    for (int e = 0; e < 8; ++e) o[e] = (h16)acc[8 * sk + e];
                    *(GAS h16x8*)(VFA + ((((size_t)bh * 64 + j) * 4 + (sub - 2) * 2 + sk) * 64 + lane) * 8) = o; }
            }
        }
    }
    {
        const h16x8 a = *(const GAS h16x8*)(cA + tok * 384 + 320 + 8 * h), c2 = *(const GAS h16x8*)(cA + tok * 384 + 336 + 8 * h);
        h16x8 o1, o2;
#pragma unroll
        for (int e = 0; e < 8; ++e) { const int i = 8 * h + e; const float c = cosT[s * 16 + i], sn = sinT[s * 16 + i], x1 = (float)a[e], x2 = (float)c2[e];
            o1[e] = (h16)(x1 * c - x2 * sn); o2[e] = (h16)(x1 * sn + x2 * c); }
        *(GAS h16x8*)(KRF + (((size_t)b * 64 + j) * 2 + 0) * 512 + lane * 8) = o1; *(GAS h16x8*)(KRF + (((size_t)b * 64 + j) * 2 + 1) * 512 + lane * 8) = o2;
    }
}
DEVI void ph_small_weights(const gf32* w_uq, const gf32* qn, const gf32* w_ukv, const gf32* kvn, gh16* WuqF, gh16* WukvF) {
    const int gt = blockIdx.x * NTHR + otid(), nthr = gridDim.x * NTHR;
    for (int i = gt; i < 2 * 12 * 12 * 64; i += nthr) { const int lane = i & 63, ks = (i >> 6) % 12, nb = (i / (64 * 12)) % 12, l = i / (64 * 144);
        h16x8 o;
#pragma unroll
        for (int e = 0; e < 8; ++e) { const int k = 16 * ks + 8 * (lane >> 5) + e; o[e] = (h16)(w_uq[(size_t)l * 192 * 384 + k * 384 + nb * 32 + (lane & 31)] * qn[l * 192 + k]); }
        *(GAS h16x8*)(WuqF + (size_t)i * 8) = o; }
    for (int i = gt; i < 2 * 16 * 8 * 64; i += nthr) { const int lane = i & 63, ks = (i >> 6) & 7, nb = (i >> 9) & 15, l = i >> 13;
        h16x8 o;
#pragma unroll
        for (int e = 0; e < 8; ++e) { const int k = 16 * ks + 8 * (lane >> 5) + e; o[e] = (h16)(w_ukv[(size_t)l * 128 * 512 + k * 512 + nb * 32 + (lane & 31)] * kvn[l * 128 + k]); }
        *(GAS h16x8*)(WukvF + (size_t)i * 8) = o; }
}

constexpr int LDS_BYTES = 160 * 1024;
struct Params { const float* in[12]; float* out; unsigned char* ws; };

DEVI void ph_tables(const gf32* __restrict__ rel_bias, gf32* biasTab, gf32* cosT, gf32* sinT) {
    for (int i = blockIdx.x * NTHR + threadIdx.x; i < 2048 * 16; i += gridDim.x * NTHR) {
        if (i < 12 * 2048) { int hh = i / 2048, n = i % 2048; biasTab[i] = rel_bias[t5_bucket(n) * 12 + hh] * LOG2E; }
        int pos = i / 16, j = i % 16;
        float inv = (float)pow(10000.0, -(double)(2 * j) / 32.0);
        float ang = (float)pos * inv;
        cosT[i] = (float)cos((double)ang); sinT[i] = (float)sin((double)ang);
    }
}

extern __shared__ __attribute__((aligned(16))) unsigned char smem[];
constexpr int LDS_BAR_OFF = 160 * 1024 - 16;

#define REP(k) for (int rep_ = 0; rep_ < ((DUP_PHASE == (k)) ? 2 : 1); ++rep_)
DEVI gu8* ows(unsigned char* w0) { gu8* w = (gu8*)w0; asm volatile("" : "+s"(w)); return w; }
#define WSP(T, off) ((GAS T*)(w + (off)))
#define GIN(k) ((const gf32*)p.in[k])

__global__ void __launch_bounds__(NTHR, 2) mega(Params p) {
    if (threadIdx.x == 0) *(uint4*)(smem + LDS_BAR_OFF) = make_uint4(0u, 0u, 0u, 0u);
    __syncthreads();
    XcdBarrier bar = xcd_barrier_post((unsigned*)(p.ws + OFF_CTL), (volatile LAS unsigned*)(smem + LDS_BAR_OFF));
    lu8* lds = (lu8*)smem;
    const int nw = gridDim.x * NWAVE;

    REP(1) {
        gu8* w = ows(p.ws);
        ph_tables(GIN(11), WSP(float, OFF_BIAS), WSP(float, OFF_COS), WSP(float, OFF_SIN));
        int base = 0; const int total = 2 * (64 * 16) + 2 * (16 * 16);
        cvt_transpose<true>(GIN(1), INC, GIN(3), WSP(h16, OFF_WINT), MYC, DM, lds, blockIdx.x, total, base);
        cvt_transpose<true>(GIN(1) + (size_t)DM * INC, INC, GIN(3) + DM, WSP(h16, OFF_WINT) + (size_t)MYC * DM, MYC, DM, lds, blockIdx.x, total, base);
        cvt_transpose<false>(GIN(2), DM, nullptr, WSP(h16, OFF_WOUTT), DM, DM, lds, blockIdx.x, total, base);
        cvt_transpose<false>(GIN(2) + (size_t)DM * DM, DM, nullptr, WSP(h16, OFF_WOUTT) + (size_t)DM * DM, DM, DM, lds, blockIdx.x, total, base);
        ph_small_weights(GIN(7), GIN(5), GIN(8), GIN(6), WSP(h16, OFF_WUQT), WSP(h16, OFF_WUKVT));
        ph_rowstat_cvt(GIN(0), WSP(float, OFF_SSQH), WSP(h16, OFF_H16));
    }
    xcd_barrier(bar);
    for (int layer = 0; layer < 2; ++layer) {
        const float lambda_init = layer == 0 ? 0.2f : 0.35550906759f;
        REP(2) {
            if (rep_) xcd_barrier(bar);
            gu8* w = ows(p.ws);
            pg8::Gemm g{(const pg8::bf16_t*)(p.ws + OFF_H16), (const pg8::bf16_t*)(p.ws + OFF_WINT) + (size_t)layer * MYC * DM, NT, MYC, DM};
            int bid_ = (int)blockIdx.x; asm volatile("" : "+s"(bid_));
            pg8::StaticOrder S; S.init(NT, MYC, (int)gridDim.x, bid_);
            EpiRoute E{w, WSP(float, OFF_SSQH)};
            pg8::gemm_phase<EpiRoute, pg8::StaticOrder, true, true>(lds, g, S, E);
        }
        xcd_barrier(bar);
        REP(3) {
            gu8* w = ows(p.ws);
            for (int it = ogw(); it < NT / 32; it += nw) mla_item(it, WSP(h16, OFF_CA), WSP(h16, OFF_WUQT) + (size_t)layer * 384 * 192, WSP(h16, OFF_WUKVT) + (size_t)layer * 512 * 128, WSP(float, OFF_COS), WSP(float, OFF_SIN), WSP(h16, OFF_QA), WSP(h16, OFF_KFA), WSP(h16, OFF_KRF), WSP(h16, OFF_VFA));
        }
        {
            gu8* w = ows(p.ws);
            ph_topk(WSP(h16, OFF_IDX), WSP(h16, OFF_KIF), WSP(unsigned, OFF_MASK), WSP(unsigned, OFF_CTL) + 3600 + 16 * (40 + layer), lds, (DUP_PHASE == 4 || DUP_PHASE >= 30) ? 2 : 1);
        }
        REP(3) {
            gu8* w = ows(p.ws);
            ph_vtrans(WSP(h16, OFF_VTMP), WSP(h16, OFF_VF), lds);
        }
        xcd_barrier(bar);
        for (int rep_ = 0; rep_ < ((DUP_PHASE == 5 || DUP_PHASE >= 10) ? 2 : 1); ++rep_) {
            if (rep_) xcd_barrier(bar);
            const int hot_ = (DUP_PHASE >= 10 && rep_) ? DUP_PHASE - 9 : 0;
            gu8* w = ows(p.ws);
            p2_setup(WSP(float, OFF_BIAS), GIN(9) + layer * 128, lambda_init, lds);
            if (DUP_PHASE >= 20 && rep_) { probe_item(130, DUP_PHASE - 20); continue; }
            const int xcc = (int)(xb_xcc_id() & 7u);
            for (int dq = 0; dq < 8; ++dq) {
                const int bq = (xcc + dq) & 7;
                gu32* ctr = WSP(unsigned, OFF_CTL) + 3600 + 16 * (bq + 8 * layer + 16 * rep_);
                for (;;) { const int e = wq_next(ctr); if (e >= 768) break;
                    if (e < 256) { const int hh = e >> 6, lvl = 63 - (e & 63);
                        flashCD_item<2, false>(bq, hh, lvl, 8 + hh, WSP(h16, OFF_QD), WSP(h16, OFF_KFD), WSP(h16, OFF_VF) + 4 * FSZ, nullptr, WSP(float, OFF_BIAS), lds,
                                               GIN(10) + layer * 64, lambda_init, WSP(h16, OFF_GATE), WSP(h16, OFF_MIX), 768, hot_); }
                    else if (e < 384) { const int e2 = e - 256, hh = e2 >> 5, pr = 31 - (e2 & 31);
                        flashQ2_item<1>(bq, hh, pr, WSP(h16, OFF_QC), WSP(h16, OFF_KFC), nullptr, WSP(h16, OFF_VF) + 3 * FSZ, WSP(unsigned, OFF_MASK), WSP(float, OFF_BIAS), lds, WSP(h16, OFF_GATE), WSP(h16, OFF_MIX), 512, 4 + hh, hot_); }
                    else if (e < 512) { const int e2 = e - 384, hh = e2 >> 5, pr = 31 - (e2 & 31);
                        flashQ2_item<0>(bq, hh, pr, WSP(h16, OFF_QA), WSP(h16, OFF_KFA), WSP(h16, OFF_KRF), WSP(h16, OFF_VFA), nullptr, WSP(float, OFF_BIAS), lds, WSP(h16, OFF_GATE), WSP(h16, OFF_MIX), 0, 0, hot_); }
                    else { const int e2 = e - 512, hh = e2 >> 6, lvl = e2 & 63;
                        flashB_item(bq, hh, lvl & 15, lvl >> 4, WSP(h16, OFF_QB), WSP(h16, OFF_KFB), WSP(h16, OFF_VF), lds, WSP(h16, OFF_GATE), WSP(h16, OFF_MIX), hot_); }
                }
            }
        }
        xcd_barrier(bar);
        for (int rep_ = 0; rep_ < ((DUP_PHASE == 6 && layer == 0) ? 2 : 1); ++rep_) {
            if (rep_) xcd_barrier(bar);
            gu8* w = ows(p.ws);
int bid_ = (int)blockIdx.x; asm volatile("" : "+s"(bid_));
            pg8::Gemm g{(const pg8::bf16_t*)(p.ws + OFF_MIX), (const pg8::bf16_t*)(p.ws + OFF_WOUTT) + (size_t)layer * DM * DM, NT, DM, DM};
            pg8::StaticOrder S; S.init(NT, DM, (int)gridDim.x, bid_);
            EpiOut E{layer == 0 ? GIN(0) : (const gf32*)p.out, (gf32*)p.out, WSP(h16, OFF_H16), GIN(4) + layer * DM, WSP(float, OFF_SSQY), WSP(float, OFF_SSQH), &bar, layer == 0};
            pg8::gemm_phase<EpiOut, pg8::StaticOrder, false, true>(lds, g, S, E);
        }
        xcd_barrier(bar);
    }
}

extern "C" void kernel_launch(void* const* d_in, const int* in_sizes, int n_in, void* d_out, int out_size, void* d_ws, size_t ws_size, hipStream_t stream) {
    static int grid = 0;
    if (grid == 0) {
        int dev = 0, cus = 0, per_cu = 0;
        (void)hipGetDevice(&dev);
        (void)hipDeviceGetAttribute(&cus, hipDeviceAttributeMultiprocessorCount, dev);
        (void)hipFuncSetAttribute((const void*)mega, hipFuncAttributeMaxDynamicSharedMemorySize, LDS_BYTES);
        (void)hipOccupancyMaxActiveBlocksPerMultiprocessor(&per_cu, (const void*)mega, NTHR, LDS_BYTES);
        (void)hipGetLastError();
        grid = (cus > 0 && cus < 256) ? cus : 256;
    }
    (void)hipMemsetAsync((char*)d_ws + OFF_CTL, 0, 32768, stream);
    Params p{};
    for (int i = 0; i < 12; ++i) p.in[i] = (const float*)d_in[i];
    p.out = (float*)d_out; p.ws = (unsigned char*)d_ws;
    hipLaunchKernelGGL(mega, dim3(grid), dim3(NTHR), LDS_BYTES, stream, p);
}
```

```cpp
#include <hip/hip_runtime.h>
#include <stdint.h>
#include <math.h>

#ifndef DUP_PHASE
#define DUP_PHASE 0
#endif
typedef _Float16 h16;
#define GAS __attribute__((address_space(1)))
#define LAS __attribute__((address_space(3)))
typedef GAS h16 gh16; typedef GAS float gf32; typedef GAS unsigned gu32; typedef GAS unsigned char gu8;
typedef LAS h16 lh16; typedef LAS float lf32; typedef LAS unsigned lu32; typedef LAS unsigned char lu8;
#define DEVI __device__ __forceinline__
DEVI int ogw();
DEVI int otid() { int t = threadIdx.x; asm volatile("" : "+v"(t)); return t; }

constexpr int NB = 8, SEQ = 2048, DM = 1024, NT = NB * SEQ, INC = 3976, MYC = 4096;
constexpr float LOG2E = 1.4426950408889634f;
constexpr float EPS = 1e-6f;

DEVI int ogw() { return blockIdx.x * 8 + (otid() >> 6); }
__host__ __device__ constexpr int ref_col(int my) {
    if (my < 352) return my;
    if (my < 384) return -1;
    if (my < 640) return 352 + (my - 384);
    if (my < 896) return 1376 + (my - 640);
    if (my < 1152) return 2696 + (my - 896);
    if (my < 1408) return 3720 + (my - 1152);
    if (my < 1664) return 608 + (my - 1408);
    if (my < 1920) return 864 + (my - 1664);
    if (my < 2176) return 1632 + (my - 1920);
    if (my < 2432) return 1888 + (my - 2176);
    if (my < 2688) return 2952 + (my - 2432);
    if (my < 2944) return 3208 + (my - 2688);
    if (my < 3200) return 1120 + (my - 2944);
    if (my < 3456) return 2144 + (my - 3200);
    if (my < 3712) return 3464 + (my - 3456);
    if (my < 3968) return 2400 + (my - 3712);
    if (my < 4000) return 2656 + (my - 3968);
    if (my < 4008) return 2688 + (my - 4000);
    return -1;
}

constexpr size_t MiB = 1024 * 1024;
constexpr size_t OFF_CTL = 0;
constexpr size_t OFF_RSTD = 64 * 1024;
constexpr size_t OFF_BIAS = 128 * 1024;
constexpr size_t OFF_COS = 256 * 1024;
constexpr size_t OFF_SIN = 384 * 1024;
constexpr size_t OFF_SSQY = 512 * 1024;
constexpr size_t OFF_SSQH = 768 * 1024;
constexpr size_t OFF_CA = 1 * MiB;
constexpr size_t OFF_GATE = OFF_CA + 12 * MiB;
constexpr size_t OFF_QB = OFF_GATE + 32 * MiB;
constexpr size_t OFF_QC = OFF_QB + 8 * MiB;
constexpr size_t OFF_QD = OFF_QC + 8 * MiB;
constexpr size_t OFF_KFB = OFF_QD + 8 * MiB;
constexpr size_t OFF_KFC = OFF_KFB + 24 * MiB;
constexpr size_t OFF_KFD = OFF_KFC + 8 * MiB;
constexpr size_t OFF_IDX = OFF_KFD + 8 * MiB;
constexpr size_t OFF_KIF = OFF_IDX + 10 * MiB;
constexpr size_t OFF_MIX = OFF_KIF + 1 * MiB;
constexpr size_t OFF_VTMP = OFF_MIX;
constexpr size_t OFF_MASK = OFF_MIX + 32 * MiB;
constexpr size_t OFF_H16 = OFF_MASK + 4 * MiB;
constexpr size_t OFF_QA = OFF_H16;
constexpr size_t OFF_KFA = OFF_QA + 12 * MiB;
constexpr size_t OFF_KRF = OFF_KFA + 8 * MiB;
constexpr size_t OFF_VFA = OFF_KRF + 1 * MiB;
constexpr size_t OFF_WINT = OFF_H16 + 32 * MiB;
constexpr size_t OFF_WOUTT = OFF_WINT + 16 * MiB;
constexpr size_t OFF_WUQT = OFF_WOUTT + 4 * MiB;
constexpr size_t OFF_WUKVT = OFF_WUQT + 512 * 1024;
constexpr size_t OFF_VF = OFF_WUKVT + 512 * 1024;
constexpr size_t OFF_END = OFF_VF + 40 * MiB;
static_assert(OFF_END <= 256 * MiB, "ws map");

struct Route { int kind; size_t off; int dcol; int pitch; float scale; int silu; };
__host__ __device__ inline Route route(int my) {
    Route r{-1, 0, 0, 0, 1.f, 0};
    if (my < 384) { r.kind = 0; r.off = OFF_CA; r.dcol = my; r.pitch = 384; }
    else if (my < 1408) { r.kind = 0; r.off = OFF_GATE; r.dcol = my - 384; r.pitch = 1024; r.silu = 1; }
    else if (my < 1664) { r.kind = 0; r.off = OFF_QB; r.dcol = my - 1408; r.pitch = 256; r.scale = 0.125f * LOG2E; }
    else if (my < 1920) { r.kind = 2; r.off = OFF_KFB; r.dcol = my - 1664; }
    else if (my < 2176) { r.kind = 0; r.off = OFF_QC; r.dcol = my - 1920; r.pitch = 256; r.scale = 0.125f * LOG2E; }
    else if (my < 2432) { r.kind = 1; r.off = OFF_KFC; r.dcol = my - 2176; }
    else if (my < 2688) { r.kind = 0; r.off = OFF_QD; r.dcol = my - 2432; r.pitch = 256; r.scale = 0.17677669529663687f * LOG2E; }
    else if (my < 2944) { r.kind = 1; r.off = OFF_KFD; r.dcol = my - 2688; }
    else if (my < 3712) { r.kind = 0; r.off = OFF_VTMP; r.dcol = my - 2944; r.pitch = 768; }
    else if (my < 3968) { r.kind = 0; r.off = OFF_IDX; r.dcol = my - 3712; r.pitch = 320; r.scale = 0.17677669529663687f; }
    else if (my < 4000) { r.kind = 3; r.off = OFF_KIF; r.dcol = my - 3968; }
    else if (my < 4032) { r.kind = 0; r.off = OFF_IDX; r.dcol = my - 3712; r.pitch = 320; }
    return r;
}
DEVI size_t kf_off(int bh, int s, int d0) { return ((((size_t)bh * 64 + (s >> 5)) * 4 + (d0 >> 4)) * 64 + (s & 31) + 32 * ((d0 >> 3) & 1)) * 8; }
DEVI size_t kf4_off(int bh, int s, int d0) { const int pp = s >> 2, r4 = s & 3; return (((((size_t)bh * 4 + r4) * 16 + (pp >> 5)) * 4 + (d0 >> 4)) * 64 + (pp & 31) + 32 * ((d0 >> 3) & 1)) * 8; }
DEVI size_t kf16_off(int bh, int s, int d0) { const int pp = s >> 4, r = s & 15; return (((((size_t)bh * 16 + r) * 4 + (pp >> 5)) * 4 + (d0 >> 4)) * 64 + (pp & 31) + 32 * ((d0 >> 3) & 1)) * 8; }
DEVI size_t mixf_off(size_t tok, int c0) { return tok * 1024 + (size_t)c0; }
constexpr size_t FSZ = (size_t)32 * 64 * 4 * 64 * 8;

__device__ __constant__ unsigned short kP2Order[1024] = {63, 127, 191, 255, 62, 126, 190, 254, 61, 125, 189, 253, 60, 124, 188, 252, 59, 123, 187, 251, 58, 122, 186, 250, 57, 121, 185, 249, 56, 120, 184, 248, 55, 119, 183, 247, 54, 118, 182, 246, 53, 117, 181, 245, 52, 116, 180, 244, 51, 115, 179, 243, 50, 114, 178, 242, 49, 113, 177, 241, 48, 112, 176, 240, 47, 111, 175, 239, 46, 110, 174, 238, 45, 109, 173, 237, 44, 108, 172, 236, 43, 107, 171, 235, 42, 106, 170, 234, 41, 105, 169, 233, 40, 104, 168, 232, 39, 103, 167, 231, 319, 383, 447, 511, 318, 382, 446, 510, 38, 102, 166, 230, 317, 381, 445, 509, 316, 380, 444, 508, 37, 101, 165, 229, 315, 379, 443, 507, 36, 100, 164, 228, 314, 378, 442, 506, 313, 377, 441, 505, 35, 99, 163, 227, 312, 376, 440, 504, 34, 98, 162, 226, 311, 375, 439, 503, 310, 374, 438, 502, 33, 97, 161, 225, 309, 373, 437, 501, 308, 372, 436, 500, 32, 96, 160, 224, 307, 371, 435, 499, 31, 95, 159, 223, 306, 370, 434, 498, 305, 369, 433, 497, 30, 94, 158, 222, 304, 368, 432, 496, 29, 93, 157, 221, 303, 367, 431, 495, 302, 366, 430, 494, 28, 92, 156, 220, 301, 365, 429, 493, 300, 364, 428, 492, 27, 91, 155, 219, 299, 363, 427, 491, 26, 90, 154, 218, 298, 362, 426, 490, 575, 639, 703, 767, 297, 361, 425, 489, 574, 638, 702, 766, 25, 89, 153, 217, 573, 637, 701, 765, 296, 360, 424, 488, 572, 636, 700, 764, 24, 88, 152, 216, 295, 359, 423, 487, 571, 635, 699, 763, 570, 634, 698, 762, 294, 358, 422, 486, 569, 633, 697, 761, 23, 87, 151, 215, 293, 357, 421, 485, 568, 632, 696, 760, 567, 631, 695, 759, 292, 356, 420, 484, 22, 86, 150, 214, 566, 630, 694, 758, 291, 355, 419, 483, 565, 629, 693, 757, 564, 628, 692, 756, 21, 85, 149, 213, 290, 354, 418, 482, 563, 627, 691, 755, 289, 353, 417, 481, 562, 626, 690, 754, 20, 84, 148, 212, 561, 625, 689, 753, 288, 352, 416, 480, 560, 624, 688, 752, 19, 83, 147, 211, 287, 351, 415, 479, 559, 623, 687, 751, 558, 622, 686, 750, 286, 350, 414, 478, 557, 621, 685, 749, 18, 82, 146, 210, 285, 349, 413, 477, 556, 620, 684, 748, 555, 619, 683, 747, 284, 348, 412, 476, 17, 81, 145, 209, 554, 618, 682, 746, 283, 347, 411, 475, 553, 617, 681, 745, 552, 616, 680, 744, 16, 80, 144, 208, 282, 346, 410, 474, 551, 615, 679, 743, 281, 345, 409, 473, 550, 614, 678, 742, 15, 79, 143, 207, 549, 613, 677, 741, 280, 344, 408, 472, 548, 612, 676, 740, 14, 78, 142, 206, 279, 343, 407, 471, 547, 611, 675, 739, 546, 610, 674, 738, 278, 342, 406, 470, 545, 609, 673, 737, 13, 77, 141, 205, 277, 341, 405, 469, 544, 608, 672, 736, 543, 607, 671, 735, 276, 340, 404, 468, 12, 76, 140, 204, 542, 606, 670, 734, 275, 339, 403, 467, 541, 605, 669, 733, 768, 769, 770, 771, 772, 773, 774, 775, 776, 777, 778, 779, 780, 781, 782, 783, 784, 785, 786, 787, 788, 789, 790, 791, 792, 793, 794, 795, 796, 797, 798, 799, 800, 801, 802, 803, 804, 805, 806, 807, 808, 809, 810, 811, 812, 813, 814, 815, 816, 817, 818, 819, 820, 821, 822, 823, 824, 825, 826, 827, 828, 829, 830, 831, 832, 833, 834, 835, 836, 837, 838, 839, 840, 841, 842, 843, 844, 845, 846, 847, 848, 849, 850, 851, 852, 853, 854, 855, 856, 857, 858, 859, 860, 861, 862, 863, 864, 865, 866, 867, 868, 869, 870, 871, 872, 873, 874, 875, 876, 877, 878, 879, 880, 881, 882, 883, 884, 885, 886, 887, 888, 889, 890, 891, 892, 893, 894, 895, 896, 897, 898, 899, 900, 901, 902, 903, 904, 905, 906, 907, 908, 909, 910, 911, 912, 913, 914, 915, 916, 917, 918, 919, 920, 921, 922, 923, 924, 925, 926, 927, 928, 929, 930, 931, 932, 933, 934, 935, 936, 937, 938, 939, 940, 941, 942, 943, 944, 945, 946, 947, 948, 949, 950, 951, 952, 953, 954, 955, 956, 957, 958, 959, 960, 961, 962, 963, 964, 965, 966, 967, 968, 969, 970, 971, 972, 973, 974, 975, 976, 977, 978, 979, 980, 981, 982, 983, 984, 985, 986, 987, 988, 989, 990, 991, 992, 993, 994, 995, 996, 997, 998, 999, 1000, 1001, 1002, 1003, 1004, 1005, 1006, 1007, 1008, 1009, 1010, 1011, 1012, 1013, 1014, 1015, 1016, 1017, 1018, 1019, 1020, 1021, 1022, 1023, 540, 604, 668, 732, 11, 75, 139, 203, 274, 338, 402, 466, 539, 603, 667, 731, 273, 337, 401, 465, 538, 602, 666, 730, 10, 74, 138, 202, 537, 601, 665, 729, 272, 336, 400, 464, 536, 600, 664, 728, 9, 73, 137, 201, 271, 335, 399, 463, 535, 599, 663, 727, 534, 598, 662, 726, 270, 334, 398, 462, 533, 597, 661, 725, 8, 72, 136, 200, 269, 333, 397, 461, 532, 596, 660, 724, 531, 595, 659, 723, 268, 332, 396, 460, 7, 71, 135, 199, 530, 594, 658, 722, 267, 331, 395, 459, 529, 593, 657, 721, 528, 592, 656, 720, 6, 70, 134, 198, 266, 330, 394, 458, 527, 591, 655, 719, 265, 329, 393, 457, 526, 590, 654, 718, 5, 69, 133, 197, 525, 589, 653, 717, 264, 328, 392, 456, 524, 588, 652, 716, 4, 68, 132, 196, 263, 327, 391, 455, 523, 587, 651, 715, 522, 586, 650, 714, 262, 326, 390, 454, 521, 585, 649, 713, 3, 67, 131, 195, 261, 325, 389, 453, 520, 584, 648, 712, 519, 583, 647, 711, 260, 324, 388, 452, 2, 66, 130, 194, 518, 582, 646, 710, 259, 323, 387, 451, 517, 581, 645, 709, 516, 580, 644, 708, 1, 65, 129, 193, 258, 322, 386, 450, 515, 579, 643, 707, 257, 321, 385, 449, 514, 578, 642, 706, 0, 64, 128, 192, 513, 577, 641, 705, 256, 320, 384, 448, 512, 576, 640, 704};
__device__ __constant__ unsigned char kWgOrder[96] = {7, 15, 23, 31, 6, 14, 22, 30, 39, 47, 55, 63, 5, 13, 21, 29, 38, 46, 54, 62, 4, 12, 20, 28, 71, 79, 87, 95, 37, 45, 53, 61, 70, 78, 86, 94, 3, 11, 19, 27, 36, 44, 52, 60, 69, 77, 85, 93, 35, 43, 51, 59, 68, 76, 84, 92, 2, 10, 18, 26, 67, 75, 83, 91, 34, 42, 50, 58, 1, 9, 17, 25, 66, 74, 82, 90, 33, 41, 49, 57, 65, 73, 81, 89, 0, 8, 16, 24, 32, 40, 48, 56, 64, 72, 80, 88};
__device__ __constant__ int kBucketStart[16] = {16, 22, 30, 40, 54, 73, 99, 134, 182, 246, 332, 450, 609, 825, 1117, 1513};
DEVI int t5_bucket(int n) {
    if (n < 16) return n;
    int b = 16;
#pragma unroll
    for (int j = 1; j < 16; ++j) b += (n >= kBucketStart[j]) ? 1 : 0;
    return b;
}


#define XB_TMO      128
#define XB_XCNT(j)  (256  + 64 * (j))
#define XB_XSUB(j)  (1280 + 64 * (j))
#define XB_XGEN(j)  (2304 + 64 * (j))
#define XB_TOP      3328
#define XB_TOPGEN   3392
#define XCD_BAR_WORDS 3456
#define XB_SPIN_CAP (1u << 18)
__device__ __forceinline__ unsigned xb_ld(unsigned* p)              { return __hip_atomic_load(p, __ATOMIC_RELAXED, __HIP_MEMORY_SCOPE_AGENT); }
__device__ __forceinline__ unsigned xb_add(unsigned* p, unsigned v) { return __hip_atomic_fetch_add(p, v, __ATOMIC_RELAXED, __HIP_MEMORY_SCOPE_AGENT); }
__device__ __forceinline__ unsigned xb_xcc_id() { return (unsigned)__builtin_amdgcn_s_getreg((3 << 11) | 20) & 0xFu; }
#define XB_SPIN(cond, bar) do { unsigned _sp = 0; while (cond) { __builtin_amdgcn_s_sleep(1); \
    if ((++_sp & 255u) == 0u) { if (xb_ld(&(bar)[XB_TMO])) break; if (_sp > XB_SPIN_CAP) { atomicAdd(&(bar)[XB_TMO], 1u); break; } } } } while (0)
struct XcdBarrier { unsigned* bar; unsigned x; volatile LAS unsigned* st; };
__device__ __forceinline__ XcdBarrier xcd_barrier_post(unsigned* bar, volatile LAS unsigned* st) {
    XcdBarrier b; b.bar = bar; b.x = xb_xcc_id(); b.st = st;
    if (threadIdx.x == 0) (void)xb_add(&bar[XB_XCNT(b.x)], 1u);
    return b;
}
__device__ __forceinline__ void xcd_barrier_complete(unsigned* bar, unsigned x, unsigned& nloc, unsigned& nx) {
    const unsigned G = gridDim.x * gridDim.y * gridDim.z;
    unsigned sum, cnt, mine, sp = 0u;
    for (;;) {
        sum = 0u; cnt = 0u; mine = 0u;
#pragma unroll
        for (unsigned j = 0; j < 16; ++j) { const unsigned c = xb_ld(&bar[XB_XCNT(j)]); sum += c; cnt += (c > 0u) ? 1u : 0u; mine = (j == x) ? c : mine; }
        if (sum == G) break;
        __builtin_amdgcn_s_sleep(1);
        if ((++sp & 255u) == 0u) { if (xb_ld(&bar[XB_TMO])) break; if (sp > XB_SPIN_CAP) { atomicAdd(&bar[XB_TMO], 1u); break; } }
    }
    nloc = mine > 0u ? mine : 1u; nx = cnt > 0u ? cnt : 1u;
}
__device__ __forceinline__ void xcd_barrier(const XcdBarrier& b) {
    asm volatile("s_waitcnt vmcnt(0)" ::: "memory");
    __syncthreads();
    if (otid() == 0) {
        unsigned* bar = b.bar; unsigned bx = b.x; asm volatile("" : "+s"(bx));
        __builtin_amdgcn_s_waitcnt(0);
        unsigned nloc = b.st[0], nx = b.st[1];
        if (nloc == 0u) { xcd_barrier_complete(bar, bx, nloc, nx); b.st[0] = nloc; b.st[1] = nx; }
        const unsigned old = xb_add(&bar[XB_XSUB(bx)], 1u);
        const unsigned gen = old / nloc;
        if (old + 1u == (gen + 1u) * nloc) {
            __builtin_amdgcn_fence(__ATOMIC_RELEASE, "agent");
            asm volatile("s_waitcnt vmcnt(0)" ::: "memory");
            const unsigned og = xb_add(&bar[XB_TOP], 1u);
            const unsigned tg = og / nx;
            if (og + 1u == (tg + 1u) * nx) xb_add(&bar[XB_TOPGEN], 1u);
            else XB_SPIN(xb_ld(&bar[XB_TOPGEN]) == tg, bar);
            __builtin_amdgcn_fence(__ATOMIC_ACQUIRE, "agent");
            xb_add(&bar[XB_XGEN(bx)], 1u);
            asm volatile("s_waitcnt vmcnt(0)" ::: "memory");
        } else {
            XB_SPIN(xb_ld(&bar[XB_XGEN(bx)]) == gen, bar);
            __builtin_amdgcn_fence(__ATOMIC_ACQUIRE, "agent");
            asm volatile("s_waitcnt vmcnt(0)" ::: "memory");
        }
    }
    __syncthreads();
}

namespace pg8 {
#define PG8_LAS __attribute__((address_space(3)))
typedef unsigned short bf16_t;
typedef _Float16 f16x8 __attribute__((ext_vector_type(8)));
typedef float f32x4 __attribute__((ext_vector_type(4)));
typedef unsigned u32x4 __attribute__((ext_vector_type(4)));
constexpr int BM = 256, BK = 64, HALF = 128, HTB = HALF * BK * 2  , STAGE_BYTES = 8 * HTB, NXCD = 8, WGM = 8;

__host__ __device__ __forceinline__ int lds_byte(int r, int c) { const int st = (r >> 4) * 2 + (c >> 5), rr = r & 15, cc = c & 31, ob = rr * 64 + cc * 2; return st * 1024 + (ob ^ (((ob >> 9) & 1) << 5)); }
__host__ __device__ __forceinline__ void stage_rc(int b, int& R, int& C) { const int st = b / 1024, sb = b % 1024, swz = sb ^ (((sb >> 9) & 1) << 5); R = (st >> 1) * 16 + swz / 64; C = (st & 1) * 32 + (swz % 64) / 2; }
__host__ __device__ __forceinline__ int perm32(int rho) { const int n = rho >> 4, i = rho & 15; return 8 * (i >> 2) + 4 * n + (i & 3); }

struct Unit { int pm, pn; };
struct Gemm { const bf16_t* A; const bf16_t* Bt; int M, N, K; };

struct StaticOrder {
    int nM, nN, nwg, G, c;
    __host__ __device__ void init(int M, int N, int G_, int c_) { nM = M / BM; nN = N / BM; nwg = nM * nN; G = G_; c = c_; }
    __host__ __device__ bool next(int i, Unit& u) const {
        const long L = (long)i * G + c; if (L >= nwg) return false;
        int wgid = (int)L; { const int q = nwg / NXCD, r = nwg % NXCD, xcd = wgid % NXCD, off = wgid / NXCD; wgid = (xcd < r ? xcd * (q + 1) : r * (q + 1) + (xcd - r) * q) + off; }
        const int nig = WGM * nN, gid = wgid / nig, fm = gid * WGM, gsz = (nM - fm) < WGM ? (nM - fm) : WGM;
        u.pm = fm + ((wgid % nig) % gsz); u.pn = (wgid % nig) / gsz; return true;
    }
    __device__ __forceinline__ void a_ready(const Unit&) const {}
    __device__ __forceinline__ void done(const Unit&) const {}
};

template <class Epi, class Sched, bool ALIGN_EPI = false, bool SP2 = false>
__device__ __forceinline__ void gemm_phase(PG8_LAS unsigned char* lds, const Gemm g, const Sched& S, const Epi& E) {
    const int tid = otid(), wid = __builtin_amdgcn_readfirstlane(tid >> 6), lane = tid & 63, wr = wid >> 2, wc = wid & 3, fr = lane & 15, fq = lane >> 4;
    const int K = g.K, nt = K / BK;
    unsigned voffA[2], voffB[2];
#pragma unroll
    for (int i = 0; i < 2; ++i) { int R, C; stage_rc(tid * 16 + i * 8192, R, C); const int Rb = Epi::PERM ? ((R & ~31) + perm32(R & 31)) : R;
        voffA[i] = (unsigned)(R * K + C) * 2u; voffB[i] = (unsigned)(Rb * K + C) * 2u; }
    const size_t kstep = (size_t)(BK * 2);
    const size_t hstep = (size_t)HALF * K * 2;
    const size_t tstep = 2 * hstep;
    const unsigned ldsw = (unsigned)wid * 1024u;
    const int aoff = lds_byte(wr * 64 + fr, fq * 8), boff = lds_byte(wc * 32 + fr, fq * 8);
#define PG8_SA(b, h) (((b) * 2 + (h)) * HTB)
#define PG8_SB(b, h) ((4 + (b) * 2 + (h)) * HTB)
#define PG8_STAGE(bufoff, gbase, voff) do { _Pragma("unroll") for (int _i = 0; _i < 2; ++_i) \
        __builtin_amdgcn_global_load_lds((const unsigned*)((const char*)(gbase) + (voff)[_i]), (PG8_LAS unsigned*)(lds + (bufoff) + ldsw + _i * 8192), 16, 0, 0); } while (0)
#define PG8_LDA(dst, b, h) do { _Pragma("unroll") for (int m = 0; m < 4; ++m) _Pragma("unroll") for (int k = 0; k < 2; ++k) dst[m][k] = *(const PG8_LAS f16x8*)(lds + PG8_SA(b, h) + aoff + m * 2048 + k * 1024); } while (0)
#define PG8_LDB(dst, b, h) do { _Pragma("unroll") for (int n = 0; n < 2; ++n) _Pragma("unroll") for (int k = 0; k < 2; ++k) dst[n][k] = *(const PG8_LAS f16x8*)(lds + PG8_SB(b, h) + boff + n * 2048 + k * 1024); } while (0)
#define PG8_MMA(ai, bj, At, Bt) do { __builtin_amdgcn_s_setprio(1); _Pragma("unroll") for (int m = 0; m < 4; ++m) _Pragma("unroll") for (int n = 0; n < 2; ++n) _Pragma("unroll") for (int k = 0; k < 2; ++k) \
        acc[ai][bj][m][n] = __builtin_amdgcn_mfma_f32_16x16x32_f16(Bt[n][k], At[m][k], acc[ai][bj][m][n], 0, 0, 0); __builtin_amdgcn_s_setprio(0); } while (0)
#define PG8_WAIT_V(n) asm volatile("s_waitcnt vmcnt(" #n ")" ::: "memory")
#define PG8_WAIT_L(n) asm volatile("s_waitcnt lgkmcnt(" #n ")" ::: "memory")
#define PG8_BAR __builtin_amdgcn_s_barrier()
#define PG8_SCHED __builtin_amdgcn_sched_barrier(0)
    Unit cur, nxt; int ui = 0;
    if (!S.next(0, cur)) return;
    f32x4 acc[2][2][4][2];
#pragma unroll
    for (int a = 0; a < 2; ++a)
#pragma unroll
        for (int b = 0; b < 2; ++b)
#pragma unroll
            for (int m = 0; m < 4; ++m)
#pragma unroll
                for (int n = 0; n < 2; ++n) acc[a][b][m][n] = (f32x4){0.f, 0.f, 0.f, 0.f};
    f16x8 At[4][2], B0[2][2], B1[2][2];
    const char* cA = (const char*)g.A + (size_t)cur.pm * tstep; const char* cB = (const char*)g.Bt + (size_t)cur.pn * tstep;
    S.a_ready(cur);
    if constexpr (SP2) {
        PG8_STAGE(PG8_SB(0, 0), cB, voffB); PG8_STAGE(PG8_SB(0, 1), cB + hstep, voffB); PG8_STAGE(PG8_SA(0, 0), cA, voffA); PG8_STAGE(PG8_SA(0, 1), cA + hstep, voffA);
        if (wr == 1) PG8_BAR;
        PG8_WAIT_V(2); PG8_BAR;
        PG8_STAGE(PG8_SB(1, 0), cB + kstep, voffB); PG8_STAGE(PG8_SA(1, 0), cA + kstep, voffA); PG8_STAGE(PG8_SB(1, 1), cB + hstep + kstep, voffB);
        PG8_WAIT_V(6); PG8_BAR;
    } else {
        PG8_STAGE(PG8_SB(0, 0), cB, voffB); PG8_STAGE(PG8_SA(0, 0), cA, voffA); PG8_STAGE(PG8_SB(0, 1), cB + hstep, voffB); PG8_STAGE(PG8_SA(0, 1), cA + hstep, voffA);
        if (wr == 1) PG8_BAR;
        PG8_WAIT_V(4); PG8_BAR;
        PG8_STAGE(PG8_SB(1, 0), cB + kstep, voffB); PG8_STAGE(PG8_SA(1, 0), cA + kstep, voffA); PG8_STAGE(PG8_SB(1, 1), cB + hstep + kstep, voffB);
        PG8_WAIT_V(6); PG8_BAR;
    }
    for (;;) {
        const bool has_next = S.next(ui + 1, nxt);
        const char* nA = has_next ? (const char*)g.A + (size_t)nxt.pm * tstep : cA; const char* nB = has_next ? (const char*)g.Bt + (size_t)nxt.pn * tstep : cB;
        for (int t = 0; t < nt; t += 2) {
            const bool last = (t == nt - 2);
            const char* a1 = cA + (size_t)(t + 1) * kstep;
            const char* a2 = last ? nA : cA + (size_t)(t + 2) * kstep; const char* b2 = last ? nB : cB + (size_t)(t + 2) * kstep;
            const char* a3 = a2 + kstep; const char* b3 = b2 + kstep;
            if (last && has_next) S.a_ready(nxt);
            if constexpr (SP2) {
            PG8_LDB(B0, 0, 0); PG8_LDB(B1, 0, 1); PG8_SCHED; PG8_LDA(At, 0, 0); PG8_STAGE(PG8_SA(1, 1), a1 + hstep, voffA);
            PG8_WAIT_V(8); PG8_WAIT_L(0); PG8_BAR; PG8_MMA(0, 0, At, B0); PG8_MMA(0, 1, At, B1); PG8_BAR; PG8_SCHED;
            PG8_LDA(At, 0, 1); PG8_STAGE(PG8_SB(0, 0), b2, voffB); PG8_STAGE(PG8_SB(0, 1), b2 + hstep, voffB); PG8_STAGE(PG8_SA(0, 0), a2, voffA);
            PG8_WAIT_V(8); PG8_WAIT_L(0); PG8_BAR; PG8_MMA(1, 0, At, B0); PG8_MMA(1, 1, At, B1); PG8_BAR; PG8_SCHED;
            PG8_LDB(B0, 1, 0); PG8_LDB(B1, 1, 1); PG8_SCHED; PG8_LDA(At, 1, 0); PG8_STAGE(PG8_SA(0, 1), a2 + hstep, voffA);
            PG8_WAIT_V(8); PG8_WAIT_L(0); PG8_BAR; PG8_MMA(0, 0, At, B0); PG8_MMA(0, 1, At, B1); PG8_BAR; PG8_SCHED;
            PG8_LDA(At, 1, 1); PG8_STAGE(PG8_SB(1, 0), b3, voffB); PG8_STAGE(PG8_SB(1, 1), b3 + hstep, voffB); PG8_STAGE(PG8_SA(1, 0), a3, voffA);
            PG8_WAIT_V(8); PG8_WAIT_L(0); PG8_BAR; PG8_MMA(1, 0, At, B0); PG8_MMA(1, 1, At, B1); PG8_BAR; PG8_SCHED;
            } else {
            PG8_LDB(B0, 0, 0); PG8_SCHED; PG8_LDA(At, 0, 0); PG8_STAGE(PG8_SA(1, 1), a1 + hstep, voffA);
            PG8_WAIT_L(8); PG8_BAR; PG8_WAIT_L(0); PG8_MMA(0, 0, At, B0); PG8_BAR; PG8_SCHED;
            PG8_LDB(B1, 0, 1); PG8_STAGE(PG8_SB(0, 0), b2, voffB);
            PG8_BAR; PG8_WAIT_L(0); PG8_MMA(0, 1, At, B1); PG8_BAR;
            PG8_LDA(At, 0, 1); PG8_STAGE(PG8_SA(0, 0), a2, voffA);
            PG8_BAR; PG8_WAIT_L(0); PG8_MMA(1, 0, At, B0); PG8_BAR; PG8_SCHED;
            PG8_STAGE(PG8_SB(0, 1), b2 + hstep, voffB);
            PG8_WAIT_V(6); PG8_BAR; PG8_MMA(1, 1, At, B1); PG8_BAR;
            PG8_LDB(B0, 1, 0); PG8_SCHED; PG8_LDA(At, 1, 0); PG8_STAGE(PG8_SA(0, 1), a2 + hstep, voffA);
            PG8_WAIT_L(8); PG8_BAR; PG8_WAIT_L(0); PG8_MMA(0, 0, At, B0); PG8_BAR; PG8_SCHED;
            PG8_LDB(B1, 1, 1); PG8_STAGE(PG8_SB(1, 0), b3, voffB);
            PG8_BAR; PG8_WAIT_L(0); PG8_MMA(0, 1, At, B1); PG8_BAR;
            PG8_LDA(At, 1, 1); PG8_STAGE(PG8_SA(1, 0), a3, voffA);
            PG8_BAR; PG8_WAIT_L(0); PG8_MMA(1, 0, At, B0); PG8_BAR; PG8_SCHED;
            PG8_STAGE(PG8_SB(1, 1), b3 + hstep, voffB);
            PG8_WAIT_V(6); PG8_BAR; PG8_MMA(1, 1, At, B1); PG8_BAR;
            }
        }
        if constexpr (ALIGN_EPI) { if (wr == 0) PG8_BAR; }
        if constexpr (!Epi::AFTER_DRAIN) { E(acc, cur, wr, wc, fr, fq); S.done(cur); }
        if (!has_next) break;
#pragma unroll
        for (int a = 0; a < 2; ++a)
#pragma unroll
            for (int b = 0; b < 2; ++b)
#pragma unroll
                for (int m = 0; m < 4; ++m)
#pragma unroll
                    for (int n = 0; n < 2; ++n) acc[a][b][m][n] = (f32x4){0.f, 0.f, 0.f, 0.f};
        cur = nxt; cA = nA; cB = nB; ++ui;
        if constexpr (ALIGN_EPI) { if (wr == 1) PG8_BAR; }
    }
    PG8_WAIT_V(0);
    if constexpr (!ALIGN_EPI) { if (wr == 0) PG8_BAR; }
    PG8_BAR;
    if constexpr (Epi::AFTER_DRAIN) { E.fused(acc, cur, wr, wc, fr, fq, lds, wid, lane); S.done(cur); }
#undef PG8_SA
#undef PG8_SB
#undef PG8_STAGE
#undef PG8_LDA
#undef PG8_LDB
#undef PG8_MMA
#undef PG8_WAIT_V
#undef PG8_WAIT_L
#undef PG8_BAR
#undef PG8_SCHED
}
}


typedef float f32x4_t __attribute__((ext_vector_type(4)));
typedef _Float16 h16x8 __attribute__((ext_vector_type(8)));
DEVI float silu_f(float v) { return v / (1.f + __expf(-v)); }
struct EpiRoute {
    static constexpr bool PERM = true, AFTER_DRAIN = false;
    gu8* ws; const gf32* ssq;
    DEVI void operator()(const pg8::f32x4 (&acc)[2][2][4][2], const pg8::Unit& u, int wr, int wc, int fr, int fq) const {
        const int row0 = u.pm * 256 + wr * 64 + fr;
        float rs[2][4];
#pragma unroll
        for (int ai = 0; ai < 2; ++ai)
#pragma unroll
            for (int m = 0; m < 4; ++m) { const int rw = row0 + ai * 128 + m * 16; rs[ai][m] = rsqrtf((ssq[rw] + ssq[NT + rw] + ssq[2 * NT + rw] + ssq[3 * NT + rw]) * (1.f / DM) + EPS); }
#pragma unroll
        for (int bj = 0; bj < 2; ++bj) {
            const int cg = u.pn * 256 + bj * 128 + wc * 32;
            const Route r = route(cg);
            if (r.kind < 0) continue;
            gh16* base = (gh16*)(ws + r.off);
            const int c = r.dcol + 8 * fq;
#pragma unroll
            for (int ai = 0; ai < 2; ++ai)
#pragma unroll
                for (int m = 0; m < 4; ++m) {
                    const int row = row0 + ai * 128 + m * 16; const float sc = rs[ai][m] * r.scale;
                    float v[8];
#pragma unroll
                    for (int j = 0; j < 4; ++j) { v[j] = acc[ai][bj][m][0][j] * sc; v[4 + j] = acc[ai][bj][m][1][j] * sc; }
                    if (r.silu) {
#pragma unroll
                        for (int j = 0; j < 8; ++j) v[j] = silu_f(v[j]);
                    }
                    h16x8 o;
#pragma unroll
                    for (int j = 0; j < 8; ++j) o[j] = (h16)v[j];
                    if (r.kind == 0) *(GAS h16x8*)(base + (size_t)row * r.pitch + c) = o;
                    else {
                        const int b = row >> 11, sq = row & 2047;
                        if (r.kind == 3) *(GAS h16x8*)(base + (((size_t)b * 128 + (sq >> 4)) * 64 + (sq & 15) + 16 * (c >> 3)) * 8) = o;
                        else {
                            const int bh = b * 4 + (c >> 6), d0 = c & 63;
                            *(GAS h16x8*)(base + kf_off(bh, sq, d0)) = o;
                            if (r.kind == 2) { *(GAS h16x8*)(base + FSZ + kf4_off(bh, sq, d0)) = o; *(GAS h16x8*)(base + 2 * FSZ + kf16_off(bh, sq, d0)) = o; }
                        }
                    }
                }
        }
    }
};

struct EpiOut {
    static constexpr bool PERM = true, AFTER_DRAIN = true;
    const gf32* h_in; gf32* h_out; gh16* h16o; const gf32* gpost; gf32* ssqy; gf32* ssqh; const XcdBarrier* bar; bool write_next;
    DEVI void rowsum_publish(const float (&ps)[2][4], gf32* dst, const pg8::Unit& u, int wr, int wc, int fr, int fq, PG8_LAS unsigned char* lds) const {
        lf32* red = (lf32*)lds;
        __syncthreads();
#pragma unroll
        for (int ai = 0; ai < 2; ++ai)
#pragma unroll
            for (int m = 0; m < 4; ++m) { float v = ps[ai][m]; v += __shfl_xor(v, 16); v += __shfl_xor(v, 32); if (fq == 0) red[wc * 256 + ai * 128 + wr * 64 + m * 16 + fr] = v; }
        __syncthreads();
        const int t = otid();
        if (t < 256) dst[(size_t)u.pn * NT + u.pm * 256 + t] = red[t] + red[256 + t] + red[512 + t] + red[768 + t];
    }
    DEVI void fused(pg8::f32x4 (&acc)[2][2][4][2], const pg8::Unit& u, int wr, int wc, int fr, int fq, PG8_LAS unsigned char* lds, int wid, int lane) const {
        float ps[2][4];
#pragma unroll
        for (int ai = 0; ai < 2; ++ai)
#pragma unroll
            for (int m = 0; m < 4; ++m) { float v = 0.f;
#pragma unroll
                for (int bj = 0; bj < 2; ++bj)
#pragma unroll
                    for (int n = 0; n < 2; ++n)
#pragma unroll
                        for (int e = 0; e < 4; ++e) v += acc[ai][bj][m][n][e] * acc[ai][bj][m][n][e];
                ps[ai][m] = v; }
        rowsum_publish(ps, ssqy, u, wr, wc, fr, fq, lds);
        xcd_barrier(*bar);
        const int row0 = u.pm * 256 + wr * 64 + fr;
#pragma unroll
        for (int ai = 0; ai < 2; ++ai)
#pragma unroll
            for (int m = 0; m < 4; ++m) {
                const int row = row0 + ai * 128 + m * 16;
                const float rs = rsqrtf((ssqy[row] + ssqy[NT + row] + ssqy[2 * NT + row] + ssqy[3 * NT + row]) * (1.f / DM) + EPS);
                float v2 = 0.f;
#pragma unroll
                for (int bj = 0; bj < 2; ++bj) {
                    const int col = u.pn * 256 + bj * 128 + wc * 32 + 8 * fq;
                    const size_t off = (size_t)row * DM + col;
                    h16x8 oh;
#pragma unroll
                    for (int n = 0; n < 2; ++n) {
                        const f32x4_t hv = *(const GAS f32x4_t*)(h_in + off + 4 * n), gv = *(const GAS f32x4_t*)(gpost + col + 4 * n);
                        f32x4_t o;
#pragma unroll
                        for (int e = 0; e < 4; ++e) { o[e] = hv[e] + acc[ai][bj][m][n][e] * rs * gv[e]; v2 += o[e] * o[e]; oh[4 * n + e] = (h16)o[e]; }
                        *(GAS f32x4_t*)(h_out + off + 4 * n) = o;
                    }
                    if (write_next) *(GAS h16x8*)(h16o + off) = oh;
                }
                ps[ai][m] = v2;
            }
        if (write_next) rowsum_publish(ps, ssqh, u, wr, wc, fr, fq, lds);
    }
    DEVI void operator()(const pg8::f32x4 (&)[2][2][4][2], const pg8::Unit&, int, int, int, int) const {}
};

constexpr int NTHR = 512, NWAVE = 8;

template <bool REF>
DEVI void cvt_transpose(const gf32* __restrict__ src, int src_pitch, const gf32* __restrict__ g, gh16* dst, int N, int K, lu8* lds, int item0, int nitems_total, int& item_base) {
    const int tid = otid();
    LAS float (*tile)[65] = (LAS float (*)[65])lds;
    const int ntn = N / 64, ntk = K / 64, n_it = ntn * ntk;
    for (int it = item0; it < nitems_total; it += gridDim.x) {
        const int li = it - item_base; if (li < 0 || li >= n_it) continue;
        const int n0 = (li % ntn) * 64, k0 = (li / ntn) * 64;
        __syncthreads();
        const int c = tid & 63; int rc = n0 + c; if (REF) rc = ref_col(rc);
#pragma unroll
        for (int ps = 0; ps < 8; ++ps) { const int k = ps * 8 + (tid >> 6);
            tile[k][c] = rc >= 0 ? src[(size_t)(k0 + k) * src_pitch + rc] * (g ? g[k0 + k] : 1.f) : 0.f; }
        __syncthreads();
        const int cc = tid >> 3, kq = (tid & 7) * 8;
        h16x8 o;
#pragma unroll
        for (int j = 0; j < 8; ++j) o[j] = (h16)tile[kq + j][cc];
        *(GAS h16x8*)(dst + (size_t)(n0 + cc) * K + k0 + kq) = o;
    }
    item_base += n_it;
}

DEVI void ph_rowstat_cvt(const gf32* h, gf32* ssq, gh16* h16o) {
    const int t_ = otid(); const int lane = t_ & 63, gw = blockIdx.x * NWAVE + (t_ >> 6), nw = gridDim.x * NWAVE;
    for (int row = gw; row < NT; row += nw) {
        const GAS f32x4_t* p = (const GAS f32x4_t*)(h + (size_t)row * DM);
        float s = 0.f;
#pragma unroll
        for (int i = 0; i < 4; ++i) { f32x4_t v = p[lane + 64 * i]; s += v[0] * v[0] + v[1] * v[1] + v[2] * v[2] + v[3] * v[3];
            typedef _Float16 h16x4 __attribute__((ext_vector_type(4)));
            h16x4 o; o[0] = (h16)v[0]; o[1] = (h16)v[1]; o[2] = (h16)v[2]; o[3] = (h16)v[3];
            *(GAS h16x4*)(h16o + (size_t)row * DM + (lane + 64 * i) * 4) = o; }
        for (int o = 32; o; o >>= 1) s += __shfl_xor(s, o);
        if (lane == 0) { ssq[row] = s; ssq[NT + row] = 0.f; ssq[2 * NT + row] = 0.f; ssq[3 * NT + row] = 0.f; }
    }
}

typedef float f32x16 __attribute__((ext_vector_type(16)));
typedef _Float16 h16x4 __attribute__((ext_vector_type(4)));
DEVI f32x16 mfma32(h16x8 a, h16x8 b, f32x16 c) { return __builtin_amdgcn_mfma_f32_32x32x16_f16(a, b, c, 0, 0, 0); }
#define CROW(r) (((r) & 3) + 8 * ((r) >> 2))
DEVI float xh_max(float x) { auto r = __builtin_amdgcn_permlane32_swap(__float_as_uint(x), __float_as_uint(x), false, false); return fmaxf(__uint_as_float(r[0]), __uint_as_float(r[1])); }
DEVI float xh_sum(float x) { auto r = __builtin_amdgcn_permlane32_swap(__float_as_uint(x), __float_as_uint(x), false, false); return __uint_as_float(r[0]) + __uint_as_float(r[1]); }
DEVI unsigned pk2h(float a, float b) { auto v = __builtin_amdgcn_cvt_pkrtz(a, b); return __builtin_bit_cast(unsigned, v); }
DEVI h16x8 pack8(const f32x16& p, int s) {
    typedef unsigned u32x4_t __attribute__((ext_vector_type(4)));
    u32x4_t w;
    w[0] = pk2h(p[8 * s + 0], p[8 * s + 1]); w[1] = pk2h(p[8 * s + 2], p[8 * s + 3]); w[2] = pk2h(p[8 * s + 4], p[8 * s + 5]); w[3] = pk2h(p[8 * s + 6], p[8 * s + 7]);
    return __builtin_bit_cast(h16x8, w);
}
DEVI h16x8 ldv8(const gh16* p) {
    h16x4 a = *(const GAS h16x4*)p, b = *(const GAS h16x4*)(p + 8);
    h16x8 r; r[0] = a[0]; r[1] = a[1]; r[2] = a[2]; r[3] = a[3]; r[4] = b[0]; r[5] = b[1]; r[6] = b[2]; r[7] = b[3]; return r;
}
DEVI void softmax_tile(f32x16& S, float& m, float& l, f32x16& O0, f32x16& O1) {
    float mx = S[0];
#pragma unroll
    for (int r = 1; r < 16; ++r) mx = fmaxf(mx, S[r]);
    mx = xh_max(mx);
    if (__any(mx > m)) {
        const float mn = fmaxf(m, mx), al = __builtin_amdgcn_exp2f(m - mn);
        l *= al; O0 *= al; O1 *= al; m = mn;
    }
#pragma unroll
    for (int r = 0; r < 16; ++r) S[r] = __builtin_amdgcn_exp2f(S[r] - m);
    l += ((S[0] + S[1]) + (S[2] + S[3])) + ((S[4] + S[5]) + (S[6] + S[7])) + (((S[8] + S[9]) + (S[10] + S[11])) + ((S[12] + S[13]) + (S[14] + S[15])));
}
DEVI void softmax_tile_h(f32x16& S, float& m, float& l, f32x16& O0, f32x16& O1, int hot) { if (hot < 2) softmax_tile(S, m, l, O0, O1); else l += S[0]; }
DEVI int wq_next(gu32* ctr) {
    int e = 0;
    if ((otid() & 63) == 0) e = (int)__hip_atomic_fetch_add(ctr, 1u, __ATOMIC_RELAXED, __HIP_MEMORY_SCOPE_AGENT);
    return __builtin_amdgcn_readfirstlane(e);
}

DEVI void flashA_item(int b, int hh, int qt, const gh16* qA, const gh16* KF, const gh16* KRF, const gh16* VF, const gh16* gate, gh16* mix) {
    const int lane = otid() & 63, q = lane & 31, h = lane >> 5;
    const size_t tokq = (size_t)b * SEQ + qt * 32 + q;
    h16x8 qf[6];
#pragma unroll
    for (int ks = 0; ks < 6; ++ks) qf[ks] = *(const GAS h16x8*)(qA + tokq * 384 + hh * 96 + ks * 16 + 8 * h);
    f32x16 O0 = {}, O1 = {};
    float m = -1e30f, l = 0.f;
    const gh16* kp = KF + (size_t)(b * 4 + hh) * 64 * 2048 + lane * 8;
    const gh16* rp = KRF + (size_t)b * 64 * 1024 + lane * 8;
    const gh16* vp = VF + (size_t)(b * 4 + hh) * 64 * 2048 + lane * 8;
    h16x8 kf[6];
#pragma unroll
    for (int ks = 0; ks < 4; ++ks) kf[ks] = *(const GAS h16x8*)(kp + ks * 512);
#pragma unroll
    for (int ks = 0; ks < 2; ++ks) kf[4 + ks] = *(const GAS h16x8*)(rp + ks * 512);
    h16x8 vf[4], vn[4];
#pragma unroll
    for (int f = 0; f < 4; ++f) vf[f] = *(const GAS h16x8*)(vp + f * 512);
    for (int j = 0; j <= qt; ++j) {
        f32x16 S = {};
#pragma unroll
        for (int ks = 0; ks < 6; ++ks) S = mfma32(kf[ks], qf[ks], S);
        if (j < qt) {
#pragma unroll
            for (int ks = 0; ks < 4; ++ks) kf[ks] = *(const GAS h16x8*)(kp + (size_t)(j + 1) * 2048 + ks * 512);
#pragma unroll
            for (int ks = 0; ks < 2; ++ks) kf[4 + ks] = *(const GAS h16x8*)(rp + (size_t)(j + 1) * 1024 + ks * 512);
#pragma unroll
            for (int f = 0; f < 4; ++f) vn[f] = *(const GAS h16x8*)(vp + (size_t)(j + 1) * 2048 + f * 512);
        } else {
#pragma unroll
            for (int r = 0; r < 16; ++r) S[r] = (CROW(r) + 4 * h > q) ? -3e38f : S[r];
        }
        softmax_tile(S, m, l, O0, O1);
        const h16x8 p0 = pack8(S, 0), p1 = pack8(S, 1);
        O0 = mfma32(vf[0], p0, O0); O0 = mfma32(vf[1], p1, O0);
        O1 = mfma32(vf[2], p0, O1); O1 = mfma32(vf[3], p1, O1);
#pragma unroll
        for (int f = 0; f < 4; ++f) vf[f] = vn[f];
    }
    const float il = 1.f / xh_sum(l);
    const gh16* gp = gate + tokq * 1024 + hh * 64 + 4 * h;
#pragma unroll
    for (int db = 0; db < 2; ++db)
#pragma unroll
        for (int g = 0; g < 4; ++g) {
            const h16x4 gv = *(const GAS h16x4*)(gp + db * 32 + 8 * g); h16x4 o;
#pragma unroll
            for (int e = 0; e < 4; ++e) o[e] = (h16)((db ? O1[4 * g + e] : O0[4 * g + e]) * il * (float)gv[e]);
            *(GAS h16x4*)(mix + mixf_off(tokq, hh * 64 + db * 32 + 8 * g + 4 * h)) = o;
        }
}

DEVI int far_bucket(int n) { return 23 + (n >= 182 ? 1 : 0) + (n >= 246 ? 1 : 0) + (n >= 332 ? 1 : 0) + (n >= 450 ? 1 : 0) + (n >= 609 ? 1 : 0) + (n >= 825 ? 1 : 0) + (n >= 1117 ? 1 : 0) + (n >= 1513 ? 1 : 0); }
DEVI int far_start(int bk) { return bk == 24 ? 182 : bk == 25 ? 246 : bk == 26 ? 332 : bk == 27 ? 450 : bk == 28 ? 609 : bk == 29 ? 825 : bk == 30 ? 1117 : 1513; }
constexpr int L_NEAR = 0, L_R3 = 12288, L_R2 = 15360, L_R1 = 21504, L_LAM = 39936, L_P2END = 40000;
constexpr int L_BIASL = 40000, L_RING = 41984, L_MRING = L_RING + 4 * 10240, L_WQ = L_MRING + 8192;
DEVI void p2_setup(const gf32* biasTab, const gf32* lam_p, float lambda_init, lu8* lds) {
    const int tid = otid();
    lf32* nearR = (lf32*)(lds + L_NEAR);
    for (int i = tid; i < 12 * 256; i += NTHR) { const int hb = i >> 8, u = i & 255, tix = 223 - u; nearR[i] = tix < 0 ? -3e38f : biasTab[hb * 2048 + tix]; }
    lf32* R3 = (lf32*)(lds + L_R3); lf32* R2 = (lf32*)(lds + L_R2); lf32* R1 = (lf32*)(lds + L_R1);
    for (int i = tid; i < 4 * 192; i += NTHR) { const int hb = i / 192, kk = 159 - (i % 192); R3[i] = (kk < 0 || kk > 128) ? -3e38f : biasTab[hb * 2048 + kk * 16]; }
    for (int i = tid; i < 4 * 384; i += NTHR) { const int hb = i / 384, kk = 255 - (i % 384); R2[i] = (kk < 0 || kk > 128) ? -3e38f : biasTab[hb * 2048 + kk * 4]; }
    for (int i = tid; i < 4 * 1152; i += NTHR) { const int hb = i / 1152, kk = 639 - (i % 1152); R1[i] = (kk < 0 || kk > 128) ? -3e38f : biasTab[hb * 2048 + kk]; }
    { lf32* bl = (lf32*)(lds + L_BIASL); for (int i = tid; i < 12 * 32; i += NTHR) { const int hb = i >> 5, k = i & 31; bl[i] = biasTab[hb * 2048 + (k < 16 ? k : kBucketStart[k - 16])]; } }
    if (tid == 0) { float a1 = 0.f, a2 = 0.f; for (int i = 0; i < 32; ++i) { a1 += lam_p[i] * lam_p[32 + i]; a2 += lam_p[64 + i] * lam_p[96 + i]; }
        *(lf32*)(lds + L_LAM) = expf(a1) - expf(a2) + lambda_init; }
    __syncthreads();
}

DEVI void ph_vtrans(const gh16* vtmp, gh16* VF, lu8* lds) {
    const int tid = otid();
    LAS h16 (*tile)[72] = (LAS h16 (*)[72])lds;
    for (int it = blockIdx.x; it < 3 * 32 * 4; it += gridDim.x) {
        const int src = it >> 7, bh = (it >> 2) & 31, blk = it & 3, b = bh >> 2, hh = bh & 3;
        __syncthreads();
#pragma unroll
        for (int k = 0; k < 8; ++k) { const int idx = k * NTHR + tid, row = idx >> 3, c8 = idx & 7;
            *(LAS h16x8*)&tile[row][c8 * 8] = *(const GAS h16x8*)(vtmp + ((size_t)b * SEQ + blk * 512 + row) * 768 + src * 256 + hh * 64 + c8 * 8); }
        __syncthreads();
        gh16* out0 = VF + (src == 0 ? 0 : (src == 1 ? 3 * FSZ : 4 * FSZ));
#pragma unroll 1
        for (int k = 0; k < 8; ++k) {
            const int fl = k * NTHR + tid, lane = fl & 63, frag = (fl >> 6) & 3, dl = lane & 31, hp = lane >> 5, db = frag >> 1, sk = frag & 1;
            {
                const int tl = fl >> 8; h16x8 o;
#pragma unroll
                for (int e = 0; e < 8; ++e) o[e] = tile[tl * 32 + 16 * sk + 8 * (e >> 2) + 4 * hp + (e & 3)][db * 32 + dl];
                *(GAS h16x8*)(out0 + ((((size_t)bh * 64 + blk * 16 + tl) * 4 + frag) * 64 + lane) * 8) = o;
            }
            if (src == 0) {
                {
                    const int r4 = fl >> 10, tl = (fl >> 8) & 3; h16x8 o;
#pragma unroll
                    for (int e = 0; e < 8; ++e) o[e] = tile[4 * (tl * 32 + 16 * sk + 8 * (e >> 2) + 4 * hp + (e & 3)) + r4][db * 32 + dl];
                    *(GAS h16x8*)(out0 + FSZ + (((((size_t)bh * 4 + r4) * 16 + blk * 4 + tl) * 4 + frag) * 64 + lane) * 8) = o;
                }
                {
                    const int r = fl >> 8; h16x8 o;
#pragma unroll
                    for (int e = 0; e < 8; ++e) o[e] = tile[16 * (16 * sk + 8 * (e >> 2) + 4 * hp + (e & 3)) + r][db * 32 + dl];
                    *(GAS h16x8*)(out0 + 2 * FSZ + (((((size_t)bh * 16 + r) * 4 + blk) * 4 + frag) * 64 + lane) * 8) = o;
                }
            }
        }
    }
}

template <int NMAP, bool MASK>
DEVI void flashCD_item(int b, int hh, int qt, int hb, const gh16* Q, const gh16* KF, const gh16* VF, const gu32* mask, const gf32* biasTab, const lu8* lds,
                       const gf32* subln, float lambda_init, const gh16* gate, gh16* mix, int mixcol, int hot = 0) {
    constexpr int NKS = 4 / NMAP;
    const int lane = otid() & 63, q = lane & 31, h = lane >> 5;
    const size_t tokq = (size_t)b * SEQ + qt * 32 + q;
    const gh16* kp = KF + (size_t)(b * 4 + hh) * 64 * 2048 + lane * 8;
    const gh16* vp = VF + (size_t)(b * 4 + hh) * 64 * 2048 + lane * 8;
    h16x8 qf[NMAP][NKS], kf[NMAP][NKS];
#pragma unroll
    for (int mp = 0; mp < NMAP; ++mp)
#pragma unroll
        for (int ks = 0; ks < NKS; ++ks) {
            qf[mp][ks] = *(const GAS h16x8*)(Q + tokq * 256 + hh * 64 + (mp * NKS + ks) * 16 + 8 * h);
            kf[mp][ks] = *(const GAS h16x8*)(kp + (mp * NKS + ks) * 512);
        }
    f32x16 O[NMAP][2]; float m[NMAP], l[NMAP];
#pragma unroll
    for (int mp = 0; mp < NMAP; ++mp) { O[mp][0] = (f32x16){}; O[mp][1] = (f32x16){}; m[mp] = -1e30f; l[mp] = 0.f; }
    const lf32* nearR = (const lf32*)(lds + L_NEAR) + hb * 256;
    const gf32* bt = biasTab + hb * 2048;
    h16x8 vf[2][2], vn[2][2];
#pragma unroll
    for (int db = 0; db < 2; ++db)
#pragma unroll
        for (int sk = 0; sk < 2; ++sk) vf[db][sk] = *(const GAS h16x8*)(vp + (db * 2 + sk) * 512);
    unsigned mw = 0xffffffffu, mwn = 0xffffffffu;
    if (MASK) mw = mask[tokq * 64];
    for (int j = 0; j <= qt; ++j) {
        f32x16 S[NMAP];
#pragma unroll
        for (int mp = 0; mp < NMAP; ++mp) { S[mp] = (f32x16){};
#pragma unroll
            for (int ks = 0; ks < NKS; ++ks) S[mp] = mfma32(kf[mp][ks], qf[mp][ks], S[mp]); }
        if (j < qt && hot < 5) {
#pragma unroll
            for (int mp = 0; mp < NMAP; ++mp)
#pragma unroll
                for (int ks = 0; ks < NKS; ++ks) kf[mp][ks] = *(const GAS h16x8*)(kp + (size_t)(hot ? 0 : j + 1) * 2048 + (mp * NKS + ks) * 512);
#pragma unroll
            for (int db = 0; db < 2; ++db)
#pragma unroll
                for (int sk = 0; sk < 2; ++sk) vn[db][sk] = *(const GAS h16x8*)(vp + (size_t)(hot ? 0 : j + 1) * 2048 + (db * 2 + sk) * 512);
            if (MASK) mwn = mask[tokq * 64 + j + 1];
        }
        const int D0 = (qt - j) * 32;
        if (hot >= 3) {} else
        if (D0 < 192) {
            const lf32* tp = nearR + (223 - D0 - q + 4 * h);
#pragma unroll
            for (int r = 0; r < 16; ++r) { const float bv = tp[CROW(r)];
#pragma unroll
                for (int mp = 0; mp < NMAP; ++mp) S[mp][r] += bv; }
        } else {
            const int blo = far_bucket(D0 - 31), bhi = far_bucket(D0 + 31);
            const lf32* biasL = (const lf32*)(lds + L_BIASL) + hb * 32;
            const float lo = biasL[blo], hi = biasL[bhi];
            if (blo == bhi) {
#pragma unroll
                for (int mp = 0; mp < NMAP; ++mp) S[mp] += lo;
            } else {
                const int x = D0 + q - 4 * h - far_start(bhi);
#pragma unroll
                for (int r = 0; r < 16; ++r) { const float bv = (x >= CROW(r)) ? hi : lo;
#pragma unroll
                    for (int mp = 0; mp < NMAP; ++mp) S[mp][r] += bv; }
            }
        }
        if (MASK && hot < 3) {
#pragma unroll
            for (int r = 0; r < 16; ++r) S[0][r] = (((mw >> (4 * h)) >> CROW(r)) & 1u) ? S[0][r] : -3e38f;
        }
#pragma unroll
        for (int mp = 0; mp < NMAP; ++mp) {
            softmax_tile_h(S[mp], m[mp], l[mp], O[mp][0], O[mp][1], hot);
            const h16x8 p0 = pack8(S[mp], 0), p1 = pack8(S[mp], 1);
            if (hot < 4) {
            O[mp][0] = mfma32(vf[0][0], p0, O[mp][0]); O[mp][0] = mfma32(vf[0][1], p1, O[mp][0]);
            O[mp][1] = mfma32(vf[1][0], p0, O[mp][1]); O[mp][1] = mfma32(vf[1][1], p1, O[mp][1]);
            } else { O[mp][0][0] += (float)p0[0] + (float)p1[0]; }
        }
#pragma unroll
        for (int db = 0; db < 2; ++db)
#pragma unroll
            for (int sk = 0; sk < 2; ++sk) vf[db][sk] = vn[db][sk];
        mw = mwn;
    }
    f32x16 R0, R1;
    if (NMAP == 2) {
        const float lam = *(const lf32*)(lds + L_LAM);
        const float i0 = 1.f / xh_sum(l[0]), i1 = lam / xh_sum(l[NMAP - 1]);
        R0 = O[0][0] * i0 - O[NMAP - 1][0] * i1; R1 = O[0][1] * i0 - O[NMAP - 1][1] * i1;
        float ss = 0.f;
#pragma unroll
        for (int r = 0; r < 16; ++r) ss += R0[r] * R0[r] + R1[r] * R1[r];
        ss = xh_sum(ss);
        const float rs = rsqrtf(ss * (1.f / 64.f) + EPS) * (1.f - lambda_init);
        R0 *= rs; R1 *= rs;
    } else {
        const float il = 1.f / xh_sum(l[0]);
        R0 = O[0][0] * il; R1 = O[0][1] * il;
    }
    const gh16* gp = gate + tokq * 1024 + mixcol + hh * 64 + 4 * h;
#pragma unroll
    for (int db = 0; db < 2; ++db)
#pragma unroll
        for (int g = 0; g < 4; ++g) {
            const h16x4 gv = *(const GAS h16x4*)(gp + db * 32 + 8 * g); h16x4 o;
#pragma unroll
            for (int e = 0; e < 4; ++e) { float v = (db ? R1[4 * g + e] : R0[4 * g + e]) * (float)gv[e];
                if (NMAP == 2) v *= subln[db * 32 + 8 * g + 4 * h + e];
                o[e] = (h16)v; }
            if (!hot) *(GAS h16x4*)(mix + mixf_off(tokq, mixcol + hh * 64 + db * 32 + 8 * g + 4 * h)) = o; else asm volatile("" :: "v"(o));
        }
}

template <int BR>
DEVI void flashQ2_item(int b, int hh, int pr, const gh16* Q, const gh16* KF, const gh16* KRF, const gh16* VF, const gu32* mask, const gf32* biasTab, const lu8* lds,
                       const gh16* gate, gh16* mix, int mixcol, int hb, int hot = 0) {
    constexpr int NQK = BR == 0 ? 6 : 4;
    const int lane = otid() & 63, q = lane & 31, h = lane >> 5, bh = b * 4 + hh;
    const int qt1 = 2 * pr + 1;
    size_t tokq[2]; h16x8 qf[2][NQK];
#pragma unroll
    for (int qi = 0; qi < 2; ++qi) { tokq[qi] = (size_t)b * SEQ + (2 * pr + qi) * 32 + q;
#pragma unroll
        for (int ks = 0; ks < NQK; ++ks) qf[qi][ks] = *(const GAS h16x8*)(Q + tokq[qi] * (BR == 0 ? 384 : 256) + hh * (BR == 0 ? 96 : 64) + ks * 16 + 8 * h); }
    f32x16 O[2][2]; float m[2], l[2];
#pragma unroll
    for (int qi = 0; qi < 2; ++qi) { O[qi][0] = (f32x16){}; O[qi][1] = (f32x16){}; m[qi] = -1e30f; l[qi] = 0.f; }
    const gh16* kp = KF + (size_t)bh * 64 * 2048 + lane * 8;
    const gh16* rp = KRF + (size_t)b * 64 * 1024 + lane * 8;
    const gh16* vp = VF + (size_t)bh * 64 * 2048 + lane * 8;
    const lf32* nearR = (const lf32*)(lds + L_NEAR) + hb * 256;
    const gf32* bt = biasTab + hb * 2048;
    h16x8 kf[NQK], vf[4];
#pragma unroll
    for (int ks = 0; ks < NQK; ++ks) kf[ks] = (BR == 0 && ks >= 4) ? *(const GAS h16x8*)(rp + (ks - 4) * 512) : *(const GAS h16x8*)(kp + ks * 512);
    unsigned mw[2] = {0xffffffffu, 0xffffffffu}, mwn[2] = {0xffffffffu, 0xffffffffu};
    if (BR == 1) { mw[0] = mask[tokq[0] * 64]; mw[1] = mask[tokq[1] * 64]; }
#pragma unroll 1
    for (int j = 0; j <= qt1; ++j) {
#pragma unroll
        for (int f = 0; f < 4; ++f) vf[f] = *(const GAS h16x8*)(vp + (size_t)(hot ? 0 : j) * 2048 + f * 512);
        f32x16 S[2];
#pragma unroll
        for (int qi = 0; qi < 2; ++qi) { S[qi] = (f32x16){};
#pragma unroll
            for (int ks = 0; ks < NQK; ++ks) S[qi] = mfma32(kf[ks], qf[qi][ks], S[qi]); }
        if (j < qt1 && hot < 5) {
#pragma unroll
            for (int ks = 0; ks < NQK; ++ks) kf[ks] = (BR == 0 && ks >= 4) ? *(const GAS h16x8*)(rp + (size_t)(hot ? 0 : j + 1) * 1024 + (ks - 4) * 512) : *(const GAS h16x8*)(kp + (size_t)(hot ? 0 : j + 1) * 2048 + ks * 512);
            if (BR == 1) { mwn[0] = mask[tokq[0] * 64 + (j + 1 < qt1 ? j + 1 : j)]; mwn[1] = mask[tokq[1] * 64 + j + 1]; }
        }
#pragma unroll
        for (int qi = 0; qi < 2; ++qi) {
            const int qt = 2 * pr + qi;
            if (j <= qt) {
                const int D0 = (qt - j) * 32;
                if (hot >= 3) {} else
                if (BR == 0) {
                    if (D0 == 0) {
#pragma unroll
                        for (int r = 0; r < 16; ++r) S[qi][r] = (CROW(r) + 4 * h > q) ? -3e38f : S[qi][r];
                    }
                } else {
                    if (D0 < 192) {
                        const lf32* tp = nearR + (223 - D0 - q + 4 * h);
#pragma unroll
                        for (int r = 0; r < 16; ++r) S[qi][r] += tp[CROW(r)];
                    } else {
                        const int blo = far_bucket(D0 - 31), bhi = far_bucket(D0 + 31);
                        const lf32* biasL = (const lf32*)(lds + L_BIASL) + hb * 32;
                        const float lo = biasL[blo], hi = biasL[bhi];
                        if (blo == bhi) S[qi] += lo;
                        else {
                            const int x = D0 + q - 4 * h - far_start(bhi);
#pragma unroll
                            for (int r = 0; r < 16; ++r) S[qi][r] += (x >= CROW(r)) ? hi : lo;
                        }
                    }
                    const unsigned mm = mw[qi] >> (4 * h);
#pragma unroll
                    for (int r = 0; r < 16; ++r) S[qi][r] = ((mm >> CROW(r)) & 1u) ? S[qi][r] : -3e38f;
                }
                softmax_tile_h(S[qi], m[qi], l[qi], O[qi][0], O[qi][1], hot);
                const h16x8 p0 = pack8(S[qi], 0), p1 = pack8(S[qi], 1);
                if (hot < 4) {
                O[qi][0] = mfma32(vf[0], p0, O[qi][0]); O[qi][0] = mfma32(vf[1], p1, O[qi][0]);
                O[qi][1] = mfma32(vf[2], p0, O[qi][1]); O[qi][1] = mfma32(vf[3], p1, O[qi][1]);
                } else { O[qi][0][0] += (float)p0[0] + (float)p1[0]; }
            }
        }
        mw[0] = mwn[0]; mw[1] = mwn[1];
    }
#pragma unroll
    for (int qi = 0; qi < 2; ++qi) {
        const float il = 1.f / xh_sum(l[qi]);
        const gh16* gp = gate + tokq[qi] * 1024 + mixcol + hh * 64 + 4 * h;
#pragma unroll
        for (int db = 0; db < 2; ++db)
#pragma unroll
            for (int g = 0; g < 4; ++g) {
                const h16x4 gv = *(const GAS h16x4*)(gp + db * 32 + 8 * g); h16x4 o;
#pragma unroll
                for (int e = 0; e < 4; ++e) o[e] = (h16)(O[qi][db][4 * g + e] * il * (float)gv[e]);
                if (!hot) *(GAS h16x4*)(mix + mixf_off(tokq[qi], mixcol + hh * 64 + db * 32 + 8 * g + 4 * h)) = o; else asm volatile("" :: "v"(o));
            }
    }
}

template <int BR>
DEVI void flashWG_item(int b, int hh, int Qb, const gh16* Q, const gh16* KF, const gh16* KRF, const gh16* VF, const gu32* mask, lu8* lds,
                       const gf32* subln, float lambda_init, const gh16* gate, gh16* mix, int mixcol, int hb) {
    constexpr int NMAP = BR == 2 ? 2 : 1, NQK = BR == 0 ? 6 : 4, NKS = NQK / NMAP, NP = NQK + 4, TB = NP * 1024, NDMA = BR == 2 ? 1 : 2, DD = 3;
    const int tid = otid(), lane = tid & 63, q = lane & 31, h = lane >> 5, wv = __builtin_amdgcn_readfirstlane(tid >> 6);
    const int qt = 8 * Qb + wv, last = 8 * Qb + 7, bh = b * 4 + hh;
    const size_t tokq = (size_t)b * SEQ + qt * 32 + q;
    h16x8 qf[NQK];
#pragma unroll
    for (int ks = 0; ks < NQK; ++ks) qf[ks] = *(const GAS h16x8*)(Q + tokq * (BR == 0 ? 384 : 256) + hh * (BR == 0 ? 96 : 64) + ks * 16 + 8 * h);
    f32x16 O[NMAP][2]; float m[NMAP], l[NMAP];
#pragma unroll
    for (int mp = 0; mp < NMAP; ++mp) { O[mp][0] = (f32x16){}; O[mp][1] = (f32x16){}; m[mp] = -1e30f; l[mp] = 0.f; }
    asm volatile("s_waitcnt vmcnt(0)" ::: "memory");
    __syncthreads();
    lu8* ring = lds + L_RING; lu8* mring = lds + L_MRING;
    auto issue = [&](int jt) {
        const int jc = jt < last ? jt : last, slot = jt & 3;
        {
            const int pc = wv;
            const gh16* src = pc < 4 ? KF + ((size_t)bh * 64 + jc) * 2048 + pc * 512
                            : (BR == 0 && pc < 6) ? KRF + ((size_t)b * 64 + jc) * 1024 + (pc - 4) * 512
                            : VF + ((size_t)bh * 64 + jc) * 2048 + (pc - NQK) * 512;
            __builtin_amdgcn_global_load_lds((const GAS unsigned*)(src + lane * 8), (LAS unsigned*)(ring + slot * TB + pc * 1024), 16, 0, 0);
        }
        if (BR == 0) {
            const int pc = 8 + (wv & 1);
            const gh16* src = VF + ((size_t)bh * 64 + jc) * 2048 + (pc - NQK) * 512;
            __builtin_amdgcn_global_load_lds((const GAS unsigned*)(src + lane * 8), (LAS unsigned*)(ring + slot * TB + pc * 1024), 16, 0, 0);
        }
        if (BR == 1) __builtin_amdgcn_global_load_lds((const GAS unsigned*)(mask + tokq * 64 + (jc <= qt ? jc : qt)), (LAS unsigned*)(mring + (slot * 8 + wv) * 256), 4, 0, 0);
    };
#pragma unroll
    for (int jt = 0; jt < DD; ++jt) issue(jt);
    const lf32* nearR = (const lf32*)(lds + L_NEAR) + hb * 256;
    const lf32* biasL = (const lf32*)(lds + L_BIASL) + hb * 32;
    f32x16 S[NMAP], Sn[NMAP];
    asm volatile("s_waitcnt vmcnt(%0)" :: "n"((DD - 1) * NDMA) : "memory");
    __builtin_amdgcn_s_barrier();
#pragma unroll
    for (int mp = 0; mp < NMAP; ++mp) { S[mp] = (f32x16){};
#pragma unroll
        for (int ks = 0; ks < NKS; ++ks) S[mp] = mfma32(*(const LAS h16x8*)(ring + lane * 16 + (mp * NKS + ks) * 1024), qf[mp * NKS + ks], S[mp]); }
#pragma unroll 1
    for (int j = 0; j <= last; ++j) {
        asm volatile("s_waitcnt vmcnt(%0)" :: "n"((DD - 2) * NDMA) : "memory");
        __builtin_amdgcn_s_barrier();
        issue(j + DD);
        if (j <= qt) {
            const lu8* sl = ring + (j & 3) * TB + lane * 16;
            if (j + 1 <= qt) {
                const lu8* sn = ring + ((j + 1) & 3) * TB + lane * 16;
#pragma unroll
                for (int mp = 0; mp < NMAP; ++mp) { Sn[mp] = (f32x16){};
#pragma unroll
                    for (int ks = 0; ks < NKS; ++ks) Sn[mp] = mfma32(*(const LAS h16x8*)(sn + (mp * NKS + ks) * 1024), qf[mp * NKS + ks], Sn[mp]); }
            }
            h16x8 vf[4];
#pragma unroll
            for (int f = 0; f < 4; ++f) vf[f] = *(const LAS h16x8*)(sl + (NQK + f) * 1024);
            const int D0 = (qt - j) * 32;
            if (BR == 0) {
                if (D0 == 0) {
#pragma unroll
                    for (int r = 0; r < 16; ++r) S[0][r] = (CROW(r) + 4 * h > q) ? -3e38f : S[0][r];
                }
            } else if (D0 < 192) {
                const lf32* tp = nearR + (223 - D0 - q + 4 * h);
#pragma unroll
                for (int r = 0; r < 16; ++r) { const float bv = tp[CROW(r)];
#pragma unroll
                    for (int mp = 0; mp < NMAP; ++mp) S[mp][r] += bv; }
            } else {
                int blo = 23, bhi = 23;
#pragma unroll
                for (int jj = 8; jj < 16; ++jj) { blo += (D0 - 31 >= kBucketStart[jj]) ? 1 : 0; bhi += (D0 + 31 >= kBucketStart[jj]) ? 1 : 0; }
                const float lo = biasL[blo], hi = biasL[bhi];
                if (blo == bhi) {
#pragma unroll
                    for (int mp = 0; mp < NMAP; ++mp) S[mp] += lo;
                } else {
                    const int x = D0 + q - 4 * h - kBucketStart[bhi - 16];
#pragma unroll
                    for (int r = 0; r < 16; ++r) { const float bv = (x >= CROW(r)) ? hi : lo;
#pragma unroll
                        for (int mp = 0; mp < NMAP; ++mp) S[mp][r] += bv; }
                }
            }
            if (BR == 1) {
                const unsigned mw = *(const LAS unsigned*)(mring + ((j & 3) * 8 + wv) * 256 + lane * 4) >> (4 * h);
#pragma unroll
                for (int r = 0; r < 16; ++r) S[0][r] = ((mw >> CROW(r)) & 1u) ? S[0][r] : -3e38f;
            }
#pragma unroll
            for (int mp = 0; mp < NMAP; ++mp) {
                softmax_tile(S[mp], m[mp], l[mp], O[mp][0], O[mp][1]);
                const h16x8 p0 = pack8(S[mp], 0), p1 = pack8(S[mp], 1);
                O[mp][0] = mfma32(vf[0], p0, O[mp][0]); O[mp][0] = mfma32(vf[1], p1, O[mp][0]);
                O[mp][1] = mfma32(vf[2], p0, O[mp][1]); O[mp][1] = mfma32(vf[3], p1, O[mp][1]);
            }
#pragma unroll
            for (int mp = 0; mp < NMAP; ++mp) S[mp] = Sn[mp];
        }
    }
    asm volatile("s_waitcnt vmcnt(0)" ::: "memory");
    f32x16 R0, R1;
    if (NMAP == 2) {
        const float lam = *(const lf32*)(lds + L_LAM);
        const float i0 = 1.f / xh_sum(l[0]), i1 = lam / xh_sum(l[NMAP - 1]);
        R0 = O[0][0] * i0 - O[NMAP - 1][0] * i1; R1 = O[0][1] * i0 - O[NMAP - 1][1] * i1;
        float ss = 0.f;
#pragma unroll
        for (int r = 0; r < 16; ++r) ss += R0[r] * R0[r] + R1[r] * R1[r];
        ss = xh_sum(ss);
        const float rs = rsqrtf(ss * (1.f / 64.f) + EPS) * (1.f - lambda_init);
        R0 *= rs; R1 *= rs;
    } else {
        const float il = 1.f / xh_sum(l[0]);
        R0 = O[0][0] * il; R1 = O[0][1] * il;
    }
    const gh16* gp = gate + tokq * 1024 + mixcol + hh * 64 + 4 * h;
#pragma unroll
    for (int db = 0; db < 2; ++db)
#pragma unroll
        for (int g = 0; g < 4; ++g) {
            const h16x4 gv = *(const GAS h16x4*)(gp + db * 32 + 8 * g); h16x4 o;
#pragma unroll
            for (int e = 0; e < 4; ++e) { float v = (db ? R1[4 * g + e] : R0[4 * g + e]) * (float)gv[e];
                if (NMAP == 2) v *= subln[db * 32 + 8 * g + 4 * h + e];
                o[e] = (h16)v; }
            *(GAS h16x4*)(mix + mixf_off(tokq, mixcol + hh * 64 + db * 32 + 8 * g + 4 * h)) = o;
        }
}

constexpr int L_RING2 = 41984, L_MRING2 = L_RING2 + 8 * 10240, L_WQ2 = L_MRING2 + 8 * 8 * 256;
template <int BR>
DEVI void flashWG2_item(int b, int hh, int Qb, const gh16* Q, const gh16* KF, const gh16* KRF, const gh16* VF, const gu32* mask, lu8* lds,
                        const gf32* subln, float lambda_init, const gh16* gate, gh16* mix, int mixcol, int hb) {
    constexpr int NMAP = BR == 2 ? 2 : 1, NQK = BR == 0 ? 6 : 4, NKS = NQK / NMAP, NP = NQK + 4, TB = NP * 1024;
    const int tid = otid(), lane = tid & 63, q = lane & 31, h = lane >> 5, wv = __builtin_amdgcn_readfirstlane(tid >> 6);
    const int qt = 8 * Qb + wv, NS = 2 * Qb + 2, bh = b * 4 + hh;
    const size_t tokq = (size_t)b * SEQ + qt * 32 + q;
    h16x8 qf[NQK];
#pragma unroll
    for (int ks = 0; ks < NQK; ++ks) qf[ks] = *(const GAS h16x8*)(Q + tokq * (BR == 0 ? 384 : 256) + hh * (BR == 0 ? 96 : 64) + ks * 16 + 8 * h);
    f32x16 O[NMAP][2]; float m[NMAP], l[NMAP];
#pragma unroll
    for (int mp = 0; mp < NMAP; ++mp) { O[mp][0] = (f32x16){}; O[mp][1] = (f32x16){}; m[mp] = -1e30f; l[mp] = 0.f; }
    lu8* ring = lds + L_RING2; lu8* mring = lds + L_MRING2;
    auto issue = [&](int st) {
#pragma unroll
        for (int u = 0; u < (4 * NP + 7) / 8; ++u) {
            const int id = wv + 8 * u;
            if (id < 4 * NP) {
                const int ti = id / NP, pc = id % NP, jt = 4 * st + ti, slot = jt & 7;
                const gh16* src = pc < 4 ? KF + ((size_t)bh * 64 + jt) * 2048 + pc * 512
                                : (BR == 0 && pc < 6) ? KRF + ((size_t)b * 64 + jt) * 1024 + (pc - 4) * 512
                                : VF + ((size_t)bh * 64 + jt) * 2048 + (pc - NQK) * 512;
                __builtin_amdgcn_global_load_lds((const GAS unsigned*)(src + lane * 8), (LAS unsigned*)(ring + slot * TB + pc * 1024), 16, 0, 0);
            }
        }
        if (BR == 1) {
#pragma unroll
            for (int ti = 0; ti < 4; ++ti) { const int jt = 4 * st + ti;
                __builtin_amdgcn_global_load_lds((const GAS unsigned*)(mask + tokq * 64 + (jt <= qt ? jt : qt)), (LAS unsigned*)(mring + ((jt & 7) * 8 + wv) * 256), 4, 0, 0); }
        }
    };
    asm volatile("s_waitcnt vmcnt(0)" ::: "memory");
    __syncthreads();
    issue(0);
    const lf32* nearR = (const lf32*)(lds + L_NEAR) + hb * 256;
    const lf32* biasL = (const lf32*)(lds + L_BIASL) + hb * 32;
#pragma unroll 1
    for (int st = 0; st < NS; ++st) {
        asm volatile("s_waitcnt vmcnt(0)" ::: "memory");
        __builtin_amdgcn_s_barrier();
        if (st + 1 < NS) issue(st + 1);
#pragma unroll 1
        for (int j = 4 * st; j < 4 * st + 4; ++j) {
            if (j > qt) break;
            const lu8* sl = ring + (j & 7) * TB + lane * 16;
            f32x16 S[NMAP];
#pragma unroll
            for (int mp = 0; mp < NMAP; ++mp) { S[mp] = (f32x16){};
#pragma unroll
                for (int ks = 0; ks < NKS; ++ks) S[mp] = mfma32(*(const LAS h16x8*)(sl + (mp * NKS + ks) * 1024), qf[mp * NKS + ks], S[mp]); }
            h16x8 vf[4];
#pragma unroll
            for (int f = 0; f < 4; ++f) vf[f] = *(const LAS h16x8*)(sl + (NQK + f) * 1024);
            const int D0 = (qt - j) * 32;
            if (BR == 0) {
                if (D0 == 0) {
#pragma unroll
                    for (int r = 0; r < 16; ++r) S[0][r] = (CROW(r) + 4 * h > q) ? -3e38f : S[0][r];
                }
            } else if (D0 < 192) {
                const lf32* tp = nearR + (223 - D0 - q + 4 * h);
#pragma unroll
                for (int r = 0; r < 16; ++r) { const float bv = tp[CROW(r)];
#pragma unroll
                    for (int mp = 0; mp < NMAP; ++mp) S[mp][r] += bv; }
            } else {
                const int blo = far_bucket(D0 - 31), bhi = far_bucket(D0 + 31);
                const float lo = biasL[blo], hi = biasL[bhi];
                if (blo == bhi) {
#pragma unroll
                    for (int mp = 0; mp < NMAP; ++mp) S[mp] += lo;
                } else {
                    const int x = D0 + q - 4 * h - far_start(bhi);
#pragma unroll
                    for (int r = 0; r < 16; ++r) { const float bv = (x >= CROW(r)) ? hi : lo;
#pragma unroll
                        for (int mp = 0; mp < NMAP; ++mp) S[mp][r] += bv; }
                }
            }
            if (BR == 1) {
                const unsigned mw = *(const LAS unsigned*)(mring + ((j & 7) * 8 + wv) * 256 + lane * 4) >> (4 * h);
#pragma unroll
                for (int r = 0; r < 16; ++r) S[0][r] = ((mw >> CROW(r)) & 1u) ? S[0][r] : -3e38f;
            }
#pragma unroll
            for (int mp = 0; mp < NMAP; ++mp) {
                softmax_tile(S[mp], m[mp], l[mp], O[mp][0], O[mp][1]);
                const h16x8 p0 = pack8(S[mp], 0), p1 = pack8(S[mp], 1);
                O[mp][0] = mfma32(vf[0], p0, O[mp][0]); O[mp][0] = mfma32(vf[1], p1, O[mp][0]);
                O[mp][1] = mfma32(vf[2], p0, O[mp][1]); O[mp][1] = mfma32(vf[3], p1, O[mp][1]);
            }
        }
    }
    asm volatile("s_waitcnt vmcnt(0)" ::: "memory");
    f32x16 R0, R1;
    if (NMAP == 2) {
        const float lam = *(const lf32*)(lds + L_LAM);
        const float i0 = 1.f / xh_sum(l[0]), i1 = lam / xh_sum(l[NMAP - 1]);
        R0 = O[0][0] * i0 - O[NMAP - 1][0] * i1; R1 = O[0][1] * i0 - O[NMAP - 1][1] * i1;
        float ss = 0.f;
#pragma unroll
        for (int r = 0; r < 16; ++r) ss += R0[r] * R0[r] + R1[r] * R1[r];
        ss = xh_sum(ss);
        const float rs = rsqrtf(ss * (1.f / 64.f) + EPS) * (1.f - lambda_init);
        R0 *= rs; R1 *= rs;
    } else {
        const float il = 1.f / xh_sum(l[0]);
        R0 = O[0][0] * il; R1 = O[0][1] * il;
    }
    const gh16* gp = gate + tokq * 1024 + mixcol + hh * 64 + 4 * h;
#pragma unroll
    for (int db = 0; db < 2; ++db)
#pragma unroll
        for (int g = 0; g < 4; ++g) {
            const h16x4 gv = *(const GAS h16x4*)(gp + db * 32 + 8 * g); h16x4 o;
#pragma unroll
            for (int e = 0; e < 4; ++e) { float v = (db ? R1[4 * g + e] : R0[4 * g + e]) * (float)gv[e];
                if (NMAP == 2) v *= subln[db * 32 + 8 * g + 4 * h + e];
                o[e] = (h16)v; }
            *(GAS h16x4*)(mix + mixf_off(tokq, mixcol + hh * 64 + db * 32 + 8 * g + 4 * h)) = o;
        }
}


DEVI void probe_item(int ntile, int mode) {
    const int lane = otid() & 63;
    h16x8 a, bq;
#pragma unroll
    for (int e = 0; e < 8; ++e) { a[e] = (h16)(lane * 0.001f + e); bq[e] = (h16)(e * 0.01f); }
    f32x16 O0 = {}, O1 = {}; float m = -1e30f, l = 0.f;
#pragma unroll 1
    for (int j = 0; j < ntile; ++j) {
        f32x16 S = {};
#pragma unroll
        for (int ks = 0; ks < 6; ++ks) S = mfma32(a, bq, S);
        if (mode >= 1) softmax_tile(S, m, l, O0, O1);
        const h16x8 p0 = pack8(S, 0), p1 = pack8(S, 1);
        O0 = mfma32(a, p0, O0); O0 = mfma32(a, p1, O0);
        O1 = mfma32(a, p0, O1); O1 = mfma32(a, p1, O1);
    }
    asm volatile("" :: "v"(O0), "v"(O1), "v"(l));
}
DEVI void flashB_tile(const h16x8 (&qf)[4], const gh16* kfr, const gh16* vfr, const lf32* tp, f32x16& O0, f32x16& O1, float& m, float& l, int hot) {
    h16x8 vf[4], kf[4];
#pragma unroll
    for (int f = 0; f < 4; ++f) { kf[f] = *(const GAS h16x8*)(kfr + f * 512); vf[f] = *(const GAS h16x8*)(vfr + f * 512); }
    f32x16 S = {};
#pragma unroll
    for (int ks = 0; ks < 4; ++ks) S = mfma32(kf[ks], qf[ks], S);
    if (hot < 3) {
#pragma unroll
    for (int r = 0; r < 16; ++r) S[r] += tp[CROW(r)];
    }
    softmax_tile_h(S, m, l, O0, O1, hot);
    const h16x8 p0 = pack8(S, 0), p1 = pack8(S, 1);
    if (hot < 4) {
    O0 = mfma32(vf[0], p0, O0); O0 = mfma32(vf[1], p1, O0);
    O1 = mfma32(vf[2], p0, O1); O1 = mfma32(vf[3], p1, O1);
    } else { O0[0] += (float)p0[0] + (float)p1[0]; }
}
DEVI void flashB_item(int b, int hh, int r, int qg, const gh16* Q, const gh16* KF, const gh16* VF, const lu8* lds, const gh16* gate, gh16* mix, int hot = 0) {
    const int lane = otid() & 63, q = lane & 31, h = lane >> 5, bh = b * 4 + hh;
    const size_t tokq = (size_t)b * SEQ + qg * 512 + 16 * q + r;
    h16x8 qf[4];
#pragma unroll
    for (int ks = 0; ks < 4; ++ks) qf[ks] = *(const GAS h16x8*)(Q + tokq * 256 + hh * 64 + ks * 16 + 8 * h);
    f32x16 O0 = {}, O1 = {}; float m = -1e30f, l = 0.f;
    {
        const lf32* R3 = (const lf32*)(lds + L_R3) + hh * 192;
        const size_t base = 2 * FSZ + ((size_t)bh * 16 + r) * 4 * 2048 + lane * 8;
        for (int tl = (qg >= 4 ? qg - 4 : 0); tl <= qg; ++tl) {
            const int c = qg * 32 + q - tl * 32;
            flashB_tile(qf, KF + base + (size_t)(hot ? 0 : tl) * 2048, VF + base + (size_t)(hot ? 0 : tl) * 2048, R3 + (159 - c + 4 * h), O0, O1, m, l, hot);
        }
    }
    {
        const lf32* R2 = (const lf32*)(lds + L_R2) + hh * 384;
        const size_t base = FSZ + ((size_t)bh * 4 + (r & 3)) * 16 * 2048 + lane * 8;
        for (int tl = (qg >= 1 ? qg * 4 - 4 : 0); tl <= qg * 4 + 3; ++tl) {
            const int c = qg * 128 + 4 * q + (r >> 2) - tl * 32;
            flashB_tile(qf, KF + base + (size_t)(hot ? 0 : tl) * 2048, VF + base + (size_t)(hot ? 0 : tl) * 2048, R2 + (255 - c + 4 * h), O0, O1, m, l, hot);
        }
    }
    {
        const lf32* R1 = (const lf32*)(lds + L_R1) + hh * 1152;
        const size_t base = (size_t)bh * 64 * 2048 + lane * 8;
        for (int tl = (qg >= 1 ? qg * 16 - 4 : 0); tl <= qg * 16 + 15; ++tl) {
            const int c = qg * 512 + 16 * q + r - tl * 32;
            flashB_tile(qf, KF + base + (size_t)(hot ? 0 : tl) * 2048, VF + base + (size_t)(hot ? 0 : tl) * 2048, R1 + (639 - c + 4 * h), O0, O1, m, l, hot);
        }
    }
    const float il = 1.f / xh_sum(l);
    const gh16* gp = gate + tokq * 1024 + 256 + hh * 64 + 4 * h;
#pragma unroll
    for (int db = 0; db < 2; ++db)
#pragma unroll
        for (int g = 0; g < 4; ++g) {
            const h16x4 gv = *(const GAS h16x4*)(gp + db * 32 + 8 * g); h16x4 o;
#pragma unroll
            for (int e = 0; e < 4; ++e) o[e] = (h16)((db ? O1[4 * g + e] : O0[4 * g + e]) * il * (float)gv[e]);
            if (!hot) *(GAS h16x4*)(mix + mixf_off(tokq, 256 + hh * 64 + db * 32 + 8 * g + 4 * h)) = o; else asm volatile("" :: "v"(o));
        }
}

typedef float f32x4v __attribute__((ext_vector_type(4)));
typedef unsigned u32x4v __attribute__((ext_vector_type(4)));
DEVI f32x4v mfma16(h16x8 a, h16x8 b, f32x4v c) { return __builtin_amdgcn_mfma_f32_16x16x32_f16(a, b, c, 0, 0, 0); }
constexpr int TK_KSTRIDE = 2308;
constexpr int TK_KEYS = 0, TK_MISC = 16 * TK_KSTRIDE * 4, TK_END = TK_MISC + 64;
DEVI void topk_item(int b, int T16, const gh16* idx, const gh16* KIF, gu32* mask, lu8* lds, int skip = 0) {
    const int tid = otid(), lane = tid & 63, wv = __builtin_amdgcn_readfirstlane(tid >> 6);
    const int t0 = T16 * 16;
    lu32* keys = (lu32*)(lds + TK_KEYS);
    if (T16 < 16) {
        const int sq = tid & 15, sc_ = tid >> 4;
        const unsigned tk = (unsigned)(b * SEQ + t0 + sq) * 64u + 2u * sc_;
        unsigned ones = 0xffffffffu; asm volatile("" : "+v"(ones));
        if (sc_ < 4) { mask[tk] = ones; mask[tk + 1] = ones; }
        return;
    }
    __syncthreads();
    if (skip == 2) return;
    {
        const int q = lane & 15, kq = lane >> 4;
        const size_t tokq = (size_t)b * SEQ + t0 + q;
        h16x8 qf[8], ql; float sg[8]; float P = 0.f, N = 0.f; float lin[8];
#pragma unroll
        for (int e = 0; e < 8; ++e) lin[e] = 0.f;
#pragma unroll
        for (int hd = 0; hd < 8; ++hd) {
            const h16x8 raw = *(const GAS h16x8*)(idx + tokq * 320 + hd * 32 + 8 * kq);
            const float c = (float)idx[tokq * 320 + 288 + hd] * (0.5f * 0.35355339059327373f), ac = fabsf(c);
            float nn = 0.f;
#pragma unroll
            for (int e = 0; e < 8; ++e) { const float v = (float)raw[e]; nn += v * v; lin[e] += c * v; qf[hd][e] = (h16)(ac * v); }
            nn += __shfl_xor(nn, 16); nn += __shfl_xor(nn, 32);
            const float bd = 2.f * ac * sqrtf(nn) * 12.f;
            if (c > 0.f) P += bd; else N += bd;
            sg[hd] = c >= 0.f ? 1.f : -1.f;
        }
#pragma unroll
        for (int e = 0; e < 8; ++e) ql[e] = (h16)lin[e];
        const float lo = -N, scl = 2097151.f / fmaxf(P + N, 1e-20f);
        const int nblk = T16 + 1, nblk2 = (nblk + 1) & ~1;
#pragma unroll 1
        for (int rpS = 0; rpS < (DUP_PHASE == 7 ? 2 : 1); ++rpS)
        for (int kb0 = wv; kb0 < nblk2; kb0 += 32) {
            h16x8 kf4[4];
#pragma unroll
            for (int u = 0; u < 4; ++u) { const int kb = kb0 + 8 * u < nblk ? kb0 + 8 * u : 0; kf4[u] = *(const GAS h16x8*)(KIF + ((size_t)(b * 128 + kb) * 64 + lane) * 8); }
#pragma unroll
            for (int u = 0; u < 4; ++u) {
                const int kb = kb0 + 8 * u;
                if (kb < nblk2) {
                    const h16x8 kf = kf4[u];
                    f32x4v sc = mfma16(kf, ql, (f32x4v){0.f, 0.f, 0.f, 0.f});
#pragma unroll
                    for (int hd = 0; hd < 8; ++hd) { const f32x4v x = mfma16(kf, qf[hd], (f32x4v){0.f, 0.f, 0.f, 0.f});
#pragma unroll
                        for (int r = 0; r < 4; ++r) sc[r] = __builtin_fmaf(__builtin_fabsf(x[r]), sg[hd], sc[r]); }
                    u32x4v kv;
#pragma unroll
                    for (int r = 0; r < 4; ++r) { const float x = fminf(fmaxf((sc[r] - lo) * scl, 0.f), 2097151.f); unsigned uu = (unsigned)x + 1u;
                        if (16 * kb + 4 * kq + r > t0 + q) uu = 0u; kv[r] = uu; }
                    const int k = 16 * kb + 4 * kq;
                    *(LAS u32x4v*)(keys + q * TK_KSTRIDE + k + 4 * (k >> 5)) = kv;
                }
            }
        }
    }
    __syncthreads();
    if (skip == 1) return;
    const int nw32 = (t0 + 16 + 31) >> 5;
    unsigned ka[32], kc[32];
    {
        const lu32* ra = keys + (2 * wv) * TK_KSTRIDE + 36 * lane, * rc = keys + (2 * wv + 1) * TK_KSTRIDE + 36 * lane;
        const bool have = lane < nw32;
#pragma unroll
        for (int i = 0; i < 8; ++i) {
            u32x4v va = {0u, 0u, 0u, 0u}, vc = {0u, 0u, 0u, 0u};
            if (have) { va = *(const LAS u32x4v*)(ra + 4 * i); vc = *(const LAS u32x4v*)(rc + 4 * i); }
#pragma unroll
            for (int r = 0; r < 4; ++r) { ka[4 * i + r] = va[r]; kc[4 * i + r] = vc[r]; }
        }
    }
    typedef unsigned short u16x2 __attribute__((ext_vector_type(2)));
    u16x2 kha[16], khc[16];
#pragma unroll
    for (int i = 0; i < 16; ++i) { kha[i] = (u16x2){(unsigned short)(ka[2 * i] >> 7), (unsigned short)(ka[2 * i + 1] >> 7)}; khc[i] = (u16x2){(unsigned short)(kc[2 * i] >> 7), (unsigned short)(kc[2 * i + 1] >> 7)}; }
    auto wave_sum2 = [&](unsigned v) -> unsigned {
        v += (unsigned)__builtin_amdgcn_update_dpp(0, (int)v, 0x111, 0xf, 0xf, false);
        v += (unsigned)__builtin_amdgcn_update_dpp(0, (int)v, 0x112, 0xf, 0xf, false);
        v += (unsigned)__builtin_amdgcn_update_dpp(0, (int)v, 0x114, 0xf, 0xf, false);
        v += (unsigned)__builtin_amdgcn_update_dpp(0, (int)v, 0x118, 0xf, 0xf, false);
        v += (unsigned)__builtin_amdgcn_update_dpp(0, (int)v, 0x142, 0xa, 0xf, false);
        v += (unsigned)__builtin_amdgcn_update_dpp(0, (int)v, 0x143, 0xc, 0xf, false);
        return (unsigned)__builtin_amdgcn_readlane((int)v, 63);
    };
    auto count2 = [&](unsigned Pa, unsigned Pc) -> unsigned {
        const unsigned short pa1 = (unsigned short)(Pa - 1u), pc1 = (unsigned short)(Pc - 1u);
        u16x2 aa = {0, 0}, ac = {0, 0};
#pragma unroll
        for (int i = 0; i < 16; ++i) { aa += ((u16x2){pa1, pa1} - kha[i]) >> 15; ac += ((u16x2){pc1, pc1} - khc[i]) >> 15; }
        return wave_sum2(((unsigned)aa[0] + (unsigned)aa[1]) | (((unsigned)ac[0] + (unsigned)ac[1]) << 16));
    };
    unsigned T15a = 0u, T15c = 0u;
#pragma unroll 1
    for (int bit = 14; bit >= 0; --bit) { const unsigned Pa = T15a | (1u << bit), Pc = T15c | (1u << bit); const unsigned c = count2(Pa, Pc);
        if ((c & 0xffffu) >= 256u) T15a = Pa;
        if ((c >> 16) >= 256u) T15c = Pc; }
    const unsigned cab = count2(T15a + 1u, T15c + 1u);
    unsigned Tq[2];
#pragma unroll
    for (int qq = 0; qq < 2; ++qq) {
        const unsigned T15 = qq ? T15c : T15a; const int above = (int)(qq ? (cab >> 16) : (cab & 0xffffu));
        unsigned c0 = 0u, c1 = 0u, nc = 0u;
#pragma unroll
        for (int i = 0; i < 32; ++i) { const unsigned k = qq ? kc[i] : ka[i]; const bool is = (k >> 7) == T15 && k != 0u; const unsigned v = (k & 127u) + 1u;
            c1 = (is && nc == 1u) ? v : c1; c0 = (is && nc == 0u) ? v : c0; nc += is ? 1u : 0u; }
        unsigned low = 0u;
        if (__ballot(nc > 2u) == 0ull) {
#pragma unroll 1
            for (int bit = 6; bit >= 0; --bit) { const unsigned P = low | (1u << bit);
                const unsigned lc = (c0 > P ? 1u : 0u) + (c1 > P ? 1u : 0u);
                const int c = above + __builtin_popcountll(__ballot(lc & 1u)) + 2 * __builtin_popcountll(__ballot(lc >> 1));
                if (c >= 256) low = P; }
        } else {
#pragma unroll 1
            for (int bit = 6; bit >= 0; --bit) { const unsigned P = (T15 << 7) | low | (1u << bit);
                unsigned lc = 0u;
#pragma unroll
                for (int i = 0; i < 32; ++i) lc += ((qq ? kc[i] : ka[i]) >= P) ? 1u : 0u;
                int c = 0;
#pragma unroll
                for (int bp = 0; bp < 6; ++bp) c += __builtin_popcountll(__ballot((lc >> bp) & 1u)) << bp;
                if (c >= 256) low |= (1u << bit); }
        }
        Tq[qq] = (T15 << 7) | low;
    }
    const unsigned Ta = Tq[0], Tc = Tq[1];
#pragma unroll
    for (int qq = 0; qq < 2; ++qq) {
        const unsigned T = qq ? Tc : Ta;
        unsigned gt = 0u, eq = 0u;
#pragma unroll
        for (int i = 31; i >= 0; --i) { const unsigned k = qq ? kc[i] : ka[i]; gt = (gt << 1) | (k > T ? 1u : 0u); eq = (eq << 1) | (k == T ? 1u : 0u); }
        const unsigned pcg = (unsigned)__builtin_popcount(gt), pce = (unsigned)__builtin_popcount(eq);
        int totg = 0, before = 0;
#pragma unroll
        for (int bp = 0; bp < 6; ++bp) {
            totg += __builtin_popcountll(__ballot((pcg >> bp) & 1u)) << bp;
            const unsigned long long mk = __ballot((pce >> bp) & 1u);
            before += (int)__builtin_amdgcn_mbcnt_hi((unsigned)(mk >> 32), __builtin_amdgcn_mbcnt_lo((unsigned)mk, 0u)) << bp;
        }
        const int R = 256 - totg;
        int allow = R - before; allow = allow < 0 ? 0 : (allow > pce ? pce : allow);
        unsigned keep = eq;
        if (allow < pce) { keep = 0u; unsigned e = eq; for (int c = 0; c < allow; ++c) { const unsigned bit = e & (0u - e); keep |= bit; e ^= bit; } }
        if (lane < nw32) mask[((size_t)b * SEQ + t0 + 2 * wv + qq) * 64 + lane] = gt | keep;
    }
}
DEVI void ph_topk(const gh16* idx, const gh16* KIF, gu32* mask, gu32* ctr, lu8* lds, int nrep) {
    lu32* slot = (lu32*)(lds + TK_MISC);
    const bool lead = otid() == 0;
    __syncthreads();
    if (lead) *slot = __hip_atomic_fetch_add(ctr, 1u, __ATOMIC_RELAXED, __HIP_MEMORY_SCOPE_AGENT);
    __syncthreads();
    int e = (int)*slot;
#pragma unroll 1
    while (e < 1024 * nrep) {
        unsigned nxt = 0u;
        if (lead) nxt = __hip_atomic_fetch_add(ctr, 1u, __ATOMIC_RELAXED, __HIP_MEMORY_SCOPE_AGENT);
        const int e2 = e & 1023;
        topk_item(e2 & 7, 127 - (e2 >> 3), idx, KIF, mask, lds, (DUP_PHASE >= 30 && e >= 1024) ? DUP_PHASE - 29 : 0);
        __syncthreads();
        if (lead) *slot = nxt;
        __syncthreads();
        e = (int)*slot;
    }
}

DEVI void ph_out(const gh16* mix, const gh16* WoT, const gf32* __restrict__ gpost, const gf32* h_in, gf32* h_out, gh16* h16o, gf32* rstd_next, bool write_next, lu8* lds) {
    const int tid = otid(), lane = tid & 63, q = lane & 31, h = lane >> 5, wv = __builtin_amdgcn_readfirstlane(tid >> 6);
    lf32* red = (lf32*)lds;
    for (int u = blockIdx.x; u < NT / 64; u += gridDim.x) {
        f32x16 acc[4][2];
#pragma unroll
        for (int rb = 0; rb < 4; ++rb) { acc[rb][0] = (f32x16){}; acc[rb][1] = (f32x16){}; }
        const gh16* apu = WoT + (size_t)(wv * 4) * 64 * 512;
        const gh16* bpu = mix + (size_t)(u * 2) * 64 * 512;
        const unsigned lo8 = lane * 8;
#define ap(off) (apu + (off) + lo8)
#define bp(off) (bpu + (off) + lo8)
        h16x8 a0[4], b0[2], a1[4], b1[2], a2[4], b2[2];
#define P3_LOAD(A, B, ks_) do { const int ko_ = ((ks_) < 64 ? (ks_) : 63) * 512; _Pragma("unroll") for (int rb = 0; rb < 4; ++rb) A[rb] = *(const GAS h16x8*)(ap(rb * 64 * 512 + ko_)); \
        _Pragma("unroll") for (int tb = 0; tb < 2; ++tb) B[tb] = *(const GAS h16x8*)(bp(tb * 64 * 512 + ko_)); } while (0)
#define P3_MMA(A, B) do { _Pragma("unroll") for (int rb = 0; rb < 4; ++rb) _Pragma("unroll") for (int tb = 0; tb < 2; ++tb) acc[rb][tb] = mfma32(A[rb], B[tb], acc[rb][tb]); } while (0)
        P3_LOAD(a0, b0, 0); P3_LOAD(a1, b1, 1);
#pragma unroll 1
        for (int ks = 0; ks < 63; ks += 3) {
            P3_LOAD(a2, b2, ks + 2); __builtin_amdgcn_sched_barrier(0); P3_MMA(a0, b0); __builtin_amdgcn_sched_barrier(0);
            P3_LOAD(a0, b0, ks + 3); __builtin_amdgcn_sched_barrier(0); P3_MMA(a1, b1); __builtin_amdgcn_sched_barrier(0);
            P3_LOAD(a1, b1, ks + 4); __builtin_amdgcn_sched_barrier(0); P3_MMA(a2, b2); __builtin_amdgcn_sched_barrier(0);
        }
        P3_MMA(a0, b0);
#undef P3_LOAD
#undef P3_MMA
#undef ap
#undef bp
        int qe = q, he = h; asm volatile("" : "+v"(qe), "+v"(he));
        __syncthreads();
#pragma unroll
        for (int tb = 0; tb < 2; ++tb) {
            float ss = 0.f;
#pragma unroll
            for (int rb = 0; rb < 4; ++rb)
#pragma unroll
                for (int r = 0; r < 16; ++r) ss += acc[rb][tb][r] * acc[rb][tb][r];
            ss = xh_sum(ss);
            if (he == 0) red[wv * 64 + tb * 32 + qe] = ss;
        }
        __syncthreads();
        float ssn[2] = {0.f, 0.f};
#pragma unroll
        for (int tb = 0; tb < 2; ++tb) {
            float tot = 0.f;
#pragma unroll
            for (int w2 = 0; w2 < 8; ++w2) tot += red[w2 * 64 + tb * 32 + qe];
            const float rs = rsqrtf(tot * (1.f / DM) + EPS);
            const size_t rowoff = (size_t)(u * 64 + tb * 32 + qe) * DM;
#pragma unroll
            for (int rb = 0; rb < 4; ++rb)
#pragma unroll
                for (int g = 0; g < 4; ++g) {
                    const int n = wv * 128 + rb * 32 + 8 * g + 4 * he;
                    const f32x4_t hv = *(const GAS f32x4_t*)(h_in + rowoff + n), gv = *(const GAS f32x4_t*)(gpost + n);
                    f32x4_t o;
                    o[0] = hv[0] + acc[rb][tb][4 * g + 0] * rs * gv[0]; o[1] = hv[1] + acc[rb][tb][4 * g + 1] * rs * gv[1];
                    o[2] = hv[2] + acc[rb][tb][4 * g + 2] * rs * gv[2]; o[3] = hv[3] + acc[rb][tb][4 * g + 3] * rs * gv[3];
                    *(GAS f32x4_t*)(h_out + rowoff + n) = o;
                    if (write_next) { h16x4 oh; oh[0] = (h16)o[0]; oh[1] = (h16)o[1]; oh[2] = (h16)o[2]; oh[3] = (h16)o[3]; *(GAS h16x4*)(h16o + rowoff + n) = oh;
                        ssn[tb] += o[0] * o[0] + o[1] * o[1] + o[2] * o[2] + o[3] * o[3]; }
                }
        }
        if (write_next) {
#pragma unroll
            for (int tb = 0; tb < 2; ++tb) { const float v = xh_sum(ssn[tb]); if (he == 0) red[512 + wv * 64 + tb * 32 + qe] = v; }
            __syncthreads();
            if (tid < 64) { float tot = 0.f;
#pragma unroll
                for (int w2 = 0; w2 < 8; ++w2) tot += red[512 + w2 * 64 + tid];
                rstd_next[u * 64 + tid] = rsqrtf(tot * (1.f / DM) + EPS); }
        }
    }
}

DEVI void mla_item(int it, const gh16* cA, const gh16* WuqT, const gh16* WukvT, const gf32* cosT, const gf32* sinT, gh16* qA, gh16* KFA, gh16* KRF, gh16* VFA) {
    const int lane = otid() & 63, q = lane & 31, h = lane >> 5;
    const size_t tok = (size_t)it * 32 + q; const int b = it >> 6, j = it & 63, s = j * 32 + q;
    const float qs = 0.10206207261596577f * LOG2E;
    {
        h16x8 cf[12]; float ss = 0.f;
#pragma unroll
        for (int ks = 0; ks < 12; ++ks) { cf[ks] = *(const GAS h16x8*)(cA + tok * 384 + ks * 16 + 8 * h);
#pragma unroll
            for (int e = 0; e < 8; ++e) { const float v = (float)cf[ks][e]; ss += v * v; } }
        const float rs = rsqrtf(xh_sum(ss) * (1.f / 192.f) + EPS) * qs;
#pragma unroll 1
        for (int nb = 0; nb < 12; ++nb) {
            f32x16 acc = {};
            const gh16* wp = WuqT + (size_t)nb * 12 * 512 + lane * 8;
#pragma unroll
            for (int ks = 0; ks < 12; ++ks) acc = mfma32(*(const GAS h16x8*)(wp + ks * 512), cf[ks], acc);
            acc *= rs;
            const int hh = nb / 3, part = nb % 3;
            if (part == 2) {
#pragma unroll
                for (int r = 0; r < 8; ++r) { const int i = CROW(r) + 4 * h; const float c = cosT[s * 16 + i], sn = sinT[s * 16 + i], x1 = acc[r], x2 = acc[r + 8];
                    acc[r] = x1 * c - x2 * sn; acc[r + 8] = x1 * sn + x2 * c; }
            }
            gh16* op = qA + tok * 384 + hh * 96 + part * 32 + 4 * h;
#pragma unroll
            for (int g = 0; g < 4; ++g) { h16x4 o; o[0] = (h16)acc[4 * g]; o[1] = (h16)acc[4 * g + 1]; o[2] = (h16)acc[4 * g + 2]; o[3] = (h16)acc[4 * g + 3]; *(GAS h16x4*)(op + 8 * g) = o; }
        }
    }
    {
        h16x8 cf[8]; float ss = 0.f;
#pragma unroll
        for (int ks = 0; ks < 8; ++ks) { cf[ks] = *(const GAS h16x8*)(cA + tok * 384 + 192 + ks * 16 + 8 * h);
#pragma unroll
            for (int e = 0; e < 8; ++e) { const float v = (float)cf[ks][e]; ss += v * v; } }
        const float rs = rsqrtf(xh_sum(ss) * (1.f / 128.f) + EPS);
#pragma unroll
        for (int ks = 0; ks < 8; ++ks)
#pragma unroll
            for (int e = 0; e < 8; ++e) cf[ks][e] = (h16)((float)cf[ks][e] * rs);
#pragma unroll 1
        for (int nb = 0; nb < 16; ++nb) {
            const int hh = nb >> 2, sub = nb & 3, bh = b * 4 + hh;
            const gh16* wp = WukvT + (size_t)nb * 8 * 512 + lane * 8;
            f32x16 acc = {};
            if (sub < 2) {
#pragma unroll
                for (int ks = 0; ks < 8; ++ks) acc = mfma32(*(const GAS h16x8*)(wp + ks * 512), cf[ks], acc);
#pragma unroll
                for (int g = 0; g < 4; ++g) { h16x4 o; o[0] = (h16)acc[4 * g]; o[1] = (h16)acc[4 * g + 1]; o[2] = (h16)acc[4 * g + 2]; o[3] = (h16)acc[4 * g + 3];
                    *(GAS h16x4*)(KFA + ((((size_t)bh * 64 + j) * 4 + 2 * sub + (g >> 1)) * 64 + q + 32 * (g & 1)) * 8 + 4 * h) = o; }
            } else {
#pragma unroll
                for (int ks = 0; ks < 8; ++ks) acc = mfma32(cf[ks], *(const GAS h16x8*)(wp + ks * 512), acc);
#pragma unroll
                for (int sk = 0; sk < 2; ++sk) { h16x8 o;
#pragma unroll
                    for (int e = 0; e < 8; ++e) o[e] = (h16)acc[8 * sk + e];
                    *(GAS h16x8*)(VFA + ((((size_t)bh * 64 + j) * 4 + (sub - 2) * 2 + sk) * 64 + lane) * 8) = o; }
            }
        }
    }
    {
        const h16x8 a = *(const GAS h16x8*)(cA + tok * 384 + 320 + 8 * h), c2 = *(const GAS h16x8*)(cA + tok * 384 + 336 + 8 * h);
        h16x8 o1, o2;
#pragma unroll
        for (int e = 0; e < 8; ++e) { const int i = 8 * h + e; const float c = cosT[s * 16 + i], sn = sinT[s * 16 + i], x1 = (float)a[e], x2 = (float)c2[e];
            o1[e] = (h16)(x1 * c - x2 * sn); o2[e] = (h16)(x1 * sn + x2 * c); }
        *(GAS h16x8*)(KRF + (((size_t)b * 64 + j) * 2 + 0) * 512 + lane * 8) = o1; *(GAS h16x8*)(KRF + (((size_t)b * 64 + j) * 2 + 1) * 512 + lane * 8) = o2;
    }
}
DEVI void ph_small_weights(const gf32* w_uq, const gf32* qn, const gf32* w_ukv, const gf32* kvn, gh16* WuqF, gh16* WukvF) {
    const int gt = blockIdx.x * NTHR + otid(), nthr = gridDim.x * NTHR;
    for (int i = gt; i < 2 * 12 * 12 * 64; i += nthr) { const int lane = i & 63, ks = (i >> 6) % 12, nb = (i / (64 * 12)) % 12, l = i / (64 * 144);
        h16x8 o;
#pragma unroll
        for (int e = 0; e < 8; ++e) { const int k = 16 * ks + 8 * (lane >> 5) + e; o[e] = (h16)(w_uq[(size_t)l * 192 * 384 + k * 384 + nb * 32 + (lane & 31)] * qn[l * 192 + k]); }
        *(GAS h16x8*)(WuqF + (size_t)i * 8) = o; }
    for (int i = gt; i < 2 * 16 * 8 * 64; i += nthr) { const int lane = i & 63, ks = (i >> 6) & 7, nb = (i >> 9) & 15, l = i >> 13;
        h16x8 o;
#pragma unroll
        for (int e = 0; e < 8; ++e) { const int k = 16 * ks + 8 * (lane >> 5) + e; o[e] = (h16)(w_ukv[(size_t)l * 128 * 512 + k * 512 + nb * 32 + (lane & 31)] * kvn[l * 128 + k]); }
        *(GAS h16x8*)(WukvF + (size_t)i * 8) = o; }
}

constexpr int LDS_BYTES = 160 * 1024;
struct Params { const float* in[12]; float* out; unsigned char* ws; };

DEVI void ph_tables(const gf32* __restrict__ rel_bias, gf32* biasTab, gf32* cosT, gf32* sinT) {
    for (int i = blockIdx.x * NTHR + threadIdx.x; i < 2048 * 16; i += gridDim.x * NTHR) {
        if (i < 12 * 2048) { int hh = i / 2048, n = i % 2048; biasTab[i] = rel_bias[t5_bucket(n) * 12 + hh] * LOG2E; }
        int pos = i / 16, j = i % 16;
        float inv = (float)pow(10000.0, -(double)(2 * j) / 32.0);
        float ang = (float)pos * inv;
        cosT[i] = (float)cos((double)ang); sinT[i] = (float)sin((double)ang);
    }
}

extern __shared__ __attribute__((aligned(16))) unsigned char smem[];
constexpr int LDS_BAR_OFF = 160 * 1024 - 16;

#define REP(k) for (int rep_ = 0; rep_ < ((DUP_PHASE == (k)) ? 2 : 1); ++rep_)
DEVI gu8* ows(unsigned char* w0) { gu8* w = (gu8*)w0; asm volatile("" : "+s"(w)); return w; }
#define WSP(T, off) ((GAS T*)(w + (off)))
#define GIN(k) ((const gf32*)p.in[k])

__global__ void __launch_bounds__(NTHR, 2) mega(Params p) {
    if (threadIdx.x == 0) *(uint4*)(smem + LDS_BAR_OFF) = make_uint4(0u, 0u, 0u, 0u);
    __syncthreads();
    XcdBarrier bar = xcd_barrier_post((unsigned*)(p.ws + OFF_CTL), (volatile LAS unsigned*)(smem + LDS_BAR_OFF));
    lu8* lds = (lu8*)smem;
    const int nw = gridDim.x * NWAVE;

    REP(1) {
        gu8* w = ows(p.ws);
        ph_tables(GIN(11), WSP(float, OFF_BIAS), WSP(float, OFF_COS), WSP(float, OFF_SIN));
        int base = 0; const int total = 2 * (64 * 16) + 2 * (16 * 16);
        cvt_transpose<true>(GIN(1), INC, GIN(3), WSP(h16, OFF_WINT), MYC, DM, lds, blockIdx.x, total, base);
        cvt_transpose<true>(GIN(1) + (size_t)DM * INC, INC, GIN(3) + DM, WSP(h16, OFF_WINT) + (size_t)MYC * DM, MYC, DM, lds, blockIdx.x, total, base);
        cvt_transpose<false>(GIN(2), DM, nullptr, WSP(h16, OFF_WOUTT), DM, DM, lds, blockIdx.x, total, base);
        cvt_transpose<false>(GIN(2) + (size_t)DM * DM, DM, nullptr, WSP(h16, OFF_WOUTT) + (size_t)DM * DM, DM, DM, lds, blockIdx.x, total, base);
        ph_small_weights(GIN(7), GIN(5), GIN(8), GIN(6), WSP(h16, OFF_WUQT), WSP(h16, OFF_WUKVT));
        ph_rowstat_cvt(GIN(0), WSP(float, OFF_SSQH), WSP(h16, OFF_H16));
    }
    xcd_barrier(bar);
    for (int layer = 0; layer < 2; ++layer) {
        const float lambda_init = layer == 0 ? 0.2f : 0.35550906759f;
        REP(2) {
            if (rep_) xcd_barrier(bar);
            gu8* w = ows(p.ws);
            pg8::Gemm g{(const pg8::bf16_t*)(p.ws + OFF_H16), (const pg8::bf16_t*)(p.ws + OFF_WINT) + (size_t)layer * MYC * DM, NT, MYC, DM};
            int bid_ = (int)blockIdx.x; asm volatile("" : "+s"(bid_));
            pg8::StaticOrder S; S.init(NT, MYC, (int)gridDim.x, bid_);
            EpiRoute E{w, WSP(float, OFF_SSQH)};
            pg8::gemm_phase<EpiRoute, pg8::StaticOrder, true, true>(lds, g, S, E);
        }
        xcd_barrier(bar);
        REP(3) {
            gu8* w = ows(p.ws);
            for (int it = ogw(); it < NT / 32; it += nw) mla_item(it, WSP(h16, OFF_CA), WSP(h16, OFF_WUQT) + (size_t)layer * 384 * 192, WSP(h16, OFF_WUKVT) + (size_t)layer * 512 * 128, WSP(float, OFF_COS), WSP(float, OFF_SIN), WSP(h16, OFF_QA), WSP(h16, OFF_KFA), WSP(h16, OFF_KRF), WSP(h16, OFF_VFA));
        }
        {
            gu8* w = ows(p.ws);
            ph_topk(WSP(h16, OFF_IDX), WSP(h16, OFF_KIF), WSP(unsigned, OFF_MASK), WSP(unsigned, OFF_CTL) + 3600 + 16 * (40 + layer), lds, (DUP_PHASE == 4 || DUP_PHASE >= 30) ? 2 : 1);
        }
        REP(3) {
            gu8* w = ows(p.ws);
            ph_vtrans(WSP(h16, OFF_VTMP), WSP(h16, OFF_VF), lds);
        }
        xcd_barrier(bar);
        for (int rep_ = 0; rep_ < ((DUP_PHASE == 5 || DUP_PHASE >= 10) ? 2 : 1); ++rep_) {
            if (rep_) xcd_barrier(bar);
            const int hot_ = (DUP_PHASE >= 10 && rep_) ? DUP_PHASE - 9 : 0;
            gu8* w = ows(p.ws);
            p2_setup(WSP(float, OFF_BIAS), GIN(9) + layer * 128, lambda_init, lds);
            if (DUP_PHASE >= 20 && rep_) { probe_item(130, DUP_PHASE - 20); continue; }
            const int xcc = (int)(xb_xcc_id() & 7u);
            for (int dq = 0; dq < 8; ++dq) {
                const int bq = (xcc + dq) & 7;
                gu32* ctr = WSP(unsigned, OFF_CTL) + 3600 + 16 * (bq + 8 * layer + 16 * rep_);
                for (;;) { const int e = wq_next(ctr); if (e >= 768) break;
                    if (e >= 512) { const int e2 = e - 512, hh = e2 >> 6, lvl = e2 & 63;
                        flashB_item(bq, hh, lvl & 15, lvl >> 4, WSP(h16, OFF_QB), WSP(h16, OFF_KFB), WSP(h16, OFF_VF), lds, WSP(h16, OFF_GATE), WSP(h16, OFF_MIX), hot_); }
                    else if (e >= 384) { const int e2 = e - 384, hh = e2 >> 5, pr = 31 - (e2 & 31);
                        flashQ2_item<0>(bq, hh, pr, WSP(h16, OFF_QA), WSP(h16, OFF_KFA), WSP(h16, OFF_KRF), WSP(h16, OFF_VFA), nullptr, WSP(float, OFF_BIAS), lds, WSP(h16, OFF_GATE), WSP(h16, OFF_MIX), 0, 0, hot_); }
                    else if (e >= 256) { const int e2 = e - 256, hh = e2 >> 5, pr = 31 - (e2 & 31);
                        flashQ2_item<1>(bq, hh, pr, WSP(h16, OFF_QC), WSP(h16, OFF_KFC), nullptr, WSP(h16, OFF_VF) + 3 * FSZ, WSP(unsigned, OFF_MASK), WSP(float, OFF_BIAS), lds, WSP(h16, OFF_GATE), WSP(h16, OFF_MIX), 512, 4 + hh, hot_); }
                    else { const int hh = e >> 6, lvl = 63 - (e & 63);
                        flashCD_item<2, false>(bq, hh, lvl, 8 + hh, WSP(h16, OFF_QD), WSP(h16, OFF_KFD), WSP(h16, OFF_VF) + 4 * FSZ, nullptr, WSP(float, OFF_BIAS), lds,
                                               GIN(10) + layer * 64, lambda_init, WSP(h16, OFF_GATE), WSP(h16, OFF_MIX), 768, hot_); }
                }
            }
        }
        xcd_barrier(bar);
        for (int rep_ = 0; rep_ < ((DUP_PHASE == 6 && layer == 0) ? 2 : 1); ++rep_) {
            if (rep_) xcd_barrier(bar);
            gu8* w = ows(p.ws);
int bid_ = (int)blockIdx.x; asm volatile("" : "+s"(bid_));
            pg8::Gemm g{(const pg8::bf16_t*)(p.ws + OFF_MIX), (const pg8::bf16_t*)(p.ws + OFF_WOUTT) + (size_t)layer * DM * DM, NT, DM, DM};
            pg8::StaticOrder S; S.init(NT, DM, (int)gridDim.x, bid_);
            EpiOut E{layer == 0 ? GIN(0) : (const gf32*)p.out, (gf32*)p.out, WSP(h16, OFF_H16), GIN(4) + layer * DM, WSP(float, OFF_SSQY), WSP(float, OFF_SSQH), &bar, layer == 0};
            pg8::gemm_phase<EpiOut, pg8::StaticOrder, false, true>(lds, g, S, E);
        }
        xcd_barrier(bar);
    }
}

extern "C" void kernel_launch(void* const* d_in, const int* in_sizes, int n_in, void* d_out, int out_size, void* d_ws, size_t ws_size, hipStream_t stream) {
    static int grid = 0;
    if (grid == 0) {
        int dev = 0, cus = 0, per_cu = 0;
        (void)hipGetDevice(&dev);
        (void)hipDeviceGetAttribute(&cus, hipDeviceAttributeMultiprocessorCount, dev);
        (void)hipFuncSetAttribute((const void*)mega, hipFuncAttributeMaxDynamicSharedMemorySize, LDS_BYTES);
        (void)hipOccupancyMaxActiveBlocksPerMultiprocessor(&per_cu, (const void*)mega, NTHR, LDS_BYTES);
        (void)hipGetLastError();
        grid = (cus > 0 && cus < 256) ? cus : 256;
    }
    (void)hipMemsetAsync((char*)d_ws + OFF_CTL, 0, 32768, stream);
    Params p{};
    for (int i = 0; i < 12; ++i) p.in[i] = (const float*)d_in[i];
    p.out = (float*)d_out; p.ws = (unsigned char*)d_ws;
    hipLaunchKernelGGL(mega, dim3(grid), dim3(NTHR), LDS_BYTES, stream, p);
}
```

```cpp
#include <hip/hip_runtime.h>
#include <stdint.h>
#include <math.h>

#ifndef DUP_PHASE
#define DUP_PHASE 0
#endif
typedef _Float16 h16;
#define GAS __attribute__((address_space(1)))
#define LAS __attribute__((address_space(3)))
typedef GAS h16 gh16; typedef GAS float gf32; typedef GAS unsigned gu32; typedef GAS unsigned char gu8;
typedef LAS h16 lh16; typedef LAS float lf32; typedef LAS unsigned lu32; typedef LAS unsigned char lu8;
#define DEVI __device__ __forceinline__
DEVI int ogw();
DEVI int otid() { int t = threadIdx.x; asm volatile("" : "+v"(t)); return t; }

constexpr int NB = 8, SEQ = 2048, DM = 1024, NT = NB * SEQ, INC = 3976, MYC = 4096;
constexpr float LOG2E = 1.4426950408889634f;
constexpr float EPS = 1e-6f;

DEVI int ogw() { return blockIdx.x * 8 + (otid() >> 6); }
__host__ __device__ constexpr int ref_col(int my) {
    if (my < 352) return my;
    if (my < 384) return -1;
    if (my < 640) return 352 + (my - 384);
    if (my < 896) return 1376 + (my - 640);
    if (my < 1152) return 2696 + (my - 896);
    if (my < 1408) return 3720 + (my - 1152);
    if (my < 1664) return 608 + (my - 1408);
    if (my < 1920) return 864 + (my - 1664);
    if (my < 2176) return 1632 + (my - 1920);
    if (my < 2432) return 1888 + (my - 2176);
    if (my < 2688) return 2952 + (my - 2432);
    if (my < 2944) return 3208 + (my - 2688);
    if (my < 3200) return 1120 + (my - 2944);
    if (my < 3456) return 2144 + (my - 3200);
    if (my < 3712) return 3464 + (my - 3456);
    if (my < 3968) return 2400 + (my - 3712);
    if (my < 4000) return 2656 + (my - 3968);
    if (my < 4008) return 2688 + (my - 4000);
    return -1;
}

constexpr size_t MiB = 1024 * 1024;
constexpr size_t OFF_CTL = 0;
constexpr size_t OFF_RSTD = 64 * 1024;
constexpr size_t OFF_BIAS = 128 * 1024;
constexpr size_t OFF_COS = 256 * 1024;
constexpr size_t OFF_SIN = 384 * 1024;
constexpr size_t OFF_SSQY = 512 * 1024;
constexpr size_t OFF_SSQH = 768 * 1024;
constexpr size_t OFF_CA = 1 * MiB;
constexpr size_t OFF_GATE = OFF_CA + 12 * MiB;
constexpr size_t OFF_QB = OFF_GATE + 32 * MiB;
constexpr size_t OFF_QC = OFF_QB + 8 * MiB;
constexpr size_t OFF_QD = OFF_QC + 8 * MiB;
constexpr size_t OFF_KFB = OFF_QD + 8 * MiB;
constexpr size_t OFF_KFC = OFF_KFB + 24 * MiB;
constexpr size_t OFF_KFD = OFF_KFC + 8 * MiB;
constexpr size_t OFF_IDX = OFF_KFD + 8 * MiB;
constexpr size_t OFF_KIF = OFF_IDX + 10 * MiB;
constexpr size_t OFF_MIX = OFF_KIF + 1 * MiB;
constexpr size_t OFF_VTMP = OFF_MIX;
constexpr size_t OFF_MASK = OFF_MIX + 32 * MiB;
constexpr size_t OFF_H16 = OFF_MASK + 4 * MiB;
constexpr size_t OUT_QA = 0;
constexpr size_t OUT_KFA = OUT_QA + 12 * MiB;
constexpr size_t OUT_KRF = OUT_KFA + 8 * MiB;
constexpr size_t OUT_VFA = OUT_KRF + 1 * MiB;
constexpr size_t OFF_WINT = OFF_H16 + 32 * MiB;
constexpr size_t OFF_WOUTT = OFF_WINT + 16 * MiB;
constexpr size_t OFF_WUQT = OFF_WOUTT + 4 * MiB;
constexpr size_t OFF_WUKVT = OFF_WUQT + 512 * 1024;
constexpr size_t OFF_VF = OFF_WUKVT + 512 * 1024;
constexpr size_t OFF_END = OFF_VF + 40 * MiB;
static_assert(OFF_END <= 256 * MiB, "ws map");

struct Route { int kind; size_t off; int dcol; int pitch; float scale; int silu; };
__host__ __device__ inline Route route(int my) {
    Route r{-1, 0, 0, 0, 1.f, 0};
    if (my < 384) { r.kind = 0; r.off = OFF_CA; r.dcol = my; r.pitch = 384; }
    else if (my < 1408) { r.kind = 0; r.off = OFF_GATE; r.dcol = my - 384; r.pitch = 1024; r.silu = 1; }
    else if (my < 1664) { r.kind = 0; r.off = OFF_QB; r.dcol = my - 1408; r.pitch = 256; r.scale = 0.125f * LOG2E; }
    else if (my < 1920) { r.kind = 2; r.off = OFF_KFB; r.dcol = my - 1664; }
    else if (my < 2176) { r.kind = 0; r.off = OFF_QC; r.dcol = my - 1920; r.pitch = 256; r.scale = 0.125f * LOG2E; }
    else if (my < 2432) { r.kind = 1; r.off = OFF_KFC; r.dcol = my - 2176; }
    else if (my < 2688) { r.kind = 0; r.off = OFF_QD; r.dcol = my - 2432; r.pitch = 256; r.scale = 0.17677669529663687f * LOG2E; }
    else if (my < 2944) { r.kind = 1; r.off = OFF_KFD; r.dcol = my - 2688; }
    else if (my < 3712) { r.kind = 0; r.off = OFF_VTMP; r.dcol = my - 2944; r.pitch = 768; }
    else if (my < 3968) { r.kind = 0; r.off = OFF_IDX; r.dcol = my - 3712; r.pitch = 320; r.scale = 0.17677669529663687f; }
    else if (my < 4000) { r.kind = 3; r.off = OFF_KIF; r.dcol = my - 3968; }
    else if (my < 4032) { r.kind = 0; r.off = OFF_IDX; r.dcol = my - 3712; r.pitch = 320; }
    return r;
}
DEVI size_t kf_off(int bh, int s, int d0) { return ((((size_t)bh * 64 + (s >> 5)) * 4 + (d0 >> 4)) * 64 + (s & 31) + 32 * ((d0 >> 3) & 1)) * 8; }
DEVI size_t kf4_off(int bh, int s, int d0) { const int pp = s >> 2, r4 = s & 3; return (((((size_t)bh * 4 + r4) * 16 + (pp >> 5)) * 4 + (d0 >> 4)) * 64 + (pp & 31) + 32 * ((d0 >> 3) & 1)) * 8; }
DEVI size_t kf16_off(int bh, int s, int d0) { const int pp = s >> 4, r = s & 15; return (((((size_t)bh * 16 + r) * 4 + (pp >> 5)) * 4 + (d0 >> 4)) * 64 + (pp & 31) + 32 * ((d0 >> 3) & 1)) * 8; }
DEVI size_t mixf_off(size_t tok, int c0) { return tok * 1024 + (size_t)c0; }
constexpr size_t FSZ = (size_t)32 * 64 * 4 * 64 * 8;

__device__ __constant__ unsigned short kP2Order[1024] = {63, 127, 191, 255, 62, 126, 190, 254, 61, 125, 189, 253, 60, 124, 188, 252, 59, 123, 187, 251, 58, 122, 186, 250, 57, 121, 185, 249, 56, 120, 184, 248, 55, 119, 183, 247, 54, 118, 182, 246, 53, 117, 181, 245, 52, 116, 180, 244, 51, 115, 179, 243, 50, 114, 178, 242, 49, 113, 177, 241, 48, 112, 176, 240, 47, 111, 175, 239, 46, 110, 174, 238, 45, 109, 173, 237, 44, 108, 172, 236, 43, 107, 171, 235, 42, 106, 170, 234, 41, 105, 169, 233, 40, 104, 168, 232, 39, 103, 167, 231, 319, 383, 447, 511, 318, 382, 446, 510, 38, 102, 166, 230, 317, 381, 445, 509, 316, 380, 444, 508, 37, 101, 165, 229, 315, 379, 443, 507, 36, 100, 164, 228, 314, 378, 442, 506, 313, 377, 441, 505, 35, 99, 163, 227, 312, 376, 440, 504, 34, 98, 162, 226, 311, 375, 439, 503, 310, 374, 438, 502, 33, 97, 161, 225, 309, 373, 437, 501, 308, 372, 436, 500, 32, 96, 160, 224, 307, 371, 435, 499, 31, 95, 159, 223, 306, 370, 434, 498, 305, 369, 433, 497, 30, 94, 158, 222, 304, 368, 432, 496, 29, 93, 157, 221, 303, 367, 431, 495, 302, 366, 430, 494, 28, 92, 156, 220, 301, 365, 429, 493, 300, 364, 428, 492, 27, 91, 155, 219, 299, 363, 427, 491, 26, 90, 154, 218, 298, 362, 426, 490, 575, 639, 703, 767, 297, 361, 425, 489, 574, 638, 702, 766, 25, 89, 153, 217, 573, 637, 701, 765, 296, 360, 424, 488, 572, 636, 700, 764, 24, 88, 152, 216, 295, 359, 423, 487, 571, 635, 699, 763, 570, 634, 698, 762, 294, 358, 422, 486, 569, 633, 697, 761, 23, 87, 151, 215, 293, 357, 421, 485, 568, 632, 696, 760, 567, 631, 695, 759, 292, 356, 420, 484, 22, 86, 150, 214, 566, 630, 694, 758, 291, 355, 419, 483, 565, 629, 693, 757, 564, 628, 692, 756, 21, 85, 149, 213, 290, 354, 418, 482, 563, 627, 691, 755, 289, 353, 417, 481, 562, 626, 690, 754, 20, 84, 148, 212, 561, 625, 689, 753, 288, 352, 416, 480, 560, 624, 688, 752, 19, 83, 147, 211, 287, 351, 415, 479, 559, 623, 687, 751, 558, 622, 686, 750, 286, 350, 414, 478, 557, 621, 685, 749, 18, 82, 146, 210, 285, 349, 413, 477, 556, 620, 684, 748, 555, 619, 683, 747, 284, 348, 412, 476, 17, 81, 145, 209, 554, 618, 682, 746, 283, 347, 411, 475, 553, 617, 681, 745, 552, 616, 680, 744, 16, 80, 144, 208, 282, 346, 410, 474, 551, 615, 679, 743, 281, 345, 409, 473, 550, 614, 678, 742, 15, 79, 143, 207, 549, 613, 677, 741, 280, 344, 408, 472, 548, 612, 676, 740, 14, 78, 142, 206, 279, 343, 407, 471, 547, 611, 675, 739, 546, 610, 674, 738, 278, 342, 406, 470, 545, 609, 673, 737, 13, 77, 141, 205, 277, 341, 405, 469, 544, 608, 672, 736, 543, 607, 671, 735, 276, 340, 404, 468, 12, 76, 140, 204, 542, 606, 670, 734, 275, 339, 403, 467, 541, 605, 669, 733, 768, 769, 770, 771, 772, 773, 774, 775, 776, 777, 778, 779, 780, 781, 782, 783, 784, 785, 786, 787, 788, 789, 790, 791, 792, 793, 794, 795, 796, 797, 798, 799, 800, 801, 802, 803, 804, 805, 806, 807, 808, 809, 810, 811, 812, 813, 814, 815, 816, 817, 818, 819, 820, 821, 822, 823, 824, 825, 826, 827, 828, 829, 830, 831, 832, 833, 834, 835, 836, 837, 838, 839, 840, 841, 842, 843, 844, 845, 846, 847, 848, 849, 850, 851, 852, 853, 854, 855, 856, 857, 858, 859, 860, 861, 862, 863, 864, 865, 866, 867, 868, 869, 870, 871, 872, 873, 874, 875, 876, 877, 878, 879, 880, 881, 882, 883, 884, 885, 886, 887, 888, 889, 890, 891, 892, 893, 894, 895, 896, 897, 898, 899, 900, 901, 902, 903, 904, 905, 906, 907, 908, 909, 910, 911, 912, 913, 914, 915, 916, 917, 918, 919, 920, 921, 922, 923, 924, 925, 926, 927, 928, 929, 930, 931, 932, 933, 934, 935, 936, 937, 938, 939, 940, 941, 942, 943, 944, 945, 946, 947, 948, 949, 950, 951, 952, 953, 954, 955, 956, 957, 958, 959, 960, 961, 962, 963, 964, 965, 966, 967, 968, 969, 970, 971, 972, 973, 974, 975, 976, 977, 978, 979, 980, 981, 982, 983, 984, 985, 986, 987, 988, 989, 990, 991, 992, 993, 994, 995, 996, 997, 998, 999, 1000, 1001, 1002, 1003, 1004, 1005, 1006, 1007, 1008, 1009, 1010, 1011, 1012, 1013, 1014, 1015, 1016, 1017, 1018, 1019, 1020, 1021, 1022, 1023, 540, 604, 668, 732, 11, 75, 139, 203, 274, 338, 402, 466, 539, 603, 667, 731, 273, 337, 401, 465, 538, 602, 666, 730, 10, 74, 138, 202, 537, 601, 665, 729, 272, 336, 400, 464, 536, 600, 664, 728, 9, 73, 137, 201, 271, 335, 399, 463, 535, 599, 663, 727, 534, 598, 662, 726, 270, 334, 398, 462, 533, 597, 661, 725, 8, 72, 136, 200, 269, 333, 397, 461, 532, 596, 660, 724, 531, 595, 659, 723, 268, 332, 396, 460, 7, 71, 135, 199, 530, 594, 658, 722, 267, 331, 395, 459, 529, 593, 657, 721, 528, 592, 656, 720, 6, 70, 134, 198, 266, 330, 394, 458, 527, 591, 655, 719, 265, 329, 393, 457, 526, 590, 654, 718, 5, 69, 133, 197, 525, 589, 653, 717, 264, 328, 392, 456, 524, 588, 652, 716, 4, 68, 132, 196, 263, 327, 391, 455, 523, 587, 651, 715, 522, 586, 650, 714, 262, 326, 390, 454, 521, 585, 649, 713, 3, 67, 131, 195, 261, 325, 389, 453, 520, 584, 648, 712, 519, 583, 647, 711, 260, 324, 388, 452, 2, 66, 130, 194, 518, 582, 646, 710, 259, 323, 387, 451, 517, 581, 645, 709, 516, 580, 644, 708, 1, 65, 129, 193, 258, 322, 386, 450, 515, 579, 643, 707, 257, 321, 385, 449, 514, 578, 642, 706, 0, 64, 128, 192, 513, 577, 641, 705, 256, 320, 384, 448, 512, 576, 640, 704};
__device__ __constant__ unsigned char kWgOrder[96] = {7, 15, 23, 31, 6, 14, 22, 30, 39, 47, 55, 63, 5, 13, 21, 29, 38, 46, 54, 62, 4, 12, 20, 28, 71, 79, 87, 95, 37, 45, 53, 61, 70, 78, 86, 94, 3, 11, 19, 27, 36, 44, 52, 60, 69, 77, 85, 93, 35, 43, 51, 59, 68, 76, 84, 92, 2, 10, 18, 26, 67, 75, 83, 91, 34, 42, 50, 58, 1, 9, 17, 25, 66, 74, 82, 90, 33, 41, 49, 57, 65, 73, 81, 89, 0, 8, 16, 24, 32, 40, 48, 56, 64, 72, 80, 88};
__device__ __constant__ int kBucketStart[16] = {16, 22, 30, 40, 54, 73, 99, 134, 182, 246, 332, 450, 609, 825, 1117, 1513};
DEVI int t5_bucket(int n) {
    if (n < 16) return n;
    int b = 16;
#pragma unroll
    for (int j = 1; j < 16; ++j) b += (n >= kBucketStart[j]) ? 1 : 0;
    return b;
}


#define XB_TMO      128
#define XB_XCNT(j)  (256  + 64 * (j))
#define XB_XSUB(j)  (1280 + 64 * (j))
#define XB_XGEN(j)  (2304 + 64 * (j))
#define XB_TOP      3328
#define XB_TOPGEN   3392
#define XCD_BAR_WORDS 3456
#define XB_SPIN_CAP (1u << 18)
__device__ __forceinline__ unsigned xb_ld(unsigned* p)              { return __hip_atomic_load(p, __ATOMIC_RELAXED, __HIP_MEMORY_SCOPE_AGENT); }
__device__ __forceinline__ unsigned xb_add(unsigned* p, unsigned v) { return __hip_atomic_fetch_add(p, v, __ATOMIC_RELAXED, __HIP_MEMORY_SCOPE_AGENT); }
__device__ __forceinline__ unsigned xb_xcc_id() { return (unsigned)__builtin_amdgcn_s_getreg((3 << 11) | 20) & 0xFu; }
#define XB_SPIN(cond, bar) do { unsigned _sp = 0; while (cond) { __builtin_amdgcn_s_sleep(1); \
    if ((++_sp & 255u) == 0u) { if (xb_ld(&(bar)[XB_TMO])) break; if (_sp > XB_SPIN_CAP) { atomicAdd(&(bar)[XB_TMO], 1u); break; } } } } while (0)
struct XcdBarrier { unsigned* bar; unsigned x; volatile LAS unsigned* st; };
__device__ __forceinline__ XcdBarrier xcd_barrier_post(unsigned* bar, volatile LAS unsigned* st) {
    XcdBarrier b; b.bar = bar; b.x = xb_xcc_id(); b.st = st;
    if (threadIdx.x == 0) (void)xb_add(&bar[XB_XCNT(b.x)], 1u);
    return b;
}
__device__ __forceinline__ void xcd_barrier_complete(unsigned* bar, unsigned x, unsigned& nloc, unsigned& nx) {
    const unsigned G = gridDim.x * gridDim.y * gridDim.z;
    unsigned sum, cnt, mine, sp = 0u;
    for (;;) {
        sum = 0u; cnt = 0u; mine = 0u;
#pragma unroll
        for (unsigned j = 0; j < 16; ++j) { const unsigned c = xb_ld(&bar[XB_XCNT(j)]); sum += c; cnt += (c > 0u) ? 1u : 0u; mine = (j == x) ? c : mine; }
        if (sum == G) break;
        __builtin_amdgcn_s_sleep(1);
        if ((++sp & 255u) == 0u) { if (xb_ld(&bar[XB_TMO])) break; if (sp > XB_SPIN_CAP) { atomicAdd(&bar[XB_TMO], 1u); break; } }
    }
    nloc = mine > 0u ? mine : 1u; nx = cnt > 0u ? cnt : 1u;
}
__device__ __forceinline__ void xcd_barrier(const XcdBarrier& b) {
    asm volatile("s_waitcnt vmcnt(0)" ::: "memory");
    __syncthreads();
    if (otid() == 0) {
        unsigned* bar = b.bar; unsigned bx = b.x; asm volatile("" : "+s"(bx));
        __builtin_amdgcn_s_waitcnt(0);
        unsigned nloc = b.st[0], nx = b.st[1];
        if (nloc == 0u) { xcd_barrier_complete(bar, bx, nloc, nx); b.st[0] = nloc; b.st[1] = nx; }
        const unsigned old = xb_add(&bar[XB_XSUB(bx)], 1u);
        const unsigned gen = old / nloc;
        if (old + 1u == (gen + 1u) * nloc) {
            __builtin_amdgcn_fence(__ATOMIC_RELEASE, "agent");
            asm volatile("s_waitcnt vmcnt(0)" ::: "memory");
            const unsigned og = xb_add(&bar[XB_TOP], 1u);
            const unsigned tg = og / nx;
            if (og + 1u == (tg + 1u) * nx) xb_add(&bar[XB_TOPGEN], 1u);
            else XB_SPIN(xb_ld(&bar[XB_TOPGEN]) == tg, bar);
            __builtin_amdgcn_fence(__ATOMIC_ACQUIRE, "agent");
            xb_add(&bar[XB_XGEN(bx)], 1u);
            asm volatile("s_waitcnt vmcnt(0)" ::: "memory");
        } else {
            XB_SPIN(xb_ld(&bar[XB_XGEN(bx)]) == gen, bar);
            __builtin_amdgcn_fence(__ATOMIC_ACQUIRE, "agent");
            asm volatile("s_waitcnt vmcnt(0)" ::: "memory");
        }
    }
    __syncthreads();
}

namespace pg8 {
#define PG8_LAS __attribute__((address_space(3)))
typedef unsigned short bf16_t;
typedef _Float16 f16x8 __attribute__((ext_vector_type(8)));
typedef float f32x4 __attribute__((ext_vector_type(4)));
typedef unsigned u32x4 __attribute__((ext_vector_type(4)));
constexpr int BM = 256, BK = 64, HALF = 128, HTB = HALF * BK * 2  , STAGE_BYTES = 8 * HTB, NXCD = 8, WGM = 8;

__host__ __device__ __forceinline__ int lds_byte(int r, int c) { const int st = (r >> 4) * 2 + (c >> 5), rr = r & 15, cc = c & 31, ob = rr * 64 + cc * 2; return st * 1024 + (ob ^ (((ob >> 9) & 1) << 5)); }
__host__ __device__ __forceinline__ void stage_rc(int b, int& R, int& C) { const int st = b / 1024, sb = b % 1024, swz = sb ^ (((sb >> 9) & 1) << 5); R = (st >> 1) * 16 + swz / 64; C = (st & 1) * 32 + (swz % 64) / 2; }
__host__ __device__ __forceinline__ int perm32(int rho) { const int n = rho >> 4, i = rho & 15; return 8 * (i >> 2) + 4 * n + (i & 3); }

struct Unit { int pm, pn; };
struct Gemm { const bf16_t* A; const bf16_t* Bt; int M, N, K; };

struct StaticOrder {
    int nM, nN, nwg, G, c;
    __host__ __device__ void init(int M, int N, int G_, int c_) { nM = M / BM; nN = N / BM; nwg = nM * nN; G = G_; c = c_; }
    __host__ __device__ bool next(int i, Unit& u) const {
        const long L = (long)i * G + c; if (L >= nwg) return false;
        int wgid = (int)L; { const int q = nwg / NXCD, r = nwg % NXCD, xcd = wgid % NXCD, off = wgid / NXCD; wgid = (xcd < r ? xcd * (q + 1) : r * (q + 1) + (xcd - r) * q) + off; }
        const int nig = WGM * nN, gid = wgid / nig, fm = gid * WGM, gsz = (nM - fm) < WGM ? (nM - fm) : WGM;
        u.pm = fm + ((wgid % nig) % gsz); u.pn = (wgid % nig) / gsz; return true;
    }
    __device__ __forceinline__ void a_ready(const Unit&) const {}
    __device__ __forceinline__ void done(const Unit&) const {}
};

template <class Epi, class Sched, bool ALIGN_EPI = false, bool SP2 = false>
__device__ __forceinline__ void gemm_phase(PG8_LAS unsigned char* lds, const Gemm g, const Sched& S, const Epi& E) {
    const int tid = otid(), wid = __builtin_amdgcn_readfirstlane(tid >> 6), lane = tid & 63, wr = wid >> 2, wc = wid & 3, fr = lane & 15, fq = lane >> 4;
    const int K = g.K, nt = K / BK;
    unsigned voffA[2], voffB[2];
#pragma unroll
    for (int i = 0; i < 2; ++i) { int R, C; stage_rc(tid * 16 + i * 8192, R, C); const int Rb = Epi::PERM ? ((R & ~31) + perm32(R & 31)) : R;
        voffA[i] = (unsigned)(R * K + C) * 2u; voffB[i] = (unsigned)(Rb * K + C) * 2u; }
    const size_t kstep = (size_t)(BK * 2);
    const size_t hstep = (size_t)HALF * K * 2;
    const size_t tstep = 2 * hstep;
    const unsigned ldsw = (unsigned)wid * 1024u;
    const int aoff = lds_byte(wr * 64 + fr, fq * 8), boff = lds_byte(wc * 32 + fr, fq * 8);
#define PG8_SA(b, h) (((b) * 2 + (h)) * HTB)
#define PG8_SB(b, h) ((4 + (b) * 2 + (h)) * HTB)
#define PG8_STAGE(bufoff, gbase, voff) do { _Pragma("unroll") for (int _i = 0; _i < 2; ++_i) \
        __builtin_amdgcn_global_load_lds((const unsigned*)((const char*)(gbase) + (voff)[_i]), (PG8_LAS unsigned*)(lds + (bufoff) + ldsw + _i * 8192), 16, 0, 0); } while (0)
#define PG8_LDA(dst, b, h) do { _Pragma("unroll") for (int m = 0; m < 4; ++m) _Pragma("unroll") for (int k = 0; k < 2; ++k) dst[m][k] = *(const PG8_LAS f16x8*)(lds + PG8_SA(b, h) + aoff + m * 2048 + k * 1024); } while (0)
#define PG8_LDB(dst, b, h) do { _Pragma("unroll") for (int n = 0; n < 2; ++n) _Pragma("unroll") for (int k = 0; k < 2; ++k) dst[n][k] = *(const PG8_LAS f16x8*)(lds + PG8_SB(b, h) + boff + n * 2048 + k * 1024); } while (0)
#define PG8_MMA(ai, bj, At, Bt) do { __builtin_amdgcn_s_setprio(1); _Pragma("unroll") for (int m = 0; m < 4; ++m) _Pragma("unroll") for (int n = 0; n < 2; ++n) _Pragma("unroll") for (int k = 0; k < 2; ++k) \
        acc[ai][bj][m][n] = __builtin_amdgcn_mfma_f32_16x16x32_f16(Bt[n][k], At[m][k], acc[ai][bj][m][n], 0, 0, 0); __builtin_amdgcn_s_setprio(0); } while (0)
#define PG8_WAIT_V(n) asm volatile("s_waitcnt vmcnt(" #n ")" ::: "memory")
#define PG8_WAIT_L(n) asm volatile("s_waitcnt lgkmcnt(" #n ")" ::: "memory")
#define PG8_BAR __builtin_amdgcn_s_barrier()
#define PG8_SCHED __builtin_amdgcn_sched_barrier(0)
    Unit cur, nxt; int ui = 0;
    if (!S.next(0, cur)) return;
    f32x4 acc[2][2][4][2];
#pragma unroll
    for (int a = 0; a < 2; ++a)
#pragma unroll
        for (int b = 0; b < 2; ++b)
#pragma unroll
            for (int m = 0; m < 4; ++m)
#pragma unroll
                for (int n = 0; n < 2; ++n) acc[a][b][m][n] = (f32x4){0.f, 0.f, 0.f, 0.f};
    f16x8 At[4][2], B0[2][2], B1[2][2];
    const char* cA = (const char*)g.A + (size_t)cur.pm * tstep; const char* cB = (const char*)g.Bt + (size_t)cur.pn * tstep;
    S.a_ready(cur);
    if constexpr (SP2) {
        PG8_STAGE(PG8_SB(0, 0), cB, voffB); PG8_STAGE(PG8_SB(0, 1), cB + hstep, voffB); PG8_STAGE(PG8_SA(0, 0), cA, voffA); PG8_STAGE(PG8_SA(0, 1), cA + hstep, voffA);
        if (wr == 1) PG8_BAR;
        PG8_WAIT_V(2); PG8_BAR;
        PG8_STAGE(PG8_SB(1, 0), cB + kstep, voffB); PG8_STAGE(PG8_SA(1, 0), cA + kstep, voffA); PG8_STAGE(PG8_SB(1, 1), cB + hstep + kstep, voffB);
        PG8_WAIT_V(6); PG8_BAR;
    } else {
        PG8_STAGE(PG8_SB(0, 0), cB, voffB); PG8_STAGE(PG8_SA(0, 0), cA, voffA); PG8_STAGE(PG8_SB(0, 1), cB + hstep, voffB); PG8_STAGE(PG8_SA(0, 1), cA + hstep, voffA);
        if (wr == 1) PG8_BAR;
        PG8_WAIT_V(4); PG8_BAR;
        PG8_STAGE(PG8_SB(1, 0), cB + kstep, voffB); PG8_STAGE(PG8_SA(1, 0), cA + kstep, voffA); PG8_STAGE(PG8_SB(1, 1), cB + hstep + kstep, voffB);
        PG8_WAIT_V(6); PG8_BAR;
    }
    for (;;) {
        const bool has_next = S.next(ui + 1, nxt);
        const char* nA = has_next ? (const char*)g.A + (size_t)nxt.pm * tstep : cA; const char* nB = has_next ? (const char*)g.Bt + (size_t)nxt.pn * tstep : cB;
        for (int t = 0; t < nt; t += 2) {
            const bool last = (t == nt - 2);
            const char* a1 = cA + (size_t)(t + 1) * kstep;
            const char* a2 = last ? nA : cA + (size_t)(t + 2) * kstep; const char* b2 = last ? nB : cB + (size_t)(t + 2) * kstep;
            const char* a3 = a2 + kstep; const char* b3 = b2 + kstep;
            if (last && has_next) S.a_ready(nxt);
            if constexpr (SP2) {
            PG8_LDB(B0, 0, 0); PG8_LDB(B1, 0, 1); PG8_SCHED; PG8_LDA(At, 0, 0); PG8_STAGE(PG8_SA(1, 1), a1 + hstep, voffA);
            PG8_WAIT_V(8); PG8_WAIT_L(0); PG8_BAR; PG8_MMA(0, 0, At, B0); PG8_MMA(0, 1, At, B1); PG8_BAR; PG8_SCHED;
            PG8_LDA(At, 0, 1); PG8_STAGE(PG8_SB(0, 0), b2, voffB); PG8_STAGE(PG8_SB(0, 1), b2 + hstep, voffB); PG8_STAGE(PG8_SA(0, 0), a2, voffA);
            PG8_WAIT_V(8); PG8_WAIT_L(0); PG8_BAR; PG8_MMA(1, 0, At, B0); PG8_MMA(1, 1, At, B1); PG8_BAR; PG8_SCHED;
            PG8_LDB(B0, 1, 0); PG8_LDB(B1, 1, 1); PG8_SCHED; PG8_LDA(At, 1, 0); PG8_STAGE(PG8_SA(0, 1), a2 + hstep, voffA);
            PG8_WAIT_V(8); PG8_WAIT_L(0); PG8_BAR; PG8_MMA(0, 0, At, B0); PG8_MMA(0, 1, At, B1); PG8_BAR; PG8_SCHED;
            PG8_LDA(At, 1, 1); PG8_STAGE(PG8_SB(1, 0), b3, voffB); PG8_STAGE(PG8_SB(1, 1), b3 + hstep, voffB); PG8_STAGE(PG8_SA(1, 0), a3, voffA);
            PG8_WAIT_V(8); PG8_WAIT_L(0); PG8_BAR; PG8_MMA(1, 0, At, B0); PG8_MMA(1, 1, At, B1); PG8_BAR; PG8_SCHED;
            } else {
            PG8_LDB(B0, 0, 0); PG8_SCHED; PG8_LDA(At, 0, 0); PG8_STAGE(PG8_SA(1, 1), a1 + hstep, voffA);
            PG8_WAIT_L(8); PG8_BAR; PG8_WAIT_L(0); PG8_MMA(0, 0, At, B0); PG8_BAR; PG8_SCHED;
            PG8_LDB(B1, 0, 1); PG8_STAGE(PG8_SB(0, 0), b2, voffB);
            PG8_BAR; PG8_WAIT_L(0); PG8_MMA(0, 1, At, B1); PG8_BAR;
            PG8_LDA(At, 0, 1); PG8_STAGE(PG8_SA(0, 0), a2, voffA);
            PG8_BAR; PG8_WAIT_L(0); PG8_MMA(1, 0, At, B0); PG8_BAR; PG8_SCHED;
            PG8_STAGE(PG8_SB(0, 1), b2 + hstep, voffB);
            PG8_WAIT_V(6); PG8_BAR; PG8_MMA(1, 1, At, B1); PG8_BAR;
            PG8_LDB(B0, 1, 0); PG8_SCHED; PG8_LDA(At, 1, 0); PG8_STAGE(PG8_SA(0, 1), a2 + hstep, voffA);
            PG8_WAIT_L(8); PG8_BAR; PG8_WAIT_L(0); PG8_MMA(0, 0, At, B0); PG8_BAR; PG8_SCHED;
            PG8_LDB(B1, 1, 1); PG8_STAGE(PG8_SB(1, 0), b3, voffB);
            PG8_BAR; PG8_WAIT_L(0); PG8_MMA(0, 1, At, B1); PG8_BAR;
            PG8_LDA(At, 1, 1); PG8_STAGE(PG8_SA(1, 0), a3, voffA);
            PG8_BAR; PG8_WAIT_L(0); PG8_MMA(1, 0, At, B0); PG8_BAR; PG8_SCHED;
            PG8_STAGE(PG8_SB(1, 1), b3 + hstep, voffB);
            PG8_WAIT_V(6); PG8_BAR; PG8_MMA(1, 1, At, B1); PG8_BAR;
            }
        }
        if constexpr (ALIGN_EPI) { if (wr == 0) PG8_BAR; }
        if constexpr (!Epi::AFTER_DRAIN) { E(acc, cur, wr, wc, fr, fq); S.done(cur); }
        if (!has_next) break;
#pragma unroll
        for (int a = 0; a < 2; ++a)
#pragma unroll
            for (int b = 0; b < 2; ++b)
#pragma unroll
                for (int m = 0; m < 4; ++m)
#pragma unroll
                    for (int n = 0; n < 2; ++n) acc[a][b][m][n] = (f32x4){0.f, 0.f, 0.f, 0.f};
        cur = nxt; cA = nA; cB = nB; ++ui;
        if constexpr (ALIGN_EPI) { if (wr == 1) PG8_BAR; }
    }
    PG8_WAIT_V(0);
    if constexpr (!ALIGN_EPI) { if (wr == 0) PG8_BAR; }
    PG8_BAR;
    if constexpr (Epi::AFTER_DRAIN) { E.fused(acc, cur, wr, wc, fr, fq, lds, wid, lane); S.done(cur); }
#undef PG8_SA
#undef PG8_SB
#undef PG8_STAGE
#undef PG8_LDA
#undef PG8_LDB
#undef PG8_MMA
#undef PG8_WAIT_V
#undef PG8_WAIT_L
#undef PG8_BAR
#undef PG8_SCHED
}
}


typedef float f32x4_t __attribute__((ext_vector_type(4)));
typedef _Float16 h16x8 __attribute__((ext_vector_type(8)));
DEVI float silu_f(float v) { return v / (1.f + __expf(-v)); }
struct EpiRoute {
    static constexpr bool PERM = true, AFTER_DRAIN = false;
    gu8* ws; const gf32* ssq;
    DEVI void operator()(const pg8::f32x4 (&acc)[2][2][4][2], const pg8::Unit& u, int wr, int wc, int fr, int fq) const {
        const int row0 = u.pm * 256 + wr * 64 + fr;
        float rs[2][4];
#pragma unroll
        for (int ai = 0; ai < 2; ++ai)
#pragma unroll
            for (int m = 0; m < 4; ++m) { const int rw = row0 + ai * 128 + m * 16; rs[ai][m] = rsqrtf((ssq[rw] + ssq[NT + rw] + ssq[2 * NT + rw] + ssq[3 * NT + rw]) * (1.f / DM) + EPS); }
#pragma unroll
        for (int bj = 0; bj < 2; ++bj) {
            const int cg = u.pn * 256 + bj * 128 + wc * 32;
            const Route r = route(cg);
            if (r.kind < 0) continue;
            gh16* base = (gh16*)(ws + r.off);
            const int c = r.dcol + 8 * fq;
#pragma unroll
            for (int ai = 0; ai < 2; ++ai)
#pragma unroll
                for (int m = 0; m < 4; ++m) {
                    const int row = row0 + ai * 128 + m * 16; const float sc = rs[ai][m] * r.scale;
                    float v[8];
#pragma unroll
                    for (int j = 0; j < 4; ++j) { v[j] = acc[ai][bj][m][0][j] * sc; v[4 + j] = acc[ai][bj][m][1][j] * sc; }
                    if (r.silu) {
#pragma unroll
                        for (int j = 0; j < 8; ++j) v[j] = silu_f(v[j]);
                    }
                    h16x8 o;
#pragma unroll
                    for (int j = 0; j < 8; ++j) o[j] = (h16)v[j];
                    if (r.kind == 0) *(GAS h16x8*)(base + (size_t)row * r.pitch + c) = o;
                    else {
                        const int b = row >> 11, sq = row & 2047;
                        if (r.kind == 3) *(GAS h16x8*)(base + (((size_t)b * 128 + (sq >> 4)) * 64 + (sq & 15) + 16 * (c >> 3)) * 8) = o;
                        else {
                            const int bh = b * 4 + (c >> 6), d0 = c & 63;
                            *(GAS h16x8*)(base + kf_off(bh, sq, d0)) = o;
                            if (r.kind == 2) { *(GAS h16x8*)(base + FSZ + kf4_off(bh, sq, d0)) = o; *(GAS h16x8*)(base + 2 * FSZ + kf16_off(bh, sq, d0)) = o; }
                        }
                    }
                }
        }
    }
};

struct EpiOut {
    static constexpr bool PERM = true, AFTER_DRAIN = true;
    gf32* h_out; gh16* h16o; const gf32* gpost; gf32* ssqy; gf32* ssqh; const XcdBarrier* bar; bool write_next;
    DEVI void rowsum_publish(const float (&ps)[2][4], gf32* dst, const pg8::Unit& u, int wr, int wc, int fr, int fq, PG8_LAS unsigned char* lds) const {
        lf32* red = (lf32*)lds;
        __syncthreads();
#pragma unroll
        for (int ai = 0; ai < 2; ++ai)
#pragma unroll
            for (int m = 0; m < 4; ++m) { float v = ps[ai][m]; v += __shfl_xor(v, 16); v += __shfl_xor(v, 32); if (fq == 0) red[wc * 256 + ai * 128 + wr * 64 + m * 16 + fr] = v; }
        __syncthreads();
        const int t = otid();
        if (t < 256) dst[(size_t)u.pn * NT + u.pm * 256 + t] = red[t] + red[256 + t] + red[512 + t] + red[768 + t];
    }
    DEVI void fused(pg8::f32x4 (&acc)[2][2][4][2], const pg8::Unit& u, int wr, int wc, int fr, int fq, PG8_LAS unsigned char* lds, int wid, int lane) const {
        float ps[2][4];
#pragma unroll
        for (int ai = 0; ai < 2; ++ai)
#pragma unroll
            for (int m = 0; m < 4; ++m) { float v = 0.f;
#pragma unroll
                for (int bj = 0; bj < 2; ++bj)
#pragma unroll
                    for (int n = 0; n < 2; ++n)
#pragma unroll
                        for (int e = 0; e < 4; ++e) v += acc[ai][bj][m][n][e] * acc[ai][bj][m][n][e];
                ps[ai][m] = v; }
        rowsum_publish(ps, ssqy, u, wr, wc, fr, fq, lds);
        xcd_barrier(*bar);
        const int row0 = u.pm * 256 + wr * 64 + fr, col0 = u.pn * 256 + wc * 32 + 8 * fq;
        float rs[2][4];
        {
            float sv[2][4][4];
#pragma unroll
            for (int ai = 0; ai < 2; ++ai)
#pragma unroll
                for (int m = 0; m < 4; ++m)
#pragma unroll
                    for (int q = 0; q < 4; ++q) sv[ai][m][q] = ssqy[(size_t)q * NT + row0 + ai * 128 + m * 16];
#pragma unroll
            for (int ai = 0; ai < 2; ++ai)
#pragma unroll
                for (int m = 0; m < 4; ++m) rs[ai][m] = rsqrtf(((sv[ai][m][0] + sv[ai][m][1]) + (sv[ai][m][2] + sv[ai][m][3])) * (1.f / DM) + EPS);
        }
        f32x4_t gv[2][2];
#pragma unroll
        for (int bj = 0; bj < 2; ++bj)
#pragma unroll
            for (int n = 0; n < 2; ++n) gv[bj][n] = *(const GAS f32x4_t*)(gpost + col0 + bj * 128 + 4 * n);
#pragma unroll
        for (int ai = 0; ai < 2; ++ai) {
            h16x8 hh[4][2];
#pragma unroll
            for (int m = 0; m < 4; ++m)
#pragma unroll
                for (int bj = 0; bj < 2; ++bj) hh[m][bj] = *(const GAS h16x8*)(h16o + (size_t)(row0 + ai * 128 + m * 16) * DM + col0 + bj * 128);
            __builtin_amdgcn_sched_barrier(0);
#pragma unroll
            for (int m = 0; m < 4; ++m) {
                float v2 = 0.f;
#pragma unroll
                for (int bj = 0; bj < 2; ++bj)
#pragma unroll
                    for (int n = 0; n < 2; ++n)
#pragma unroll
                        for (int e = 0; e < 4; ++e) { const float o = (float)hh[m][bj][4 * n + e] + acc[ai][bj][m][n][e] * rs[ai][m] * gv[bj][n][e]; acc[ai][bj][m][n][e] = o; v2 += o * o; }
                ps[ai][m] = v2;
            }
        }
        if (write_next) {
#pragma unroll
            for (int ai = 0; ai < 2; ++ai)
#pragma unroll
                for (int m = 0; m < 4; ++m)
#pragma unroll
                    for (int bj = 0; bj < 2; ++bj) { h16x8 oh;
#pragma unroll
                        for (int n = 0; n < 2; ++n)
#pragma unroll
                            for (int e = 0; e < 4; ++e) oh[4 * n + e] = (h16)acc[ai][bj][m][n][e];
                        *(GAS h16x8*)(h16o + (size_t)(row0 + ai * 128 + m * 16) * DM + col0 + bj * 128) = oh; }
        } else {
#pragma unroll
            for (int ai = 0; ai < 2; ++ai)
#pragma unroll
                for (int m = 0; m < 4; ++m)
#pragma unroll
                    for (int bj = 0; bj < 2; ++bj)
#pragma unroll
                        for (int n = 0; n < 2; ++n) *(GAS f32x4_t*)(h_out + (size_t)(row0 + ai * 128 + m * 16) * DM + col0 + bj * 128 + 4 * n) = acc[ai][bj][m][n];
        }
        if (write_next) rowsum_publish(ps, ssqh, u, wr, wc, fr, fq, lds);
    }
    DEVI void operator()(const pg8::f32x4 (&)[2][2][4][2], const pg8::Unit&, int, int, int, int) const {}
};

constexpr int NTHR = 512, NWAVE = 8;

template <bool REF>
DEVI void cvt_transpose(const gf32* __restrict__ src, int src_pitch, const gf32* __restrict__ g, gh16* dst, int N, int K, lu8* lds, int item0, int nitems_total, int& item_base) {
    const int tid = otid();
    LAS float (*tile)[65] = (LAS float (*)[65])lds;
    const int ntn = N / 64, ntk = K / 64, n_it = ntn * ntk;
    for (int it = item0; it < nitems_total; it += gridDim.x) {
        const int li = it - item_base; if (li < 0 || li >= n_it) continue;
        const int n0 = (li % ntn) * 64, k0 = (li / ntn) * 64;
        __syncthreads();
        const int c = tid & 63; int rc = n0 + c; if (REF) rc = ref_col(rc);
#pragma unroll
        for (int ps = 0; ps < 8; ++ps) { const int k = ps * 8 + (tid >> 6);
            tile[k][c] = rc >= 0 ? src[(size_t)(k0 + k) * src_pitch + rc] * (g ? g[k0 + k] : 1.f) : 0.f; }
        __syncthreads();
        const int cc = tid >> 3, kq = (tid & 7) * 8;
        h16x8 o;
#pragma unroll
        for (int j = 0; j < 8; ++j) o[j] = (h16)tile[kq + j][cc];
        *(GAS h16x8*)(dst + (size_t)(n0 + cc) * K + k0 + kq) = o;
    }
    item_base += n_it;
}

DEVI void ph_rowstat_cvt(const gf32* h, gf32* ssq, gh16* h16o) {
    const int t_ = otid(); const int lane = t_ & 63, gw = blockIdx.x * NWAVE + (t_ >> 6), nw = gridDim.x * NWAVE;
    for (int row = gw; row < NT; row += nw) {
        const GAS f32x4_t* p = (const GAS f32x4_t*)(h + (size_t)row * DM);
        float s = 0.f;
#pragma unroll
        for (int i = 0; i < 4; ++i) { f32x4_t v = p[lane + 64 * i]; s += v[0] * v[0] + v[1] * v[1] + v[2] * v[2] + v[3] * v[3];
            typedef _Float16 h16x4 __attribute__((ext_vector_type(4)));
            h16x4 o; o[0] = (h16)v[0]; o[1] = (h16)v[1]; o[2] = (h16)v[2]; o[3] = (h16)v[3];
            *(GAS h16x4*)(h16o + (size_t)row * DM + (lane + 64 * i) * 4) = o; }
        for (int o = 32; o; o >>= 1) s += __shfl_xor(s, o);
        if (lane == 0) { ssq[row] = s; ssq[NT + row] = 0.f; ssq[2 * NT + row] = 0.f; ssq[3 * NT + row] = 0.f; }
    }
}

typedef float f32x16 __attribute__((ext_vector_type(16)));
typedef _Float16 h16x4 __attribute__((ext_vector_type(4)));
DEVI f32x16 mfma32(h16x8 a, h16x8 b, f32x16 c) { return __builtin_amdgcn_mfma_f32_32x32x16_f16(a, b, c, 0, 0, 0); }
#define CROW(r) (((r) & 3) + 8 * ((r) >> 2))
DEVI float xh_max(float x) { auto r = __builtin_amdgcn_permlane32_swap(__float_as_uint(x), __float_as_uint(x), false, false); return fmaxf(__uint_as_float(r[0]), __uint_as_float(r[1])); }
DEVI float xh_sum(float x) { auto r = __builtin_amdgcn_permlane32_swap(__float_as_uint(x), __float_as_uint(x), false, false); return __uint_as_float(r[0]) + __uint_as_float(r[1]); }
DEVI unsigned pk2h(float a, float b) { auto v = __builtin_amdgcn_cvt_pkrtz(a, b); return __builtin_bit_cast(unsigned, v); }
DEVI h16x8 pack8(const f32x16& p, int s) {
    typedef unsigned u32x4_t __attribute__((ext_vector_type(4)));
    u32x4_t w;
    w[0] = pk2h(p[8 * s + 0], p[8 * s + 1]); w[1] = pk2h(p[8 * s + 2], p[8 * s + 3]); w[2] = pk2h(p[8 * s + 4], p[8 * s + 5]); w[3] = pk2h(p[8 * s + 6], p[8 * s + 7]);
    return __builtin_bit_cast(h16x8, w);
}
DEVI h16x8 ldv8(const gh16* p) {
    h16x4 a = *(const GAS h16x4*)p, b = *(const GAS h16x4*)(p + 8);
    h16x8 r; r[0] = a[0]; r[1] = a[1]; r[2] = a[2]; r[3] = a[3]; r[4] = b[0]; r[5] = b[1]; r[6] = b[2]; r[7] = b[3]; return r;
}
DEVI void softmax_tile(f32x16& S, float& m, float& l, f32x16& O0, f32x16& O1) {
    float mx = S[0];
#pragma unroll
    for (int r = 1; r < 16; ++r) mx = fmaxf(mx, S[r]);
    mx = xh_max(mx);
    if (__any(mx > m)) {
        const float mn = fmaxf(m, mx), al = __builtin_amdgcn_exp2f(m - mn);
        l *= al; O0 *= al; O1 *= al; m = mn;
    }
#pragma unroll
    for (int r = 0; r < 16; ++r) S[r] = __builtin_amdgcn_exp2f(S[r] - m);
    l += ((S[0] + S[1]) + (S[2] + S[3])) + ((S[4] + S[5]) + (S[6] + S[7])) + (((S[8] + S[9]) + (S[10] + S[11])) + ((S[12] + S[13]) + (S[14] + S[15])));
}
DEVI void softmax_tile_h(f32x16& S, float& m, float& l, f32x16& O0, f32x16& O1, int hot) { if (hot < 2) softmax_tile(S, m, l, O0, O1); else l += S[0]; }
DEVI int wq_next(gu32* ctr) {
    int e = 0;
    if ((otid() & 63) == 0) e = (int)__hip_atomic_fetch_add(ctr, 1u, __ATOMIC_RELAXED, __HIP_MEMORY_SCOPE_AGENT);
    return __builtin_amdgcn_readfirstlane(e);
}

DEVI void flashA_item(int b, int hh, int qt, const gh16* qA, const gh16* KF, const gh16* KRF, const gh16* VF, const gh16* gate, gh16* mix) {
    const int lane = otid() & 63, q = lane & 31, h = lane >> 5;
    const size_t tokq = (size_t)b * SEQ + qt * 32 + q;
    h16x8 qf[6];
#pragma unroll
    for (int ks = 0; ks < 6; ++ks) qf[ks] = *(const GAS h16x8*)(qA + tokq * 384 + hh * 96 + ks * 16 + 8 * h);
    f32x16 O0 = {}, O1 = {};
    float m = -1e30f, l = 0.f;
    const gh16* kp = KF + (size_t)(b * 4 + hh) * 64 * 2048 + lane * 8;
    const gh16* rp = KRF + (size_t)b * 64 * 1024 + lane * 8;
    const gh16* vp = VF + (size_t)(b * 4 + hh) * 64 * 2048 + lane * 8;
    h16x8 kf[6];
#pragma unroll
    for (int ks = 0; ks < 4; ++ks) kf[ks] = *(const GAS h16x8*)(kp + ks * 512);
#pragma unroll
    for (int ks = 0; ks < 2; ++ks) kf[4 + ks] = *(const GAS h16x8*)(rp + ks * 512);
    h16x8 vf[4], vn[4];
#pragma unroll
    for (int f = 0; f < 4; ++f) vf[f] = *(const GAS h16x8*)(vp + f * 512);
    for (int j = 0; j <= qt; ++j) {
        f32x16 S = {};
#pragma unroll
        for (int ks = 0; ks < 6; ++ks) S = mfma32(kf[ks], qf[ks], S);
        if (j < qt) {
#pragma unroll
            for (int ks = 0; ks < 4; ++ks) kf[ks] = *(const GAS h16x8*)(kp + (size_t)(j + 1) * 2048 + ks * 512);
#pragma unroll
            for (int ks = 0; ks < 2; ++ks) kf[4 + ks] = *(const GAS h16x8*)(rp + (size_t)(j + 1) * 1024 + ks * 512);
#pragma unroll
            for (int f = 0; f < 4; ++f) vn[f] = *(const GAS h16x8*)(vp + (size_t)(j + 1) * 2048 + f * 512);
        } else {
#pragma unroll
            for (int r = 0; r < 16; ++r) S[r] = (CROW(r) + 4 * h > q) ? -3e38f : S[r];
        }
        softmax_tile(S, m, l, O0, O1);
        const h16x8 p0 = pack8(S, 0), p1 = pack8(S, 1);
        O0 = mfma32(vf[0], p0, O0); O0 = mfma32(vf[1], p1, O0);
        O1 = mfma32(vf[2], p0, O1); O1 = mfma32(vf[3], p1, O1);
#pragma unroll
        for (int f = 0; f < 4; ++f) vf[f] = vn[f];
    }
    const float il = 1.f / xh_sum(l);
    const gh16* gp = gate + tokq * 1024 + hh * 64 + 4 * h;
#pragma unroll
    for (int db = 0; db < 2; ++db)
#pragma unroll
        for (int g = 0; g < 4; ++g) {
            const h16x4 gv = *(const GAS h16x4*)(gp + db * 32 + 8 * g); h16x4 o;
#pragma unroll
            for (int e = 0; e < 4; ++e) o[e] = (h16)((db ? O1[4 * g + e] : O0[4 * g + e]) * il * (float)gv[e]);
            *(GAS h16x4*)(mix + mixf_off(tokq, hh * 64 + db * 32 + 8 * g + 4 * h)) = o;
        }
}

DEVI int far_bucket(int n) { return 23 + (n >= 182 ? 1 : 0) + (n >= 246 ? 1 : 0) + (n >= 332 ? 1 : 0) + (n >= 450 ? 1 : 0) + (n >= 609 ? 1 : 0) + (n >= 825 ? 1 : 0) + (n >= 1117 ? 1 : 0) + (n >= 1513 ? 1 : 0); }
DEVI int far_start(int bk) { return bk == 24 ? 182 : bk == 25 ? 246 : bk == 26 ? 332 : bk == 27 ? 450 : bk == 28 ? 609 : bk == 29 ? 825 : bk == 30 ? 1117 : 1513; }
constexpr int L_NEAR = 0, L_R3 = 12288, L_R2 = 15360, L_R1 = 21504, L_LAM = 39936, L_P2END = 40000;
constexpr int L_BIASL = 40000, L_RING = 41984, L_MRING = L_RING + 4 * 10240, L_WQ = L_MRING + 8192;
DEVI void p2_setup(const gf32* biasTab, const gf32* lam_p, float lambda_init, lu8* lds) {
    const int tid = otid();
    lf32* nearR = (lf32*)(lds + L_NEAR);
    for (int i = tid; i < 12 * 256; i += NTHR) { const int hb = i >> 8, u = i & 255, tix = 223 - u; nearR[i] = tix < 0 ? -3e38f : biasTab[hb * 2048 + tix]; }
    lf32* R3 = (lf32*)(lds + L_R3); lf32* R2 = (lf32*)(lds + L_R2); lf32* R1 = (lf32*)(lds + L_R1);
    for (int i = tid; i < 4 * 192; i += NTHR) { const int hb = i / 192, kk = 159 - (i % 192); R3[i] = (kk < 0 || kk > 128) ? -3e38f : biasTab[hb * 2048 + kk * 16]; }
    for (int i = tid; i < 4 * 384; i += NTHR) { const int hb = i / 384, kk = 255 - (i % 384); R2[i] = (kk < 0 || kk > 128) ? -3e38f : biasTab[hb * 2048 + kk * 4]; }
    for (int i = tid; i < 4 * 1152; i += NTHR) { const int hb = i / 1152, kk = 639 - (i % 1152); R1[i] = (kk < 0 || kk > 128) ? -3e38f : biasTab[hb * 2048 + kk]; }
    { lf32* bl = (lf32*)(lds + L_BIASL); for (int i = tid; i < 12 * 32; i += NTHR) { const int hb = i >> 5, k = i & 31; bl[i] = biasTab[hb * 2048 + (k < 16 ? k : kBucketStart[k - 16])]; } }
    if (tid == 0) { float a1 = 0.f, a2 = 0.f; for (int i = 0; i < 32; ++i) { a1 += lam_p[i] * lam_p[32 + i]; a2 += lam_p[64 + i] * lam_p[96 + i]; }
        *(lf32*)(lds + L_LAM) = expf(a1) - expf(a2) + lambda_init; }
    __syncthreads();
}

DEVI void ph_vtrans(const gh16* vtmp, gh16* VF, lu8* lds) {
    const int tid = otid();
    LAS h16 (*tile)[72] = (LAS h16 (*)[72])lds;
    for (int it = blockIdx.x; it < 3 * 32 * 4; it += gridDim.x) {
        const int src = it >> 7, bh = (it >> 2) & 31, blk = it & 3, b = bh >> 2, hh = bh & 3;
        __syncthreads();
#pragma unroll
        for (int k = 0; k < 8; ++k) { const int idx = k * NTHR + tid, row = idx >> 3, c8 = idx & 7;
            *(LAS h16x8*)&tile[row][c8 * 8] = *(const GAS h16x8*)(vtmp + ((size_t)b * SEQ + blk * 512 + row) * 768 + src * 256 + hh * 64 + c8 * 8); }
        __syncthreads();
        gh16* out0 = VF + (src == 0 ? 0 : (src == 1 ? 3 * FSZ : 4 * FSZ));
#pragma unroll 1
        for (int k = 0; k < 8; ++k) {
            const int fl = k * NTHR + tid, lane = fl & 63, frag = (fl >> 6) & 3, dl = lane & 31, hp = lane >> 5, db = frag >> 1, sk = frag & 1;
            {
                const int tl = fl >> 8; h16x8 o;
#pragma unroll
                for (int e = 0; e < 8; ++e) o[e] = tile[tl * 32 + 16 * sk + 8 * (e >> 2) + 4 * hp + (e & 3)][db * 32 + dl];
                *(GAS h16x8*)(out0 + ((((size_t)bh * 64 + blk * 16 + tl) * 4 + frag) * 64 + lane) * 8) = o;
            }
            if (src == 0) {
                {
                    const int r4 = fl >> 10, tl = (fl >> 8) & 3; h16x8 o;
#pragma unroll
                    for (int e = 0; e < 8; ++e) o[e] = tile[4 * (tl * 32 + 16 * sk + 8 * (e >> 2) + 4 * hp + (e & 3)) + r4][db * 32 + dl];
                    *(GAS h16x8*)(out0 + FSZ + (((((size_t)bh * 4 + r4) * 16 + blk * 4 + tl) * 4 + frag) * 64 + lane) * 8) = o;
                }
                {
                    const int r = fl >> 8; h16x8 o;
#pragma unroll
                    for (int e = 0; e < 8; ++e) o[e] = tile[16 * (16 * sk + 8 * (e >> 2) + 4 * hp + (e & 3)) + r][db * 32 + dl];
                    *(GAS h16x8*)(out0 + 2 * FSZ + (((((size_t)bh * 16 + r) * 4 + blk) * 4 + frag) * 64 + lane) * 8) = o;
                }
            }
        }
    }
}

template <int NMAP, bool MASK>
DEVI void flashCD_item(int b, int hh, int qt, int hb, const gh16* Q, const gh16* KF, const gh16* VF, const gu32* mask, const gf32* biasTab, const lu8* lds,
                       const gf32* subln, float lambda_init, const gh16* gate, gh16* mix, int mixcol, int hot = 0) {
    constexpr int NKS = 4 / NMAP;
    const int lane = otid() & 63, q = lane & 31, h = lane >> 5;
    const size_t tokq = (size_t)b * SEQ + qt * 32 + q;
    const gh16* kp = KF + (size_t)(b * 4 + hh) * 64 * 2048 + lane * 8;
    const gh16* vp = VF + (size_t)(b * 4 + hh) * 64 * 2048 + lane * 8;
    h16x8 qf[NMAP][NKS], kf[NMAP][NKS];
#pragma unroll
    for (int mp = 0; mp < NMAP; ++mp)
#pragma unroll
        for (int ks = 0; ks < NKS; ++ks) {
            qf[mp][ks] = *(const GAS h16x8*)(Q + tokq * 256 + hh * 64 + (mp * NKS + ks) * 16 + 8 * h);
            kf[mp][ks] = *(const GAS h16x8*)(kp + (mp * NKS + ks) * 512);
        }
    f32x16 O[NMAP][2]; float m[NMAP], l[NMAP];
#pragma unroll
    for (int mp = 0; mp < NMAP; ++mp) { O[mp][0] = (f32x16){}; O[mp][1] = (f32x16){}; m[mp] = -1e30f; l[mp] = 0.f; }
    const lf32* nearR = (const lf32*)(lds + L_NEAR) + hb * 256;
    const gf32* bt = biasTab + hb * 2048;
    h16x8 vf[2][2], vn[2][2];
#pragma unroll
    for (int db = 0; db < 2; ++db)
#pragma unroll
        for (int sk = 0; sk < 2; ++sk) vf[db][sk] = *(const GAS h16x8*)(vp + (db * 2 + sk) * 512);
    unsigned mw = 0xffffffffu, mwn = 0xffffffffu;
    if (MASK) mw = mask[tokq * 64];
    for (int j = 0; j <= qt; ++j) {
        f32x16 S[NMAP];
#pragma unroll
        for (int mp = 0; mp < NMAP; ++mp) { S[mp] = (f32x16){};
#pragma unroll
            for (int ks = 0; ks < NKS; ++ks) S[mp] = mfma32(kf[mp][ks], qf[mp][ks], S[mp]); }
        if (j < qt && hot < 5) {
#pragma unroll
            for (int mp = 0; mp < NMAP; ++mp)
#pragma unroll
                for (int ks = 0; ks < NKS; ++ks) kf[mp][ks] = *(const GAS h16x8*)(kp + (size_t)(hot ? 0 : j + 1) * 2048 + (mp * NKS + ks) * 512);
#pragma unroll
            for (int db = 0; db < 2; ++db)
#pragma unroll
                for (int sk = 0; sk < 2; ++sk) vn[db][sk] = *(const GAS h16x8*)(vp + (size_t)(hot ? 0 : j + 1) * 2048 + (db * 2 + sk) * 512);
            if (MASK) mwn = mask[tokq * 64 + j + 1];
        }
        const int D0 = (qt - j) * 32;
        if (hot >= 3) {} else
        if (D0 < 192) {
            const lf32* tp = nearR + (223 - D0 - q + 4 * h);
#pragma unroll
            for (int r = 0; r < 16; ++r) { const float bv = tp[CROW(r)];
#pragma unroll
                for (int mp = 0; mp < NMAP; ++mp) S[mp][r] += bv; }
        } else {
            const int blo = far_bucket(D0 - 31), bhi = far_bucket(D0 + 31);
            const lf32* biasL = (const lf32*)(lds + L_BIASL) + hb * 32;
            const float lo = biasL[blo], hi = biasL[bhi];
            if (blo == bhi) {
#pragma unroll
                for (int mp = 0; mp < NMAP; ++mp) S[mp] += lo;
            } else {
                const int x = D0 + q - 4 * h - far_start(bhi);
#pragma unroll
                for (int r = 0; r < 16; ++r) { const float bv = (x >= CROW(r)) ? hi : lo;
#pragma unroll
                    for (int mp = 0; mp < NMAP; ++mp) S[mp][r] += bv; }
            }
        }
        if (MASK && hot < 3) {
#pragma unroll
            for (int r = 0; r < 16; ++r) S[0][r] = (((mw >> (4 * h)) >> CROW(r)) & 1u) ? S[0][r] : -3e38f;
        }
#pragma unroll
        for (int mp = 0; mp < NMAP; ++mp) {
            softmax_tile_h(S[mp], m[mp], l[mp], O[mp][0], O[mp][1], hot);
            const h16x8 p0 = pack8(S[mp], 0), p1 = pack8(S[mp], 1);
            if (hot < 4) {
            O[mp][0] = mfma32(vf[0][0], p0, O[mp][0]); O[mp][0] = mfma32(vf[0][1], p1, O[mp][0]);
            O[mp][1] = mfma32(vf[1][0], p0, O[mp][1]); O[mp][1] = mfma32(vf[1][1], p1, O[mp][1]);
            } else { O[mp][0][0] += (float)p0[0] + (float)p1[0]; }
        }
#pragma unroll
        for (int db = 0; db < 2; ++db)
#pragma unroll
            for (int sk = 0; sk < 2; ++sk) vf[db][sk] = vn[db][sk];
        mw = mwn;
    }
    f32x16 R0, R1;
    if (NMAP == 2) {
        const float lam = *(const lf32*)(lds + L_LAM);
        const float i0 = 1.f / xh_sum(l[0]), i1 = lam / xh_sum(l[NMAP - 1]);
        R0 = O[0][0] * i0 - O[NMAP - 1][0] * i1; R1 = O[0][1] * i0 - O[NMAP - 1][1] * i1;
        float ss = 0.f;
#pragma unroll
        for (int r = 0; r < 16; ++r) ss += R0[r] * R0[r] + R1[r] * R1[r];
        ss = xh_sum(ss);
        const float rs = rsqrtf(ss * (1.f / 64.f) + EPS) * (1.f - lambda_init);
        R0 *= rs; R1 *= rs;
    } else {
        const float il = 1.f / xh_sum(l[0]);
        R0 = O[0][0] * il; R1 = O[0][1] * il;
    }
    const gh16* gp = gate + tokq * 1024 + mixcol + hh * 64 + 4 * h;
#pragma unroll
    for (int db = 0; db < 2; ++db)
#pragma unroll
        for (int g = 0; g < 4; ++g) {
            const h16x4 gv = *(const GAS h16x4*)(gp + db * 32 + 8 * g); h16x4 o;
#pragma unroll
            for (int e = 0; e < 4; ++e) { float v = (db ? R1[4 * g + e] : R0[4 * g + e]) * (float)gv[e];
                if (NMAP == 2) v *= subln[db * 32 + 8 * g + 4 * h + e];
                o[e] = (h16)v; }
            if (!hot) *(GAS h16x4*)(mix + mixf_off(tokq, mixcol + hh * 64 + db * 32 + 8 * g + 4 * h)) = o; else asm volatile("" :: "v"(o));
        }
}

template <int BR>
DEVI void flashQ2_item(int b, int hh, int pr, const gh16* Q, const gh16* KF, const gh16* KRF, const gh16* VF, const gu32* mask, const gf32* biasTab, const lu8* lds,
                       const gh16* gate, gh16* mix, int mixcol, int hb, int hot = 0) {
    constexpr int NQK = BR == 0 ? 6 : 4;
    const int lane = otid() & 63, q = lane & 31, h = lane >> 5, bh = b * 4 + hh;
    const int qt1 = 2 * pr + 1;
    size_t tokq[2]; h16x8 qf[2][NQK];
#pragma unroll
    for (int qi = 0; qi < 2; ++qi) { tokq[qi] = (size_t)b * SEQ + (2 * pr + qi) * 32 + q;
#pragma unroll
        for (int ks = 0; ks < NQK; ++ks) qf[qi][ks] = *(const GAS h16x8*)(Q + tokq[qi] * (BR == 0 ? 384 : 256) + hh * (BR == 0 ? 96 : 64) + ks * 16 + 8 * h); }
    f32x16 O[2][2]; float m[2], l[2];
#pragma unroll
    for (int qi = 0; qi < 2; ++qi) { O[qi][0] = (f32x16){}; O[qi][1] = (f32x16){}; m[qi] = -1e30f; l[qi] = 0.f; }
    const gh16* kp = KF + (size_t)bh * 64 * 2048 + lane * 8;
    const gh16* rp = KRF + (size_t)b * 64 * 1024 + lane * 8;
    const gh16* vp = VF + (size_t)bh * 64 * 2048 + lane * 8;
    const lf32* nearR = (const lf32*)(lds + L_NEAR) + hb * 256;
    const gf32* bt = biasTab + hb * 2048;
    h16x8 kf[NQK], vf[4];
#pragma unroll
    for (int ks = 0; ks < NQK; ++ks) kf[ks] = (BR == 0 && ks >= 4) ? *(const GAS h16x8*)(rp + (ks - 4) * 512) : *(const GAS h16x8*)(kp + ks * 512);
    unsigned mw[2] = {0xffffffffu, 0xffffffffu}, mwn[2] = {0xffffffffu, 0xffffffffu};
    if (BR == 1) { mw[0] = mask[tokq[0] * 64]; mw[1] = mask[tokq[1] * 64]; }
#pragma unroll 1
    for (int j = 0; j <= qt1; ++j) {
#pragma unroll
        for (int f = 0; f < 4; ++f) vf[f] = *(const GAS h16x8*)(vp + (size_t)(hot ? 0 : j) * 2048 + f * 512);
        f32x16 S[2];
#pragma unroll
        for (int qi = 0; qi < 2; ++qi) { S[qi] = (f32x16){};
#pragma unroll
            for (int ks = 0; ks < NQK; ++ks) S[qi] = mfma32(kf[ks], qf[qi][ks], S[qi]); }
        if (j < qt1 && hot < 5) {
#pragma unroll
            for (int ks = 0; ks < NQK; ++ks) kf[ks] = (BR == 0 && ks >= 4) ? *(const GAS h16x8*)(rp + (size_t)(hot ? 0 : j + 1) * 1024 + (ks - 4) * 512) : *(const GAS h16x8*)(kp + (size_t)(hot ? 0 : j + 1) * 2048 + ks * 512);
            if (BR == 1) { mwn[0] = mask[tokq[0] * 64 + (j + 1 < qt1 ? j + 1 : j)]; mwn[1] = mask[tokq[1] * 64 + j + 1]; }
        }
#pragma unroll
        for (int qi = 0; qi < 2; ++qi) {
            const int qt = 2 * pr + qi;
            if (j <= qt) {
                const int D0 = (qt - j) * 32;
                if (hot >= 3) {} else
                if (BR == 0) {
                    if (D0 == 0) {
#pragma unroll
                        for (int r = 0; r < 16; ++r) S[qi][r] = (CROW(r) + 4 * h > q) ? -3e38f : S[qi][r];
                    }
                } else {
                    if (D0 < 192) {
                        const lf32* tp = nearR + (223 - D0 - q + 4 * h);
#pragma unroll
                        for (int r = 0; r < 16; ++r) S[qi][r] += tp[CROW(r)];
                    } else {
                        const int blo = far_bucket(D0 - 31), bhi = far_bucket(D0 + 31);
                        const lf32* biasL = (const lf32*)(lds + L_BIASL) + hb * 32;
                        const float lo = biasL[blo], hi = biasL[bhi];
                        if (blo == bhi) S[qi] += lo;
                        else {
                            const int x = D0 + q - 4 * h - far_start(bhi);
#pragma unroll
                            for (int r = 0; r < 16; ++r) S[qi][r] += (x >= CROW(r)) ? hi : lo;
                        }
                    }
                    const unsigned mm = mw[qi] >> (4 * h);
#pragma unroll
                    for (int r = 0; r < 16; ++r) S[qi][r] = ((mm >> CROW(r)) & 1u) ? S[qi][r] : -3e38f;
                }
                softmax_tile_h(S[qi], m[qi], l[qi], O[qi][0], O[qi][1], hot);
                const h16x8 p0 = pack8(S[qi], 0), p1 = pack8(S[qi], 1);
                if (hot < 4) {
                O[qi][0] = mfma32(vf[0], p0, O[qi][0]); O[qi][0] = mfma32(vf[1], p1, O[qi][0]);
                O[qi][1] = mfma32(vf[2], p0, O[qi][1]); O[qi][1] = mfma32(vf[3], p1, O[qi][1]);
                } else { O[qi][0][0] += (float)p0[0] + (float)p1[0]; }
            }
        }
        mw[0] = mwn[0]; mw[1] = mwn[1];
    }
#pragma unroll
    for (int qi = 0; qi < 2; ++qi) {
        const float il = 1.f / xh_sum(l[qi]);
        const gh16* gp = gate + tokq[qi] * 1024 + mixcol + hh * 64 + 4 * h;
#pragma unroll
        for (int db = 0; db < 2; ++db)
#pragma unroll
            for (int g = 0; g < 4; ++g) {
                const h16x4 gv = *(const GAS h16x4*)(gp + db * 32 + 8 * g); h16x4 o;
#pragma unroll
                for (int e = 0; e < 4; ++e) o[e] = (h16)(O[qi][db][4 * g + e] * il * (float)gv[e]);
                if (!hot) *(GAS h16x4*)(mix + mixf_off(tokq[qi], mixcol + hh * 64 + db * 32 + 8 * g + 4 * h)) = o; else asm volatile("" :: "v"(o));
            }
    }
}

template <int BR>
DEVI void flashWG_item(int b, int hh, int Qb, const gh16* Q, const gh16* KF, const gh16* KRF, const gh16* VF, const gu32* mask, lu8* lds,
                       const gf32* subln, float lambda_init, const gh16* gate, gh16* mix, int mixcol, int hb) {
    constexpr int NMAP = BR == 2 ? 2 : 1, NQK = BR == 0 ? 6 : 4, NKS = NQK / NMAP, NP = NQK + 4, TB = NP * 1024, NDMA = BR == 2 ? 1 : 2, DD = 3;
    const int tid = otid(), lane = tid & 63, q = lane & 31, h = lane >> 5, wv = __builtin_amdgcn_readfirstlane(tid >> 6);
    const int qt = 8 * Qb + wv, last = 8 * Qb + 7, bh = b * 4 + hh;
    const size_t tokq = (size_t)b * SEQ + qt * 32 + q;
    h16x8 qf[NQK];
#pragma unroll
    for (int ks = 0; ks < NQK; ++ks) qf[ks] = *(const GAS h16x8*)(Q + tokq * (BR == 0 ? 384 : 256) + hh * (BR == 0 ? 96 : 64) + ks * 16 + 8 * h);
    f32x16 O[NMAP][2]; float m[NMAP], l[NMAP];
#pragma unroll
    for (int mp = 0; mp < NMAP; ++mp) { O[mp][0] = (f32x16){}; O[mp][1] = (f32x16){}; m[mp] = -1e30f; l[mp] = 0.f; }
    asm volatile("s_waitcnt vmcnt(0)" ::: "memory");
    __syncthreads();
    lu8* ring = lds + L_RING; lu8* mring = lds + L_MRING;
    auto issue = [&](int jt) {
        const int jc = jt < last ? jt : last, slot = jt & 3;
        {
            const int pc = wv;
            const gh16* src = pc < 4 ? KF + ((size_t)bh * 64 + jc) * 2048 + pc * 512
                            : (BR == 0 && pc < 6) ? KRF + ((size_t)b * 64 + jc) * 1024 + (pc - 4) * 512
                            : VF + ((size_t)bh * 64 + jc) * 2048 + (pc - NQK) * 512;
            __builtin_amdgcn_global_load_lds((const GAS unsigned*)(src + lane * 8), (LAS unsigned*)(ring + slot * TB + pc * 1024), 16, 0, 0);
        }
        if (BR == 0) {
            const int pc = 8 + (wv & 1);
            const gh16* src = VF + ((size_t)bh * 64 + jc) * 2048 + (pc - NQK) * 512;
            __builtin_amdgcn_global_load_lds((const GAS unsigned*)(src + lane * 8), (LAS unsigned*)(ring + slot * TB + pc * 1024), 16, 0, 0);
        }
        if (BR == 1) __builtin_amdgcn_global_load_lds((const GAS unsigned*)(mask + tokq * 64 + (jc <= qt ? jc : qt)), (LAS unsigned*)(mring + (slot * 8 + wv) * 256), 4, 0, 0);
    };
#pragma unroll
    for (int jt = 0; jt < DD; ++jt) issue(jt);
    const lf32* nearR = (const lf32*)(lds + L_NEAR) + hb * 256;
    const lf32* biasL = (const lf32*)(lds + L_BIASL) + hb * 32;
    f32x16 S[NMAP], Sn[NMAP];
    asm volatile("s_waitcnt vmcnt(%0)" :: "n"((DD - 1) * NDMA) : "memory");
    __builtin_amdgcn_s_barrier();
#pragma unroll
    for (int mp = 0; mp < NMAP; ++mp) { S[mp] = (f32x16){};
#pragma unroll
        for (int ks = 0; ks < NKS; ++ks) S[mp] = mfma32(*(const LAS h16x8*)(ring + lane * 16 + (mp * NKS + ks) * 1024), qf[mp * NKS + ks], S[mp]); }
#pragma unroll 1
    for (int j = 0; j <= last; ++j) {
        asm volatile("s_waitcnt vmcnt(%0)" :: "n"((DD - 2) * NDMA) : "memory");
        __builtin_amdgcn_s_barrier();
        issue(j + DD);
        if (j <= qt) {
            const lu8* sl = ring + (j & 3) * TB + lane * 16;
            if (j + 1 <= qt) {
                const lu8* sn = ring + ((j + 1) & 3) * TB + lane * 16;
#pragma unroll
                for (int mp = 0; mp < NMAP; ++mp) { Sn[mp] = (f32x16){};
#pragma unroll
                    for (int ks = 0; ks < NKS; ++ks) Sn[mp] = mfma32(*(const LAS h16x8*)(sn + (mp * NKS + ks) * 1024), qf[mp * NKS + ks], Sn[mp]); }
            }
            h16x8 vf[4];
#pragma unroll
            for (int f = 0; f < 4; ++f) vf[f] = *(const LAS h16x8*)(sl + (NQK + f) * 1024);
            const int D0 = (qt - j) * 32;
            if (BR == 0) {
                if (D0 == 0) {
#pragma unroll
                    for (int r = 0; r < 16; ++r) S[0][r] = (CROW(r) + 4 * h > q) ? -3e38f : S[0][r];
                }
            } else if (D0 < 192) {
                const lf32* tp = nearR + (223 - D0 - q + 4 * h);
#pragma unroll
                for (int r = 0; r < 16; ++r) { const float bv = tp[CROW(r)];
#pragma unroll
                    for (int mp = 0; mp < NMAP; ++mp) S[mp][r] += bv; }
            } else {
                int blo = 23, bhi = 23;
#pragma unroll
                for (int jj = 8; jj < 16; ++jj) { blo += (D0 - 31 >= kBucketStart[jj]) ? 1 : 0; bhi += (D0 + 31 >= kBucketStart[jj]) ? 1 : 0; }
                const float lo = biasL[blo], hi = biasL[bhi];
                if (blo == bhi) {
#pragma unroll
                    for (int mp = 0; mp < NMAP; ++mp) S[mp] += lo;
                } else {
                    const int x = D0 + q - 4 * h - kBucketStart[bhi - 16];
#pragma unroll
                    for (int r = 0; r < 16; ++r) { const float bv = (x >= CROW(r)) ? hi : lo;
#pragma unroll
                        for (int mp = 0; mp < NMAP; ++mp) S[mp][r] += bv; }
                }
            }
            if (BR == 1) {
                const unsigned mw = *(const LAS unsigned*)(mring + ((j & 3) * 8 + wv) * 256 + lane * 4) >> (4 * h);
#pragma unroll
                for (int r = 0; r < 16; ++r) S[0][r] = ((mw >> CROW(r)) & 1u) ? S[0][r] : -3e38f;
            }
#pragma unroll
            for (int mp = 0; mp < NMAP; ++mp) {
                softmax_tile(S[mp], m[mp], l[mp], O[mp][0], O[mp][1]);
                const h16x8 p0 = pack8(S[mp], 0), p1 = pack8(S[mp], 1);
                O[mp][0] = mfma32(vf[0], p0, O[mp][0]); O[mp][0] = mfma32(vf[1], p1, O[mp][0]);
                O[mp][1] = mfma32(vf[2], p0, O[mp][1]); O[mp][1] = mfma32(vf[3], p1, O[mp][1]);
            }
#pragma unroll
            for (int mp = 0; mp < NMAP; ++mp) S[mp] = Sn[mp];
        }
    }
    asm volatile("s_waitcnt vmcnt(0)" ::: "memory");
    f32x16 R0, R1;
    if (NMAP == 2) {
        const float lam = *(const lf32*)(lds + L_LAM);
        const float i0 = 1.f / xh_sum(l[0]), i1 = lam / xh_sum(l[NMAP - 1]);
        R0 = O[0][0] * i0 - O[NMAP - 1][0] * i1; R1 = O[0][1] * i0 - O[NMAP - 1][1] * i1;
        float ss = 0.f;
#pragma unroll
        for (int r = 0; r < 16; ++r) ss += R0[r] * R0[r] + R1[r] * R1[r];
        ss = xh_sum(ss);
        const float rs = rsqrtf(ss * (1.f / 64.f) + EPS) * (1.f - lambda_init);
        R0 *= rs; R1 *= rs;
    } else {
        const float il = 1.f / xh_sum(l[0]);
        R0 = O[0][0] * il; R1 = O[0][1] * il;
    }
    const gh16* gp = gate + tokq * 1024 + mixcol + hh * 64 + 4 * h;
#pragma unroll
    for (int db = 0; db < 2; ++db)
#pragma unroll
        for (int g = 0; g < 4; ++g) {
            const h16x4 gv = *(const GAS h16x4*)(gp + db * 32 + 8 * g); h16x4 o;
#pragma unroll
            for (int e = 0; e < 4; ++e) { float v = (db ? R1[4 * g + e] : R0[4 * g + e]) * (float)gv[e];
                if (NMAP == 2) v *= subln[db * 32 + 8 * g + 4 * h + e];
                o[e] = (h16)v; }
            *(GAS h16x4*)(mix + mixf_off(tokq, mixcol + hh * 64 + db * 32 + 8 * g + 4 * h)) = o;
        }
}

constexpr int L_RING2 = 41984, L_MRING2 = L_RING2 + 8 * 10240, L_WQ2 = L_MRING2 + 8 * 8 * 256;
template <int BR>
DEVI void flashWG2_item(int b, int hh, int Qb, const gh16* Q, const gh16* KF, const gh16* KRF, const gh16* VF, const gu32* mask, lu8* lds,
                        const gf32* subln, float lambda_init, const gh16* gate, gh16* mix, int mixcol, int hb) {
    constexpr int NMAP = BR == 2 ? 2 : 1, NQK = BR == 0 ? 6 : 4, NKS = NQK / NMAP, NP = NQK + 4, TB = NP * 1024;
    const int tid = otid(), lane = tid & 63, q = lane & 31, h = lane >> 5, wv = __builtin_amdgcn_readfirstlane(tid >> 6);
    const int qt = 8 * Qb + wv, NS = 2 * Qb + 2, bh = b * 4 + hh;
    const size_t tokq = (size_t)b * SEQ + qt * 32 + q;
    h16x8 qf[NQK];
#pragma unroll
    for (int ks = 0; ks < NQK; ++ks) qf[ks] = *(const GAS h16x8*)(Q + tokq * (BR == 0 ? 384 : 256) + hh * (BR == 0 ? 96 : 64) + ks * 16 + 8 * h);
    f32x16 O[NMAP][2]; float m[NMAP], l[NMAP];
#pragma unroll
    for (int mp = 0; mp < NMAP; ++mp) { O[mp][0] = (f32x16){}; O[mp][1] = (f32x16){}; m[mp] = -1e30f; l[mp] = 0.f; }
    lu8* ring = lds + L_RING2; lu8* mring = lds + L_MRING2;
    auto issue = [&](int st) {
#pragma unroll
        for (int u = 0; u < (4 * NP + 7) / 8; ++u) {
            const int id = wv + 8 * u;
            if (id < 4 * NP) {
                const int ti = id / NP, pc = id % NP, jt = 4 * st + ti, slot = jt & 7;
                const gh16* src = pc < 4 ? KF + ((size_t)bh * 64 + jt) * 2048 + pc * 512
                                : (BR == 0 && pc < 6) ? KRF + ((size_t)b * 64 + jt) * 1024 + (pc - 4) * 512
                                : VF + ((size_t)bh * 64 + jt) * 2048 + (pc - NQK) * 512;
                __builtin_amdgcn_global_load_lds((const GAS unsigned*)(src + lane * 8), (LAS unsigned*)(ring + slot * TB + pc * 1024), 16, 0, 0);
            }
        }
        if (BR == 1) {
#pragma unroll
            for (int ti = 0; ti < 4; ++ti) { const int jt = 4 * st + ti;
                __builtin_amdgcn_global_load_lds((const GAS unsigned*)(mask + tokq * 64 + (jt <= qt ? jt : qt)), (LAS unsigned*)(mring + ((jt & 7) * 8 + wv) * 256), 4, 0, 0); }
        }
    };
    asm volatile("s_waitcnt vmcnt(0)" ::: "memory");
    __syncthreads();
    issue(0);
    const lf32* nearR = (const lf32*)(lds + L_NEAR) + hb * 256;
    const lf32* biasL = (const lf32*)(lds + L_BIASL) + hb * 32;
#pragma unroll 1
    for (int st = 0; st < NS; ++st) {
        asm volatile("s_waitcnt vmcnt(0)" ::: "memory");
        __builtin_amdgcn_s_barrier();
        if (st + 1 < NS) issue(st + 1);
#pragma unroll 1
        for (int j = 4 * st; j < 4 * st + 4; ++j) {
            if (j > qt) break;
            const lu8* sl = ring + (j & 7) * TB + lane * 16;
            f32x16 S[NMAP];
#pragma unroll
            for (int mp = 0; mp < NMAP; ++mp) { S[mp] = (f32x16){};
#pragma unroll
                for (int ks = 0; ks < NKS; ++ks) S[mp] = mfma32(*(const LAS h16x8*)(sl + (mp * NKS + ks) * 1024), qf[mp * NKS + ks], S[mp]); }
            h16x8 vf[4];
#pragma unroll
            for (int f = 0; f < 4; ++f) vf[f] = *(const LAS h16x8*)(sl + (NQK + f) * 1024);
            const int D0 = (qt - j) * 32;
            if (BR == 0) {
                if (D0 == 0) {
#pragma unroll
                    for (int r = 0; r < 16; ++r) S[0][r] = (CROW(r) + 4 * h > q) ? -3e38f : S[0][r];
                }
            } else if (D0 < 192) {
                const lf32* tp = nearR + (223 - D0 - q + 4 * h);
#pragma unroll
                for (int r = 0; r < 16; ++r) { const float bv = tp[CROW(r)];
#pragma unroll
                    for (int mp = 0; mp < NMAP; ++mp) S[mp][r] += bv; }
            } else {
                const int blo = far_bucket(D0 - 31), bhi = far_bucket(D0 + 31);
                const float lo = biasL[blo], hi = biasL[bhi];
                if (blo == bhi) {
#pragma unroll
                    for (int mp = 0; mp < NMAP; ++mp) S[mp] += lo;
                } else {
                    const int x = D0 + q - 4 * h - far_start(bhi);
#pragma unroll
                    for (int r = 0; r < 16; ++r) { const float bv = (x >= CROW(r)) ? hi : lo;
#pragma unroll
                        for (int mp = 0; mp < NMAP; ++mp) S[mp][r] += bv; }
                }
            }
            if (BR == 1) {
                const unsigned mw = *(const LAS unsigned*)(mring + ((j & 7) * 8 + wv) * 256 + lane * 4) >> (4 * h);
#pragma unroll
                for (int r = 0; r < 16; ++r) S[0][r] = ((mw >> CROW(r)) & 1u) ? S[0][r] : -3e38f;
            }
#pragma unroll
            for (int mp = 0; mp < NMAP; ++mp) {
                softmax_tile(S[mp], m[mp], l[mp], O[mp][0], O[mp][1]);
                const h16x8 p0 = pack8(S[mp], 0), p1 = pack8(S[mp], 1);
                O[mp][0] = mfma32(vf[0], p0, O[mp][0]); O[mp][0] = mfma32(vf[1], p1, O[mp][0]);
                O[mp][1] = mfma32(vf[2], p0, O[mp][1]); O[mp][1] = mfma32(vf[3], p1, O[mp][1]);
            }
        }
    }
    asm volatile("s_waitcnt vmcnt(0)" ::: "memory");
    f32x16 R0, R1;
    if (NMAP == 2) {
        const float lam = *(const lf32*)(lds + L_LAM);
        const float i0 = 1.f / xh_sum(l[0]), i1 = lam / xh_sum(l[NMAP - 1]);
        R0 = O[0][0] * i0 - O[NMAP - 1][0] * i1; R1 = O[0][1] * i0 - O[NMAP - 1][1] * i1;
        float ss = 0.f;
#pragma unroll
        for (int r = 0; r < 16; ++r) ss += R0[r] * R0[r] + R1[r] * R1[r];
        ss = xh_sum(ss);
        const float rs = rsqrtf(ss * (1.f / 64.f) + EPS) * (1.f - lambda_init);
        R0 *= rs; R1 *= rs;
    } else {
        const float il = 1.f / xh_sum(l[0]);
        R0 = O[0][0] * il; R1 = O[0][1] * il;
    }
    const gh16* gp = gate + tokq * 1024 + mixcol + hh * 64 + 4 * h;
#pragma unroll
    for (int db = 0; db < 2; ++db)
#pragma unroll
        for (int g = 0; g < 4; ++g) {
            const h16x4 gv = *(const GAS h16x4*)(gp + db * 32 + 8 * g); h16x4 o;
#pragma unroll
            for (int e = 0; e < 4; ++e) { float v = (db ? R1[4 * g + e] : R0[4 * g + e]) * (float)gv[e];
                if (NMAP == 2) v *= subln[db * 32 + 8 * g + 4 * h + e];
                o[e] = (h16)v; }
            *(GAS h16x4*)(mix + mixf_off(tokq, mixcol + hh * 64 + db * 32 + 8 * g + 4 * h)) = o;
        }
}


DEVI void probe_item(int ntile, int mode) {
    const int lane = otid() & 63;
    h16x8 a, bq;
#pragma unroll
    for (int e = 0; e < 8; ++e) { a[e] = (h16)(lane * 0.001f + e); bq[e] = (h16)(e * 0.01f); }
    f32x16 O0 = {}, O1 = {}; float m = -1e30f, l = 0.f;
#pragma unroll 1
    for (int j = 0; j < ntile; ++j) {
        f32x16 S = {};
#pragma unroll
        for (int ks = 0; ks < 6; ++ks) S = mfma32(a, bq, S);
        if (mode >= 1) softmax_tile(S, m, l, O0, O1);
        const h16x8 p0 = pack8(S, 0), p1 = pack8(S, 1);
        O0 = mfma32(a, p0, O0); O0 = mfma32(a, p1, O0);
        O1 = mfma32(a, p0, O1); O1 = mfma32(a, p1, O1);
    }
    asm volatile("" :: "v"(O0), "v"(O1), "v"(l));
}
DEVI void flashB_tile(const h16x8 (&qf)[4], const gh16* kfr, const gh16* vfr, const lf32* tp, f32x16& O0, f32x16& O1, float& m, float& l, int hot) {
    h16x8 vf[4], kf[4];
#pragma unroll
    for (int f = 0; f < 4; ++f) { kf[f] = *(const GAS h16x8*)(kfr + f * 512); vf[f] = *(const GAS h16x8*)(vfr + f * 512); }
    f32x16 S = {};
#pragma unroll
    for (int ks = 0; ks < 4; ++ks) S = mfma32(kf[ks], qf[ks], S);
    if (hot < 3) {
#pragma unroll
    for (int r = 0; r < 16; ++r) S[r] += tp[CROW(r)];
    }
    softmax_tile_h(S, m, l, O0, O1, hot);
    const h16x8 p0 = pack8(S, 0), p1 = pack8(S, 1);
    if (hot < 4) {
    O0 = mfma32(vf[0], p0, O0); O0 = mfma32(vf[1], p1, O0);
    O1 = mfma32(vf[2], p0, O1); O1 = mfma32(vf[3], p1, O1);
    } else { O0[0] += (float)p0[0] + (float)p1[0]; }
}
DEVI void flashB_item(int b, int hh, int r, int qg, const gh16* Q, const gh16* KF, const gh16* VF, const lu8* lds, const gh16* gate, gh16* mix, int hot = 0) {
    const int lane = otid() & 63, q = lane & 31, h = lane >> 5, bh = b * 4 + hh;
    const size_t tokq = (size_t)b * SEQ + qg * 512 + 16 * q + r;
    h16x8 qf[4];
#pragma unroll
    for (int ks = 0; ks < 4; ++ks) qf[ks] = *(const GAS h16x8*)(Q + tokq * 256 + hh * 64 + ks * 16 + 8 * h);
    f32x16 O0 = {}, O1 = {}; float m = -1e30f, l = 0.f;
    {
        const lf32* R3 = (const lf32*)(lds + L_R3) + hh * 192;
        const size_t base = 2 * FSZ + ((size_t)bh * 16 + r) * 4 * 2048 + lane * 8;
        for (int tl = (qg >= 4 ? qg - 4 : 0); tl <= qg; ++tl) {
            const int c = qg * 32 + q - tl * 32;
            flashB_tile(qf, KF + base + (size_t)(hot ? 0 : tl) * 2048, VF + base + (size_t)(hot ? 0 : tl) * 2048, R3 + (159 - c + 4 * h), O0, O1, m, l, hot);
        }
    }
    {
        const lf32* R2 = (const lf32*)(lds + L_R2) + hh * 384;
        const size_t base = FSZ + ((size_t)bh * 4 + (r & 3)) * 16 * 2048 + lane * 8;
        for (int tl = (qg >= 1 ? qg * 4 - 4 : 0); tl <= qg * 4 + 3; ++tl) {
            const int c = qg * 128 + 4 * q + (r >> 2) - tl * 32;
            flashB_tile(qf, KF + base + (size_t)(hot ? 0 : tl) * 2048, VF + base + (size_t)(hot ? 0 : tl) * 2048, R2 + (255 - c + 4 * h), O0, O1, m, l, hot);
        }
    }
    {
        const lf32* R1 = (const lf32*)(lds + L_R1) + hh * 1152;
        const size_t base = (size_t)bh * 64 * 2048 + lane * 8;
        for (int tl = (qg >= 1 ? qg * 16 - 4 : 0); tl <= qg * 16 + 15; ++tl) {
            const int c = qg * 512 + 16 * q + r - tl * 32;
            flashB_tile(qf, KF + base + (size_t)(hot ? 0 : tl) * 2048, VF + base + (size_t)(hot ? 0 : tl) * 2048, R1 + (639 - c + 4 * h), O0, O1, m, l, hot);
        }
    }
    const float il = 1.f / xh_sum(l);
    const gh16* gp = gate + tokq * 1024 + 256 + hh * 64 + 4 * h;
#pragma unroll
    for (int db = 0; db < 2; ++db)
#pragma unroll
        for (int g = 0; g < 4; ++g) {
            const h16x4 gv = *(const GAS h16x4*)(gp + db * 32 + 8 * g); h16x4 o;
#pragma unroll
            for (int e = 0; e < 4; ++e) o[e] = (h16)((db ? O1[4 * g + e] : O0[4 * g + e]) * il * (float)gv[e]);
            if (!hot) *(GAS h16x4*)(mix + mixf_off(tokq, 256 + hh * 64 + db * 32 + 8 * g + 4 * h)) = o; else asm volatile("" :: "v"(o));
        }
}

typedef float f32x4v __attribute__((ext_vector_type(4)));
typedef unsigned u32x4v __attribute__((ext_vector_type(4)));
DEVI f32x4v mfma16(h16x8 a, h16x8 b, f32x4v c) { return __builtin_amdgcn_mfma_f32_16x16x32_f16(a, b, c, 0, 0, 0); }
constexpr int TK_KSTRIDE = 2308;
constexpr int TK_KEYS = 0, TK_MISC = 16 * TK_KSTRIDE * 4, TK_END = TK_MISC + 64;
DEVI void topk_item(int b, int T16, const gh16* idx, const gh16* KIF, gu32* mask, lu8* lds, int skip = 0) {
    const int tid = otid(), lane = tid & 63, wv = __builtin_amdgcn_readfirstlane(tid >> 6);
    const int t0 = T16 * 16;
    lu32* keys = (lu32*)(lds + TK_KEYS);
    if (T16 < 16) {
        const int sq = tid & 15, sc_ = tid >> 4;
        const unsigned tk = (unsigned)(b * SEQ + t0 + sq) * 64u + 2u * sc_;
        unsigned ones = 0xffffffffu; asm volatile("" : "+v"(ones));
        if (sc_ < 4) { mask[tk] = ones; mask[tk + 1] = ones; }
        return;
    }
    __syncthreads();
    if (skip == 2) return;
    {
        const int q = lane & 15, kq = lane >> 4;
        const size_t tokq = (size_t)b * SEQ + t0 + q;
        h16x8 qf[8], ql; float sg[8]; float P = 0.f, N = 0.f; float lin[8];
#pragma unroll
        for (int e = 0; e < 8; ++e) lin[e] = 0.f;
#pragma unroll
        for (int hd = 0; hd < 8; ++hd) {
            const h16x8 raw = *(const GAS h16x8*)(idx + tokq * 320 + hd * 32 + 8 * kq);
            const float c = (float)idx[tokq * 320 + 288 + hd] * (0.5f * 0.35355339059327373f), ac = fabsf(c);
            float nn = 0.f;
#pragma unroll
            for (int e = 0; e < 8; ++e) { const float v = (float)raw[e]; nn += v * v; lin[e] += c * v; qf[hd][e] = (h16)(ac * v); }
            nn += __shfl_xor(nn, 16); nn += __shfl_xor(nn, 32);
            const float bd = 2.f * ac * sqrtf(nn) * 12.f;
            if (c > 0.f) P += bd; else N += bd;
            sg[hd] = c >= 0.f ? 1.f : -1.f;
        }
#pragma unroll
        for (int e = 0; e < 8; ++e) ql[e] = (h16)lin[e];
        const float lo = -N, scl = 2097151.f / fmaxf(P + N, 1e-20f);
        const int nblk = T16 + 1, nblk2 = (nblk + 1) & ~1;
#pragma unroll 1
        for (int rpS = 0; rpS < (DUP_PHASE == 7 ? 2 : 1); ++rpS)
        for (int kb0 = wv; kb0 < nblk2; kb0 += 32) {
            h16x8 kf4[4];
#pragma unroll
            for (int u = 0; u < 4; ++u) { const int kb = kb0 + 8 * u < nblk ? kb0 + 8 * u : 0; kf4[u] = *(const GAS h16x8*)(KIF + ((size_t)(b * 128 + kb) * 64 + lane) * 8); }
#pragma unroll
            for (int u = 0; u < 4; ++u) {
                const int kb = kb0 + 8 * u;
                if (kb < nblk2) {
                    const h16x8 kf = kf4[u];
                    f32x4v sc = mfma16(kf, ql, (f32x4v){0.f, 0.f, 0.f, 0.f});
#pragma unroll
                    for (int hd = 0; hd < 8; ++hd) { const f32x4v x = mfma16(kf, qf[hd], (f32x4v){0.f, 0.f, 0.f, 0.f});
#pragma unroll
                        for (int r = 0; r < 4; ++r) sc[r] = __builtin_fmaf(__builtin_fabsf(x[r]), sg[hd], sc[r]); }
                    u32x4v kv;
#pragma unroll
                    for (int r = 0; r < 4; ++r) { const float x = fminf(fmaxf((sc[r] - lo) * scl, 0.f), 2097151.f); unsigned uu = (unsigned)x + 1u;
                        if (16 * kb + 4 * kq + r > t0 + q) uu = 0u; kv[r] = uu; }
                    const int k = 16 * kb + 4 * kq;
                    *(LAS u32x4v*)(keys + q * TK_KSTRIDE + k + 4 * (k >> 5)) = kv;
                }
            }
        }
    }
    __syncthreads();
    if (skip == 1) return;
    const int nw32 = (t0 + 16 + 31) >> 5;
    unsigned ka[32], kc[32];
    {
        const lu32* ra = keys + (2 * wv) * TK_KSTRIDE + 36 * lane, * rc = keys + (2 * wv + 1) * TK_KSTRIDE + 36 * lane;
        const bool have = lane < nw32;
#pragma unroll
        for (int i = 0; i < 8; ++i) {
            u32x4v va = {0u, 0u, 0u, 0u}, vc = {0u, 0u, 0u, 0u};
            if (have) { va = *(const LAS u32x4v*)(ra + 4 * i); vc = *(const LAS u32x4v*)(rc + 4 * i); }
#pragma unroll
            for (int r = 0; r < 4; ++r) { ka[4 * i + r] = va[r]; kc[4 * i + r] = vc[r]; }
        }
    }
    typedef unsigned short u16x2 __attribute__((ext_vector_type(2)));
    u16x2 kha[16], khc[16];
#pragma unroll
    for (int i = 0; i < 16; ++i) { kha[i] = (u16x2){(unsigned short)(ka[2 * i] >> 7), (unsigned short)(ka[2 * i + 1] >> 7)}; khc[i] = (u16x2){(unsigned short)(kc[2 * i] >> 7), (unsigned short)(kc[2 * i + 1] >> 7)}; }
    auto wave_sum2 = [&](unsigned v) -> unsigned {
        v += (unsigned)__builtin_amdgcn_update_dpp(0, (int)v, 0x111, 0xf, 0xf, false);
        v += (unsigned)__builtin_amdgcn_update_dpp(0, (int)v, 0x112, 0xf, 0xf, false);
        v += (unsigned)__builtin_amdgcn_update_dpp(0, (int)v, 0x114, 0xf, 0xf, false);
        v += (unsigned)__builtin_amdgcn_update_dpp(0, (int)v, 0x118, 0xf, 0xf, false);
        v += (unsigned)__builtin_amdgcn_update_dpp(0, (int)v, 0x142, 0xa, 0xf, false);
        v += (unsigned)__builtin_amdgcn_update_dpp(0, (int)v, 0x143, 0xc, 0xf, false);
        return (unsigned)__builtin_amdgcn_readlane((int)v, 63);
    };
    auto count2 = [&](unsigned Pa, unsigned Pc) -> unsigned {
        const unsigned short pa1 = (unsigned short)(Pa - 1u), pc1 = (unsigned short)(Pc - 1u);
        u16x2 aa = {0, 0}, ac = {0, 0};
#pragma unroll
        for (int i = 0; i < 16; ++i) { aa += ((u16x2){pa1, pa1} - kha[i]) >> 15; ac += ((u16x2){pc1, pc1} - khc[i]) >> 15; }
        return wave_sum2(((unsigned)aa[0] + (unsigned)aa[1]) | (((unsigned)ac[0] + (unsigned)ac[1]) << 16));
    };
    unsigned T15a = 0u, T15c = 0u;
#pragma unroll 1
    for (int bit = 14; bit >= 0; --bit) { const unsigned Pa = T15a | (1u << bit), Pc = T15c | (1u << bit); const unsigned c = count2(Pa, Pc);
        if ((c & 0xffffu) >= 256u) T15a = Pa;
        if ((c >> 16) >= 256u) T15c = Pc; }
    const unsigned cab = count2(T15a + 1u, T15c + 1u);
    unsigned Tq[2];
#pragma unroll
    for (int qq = 0; qq < 2; ++qq) {
        const unsigned T15 = qq ? T15c : T15a; const int above = (int)(qq ? (cab >> 16) : (cab & 0xffffu));
        unsigned c0 = 0u, c1 = 0u, nc = 0u;
#pragma unroll
        for (int i = 0; i < 32; ++i) { const unsigned k = qq ? kc[i] : ka[i]; const bool is = (k >> 7) == T15 && k != 0u; const unsigned v = (k & 127u) + 1u;
            c1 = (is && nc == 1u) ? v : c1; c0 = (is && nc == 0u) ? v : c0; nc += is ? 1u : 0u; }
        unsigned low = 0u;
        if (__ballot(nc > 2u) == 0ull) {
#pragma unroll 1
            for (int bit = 6; bit >= 0; --bit) { const unsigned P = low | (1u << bit);
                const unsigned lc = (c0 > P ? 1u : 0u) + (c1 > P ? 1u : 0u);
                const int c = above + __builtin_popcountll(__ballot(lc & 1u)) + 2 * __builtin_popcountll(__ballot(lc >> 1));
                if (c >= 256) low = P; }
        } else {
#pragma unroll 1
            for (int bit = 6; bit >= 0; --bit) { const unsigned P = (T15 << 7) | low | (1u << bit);
                unsigned lc = 0u;
#pragma unroll
                for (int i = 0; i < 32; ++i) lc += ((qq ? kc[i] : ka[i]) >= P) ? 1u : 0u;
                int c = 0;
#pragma unroll
                for (int bp = 0; bp < 6; ++bp) c += __builtin_popcountll(__ballot((lc >> bp) & 1u)) << bp;
                if (c >= 256) low |= (1u << bit); }
        }
        Tq[qq] = (T15 << 7) | low;
    }
    const unsigned Ta = Tq[0], Tc = Tq[1];
#pragma unroll
    for (int qq = 0; qq < 2; ++qq) {
        const unsigned T = qq ? Tc : Ta;
        unsigned gt = 0u, eq = 0u;
#pragma unroll
        for (int i = 31; i >= 0; --i) { const unsigned k = qq ? kc[i] : ka[i]; gt = (gt << 1) | (k > T ? 1u : 0u); eq = (eq << 1) | (k == T ? 1u : 0u); }
        const unsigned pcg = (unsigned)__builtin_popcount(gt), pce = (unsigned)__builtin_popcount(eq);
        int totg = 0, before = 0;
#pragma unroll
        for (int bp = 0; bp < 6; ++bp) {
            totg += __builtin_popcountll(__ballot((pcg >> bp) & 1u)) << bp;
            const unsigned long long mk = __ballot((pce >> bp) & 1u);
            before += (int)__builtin_amdgcn_mbcnt_hi((unsigned)(mk >> 32), __builtin_amdgcn_mbcnt_lo((unsigned)mk, 0u)) << bp;
        }
        const int R = 256 - totg;
        int allow = R - before; allow = allow < 0 ? 0 : (allow > pce ? pce : allow);
        unsigned keep = eq;
        if (allow < pce) { keep = 0u; unsigned e = eq; for (int c = 0; c < allow; ++c) { const unsigned bit = e & (0u - e); keep |= bit; e ^= bit; } }
        if (lane < nw32) mask[((size_t)b * SEQ + t0 + 2 * wv + qq) * 64 + lane] = gt | keep;
    }
}
DEVI void ph_topk(const gh16* idx, const gh16* KIF, gu32* mask, gu32* ctr, lu8* lds, int nrep) {
    lu32* slot = (lu32*)(lds + TK_MISC);
    const bool lead = otid() == 0;
    __syncthreads();
    if (lead) *slot = __hip_atomic_fetch_add(ctr, 1u, __ATOMIC_RELAXED, __HIP_MEMORY_SCOPE_AGENT);
    __syncthreads();
    int e = (int)*slot;
#pragma unroll 1
    while (e < 1024 * nrep) {
        unsigned nxt = 0u;
        if (lead) nxt = __hip_atomic_fetch_add(ctr, 1u, __ATOMIC_RELAXED, __HIP_MEMORY_SCOPE_AGENT);
        const int e2 = e & 1023;
        topk_item(e2 & 7, 127 - (e2 >> 3), idx, KIF, mask, lds, (DUP_PHASE >= 30 && e >= 1024) ? DUP_PHASE - 29 : 0);
        __syncthreads();
        if (lead) *slot = nxt;
        __syncthreads();
        e = (int)*slot;
    }
}

DEVI void ph_out(const gh16* mix, const gh16* WoT, const gf32* __restrict__ gpost, const gf32* h_in, gf32* h_out, gh16* h16o, gf32* rstd_next, bool write_next, lu8* lds) {
    const int tid = otid(), lane = tid & 63, q = lane & 31, h = lane >> 5, wv = __builtin_amdgcn_readfirstlane(tid >> 6);
    lf32* red = (lf32*)lds;
    for (int u = blockIdx.x; u < NT / 64; u += gridDim.x) {
        f32x16 acc[4][2];
#pragma unroll
        for (int rb = 0; rb < 4; ++rb) { acc[rb][0] = (f32x16){}; acc[rb][1] = (f32x16){}; }
        const gh16* apu = WoT + (size_t)(wv * 4) * 64 * 512;
        const gh16* bpu = mix + (size_t)(u * 2) * 64 * 512;
        const unsigned lo8 = lane * 8;
#define ap(off) (apu + (off) + lo8)
#define bp(off) (bpu + (off) + lo8)
        h16x8 a0[4], b0[2], a1[4], b1[2], a2[4], b2[2];
#define P3_LOAD(A, B, ks_) do { const int ko_ = ((ks_) < 64 ? (ks_) : 63) * 512; _Pragma("unroll") for (int rb = 0; rb < 4; ++rb) A[rb] = *(const GAS h16x8*)(ap(rb * 64 * 512 + ko_)); \
        _Pragma("unroll") for (int tb = 0; tb < 2; ++tb) B[tb] = *(const GAS h16x8*)(bp(tb * 64 * 512 + ko_)); } while (0)
#define P3_MMA(A, B) do { _Pragma("unroll") for (int rb = 0; rb < 4; ++rb) _Pragma("unroll") for (int tb = 0; tb < 2; ++tb) acc[rb][tb] = mfma32(A[rb], B[tb], acc[rb][tb]); } while (0)
        P3_LOAD(a0, b0, 0); P3_LOAD(a1, b1, 1);
#pragma unroll 1
        for (int ks = 0; ks < 63; ks += 3) {
            P3_LOAD(a2, b2, ks + 2); __builtin_amdgcn_sched_barrier(0); P3_MMA(a0, b0); __builtin_amdgcn_sched_barrier(0);
            P3_LOAD(a0, b0, ks + 3); __builtin_amdgcn_sched_barrier(0); P3_MMA(a1, b1); __builtin_amdgcn_sched_barrier(0);
            P3_LOAD(a1, b1, ks + 4); __builtin_amdgcn_sched_barrier(0); P3_MMA(a2, b2); __builtin_amdgcn_sched_barrier(0);
        }
        P3_MMA(a0, b0);
#undef P3_LOAD
#undef P3_MMA
#undef ap
#undef bp
        int qe = q, he = h; asm volatile("" : "+v"(qe), "+v"(he));
        __syncthreads();
#pragma unroll
        for (int tb = 0; tb < 2; ++tb) {
            float ss = 0.f;
#pragma unroll
            for (int rb = 0; rb < 4; ++rb)
#pragma unroll
                for (int r = 0; r < 16; ++r) ss += acc[rb][tb][r] * acc[rb][tb][r];
            ss = xh_sum(ss);
            if (he == 0) red[wv * 64 + tb * 32 + qe] = ss;
        }
        __syncthreads();
        float ssn[2] = {0.f, 0.f};
#pragma unroll
        for (int tb = 0; tb < 2; ++tb) {
            float tot = 0.f;
#pragma unroll
            for (int w2 = 0; w2 < 8; ++w2) tot += red[w2 * 64 + tb * 32 + qe];
            const float rs = rsqrtf(tot * (1.f / DM) + EPS);
            const size_t rowoff = (size_t)(u * 64 + tb * 32 + qe) * DM;
#pragma unroll
            for (int rb = 0; rb < 4; ++rb)
#pragma unroll
                for (int g = 0; g < 4; ++g) {
                    const int n = wv * 128 + rb * 32 + 8 * g + 4 * he;
                    const f32x4_t hv = *(const GAS f32x4_t*)(h_in + rowoff + n), gv = *(const GAS f32x4_t*)(gpost + n);
                    f32x4_t o;
                    o[0] = hv[0] + acc[rb][tb][4 * g + 0] * rs * gv[0]; o[1] = hv[1] + acc[rb][tb][4 * g + 1] * rs * gv[1];
                    o[2] = hv[2] + acc[rb][tb][4 * g + 2] * rs * gv[2]; o[3] = hv[3] + acc[rb][tb][4 * g + 3] * rs * gv[3];
                    *(GAS f32x4_t*)(h_out + rowoff + n) = o;
                    if (write_next) { h16x4 oh; oh[0] = (h16)o[0]; oh[1] = (h16)o[1]; oh[2] = (h16)o[2]; oh[3] = (h16)o[3]; *(GAS h16x4*)(h16o + rowoff + n) = oh;
                        ssn[tb] += o[0] * o[0] + o[1] * o[1] + o[2] * o[2] + o[3] * o[3]; }
                }
        }
        if (write_next) {
#pragma unroll
            for (int tb = 0; tb < 2; ++tb) { const float v = xh_sum(ssn[tb]); if (he == 0) red[512 + wv * 64 + tb * 32 + qe] = v; }
            __syncthreads();
            if (tid < 64) { float tot = 0.f;
#pragma unroll
                for (int w2 = 0; w2 < 8; ++w2) tot += red[512 + w2 * 64 + tid];
                rstd_next[u * 64 + tid] = rsqrtf(tot * (1.f / DM) + EPS); }
        }
    }
}

DEVI void mla_item(int it, const gh16* cA, const gh16* WuqT, const gh16* WukvT, const gf32* cosT, const gf32* sinT, gh16* qA, gh16* KFA, gh16* KRF, gh16* VFA) {
    const int lane = otid() & 63, q = lane & 31, h = lane >> 5;
    const size_t tok = (size_t)it * 32 + q; const int b = it >> 6, j = it & 63, s = j * 32 + q;
    const float qs = 0.10206207261596577f * LOG2E;
    {
        h16x8 cf[12]; float ss = 0.f;
#pragma unroll
        for (int ks = 0; ks < 12; ++ks) { cf[ks] = *(const GAS h16x8*)(cA + tok * 384 + ks * 16 + 8 * h);
#pragma unroll
            for (int e = 0; e < 8; ++e) { const float v = (float)cf[ks][e]; ss += v * v; } }
        const float rs = rsqrtf(xh_sum(ss) * (1.f / 192.f) + EPS) * qs;
#pragma unroll 1
        for (int nb = 0; nb < 12; ++nb) {
            f32x16 acc = {};
            const gh16* wp = WuqT + (size_t)nb * 12 * 512 + lane * 8;
#pragma unroll
            for (int ks = 0; ks < 12; ++ks) acc = mfma32(*(const GAS h16x8*)(wp + ks * 512), cf[ks], acc);
            acc *= rs;
            const int hh = nb / 3, part = nb % 3;
            if (part == 2) {
#pragma unroll
                for (int r = 0; r < 8; ++r) { const int i = CROW(r) + 4 * h; const float c = cosT[s * 16 + i], sn = sinT[s * 16 + i], x1 = acc[r], x2 = acc[r + 8];
                    acc[r] = x1 * c - x2 * sn; acc[r + 8] = x1 * sn + x2 * c; }
            }
            gh16* op = qA + tok * 384 + hh * 96 + part * 32 + 4 * h;
#pragma unroll
            for (int g = 0; g < 4; ++g) { h16x4 o; o[0] = (h16)acc[4 * g]; o[1] = (h16)acc[4 * g + 1]; o[2] = (h16)acc[4 * g + 2]; o[3] = (h16)acc[4 * g + 3]; *(GAS h16x4*)(op + 8 * g) = o; }
        }
    }
    {
        h16x8 cf[8]; float ss = 0.f;
#pragma unroll
        for (int ks = 0; ks < 8; ++ks) { cf[ks] = *(const GAS h16x8*)(cA + tok * 384 + 192 + ks * 16 + 8 * h);
#pragma unroll
            for (int e = 0; e < 8; ++e) { const float v = (float)cf[ks][e]; ss += v * v; } }
        const float rs = rsqrtf(xh_sum(ss) * (1.f / 128.f) + EPS);
#pragma unroll
        for (int ks = 0; ks < 8; ++ks)
#pragma unroll
            for (int e = 0; e < 8; ++e) cf[ks][e] = (h16)((float)cf[ks][e] * rs);
#pragma unroll 1
        for (int nb = 0; nb < 16; ++nb) {
            const int hh = nb >> 2, sub = nb & 3, bh = b * 4 + hh;
            const gh16* wp = WukvT + (size_t)nb * 8 * 512 + lane * 8;
            f32x16 acc = {};
            if (sub < 2) {
#pragma unroll
                for (int ks = 0; ks < 8; ++ks) acc = mfma32(*(const GAS h16x8*)(wp + ks * 512), cf[ks], acc);
#pragma unroll
                for (int g = 0; g < 4; ++g) { h16x4 o; o[0] = (h16)acc[4 * g]; o[1] = (h16)acc[4 * g + 1]; o[2] = (h16)acc[4 * g + 2]; o[3] = (h16)acc[4 * g + 3];
                    *(GAS h16x4*)(KFA + ((((size_t)bh * 64 + j) * 4 + 2 * sub + (g >> 1)) * 64 + q + 32 * (g & 1)) * 8 + 4 * h) = o; }
            } else {
#pragma unroll
                for (int ks = 0; ks < 8; ++ks) acc = mfma32(cf[ks], *(const GAS h16x8*)(wp + ks * 512), acc);
#pragma unroll
                for (int sk = 0; sk < 2; ++sk) { h16x8 o;
#pragma unroll
                    for (int e = 0; e < 8; ++e) o[e] = (h16)acc[8 * sk + e];
                    *(GAS h16x8*)(VFA + ((((size_t)bh * 64 + j) * 4 + (sub - 2) * 2 + sk) * 64 + lane) * 8) = o; }
            }
        }
    }
    {
        const h16x8 a = *(const GAS h16x8*)(cA + tok * 384 + 320 + 8 * h), c2 = *(const GAS h16x8*)(cA + tok * 384 + 336 + 8 * h);
        h16x8 o1, o2;
#pragma unroll
        for (int e = 0; e < 8; ++e) { const int i = 8 * h + e; const float c = cosT[s * 16 + i], sn = sinT[s * 16 + i], x1 = (float)a[e], x2 = (float)c2[e];
            o1[e] = (h16)(x1 * c - x2 * sn); o2[e] = (h16)(x1 * sn + x2 * c); }
        *(GAS h16x8*)(KRF + (((size_t)b * 64 + j) * 2 + 0) * 512 + lane * 8) = o1; *(GAS h16x8*)(KRF + (((size_t)b * 64 + j) * 2 + 1) * 512 + lane * 8) = o2;
    }
}
DEVI void ph_small_weights(const gf32* w_uq, const gf32* qn, const gf32* w_ukv, const gf32* kvn, gh16* WuqF, gh16* WukvF) {
    const int gt = blockIdx.x * NTHR + otid(), nthr = gridDim.x * NTHR;
    for (int i = gt; i < 2 * 12 * 12 * 64; i += nthr) { const int lane = i & 63, ks = (i >> 6) % 12, nb = (i / (64 * 12)) % 12, l = i / (64 * 144);
        h16x8 o;
#pragma unroll
        for (int e = 0; e < 8; ++e) { const int k = 16 * ks + 8 * (lane >> 5) + e; o[e] = (h16)(w_uq[(size_t)l * 192 * 384 + k * 384 + nb * 32 + (lane & 31)] * qn[l * 192 + k]); }
        *(GAS h16x8*)(WuqF + (size_t)i * 8) = o; }
    for (int i = gt; i < 2 * 16 * 8 * 64; i += nthr) { const int lane = i & 63, ks = (i >> 6) & 7, nb = (i >> 9) & 15, l = i >> 13;
        h16x8 o;
#pragma unroll
        for (int e = 0; e < 8; ++e) { const int k = 16 * ks + 8 * (lane >> 5) + e; o[e] = (h16)(w_ukv[(size_t)l * 128 * 512 + k * 512 + nb * 32 + (lane & 31)] * kvn[l * 128 + k]); }
        *(GAS h16x8*)(WukvF + (size_t)i * 8) = o; }
}

constexpr int LDS_BYTES = 160 * 1024;
struct Params { const float* in[12]; float* out; unsigned char* ws; };

DEVI void ph_tables(const gf32* __restrict__ rel_bias, gf32* biasTab, gf32* cosT, gf32* sinT) {
    for (int i = blockIdx.x * NTHR + threadIdx.x; i < 2048 * 16; i += gridDim.x * NTHR) {
        if (i < 12 * 2048) { int hh = i / 2048, n = i % 2048; biasTab[i] = rel_bias[t5_bucket(n) * 12 + hh] * LOG2E; }
        int pos = i / 16, j = i % 16;
        float inv = (float)pow(10000.0, -(double)(2 * j) / 32.0);
        float ang = (float)pos * inv;
        cosT[i] = (float)cos((double)ang); sinT[i] = (float)sin((double)ang);
    }
}

extern __shared__ __attribute__((aligned(16))) unsigned char smem[];
constexpr int LDS_BAR_OFF = 160 * 1024 - 16;

#define REP(k) for (int rep_ = 0; rep_ < ((DUP_PHASE == (k)) ? 2 : 1); ++rep_)
DEVI gu8* ows(unsigned char* w0) { gu8* w = (gu8*)w0; asm volatile("" : "+s"(w)); return w; }
#define WSP(T, off) ((GAS T*)(w + (off)))
#define OSP(T, off) ((GAS T*)(wo + (off)))
#define GIN(k) ((const gf32*)p.in[k])

__global__ void __launch_bounds__(NTHR, 2) mega(Params p) {
    if (threadIdx.x == 0) *(uint4*)(smem + LDS_BAR_OFF) = make_uint4(0u, 0u, 0u, 0u);
    __syncthreads();
    XcdBarrier bar = xcd_barrier_post((unsigned*)(p.ws + OFF_CTL), (volatile LAS unsigned*)(smem + LDS_BAR_OFF));
    lu8* lds = (lu8*)smem;
    const int nw = gridDim.x * NWAVE;

    REP(1) {
        gu8* w = ows(p.ws);
        ph_tables(GIN(11), WSP(float, OFF_BIAS), WSP(float, OFF_COS), WSP(float, OFF_SIN));
        int base = 0; const int total = 2 * (64 * 16) + 2 * (16 * 16);
        cvt_transpose<true>(GIN(1), INC, GIN(3), WSP(h16, OFF_WINT), MYC, DM, lds, blockIdx.x, total, base);
        cvt_transpose<true>(GIN(1) + (size_t)DM * INC, INC, GIN(3) + DM, WSP(h16, OFF_WINT) + (size_t)MYC * DM, MYC, DM, lds, blockIdx.x, total, base);
        cvt_transpose<false>(GIN(2), DM, nullptr, WSP(h16, OFF_WOUTT), DM, DM, lds, blockIdx.x, total, base);
        cvt_transpose<false>(GIN(2) + (size_t)DM * DM, DM, nullptr, WSP(h16, OFF_WOUTT) + (size_t)DM * DM, DM, DM, lds, blockIdx.x, total, base);
        ph_small_weights(GIN(7), GIN(5), GIN(8), GIN(6), WSP(h16, OFF_WUQT), WSP(h16, OFF_WUKVT));
        ph_rowstat_cvt(GIN(0), WSP(float, OFF_SSQH), WSP(h16, OFF_H16));
    }
    xcd_barrier(bar);
    for (int layer = 0; layer < 2; ++layer) {
        const float lambda_init = layer == 0 ? 0.2f : 0.35550906759f;
        REP(2) {
            if (rep_) xcd_barrier(bar);
            gu8* w = ows(p.ws);
            pg8::Gemm g{(const pg8::bf16_t*)(p.ws + OFF_H16), (const pg8::bf16_t*)(p.ws + OFF_WINT) + (size_t)layer * MYC * DM, NT, MYC, DM};
            int bid_ = (int)blockIdx.x; asm volatile("" : "+s"(bid_));
            pg8::StaticOrder S; S.init(NT, MYC, (int)gridDim.x, bid_);
            EpiRoute E{w, WSP(float, OFF_SSQH)};
            pg8::gemm_phase<EpiRoute, pg8::StaticOrder, true, true>(lds, g, S, E);
        }
        xcd_barrier(bar);
        REP(3) {
            gu8* w = ows(p.ws); gu8* wo = ows((unsigned char*)p.out);
            for (int it = ogw(); it < NT / 32; it += nw) mla_item(it, WSP(h16, OFF_CA), WSP(h16, OFF_WUQT) + (size_t)layer * 384 * 192, WSP(h16, OFF_WUKVT) + (size_t)layer * 512 * 128, WSP(float, OFF_COS), WSP(float, OFF_SIN), OSP(h16, OUT_QA), OSP(h16, OUT_KFA), OSP(h16, OUT_KRF), OSP(h16, OUT_VFA));
        }
        {
            gu8* w = ows(p.ws);
            ph_topk(WSP(h16, OFF_IDX), WSP(h16, OFF_KIF), WSP(unsigned, OFF_MASK), WSP(unsigned, OFF_CTL) + 3600 + 16 * (40 + layer), lds, (DUP_PHASE == 4 || DUP_PHASE >= 30) ? 2 : 1);
        }
        REP(3) {
            gu8* w = ows(p.ws);
            ph_vtrans(WSP(h16, OFF_VTMP), WSP(h16, OFF_VF), lds);
        }
        xcd_barrier(bar);
        for (int rep_ = 0; rep_ < ((DUP_PHASE == 5 || DUP_PHASE >= 10) ? 2 : 1); ++rep_) {
            if (rep_) xcd_barrier(bar);
            const int hot_ = (DUP_PHASE >= 10 && rep_) ? DUP_PHASE - 9 : 0;
            gu8* w = ows(p.ws); gu8* wo = ows((unsigned char*)p.out);
            p2_setup(WSP(float, OFF_BIAS), GIN(9) + layer * 128, lambda_init, lds);
            if (DUP_PHASE >= 20 && rep_) { probe_item(130, DUP_PHASE - 20); continue; }
            const int xcc = (int)(xb_xcc_id() & 7u);
            for (int dq = 0; dq < 8; ++dq) {
                const int bq = (xcc + dq) & 7;
                gu32* ctr = WSP(unsigned, OFF_CTL) + 3600 + 16 * (bq + 8 * layer + 16 * rep_);
                for (;;) { const int e = wq_next(ctr); if (e >= 768) break;
                    if (e >= 512) { const int e2 = e - 512, hh = e2 >> 6, lvl = e2 & 63;
                        flashB_item(bq, hh, lvl & 15, lvl >> 4, WSP(h16, OFF_QB), WSP(h16, OFF_KFB), WSP(h16, OFF_VF), lds, WSP(h16, OFF_GATE), WSP(h16, OFF_MIX), hot_); }
                    else if (e >= 384) { const int e2 = e - 384, hh = e2 >> 5, pr = 31 - (e2 & 31);
                        flashQ2_item<0>(bq, hh, pr, OSP(h16, OUT_QA), OSP(h16, OUT_KFA), OSP(h16, OUT_KRF), OSP(h16, OUT_VFA), nullptr, WSP(float, OFF_BIAS), lds, WSP(h16, OFF_GATE), WSP(h16, OFF_MIX), 0, 0, hot_); }
                    else if (e >= 256) { const int e2 = e - 256, hh = e2 >> 5, pr = 31 - (e2 & 31);
                        flashQ2_item<1>(bq, hh, pr, WSP(h16, OFF_QC), WSP(h16, OFF_KFC), nullptr, WSP(h16, OFF_VF) + 3 * FSZ, WSP(unsigned, OFF_MASK), WSP(float, OFF_BIAS), lds, WSP(h16, OFF_GATE), WSP(h16, OFF_MIX), 512, 4 + hh, hot_); }
                    else { const int hh = e >> 6, lvl = 63 - (e & 63);
                        flashCD_item<2, false>(bq, hh, lvl, 8 + hh, WSP(h16, OFF_QD), WSP(h16, OFF_KFD), WSP(h16, OFF_VF) + 4 * FSZ, nullptr, WSP(float, OFF_BIAS), lds,
                                               GIN(10) + layer * 64, lambda_init, WSP(h16, OFF_GATE), WSP(h16, OFF_MIX), 768, hot_); }
                }
            }
        }
        xcd_barrier(bar);
        for (int rep_ = 0; rep_ < ((DUP_PHASE == 6 && layer == 0) ? 2 : 1); ++rep_) {
            if (rep_) xcd_barrier(bar);
            gu8* w = ows(p.ws);
int bid_ = (int)blockIdx.x; asm volatile("" : "+s"(bid_));
            pg8::Gemm g{(const pg8::bf16_t*)(p.ws + OFF_MIX), (const pg8::bf16_t*)(p.ws + OFF_WOUTT) + (size_t)layer * DM * DM, NT, DM, DM};
            pg8::StaticOrder S; S.init(NT, DM, (int)gridDim.x, bid_);
            EpiOut E{(gf32*)p.out, WSP(h16, OFF_H16), GIN(4) + layer * DM, WSP(float, OFF_SSQY), WSP(float, OFF_SSQH), &bar, layer == 0};
            pg8::gemm_phase<EpiOut, pg8::StaticOrder, false, true>(lds, g, S, E);
        }
        xcd_barrier(bar);
    }
}

extern "C" void kernel_launch(void* const* d_in, const int* in_sizes, int n_in, void* d_out, int out_size, void* d_ws, size_t ws_size, hipStream_t stream) {
    static int grid = 0;
    if (grid == 0) {
        int dev = 0, cus = 0, per_cu = 0;
        (void)hipGetDevice(&dev);
        (void)hipDeviceGetAttribute(&cus, hipDeviceAttributeMultiprocessorCount, dev);
        (void)hipFuncSetAttribute((const void*)mega, hipFuncAttributeMaxDynamicSharedMemorySize, LDS_BYTES);
        (void)hipOccupancyMaxActiveBlocksPerMultiprocessor(&per_cu, (const void*)mega, NTHR, LDS_BYTES);
        (void)hipGetLastError();
        grid = (cus > 0 && cus < 256) ? cus : 256;
    }
    (void)hipMemsetAsync((char*)d_ws + OFF_CTL, 0, 32768, stream);
    Params p{};
    for (int i = 0; i < 12; ++i) p.in[i] = (const float*)d_in[i];
    p.out = (float*)d_out; p.ws = (unsigned char*)d_ws;
    hipLaunchKernelGGL(mega, dim3(grid), dim3(NTHR), LDS_BYTES, stream, p);
}
```

```cpp
#include <hip/hip_runtime.h>
#include <stdint.h>
#include <math.h>

#ifndef DUP_PHASE
#define DUP_PHASE 0
#endif
#ifndef P0_DUP
#define P0_DUP 0
#endif
typedef _Float16 h16;
#define GAS __attribute__((address_space(1)))
#define LAS __attribute__((address_space(3)))
typedef GAS h16 gh16; typedef GAS float gf32; typedef GAS unsigned gu32; typedef GAS unsigned char gu8;
typedef LAS h16 lh16; typedef LAS float lf32; typedef LAS unsigned lu32; typedef LAS unsigned char lu8;
#define DEVI __device__ __forceinline__
DEVI int ogw();
DEVI int otid() { int t = threadIdx.x; asm volatile("" : "+v"(t)); return t; }
DEVI float shflx(float v, int m) { const int l = (otid() & 63) ^ m; return __int_as_float(__builtin_amdgcn_ds_bpermute(l << 2, __float_as_int(v))); }

constexpr int NB = 8, SEQ = 2048, DM = 1024, NT = NB * SEQ, INC = 3976, MYC = 4096;
constexpr float LOG2E = 1.4426950408889634f;
constexpr float EPS = 1e-6f;

DEVI int ogw() { return blockIdx.x * 8 + (otid() >> 6); }
__host__ __device__ constexpr int ref_col(int my) {
    if (my < 352) return my;
    if (my < 384) return -1;
    if (my < 640) return 352 + (my - 384);
    if (my < 896) return 1376 + (my - 640);
    if (my < 1152) return 2696 + (my - 896);
    if (my < 1408) return 3720 + (my - 1152);
    if (my < 1664) return 608 + (my - 1408);
    if (my < 1920) return 864 + (my - 1664);
    if (my < 2176) return 1632 + (my - 1920);
    if (my < 2432) return 1888 + (my - 2176);
    if (my < 2688) return 2952 + (my - 2432);
    if (my < 2944) return 3208 + (my - 2688);
    if (my < 3200) return 1120 + (my - 2944);
    if (my < 3456) return 2144 + (my - 3200);
    if (my < 3712) return 3464 + (my - 3456);
    if (my < 3968) return 2400 + (my - 3712);
    if (my < 4000) return 2656 + (my - 3968);
    if (my < 4008) return 2688 + (my - 4000);
    return -1;
}

constexpr size_t MiB = 1024 * 1024;
constexpr size_t OFF_CTL = 0;
constexpr size_t OFF_RSTD = 64 * 1024;
constexpr size_t OFF_BIAS = 128 * 1024;
constexpr size_t OFF_COS = 256 * 1024;
constexpr size_t OFF_SIN = 384 * 1024;
constexpr size_t OFF_SSQY = 512 * 1024;
constexpr size_t OFF_SSQH = 768 * 1024;
constexpr size_t OFF_CA = 1 * MiB;
constexpr size_t OFF_GATE = OFF_CA + 12 * MiB;
constexpr size_t OFF_QB = OFF_GATE + 32 * MiB;
constexpr size_t OFF_QC = OFF_QB + 8 * MiB;
constexpr size_t OFF_QD = OFF_QC + 8 * MiB;
constexpr size_t OFF_KFB = OFF_QD + 8 * MiB;
constexpr size_t OFF_KFC = OFF_KFB + 24 * MiB;
constexpr size_t OFF_KFD = OFF_KFC + 8 * MiB;
constexpr size_t OFF_IDX = OFF_KFD + 8 * MiB;
constexpr size_t OFF_KIF = OFF_IDX + 10 * MiB;
constexpr size_t OFF_MIX = OFF_KIF + 1 * MiB;
constexpr size_t OFF_VTMP = OFF_MIX;
constexpr size_t OFF_MASK = OFF_MIX + 32 * MiB;
constexpr size_t OFF_H16 = OFF_MASK + 4 * MiB;
constexpr size_t OUT_QA = 0;
constexpr size_t OUT_KFA = OUT_QA + 12 * MiB;
constexpr size_t OUT_KRF = OUT_KFA + 8 * MiB;
constexpr size_t OUT_VFA = OUT_KRF + 1 * MiB;
constexpr size_t OFF_WINT = OFF_H16 + 32 * MiB;
constexpr size_t OFF_WOUTT = OFF_WINT + 16 * MiB;
constexpr size_t OFF_WUQT = OFF_WOUTT + 4 * MiB;
constexpr size_t OFF_WUKVT = OFF_WUQT + 512 * 1024;
constexpr size_t OFF_VF = OFF_WUKVT + 512 * 1024;
constexpr size_t OFF_END = OFF_VF + 40 * MiB;
static_assert(OFF_END <= 256 * MiB, "ws map");

struct Route { int kind; size_t off; int dcol; int pitch; float scale; int silu; };
__host__ __device__ inline Route route(int my) {
    Route r{-1, 0, 0, 0, 1.f, 0};
    if (my < 384) { r.kind = 0; r.off = OFF_CA; r.dcol = my; r.pitch = 384; }
    else if (my < 1408) { r.kind = 0; r.off = OFF_GATE; r.dcol = my - 384; r.pitch = 1024; r.silu = 1; }
    else if (my < 1664) { r.kind = 0; r.off = OFF_QB; r.dcol = my - 1408; r.pitch = 256; r.scale = 0.125f * LOG2E; }
    else if (my < 1920) { r.kind = 2; r.off = OFF_KFB; r.dcol = my - 1664; }
    else if (my < 2176) { r.kind = 0; r.off = OFF_QC; r.dcol = my - 1920; r.pitch = 256; r.scale = 0.125f * LOG2E; }
    else if (my < 2432) { r.kind = 1; r.off = OFF_KFC; r.dcol = my - 2176; }
    else if (my < 2688) { r.kind = 0; r.off = OFF_QD; r.dcol = my - 2432; r.pitch = 256; r.scale = 0.17677669529663687f * LOG2E; }
    else if (my < 2944) { r.kind = 1; r.off = OFF_KFD; r.dcol = my - 2688; }
    else if (my < 3712) { r.kind = 0; r.off = OFF_VTMP; r.dcol = my - 2944; r.pitch = 768; }
    else if (my < 3968) { r.kind = 0; r.off = OFF_IDX; r.dcol = my - 3712; r.pitch = 320; r.scale = 0.17677669529663687f; }
    else if (my < 4000) { r.kind = 3; r.off = OFF_KIF; r.dcol = my - 3968; }
    else if (my < 4032) { r.kind = 0; r.off = OFF_IDX; r.dcol = my - 3712; r.pitch = 320; }
    return r;
}
DEVI size_t kf_off(int bh, int s, int d0) { return ((((size_t)bh * 64 + (s >> 5)) * 4 + (d0 >> 4)) * 64 + (s & 31) + 32 * ((d0 >> 3) & 1)) * 8; }
DEVI size_t kf4_off(int bh, int s, int d0) { const int pp = s >> 2, r4 = s & 3; return (((((size_t)bh * 4 + r4) * 16 + (pp >> 5)) * 4 + (d0 >> 4)) * 64 + (pp & 31) + 32 * ((d0 >> 3) & 1)) * 8; }
DEVI size_t kf16_off(int bh, int s, int d0) { const int pp = s >> 4, r = s & 15; return (((((size_t)bh * 16 + r) * 4 + (pp >> 5)) * 4 + (d0 >> 4)) * 64 + (pp & 31) + 32 * ((d0 >> 3) & 1)) * 8; }
DEVI size_t mixf_off(size_t tok, int c0) { return tok * 1024 + (size_t)c0; }
constexpr size_t FSZ = (size_t)32 * 64 * 4 * 64 * 8;

__device__ __constant__ unsigned short kP2Order[1024] = {63, 127, 191, 255, 62, 126, 190, 254, 61, 125, 189, 253, 60, 124, 188, 252, 59, 123, 187, 251, 58, 122, 186, 250, 57, 121, 185, 249, 56, 120, 184, 248, 55, 119, 183, 247, 54, 118, 182, 246, 53, 117, 181, 245, 52, 116, 180, 244, 51, 115, 179, 243, 50, 114, 178, 242, 49, 113, 177, 241, 48, 112, 176, 240, 47, 111, 175, 239, 46, 110, 174, 238, 45, 109, 173, 237, 44, 108, 172, 236, 43, 107, 171, 235, 42, 106, 170, 234, 41, 105, 169, 233, 40, 104, 168, 232, 39, 103, 167, 231, 319, 383, 447, 511, 318, 382, 446, 510, 38, 102, 166, 230, 317, 381, 445, 509, 316, 380, 444, 508, 37, 101, 165, 229, 315, 379, 443, 507, 36, 100, 164, 228, 314, 378, 442, 506, 313, 377, 441, 505, 35, 99, 163, 227, 312, 376, 440, 504, 34, 98, 162, 226, 311, 375, 439, 503, 310, 374, 438, 502, 33, 97, 161, 225, 309, 373, 437, 501, 308, 372, 436, 500, 32, 96, 160, 224, 307, 371, 435, 499, 31, 95, 159, 223, 306, 370, 434, 498, 305, 369, 433, 497, 30, 94, 158, 222, 304, 368, 432, 496, 29, 93, 157, 221, 303, 367, 431, 495, 302, 366, 430, 494, 28, 92, 156, 220, 301, 365, 429, 493, 300, 364, 428, 492, 27, 91, 155, 219, 299, 363, 427, 491, 26, 90, 154, 218, 298, 362, 426, 490, 575, 639, 703, 767, 297, 361, 425, 489, 574, 638, 702, 766, 25, 89, 153, 217, 573, 637, 701, 765, 296, 360, 424, 488, 572, 636, 700, 764, 24, 88, 152, 216, 295, 359, 423, 487, 571, 635, 699, 763, 570, 634, 698, 762, 294, 358, 422, 486, 569, 633, 697, 761, 23, 87, 151, 215, 293, 357, 421, 485, 568, 632, 696, 760, 567, 631, 695, 759, 292, 356, 420, 484, 22, 86, 150, 214, 566, 630, 694, 758, 291, 355, 419, 483, 565, 629, 693, 757, 564, 628, 692, 756, 21, 85, 149, 213, 290, 354, 418, 482, 563, 627, 691, 755, 289, 353, 417, 481, 562, 626, 690, 754, 20, 84, 148, 212, 561, 625, 689, 753, 288, 352, 416, 480, 560, 624, 688, 752, 19, 83, 147, 211, 287, 351, 415, 479, 559, 623, 687, 751, 558, 622, 686, 750, 286, 350, 414, 478, 557, 621, 685, 749, 18, 82, 146, 210, 285, 349, 413, 477, 556, 620, 684, 748, 555, 619, 683, 747, 284, 348, 412, 476, 17, 81, 145, 209, 554, 618, 682, 746, 283, 347, 411, 475, 553, 617, 681, 745, 552, 616, 680, 744, 16, 80, 144, 208, 282, 346, 410, 474, 551, 615, 679, 743, 281, 345, 409, 473, 550, 614, 678, 742, 15, 79, 143, 207, 549, 613, 677, 741, 280, 344, 408, 472, 548, 612, 676, 740, 14, 78, 142, 206, 279, 343, 407, 471, 547, 611, 675, 739, 546, 610, 674, 738, 278, 342, 406, 470, 545, 609, 673, 737, 13, 77, 141, 205, 277, 341, 405, 469, 544, 608, 672, 736, 543, 607, 671, 735, 276, 340, 404, 468, 12, 76, 140, 204, 542, 606, 670, 734, 275, 339, 403, 467, 541, 605, 669, 733, 768, 769, 770, 771, 772, 773, 774, 775, 776, 777, 778, 779, 780, 781, 782, 783, 784, 785, 786, 787, 788, 789, 790, 791, 792, 793, 794, 795, 796, 797, 798, 799, 800, 801, 802, 803, 804, 805, 806, 807, 808, 809, 810, 811, 812, 813, 814, 815, 816, 817, 818, 819, 820, 821, 822, 823, 824, 825, 826, 827, 828, 829, 830, 831, 832, 833, 834, 835, 836, 837, 838, 839, 840, 841, 842, 843, 844, 845, 846, 847, 848, 849, 850, 851, 852, 853, 854, 855, 856, 857, 858, 859, 860, 861, 862, 863, 864, 865, 866, 867, 868, 869, 870, 871, 872, 873, 874, 875, 876, 877, 878, 879, 880, 881, 882, 883, 884, 885, 886, 887, 888, 889, 890, 891, 892, 893, 894, 895, 896, 897, 898, 899, 900, 901, 902, 903, 904, 905, 906, 907, 908, 909, 910, 911, 912, 913, 914, 915, 916, 917, 918, 919, 920, 921, 922, 923, 924, 925, 926, 927, 928, 929, 930, 931, 932, 933, 934, 935, 936, 937, 938, 939, 940, 941, 942, 943, 944, 945, 946, 947, 948, 949, 950, 951, 952, 953, 954, 955, 956, 957, 958, 959, 960, 961, 962, 963, 964, 965, 966, 967, 968, 969, 970, 971, 972, 973, 974, 975, 976, 977, 978, 979, 980, 981, 982, 983, 984, 985, 986, 987, 988, 989, 990, 991, 992, 993, 994, 995, 996, 997, 998, 999, 1000, 1001, 1002, 1003, 1004, 1005, 1006, 1007, 1008, 1009, 1010, 1011, 1012, 1013, 1014, 1015, 1016, 1017, 1018, 1019, 1020, 1021, 1022, 1023, 540, 604, 668, 732, 11, 75, 139, 203, 274, 338, 402, 466, 539, 603, 667, 731, 273, 337, 401, 465, 538, 602, 666, 730, 10, 74, 138, 202, 537, 601, 665, 729, 272, 336, 400, 464, 536, 600, 664, 728, 9, 73, 137, 201, 271, 335, 399, 463, 535, 599, 663, 727, 534, 598, 662, 726, 270, 334, 398, 462, 533, 597, 661, 725, 8, 72, 136, 200, 269, 333, 397, 461, 532, 596, 660, 724, 531, 595, 659, 723, 268, 332, 396, 460, 7, 71, 135, 199, 530, 594, 658, 722, 267, 331, 395, 459, 529, 593, 657, 721, 528, 592, 656, 720, 6, 70, 134, 198, 266, 330, 394, 458, 527, 591, 655, 719, 265, 329, 393, 457, 526, 590, 654, 718, 5, 69, 133, 197, 525, 589, 653, 717, 264, 328, 392, 456, 524, 588, 652, 716, 4, 68, 132, 196, 263, 327, 391, 455, 523, 587, 651, 715, 522, 586, 650, 714, 262, 326, 390, 454, 521, 585, 649, 713, 3, 67, 131, 195, 261, 325, 389, 453, 520, 584, 648, 712, 519, 583, 647, 711, 260, 324, 388, 452, 2, 66, 130, 194, 518, 582, 646, 710, 259, 323, 387, 451, 517, 581, 645, 709, 516, 580, 644, 708, 1, 65, 129, 193, 258, 322, 386, 450, 515, 579, 643, 707, 257, 321, 385, 449, 514, 578, 642, 706, 0, 64, 128, 192, 513, 577, 641, 705, 256, 320, 384, 448, 512, 576, 640, 704};
__device__ __constant__ unsigned char kWgOrder[96] = {7, 15, 23, 31, 6, 14, 22, 30, 39, 47, 55, 63, 5, 13, 21, 29, 38, 46, 54, 62, 4, 12, 20, 28, 71, 79, 87, 95, 37, 45, 53, 61, 70, 78, 86, 94, 3, 11, 19, 27, 36, 44, 52, 60, 69, 77, 85, 93, 35, 43, 51, 59, 68, 76, 84, 92, 2, 10, 18, 26, 67, 75, 83, 91, 34, 42, 50, 58, 1, 9, 17, 25, 66, 74, 82, 90, 33, 41, 49, 57, 65, 73, 81, 89, 0, 8, 16, 24, 32, 40, 48, 56, 64, 72, 80, 88};
__device__ __constant__ int kBucketStart[16] = {16, 22, 30, 40, 54, 73, 99, 134, 182, 246, 332, 450, 609, 825, 1117, 1513};
DEVI int t5_bucket(int n) {
    if (n < 16) return n;
    int b = 16;
#pragma unroll
    for (int j = 1; j < 16; ++j) b += (n >= kBucketStart[j]) ? 1 : 0;
    return b;
}


#define XB_TMO      128
#define XB_XCNT(j)  (256  + 64 * (j))
#define XB_XSUB(j)  (1280 + 64 * (j))
#define XB_XGEN(j)  (2304 + 64 * (j))
#define XB_TOP      3328
#define XB_TOPGEN   3392
#define XCD_BAR_WORDS 3456
#define XB_SPIN_CAP (1u << 18)
__device__ __forceinline__ unsigned xb_ld(unsigned* p)              { return __hip_atomic_load(p, __ATOMIC_RELAXED, __HIP_MEMORY_SCOPE_AGENT); }
__device__ __forceinline__ unsigned xb_add(unsigned* p, unsigned v) { return __hip_atomic_fetch_add(p, v, __ATOMIC_RELAXED, __HIP_MEMORY_SCOPE_AGENT); }
__device__ __forceinline__ unsigned xb_xcc_id() { return (unsigned)__builtin_amdgcn_s_getreg((3 << 11) | 20) & 0xFu; }
#define XB_SPIN(cond, bar) do { unsigned _sp = 0; while (cond) { __builtin_amdgcn_s_sleep(1); \
    if ((++_sp & 255u) == 0u) { if (xb_ld(&(bar)[XB_TMO])) break; if (_sp > XB_SPIN_CAP) { atomicAdd(&(bar)[XB_TMO], 1u); break; } } } } while (0)
struct XcdBarrier { unsigned* bar; unsigned x; volatile LAS unsigned* st; };
__device__ __forceinline__ XcdBarrier xcd_barrier_post(unsigned* bar, volatile LAS unsigned* st) {
    XcdBarrier b; b.bar = bar; b.x = xb_xcc_id(); b.st = st;
    if (threadIdx.x == 0) (void)xb_add(&bar[XB_XCNT(b.x)], 1u);
    return b;
}
__device__ __forceinline__ void xcd_barrier_complete(unsigned* bar, unsigned x, unsigned& nloc, unsigned& nx) {
    const unsigned G = gridDim.x * gridDim.y * gridDim.z;
    unsigned sum, cnt, mine, sp = 0u;
    for (;;) {
        sum = 0u; cnt = 0u; mine = 0u;
#pragma unroll
        for (unsigned j = 0; j < 16; ++j) { const unsigned c = xb_ld(&bar[XB_XCNT(j)]); sum += c; cnt += (c > 0u) ? 1u : 0u; mine = (j == x) ? c : mine; }
        if (sum == G) break;
        __builtin_amdgcn_s_sleep(1);
        if ((++sp & 255u) == 0u) { if (xb_ld(&bar[XB_TMO])) break; if (sp > XB_SPIN_CAP) { atomicAdd(&bar[XB_TMO], 1u); break; } }
    }
    nloc = mine > 0u ? mine : 1u; nx = cnt > 0u ? cnt : 1u;
}
__device__ __forceinline__ void xcd_barrier(const XcdBarrier& b) {
    asm volatile("s_waitcnt vmcnt(0)" ::: "memory");
    __syncthreads();
    if (otid() == 0) {
        unsigned* bar = b.bar; unsigned bx = b.x; asm volatile("" : "+s"(bx));
        __builtin_amdgcn_s_waitcnt(0);
        unsigned nloc = b.st[0], nx = b.st[1];
        if (nloc == 0u) { xcd_barrier_complete(bar, bx, nloc, nx); b.st[0] = nloc; b.st[1] = nx; }
        const unsigned old = xb_add(&bar[XB_XSUB(bx)], 1u);
        const unsigned gen = old / nloc;
        if (old + 1u == (gen + 1u) * nloc) {
            __builtin_amdgcn_fence(__ATOMIC_RELEASE, "agent");
            asm volatile("s_waitcnt vmcnt(0)" ::: "memory");
            const unsigned og = xb_add(&bar[XB_TOP], 1u);
            const unsigned tg = og / nx;
            if (og + 1u == (tg + 1u) * nx) xb_add(&bar[XB_TOPGEN], 1u);
            else XB_SPIN(xb_ld(&bar[XB_TOPGEN]) == tg, bar);
            __builtin_amdgcn_fence(__ATOMIC_ACQUIRE, "agent");
            xb_add(&bar[XB_XGEN(bx)], 1u);
            asm volatile("s_waitcnt vmcnt(0)" ::: "memory");
        } else {
            XB_SPIN(xb_ld(&bar[XB_XGEN(bx)]) == gen, bar);
            __builtin_amdgcn_fence(__ATOMIC_ACQUIRE, "agent");
            asm volatile("s_waitcnt vmcnt(0)" ::: "memory");
        }
    }
    __syncthreads();
}

namespace pg8 {
#define PG8_LAS __attribute__((address_space(3)))
typedef unsigned short bf16_t;
typedef _Float16 f16x8 __attribute__((ext_vector_type(8)));
typedef float f32x4 __attribute__((ext_vector_type(4)));
typedef unsigned u32x4 __attribute__((ext_vector_type(4)));
constexpr int BM = 256, BK = 64, HALF = 128, HTB = HALF * BK * 2  , STAGE_BYTES = 8 * HTB, NXCD = 8, WGM = 8;

__host__ __device__ __forceinline__ int lds_byte(int r, int c) { const int st = (r >> 4) * 2 + (c >> 5), rr = r & 15, cc = c & 31, ob = rr * 64 + cc * 2; return st * 1024 + (ob ^ (((ob >> 9) & 1) << 5)); }
__host__ __device__ __forceinline__ void stage_rc(int b, int& R, int& C) { const int st = b / 1024, sb = b % 1024, swz = sb ^ (((sb >> 9) & 1) << 5); R = (st >> 1) * 16 + swz / 64; C = (st & 1) * 32 + (swz % 64) / 2; }
__host__ __device__ __forceinline__ int perm32(int rho) { const int n = rho >> 4, i = rho & 15; return 8 * (i >> 2) + 4 * n + (i & 3); }

struct Unit { int pm, pn; };
struct Gemm { const bf16_t* A; const bf16_t* Bt; int M, N, K; };

struct StaticOrder {
    int nM, nN, nwg, G, c;
    __host__ __device__ void init(int M, int N, int G_, int c_) { nM = M / BM; nN = N / BM; nwg = nM * nN; G = G_; c = c_; }
    __host__ __device__ bool next(int i, Unit& u) const {
        const long L = (long)i * G + c; if (L >= nwg) return false;
        int wgid = (int)L; { const int q = nwg / NXCD, r = nwg % NXCD, xcd = wgid % NXCD, off = wgid / NXCD; wgid = (xcd < r ? xcd * (q + 1) : r * (q + 1) + (xcd - r) * q) + off; }
        const int nig = WGM * nN, gid = wgid / nig, fm = gid * WGM, gsz = (nM - fm) < WGM ? (nM - fm) : WGM;
        u.pm = fm + ((wgid % nig) % gsz); u.pn = (wgid % nig) / gsz; return true;
    }
    __device__ __forceinline__ void a_ready(const Unit&) const {}
    __device__ __forceinline__ void done(const Unit&) const {}
};

template <class Epi, class Sched, bool ALIGN_EPI = false, bool SP2 = false>
__device__ __forceinline__ void gemm_phase(PG8_LAS unsigned char* lds, const Gemm g, const Sched& S, const Epi& E) {
    const int tid = otid(), wid = __builtin_amdgcn_readfirstlane(tid >> 6), lane = tid & 63, wr = wid >> 2, wc = wid & 3, fr = lane & 15, fq = lane >> 4;
    const int K = g.K, nt = K / BK;
    unsigned voffA[2], voffB[2];
#pragma unroll
    for (int i = 0; i < 2; ++i) { int R, C; stage_rc(tid * 16 + i * 8192, R, C); const int Rb = Epi::PERM ? ((R & ~31) + perm32(R & 31)) : R;
        voffA[i] = (unsigned)(R * K + C) * 2u; voffB[i] = (unsigned)(Rb * K + C) * 2u; }
    const size_t kstep = (size_t)(BK * 2);
    const size_t hstep = (size_t)HALF * K * 2;
    const size_t tstep = 2 * hstep;
    const unsigned ldsw = (unsigned)wid * 1024u;
    const int aoff = lds_byte(wr * 64 + fr, fq * 8), boff = lds_byte(wc * 32 + fr, fq * 8);
#define PG8_SA(b, h) (((b) * 2 + (h)) * HTB)
#define PG8_SB(b, h) ((4 + (b) * 2 + (h)) * HTB)
#define PG8_STAGE(bufoff, gbase, voff) do { _Pragma("unroll") for (int _i = 0; _i < 2; ++_i) \
        __builtin_amdgcn_global_load_lds((const unsigned*)((const char*)(gbase) + (voff)[_i]), (PG8_LAS unsigned*)(lds + (bufoff) + ldsw + _i * 8192), 16, 0, 0); } while (0)
#define PG8_LDA(dst, b, h) do { _Pragma("unroll") for (int m = 0; m < 4; ++m) _Pragma("unroll") for (int k = 0; k < 2; ++k) dst[m][k] = *(const PG8_LAS f16x8*)(lds + PG8_SA(b, h) + aoff + m * 2048 + k * 1024); } while (0)
#define PG8_LDB(dst, b, h) do { _Pragma("unroll") for (int n = 0; n < 2; ++n) _Pragma("unroll") for (int k = 0; k < 2; ++k) dst[n][k] = *(const PG8_LAS f16x8*)(lds + PG8_SB(b, h) + boff + n * 2048 + k * 1024); } while (0)
#define PG8_MMA(ai, bj, At, Bt) do { __builtin_amdgcn_s_setprio(1); _Pragma("unroll") for (int m = 0; m < 4; ++m) _Pragma("unroll") for (int n = 0; n < 2; ++n) _Pragma("unroll") for (int k = 0; k < 2; ++k) \
        acc[ai][bj][m][n] = __builtin_amdgcn_mfma_f32_16x16x32_f16(Bt[n][k], At[m][k], acc[ai][bj][m][n], 0, 0, 0); __builtin_amdgcn_s_setprio(0); } while (0)
#define PG8_WAIT_V(n) asm volatile("s_waitcnt vmcnt(" #n ")" ::: "memory")
#define PG8_WAIT_L(n) asm volatile("s_waitcnt lgkmcnt(" #n ")" ::: "memory")
#define PG8_BAR __builtin_amdgcn_s_barrier()
#define PG8_SCHED __builtin_amdgcn_sched_barrier(0)
    Unit cur, nxt; int ui = 0;
    if (!S.next(0, cur)) return;
    f32x4 acc[2][2][4][2];
#pragma unroll
    for (int a = 0; a < 2; ++a)
#pragma unroll
        for (int b = 0; b < 2; ++b)
#pragma unroll
            for (int m = 0; m < 4; ++m)
#pragma unroll
                for (int n = 0; n < 2; ++n) acc[a][b][m][n] = (f32x4){0.f, 0.f, 0.f, 0.f};
    f16x8 At[4][2], B0[2][2], B1[2][2];
    const char* cA = (const char*)g.A + (size_t)cur.pm * tstep; const char* cB = (const char*)g.Bt + (size_t)cur.pn * tstep;
    S.a_ready(cur);
    if constexpr (SP2) {
        PG8_STAGE(PG8_SB(0, 0), cB, voffB); PG8_STAGE(PG8_SB(0, 1), cB + hstep, voffB); PG8_STAGE(PG8_SA(0, 0), cA, voffA); PG8_STAGE(PG8_SA(0, 1), cA + hstep, voffA);
        if (wr == 1) PG8_BAR;
        PG8_WAIT_V(2); PG8_BAR;
        PG8_STAGE(PG8_SB(1, 0), cB + kstep, voffB); PG8_STAGE(PG8_SA(1, 0), cA + kstep, voffA); PG8_STAGE(PG8_SB(1, 1), cB + hstep + kstep, voffB);
        PG8_WAIT_V(6); PG8_BAR;
    } else {
        PG8_STAGE(PG8_SB(0, 0), cB, voffB); PG8_STAGE(PG8_SA(0, 0), cA, voffA); PG8_STAGE(PG8_SB(0, 1), cB + hstep, voffB); PG8_STAGE(PG8_SA(0, 1), cA + hstep, voffA);
        if (wr == 1) PG8_BAR;
        PG8_WAIT_V(4); PG8_BAR;
        PG8_STAGE(PG8_SB(1, 0), cB + kstep, voffB); PG8_STAGE(PG8_SA(1, 0), cA + kstep, voffA); PG8_STAGE(PG8_SB(1, 1), cB + hstep + kstep, voffB);
        PG8_WAIT_V(6); PG8_BAR;
    }
    for (;;) {
        const bool has_next = S.next(ui + 1, nxt);
        const char* nA = has_next ? (const char*)g.A + (size_t)nxt.pm * tstep : cA; const char* nB = has_next ? (const char*)g.Bt + (size_t)nxt.pn * tstep : cB;
        for (int t = 0; t < nt; t += 2) {
            const bool last = (t == nt - 2);
            const char* a1 = cA + (size_t)(t + 1) * kstep;
            const char* a2 = last ? nA : cA + (size_t)(t + 2) * kstep; const char* b2 = last ? nB : cB + (size_t)(t + 2) * kstep;
            const char* a3 = a2 + kstep; const char* b3 = b2 + kstep;
            if (last && has_next) S.a_ready(nxt);
            if constexpr (SP2) {
            PG8_LDB(B0, 0, 0); PG8_LDB(B1, 0, 1); PG8_SCHED; PG8_LDA(At, 0, 0); PG8_STAGE(PG8_SA(1, 1), a1 + hstep, voffA);
            PG8_WAIT_V(8); PG8_WAIT_L(0); PG8_BAR; PG8_MMA(0, 0, At, B0); PG8_MMA(0, 1, At, B1); PG8_BAR; PG8_SCHED;
            PG8_LDA(At, 0, 1); PG8_STAGE(PG8_SB(0, 0), b2, voffB); PG8_STAGE(PG8_SB(0, 1), b2 + hstep, voffB); PG8_STAGE(PG8_SA(0, 0), a2, voffA);
            PG8_WAIT_V(8); PG8_WAIT_L(0); PG8_BAR; PG8_MMA(1, 0, At, B0); PG8_MMA(1, 1, At, B1); PG8_BAR; PG8_SCHED;
            PG8_LDB(B0, 1, 0); PG8_LDB(B1, 1, 1); PG8_SCHED; PG8_LDA(At, 1, 0); PG8_STAGE(PG8_SA(0, 1), a2 + hstep, voffA);
            PG8_WAIT_V(8); PG8_WAIT_L(0); PG8_BAR; PG8_MMA(0, 0, At, B0); PG8_MMA(0, 1, At, B1); PG8_BAR; PG8_SCHED;
            PG8_LDA(At, 1, 1); PG8_STAGE(PG8_SB(1, 0), b3, voffB); PG8_STAGE(PG8_SB(1, 1), b3 + hstep, voffB); PG8_STAGE(PG8_SA(1, 0), a3, voffA);
            PG8_WAIT_V(8); PG8_WAIT_L(0); PG8_BAR; PG8_MMA(1, 0, At, B0); PG8_MMA(1, 1, At, B1); PG8_BAR; PG8_SCHED;
            } else {
            PG8_LDB(B0, 0, 0); PG8_SCHED; PG8_LDA(At, 0, 0); PG8_STAGE(PG8_SA(1, 1), a1 + hstep, voffA);
            PG8_WAIT_L(8); PG8_BAR; PG8_WAIT_L(0); PG8_MMA(0, 0, At, B0); PG8_BAR; PG8_SCHED;
            PG8_LDB(B1, 0, 1); PG8_STAGE(PG8_SB(0, 0), b2, voffB);
            PG8_BAR; PG8_WAIT_L(0); PG8_MMA(0, 1, At, B1); PG8_BAR;
            PG8_LDA(At, 0, 1); PG8_STAGE(PG8_SA(0, 0), a2, voffA);
            PG8_BAR; PG8_WAIT_L(0); PG8_MMA(1, 0, At, B0); PG8_BAR; PG8_SCHED;
            PG8_STAGE(PG8_SB(0, 1), b2 + hstep, voffB);
            PG8_WAIT_V(6); PG8_BAR; PG8_MMA(1, 1, At, B1); PG8_BAR;
            PG8_LDB(B0, 1, 0); PG8_SCHED; PG8_LDA(At, 1, 0); PG8_STAGE(PG8_SA(0, 1), a2 + hstep, voffA);
            PG8_WAIT_L(8); PG8_BAR; PG8_WAIT_L(0); PG8_MMA(0, 0, At, B0); PG8_BAR; PG8_SCHED;
            PG8_LDB(B1, 1, 1); PG8_STAGE(PG8_SB(1, 0), b3, voffB);
            PG8_BAR; PG8_WAIT_L(0); PG8_MMA(0, 1, At, B1); PG8_BAR;
            PG8_LDA(At, 1, 1); PG8_STAGE(PG8_SA(1, 0), a3, voffA);
            PG8_BAR; PG8_WAIT_L(0); PG8_MMA(1, 0, At, B0); PG8_BAR; PG8_SCHED;
            PG8_STAGE(PG8_SB(1, 1), b3 + hstep, voffB);
            PG8_WAIT_V(6); PG8_BAR; PG8_MMA(1, 1, At, B1); PG8_BAR;
            }
        }
        if constexpr (ALIGN_EPI) { if (wr == 0) PG8_BAR; }
        if constexpr (!Epi::AFTER_DRAIN) { E(acc, cur, wr, wc, fr, fq); S.done(cur); }
        if (!has_next) break;
#pragma unroll
        for (int a = 0; a < 2; ++a)
#pragma unroll
            for (int b = 0; b < 2; ++b)
#pragma unroll
                for (int m = 0; m < 4; ++m)
#pragma unroll
                    for (int n = 0; n < 2; ++n) acc[a][b][m][n] = (f32x4){0.f, 0.f, 0.f, 0.f};
        cur = nxt; cA = nA; cB = nB; ++ui;
        if constexpr (ALIGN_EPI) { if (wr == 1) PG8_BAR; }
    }
    PG8_WAIT_V(0);
    if constexpr (!ALIGN_EPI) { if (wr == 0) PG8_BAR; }
    PG8_BAR;
    if constexpr (Epi::AFTER_DRAIN) { E.fused(acc, cur, wr, wc, fr, fq, lds, wid, lane); S.done(cur); }
#undef PG8_SA
#undef PG8_SB
#undef PG8_STAGE
#undef PG8_LDA
#undef PG8_LDB
#undef PG8_MMA
#undef PG8_WAIT_V
#undef PG8_WAIT_L
#undef PG8_BAR
#undef PG8_SCHED
}
}


typedef float f32x4_t __attribute__((ext_vector_type(4)));
typedef _Float16 h16x8 __attribute__((ext_vector_type(8)));
DEVI float silu_f(float v) { return v / (1.f + __expf(-v)); }
struct EpiRoute {
    static constexpr bool PERM = true, AFTER_DRAIN = false;
    gu8* ws; const gf32* ssq;
    DEVI void operator()(const pg8::f32x4 (&acc)[2][2][4][2], const pg8::Unit& u, int wr, int wc, int fr, int fq) const {
        const int row0 = u.pm * 256 + wr * 64 + fr;
        float rs[2][4];
#pragma unroll
        for (int ai = 0; ai < 2; ++ai)
#pragma unroll
            for (int m = 0; m < 4; ++m) { const int rw = row0 + ai * 128 + m * 16; rs[ai][m] = rsqrtf((ssq[rw] + ssq[NT + rw] + ssq[2 * NT + rw] + ssq[3 * NT + rw]) * (1.f / DM) + EPS); }
#pragma unroll
        for (int bj = 0; bj < 2; ++bj) {
            const int cg = u.pn * 256 + bj * 128 + wc * 32;
            const Route r = route(cg);
            if (r.kind < 0) continue;
            gh16* base = (gh16*)(ws + r.off);
            const int c = r.dcol + 8 * fq;
#pragma unroll
            for (int ai = 0; ai < 2; ++ai)
#pragma unroll
                for (int m = 0; m < 4; ++m) {
                    const int row = row0 + ai * 128 + m * 16; const float sc = rs[ai][m] * r.scale;
                    float v[8];
#pragma unroll
                    for (int j = 0; j < 4; ++j) { v[j] = acc[ai][bj][m][0][j] * sc; v[4 + j] = acc[ai][bj][m][1][j] * sc; }
                    if (r.silu) {
#pragma unroll
                        for (int j = 0; j < 8; ++j) v[j] = silu_f(v[j]);
                    }
                    h16x8 o;
#pragma unroll
                    for (int j = 0; j < 8; ++j) o[j] = (h16)v[j];
                    if (r.kind == 0) *(GAS h16x8*)(base + (size_t)row * r.pitch + c) = o;
                    else {
                        const int b = row >> 11, sq = row & 2047;
                        if (r.kind == 3) *(GAS h16x8*)(base + (((size_t)b * 128 + (sq >> 4)) * 64 + (sq & 15) + 16 * (c >> 3)) * 8) = o;
                        else {
                            const int bh = b * 4 + (c >> 6), d0 = c & 63;
                            *(GAS h16x8*)(base + kf_off(bh, sq, d0)) = o;
                            if (r.kind == 2) { *(GAS h16x8*)(base + FSZ + kf4_off(bh, sq, d0)) = o; *(GAS h16x8*)(base + 2 * FSZ + kf16_off(bh, sq, d0)) = o; }
                        }
                    }
                }
        }
    }
};

struct EpiOut {
    static constexpr bool PERM = true, AFTER_DRAIN = true;
    gf32* h_out; gh16* h16o; const gf32* gpost; gf32* ssqy; gf32* ssqh; const XcdBarrier* bar; bool write_next;
    DEVI void rowsum_publish(const float (&ps)[2][4], gf32* dst, const pg8::Unit& u, int wr, int wc, int fr, int fq, PG8_LAS unsigned char* lds) const {
        lf32* red = (lf32*)lds;
        __syncthreads();
#pragma unroll
        for (int ai = 0; ai < 2; ++ai)
#pragma unroll
            for (int m = 0; m < 4; ++m) { float v = ps[ai][m]; v += shflx(v, 16); v += shflx(v, 32); if (fq == 0) red[wc * 256 + ai * 128 + wr * 64 + m * 16 + fr] = v; }
        __syncthreads();
        const int t = otid();
        if (t < 256) dst[(size_t)u.pn * NT + u.pm * 256 + t] = red[t] + red[256 + t] + red[512 + t] + red[768 + t];
    }
    DEVI void fused(pg8::f32x4 (&acc)[2][2][4][2], const pg8::Unit& u, int wr, int wc, int fr, int fq, PG8_LAS unsigned char* lds, int wid, int lane) const {
        float ps[2][4];
#pragma unroll
        for (int ai = 0; ai < 2; ++ai)
#pragma unroll
            for (int m = 0; m < 4; ++m) { float v = 0.f;
#pragma unroll
                for (int bj = 0; bj < 2; ++bj)
#pragma unroll
                    for (int n = 0; n < 2; ++n)
#pragma unroll
                        for (int e = 0; e < 4; ++e) v += acc[ai][bj][m][n][e] * acc[ai][bj][m][n][e];
                ps[ai][m] = v; }
        rowsum_publish(ps, ssqy, u, wr, wc, fr, fq, lds);
        xcd_barrier(*bar);
        const int row0 = u.pm * 256 + wr * 64 + fr, col0 = u.pn * 256 + wc * 32 + 8 * fq;
        float rs[2][4];
        {
            float sv[2][4][4];
#pragma unroll
            for (int ai = 0; ai < 2; ++ai)
#pragma unroll
                for (int m = 0; m < 4; ++m)
#pragma unroll
                    for (int q = 0; q < 4; ++q) sv[ai][m][q] = ssqy[(size_t)q * NT + row0 + ai * 128 + m * 16];
#pragma unroll
            for (int ai = 0; ai < 2; ++ai)
#pragma unroll
                for (int m = 0; m < 4; ++m) rs[ai][m] = rsqrtf(((sv[ai][m][0] + sv[ai][m][1]) + (sv[ai][m][2] + sv[ai][m][3])) * (1.f / DM) + EPS);
        }
        f32x4_t gv[2][2];
#pragma unroll
        for (int bj = 0; bj < 2; ++bj)
#pragma unroll
            for (int n = 0; n < 2; ++n) gv[bj][n] = *(const GAS f32x4_t*)(gpost + col0 + bj * 128 + 4 * n);
#pragma unroll
        for (int ai = 0; ai < 2; ++ai) {
            h16x8 hh[4][2];
#pragma unroll
            for (int m = 0; m < 4; ++m)
#pragma unroll
                for (int bj = 0; bj < 2; ++bj) hh[m][bj] = *(const GAS h16x8*)(h16o + (size_t)(row0 + ai * 128 + m * 16) * DM + col0 + bj * 128);
            __builtin_amdgcn_sched_barrier(0);
#pragma unroll
            for (int m = 0; m < 4; ++m) {
                float v2 = 0.f;
#pragma unroll
                for (int bj = 0; bj < 2; ++bj)
#pragma unroll
                    for (int n = 0; n < 2; ++n)
#pragma unroll
                        for (int e = 0; e < 4; ++e) { const float o = (float)hh[m][bj][4 * n + e] + acc[ai][bj][m][n][e] * rs[ai][m] * gv[bj][n][e]; acc[ai][bj][m][n][e] = o; v2 += o * o; }
                ps[ai][m] = v2;
            }
        }
        if (write_next) {
#pragma unroll
            for (int ai = 0; ai < 2; ++ai)
#pragma unroll
                for (int m = 0; m < 4; ++m)
#pragma unroll
                    for (int bj = 0; bj < 2; ++bj) { h16x8 oh;
#pragma unroll
                        for (int n = 0; n < 2; ++n)
#pragma unroll
                            for (int e = 0; e < 4; ++e) oh[4 * n + e] = (h16)acc[ai][bj][m][n][e];
                        *(GAS h16x8*)(h16o + (size_t)(row0 + ai * 128 + m * 16) * DM + col0 + bj * 128) = oh; }
        } else {
#pragma unroll
            for (int ai = 0; ai < 2; ++ai)
#pragma unroll
                for (int m = 0; m < 4; ++m)
#pragma unroll
                    for (int bj = 0; bj < 2; ++bj)
#pragma unroll
                        for (int n = 0; n < 2; ++n) *(GAS f32x4_t*)(h_out + (size_t)(row0 + ai * 128 + m * 16) * DM + col0 + bj * 128 + 4 * n) = acc[ai][bj][m][n];
        }
        if (write_next) rowsum_publish(ps, ssqh, u, wr, wc, fr, fq, lds);
    }
    DEVI void operator()(const pg8::f32x4 (&)[2][2][4][2], const pg8::Unit&, int, int, int, int) const {}
};

constexpr int NTHR = 512, NWAVE = 8;

template <bool REF>
DEVI void cvt_transpose(const gf32* __restrict__ src, int src_pitch, const gf32* __restrict__ g, gh16* dst, int N, int K, lu8* lds, int item0, int nitems_total, int& item_base) {
    const int tid = otid();
    LAS float (*tile)[65] = (LAS float (*)[65])lds;
    const int ntn = N / 64, ntk = K / 64, n_it = ntn * ntk;
    for (int it = item0; it < nitems_total; it += gridDim.x) {
        const int li = it - item_base; if (li < 0 || li >= n_it) continue;
        const int n0 = (li % ntn) * 64, k0 = (li / ntn) * 64;
        __syncthreads();
        const int c = tid & 63; int rc = n0 + c; if (REF) rc = ref_col(rc);
#pragma unroll
        for (int ps = 0; ps < 8; ++ps) { const int k = ps * 8 + (tid >> 6);
            tile[k][c] = rc >= 0 ? src[(size_t)(k0 + k) * src_pitch + rc] * (g ? g[k0 + k] : 1.f) : 0.f; }
        __syncthreads();
        const int cc = tid >> 3, kq = (tid & 7) * 8;
        h16x8 o;
#pragma unroll
        for (int j = 0; j < 8; ++j) o[j] = (h16)tile[kq + j][cc];
        *(GAS h16x8*)(dst + (size_t)(n0 + cc) * K + k0 + kq) = o;
    }
    item_base += n_it;
}

DEVI void ph_rowstat_cvt(const gf32* h, gf32* ssq, gh16* h16o) {
    typedef _Float16 h16x4 __attribute__((ext_vector_type(4)));
    const int t_ = otid(); const int lane = t_ & 63, gw = blockIdx.x * NWAVE + (t_ >> 6), nw = gridDim.x * NWAVE;
    for (int row = gw; row < NT; row += 2 * nw) {
        const bool two = row + nw < NT; const int row1 = two ? row + nw : row;
        f32x4_t v[2][4];
#pragma unroll
        for (int r = 0; r < 2; ++r)
#pragma unroll
            for (int i = 0; i < 4; ++i) v[r][i] = ((const GAS f32x4_t*)(h + (size_t)(r ? row1 : row) * DM))[lane + 64 * i];
        __builtin_amdgcn_sched_barrier(0);
#pragma unroll
        for (int r = 0; r < 2; ++r) {
            if (r && !two) break;
            const int rw = r ? row1 : row; float s = 0.f;
#pragma unroll
            for (int i = 0; i < 4; ++i) { const f32x4_t x = v[r][i]; s += x[0] * x[0] + x[1] * x[1] + x[2] * x[2] + x[3] * x[3];
                h16x4 o; o[0] = (h16)x[0]; o[1] = (h16)x[1]; o[2] = (h16)x[2]; o[3] = (h16)x[3];
                *(GAS h16x4*)(h16o + (size_t)rw * DM + (lane + 64 * i) * 4) = o; }
            for (int o = 32; o; o >>= 1) s += shflx(s, o);
            if (lane == 0) { ssq[rw] = s; ssq[NT + rw] = 0.f; ssq[2 * NT + rw] = 0.f; ssq[3 * NT + rw] = 0.f; }
        }
    }
}

typedef float f32x16 __attribute__((ext_vector_type(16)));
typedef _Float16 h16x4 __attribute__((ext_vector_type(4)));
DEVI f32x16 mfma32(h16x8 a, h16x8 b, f32x16 c) { return __builtin_amdgcn_mfma_f32_32x32x16_f16(a, b, c, 0, 0, 0); }
#define CROW(r) (((r) & 3) + 8 * ((r) >> 2))
DEVI float xh_max(float x) { auto r = __builtin_amdgcn_permlane32_swap(__float_as_uint(x), __float_as_uint(x), false, false); return fmaxf(__uint_as_float(r[0]), __uint_as_float(r[1])); }
DEVI float xh_sum(float x) { auto r = __builtin_amdgcn_permlane32_swap(__float_as_uint(x), __float_as_uint(x), false, false); return __uint_as_float(r[0]) + __uint_as_float(r[1]); }
DEVI unsigned pk2h(float a, float b) { auto v = __builtin_amdgcn_cvt_pkrtz(a, b); return __builtin_bit_cast(unsigned, v); }
DEVI h16x8 pack8(const f32x16& p, int s) {
    typedef unsigned u32x4_t __attribute__((ext_vector_type(4)));
    u32x4_t w;
    w[0] = pk2h(p[8 * s + 0], p[8 * s + 1]); w[1] = pk2h(p[8 * s + 2], p[8 * s + 3]); w[2] = pk2h(p[8 * s + 4], p[8 * s + 5]); w[3] = pk2h(p[8 * s + 6], p[8 * s + 7]);
    return __builtin_bit_cast(h16x8, w);
}
DEVI h16x8 ldv8(const gh16* p) {
    h16x4 a = *(const GAS h16x4*)p, b = *(const GAS h16x4*)(p + 8);
    h16x8 r; r[0] = a[0]; r[1] = a[1]; r[2] = a[2]; r[3] = a[3]; r[4] = b[0]; r[5] = b[1]; r[6] = b[2]; r[7] = b[3]; return r;
}
DEVI void softmax_tile(f32x16& S, float& m, float& l, f32x16& O0, f32x16& O1) {
    float mx = S[0];
#pragma unroll
    for (int r = 1; r < 16; ++r) mx = fmaxf(mx, S[r]);
    mx = xh_max(mx);
    if (__any(mx > m)) {
        const float mn = fmaxf(m, mx), al = __builtin_amdgcn_exp2f(m - mn);
        l *= al; O0 *= al; O1 *= al; m = mn;
    }
#pragma unroll
    for (int r = 0; r < 16; ++r) S[r] = __builtin_amdgcn_exp2f(S[r] - m);
    l += ((S[0] + S[1]) + (S[2] + S[3])) + ((S[4] + S[5]) + (S[6] + S[7])) + (((S[8] + S[9]) + (S[10] + S[11])) + ((S[12] + S[13]) + (S[14] + S[15])));
}
DEVI void softmax_tile_h(f32x16& S, float& m, float& l, f32x16& O0, f32x16& O1, int hot) { if (hot < 2) softmax_tile(S, m, l, O0, O1); else l += S[0]; }
DEVI int wq_next(gu32* ctr) {
    int e = 0;
    if ((otid() & 63) == 0) e = (int)__hip_atomic_fetch_add(ctr, 1u, __ATOMIC_RELAXED, __HIP_MEMORY_SCOPE_AGENT);
    return __builtin_amdgcn_readfirstlane(e);
}

DEVI void flashA_item(int b, int hh, int qt, const gh16* qA, const gh16* KF, const gh16* KRF, const gh16* VF, const gh16* gate, gh16* mix) {
    const int lane = otid() & 63, q = lane & 31, h = lane >> 5;
    const size_t tokq = (size_t)b * SEQ + qt * 32 + q;
    h16x8 qf[6];
#pragma unroll
    for (int ks = 0; ks < 6; ++ks) qf[ks] = *(const GAS h16x8*)(qA + tokq * 384 + hh * 96 + ks * 16 + 8 * h);
    f32x16 O0 = {}, O1 = {};
    float m = -1e30f, l = 0.f;
    const gh16* kp = KF + (size_t)(b * 4 + hh) * 64 * 2048 + lane * 8;
    const gh16* rp = KRF + (size_t)b * 64 * 1024 + lane * 8;
    const gh16* vp = VF + (size_t)(b * 4 + hh) * 64 * 2048 + lane * 8;
    h16x8 kf[6];
#pragma unroll
    for (int ks = 0; ks < 4; ++ks) kf[ks] = *(const GAS h16x8*)(kp + ks * 512);
#pragma unroll
    for (int ks = 0; ks < 2; ++ks) kf[4 + ks] = *(const GAS h16x8*)(rp + ks * 512);
    h16x8 vf[4], vn[4];
#pragma unroll
    for (int f = 0; f < 4; ++f) vf[f] = *(const GAS h16x8*)(vp + f * 512);
    for (int j = 0; j <= qt; ++j) {
        f32x16 S = {};
#pragma unroll
        for (int ks = 0; ks < 6; ++ks) S = mfma32(kf[ks], qf[ks], S);
        if (j < qt) {
#pragma unroll
            for (int ks = 0; ks < 4; ++ks) kf[ks] = *(const GAS h16x8*)(kp + (size_t)(j + 1) * 2048 + ks * 512);
#pragma unroll
            for (int ks = 0; ks < 2; ++ks) kf[4 + ks] = *(const GAS h16x8*)(rp + (size_t)(j + 1) * 1024 + ks * 512);
#pragma unroll
            for (int f = 0; f < 4; ++f) vn[f] = *(const GAS h16x8*)(vp + (size_t)(j + 1) * 2048 + f * 512);
        } else {
#pragma unroll
            for (int r = 0; r < 16; ++r) S[r] = (CROW(r) + 4 * h > q) ? -3e38f : S[r];
        }
        softmax_tile(S, m, l, O0, O1);
        const h16x8 p0 = pack8(S, 0), p1 = pack8(S, 1);
        O0 = mfma32(vf[0], p0, O0); O0 = mfma32(vf[1], p1, O0);
        O1 = mfma32(vf[2], p0, O1); O1 = mfma32(vf[3], p1, O1);
#pragma unroll
        for (int f = 0; f < 4; ++f) vf[f] = vn[f];
    }
    const float il = 1.f / xh_sum(l);
    const gh16* gp = gate + tokq * 1024 + hh * 64 + 4 * h;
#pragma unroll
    for (int db = 0; db < 2; ++db)
#pragma unroll
        for (int g = 0; g < 4; ++g) {
            const h16x4 gv = *(const GAS h16x4*)(gp + db * 32 + 8 * g); h16x4 o;
#pragma unroll
            for (int e = 0; e < 4; ++e) o[e] = (h16)((db ? O1[4 * g + e] : O0[4 * g + e]) * il * (float)gv[e]);
            *(GAS h16x4*)(mix + mixf_off(tokq, hh * 64 + db * 32 + 8 * g + 4 * h)) = o;
        }
}

DEVI int far_bucket(int n) { return 23 + (n >= 182 ? 1 : 0) + (n >= 246 ? 1 : 0) + (n >= 332 ? 1 : 0) + (n >= 450 ? 1 : 0) + (n >= 609 ? 1 : 0) + (n >= 825 ? 1 : 0) + (n >= 1117 ? 1 : 0) + (n >= 1513 ? 1 : 0); }
DEVI int far_start(int bk) { return bk == 24 ? 182 : bk == 25 ? 246 : bk == 26 ? 332 : bk == 27 ? 450 : bk == 28 ? 609 : bk == 29 ? 825 : bk == 30 ? 1117 : 1513; }
constexpr int L_NEAR = 0, L_R3 = 12288, L_R2 = 15360, L_R1 = 21504, L_LAM = 39936, L_P2END = 40000;
constexpr int L_QDONE = 41600;
constexpr int L_BIASL = 40000, L_RING = 41984, L_MRING = L_RING + 4 * 10240, L_WQ = L_MRING + 8192;
DEVI void p2_setup(const gf32* biasTab, const gf32* lam_p, float lambda_init, lu8* lds) {
    const int tid = otid();
    lf32* nearR = (lf32*)(lds + L_NEAR);
    for (int i = tid; i < 12 * 256; i += NTHR) { const int hb = i >> 8, u = i & 255, tix = 223 - u; nearR[i] = tix < 0 ? -3e38f : biasTab[hb * 2048 + tix]; }
    lf32* R3 = (lf32*)(lds + L_R3); lf32* R2 = (lf32*)(lds + L_R2); lf32* R1 = (lf32*)(lds + L_R1);
    for (int i = tid; i < 4 * 192; i += NTHR) { const int hb = i / 192, kk = 159 - (i % 192); R3[i] = (kk < 0 || kk > 128) ? -3e38f : biasTab[hb * 2048 + kk * 16]; }
    for (int i = tid; i < 4 * 384; i += NTHR) { const int hb = i / 384, kk = 255 - (i % 384); R2[i] = (kk < 0 || kk > 128) ? -3e38f : biasTab[hb * 2048 + kk * 4]; }
    for (int i = tid; i < 4 * 1152; i += NTHR) { const int hb = i / 1152, kk = 639 - (i % 1152); R1[i] = (kk < 0 || kk > 128) ? -3e38f : biasTab[hb * 2048 + kk]; }
    { lf32* bl = (lf32*)(lds + L_BIASL); for (int i = tid; i < 12 * 32; i += NTHR) { const int hb = i >> 5, k = i & 31; bl[i] = biasTab[hb * 2048 + (k < 16 ? k : kBucketStart[k - 16])]; } }
    if (tid >= 64 && tid < 72) ((lu32*)(lds + L_QDONE))[tid - 64] = 0u;
    if (tid == 0) { float a1 = 0.f, a2 = 0.f; for (int i = 0; i < 32; ++i) { a1 += lam_p[i] * lam_p[32 + i]; a2 += lam_p[64 + i] * lam_p[96 + i]; }
        *(lf32*)(lds + L_LAM) = expf(a1) - expf(a2) + lambda_init; }
    __syncthreads();
}

DEVI void ph_vtrans(const gh16* vtmp, gh16* VF, lu8* lds) {
    const int tid = otid();
    LAS h16 (*tile)[72] = (LAS h16 (*)[72])lds;
    for (int it = blockIdx.x; it < 3 * 32 * 4; it += gridDim.x) {
        const int src = it >> 7, bh = (it >> 2) & 31, blk = it & 3, b = bh >> 2, hh = bh & 3;
        __syncthreads();
        h16x8 tv[8];
#pragma unroll
        for (int k = 0; k < 8; ++k) { const int idx = k * NTHR + tid, row = idx >> 3, c8 = idx & 7;
            tv[k] = *(const GAS h16x8*)(vtmp + ((size_t)b * SEQ + blk * 512 + row) * 768 + src * 256 + hh * 64 + c8 * 8); }
        __builtin_amdgcn_sched_barrier(0);
#pragma unroll
        for (int k = 0; k < 8; ++k) { const int idx = k * NTHR + tid, row = idx >> 3, c8 = idx & 7; *(LAS h16x8*)&tile[row][c8 * 8] = tv[k]; }
        __syncthreads();
        gh16* out0 = VF + (src == 0 ? 0 : (src == 1 ? 3 * FSZ : 4 * FSZ));
#pragma unroll 1
        for (int k = 0; k < 8; ++k) {
            const int fl = k * NTHR + tid, lane = fl & 63, frag = (fl >> 6) & 3, dl = lane & 31, hp = lane >> 5, db = frag >> 1, sk = frag & 1;
            {
                const int tl = fl >> 8; h16x8 o;
#pragma unroll
                for (int e = 0; e < 8; ++e) o[e] = tile[tl * 32 + 16 * sk + 8 * (e >> 2) + 4 * hp + (e & 3)][db * 32 + dl];
                *(GAS h16x8*)(out0 + ((((size_t)bh * 64 + blk * 16 + tl) * 4 + frag) * 64 + lane) * 8) = o;
            }
            if (src == 0) {
                {
                    const int r4 = fl >> 10, tl = (fl >> 8) & 3; h16x8 o;
#pragma unroll
                    for (int e = 0; e < 8; ++e) o[e] = tile[4 * (tl * 32 + 16 * sk + 8 * (e >> 2) + 4 * hp + (e & 3)) + r4][db * 32 + dl];
                    *(GAS h16x8*)(out0 + FSZ + (((((size_t)bh * 4 + r4) * 16 + blk * 4 + tl) * 4 + frag) * 64 + lane) * 8) = o;
                }
                {
                    const int r = fl >> 8; h16x8 o;
#pragma unroll
                    for (int e = 0; e < 8; ++e) o[e] = tile[16 * (16 * sk + 8 * (e >> 2) + 4 * hp + (e & 3)) + r][db * 32 + dl];
                    *(GAS h16x8*)(out0 + 2 * FSZ + (((((size_t)bh * 16 + r) * 4 + blk) * 4 + frag) * 64 + lane) * 8) = o;
                }
            }
        }
    }
}

template <bool SUBLN>
DEVI void epi_gate_store(const f32x16& R0, const f32x16& R1, float il, const gh16* gp, const gf32* sp, gh16* mp, int hot) {
    h16x4 gv[2][4]; f32x4_t sv[2][4];
#pragma unroll
    for (int db = 0; db < 2; ++db)
#pragma unroll
        for (int g = 0; g < 4; ++g) { gv[db][g] = *(const GAS h16x4*)(gp + db * 32 + 8 * g); if (SUBLN) sv[db][g] = *(const GAS f32x4_t*)(sp + db * 32 + 8 * g); }
    __builtin_amdgcn_sched_barrier(0);
#pragma unroll
    for (int db = 0; db < 2; ++db)
#pragma unroll
        for (int g = 0; g < 4; ++g) { h16x4 o;
#pragma unroll
            for (int e = 0; e < 4; ++e) { float v = (db ? R1[4 * g + e] : R0[4 * g + e]) * il * (float)gv[db][g][e]; if (SUBLN) v *= sv[db][g][e]; o[e] = (h16)v; }
            if (!hot) *(GAS h16x4*)(mp + db * 32 + 8 * g) = o; else asm volatile("" :: "v"(o));
        }
}

template <int NMAP, bool MASK>
DEVI void flashCD_item(int b, int hh, int qt, int hb, const gh16* Q, const gh16* KF, const gh16* VF, const gu32* mask, const gf32* biasTab, const lu8* lds,
                       const gf32* subln, float lambda_init, const gh16* gate, gh16* mix, int mixcol, int hot = 0) {
    constexpr int NKS = 4 / NMAP;
    const int lane = otid() & 63, q = lane & 31, h = lane >> 5;
    const size_t tokq = (size_t)b * SEQ + qt * 32 + q;
    const gh16* kp = KF + (size_t)(b * 4 + hh) * 64 * 2048 + lane * 8;
    const gh16* vp = VF + (size_t)(b * 4 + hh) * 64 * 2048 + lane * 8;
    h16x8 qf[NMAP][NKS], kf[NMAP][NKS];
#pragma unroll
    for (int mp = 0; mp < NMAP; ++mp)
#pragma unroll
        for (int ks = 0; ks < NKS; ++ks) {
            qf[mp][ks] = *(const GAS h16x8*)(Q + tokq * 256 + hh * 64 + (mp * NKS + ks) * 16 + 8 * h);
            kf[mp][ks] = *(const GAS h16x8*)(kp + (mp * NKS + ks) * 512);
        }
    f32x16 O[NMAP][2]; float m[NMAP], l[NMAP];
#pragma unroll
    for (int mp = 0; mp < NMAP; ++mp) { O[mp][0] = (f32x16){}; O[mp][1] = (f32x16){}; m[mp] = -1e30f; l[mp] = 0.f; }
    const lf32* nearR = (const lf32*)(lds + L_NEAR) + hb * 256;
    const gf32* bt = biasTab + hb * 2048;
    h16x8 vf[2][2], vn[2][2];
#pragma unroll
    for (int db = 0; db < 2; ++db)
#pragma unroll
        for (int sk = 0; sk < 2; ++sk) vf[db][sk] = *(const GAS h16x8*)(vp + (db * 2 + sk) * 512);
    unsigned mw = 0xffffffffu, mwn = 0xffffffffu;
    if (MASK) mw = mask[tokq * 64];
    for (int j = 0; j <= qt; ++j) {
        f32x16 S[NMAP];
#pragma unroll
        for (int mp = 0; mp < NMAP; ++mp) { S[mp] = (f32x16){};
#pragma unroll
            for (int ks = 0; ks < NKS; ++ks) S[mp] = mfma32(kf[mp][ks], qf[mp][ks], S[mp]); }
        if (j < qt && hot < 5) {
#pragma unroll
            for (int mp = 0; mp < NMAP; ++mp)
#pragma unroll
                for (int ks = 0; ks < NKS; ++ks) kf[mp][ks] = *(const GAS h16x8*)(kp + (size_t)(hot ? 0 : j + 1) * 2048 + (mp * NKS + ks) * 512);
#pragma unroll
            for (int db = 0; db < 2; ++db)
#pragma unroll
                for (int sk = 0; sk < 2; ++sk) vn[db][sk] = *(const GAS h16x8*)(vp + (size_t)(hot ? 0 : j + 1) * 2048 + (db * 2 + sk) * 512);
            if (MASK) mwn = mask[tokq * 64 + j + 1];
        }
        const int D0 = (qt - j) * 32;
        if (hot >= 3) {} else
        if (D0 < 192) {
            const lf32* tp = nearR + (223 - D0 - q + 4 * h);
#pragma unroll
            for (int r = 0; r < 16; ++r) { const float bv = tp[CROW(r)];
#pragma unroll
                for (int mp = 0; mp < NMAP; ++mp) S[mp][r] += bv; }
        } else {
            const int blo = far_bucket(D0 - 31), bhi = far_bucket(D0 + 31);
            const lf32* biasL = (const lf32*)(lds + L_BIASL) + hb * 32;
            const float lo = biasL[blo], hi = biasL[bhi];
            if (blo == bhi) {
#pragma unroll
                for (int mp = 0; mp < NMAP; ++mp) S[mp] += lo;
            } else {
                const int x = D0 + q - 4 * h - far_start(bhi);
#pragma unroll
                for (int r = 0; r < 16; ++r) { const float bv = (x >= CROW(r)) ? hi : lo;
#pragma unroll
                    for (int mp = 0; mp < NMAP; ++mp) S[mp][r] += bv; }
            }
        }
        if (MASK && hot < 3) {
#pragma unroll
            for (int r = 0; r < 16; ++r) S[0][r] = (((mw >> (4 * h)) >> CROW(r)) & 1u) ? S[0][r] : -3e38f;
        }
#pragma unroll
        for (int mp = 0; mp < NMAP; ++mp) {
            softmax_tile_h(S[mp], m[mp], l[mp], O[mp][0], O[mp][1], hot);
            const h16x8 p0 = pack8(S[mp], 0), p1 = pack8(S[mp], 1);
            if (hot < 4) {
            O[mp][0] = mfma32(vf[0][0], p0, O[mp][0]); O[mp][0] = mfma32(vf[0][1], p1, O[mp][0]);
            O[mp][1] = mfma32(vf[1][0], p0, O[mp][1]); O[mp][1] = mfma32(vf[1][1], p1, O[mp][1]);
            } else { O[mp][0][0] += (float)p0[0] + (float)p1[0]; }
        }
#pragma unroll
        for (int db = 0; db < 2; ++db)
#pragma unroll
            for (int sk = 0; sk < 2; ++sk) vf[db][sk] = vn[db][sk];
        mw = mwn;
    }
    f32x16 R0, R1;
    if (NMAP == 2) {
        const float lam = *(const lf32*)(lds + L_LAM);
        const float i0 = 1.f / xh_sum(l[0]), i1 = lam / xh_sum(l[NMAP - 1]);
        R0 = O[0][0] * i0 - O[NMAP - 1][0] * i1; R1 = O[0][1] * i0 - O[NMAP - 1][1] * i1;
        float ss = 0.f;
#pragma unroll
        for (int r = 0; r < 16; ++r) ss += R0[r] * R0[r] + R1[r] * R1[r];
        ss = xh_sum(ss);
        const float rs = rsqrtf(ss * (1.f / 64.f) + EPS) * (1.f - lambda_init);
        R0 *= rs; R1 *= rs;
    } else {
        const float il = 1.f / xh_sum(l[0]);
        R0 = O[0][0] * il; R1 = O[0][1] * il;
    }
    epi_gate_store<NMAP == 2>(R0, R1, 1.f, gate + tokq * 1024 + mixcol + hh * 64 + 4 * h, subln + 4 * h, mix + mixf_off(tokq, mixcol + hh * 64 + 4 * h), hot);
}

template <int BR>
DEVI void flashQ2_item(int b, int hh, int pr, const gh16* Q, const gh16* KF, const gh16* KRF, const gh16* VF, const gu32* mask, const gf32* biasTab, const lu8* lds,
                       const gh16* gate, gh16* mix, int mixcol, int hb, int hot = 0) {
    constexpr int NQK = BR == 0 ? 6 : 4;
    const int lane = otid() & 63, q = lane & 31, h = lane >> 5, bh = b * 4 + hh;
    const int qt1 = 2 * pr + 1;
    size_t tokq[2]; h16x8 qf[2][NQK];
#pragma unroll
    for (int qi = 0; qi < 2; ++qi) { tokq[qi] = (size_t)b * SEQ + (2 * pr + qi) * 32 + q;
#pragma unroll
        for (int ks = 0; ks < NQK; ++ks) qf[qi][ks] = *(const GAS h16x8*)(Q + tokq[qi] * (BR == 0 ? 384 : 256) + hh * (BR == 0 ? 96 : 64) + ks * 16 + 8 * h); }
    f32x16 O[2][2]; float m[2], l[2];
#pragma unroll
    for (int qi = 0; qi < 2; ++qi) { O[qi][0] = (f32x16){}; O[qi][1] = (f32x16){}; m[qi] = -1e30f; l[qi] = 0.f; }
    const gh16* kp = KF + (size_t)bh * 64 * 2048 + lane * 8;
    const gh16* rp = KRF + (size_t)b * 64 * 1024 + lane * 8;
    const gh16* vp = VF + (size_t)bh * 64 * 2048 + lane * 8;
    const lf32* nearR = (const lf32*)(lds + L_NEAR) + hb * 256;
    const gf32* bt = biasTab + hb * 2048;
    h16x8 kf[NQK], vf[4];
#pragma unroll
    for (int ks = 0; ks < NQK; ++ks) kf[ks] = (BR == 0 && ks >= 4) ? *(const GAS h16x8*)(rp + (ks - 4) * 512) : *(const GAS h16x8*)(kp + ks * 512);
    unsigned mw[2] = {0xffffffffu, 0xffffffffu}, mwn[2] = {0xffffffffu, 0xffffffffu};
    if (BR == 1) { mw[0] = mask[tokq[0] * 64]; mw[1] = mask[tokq[1] * 64]; }
#pragma unroll 1
    for (int j = 0; j <= qt1; ++j) {
#pragma unroll
        for (int f = 0; f < 4; ++f) vf[f] = *(const GAS h16x8*)(vp + (size_t)(hot ? 0 : j) * 2048 + f * 512);
        f32x16 S[2];
#pragma unroll
        for (int qi = 0; qi < 2; ++qi) { S[qi] = (f32x16){};
#pragma unroll
            for (int ks = 0; ks < NQK; ++ks) S[qi] = mfma32(kf[ks], qf[qi][ks], S[qi]); }
        if (j < qt1 && hot < 5) {
#pragma unroll
            for (int ks = 0; ks < NQK; ++ks) kf[ks] = (BR == 0 && ks >= 4) ? *(const GAS h16x8*)(rp + (size_t)(hot ? 0 : j + 1) * 1024 + (ks - 4) * 512) : *(const GAS h16x8*)(kp + (size_t)(hot ? 0 : j + 1) * 2048 + ks * 512);
            if (BR == 1) { mwn[0] = mask[tokq[0] * 64 + (j + 1 < qt1 ? j + 1 : j)]; mwn[1] = mask[tokq[1] * 64 + j + 1]; }
        }
#pragma unroll
        for (int qi = 0; qi < 2; ++qi) {
            const int qt = 2 * pr + qi;
            if (j <= qt) {
                const int D0 = (qt - j) * 32;
                if (hot >= 3) {} else
                if (BR == 0) {
                    if (D0 == 0) {
#pragma unroll
                        for (int r = 0; r < 16; ++r) S[qi][r] = (CROW(r) + 4 * h > q) ? -3e38f : S[qi][r];
                    }
                } else {
                    if (D0 < 192) {
                        const lf32* tp = nearR + (223 - D0 - q + 4 * h);
#pragma unroll
                        for (int r = 0; r < 16; ++r) S[qi][r] += tp[CROW(r)];
                    } else {
                        const int blo = far_bucket(D0 - 31), bhi = far_bucket(D0 + 31);
                        const lf32* biasL = (const lf32*)(lds + L_BIASL) + hb * 32;
                        const float lo = biasL[blo], hi = biasL[bhi];
                        if (blo == bhi) S[qi] += lo;
                        else {
                            const int x = D0 + q - 4 * h - far_start(bhi);
#pragma unroll
                            for (int r = 0; r < 16; ++r) S[qi][r] += (x >= CROW(r)) ? hi : lo;
                        }
                    }
                    const unsigned mm = mw[qi] >> (4 * h);
#pragma unroll
                    for (int r = 0; r < 16; ++r) S[qi][r] = ((mm >> CROW(r)) & 1u) ? S[qi][r] : -3e38f;
                }
                softmax_tile_h(S[qi], m[qi], l[qi], O[qi][0], O[qi][1], hot);
                const h16x8 p0 = pack8(S[qi], 0), p1 = pack8(S[qi], 1);
                if (hot < 4) {
                O[qi][0] = mfma32(vf[0], p0, O[qi][0]); O[qi][0] = mfma32(vf[1], p1, O[qi][0]);
                O[qi][1] = mfma32(vf[2], p0, O[qi][1]); O[qi][1] = mfma32(vf[3], p1, O[qi][1]);
                } else { O[qi][0][0] += (float)p0[0] + (float)p1[0]; }
            }
        }
        mw[0] = mwn[0]; mw[1] = mwn[1];
    }
#pragma unroll
    for (int qi = 0; qi < 2; ++qi) {
        const float il = 1.f / xh_sum(l[qi]);
        epi_gate_store<false>(O[qi][0], O[qi][1], il, gate + tokq[qi] * 1024 + mixcol + hh * 64 + 4 * h, nullptr, mix + mixf_off(tokq[qi], mixcol + hh * 64 + 4 * h), hot);
    }
}

template <int BR>
DEVI void flashWG_item(int b, int hh, int Qb, const gh16* Q, const gh16* KF, const gh16* KRF, const gh16* VF, const gu32* mask, lu8* lds,
                       const gf32* subln, float lambda_init, const gh16* gate, gh16* mix, int mixcol, int hb) {
    constexpr int NMAP = BR == 2 ? 2 : 1, NQK = BR == 0 ? 6 : 4, NKS = NQK / NMAP, NP = NQK + 4, TB = NP * 1024, NDMA = BR == 2 ? 1 : 2, DD = 3;
    const int tid = otid(), lane = tid & 63, q = lane & 31, h = lane >> 5, wv = __builtin_amdgcn_readfirstlane(tid >> 6);
    const int qt = 8 * Qb + wv, last = 8 * Qb + 7, bh = b * 4 + hh;
    const size_t tokq = (size_t)b * SEQ + qt * 32 + q;
    h16x8 qf[NQK];
#pragma unroll
    for (int ks = 0; ks < NQK; ++ks) qf[ks] = *(const GAS h16x8*)(Q + tokq * (BR == 0 ? 384 : 256) + hh * (BR == 0 ? 96 : 64) + ks * 16 + 8 * h);
    f32x16 O[NMAP][2]; float m[NMAP], l[NMAP];
#pragma unroll
    for (int mp = 0; mp < NMAP; ++mp) { O[mp][0] = (f32x16){}; O[mp][1] = (f32x16){}; m[mp] = -1e30f; l[mp] = 0.f; }
    asm volatile("s_waitcnt vmcnt(0)" ::: "memory");
    __syncthreads();
    lu8* ring = lds + L_RING; lu8* mring = lds + L_MRING;
    auto issue = [&](int jt) {
        const int jc = jt < last ? jt : last, slot = jt & 3;
        {
            const int pc = wv;
            const gh16* src = pc < 4 ? KF + ((size_t)bh * 64 + jc) * 2048 + pc * 512
                            : (BR == 0 && pc < 6) ? KRF + ((size_t)b * 64 + jc) * 1024 + (pc - 4) * 512
                            : VF + ((size_t)bh * 64 + jc) * 2048 + (pc - NQK) * 512;
            __builtin_amdgcn_global_load_lds((const GAS unsigned*)(src + lane * 8), (LAS unsigned*)(ring + slot * TB + pc * 1024), 16, 0, 0);
        }
        if (BR == 0) {
            const int pc = 8 + (wv & 1);
            const gh16* src = VF + ((size_t)bh * 64 + jc) * 2048 + (pc - NQK) * 512;
            __builtin_amdgcn_global_load_lds((const GAS unsigned*)(src + lane * 8), (LAS unsigned*)(ring + slot * TB + pc * 1024), 16, 0, 0);
        }
        if (BR == 1) __builtin_amdgcn_global_load_lds((const GAS unsigned*)(mask + tokq * 64 + (jc <= qt ? jc : qt)), (LAS unsigned*)(mring + (slot * 8 + wv) * 256), 4, 0, 0);
    };
#pragma unroll
    for (int jt = 0; jt < DD; ++jt) issue(jt);
    const lf32* nearR = (const lf32*)(lds + L_NEAR) + hb * 256;
    const lf32* biasL = (const lf32*)(lds + L_BIASL) + hb * 32;
    f32x16 S[NMAP], Sn[NMAP];
    asm volatile("s_waitcnt vmcnt(%0)" :: "n"((DD - 1) * NDMA) : "memory");
    __builtin_amdgcn_s_barrier();
#pragma unroll
    for (int mp = 0; mp < NMAP; ++mp) { S[mp] = (f32x16){};
#pragma unroll
        for (int ks = 0; ks < NKS; ++ks) S[mp] = mfma32(*(const LAS h16x8*)(ring + lane * 16 + (mp * NKS + ks) * 1024), qf[mp * NKS + ks], S[mp]); }
#pragma unroll 1
    for (int j = 0; j <= last; ++j) {
        asm volatile("s_waitcnt vmcnt(%0)" :: "n"((DD - 2) * NDMA) : "memory");
        __builtin_amdgcn_s_barrier();
        issue(j + DD);
        if (j <= qt) {
            const lu8* sl = ring + (j & 3) * TB + lane * 16;
            if (j + 1 <= qt) {
                const lu8* sn = ring + ((j + 1) & 3) * TB + lane * 16;
#pragma unroll
                for (int mp = 0; mp < NMAP; ++mp) { Sn[mp] = (f32x16){};
#pragma unroll
                    for (int ks = 0; ks < NKS; ++ks) Sn[mp] = mfma32(*(const LAS h16x8*)(sn + (mp * NKS + ks) * 1024), qf[mp * NKS + ks], Sn[mp]); }
            }
            h16x8 vf[4];
#pragma unroll
            for (int f = 0; f < 4; ++f) vf[f] = *(const LAS h16x8*)(sl + (NQK + f) * 1024);
            const int D0 = (qt - j) * 32;
            if (BR == 0) {
                if (D0 == 0) {
#pragma unroll
                    for (int r = 0; r < 16; ++r) S[0][r] = (CROW(r) + 4 * h > q) ? -3e38f : S[0][r];
                }
            } else if (D0 < 192) {
                const lf32* tp = nearR + (223 - D0 - q + 4 * h);
#pragma unroll
                for (int r = 0; r < 16; ++r) { const float bv = tp[CROW(r)];
#pragma unroll
                    for (int mp = 0; mp < NMAP; ++mp) S[mp][r] += bv; }
            } else {
                int blo = 23, bhi = 23;
#pragma unroll
                for (int jj = 8; jj < 16; ++jj) { blo += (D0 - 31 >= kBucketStart[jj]) ? 1 : 0; bhi += (D0 + 31 >= kBucketStart[jj]) ? 1 : 0; }
                const float lo = biasL[blo], hi = biasL[bhi];
                if (blo == bhi) {
#pragma unroll
                    for (int mp = 0; mp < NMAP; ++mp) S[mp] += lo;
                } else {
                    const int x = D0 + q - 4 * h - kBucketStart[bhi - 16];
#pragma unroll
                    for (int r = 0; r < 16; ++r) { const float bv = (x >= CROW(r)) ? hi : lo;
#pragma unroll
                        for (int mp = 0; mp < NMAP; ++mp) S[mp][r] += bv; }
                }
            }
            if (BR == 1) {
                const unsigned mw = *(const LAS unsigned*)(mring + ((j & 3) * 8 + wv) * 256 + lane * 4) >> (4 * h);
#pragma unroll
                for (int r = 0; r < 16; ++r) S[0][r] = ((mw >> CROW(r)) & 1u) ? S[0][r] : -3e38f;
            }
#pragma unroll
            for (int mp = 0; mp < NMAP; ++mp) {
                softmax_tile(S[mp], m[mp], l[mp], O[mp][0], O[mp][1]);
                const h16x8 p0 = pack8(S[mp], 0), p1 = pack8(S[mp], 1);
                O[mp][0] = mfma32(vf[0], p0, O[mp][0]); O[mp][0] = mfma32(vf[1], p1, O[mp][0]);
                O[mp][1] = mfma32(vf[2], p0, O[mp][1]); O[mp][1] = mfma32(vf[3], p1, O[mp][1]);
            }
#pragma unroll
            for (int mp = 0; mp < NMAP; ++mp) S[mp] = Sn[mp];
        }
    }
    asm volatile("s_waitcnt vmcnt(0)" ::: "memory");
    f32x16 R0, R1;
    if (NMAP == 2) {
        const float lam = *(const lf32*)(lds + L_LAM);
        const float i0 = 1.f / xh_sum(l[0]), i1 = lam / xh_sum(l[NMAP - 1]);
        R0 = O[0][0] * i0 - O[NMAP - 1][0] * i1; R1 = O[0][1] * i0 - O[NMAP - 1][1] * i1;
        float ss = 0.f;
#pragma unroll
        for (int r = 0; r < 16; ++r) ss += R0[r] * R0[r] + R1[r] * R1[r];
        ss = xh_sum(ss);
        const float rs = rsqrtf(ss * (1.f / 64.f) + EPS) * (1.f - lambda_init);
        R0 *= rs; R1 *= rs;
    } else {
        const float il = 1.f / xh_sum(l[0]);
        R0 = O[0][0] * il; R1 = O[0][1] * il;
    }
    const gh16* gp = gate + tokq * 1024 + mixcol + hh * 64 + 4 * h;
#pragma unroll
    for (int db = 0; db < 2; ++db)
#pragma unroll
        for (int g = 0; g < 4; ++g) {
            const h16x4 gv = *(const GAS h16x4*)(gp + db * 32 + 8 * g); h16x4 o;
#pragma unroll
            for (int e = 0; e < 4; ++e) { float v = (db ? R1[4 * g + e] : R0[4 * g + e]) * (float)gv[e];
                if (NMAP == 2) v *= subln[db * 32 + 8 * g + 4 * h + e];
                o[e] = (h16)v; }
            *(GAS h16x4*)(mix + mixf_off(tokq, mixcol + hh * 64 + db * 32 + 8 * g + 4 * h)) = o;
        }
}

constexpr int L_RING2 = 41984, L_MRING2 = L_RING2 + 8 * 10240, L_WQ2 = L_MRING2 + 8 * 8 * 256;
template <int BR>
DEVI void flashWG2_item(int b, int hh, int Qb, const gh16* Q, const gh16* KF, const gh16* KRF, const gh16* VF, const gu32* mask, lu8* lds,
                        const gf32* subln, float lambda_init, const gh16* gate, gh16* mix, int mixcol, int hb) {
    constexpr int NMAP = BR == 2 ? 2 : 1, NQK = BR == 0 ? 6 : 4, NKS = NQK / NMAP, NP = NQK + 4, TB = NP * 1024;
    const int tid = otid(), lane = tid & 63, q = lane & 31, h = lane >> 5, wv = __builtin_amdgcn_readfirstlane(tid >> 6);
    const int qt = 8 * Qb + wv, NS = 2 * Qb + 2, bh = b * 4 + hh;
    const size_t tokq = (size_t)b * SEQ + qt * 32 + q;
    h16x8 qf[NQK];
#pragma unroll
    for (int ks = 0; ks < NQK; ++ks) qf[ks] = *(const GAS h16x8*)(Q + tokq * (BR == 0 ? 384 : 256) + hh * (BR == 0 ? 96 : 64) + ks * 16 + 8 * h);
    f32x16 O[NMAP][2]; float m[NMAP], l[NMAP];
#pragma unroll
    for (int mp = 0; mp < NMAP; ++mp) { O[mp][0] = (f32x16){}; O[mp][1] = (f32x16){}; m[mp] = -1e30f; l[mp] = 0.f; }
    lu8* ring = lds + L_RING2; lu8* mring = lds + L_MRING2;
    auto issue = [&](int st) {
#pragma unroll
        for (int u = 0; u < (4 * NP + 7) / 8; ++u) {
            const int id = wv + 8 * u;
            if (id < 4 * NP) {
                const int ti = id / NP, pc = id % NP, jt = 4 * st + ti, slot = jt & 7;
                const gh16* src = pc < 4 ? KF + ((size_t)bh * 64 + jt) * 2048 + pc * 512
                                : (BR == 0 && pc < 6) ? KRF + ((size_t)b * 64 + jt) * 1024 + (pc - 4) * 512
                                : VF + ((size_t)bh * 64 + jt) * 2048 + (pc - NQK) * 512;
                __builtin_amdgcn_global_load_lds((const GAS unsigned*)(src + lane * 8), (LAS unsigned*)(ring + slot * TB + pc * 1024), 16, 0, 0);
            }
        }
        if (BR == 1) {
#pragma unroll
            for (int ti = 0; ti < 4; ++ti) { const int jt = 4 * st + ti;
                __builtin_amdgcn_global_load_lds((const GAS unsigned*)(mask + tokq * 64 + (jt <= qt ? jt : qt)), (LAS unsigned*)(mring + ((jt & 7) * 8 + wv) * 256), 4, 0, 0); }
        }
    };
    asm volatile("s_waitcnt vmcnt(0)" ::: "memory");
    __syncthreads();
    issue(0);
    const lf32* nearR = (const lf32*)(lds + L_NEAR) + hb * 256;
    const lf32* biasL = (const lf32*)(lds + L_BIASL) + hb * 32;
#pragma unroll 1
    for (int st = 0; st < NS; ++st) {
        asm volatile("s_waitcnt vmcnt(0)" ::: "memory");
        __builtin_amdgcn_s_barrier();
        if (st + 1 < NS) issue(st + 1);
#pragma unroll 1
        for (int j = 4 * st; j < 4 * st + 4; ++j) {
            if (j > qt) break;
            const lu8* sl = ring + (j & 7) * TB + lane * 16;
            f32x16 S[NMAP];
#pragma unroll
            for (int mp = 0; mp < NMAP; ++mp) { S[mp] = (f32x16){};
#pragma unroll
                for (int ks = 0; ks < NKS; ++ks) S[mp] = mfma32(*(const LAS h16x8*)(sl + (mp * NKS + ks) * 1024), qf[mp * NKS + ks], S[mp]); }
            h16x8 vf[4];
#pragma unroll
            for (int f = 0; f < 4; ++f) vf[f] = *(const LAS h16x8*)(sl + (NQK + f) * 1024);
            const int D0 = (qt - j) * 32;
            if (BR == 0) {
                if (D0 == 0) {
#pragma unroll
                    for (int r = 0; r < 16; ++r) S[0][r] = (CROW(r) + 4 * h > q) ? -3e38f : S[0][r];
                }
            } else if (D0 < 192) {
                const lf32* tp = nearR + (223 - D0 - q + 4 * h);
#pragma unroll
                for (int r = 0; r < 16; ++r) { const float bv = tp[CROW(r)];
#pragma unroll
                    for (int mp = 0; mp < NMAP; ++mp) S[mp][r] += bv; }
            } else {
                const int blo = far_bucket(D0 - 31), bhi = far_bucket(D0 + 31);
                const float lo = biasL[blo], hi = biasL[bhi];
                if (blo == bhi) {
#pragma unroll
                    for (int mp = 0; mp < NMAP; ++mp) S[mp] += lo;
                } else {
                    const int x = D0 + q - 4 * h - far_start(bhi);
#pragma unroll
                    for (int r = 0; r < 16; ++r) { const float bv = (x >= CROW(r)) ? hi : lo;
#pragma unroll
                        for (int mp = 0; mp < NMAP; ++mp) S[mp][r] += bv; }
                }
            }
            if (BR == 1) {
                const unsigned mw = *(const LAS unsigned*)(mring + ((j & 7) * 8 + wv) * 256 + lane * 4) >> (4 * h);
#pragma unroll
                for (int r = 0; r < 16; ++r) S[0][r] = ((mw >> CROW(r)) & 1u) ? S[0][r] : -3e38f;
            }
#pragma unroll
            for (int mp = 0; mp < NMAP; ++mp) {
                softmax_tile(S[mp], m[mp], l[mp], O[mp][0], O[mp][1]);
                const h16x8 p0 = pack8(S[mp], 0), p1 = pack8(S[mp], 1);
                O[mp][0] = mfma32(vf[0], p0, O[mp][0]); O[mp][0] = mfma32(vf[1], p1, O[mp][0]);
                O[mp][1] = mfma32(vf[2], p0, O[mp][1]); O[mp][1] = mfma32(vf[3], p1, O[mp][1]);
            }
        }
    }
    asm volatile("s_waitcnt vmcnt(0)" ::: "memory");
    f32x16 R0, R1;
    if (NMAP == 2) {
        const float lam = *(const lf32*)(lds + L_LAM);
        const float i0 = 1.f / xh_sum(l[0]), i1 = lam / xh_sum(l[NMAP - 1]);
        R0 = O[0][0] * i0 - O[NMAP - 1][0] * i1; R1 = O[0][1] * i0 - O[NMAP - 1][1] * i1;
        float ss = 0.f;
#pragma unroll
        for (int r = 0; r < 16; ++r) ss += R0[r] * R0[r] + R1[r] * R1[r];
        ss = xh_sum(ss);
        const float rs = rsqrtf(ss * (1.f / 64.f) + EPS) * (1.f - lambda_init);
        R0 *= rs; R1 *= rs;
    } else {
        const float il = 1.f / xh_sum(l[0]);
        R0 = O[0][0] * il; R1 = O[0][1] * il;
    }
    const gh16* gp = gate + tokq * 1024 + mixcol + hh * 64 + 4 * h;
#pragma unroll
    for (int db = 0; db < 2; ++db)
#pragma unroll
        for (int g = 0; g < 4; ++g) {
            const h16x4 gv = *(const GAS h16x4*)(gp + db * 32 + 8 * g); h16x4 o;
#pragma unroll
            for (int e = 0; e < 4; ++e) { float v = (db ? R1[4 * g + e] : R0[4 * g + e]) * (float)gv[e];
                if (NMAP == 2) v *= subln[db * 32 + 8 * g + 4 * h + e];
                o[e] = (h16)v; }
            *(GAS h16x4*)(mix + mixf_off(tokq, mixcol + hh * 64 + db * 32 + 8 * g + 4 * h)) = o;
        }
}


DEVI void probe_item(int ntile, int mode) {
    const int lane = otid() & 63;
    h16x8 a, bq;
#pragma unroll
    for (int e = 0; e < 8; ++e) { a[e] = (h16)(lane * 0.001f + e); bq[e] = (h16)(e * 0.01f); }
    f32x16 O0 = {}, O1 = {}; float m = -1e30f, l = 0.f;
#pragma unroll 1
    for (int j = 0; j < ntile; ++j) {
        f32x16 S = {};
#pragma unroll
        for (int ks = 0; ks < 6; ++ks) S = mfma32(a, bq, S);
        if (mode >= 1) softmax_tile(S, m, l, O0, O1);
        const h16x8 p0 = pack8(S, 0), p1 = pack8(S, 1);
        O0 = mfma32(a, p0, O0); O0 = mfma32(a, p1, O0);
        O1 = mfma32(a, p0, O1); O1 = mfma32(a, p1, O1);
    }
    asm volatile("" :: "v"(O0), "v"(O1), "v"(l));
}
DEVI void flashB_tile(const h16x8 (&qf)[4], const gh16* kfr, const gh16* vfr, const lf32* tp, f32x16& O0, f32x16& O1, float& m, float& l, int hot) {
    h16x8 vf[4], kf[4];
#pragma unroll
    for (int f = 0; f < 4; ++f) { kf[f] = *(const GAS h16x8*)(kfr + f * 512); vf[f] = *(const GAS h16x8*)(vfr + f * 512); }
    f32x16 S = {};
#pragma unroll
    for (int ks = 0; ks < 4; ++ks) S = mfma32(kf[ks], qf[ks], S);
    if (hot < 3) {
#pragma unroll
    for (int r = 0; r < 16; ++r) S[r] += tp[CROW(r)];
    }
    softmax_tile_h(S, m, l, O0, O1, hot);
    const h16x8 p0 = pack8(S, 0), p1 = pack8(S, 1);
    if (hot < 4) {
    O0 = mfma32(vf[0], p0, O0); O0 = mfma32(vf[1], p1, O0);
    O1 = mfma32(vf[2], p0, O1); O1 = mfma32(vf[3], p1, O1);
    } else { O0[0] += (float)p0[0] + (float)p1[0]; }
}
DEVI void flashB_item(int b, int hh, int r, int qg, const gh16* Q, const gh16* KF, const gh16* VF, const lu8* lds, const gh16* gate, gh16* mix, int hot = 0) {
    const int lane = otid() & 63, q = lane & 31, h = lane >> 5, bh = b * 4 + hh;
    const size_t tokq = (size_t)b * SEQ + qg * 512 + 16 * q + r;
    h16x8 qf[4];
#pragma unroll
    for (int ks = 0; ks < 4; ++ks) qf[ks] = *(const GAS h16x8*)(Q + tokq * 256 + hh * 64 + ks * 16 + 8 * h);
    f32x16 O0 = {}, O1 = {}; float m = -1e30f, l = 0.f;
    {
        const lf32* R3 = (const lf32*)(lds + L_R3) + hh * 192;
        const size_t base = 2 * FSZ + ((size_t)bh * 16 + r) * 4 * 2048 + lane * 8;
        for (int tl = (qg >= 4 ? qg - 4 : 0); tl <= qg; ++tl) {
            const int c = qg * 32 + q - tl * 32;
            flashB_tile(qf, KF + base + (size_t)(hot ? 0 : tl) * 2048, VF + base + (size_t)(hot ? 0 : tl) * 2048, R3 + (159 - c + 4 * h), O0, O1, m, l, hot);
        }
    }
    {
        const lf32* R2 = (const lf32*)(lds + L_R2) + hh * 384;
        const size_t base = FSZ + ((size_t)bh * 4 + (r & 3)) * 16 * 2048 + lane * 8;
        for (int tl = (qg >= 1 ? qg * 4 - 4 : 0); tl <= qg * 4 + 3; ++tl) {
            const int c = qg * 128 + 4 * q + (r >> 2) - tl * 32;
            flashB_tile(qf, KF + base + (size_t)(hot ? 0 : tl) * 2048, VF + base + (size_t)(hot ? 0 : tl) * 2048, R2 + (255 - c + 4 * h), O0, O1, m, l, hot);
        }
    }
    {
        const lf32* R1 = (const lf32*)(lds + L_R1) + hh * 1152;
        const size_t base = (size_t)bh * 64 * 2048 + lane * 8;
        for (int tl = (qg >= 1 ? qg * 16 - 4 : 0); tl <= qg * 16 + 15; ++tl) {
            const int c = qg * 512 + 16 * q + r - tl * 32;
            flashB_tile(qf, KF + base + (size_t)(hot ? 0 : tl) * 2048, VF + base + (size_t)(hot ? 0 : tl) * 2048, R1 + (639 - c + 4 * h), O0, O1, m, l, hot);
        }
    }
    const float il = 1.f / xh_sum(l);
    epi_gate_store<false>(O0, O1, il, gate + tokq * 1024 + 256 + hh * 64 + 4 * h, nullptr, mix + mixf_off(tokq, 256 + hh * 64 + 4 * h), hot);
}

typedef float f32x4v __attribute__((ext_vector_type(4)));
typedef unsigned u32x4v __attribute__((ext_vector_type(4)));
DEVI f32x4v mfma16(h16x8 a, h16x8 b, f32x4v c) { return __builtin_amdgcn_mfma_f32_16x16x32_f16(a, b, c, 0, 0, 0); }
constexpr int TK_KSTRIDE = 2308;
constexpr int TK_KEYS = 0, TK_MISC = 16 * TK_KSTRIDE * 4, TK_END = TK_MISC + 64;
DEVI void topk_item(int b, int T16, const gh16* idx, const gh16* KIF, gu32* mask, lu8* lds, int skip = 0) {
    const int tid = otid(), lane = tid & 63, wv = __builtin_amdgcn_readfirstlane(tid >> 6);
    const int t0 = T16 * 16;
    lu32* keys = (lu32*)(lds + TK_KEYS);
    if (T16 < 16) {
        const int sq = tid & 15, sc_ = tid >> 4;
        const unsigned tk = (unsigned)(b * SEQ + t0 + sq) * 64u + 2u * sc_;
        unsigned ones = 0xffffffffu; asm volatile("" : "+v"(ones));
        if (sc_ < 4) { mask[tk] = ones; mask[tk + 1] = ones; }
        return;
    }
    __syncthreads();
    if (skip == 2) return;
    {
        const int q = lane & 15, kq = lane >> 4;
        const size_t tokq = (size_t)b * SEQ + t0 + q;
        h16x8 qf[8], ql; float sg[8]; float P = 0.f, N = 0.f; float lin[8];
#pragma unroll
        for (int e = 0; e < 8; ++e) lin[e] = 0.f;
#pragma unroll
        for (int hd = 0; hd < 8; ++hd) {
            const h16x8 raw = *(const GAS h16x8*)(idx + tokq * 320 + hd * 32 + 8 * kq);
            const float c = (float)idx[tokq * 320 + 288 + hd] * (0.5f * 0.35355339059327373f), ac = fabsf(c);
            float nn = 0.f;
#pragma unroll
            for (int e = 0; e < 8; ++e) { const float v = (float)raw[e]; nn += v * v; lin[e] += c * v; qf[hd][e] = (h16)(ac * v); }
            nn += shflx(nn, 16); nn += shflx(nn, 32);
            const float bd = 2.f * ac * sqrtf(nn) * 12.f;
            if (c > 0.f) P += bd; else N += bd;
            sg[hd] = c >= 0.f ? 1.f : -1.f;
        }
#pragma unroll
        for (int e = 0; e < 8; ++e) ql[e] = (h16)lin[e];
        const float lo = -N, scl = 2097151.f / fmaxf(P + N, 1e-20f);
        const int nblk = T16 + 1, nblk2 = (nblk + 1) & ~1;
#pragma unroll 1
        for (int rpS = 0; rpS < (DUP_PHASE == 7 ? 2 : 1); ++rpS)
        {
            h16x8 kf4[4], kn4[4];
#pragma unroll
            for (int u = 0; u < 4; ++u) { const int kb = wv + 8 * u < nblk ? wv + 8 * u : 0; kf4[u] = *(const GAS h16x8*)(KIF + ((size_t)(b * 128 + kb) * 64 + lane) * 8); }
#pragma unroll 1
            for (int kb0 = wv; kb0 < nblk2; kb0 += 32) {
                if (kb0 + 32 < nblk2) {
#pragma unroll
                    for (int u = 0; u < 4; ++u) { const int kb = kb0 + 32 + 8 * u < nblk ? kb0 + 32 + 8 * u : 0; kn4[u] = *(const GAS h16x8*)(KIF + ((size_t)(b * 128 + kb) * 64 + lane) * 8); }
                }
#pragma unroll
                for (int u = 0; u < 4; ++u) {
                    const int kb = kb0 + 8 * u;
                    if (kb < nblk2) {
                        const h16x8 kf = kf4[u];
                        f32x4v sc = mfma16(kf, ql, (f32x4v){0.f, 0.f, 0.f, 0.f});
#pragma unroll
                        for (int hd = 0; hd < 8; ++hd) { const f32x4v x = mfma16(kf, qf[hd], (f32x4v){0.f, 0.f, 0.f, 0.f});
#pragma unroll
                            for (int r = 0; r < 4; ++r) sc[r] = __builtin_fmaf(__builtin_fabsf(x[r]), sg[hd], sc[r]); }
                        u32x4v kv;
#pragma unroll
                        for (int r = 0; r < 4; ++r) { const float x = fminf(fmaxf((sc[r] - lo) * scl, 0.f), 2097151.f); unsigned uu = (unsigned)x + 1u;
                            if (16 * kb + 4 * kq + r > t0 + q) uu = 0u; kv[r] = uu; }
                        const int k = 16 * kb + 4 * kq;
                        *(LAS u32x4v*)(keys + q * TK_KSTRIDE + k + 4 * (k >> 5)) = kv;
                    }
                }
#pragma unroll
                for (int u = 0; u < 4; ++u) kf4[u] = kn4[u];
            }
        }
    }
    __syncthreads();
    if (skip == 1) return;
    const int nw32 = (t0 + 16 + 31) >> 5;
    unsigned ka[32], kc[32];
    {
        const lu32* ra = keys + (2 * wv) * TK_KSTRIDE + 36 * lane, * rc = keys + (2 * wv + 1) * TK_KSTRIDE + 36 * lane;
        const bool have = lane < nw32;
#pragma unroll
        for (int i = 0; i < 8; ++i) {
            u32x4v va = {0u, 0u, 0u, 0u}, vc = {0u, 0u, 0u, 0u};
            if (have) { va = *(const LAS u32x4v*)(ra + 4 * i); vc = *(const LAS u32x4v*)(rc + 4 * i); }
#pragma unroll
            for (int r = 0; r < 4; ++r) { ka[4 * i + r] = va[r]; kc[4 * i + r] = vc[r]; }
        }
    }
    typedef unsigned short u16x2 __attribute__((ext_vector_type(2)));
    u16x2 kha[16], khc[16];
#pragma unroll
    for (int i = 0; i < 16; ++i) { kha[i] = (u16x2){(unsigned short)(ka[2 * i] >> 7), (unsigned short)(ka[2 * i + 1] >> 7)}; khc[i] = (u16x2){(unsigned short)(kc[2 * i] >> 7), (unsigned short)(kc[2 * i + 1] >> 7)}; }
    auto wave_sum2 = [&](unsigned v) -> unsigned {
        v += (unsigned)__builtin_amdgcn_update_dpp(0, (int)v, 0x111, 0xf, 0xf, false);
        v += (unsigned)__builtin_amdgcn_update_dpp(0, (int)v, 0x112, 0xf, 0xf, false);
        v += (unsigned)__builtin_amdgcn_update_dpp(0, (int)v, 0x114, 0xf, 0xf, false);
        v += (unsigned)__builtin_amdgcn_update_dpp(0, (int)v, 0x118, 0xf, 0xf, false);
        v += (unsigned)__builtin_amdgcn_update_dpp(0, (int)v, 0x142, 0xa, 0xf, false);
        v += (unsigned)__builtin_amdgcn_update_dpp(0, (int)v, 0x143, 0xc, 0xf, false);
        return (unsigned)__builtin_amdgcn_readlane((int)v, 63);
    };
    auto count2 = [&](unsigned Pa, unsigned Pc) -> unsigned {
        const unsigned short pa1 = (unsigned short)(Pa - 1u), pc1 = (unsigned short)(Pc - 1u);
        u16x2 aa = {0, 0}, ac = {0, 0};
#pragma unroll
        for (int i = 0; i < 16; ++i) { aa += ((u16x2){pa1, pa1} - kha[i]) >> 15; ac += ((u16x2){pc1, pc1} - khc[i]) >> 15; }
        return wave_sum2(((unsigned)aa[0] + (unsigned)aa[1]) | (((unsigned)ac[0] + (unsigned)ac[1]) << 16));
    };
    unsigned T15a = 0u, T15c = 0u;
#pragma unroll 1
    for (int bit = 14; bit >= 0; --bit) { const unsigned Pa = T15a | (1u << bit), Pc = T15c | (1u << bit); const unsigned c = count2(Pa, Pc);
        if ((c & 0xffffu) >= 256u) T15a = Pa;
        if ((c >> 16) >= 256u) T15c = Pc; }
    const unsigned cab = count2(T15a + 1u, T15c + 1u);
    unsigned Tq[2];
#pragma unroll
    for (int qq = 0; qq < 2; ++qq) {
        const unsigned T15 = qq ? T15c : T15a; const int above = (int)(qq ? (cab >> 16) : (cab & 0xffffu));
        unsigned c0 = 0u, c1 = 0u, nc = 0u;
#pragma unroll
        for (int i = 0; i < 32; ++i) { const unsigned k = qq ? kc[i] : ka[i]; const bool is = (k >> 7) == T15 && k != 0u; const unsigned v = (k & 127u) + 1u;
            c1 = (is && nc == 1u) ? v : c1; c0 = (is && nc == 0u) ? v : c0; nc += is ? 1u : 0u; }
        unsigned low = 0u;
        if (__ballot(nc > 2u) == 0ull) {
#pragma unroll 1
            for (int bit = 6; bit >= 0; --bit) { const unsigned P = low | (1u << bit);
                const unsigned lc = (c0 > P ? 1u : 0u) + (c1 > P ? 1u : 0u);
                const int c = above + __builtin_popcountll(__ballot(lc & 1u)) + 2 * __builtin_popcountll(__ballot(lc >> 1));
                if (c >= 256) low = P; }
        } else {
#pragma unroll 1
            for (int bit = 6; bit >= 0; --bit) { const unsigned P = (T15 << 7) | low | (1u << bit);
                unsigned lc = 0u;
#pragma unroll
                for (int i = 0; i < 32; ++i) lc += ((qq ? kc[i] : ka[i]) >= P) ? 1u : 0u;
                int c = 0;
#pragma unroll
                for (int bp = 0; bp < 6; ++bp) c += __builtin_popcountll(__ballot((lc >> bp) & 1u)) << bp;
                if (c >= 256) low |= (1u << bit); }
        }
        Tq[qq] = (T15 << 7) | low;
    }
    const unsigned Ta = Tq[0], Tc = Tq[1];
#pragma unroll
    for (int qq = 0; qq < 2; ++qq) {
        const unsigned T = qq ? Tc : Ta;
        unsigned gt = 0u, eq = 0u;
#pragma unroll
        for (int i = 31; i >= 0; --i) { const unsigned k = qq ? kc[i] : ka[i]; gt = (gt << 1) | (k > T ? 1u : 0u); eq = (eq << 1) | (k == T ? 1u : 0u); }
        const unsigned pcg = (unsigned)__builtin_popcount(gt), pce = (unsigned)__builtin_popcount(eq);
        int totg = 0, before = 0;
#pragma unroll
        for (int bp = 0; bp < 6; ++bp) {
            totg += __builtin_popcountll(__ballot((pcg >> bp) & 1u)) << bp;
            const unsigned long long mk = __ballot((pce >> bp) & 1u);
            before += (int)__builtin_amdgcn_mbcnt_hi((unsigned)(mk >> 32), __builtin_amdgcn_mbcnt_lo((unsigned)mk, 0u)) << bp;
        }
        const int R = 256 - totg;
        int allow = R - before; allow = allow < 0 ? 0 : (allow > pce ? pce : allow);
        unsigned keep = eq;
        if (allow < pce) { keep = 0u; unsigned e = eq; for (int c = 0; c < allow; ++c) { const unsigned bit = e & (0u - e); keep |= bit; e ^= bit; } }
        if (lane < nw32) mask[((size_t)b * SEQ + t0 + 2 * wv + qq) * 64 + lane] = gt | keep;
    }
}
DEVI void ph_topk(const gh16* idx, const gh16* KIF, gu32* mask, gu32* ctr, lu8* lds, int nrep) {
    lu32* slot = (lu32*)(lds + TK_MISC);
    const bool lead = otid() == 0;
    __syncthreads();
    if (lead) *slot = __hip_atomic_fetch_add(ctr, 1u, __ATOMIC_RELAXED, __HIP_MEMORY_SCOPE_AGENT);
    __syncthreads();
    int e = (int)*slot;
#pragma unroll 1
    while (e < 1024 * nrep) {
        unsigned nxt = 0u;
        if (lead) nxt = __hip_atomic_fetch_add(ctr, 1u, __ATOMIC_RELAXED, __HIP_MEMORY_SCOPE_AGENT);
        const int e2 = e & 1023;
        topk_item(e2 & 7, 127 - (e2 >> 3), idx, KIF, mask, lds, (DUP_PHASE >= 30 && e >= 1024) ? DUP_PHASE - 29 : 0);
        __syncthreads();
        if (lead) *slot = nxt;
        __syncthreads();
        e = (int)*slot;
    }
}

DEVI void ph_out(const gh16* mix, const gh16* WoT, const gf32* __restrict__ gpost, const gf32* h_in, gf32* h_out, gh16* h16o, gf32* rstd_next, bool write_next, lu8* lds) {
    const int tid = otid(), lane = tid & 63, q = lane & 31, h = lane >> 5, wv = __builtin_amdgcn_readfirstlane(tid >> 6);
    lf32* red = (lf32*)lds;
    for (int u = blockIdx.x; u < NT / 64; u += gridDim.x) {
        f32x16 acc[4][2];
#pragma unroll
        for (int rb = 0; rb < 4; ++rb) { acc[rb][0] = (f32x16){}; acc[rb][1] = (f32x16){}; }
        const gh16* apu = WoT + (size_t)(wv * 4) * 64 * 512;
        const gh16* bpu = mix + (size_t)(u * 2) * 64 * 512;
        const unsigned lo8 = lane * 8;
#define ap(off) (apu + (off) + lo8)
#define bp(off) (bpu + (off) + lo8)
        h16x8 a0[4], b0[2], a1[4], b1[2], a2[4], b2[2];
#define P3_LOAD(A, B, ks_) do { const int ko_ = ((ks_) < 64 ? (ks_) : 63) * 512; _Pragma("unroll") for (int rb = 0; rb < 4; ++rb) A[rb] = *(const GAS h16x8*)(ap(rb * 64 * 512 + ko_)); \
        _Pragma("unroll") for (int tb = 0; tb < 2; ++tb) B[tb] = *(const GAS h16x8*)(bp(tb * 64 * 512 + ko_)); } while (0)
#define P3_MMA(A, B) do { _Pragma("unroll") for (int rb = 0; rb < 4; ++rb) _Pragma("unroll") for (int tb = 0; tb < 2; ++tb) acc[rb][tb] = mfma32(A[rb], B[tb], acc[rb][tb]); } while (0)
        P3_LOAD(a0, b0, 0); P3_LOAD(a1, b1, 1);
#pragma unroll 1
        for (int ks = 0; ks < 63; ks += 3) {
            P3_LOAD(a2, b2, ks + 2); __builtin_amdgcn_sched_barrier(0); P3_MMA(a0, b0); __builtin_amdgcn_sched_barrier(0);
            P3_LOAD(a0, b0, ks + 3); __builtin_amdgcn_sched_barrier(0); P3_MMA(a1, b1); __builtin_amdgcn_sched_barrier(0);
            P3_LOAD(a1, b1, ks + 4); __builtin_amdgcn_sched_barrier(0); P3_MMA(a2, b2); __builtin_amdgcn_sched_barrier(0);
        }
        P3_MMA(a0, b0);
#undef P3_LOAD
#undef P3_MMA
#undef ap
#undef bp
        int qe = q, he = h; asm volatile("" : "+v"(qe), "+v"(he));
        __syncthreads();
#pragma unroll
        for (int tb = 0; tb < 2; ++tb) {
            float ss = 0.f;
#pragma unroll
            for (int rb = 0; rb < 4; ++rb)
#pragma unroll
                for (int r = 0; r < 16; ++r) ss += acc[rb][tb][r] * acc[rb][tb][r];
            ss = xh_sum(ss);
            if (he == 0) red[wv * 64 + tb * 32 + qe] = ss;
        }
        __syncthreads();
        float ssn[2] = {0.f, 0.f};
#pragma unroll
        for (int tb = 0; tb < 2; ++tb) {
            float tot = 0.f;
#pragma unroll
            for (int w2 = 0; w2 < 8; ++w2) tot += red[w2 * 64 + tb * 32 + qe];
            const float rs = rsqrtf(tot * (1.f / DM) + EPS);
            const size_t rowoff = (size_t)(u * 64 + tb * 32 + qe) * DM;
#pragma unroll
            for (int rb = 0; rb < 4; ++rb)
#pragma unroll
                for (int g = 0; g < 4; ++g) {
                    const int n = wv * 128 + rb * 32 + 8 * g + 4 * he;
                    const f32x4_t hv = *(const GAS f32x4_t*)(h_in + rowoff + n), gv = *(const GAS f32x4_t*)(gpost + n);
                    f32x4_t o;
                    o[0] = hv[0] + acc[rb][tb][4 * g + 0] * rs * gv[0]; o[1] = hv[1] + acc[rb][tb][4 * g + 1] * rs * gv[1];
                    o[2] = hv[2] + acc[rb][tb][4 * g + 2] * rs * gv[2]; o[3] = hv[3] + acc[rb][tb][4 * g + 3] * rs * gv[3];
                    *(GAS f32x4_t*)(h_out + rowoff + n) = o;
                    if (write_next) { h16x4 oh; oh[0] = (h16)o[0]; oh[1] = (h16)o[1]; oh[2] = (h16)o[2]; oh[3] = (h16)o[3]; *(GAS h16x4*)(h16o + rowoff + n) = oh;
                        ssn[tb] += o[0] * o[0] + o[1] * o[1] + o[2] * o[2] + o[3] * o[3]; }
                }
        }
        if (write_next) {
#pragma unroll
            for (int tb = 0; tb < 2; ++tb) { const float v = xh_sum(ssn[tb]); if (he == 0) red[512 + wv * 64 + tb * 32 + qe] = v; }
            __syncthreads();
            if (tid < 64) { float tot = 0.f;
#pragma unroll
                for (int w2 = 0; w2 < 8; ++w2) tot += red[512 + w2 * 64 + tid];
                rstd_next[u * 64 + tid] = rsqrtf(tot * (1.f / DM) + EPS); }
        }
    }
}

DEVI void mla_item(int it, const gh16* cA, const gh16* WuqT, const gh16* WukvT, const gf32* cosT, const gf32* sinT, gh16* qA, gh16* KFA, gh16* KRF, gh16* VFA) {
    const int lane = otid() & 63, q = lane & 31, h = lane >> 5;
    const size_t tok = (size_t)it * 32 + q; const int b = it >> 6, j = it & 63, s = j * 32 + q;
    const float qs = 0.10206207261596577f * LOG2E;
    {
        h16x8 cf[12]; float ss = 0.f;
#pragma unroll
        for (int ks = 0; ks < 12; ++ks) { cf[ks] = *(const GAS h16x8*)(cA + tok * 384 + ks * 16 + 8 * h);
#pragma unroll
            for (int e = 0; e < 8; ++e) { const float v = (float)cf[ks][e]; ss += v * v; } }
        const float rs = rsqrtf(xh_sum(ss) * (1.f / 192.f) + EPS) * qs;
#pragma unroll 1
        for (int nb = 0; nb < 12; ++nb) {
            f32x16 acc = {};
            const gh16* wp = WuqT + (size_t)nb * 12 * 512 + lane * 8;
#pragma unroll
            for (int ks = 0; ks < 12; ++ks) acc = mfma32(*(const GAS h16x8*)(wp + ks * 512), cf[ks], acc);
            acc *= rs;
            const int hh = nb / 3, part = nb % 3;
            if (part == 2) {
#pragma unroll
                for (int r = 0; r < 8; ++r) { const int i = CROW(r) + 4 * h; const float c = cosT[s * 16 + i], sn = sinT[s * 16 + i], x1 = acc[r], x2 = acc[r + 8];
                    acc[r] = x1 * c - x2 * sn; acc[r + 8] = x1 * sn + x2 * c; }
            }
            gh16* op = qA + tok * 384 + hh * 96 + part * 32 + 4 * h;
#pragma unroll
            for (int g = 0; g < 4; ++g) { h16x4 o; o[0] = (h16)acc[4 * g]; o[1] = (h16)acc[4 * g + 1]; o[2] = (h16)acc[4 * g + 2]; o[3] = (h16)acc[4 * g + 3]; *(GAS h16x4*)(op + 8 * g) = o; }
        }
    }
    {
        h16x8 cf[8]; float ss = 0.f;
#pragma unroll
        for (int ks = 0; ks < 8; ++ks) { cf[ks] = *(const GAS h16x8*)(cA + tok * 384 + 192 + ks * 16 + 8 * h);
#pragma unroll
            for (int e = 0; e < 8; ++e) { const float v = (float)cf[ks][e]; ss += v * v; } }
        const float rs = rsqrtf(xh_sum(ss) * (1.f / 128.f) + EPS);
#pragma unroll
        for (int ks = 0; ks < 8; ++ks)
#pragma unroll
            for (int e = 0; e < 8; ++e) cf[ks][e] = (h16)((float)cf[ks][e] * rs);
#pragma unroll 1
        for (int nb = 0; nb < 16; ++nb) {
            const int hh = nb >> 2, sub = nb & 3, bh = b * 4 + hh;
            const gh16* wp = WukvT + (size_t)nb * 8 * 512 + lane * 8;
            f32x16 acc = {};
            if (sub < 2) {
#pragma unroll
                for (int ks = 0; ks < 8; ++ks) acc = mfma32(*(const GAS h16x8*)(wp + ks * 512), cf[ks], acc);
#pragma unroll
                for (int g = 0; g < 4; ++g) { h16x4 o; o[0] = (h16)acc[4 * g]; o[1] = (h16)acc[4 * g + 1]; o[2] = (h16)acc[4 * g + 2]; o[3] = (h16)acc[4 * g + 3];
                    *(GAS h16x4*)(KFA + ((((size_t)bh * 64 + j) * 4 + 2 * sub + (g >> 1)) * 64 + q + 32 * (g & 1)) * 8 + 4 * h) = o; }
            } else {
#pragma unroll
                for (int ks = 0; ks < 8; ++ks) acc = mfma32(cf[ks], *(const GAS h16x8*)(wp + ks * 512), acc);
#pragma unroll
                for (int sk = 0; sk < 2; ++sk) { h16x8 o;
#pragma unroll
                    for (int e = 0; e < 8; ++e) o[e] = (h16)acc[8 * sk + e];
                    *(GAS h16x8*)(VFA + ((((size_t)bh * 64 + j) * 4 + (sub - 2) * 2 + sk) * 64 + lane) * 8) = o; }
            }
        }
    }
    {
        const h16x8 a = *(const GAS h16x8*)(cA + tok * 384 + 320 + 8 * h), c2 = *(const GAS h16x8*)(cA + tok * 384 + 336 + 8 * h);
        h16x8 o1, o2;
#pragma unroll
        for (int e = 0; e < 8; ++e) { const int i = 8 * h + e; const float c = cosT[s * 16 + i], sn = sinT[s * 16 + i], x1 = (float)a[e], x2 = (float)c2[e];
            o1[e] = (h16)(x1 * c - x2 * sn); o2[e] = (h16)(x1 * sn + x2 * c); }
        *(GAS h16x8*)(KRF + (((size_t)b * 64 + j) * 2 + 0) * 512 + lane * 8) = o1; *(GAS h16x8*)(KRF + (((size_t)b * 64 + j) * 2 + 1) * 512 + lane * 8) = o2;
    }
}
DEVI void ph_small_weights(const gf32* w_uq, const gf32* qn, const gf32* w_ukv, const gf32* kvn, gh16* WuqF, gh16* WukvF) {
    const int gt = blockIdx.x * NTHR + otid(), nthr = gridDim.x * NTHR;
    for (int i = gt; i < 2 * 12 * 12 * 64; i += nthr) { const int lane = i & 63, ks = (i >> 6) % 12, nb = (i / (64 * 12)) % 12, l = i / (64 * 144);
        h16x8 o;
#pragma unroll
        for (int e = 0; e < 8; ++e) { const int k = 16 * ks + 8 * (lane >> 5) + e; o[e] = (h16)(w_uq[(size_t)l * 192 * 384 + k * 384 + nb * 32 + (lane & 31)] * qn[l * 192 + k]); }
        *(GAS h16x8*)(WuqF + (size_t)i * 8) = o; }
    for (int i = gt; i < 2 * 16 * 8 * 64; i += nthr) { const int lane = i & 63, ks = (i >> 6) & 7, nb = (i >> 9) & 15, l = i >> 13;
        h16x8 o;
#pragma unroll
        for (int e = 0; e < 8; ++e) { const int k = 16 * ks + 8 * (lane >> 5) + e; o[e] = (h16)(w_ukv[(size_t)l * 128 * 512 + k * 512 + nb * 32 + (lane & 31)] * kvn[l * 128 + k]); }
        *(GAS h16x8*)(WukvF + (size_t)i * 8) = o; }
}

constexpr int LDS_BYTES = 160 * 1024;
struct Params { const float* in[12]; float* out; unsigned char* ws; };

DEVI void ph_tables(const gf32* __restrict__ rel_bias, gf32* biasTab, gf32* cosT, gf32* sinT) {
    for (int i = blockIdx.x * NTHR + threadIdx.x; i < 2048 * 16; i += gridDim.x * NTHR) {
        if (i < 12 * 2048) { int hh = i / 2048, n = i % 2048; biasTab[i] = rel_bias[t5_bucket(n) * 12 + hh] * LOG2E; }
        int pos = i / 16, j = i % 16;
        float inv = (float)pow(10000.0, -(double)(2 * j) / 32.0);
        float ang = (float)pos * inv;
        cosT[i] = (float)cos((double)ang); sinT[i] = (float)sin((double)ang);
    }
}

extern __shared__ __attribute__((aligned(16))) unsigned char smem[];
constexpr int LDS_BAR_OFF = 160 * 1024 - 16;

#define REP(k) for (int rep_ = 0; rep_ < ((DUP_PHASE == (k)) ? 2 : 1); ++rep_)
DEVI gu8* ows(unsigned char* w0) { gu8* w = (gu8*)w0; asm volatile("" : "+s"(w)); return w; }
#define WSP(T, off) ((GAS T*)(w + (off)))
#define OSP(T, off) ((GAS T*)(wo + (off)))
DEVI const gf32* gin_(int k) { const __attribute__((address_space(4))) char* ka = (const __attribute__((address_space(4))) char*)__builtin_amdgcn_kernarg_segment_ptr(); int off = k * 8; asm volatile("" : "+s"(off));
    return (const gf32*)*(const float* const __attribute__((address_space(4)))*)(ka + off); }
#define GIN(k) gin_(k)

DEVI lu8* olds() { lu8* l = (lu8*)smem; asm volatile("" : "+s"(l)); return l; }
__global__ void __launch_bounds__(NTHR, 2) mega(Params p) {
    if (threadIdx.x == 0) *(uint4*)(smem + LDS_BAR_OFF) = make_uint4(0u, 0u, 0u, 0u);
    __syncthreads();
    XcdBarrier bar = xcd_barrier_post((unsigned*)(p.ws + OFF_CTL), (volatile LAS unsigned*)(smem + LDS_BAR_OFF));
    const int nw = gridDim.x * NWAVE;

    REP(1) {
        gu8* w = ows(p.ws);
        for (int r_ = 0; r_ < ((P0_DUP & 4) ? 2 : 1); ++r_) ph_tables(GIN(11), WSP(float, OFF_BIAS), WSP(float, OFF_COS), WSP(float, OFF_SIN));
        for (int r_ = 0; r_ < ((P0_DUP & 1) ? 2 : 1); ++r_) {
        int base = 0; const int total = 2 * (64 * 16) + 2 * (16 * 16);
        cvt_transpose<true>(GIN(1), INC, GIN(3), WSP(h16, OFF_WINT), MYC, DM, olds(), blockIdx.x, total, base);
        cvt_transpose<true>(GIN(1) + (size_t)DM * INC, INC, GIN(3) + DM, WSP(h16, OFF_WINT) + (size_t)MYC * DM, MYC, DM, olds(), blockIdx.x, total, base);
        cvt_transpose<false>(GIN(2), DM, nullptr, WSP(h16, OFF_WOUTT), DM, DM, olds(), blockIdx.x, total, base);
        cvt_transpose<false>(GIN(2) + (size_t)DM * DM, DM, nullptr, WSP(h16, OFF_WOUTT) + (size_t)DM * DM, DM, DM, olds(), blockIdx.x, total, base);
        }
        for (int r_ = 0; r_ < ((P0_DUP & 4) ? 2 : 1); ++r_) ph_small_weights(GIN(7), GIN(5), GIN(8), GIN(6), WSP(h16, OFF_WUQT), WSP(h16, OFF_WUKVT));
        for (int r_ = 0; r_ < ((P0_DUP & 2) ? 2 : 1); ++r_) ph_rowstat_cvt(GIN(0), WSP(float, OFF_SSQH), WSP(h16, OFF_H16));
    }
    xcd_barrier(bar);
    for (int layer = 0; layer < 2; ++layer) {
        const float lambda_init = layer == 0 ? 0.2f : 0.35550906759f;
        REP(2) {
            if (rep_) xcd_barrier(bar);
            gu8* w = ows(p.ws);
            pg8::Gemm g{(const pg8::bf16_t*)(p.ws + OFF_H16), (const pg8::bf16_t*)(p.ws + OFF_WINT) + (size_t)layer * MYC * DM, NT, MYC, DM};
            int bid_ = (int)blockIdx.x; asm volatile("" : "+s"(bid_));
            for (int g_ = (bid_ >> 3) & 7; g_ > 0; --g_) __builtin_amdgcn_s_sleep(28);
            pg8::StaticOrder S; S.init(NT, MYC, (int)gridDim.x, bid_);
            EpiRoute E{w, WSP(float, OFF_SSQH)};
            pg8::gemm_phase<EpiRoute, pg8::StaticOrder, true, true>(olds(), g, S, E);
        }
        xcd_barrier(bar);
        REP(3) {
            gu8* w = ows(p.ws); gu8* wo = ows((unsigned char*)p.out);
            for (int it = ogw(); it < NT / 32; it += nw) mla_item(it, WSP(h16, OFF_CA), WSP(h16, OFF_WUQT) + (size_t)layer * 384 * 192, WSP(h16, OFF_WUKVT) + (size_t)layer * 512 * 128, WSP(float, OFF_COS), WSP(float, OFF_SIN), OSP(h16, OUT_QA), OSP(h16, OUT_KFA), OSP(h16, OUT_KRF), OSP(h16, OUT_VFA));
        }
        REP(3) {
            gu8* w = ows(p.ws);
            ph_vtrans(WSP(h16, OFF_VTMP), WSP(h16, OFF_VF), olds());
        }
        {
            gu8* w = ows(p.ws);
            ph_topk(WSP(h16, OFF_IDX), WSP(h16, OFF_KIF), WSP(unsigned, OFF_MASK), WSP(unsigned, OFF_CTL) + 3600 + 16 * (40 + layer), olds(), (DUP_PHASE == 4 || DUP_PHASE >= 30) ? 2 : 1);
        }
        xcd_barrier(bar);
        for (int rep_ = 0; rep_ < ((DUP_PHASE == 5 || DUP_PHASE >= 10) ? 2 : 1); ++rep_) {
            if (rep_) xcd_barrier(bar);
            const int hot_ = (DUP_PHASE >= 10 && rep_) ? DUP_PHASE - 9 : 0;
            gu8* w = ows(p.ws); gu8* wo = ows((unsigned char*)p.out);
            p2_setup(WSP(float, OFF_BIAS), GIN(9) + layer * 128, lambda_init, olds());
            if (DUP_PHASE >= 20 && rep_) { probe_item(130, DUP_PHASE - 20); continue; }
            const int xcc = (int)(xb_xcc_id() & 7u);
            bool first = gridDim.x == 256;
            for (int dq = 0; dq < 8; ++dq) {
                const int bq_ = (xcc + dq) & 7;
                gu32* ctr = WSP(unsigned, OFF_CTL) + 3600 + 16 * (bq_ + 8 * layer + 16 * rep_);
                for (;;) {
                    int bq, e;
                    if (first) { first = false; int bi = (int)blockIdx.x; asm volatile("" : "+s"(bi)); bq = bi & 7; e = (bi >> 3) * 8 + __builtin_amdgcn_readfirstlane(otid() >> 6); }
                    else {
                        volatile lu32* qd = (volatile lu32*)(olds() + L_QDONE) + bq_;
                        if (*qd) break;
                        e = wq_next(ctr) + (gridDim.x == 256 ? 256 : 0);
                        if (e >= 768) { *qd = 1u; break; }
                        bq = bq_;
                    }
                    if (e >= 512) { const int e2 = e - 512, hh = e2 >> 6, lvl = e2 & 63;
                        flashB_item(bq, hh, lvl & 15, lvl >> 4, WSP(h16, OFF_QB), WSP(h16, OFF_KFB), WSP(h16, OFF_VF), olds(), WSP(h16, OFF_GATE), WSP(h16, OFF_MIX), hot_); }
                    else if (e >= 384) { const int e2 = e - 384, hh = e2 >> 5, pr = 31 - (e2 & 31);
                        flashQ2_item<0>(bq, hh, pr, OSP(h16, OUT_QA), OSP(h16, OUT_KFA), OSP(h16, OUT_KRF), OSP(h16, OUT_VFA), nullptr, WSP(float, OFF_BIAS), olds(), WSP(h16, OFF_GATE), WSP(h16, OFF_MIX), 0, 0, hot_); }
                    else if (e >= 256) { const int e2 = e - 256, hh = e2 >> 5, pr = 31 - (e2 & 31);
                        flashQ2_item<1>(bq, hh, pr, WSP(h16, OFF_QC), WSP(h16, OFF_KFC), nullptr, WSP(h16, OFF_VF) + 3 * FSZ, WSP(unsigned, OFF_MASK), WSP(float, OFF_BIAS), olds(), WSP(h16, OFF_GATE), WSP(h16, OFF_MIX), 512, 4 + hh, hot_); }
                    else { const int hh = e >> 6, lvl = 63 - (e & 63);
                        flashCD_item<2, false>(bq, hh, lvl, 8 + hh, WSP(h16, OFF_QD), WSP(h16, OFF_KFD), WSP(h16, OFF_VF) + 4 * FSZ, nullptr, WSP(float, OFF_BIAS), olds(),
                                               GIN(10) + layer * 64, lambda_init, WSP(h16, OFF_GATE), WSP(h16, OFF_MIX), 768, hot_); }
                }
            }
        }
        xcd_barrier(bar);
        for (int rep_ = 0; rep_ < ((DUP_PHASE == 6 && layer == 0) ? 2 : 1); ++rep_) {
            if (rep_) xcd_barrier(bar);
            gu8* w = ows(p.ws);
int bid_ = (int)blockIdx.x; asm volatile("" : "+s"(bid_));
            pg8::Gemm g{(const pg8::bf16_t*)(p.ws + OFF_MIX), (const pg8::bf16_t*)(p.ws + OFF_WOUTT) + (size_t)layer * DM * DM, NT, DM, DM};
            pg8::StaticOrder S; S.init(NT, DM, (int)gridDim.x, bid_);
            EpiOut E{(gf32*)p.out, WSP(h16, OFF_H16), GIN(4) + layer * DM, WSP(float, OFF_SSQY), WSP(float, OFF_SSQH), &bar, layer == 0};
            pg8::gemm_phase<EpiOut, pg8::StaticOrder, false, true>(olds(), g, S, E);
        }
        if (layer == 0) xcd_barrier(bar);
    }
}

extern "C" void kernel_launch(void* const* d_in, const int* in_sizes, int n_in, void* d_out, int out_size, void* d_ws, size_t ws_size, hipStream_t stream) {
    static int grid = 0;
    if (grid == 0) {
        int dev = 0, cus = 0, per_cu = 0;
        (void)hipGetDevice(&dev);
        (void)hipDeviceGetAttribute(&cus, hipDeviceAttributeMultiprocessorCount, dev);
        (void)hipFuncSetAttribute((const void*)mega, hipFuncAttributeMaxDynamicSharedMemorySize, LDS_BYTES);
        (void)hipOccupancyMaxActiveBlocksPerMultiprocessor(&per_cu, (const void*)mega, NTHR, LDS_BYTES);
        (void)hipGetLastError();
        grid = (cus > 0 && cus < 256) ? cus : 256;
    }
    (void)hipMemsetAsync((char*)d_ws + OFF_CTL, 0, 32768, stream);
    Params p{};
    for (int i = 0; i < 12; ++i) p.in[i] = (const float*)d_in[i];
    p.out = (float*)d_out; p.ws = (unsigned char*)d_ws;
    hipLaunchKernelGGL(mega, dim3(grid), dim3(NTHR), LDS_BYTES, stream, p);
}
```

```cpp
#include <hip/hip_runtime.h>
#include <stdint.h>
#include <math.h>

#ifndef DUP_PHASE
#define DUP_PHASE 0
#endif
#ifndef P0_DUP
#define P0_DUP 0
#endif
typedef _Float16 h16;
#define GAS __attribute__((address_space(1)))
#define LAS __attribute__((address_space(3)))
typedef GAS h16 gh16; typedef GAS float gf32; typedef GAS unsigned gu32; typedef GAS unsigned char gu8;
typedef LAS h16 lh16; typedef LAS float lf32; typedef LAS unsigned lu32; typedef LAS unsigned char lu8;
#define DEVI __device__ __forceinline__
DEVI int ogw();
DEVI int otid() { int t = threadIdx.x; asm volatile("" : "+v"(t)); return t; }
DEVI float x16_sum(float x); DEVI float xh_sum(float x);
DEVI float shflx(float v, int m) { const int l = (otid() & 63) ^ m; return __int_as_float(__builtin_amdgcn_ds_bpermute(l << 2, __float_as_int(v))); }

constexpr int NB = 8, SEQ = 2048, DM = 1024, NT = NB * SEQ, INC = 3976, MYC = 4096;
constexpr float LOG2E = 1.4426950408889634f;
constexpr float EPS = 1e-6f;

DEVI int ogw() { return blockIdx.x * 8 + (otid() >> 6); }
__host__ __device__ constexpr int ref_col(int my) {
    if (my < 352) return my;
    if (my < 384) return -1;
    if (my < 640) return 352 + (my - 384);
    if (my < 896) return 1376 + (my - 640);
    if (my < 1152) return 2696 + (my - 896);
    if (my < 1408) return 3720 + (my - 1152);
    if (my < 1664) return 608 + (my - 1408);
    if (my < 1920) return 864 + (my - 1664);
    if (my < 2176) return 1632 + (my - 1920);
    if (my < 2432) return 1888 + (my - 2176);
    if (my < 2688) return 2952 + (my - 2432);
    if (my < 2944) return 3208 + (my - 2688);
    if (my < 3200) return 1120 + (my - 2944);
    if (my < 3456) return 2144 + (my - 3200);
    if (my < 3712) return 3464 + (my - 3456);
    if (my < 3968) return 2400 + (my - 3712);
    if (my < 4000) return 2656 + (my - 3968);
    if (my < 4008) return 2688 + (my - 4000);
    return -1;
}

constexpr size_t MiB = 1024 * 1024;
constexpr size_t OFF_CTL = 0;
constexpr size_t OFF_RSTD = 64 * 1024;
constexpr size_t OFF_BIAS = 128 * 1024;
constexpr size_t OFF_COS = 256 * 1024;
constexpr size_t OFF_SIN = 384 * 1024;
constexpr size_t OFF_SSQY = 512 * 1024;
constexpr size_t OFF_SSQH = 768 * 1024;
constexpr size_t OFF_CA = 1 * MiB;
constexpr size_t OFF_GATE = OFF_CA + 12 * MiB;
constexpr size_t OFF_QB = OFF_GATE + 32 * MiB;
constexpr size_t OFF_QC = OFF_QB + 8 * MiB;
constexpr size_t OFF_QD = OFF_QC + 8 * MiB;
constexpr size_t OFF_KFB = OFF_QD + 8 * MiB;
constexpr size_t OFF_KFC = OFF_KFB + 24 * MiB;
constexpr size_t OFF_KFD = OFF_KFC + 8 * MiB;
constexpr size_t OFF_IDX = OFF_KFD + 8 * MiB;
constexpr size_t OFF_KIF = OFF_IDX + 10 * MiB;
constexpr size_t OFF_MIX = OFF_KIF + 1 * MiB;
constexpr size_t OFF_VTMP = OFF_MIX;
constexpr size_t OFF_MASK = OFF_MIX + 32 * MiB;
constexpr size_t OFF_H16 = OFF_MASK + 4 * MiB;
constexpr size_t OUT_QA = 0;
constexpr size_t OUT_KFA = OUT_QA + 12 * MiB;
constexpr size_t OUT_KRF = OUT_KFA + 8 * MiB;
constexpr size_t OUT_VFA = OUT_KRF + 1 * MiB;
constexpr size_t OFF_WINT = OFF_H16 + 32 * MiB;
constexpr size_t OFF_WOUTT = OFF_WINT + 16 * MiB;
constexpr size_t OFF_WUQT = OFF_WOUTT + 4 * MiB;
constexpr size_t OFF_WUKVT = OFF_WUQT + 512 * 1024;
constexpr size_t OFF_VF = OFF_WUKVT + 512 * 1024;
constexpr size_t OFF_END = OFF_VF + 40 * MiB;
static_assert(OFF_END <= 256 * MiB, "ws map");

struct Route { int kind; size_t off; int dcol; int pitch; float scale; int silu; };
__host__ __device__ inline Route route(int my) {
    Route r{-1, 0, 0, 0, 1.f, 0};
    if (my < 384) { r.kind = 0; r.off = OFF_CA; r.dcol = my; r.pitch = 384; }
    else if (my < 1408) { r.kind = 0; r.off = OFF_GATE; r.dcol = my - 384; r.pitch = 1024; r.silu = 1; }
    else if (my < 1664) { r.kind = 0; r.off = OFF_QB; r.dcol = my - 1408; r.pitch = 256; r.scale = 0.125f * LOG2E; }
    else if (my < 1920) { r.kind = 2; r.off = OFF_KFB; r.dcol = my - 1664; }
    else if (my < 2176) { r.kind = 0; r.off = OFF_QC; r.dcol = my - 1920; r.pitch = 256; r.scale = 0.125f * LOG2E; }
    else if (my < 2432) { r.kind = 1; r.off = OFF_KFC; r.dcol = my - 2176; }
    else if (my < 2688) { r.kind = 0; r.off = OFF_QD; r.dcol = my - 2432; r.pitch = 256; r.scale = 0.17677669529663687f * LOG2E; }
    else if (my < 2944) { r.kind = 1; r.off = OFF_KFD; r.dcol = my - 2688; }
    else if (my < 3712) { r.kind = 0; r.off = OFF_VTMP; r.dcol = my - 2944; r.pitch = 768; }
    else if (my < 3968) { r.kind = 0; r.off = OFF_IDX; r.dcol = my - 3712; r.pitch = 320; r.scale = 0.17677669529663687f; }
    else if (my < 4000) { r.kind = 3; r.off = OFF_KIF; r.dcol = my - 3968; }
    else if (my < 4032) { r.kind = 0; r.off = OFF_IDX; r.dcol = my - 3712; r.pitch = 320; }
    return r;
}
DEVI size_t kf_off(int bh, int s, int d0) { return ((((size_t)bh * 64 + (s >> 5)) * 4 + (d0 >> 4)) * 64 + (s & 31) + 32 * ((d0 >> 3) & 1)) * 8; }
DEVI size_t kf4_off(int bh, int s, int d0) { const int pp = s >> 2, r4 = s & 3; return (((((size_t)bh * 4 + r4) * 16 + (pp >> 5)) * 4 + (d0 >> 4)) * 64 + (pp & 31) + 32 * ((d0 >> 3) & 1)) * 8; }
DEVI size_t kf16_off(int bh, int s, int d0) { const int pp = s >> 4, r = s & 15; return (((((size_t)bh * 16 + r) * 4 + (pp >> 5)) * 4 + (d0 >> 4)) * 64 + (pp & 31) + 32 * ((d0 >> 3) & 1)) * 8; }
DEVI size_t mixf_off(size_t tok, int c0) { return tok * 1024 + (size_t)c0; }
constexpr size_t FSZ = (size_t)32 * 64 * 4 * 64 * 8;

__device__ __constant__ unsigned short kP2Order[1024] = {63, 127, 191, 255, 62, 126, 190, 254, 61, 125, 189, 253, 60, 124, 188, 252, 59, 123, 187, 251, 58, 122, 186, 250, 57, 121, 185, 249, 56, 120, 184, 248, 55, 119, 183, 247, 54, 118, 182, 246, 53, 117, 181, 245, 52, 116, 180, 244, 51, 115, 179, 243, 50, 114, 178, 242, 49, 113, 177, 241, 48, 112, 176, 240, 47, 111, 175, 239, 46, 110, 174, 238, 45, 109, 173, 237, 44, 108, 172, 236, 43, 107, 171, 235, 42, 106, 170, 234, 41, 105, 169, 233, 40, 104, 168, 232, 39, 103, 167, 231, 319, 383, 447, 511, 318, 382, 446, 510, 38, 102, 166, 230, 317, 381, 445, 509, 316, 380, 444, 508, 37, 101, 165, 229, 315, 379, 443, 507, 36, 100, 164, 228, 314, 378, 442, 506, 313, 377, 441, 505, 35, 99, 163, 227, 312, 376, 440, 504, 34, 98, 162, 226, 311, 375, 439, 503, 310, 374, 438, 502, 33, 97, 161, 225, 309, 373, 437, 501, 308, 372, 436, 500, 32, 96, 160, 224, 307, 371, 435, 499, 31, 95, 159, 223, 306, 370, 434, 498, 305, 369, 433, 497, 30, 94, 158, 222, 304, 368, 432, 496, 29, 93, 157, 221, 303, 367, 431, 495, 302, 366, 430, 494, 28, 92, 156, 220, 301, 365, 429, 493, 300, 364, 428, 492, 27, 91, 155, 219, 299, 363, 427, 491, 26, 90, 154, 218, 298, 362, 426, 490, 575, 639, 703, 767, 297, 361, 425, 489, 574, 638, 702, 766, 25, 89, 153, 217, 573, 637, 701, 765, 296, 360, 424, 488, 572, 636, 700, 764, 24, 88, 152, 216, 295, 359, 423, 487, 571, 635, 699, 763, 570, 634, 698, 762, 294, 358, 422, 486, 569, 633, 697, 761, 23, 87, 151, 215, 293, 357, 421, 485, 568, 632, 696, 760, 567, 631, 695, 759, 292, 356, 420, 484, 22, 86, 150, 214, 566, 630, 694, 758, 291, 355, 419, 483, 565, 629, 693, 757, 564, 628, 692, 756, 21, 85, 149, 213, 290, 354, 418, 482, 563, 627, 691, 755, 289, 353, 417, 481, 562, 626, 690, 754, 20, 84, 148, 212, 561, 625, 689, 753, 288, 352, 416, 480, 560, 624, 688, 752, 19, 83, 147, 211, 287, 351, 415, 479, 559, 623, 687, 751, 558, 622, 686, 750, 286, 350, 414, 478, 557, 621, 685, 749, 18, 82, 146, 210, 285, 349, 413, 477, 556, 620, 684, 748, 555, 619, 683, 747, 284, 348, 412, 476, 17, 81, 145, 209, 554, 618, 682, 746, 283, 347, 411, 475, 553, 617, 681, 745, 552, 616, 680, 744, 16, 80, 144, 208, 282, 346, 410, 474, 551, 615, 679, 743, 281, 345, 409, 473, 550, 614, 678, 742, 15, 79, 143, 207, 549, 613, 677, 741, 280, 344, 408, 472, 548, 612, 676, 740, 14, 78, 142, 206, 279, 343, 407, 471, 547, 611, 675, 739, 546, 610, 674, 738, 278, 342, 406, 470, 545, 609, 673, 737, 13, 77, 141, 205, 277, 341, 405, 469, 544, 608, 672, 736, 543, 607, 671, 735, 276, 340, 404, 468, 12, 76, 140, 204, 542, 606, 670, 734, 275, 339, 403, 467, 541, 605, 669, 733, 768, 769, 770, 771, 772, 773, 774, 775, 776, 777, 778, 779, 780, 781, 782, 783, 784, 785, 786, 787, 788, 789, 790, 791, 792, 793, 794, 795, 796, 797, 798, 799, 800, 801, 802, 803, 804, 805, 806, 807, 808, 809, 810, 811, 812, 813, 814, 815, 816, 817, 818, 819, 820, 821, 822, 823, 824, 825, 826, 827, 828, 829, 830, 831, 832, 833, 834, 835, 836, 837, 838, 839, 840, 841, 842, 843, 844, 845, 846, 847, 848, 849, 850, 851, 852, 853, 854, 855, 856, 857, 858, 859, 860, 861, 862, 863, 864, 865, 866, 867, 868, 869, 870, 871, 872, 873, 874, 875, 876, 877, 878, 879, 880, 881, 882, 883, 884, 885, 886, 887, 888, 889, 890, 891, 892, 893, 894, 895, 896, 897, 898, 899, 900, 901, 902, 903, 904, 905, 906, 907, 908, 909, 910, 911, 912, 913, 914, 915, 916, 917, 918, 919, 920, 921, 922, 923, 924, 925, 926, 927, 928, 929, 930, 931, 932, 933, 934, 935, 936, 937, 938, 939, 940, 941, 942, 943, 944, 945, 946, 947, 948, 949, 950, 951, 952, 953, 954, 955, 956, 957, 958, 959, 960, 961, 962, 963, 964, 965, 966, 967, 968, 969, 970, 971, 972, 973, 974, 975, 976, 977, 978, 979, 980, 981, 982, 983, 984, 985, 986, 987, 988, 989, 990, 991, 992, 993, 994, 995, 996, 997, 998, 999, 1000, 1001, 1002, 1003, 1004, 1005, 1006, 1007, 1008, 1009, 1010, 1011, 1012, 1013, 1014, 1015, 1016, 1017, 1018, 1019, 1020, 1021, 1022, 1023, 540, 604, 668, 732, 11, 75, 139, 203, 274, 338, 402, 466, 539, 603, 667, 731, 273, 337, 401, 465, 538, 602, 666, 730, 10, 74, 138, 202, 537, 601, 665, 729, 272, 336, 400, 464, 536, 600, 664, 728, 9, 73, 137, 201, 271, 335, 399, 463, 535, 599, 663, 727, 534, 598, 662, 726, 270, 334, 398, 462, 533, 597, 661, 725, 8, 72, 136, 200, 269, 333, 397, 461, 532, 596, 660, 724, 531, 595, 659, 723, 268, 332, 396, 460, 7, 71, 135, 199, 530, 594, 658, 722, 267, 331, 395, 459, 529, 593, 657, 721, 528, 592, 656, 720, 6, 70, 134, 198, 266, 330, 394, 458, 527, 591, 655, 719, 265, 329, 393, 457, 526, 590, 654, 718, 5, 69, 133, 197, 525, 589, 653, 717, 264, 328, 392, 456, 524, 588, 652, 716, 4, 68, 132, 196, 263, 327, 391, 455, 523, 587, 651, 715, 522, 586, 650, 714, 262, 326, 390, 454, 521, 585, 649, 713, 3, 67, 131, 195, 261, 325, 389, 453, 520, 584, 648, 712, 519, 583, 647, 711, 260, 324, 388, 452, 2, 66, 130, 194, 518, 582, 646, 710, 259, 323, 387, 451, 517, 581, 645, 709, 516, 580, 644, 708, 1, 65, 129, 193, 258, 322, 386, 450, 515, 579, 643, 707, 257, 321, 385, 449, 514, 578, 642, 706, 0, 64, 128, 192, 513, 577, 641, 705, 256, 320, 384, 448, 512, 576, 640, 704};
__device__ __constant__ unsigned char kWgOrder[96] = {7, 15, 23, 31, 6, 14, 22, 30, 39, 47, 55, 63, 5, 13, 21, 29, 38, 46, 54, 62, 4, 12, 20, 28, 71, 79, 87, 95, 37, 45, 53, 61, 70, 78, 86, 94, 3, 11, 19, 27, 36, 44, 52, 60, 69, 77, 85, 93, 35, 43, 51, 59, 68, 76, 84, 92, 2, 10, 18, 26, 67, 75, 83, 91, 34, 42, 50, 58, 1, 9, 17, 25, 66, 74, 82, 90, 33, 41, 49, 57, 65, 73, 81, 89, 0, 8, 16, 24, 32, 40, 48, 56, 64, 72, 80, 88};
__device__ __constant__ int kBucketStart[16] = {16, 22, 30, 40, 54, 73, 99, 134, 182, 246, 332, 450, 609, 825, 1117, 1513};
DEVI int t5_bucket(int n) {
    if (n < 16) return n;
    int b = 16;
#pragma unroll
    for (int j = 1; j < 16; ++j) b += (n >= kBucketStart[j]) ? 1 : 0;
    return b;
}


#define XB_TMO      128
#define XB_XCNT(j)  (256  + 64 * (j))
#define XB_XSUB(j)  (1280 + 64 * (j))
#define XB_XGEN(j)  (2304 + 64 * (j))
#define XB_TOP      3328
#define XB_TOPGEN   3392
#define XCD_BAR_WORDS 3456
#define XB_SPIN_CAP (1u << 18)
__device__ __forceinline__ unsigned xb_ld(unsigned* p)              { return __hip_atomic_load(p, __ATOMIC_RELAXED, __HIP_MEMORY_SCOPE_AGENT); }
__device__ __forceinline__ unsigned xb_add(unsigned* p, unsigned v) { return __hip_atomic_fetch_add(p, v, __ATOMIC_RELAXED, __HIP_MEMORY_SCOPE_AGENT); }
__device__ __forceinline__ unsigned xb_xcc_id() { return (unsigned)__builtin_amdgcn_s_getreg((3 << 11) | 20) & 0xFu; }
#define XB_SPIN(cond, bar) do { unsigned _sp = 0; while (cond) { __builtin_amdgcn_s_sleep(1); \
    if ((++_sp & 255u) == 0u) { if (xb_ld(&(bar)[XB_TMO])) break; if (_sp > XB_SPIN_CAP) { atomicAdd(&(bar)[XB_TMO], 1u); break; } } } } while (0)
struct XcdBarrier { unsigned* bar; unsigned x; volatile LAS unsigned* st; };
__device__ __forceinline__ XcdBarrier xcd_barrier_post(unsigned* bar, volatile LAS unsigned* st) {
    XcdBarrier b; b.bar = bar; b.x = xb_xcc_id(); b.st = st;
    if (threadIdx.x == 0) (void)xb_add(&bar[XB_XCNT(b.x)], 1u);
    return b;
}
__device__ __forceinline__ void xcd_barrier_complete(unsigned* bar, unsigned x, unsigned& nloc, unsigned& nx) {
    const unsigned G = gridDim.x * gridDim.y * gridDim.z;
    unsigned sum, cnt, mine, sp = 0u;
    for (;;) {
        sum = 0u; cnt = 0u; mine = 0u;
#pragma unroll
        for (unsigned j = 0; j < 16; ++j) { const unsigned c = xb_ld(&bar[XB_XCNT(j)]); sum += c; cnt += (c > 0u) ? 1u : 0u; mine = (j == x) ? c : mine; }
        if (sum == G) break;
        __builtin_amdgcn_s_sleep(1);
        if ((++sp & 255u) == 0u) { if (xb_ld(&bar[XB_TMO])) break; if (sp > XB_SPIN_CAP) { atomicAdd(&bar[XB_TMO], 1u); break; } }
    }
    nloc = mine > 0u ? mine : 1u; nx = cnt > 0u ? cnt : 1u;
}
__device__ __forceinline__ void xcd_barrier(const XcdBarrier& b) {
    asm volatile("s_waitcnt vmcnt(0)" ::: "memory");
    __syncthreads();
    if (otid() == 0) {
        unsigned* bar = b.bar; unsigned bx = b.x; asm volatile("" : "+s"(bx));
        __builtin_amdgcn_s_waitcnt(0);
        unsigned nloc = b.st[0], nx = b.st[1];
        if (nloc == 0u) { xcd_barrier_complete(bar, bx, nloc, nx); b.st[0] = nloc; b.st[1] = nx; }
        const unsigned old = xb_add(&bar[XB_XSUB(bx)], 1u);
        const unsigned gen = old / nloc;
        if (old + 1u == (gen + 1u) * nloc) {
            __builtin_amdgcn_fence(__ATOMIC_RELEASE, "agent");
            asm volatile("s_waitcnt vmcnt(0)" ::: "memory");
            const unsigned og = xb_add(&bar[XB_TOP], 1u);
            const unsigned tg = og / nx;
            if (og + 1u == (tg + 1u) * nx) xb_add(&bar[XB_TOPGEN], 1u);
            else XB_SPIN(xb_ld(&bar[XB_TOPGEN]) == tg, bar);
            __builtin_amdgcn_fence(__ATOMIC_ACQUIRE, "agent");
            xb_add(&bar[XB_XGEN(bx)], 1u);
            asm volatile("s_waitcnt vmcnt(0)" ::: "memory");
        } else {
            XB_SPIN(xb_ld(&bar[XB_XGEN(bx)]) == gen, bar);
            __builtin_amdgcn_fence(__ATOMIC_ACQUIRE, "agent");
            asm volatile("s_waitcnt vmcnt(0)" ::: "memory");
        }
    }
    __syncthreads();
}

#define SB_E(layer) (8192 + 256 * (layer))
#define SB_P0 8704
#define SB_G3 8960
#define SB_WORDS(layer, k) (6656 + 256 * (3 * (layer) + (k)))
__device__ __forceinline__ void sb_arrive(const XcdBarrier& b, int base) {
    asm volatile("s_waitcnt vmcnt(0)" ::: "memory");
    __syncthreads();
    if (otid() == 0) {
        unsigned* bar = b.bar; unsigned bx = b.x; asm volatile("" : "+s"(bx));
        const unsigned nloc = b.st[0];
        const unsigned old = xb_add(&bar[base + 8 * bx], 1u);
        if (old + 1u == nloc) {
            __builtin_amdgcn_fence(__ATOMIC_RELEASE, "agent");
            asm volatile("s_waitcnt vmcnt(0)" ::: "memory");
            xb_add(&bar[base + 128], 1u);
        }
    }
}
__device__ __forceinline__ void sb_wait_wg(const XcdBarrier& b, int base) {
    if (otid() == 0) {
        unsigned* bar = b.bar; const unsigned nx = b.st[1];
        XB_SPIN(xb_ld(&bar[base + 128]) < nx, bar);
        __builtin_amdgcn_fence(__ATOMIC_ACQUIRE, "agent");
        asm volatile("s_waitcnt vmcnt(0)" ::: "memory");
    }
    __syncthreads();
}
__device__ __forceinline__ void sb_wait_wave(const XcdBarrier& b, int base) {
    unsigned* bar = b.bar; const unsigned nx = b.st[1];
    XB_SPIN(xb_ld(&bar[base + 128]) < nx, bar);
    __builtin_amdgcn_fence(__ATOMIC_ACQUIRE, "agent");
}

extern __shared__ __attribute__((aligned(16))) unsigned char smem[];
namespace pg8 {
#define PG8_LAS __attribute__((address_space(3)))
typedef unsigned short bf16_t;
typedef _Float16 f16x8 __attribute__((ext_vector_type(8)));
typedef float f32x4 __attribute__((ext_vector_type(4)));
typedef unsigned u32x4 __attribute__((ext_vector_type(4)));
constexpr int BM = 256, BK = 64, HALF = 128, HTB = HALF * BK * 2  , STAGE_BYTES = 8 * HTB, NXCD = 8, WGM = 8;

__host__ __device__ __forceinline__ int lds_byte(int r, int c) { const int st = (r >> 4) * 2 + (c >> 5), rr = r & 15, cc = c & 31, ob = rr * 64 + cc * 2; return st * 1024 + (ob ^ (((ob >> 9) & 1) << 5)); }
__host__ __device__ __forceinline__ void stage_rc(int b, int& R, int& C) { const int st = b / 1024, sb = b % 1024, swz = sb ^ (((sb >> 9) & 1) << 5); R = (st >> 1) * 16 + swz / 64; C = (st & 1) * 32 + (swz % 64) / 2; }
__host__ __device__ __forceinline__ int perm32(int rho) { const int n = rho >> 4, i = rho & 15; return 8 * (i >> 2) + 4 * n + (i & 3); }

struct Unit { int pm, pn; };
struct Gemm { const bf16_t* A; const bf16_t* Bt; int M, N, K; };

struct StaticOrder {
    int nM, nN, nwg, G, c;
    __host__ __device__ void init(int M, int N, int G_, int c_) { nM = M / BM; nN = N / BM; nwg = nM * nN; G = G_; c = c_; }
    __host__ __device__ bool next(int i, Unit& u) const {
        const long L = (long)i * G + c; if (L >= nwg) return false;
        int wgid = (int)L; { const int q = nwg / NXCD, r = nwg % NXCD, xcd = wgid % NXCD, off = wgid / NXCD; wgid = (xcd < r ? xcd * (q + 1) : r * (q + 1) + (xcd - r) * q) + off; }
        const int nig = WGM * nN, gid = wgid / nig, fm = gid * WGM, gsz = (nM - fm) < WGM ? (nM - fm) : WGM;
        u.pm = fm + ((wgid % nig) % gsz); u.pn = (wgid % nig) / gsz; return true;
    }
    __device__ __forceinline__ void a_ready(const Unit&) const {}
    __device__ __forceinline__ void done(const Unit&) const {}
};

struct EarlyOrder : StaticOrder {
    int layer;
    __device__ __forceinline__ bool next(int i, Unit& u) const {
        if (!StaticOrder::next(i, u)) return false;
        u.pn = (int)((0xA98765432FEDCB10ull >> (4 * u.pn)) & 15ull); return true;
    }
    __device__ __forceinline__ void done(const Unit& u) const {
        if (u.pn == 2 || u.pn >= 13) {
            asm volatile("s_waitcnt vmcnt(0)" ::: "memory");
            if ((otid() & 63) == 0) {
                const __attribute__((address_space(4))) char* ka = (const __attribute__((address_space(4))) char*)__builtin_amdgcn_kernarg_segment_ptr();
                unsigned* ctl = *(unsigned* const __attribute__((address_space(4)))*)(ka + 104) + (8192 + 256 * layer);
                const unsigned target = 8u * *(volatile LAS unsigned*)(smem + (160 * 1024 - 16));
                const unsigned old = xb_add(ctl + 8 * xb_xcc_id(), 1u);
                if (old + 1u == target) { __builtin_amdgcn_fence(__ATOMIC_RELEASE, "agent"); asm volatile("s_waitcnt vmcnt(0)" ::: "memory"); xb_add(ctl + 128, 1u); }
            }
        }
    }
};

template <class Epi, class Sched, bool ALIGN_EPI = false, bool SP2 = false>
__device__ __forceinline__ void gemm_phase(PG8_LAS unsigned char* lds, const Gemm g, const Sched& S, const Epi& E) {
    const int tid = otid(), wid = __builtin_amdgcn_readfirstlane(tid >> 6), lane = tid & 63, wr = wid >> 2, wc = wid & 3, fr = lane & 15, fq = lane >> 4;
    const int K = g.K, nt = K / BK;
    unsigned voffA[2], voffB[2];
#pragma unroll
    for (int i = 0; i < 2; ++i) { int R, C; stage_rc(tid * 16 + i * 8192, R, C); const int Rb = Epi::PERM ? ((R & ~31) + perm32(R & 31)) : R;
        voffA[i] = (unsigned)(R * K + C) * 2u; voffB[i] = (unsigned)(Rb * K + C) * 2u; }
    const size_t kstep = (size_t)(BK * 2);
    const size_t hstep = (size_t)HALF * K * 2;
    const size_t tstep = 2 * hstep;
    const unsigned ldsw = (unsigned)wid * 1024u;
    const int aoff = lds_byte(wr * 64 + fr, fq * 8), boff = lds_byte(wc * 32 + fr, fq * 8);
#define PG8_SA(b, h) (((b) * 2 + (h)) * HTB)
#define PG8_SB(b, h) ((4 + (b) * 2 + (h)) * HTB)
#define PG8_STAGE(bufoff, gbase, voff) do { _Pragma("unroll") for (int _i = 0; _i < 2; ++_i) \
        __builtin_amdgcn_global_load_lds((const unsigned*)((const char*)(gbase) + (voff)[_i]), (PG8_LAS unsigned*)(lds + (bufoff) + ldsw + _i * 8192), 16, 0, 0); } while (0)
#define PG8_LDA(dst, b, h) do { _Pragma("unroll") for (int m = 0; m < 4; ++m) _Pragma("unroll") for (int k = 0; k < 2; ++k) dst[m][k] = *(const PG8_LAS f16x8*)(lds + PG8_SA(b, h) + aoff + m * 2048 + k * 1024); } while (0)
#define PG8_LDB(dst, b, h) do { _Pragma("unroll") for (int n = 0; n < 2; ++n) _Pragma("unroll") for (int k = 0; k < 2; ++k) dst[n][k] = *(const PG8_LAS f16x8*)(lds + PG8_SB(b, h) + boff + n * 2048 + k * 1024); } while (0)
#define PG8_MMA(ai, bj, At, Bt) do { __builtin_amdgcn_s_setprio(1); _Pragma("unroll") for (int m = 0; m < 4; ++m) _Pragma("unroll") for (int n = 0; n < 2; ++n) _Pragma("unroll") for (int k = 0; k < 2; ++k) \
        acc[ai][bj][m][n] = __builtin_amdgcn_mfma_f32_16x16x32_f16(Bt[n][k], At[m][k], acc[ai][bj][m][n], 0, 0, 0); __builtin_amdgcn_s_setprio(0); } while (0)
#define PG8_WAIT_V(n) asm volatile("s_waitcnt vmcnt(" #n ")" ::: "memory")
#define PG8_WAIT_L(n) asm volatile("s_waitcnt lgkmcnt(" #n ")" ::: "memory")
#define PG8_BAR __builtin_amdgcn_s_barrier()
#define PG8_SCHED __builtin_amdgcn_sched_barrier(0)
    Unit cur, nxt; int ui = 0;
    if (!S.next(0, cur)) return;
    f32x4 acc[2][2][4][2];
#pragma unroll
    for (int a = 0; a < 2; ++a)
#pragma unroll
        for (int b = 0; b < 2; ++b)
#pragma unroll
            for (int m = 0; m < 4; ++m)
#pragma unroll
                for (int n = 0; n < 2; ++n) acc[a][b][m][n] = (f32x4){0.f, 0.f, 0.f, 0.f};
    f16x8 At[4][2], B0[2][2], B1[2][2];
    const char* cA = (const char*)g.A + (size_t)cur.pm * tstep; const char* cB = (const char*)g.Bt + (size_t)cur.pn * tstep;
    S.a_ready(cur);
    if constexpr (SP2) {
        PG8_STAGE(PG8_SB(0, 0), cB, voffB); PG8_STAGE(PG8_SB(0, 1), cB + hstep, voffB); PG8_STAGE(PG8_SA(0, 0), cA, voffA); PG8_STAGE(PG8_SA(0, 1), cA + hstep, voffA);
        if (wr == 1) PG8_BAR;
        PG8_WAIT_V(2); PG8_BAR;
        PG8_STAGE(PG8_SB(1, 0), cB + kstep, voffB); PG8_STAGE(PG8_SA(1, 0), cA + kstep, voffA); PG8_STAGE(PG8_SB(1, 1), cB + hstep + kstep, voffB);
        PG8_WAIT_V(6); PG8_BAR;
    } else {
        PG8_STAGE(PG8_SB(0, 0), cB, voffB); PG8_STAGE(PG8_SA(0, 0), cA, voffA); PG8_STAGE(PG8_SB(0, 1), cB + hstep, voffB); PG8_STAGE(PG8_SA(0, 1), cA + hstep, voffA);
        if (wr == 1) PG8_BAR;
        PG8_WAIT_V(4); PG8_BAR;
        PG8_STAGE(PG8_SB(1, 0), cB + kstep, voffB); PG8_STAGE(PG8_SA(1, 0), cA + kstep, voffA); PG8_STAGE(PG8_SB(1, 1), cB + hstep + kstep, voffB);
        PG8_WAIT_V(6); PG8_BAR;
    }
    for (;;) {
        const bool has_next = S.next(ui + 1, nxt);
        const char* nA = has_next ? (const char*)g.A + (size_t)nxt.pm * tstep : cA; const char* nB = has_next ? (const char*)g.Bt + (size_t)nxt.pn * tstep : cB;
        for (int t = 0; t < nt; t += 2) {
            const bool last = (t == nt - 2);
            const char* a1 = cA + (size_t)(t + 1) * kstep;
            const char* a2 = last ? nA : cA + (size_t)(t + 2) * kstep; const char* b2 = last ? nB : cB + (size_t)(t + 2) * kstep;
            const char* a3 = a2 + kstep; const char* b3 = b2 + kstep;
            if (last && has_next) S.a_ready(nxt);
            if constexpr (SP2) {
            PG8_LDB(B0, 0, 0); PG8_LDB(B1, 0, 1); PG8_SCHED; PG8_LDA(At, 0, 0); PG8_STAGE(PG8_SA(1, 1), a1 + hstep, voffA);
            PG8_WAIT_V(8); PG8_WAIT_L(0); PG8_BAR; PG8_MMA(0, 0, At, B0); PG8_MMA(0, 1, At, B1); PG8_BAR; PG8_SCHED;
            PG8_LDA(At, 0, 1); PG8_STAGE(PG8_SB(0, 0), b2, voffB); PG8_STAGE(PG8_SB(0, 1), b2 + hstep, voffB); PG8_STAGE(PG8_SA(0, 0), a2, voffA);
            PG8_WAIT_V(8); PG8_WAIT_L(0); PG8_BAR; PG8_MMA(1, 0, At, B0); PG8_MMA(1, 1, At, B1); PG8_BAR; PG8_SCHED;
            PG8_LDB(B0, 1, 0); PG8_LDB(B1, 1, 1); PG8_SCHED; PG8_LDA(At, 1, 0); PG8_STAGE(PG8_SA(0, 1), a2 + hstep, voffA);
            PG8_WAIT_V(8); PG8_WAIT_L(0); PG8_BAR; PG8_MMA(0, 0, At, B0); PG8_MMA(0, 1, At, B1); PG8_BAR; PG8_SCHED;
            PG8_LDA(At, 1, 1); PG8_STAGE(PG8_SB(1, 0), b3, voffB); PG8_STAGE(PG8_SB(1, 1), b3 + hstep, voffB); PG8_STAGE(PG8_SA(1, 0), a3, voffA);
            PG8_WAIT_V(8); PG8_WAIT_L(0); PG8_BAR; PG8_MMA(1, 0, At, B0); PG8_MMA(1, 1, At, B1); PG8_BAR; PG8_SCHED;
            } else {
            PG8_LDB(B0, 0, 0); PG8_SCHED; PG8_LDA(At, 0, 0); PG8_STAGE(PG8_SA(1, 1), a1 + hstep, voffA);
            PG8_WAIT_L(8); PG8_BAR; PG8_WAIT_L(0); PG8_MMA(0, 0, At, B0); PG8_BAR; PG8_SCHED;
            PG8_LDB(B1, 0, 1); PG8_STAGE(PG8_SB(0, 0), b2, voffB);
            PG8_BAR; PG8_WAIT_L(0); PG8_MMA(0, 1, At, B1); PG8_BAR;
            PG8_LDA(At, 0, 1); PG8_STAGE(PG8_SA(0, 0), a2, voffA);
            PG8_BAR; PG8_WAIT_L(0); PG8_MMA(1, 0, At, B0); PG8_BAR; PG8_SCHED;
            PG8_STAGE(PG8_SB(0, 1), b2 + hstep, voffB);
            PG8_WAIT_V(6); PG8_BAR; PG8_MMA(1, 1, At, B1); PG8_BAR;
            PG8_LDB(B0, 1, 0); PG8_SCHED; PG8_LDA(At, 1, 0); PG8_STAGE(PG8_SA(0, 1), a2 + hstep, voffA);
            PG8_WAIT_L(8); PG8_BAR; PG8_WAIT_L(0); PG8_MMA(0, 0, At, B0); PG8_BAR; PG8_SCHED;
            PG8_LDB(B1, 1, 1); PG8_STAGE(PG8_SB(1, 0), b3, voffB);
            PG8_BAR; PG8_WAIT_L(0); PG8_MMA(0, 1, At, B1); PG8_BAR;
            PG8_LDA(At, 1, 1); PG8_STAGE(PG8_SA(1, 0), a3, voffA);
            PG8_BAR; PG8_WAIT_L(0); PG8_MMA(1, 0, At, B0); PG8_BAR; PG8_SCHED;
            PG8_STAGE(PG8_SB(1, 1), b3 + hstep, voffB);
            PG8_WAIT_V(6); PG8_BAR; PG8_MMA(1, 1, At, B1); PG8_BAR;
            }
        }
        if constexpr (ALIGN_EPI) { if (wr == 0) PG8_BAR; }
        if constexpr (!Epi::AFTER_DRAIN) { E(acc, cur, wr, wc, fr, fq); S.done(cur); }
        if (!has_next) break;
#pragma unroll
        for (int a = 0; a < 2; ++a)
#pragma unroll
            for (int b = 0; b < 2; ++b)
#pragma unroll
                for (int m = 0; m < 4; ++m)
#pragma unroll
                    for (int n = 0; n < 2; ++n) acc[a][b][m][n] = (f32x4){0.f, 0.f, 0.f, 0.f};
        cur = nxt; cA = nA; cB = nB; ++ui;
        if constexpr (ALIGN_EPI) { if (wr == 1) PG8_BAR; }
    }
    PG8_WAIT_V(0);
    if constexpr (!ALIGN_EPI) { if (wr == 0) PG8_BAR; }
    PG8_BAR;
    if constexpr (Epi::AFTER_DRAIN) { E.fused(acc, cur, wr, wc, fr, fq, lds, wid, lane); S.done(cur); }
#undef PG8_SA
#undef PG8_SB
#undef PG8_STAGE
#undef PG8_LDA
#undef PG8_LDB
#undef PG8_MMA
#undef PG8_WAIT_V
#undef PG8_WAIT_L
#undef PG8_BAR
#undef PG8_SCHED
}
}


typedef float f32x4_t __attribute__((ext_vector_type(4)));
typedef _Float16 h16x8 __attribute__((ext_vector_type(8)));
DEVI float silu_f(float v) { return v * __builtin_amdgcn_rcpf(1.f + __builtin_amdgcn_exp2f(v * -1.4426950408889634f)); }
struct EpiRoute {
    static constexpr bool PERM = true, AFTER_DRAIN = false;
    gu8* ws; const gf32* ssq;
    DEVI void operator()(const pg8::f32x4 (&acc)[2][2][4][2], const pg8::Unit& u, int wr, int wc, int fr, int fq) const {
        const int row0 = u.pm * 256 + wr * 64 + fr;
        float rs[2][4];
#pragma unroll
        for (int ai = 0; ai < 2; ++ai)
#pragma unroll
            for (int m = 0; m < 4; ++m) { const int rw = row0 + ai * 128 + m * 16; rs[ai][m] = rsqrtf((ssq[rw] + ssq[NT + rw] + ssq[2 * NT + rw] + ssq[3 * NT + rw]) * (1.f / DM) + EPS); }
#pragma unroll
        for (int bj = 0; bj < 2; ++bj) {
            const int cg = u.pn * 256 + bj * 128 + wc * 32;
            const Route r = route(cg);
            if (r.kind < 0) continue;
            gh16* base = (gh16*)(ws + r.off);
            const int c = r.dcol + 8 * fq;
#pragma unroll
            for (int ai = 0; ai < 2; ++ai)
#pragma unroll
                for (int m = 0; m < 4; ++m) {
                    const int row = row0 + ai * 128 + m * 16; const float sc = rs[ai][m] * r.scale;
                    float v[8];
#pragma unroll
                    for (int j = 0; j < 4; ++j) { v[j] = acc[ai][bj][m][0][j] * sc; v[4 + j] = acc[ai][bj][m][1][j] * sc; }
                    if (r.silu) {
#pragma unroll
                        for (int j = 0; j < 8; ++j) v[j] = silu_f(v[j]);
                    }
                    h16x8 o;
#pragma unroll
                    for (int j = 0; j < 8; ++j) o[j] = (h16)v[j];
                    if (r.kind == 0) *(GAS h16x8*)(base + (size_t)row * r.pitch + c) = o;
                    else {
                        const int b = row >> 11, sq = row & 2047;
                        if (r.kind == 3) *(GAS h16x8*)(base + (((size_t)b * 128 + (sq >> 4)) * 64 + (sq & 15) + 16 * (c >> 3)) * 8) = o;
                        else {
                            const int bh = b * 4 + (c >> 6), d0 = c & 63;
                            *(GAS h16x8*)(base + kf_off(bh, sq, d0)) = o;
                            if (r.kind == 2) { *(GAS h16x8*)(base + FSZ + kf4_off(bh, sq, d0)) = o; *(GAS h16x8*)(base + 2 * FSZ + kf16_off(bh, sq, d0)) = o; }
                        }
                    }
                }
        }
    }
};

struct EpiOut {
    static constexpr bool PERM = true, AFTER_DRAIN = true;
    gf32* h_out; gh16* h16o; const gf32* gpost; gf32* ssqy; gf32* ssqh; gu32* pcnt; bool write_next;
    DEVI void rowsum_publish(const float (&ps)[2][4], gf32* dst, const pg8::Unit& u, int wr, int wc, int fr, int fq, PG8_LAS unsigned char* lds) const {
        lf32* red = (lf32*)lds;
        __syncthreads();
#pragma unroll
        for (int ai = 0; ai < 2; ++ai)
#pragma unroll
            for (int m = 0; m < 4; ++m) { float v = xh_sum(x16_sum(ps[ai][m])); if (fq == 0) red[wc * 256 + ai * 128 + wr * 64 + m * 16 + fr] = v; }
        __syncthreads();
        const int t = otid();
        if (t < 256) dst[(size_t)u.pn * NT + u.pm * 256 + t] = red[t] + red[256 + t] + red[512 + t] + red[768 + t];
    }
    DEVI void panel_exchange(const float (&ps)[2][4], const pg8::Unit& u, int wr, int wc, int fr, int fq, PG8_LAS unsigned char* lds, int wid, int lane) const {
        lf32* red = (lf32*)lds;
        __syncthreads();
#pragma unroll
        for (int ai = 0; ai < 2; ++ai)
#pragma unroll
            for (int m = 0; m < 4; ++m) { float v = xh_sum(x16_sum(ps[ai][m])); if (fq == 0) red[wc * 256 + ai * 128 + wr * 64 + m * 16 + fr] = v; }
        __syncthreads();
        const int t = otid();
        if (t < 256) {
            __hip_atomic_store(ssqy + (size_t)u.pn * NT + u.pm * 256 + t, red[t] + red[256 + t] + red[512 + t] + red[768 + t], __ATOMIC_RELAXED, __HIP_MEMORY_SCOPE_AGENT);
            asm volatile("s_waitcnt vmcnt(0)" ::: "memory");
            if (lane == 0) __hip_atomic_fetch_add(pcnt + 16 * u.pm, 1u, __ATOMIC_RELAXED, __HIP_MEMORY_SCOPE_AGENT);
        }
        if (wid == 0) {
            for (int spin = 0; spin < (1 << 24); ++spin) {
                if ((unsigned)__builtin_amdgcn_readfirstlane((int)__hip_atomic_load(pcnt + 16 * u.pm, __ATOMIC_RELAXED, __HIP_MEMORY_SCOPE_AGENT)) >= 16u) break;
                __builtin_amdgcn_s_sleep(2);
            }
            __builtin_amdgcn_fence(__ATOMIC_ACQUIRE, "agent");
        }
        asm volatile("s_waitcnt vmcnt(0) lgkmcnt(0)" ::: "memory"); __builtin_amdgcn_s_barrier(); asm volatile("" ::: "memory");
    }
    DEVI void fused(pg8::f32x4 (&acc)[2][2][4][2], const pg8::Unit& u, int wr, int wc, int fr, int fq, PG8_LAS unsigned char* lds, int wid, int lane) const {
        float ps[2][4];
#pragma unroll
        for (int ai = 0; ai < 2; ++ai)
#pragma unroll
            for (int m = 0; m < 4; ++m) { float v = 0.f;
#pragma unroll
                for (int bj = 0; bj < 2; ++bj)
#pragma unroll
                    for (int n = 0; n < 2; ++n)
#pragma unroll
                        for (int e = 0; e < 4; ++e) v += acc[ai][bj][m][n][e] * acc[ai][bj][m][n][e];
                ps[ai][m] = v; }
        const int row0 = u.pm * 256 + wr * 64 + fr, col0 = u.pn * 256 + wc * 32 + 8 * fq;
        h16x8 hh0[4][2]; f32x4_t gv[2][2];
#pragma unroll
        for (int m = 0; m < 4; ++m)
#pragma unroll
            for (int bj = 0; bj < 2; ++bj) hh0[m][bj] = *(const GAS h16x8*)(h16o + (size_t)(row0 + m * 16) * DM + col0 + bj * 128);
#pragma unroll
        for (int bj = 0; bj < 2; ++bj)
#pragma unroll
            for (int n = 0; n < 2; ++n) gv[bj][n] = *(const GAS f32x4_t*)(gpost + col0 + bj * 128 + 4 * n);
        panel_exchange(ps, u, wr, wc, fr, fq, lds, wid, lane);
        float rs[2][4];
        {
            float sv[2][4][4];
#pragma unroll
            for (int ai = 0; ai < 2; ++ai)
#pragma unroll
                for (int m = 0; m < 4; ++m)
#pragma unroll
                    for (int q = 0; q < 4; ++q) sv[ai][m][q] = __hip_atomic_load(ssqy + (size_t)q * NT + row0 + ai * 128 + m * 16, __ATOMIC_RELAXED, __HIP_MEMORY_SCOPE_AGENT);
#pragma unroll
            for (int ai = 0; ai < 2; ++ai)
#pragma unroll
                for (int m = 0; m < 4; ++m) rs[ai][m] = rsqrtf(((sv[ai][m][0] + sv[ai][m][1]) + (sv[ai][m][2] + sv[ai][m][3])) * (1.f / DM) + EPS);
        }
#pragma unroll
        for (int ai = 0; ai < 2; ++ai) {
            h16x8 hh[4][2];
#pragma unroll
            for (int m = 0; m < 4; ++m)
#pragma unroll
                for (int bj = 0; bj < 2; ++bj) hh[m][bj] = ai ? *(const GAS h16x8*)(h16o + (size_t)(row0 + 128 + m * 16) * DM + col0 + bj * 128) : hh0[m][bj];
            __builtin_amdgcn_sched_barrier(0);
#pragma unroll
            for (int m = 0; m < 4; ++m) {
                float v2 = 0.f;
#pragma unroll
                for (int bj = 0; bj < 2; ++bj)
#pragma unroll
                    for (int n = 0; n < 2; ++n)
#pragma unroll
                        for (int e = 0; e < 4; ++e) { const float o = (float)hh[m][bj][4 * n + e] + acc[ai][bj][m][n][e] * rs[ai][m] * gv[bj][n][e]; acc[ai][bj][m][n][e] = o; v2 += o * o; }
                ps[ai][m] = v2;
            }
        }
        if (write_next) {
#pragma unroll
            for (int ai = 0; ai < 2; ++ai)
#pragma unroll
                for (int m = 0; m < 4; ++m)
#pragma unroll
                    for (int bj = 0; bj < 2; ++bj) { h16x8 oh;
#pragma unroll
                        for (int n = 0; n < 2; ++n)
#pragma unroll
                            for (int e = 0; e < 4; ++e) oh[4 * n + e] = (h16)acc[ai][bj][m][n][e];
                        *(GAS h16x8*)(h16o + (size_t)(row0 + ai * 128 + m * 16) * DM + col0 + bj * 128) = oh; }
        } else {
#pragma unroll
            for (int ai = 0; ai < 2; ++ai)
#pragma unroll
                for (int m = 0; m < 4; ++m)
#pragma unroll
                    for (int bj = 0; bj < 2; ++bj)
#pragma unroll
                        for (int n = 0; n < 2; ++n) *(GAS f32x4_t*)(h_out + (size_t)(row0 + ai * 128 + m * 16) * DM + col0 + bj * 128 + 4 * n) = acc[ai][bj][m][n];
        }
        if (write_next) rowsum_publish(ps, ssqh, u, wr, wc, fr, fq, lds);
    }
    DEVI void operator()(const pg8::f32x4 (&)[2][2][4][2], const pg8::Unit&, int, int, int, int) const {}
};

constexpr int NTHR = 512, NWAVE = 8;

template <bool REF>
DEVI void cvt_transpose(const gf32* __restrict__ src, int src_pitch, const gf32* __restrict__ g, gh16* dst, int N, int K, lu8* lds, int item0, int nitems_total, int& item_base) {
    const int tid = otid();
    LAS float (*tile)[65] = (LAS float (*)[65])lds;
    const int ntn = N / 64, ntk = K / 64, n_it = ntn * ntk;
    for (int it = item0; it < nitems_total; it += gridDim.x) {
        const int li = it - item_base; if (li < 0 || li >= n_it) continue;
        const int n0 = (li % ntn) * 64, k0 = (li / ntn) * 64;
        __syncthreads();
        const int c = tid & 63; int rc = n0 + c; if (REF) rc = ref_col(rc);
#pragma unroll
        for (int ps = 0; ps < 8; ++ps) { const int k = ps * 8 + (tid >> 6);
            tile[k][c] = rc >= 0 ? src[(size_t)(k0 + k) * src_pitch + rc] * (g ? g[k0 + k] : 1.f) : 0.f; }
        __syncthreads();
        const int cc = tid >> 3, kq = (tid & 7) * 8;
        h16x8 o;
#pragma unroll
        for (int j = 0; j < 8; ++j) o[j] = (h16)tile[kq + j][cc];
        *(GAS h16x8*)(dst + (size_t)(n0 + cc) * K + k0 + kq) = o;
    }
    item_base += n_it;
}

DEVI void ph_transposes(const gf32* __restrict__ w_in, const gf32* __restrict__ g_pre, const gf32* __restrict__ w_out, gh16* WinT, gh16* WoutT, lu8* lds, int L, int jbeg = 0, int jend = 1280) {
    const int tid = otid(), c = tid & 63, kr = tid >> 6, cc = tid >> 3, kq = (tid & 7) * 8;
    LAS float (*tile)[65] = (LAS float (*)[65])lds;
    auto load = [&](int it, float (&v)[8], float (&gv)[8]) {
        if (it < 2048) {
            const int l = it >> 10, li = it & 1023, n0 = (li & 63) * 64, k0 = (li >> 6) * 64, rc = ref_col(n0 + c), rcc = rc >= 0 ? rc : 0;
            const gf32* src = w_in + (size_t)l * DM * INC + rcc; const gf32* g = g_pre + l * DM + k0 + kr;
#pragma unroll
            for (int ps = 0; ps < 8; ++ps) { v[ps] = src[(size_t)(k0 + ps * 8 + kr) * INC]; gv[ps] = g[ps * 8]; }
            if (rc < 0) {
#pragma unroll
                for (int ps = 0; ps < 8; ++ps) v[ps] = 0.f;
            }
        } else {
            const int i2 = it - 2048, l = i2 >> 8, li = i2 & 255, n0 = (li & 15) * 64, k0 = (li >> 4) * 64;
            const gf32* src = w_out + (size_t)l * DM * DM + n0 + c;
#pragma unroll
            for (int ps = 0; ps < 8; ++ps) { v[ps] = src[(size_t)(k0 + ps * 8 + kr) * DM]; gv[ps] = 1.f; }
        }
    };
    float va[8], ga[8], vb[8], gb[8];
    auto item_of = [&](int j) { return j < 1024 ? j + 1024 * L : j + 1024 + 256 * L; };
    int j = jbeg + (int)blockIdx.x;
    if (j < jend) load(item_of(j), va, ga);
    for (; j < jend; j += (int)gridDim.x) {
        const int it = item_of(j);
        const int nx = j + (int)gridDim.x;
        if (nx < jend) load(item_of(nx), vb, gb);
        __syncthreads();
#pragma unroll
        for (int ps = 0; ps < 8; ++ps) tile[ps * 8 + kr][c] = va[ps] * ga[ps];
        __syncthreads();
        h16x8 o;
#pragma unroll
        for (int j = 0; j < 8; ++j) o[j] = (h16)tile[kq + j][cc];
        gh16* dst;
        if (it < 2048) { const int l = it >> 10, li = it & 1023; dst = WinT + (size_t)l * MYC * DM + (size_t)((li & 63) * 64 + cc) * DM + (li >> 6) * 64 + kq; }
        else { const int i2 = it - 2048, l = i2 >> 8, li = i2 & 255; dst = WoutT + (size_t)l * DM * DM + (size_t)((li & 15) * 64 + cc) * DM + (li >> 4) * 64 + kq; }
        *(GAS h16x8*)dst = o;
#pragma unroll
        for (int ps = 0; ps < 8; ++ps) { va[ps] = vb[ps]; ga[ps] = gb[ps]; }
    }
}

DEVI void ph_rowstat_cvt(const gf32* h, gf32* ssq, gh16* h16o) {
    typedef _Float16 h16x4 __attribute__((ext_vector_type(4)));
    const int t_ = otid(); const int lane = t_ & 63, gw = blockIdx.x * NWAVE + (t_ >> 6), nw = gridDim.x * NWAVE;
    for (int row = gw; row < NT; row += 2 * nw) {
        const bool two = row + nw < NT; const int row1 = two ? row + nw : row;
        f32x4_t v[2][4];
#pragma unroll
        for (int r = 0; r < 2; ++r)
#pragma unroll
            for (int i = 0; i < 4; ++i) v[r][i] = ((const GAS f32x4_t*)(h + (size_t)(r ? row1 : row) * DM))[lane + 64 * i];
        __builtin_amdgcn_sched_barrier(0);
#pragma unroll
        for (int r = 0; r < 2; ++r) {
            if (r && !two) break;
            const int rw = r ? row1 : row; float s = 0.f;
#pragma unroll
            for (int i = 0; i < 4; ++i) { const f32x4_t x = v[r][i]; s += x[0] * x[0] + x[1] * x[1] + x[2] * x[2] + x[3] * x[3];
                h16x4 o; o[0] = (h16)x[0]; o[1] = (h16)x[1]; o[2] = (h16)x[2]; o[3] = (h16)x[3];
                *(GAS h16x4*)(h16o + (size_t)rw * DM + (lane + 64 * i) * 4) = o; }
            for (int o = 32; o; o >>= 1) s += shflx(s, o);
            if (lane == 0) { ssq[rw] = s; ssq[NT + rw] = 0.f; ssq[2 * NT + rw] = 0.f; ssq[3 * NT + rw] = 0.f; }
        }
    }
}

typedef float f32x16 __attribute__((ext_vector_type(16)));
typedef _Float16 h16x4 __attribute__((ext_vector_type(4)));
DEVI f32x16 mfma32(h16x8 a, h16x8 b, f32x16 c) { return __builtin_amdgcn_mfma_f32_32x32x16_f16(a, b, c, 0, 0, 0); }
#define CROW(r) (((r) & 3) + 8 * ((r) >> 2))
DEVI float fmax2_(float a, float b) { return __builtin_amdgcn_fmed3f(a, b, 3.3e38f); }
DEVI float xh_max(float x) { auto r = __builtin_amdgcn_permlane32_swap(__float_as_uint(x), __float_as_uint(x), false, false); return fmax2_(__uint_as_float(r[0]), __uint_as_float(r[1])); }
DEVI float x16_sum(float x) { auto r = __builtin_amdgcn_permlane16_swap(__float_as_uint(x), __float_as_uint(x), false, false); return __uint_as_float(r[0]) + __uint_as_float(r[1]); }
DEVI float xh_sum(float x) { auto r = __builtin_amdgcn_permlane32_swap(__float_as_uint(x), __float_as_uint(x), false, false); return __uint_as_float(r[0]) + __uint_as_float(r[1]); }
DEVI unsigned pk2h(float a, float b) { auto v = __builtin_amdgcn_cvt_pkrtz(a, b); return __builtin_bit_cast(unsigned, v); }
DEVI h16x8 pack8(const f32x16& p, int s) {
    typedef unsigned u32x4_t __attribute__((ext_vector_type(4)));
    u32x4_t w;
    w[0] = pk2h(p[8 * s + 0], p[8 * s + 1]); w[1] = pk2h(p[8 * s + 2], p[8 * s + 3]); w[2] = pk2h(p[8 * s + 4], p[8 * s + 5]); w[3] = pk2h(p[8 * s + 6], p[8 * s + 7]);
    return __builtin_bit_cast(h16x8, w);
}
DEVI h16x8 ldv8(const gh16* p) {
    h16x4 a = *(const GAS h16x4*)p, b = *(const GAS h16x4*)(p + 8);
    h16x8 r; r[0] = a[0]; r[1] = a[1]; r[2] = a[2]; r[3] = a[3]; r[4] = b[0]; r[5] = b[1]; r[6] = b[2]; r[7] = b[3]; return r;
}
DEVI void softmax_tile(f32x16& S, float& m, float& l, f32x16& O0, f32x16& O1) {
    float mx = fmax2_(S[0], S[1]);
#pragma unroll
    for (int r = 2; r < 16; r += 2) mx = fmaxf(fmaxf(mx, S[r]), S[r + 1]);
    mx = xh_max(mx);
    if (__any(mx > m + 8.f)) {
        const float mn = fmax2_(m, mx), al = __builtin_amdgcn_exp2f(m - mn);
        l *= al; O0 *= al; O1 *= al; m = mn;
    }
#pragma unroll
    for (int r = 0; r < 16; ++r) S[r] = __builtin_amdgcn_exp2f(S[r] - m);
    l += ((S[0] + S[1]) + (S[2] + S[3])) + ((S[4] + S[5]) + (S[6] + S[7])) + (((S[8] + S[9]) + (S[10] + S[11])) + ((S[12] + S[13]) + (S[14] + S[15])));
}
DEVI void softmax_tile_h(f32x16& S, float& m, float& l, f32x16& O0, f32x16& O1, int hot) { if (hot < 2) softmax_tile(S, m, l, O0, O1); else l += S[0]; }
DEVI void softmax_tile_b(f32x16& S, float& m, float& l, f32x16& O0, f32x16& O1) {
    float mx = fmax2_(S[0], S[1]);
#pragma unroll
    for (int r = 2; r < 16; r += 2) mx = fmaxf(fmaxf(mx, S[r]), S[r + 1]);
    mx = xh_max(mx);
    const bool grow = mx > m + 8.f;
    if (__any(grow && m > -1e29f)) {
        const float mn = fmax2_(m, mx), al = __builtin_amdgcn_exp2f(m - mn);
        l *= al; O0 *= al; O1 *= al; m = mn;
    }
    m = (grow && m <= -1e29f) ? mx : m;
#pragma unroll
    for (int r = 0; r < 16; ++r) S[r] = __builtin_amdgcn_exp2f(S[r] - m);
    l += ((S[0] + S[1]) + (S[2] + S[3])) + ((S[4] + S[5]) + (S[6] + S[7])) + (((S[8] + S[9]) + (S[10] + S[11])) + ((S[12] + S[13]) + (S[14] + S[15])));
}
DEVI int wq_next(gu32* ctr) {
    int e = 0;
    if ((otid() & 63) == 0) e = (int)__hip_atomic_fetch_add(ctr, 1u, __ATOMIC_RELAXED, __HIP_MEMORY_SCOPE_AGENT);
    return __builtin_amdgcn_readfirstlane(e);
}

DEVI void flashA_item(int b, int hh, int qt, const gh16* qA, const gh16* KF, const gh16* KRF, const gh16* VF, const gh16* gate, gh16* mix) {
    const int lane = otid() & 63, q = lane & 31, h = lane >> 5;
    const size_t tokq = (size_t)b * SEQ + qt * 32 + q;
    h16x8 qf[6];
#pragma unroll
    for (int ks = 0; ks < 6; ++ks) qf[ks] = *(const GAS h16x8*)(qA + tokq * 384 + hh * 96 + ks * 16 + 8 * h);
    f32x16 O0 = {}, O1 = {};
    float m = -1e30f, l = 0.f;
    const gh16* kp = KF + (size_t)(b * 4 + hh) * 64 * 2048 + lane * 8;
    const gh16* rp = KRF + (size_t)b * 64 * 1024 + lane * 8;
    const gh16* vp = VF + (size_t)(b * 4 + hh) * 64 * 2048 + lane * 8;
    h16x8 kf[6];
#pragma unroll
    for (int ks = 0; ks < 4; ++ks) kf[ks] = *(const GAS h16x8*)(kp + ks * 512);
#pragma unroll
    for (int ks = 0; ks < 2; ++ks) kf[4 + ks] = *(const GAS h16x8*)(rp + ks * 512);
    h16x8 vf[4], vn[4];
#pragma unroll
    for (int f = 0; f < 4; ++f) vf[f] = *(const GAS h16x8*)(vp + f * 512);
    for (int j = 0; j <= qt; ++j) {
        f32x16 S = {};
#pragma unroll
        for (int ks = 0; ks < 6; ++ks) S = mfma32(kf[ks], qf[ks], S);
        if (j < qt) {
#pragma unroll
            for (int ks = 0; ks < 4; ++ks) kf[ks] = *(const GAS h16x8*)(kp + (size_t)(j + 1) * 2048 + ks * 512);
#pragma unroll
            for (int ks = 0; ks < 2; ++ks) kf[4 + ks] = *(const GAS h16x8*)(rp + (size_t)(j + 1) * 1024 + ks * 512);
#pragma unroll
            for (int f = 0; f < 4; ++f) vn[f] = *(const GAS h16x8*)(vp + (size_t)(j + 1) * 2048 + f * 512);
        } else {
#pragma unroll
            for (int r = 0; r < 16; ++r) S[r] = (CROW(r) + 4 * h > q) ? -3e38f : S[r];
        }
        softmax_tile(S, m, l, O0, O1);
        const h16x8 p0 = pack8(S, 0), p1 = pack8(S, 1);
        O0 = mfma32(vf[0], p0, O0); O0 = mfma32(vf[1], p1, O0);
        O1 = mfma32(vf[2], p0, O1); O1 = mfma32(vf[3], p1, O1);
#pragma unroll
        for (int f = 0; f < 4; ++f) vf[f] = vn[f];
    }
    const float il = 1.f / xh_sum(l);
    const gh16* gp = gate + tokq * 1024 + hh * 64 + 4 * h;
#pragma unroll
    for (int db = 0; db < 2; ++db)
#pragma unroll
        for (int g = 0; g < 4; ++g) {
            const h16x4 gv = *(const GAS h16x4*)(gp + db * 32 + 8 * g); h16x4 o;
#pragma unroll
            for (int e = 0; e < 4; ++e) o[e] = (h16)((db ? O1[4 * g + e] : O0[4 * g + e]) * il * (float)gv[e]);
            *(GAS h16x4*)(mix + mixf_off(tokq, hh * 64 + db * 32 + 8 * g + 4 * h)) = o;
        }
}

DEVI int far_bucket(int n) { return 23 + (n >= 182 ? 1 : 0) + (n >= 246 ? 1 : 0) + (n >= 332 ? 1 : 0) + (n >= 450 ? 1 : 0) + (n >= 609 ? 1 : 0) + (n >= 825 ? 1 : 0) + (n >= 1117 ? 1 : 0) + (n >= 1513 ? 1 : 0); }
DEVI int far_start(int bk) { return bk == 24 ? 182 : bk == 25 ? 246 : bk == 26 ? 332 : bk == 27 ? 450 : bk == 28 ? 609 : bk == 29 ? 825 : bk == 30 ? 1117 : 1513; }
constexpr int L_NEAR = 0, L_R3 = 12288, L_R2 = 15360, L_R1 = 21504, L_LAM = 39936, L_P2END = 40000;
constexpr int L_EPI = 55296, EPI_PITCH = 144;
constexpr int L_FT = 42496;
constexpr int L_QDONE = 41600;
constexpr int L_BIASL = 40000, L_RING = 41984, L_MRING = L_RING + 4 * 10240, L_WQ = L_MRING + 8192;
DEVI void p2_setup(const gf32* biasTab, const gf32* lam_p, float lambda_init, lu8* lds) {
    const int tid = otid();
    lf32* nearR = (lf32*)(lds + L_NEAR);
    float tn[6], t3[2], t2[3], t1[9];
#pragma unroll
    for (int k = 0; k < 6; ++k) { const int i = tid + k * NTHR, hb = i >> 8, u = i & 255, tix = 223 - u; tn[k] = tix < 0 ? -3e38f : biasTab[hb * 2048 + tix]; }
#pragma unroll
    for (int k = 0; k < 2; ++k) { const int i = tid + k * NTHR, hb = i / 192, kk = 159 - (i % 192); t3[k] = (i >= 4 * 192 || kk < 0 || kk > 128) ? -3e38f : biasTab[hb * 2048 + kk * 16]; }
#pragma unroll
    for (int k = 0; k < 3; ++k) { const int i = tid + k * NTHR, hb = i / 384, kk = 255 - (i % 384); t2[k] = (kk < 0 || kk > 128) ? -3e38f : biasTab[hb * 2048 + kk * 4]; }
#pragma unroll
    for (int k = 0; k < 9; ++k) { const int i = tid + k * NTHR, hb = i / 1152, kk = 639 - (i % 1152); t1[k] = (kk < 0 || kk > 128) ? -3e38f : biasTab[hb * 2048 + kk]; }
    lf32* R3 = (lf32*)(lds + L_R3); lf32* R2 = (lf32*)(lds + L_R2); lf32* R1 = (lf32*)(lds + L_R1);
#pragma unroll
    for (int k = 0; k < 6; ++k) nearR[tid + k * NTHR] = tn[k];
#pragma unroll
    for (int k = 0; k < 2; ++k) if (tid + k * NTHR < 4 * 192) R3[tid + k * NTHR] = t3[k];
#pragma unroll
    for (int k = 0; k < 3; ++k) R2[tid + k * NTHR] = t2[k];
#pragma unroll
    for (int k = 0; k < 9; ++k) R1[tid + k * NTHR] = t1[k];
    { lf32* bl = (lf32*)(lds + L_BIASL); for (int i = tid; i < 12 * 32; i += NTHR) { const int hb = i >> 5, k = i & 31; bl[i] = biasTab[hb * 2048 + (k < 16 ? k : kBucketStart[k - 16])]; } }
    if (tid >= 64 && tid < 72) ((lu32*)(lds + L_QDONE))[tid - 64] = 0u;
#pragma unroll
    for (int k = 0; k < 2; ++k) { const int i = tid + k * NTHR;
        if (i < 12 * 64) { const int hb = i >> 6, dl = i & 63, D0 = dl * 32;
            f32x4_t ft = {0.f, 0.f, 0.f, 0.f};
            if (dl >= 6) { const int blo = far_bucket(D0 - 31), bhi = far_bucket(D0 + 31);
                ft[0] = biasTab[hb * 2048 + kBucketStart[blo - 16]]; ft[1] = biasTab[hb * 2048 + kBucketStart[bhi - 16]];
                ft[2] = __int_as_float(D0 - far_start(bhi)); ft[3] = __int_as_float(blo != bhi ? 1 : 0); }
            *(LAS f32x4_t*)(lds + L_FT + i * 16) = ft; } }
    if (tid == 0) { float a1 = 0.f, a2 = 0.f; for (int i = 0; i < 32; ++i) { a1 += lam_p[i] * lam_p[32 + i]; a2 += lam_p[64 + i] * lam_p[96 + i]; }
        *(lf32*)(lds + L_LAM) = expf(a1) - expf(a2) + lambda_init; }
    __syncthreads();
}

DEVI void ph_vtrans(const gh16* vtmp, gh16* VF, lu8* lds) {
    const int tid = otid();
    LAS h16 (*tile)[72] = (LAS h16 (*)[72])lds;
    for (int it = blockIdx.x; it < 3 * 32 * 4; it += gridDim.x) {
        const int src = it >> 7, bh = (it >> 2) & 31, blk = it & 3, b = bh >> 2, hh = bh & 3;
        __syncthreads();
        h16x8 tv[8];
#pragma unroll
        for (int k = 0; k < 8; ++k) { const int idx = k * NTHR + tid, row = idx >> 3, c8 = idx & 7;
            tv[k] = *(const GAS h16x8*)(vtmp + ((size_t)b * SEQ + blk * 512 + row) * 768 + src * 256 + hh * 64 + c8 * 8); }
        __builtin_amdgcn_sched_barrier(0);
#pragma unroll
        for (int k = 0; k < 8; ++k) { const int idx = k * NTHR + tid, row = idx >> 3, c8 = idx & 7; *(LAS h16x8*)&tile[row][c8 * 8] = tv[k]; }
        __syncthreads();
        gh16* out0 = VF + (src == 0 ? 0 : (src == 1 ? 3 * FSZ : 4 * FSZ));
#pragma unroll 1
        for (int k = 0; k < 8; ++k) {
            const int fl = k * NTHR + tid, lane = fl & 63, frag = (fl >> 6) & 3, dl = lane & 31, hp = lane >> 5, db = frag >> 1, sk = frag & 1;
            {
                const int tl = fl >> 8; h16x8 o;
#pragma unroll
                for (int e = 0; e < 8; ++e) o[e] = tile[tl * 32 + 16 * sk + 8 * (e >> 2) + 4 * hp + (e & 3)][db * 32 + dl];
                *(GAS h16x8*)(out0 + ((((size_t)bh * 64 + blk * 16 + tl) * 4 + frag) * 64 + lane) * 8) = o;
            }
            if (src == 0) {
                {
                    const int r4 = fl >> 10, tl = (fl >> 8) & 3; h16x8 o;
#pragma unroll
                    for (int e = 0; e < 8; ++e) o[e] = tile[4 * (tl * 32 + 16 * sk + 8 * (e >> 2) + 4 * hp + (e & 3)) + r4][db * 32 + dl];
                    *(GAS h16x8*)(out0 + FSZ + (((((size_t)bh * 4 + r4) * 16 + blk * 4 + tl) * 4 + frag) * 64 + lane) * 8) = o;
                }
                {
                    const int r = fl >> 8; h16x8 o;
#pragma unroll
                    for (int e = 0; e < 8; ++e) o[e] = tile[16 * (16 * sk + 8 * (e >> 2) + 4 * hp + (e & 3)) + r][db * 32 + dl];
                    *(GAS h16x8*)(out0 + 2 * FSZ + (((((size_t)bh * 16 + r) * 4 + blk) * 4 + frag) * 64 + lane) * 8) = o;
                }
            }
        }
    }
}

template <bool SUBLN>
DEVI void epi_gate_store(const f32x16& R0, const f32x16& R1, float il, const gh16* gp, const gf32* sp, gh16* mp, int hot) {
    h16x4 gv[2][4]; f32x4_t sv[2][4];
#pragma unroll
    for (int db = 0; db < 2; ++db)
#pragma unroll
        for (int g = 0; g < 4; ++g) { gv[db][g] = *(const GAS h16x4*)(gp + db * 32 + 8 * g); if (SUBLN) sv[db][g] = *(const GAS f32x4_t*)(sp + db * 32 + 8 * g); }
    __builtin_amdgcn_sched_barrier(0);
#pragma unroll
    for (int db = 0; db < 2; ++db)
#pragma unroll
        for (int g = 0; g < 4; ++g) { h16x4 o;
#pragma unroll
            for (int e = 0; e < 4; ++e) { float v = (db ? R1[4 * g + e] : R0[4 * g + e]) * il * (float)gv[db][g][e]; if (SUBLN) v *= sv[db][g][e]; o[e] = (h16)v; }
            if (!hot) *(GAS h16x4*)(mp + db * 32 + 8 * g) = o; else asm volatile("" :: "v"(o));
        }
}

template <bool SUBLN>
DEVI void epi_rows(const f32x16& R0, const f32x16& R1, float il, const gh16* gate_c, const gf32* sp, gh16* mix_c, size_t tok0, int sA, int sB, const lu8* lds, int hot) {
    const int lane = otid() & 63, q = lane & 31, h = lane >> 5, wv = __builtin_amdgcn_readfirstlane(otid() >> 6);
    lu8* reg = (lu8*)lds + L_EPI + wv * (32 * EPI_PITCH);
#pragma unroll
    for (int db = 0; db < 2; ++db)
#pragma unroll
        for (int g = 0; g < 4; ++g) { h16x4 o;
#pragma unroll
            for (int e = 0; e < 4; ++e) o[e] = (h16)((db ? R1[4 * g + e] : R0[4 * g + e]) * il);
            *(LAS h16x4*)(reg + q * EPI_PITCH + (db * 32 + 8 * g + 4 * h) * 2) = o; }
    const int c = lane & 7, rl = lane >> 3;
    h16x8 gv[4]; size_t tk[4];
#pragma unroll
    for (int k = 0; k < 4; ++k) { const int r = 8 * k + rl; tk[k] = (tok0 + (size_t)((r & 15) * sA + (r >> 4) * sB)) * 1024 + 8 * c; gv[k] = *(const GAS h16x8*)(gate_c + tk[k]); }
    h16x8 gn;
    if (SUBLN) { const f32x4_t s0 = *(const GAS f32x4_t*)(sp + 8 * c), s1 = *(const GAS f32x4_t*)(sp + 8 * c + 4);
#pragma unroll
        for (int e = 0; e < 4; ++e) { gn[e] = (h16)s0[e]; gn[4 + e] = (h16)s1[e]; } }
    __builtin_amdgcn_sched_barrier(0);
#pragma unroll
    for (int k = 0; k < 4; ++k) {
        h16x8 o = *(const LAS h16x8*)(reg + (8 * k + rl) * EPI_PITCH + c * 16);
        o = o * gv[k]; if (SUBLN) o = o * gn;
        if (!hot) *(GAS h16x8*)(mix_c + tk[k]) = o; else asm volatile("" :: "v"(o));
    }
}

template <int NMAP, bool MASK>
DEVI void flashCD_item(int b, int hh, int qt, int hb, const gh16* Q, const gh16* KF, const gh16* VF, const gu32* mask, const gf32* biasTab, const lu8* lds,
                       const gf32* subln, float lambda_init, const gh16* gate, gh16* mix, int mixcol, int hot = 0) {
    constexpr int NKS = 4 / NMAP;
    const int lane = otid() & 63, q = lane & 31, h = lane >> 5;
    const size_t tokq = (size_t)b * SEQ + qt * 32 + q;
    const gh16* kp = KF + (size_t)(b * 4 + hh) * 64 * 2048 + lane * 8;
    const gh16* vp = VF + (size_t)(b * 4 + hh) * 64 * 2048 + lane * 8;
    h16x8 qf[NMAP][NKS], kf[NMAP][NKS];
#pragma unroll
    for (int mp = 0; mp < NMAP; ++mp)
#pragma unroll
        for (int ks = 0; ks < NKS; ++ks) {
            qf[mp][ks] = *(const GAS h16x8*)(Q + tokq * 256 + hh * 64 + (mp * NKS + ks) * 16 + 8 * h);
            kf[mp][ks] = *(const GAS h16x8*)(kp + (mp * NKS + ks) * 512);
        }
    f32x16 O[NMAP][2]; float m[NMAP], l[NMAP];
#pragma unroll
    for (int mp = 0; mp < NMAP; ++mp) { O[mp][0] = (f32x16){}; O[mp][1] = (f32x16){}; m[mp] = -1e30f; l[mp] = 0.f; }
    const lf32* nearR = (const lf32*)(lds + L_NEAR) + hb * 256;
    const gf32* bt = biasTab + hb * 2048;
    h16x8 vf[2][2];
    unsigned mw = 0xffffffffu, mwn = 0xffffffffu;
    if (MASK) mw = mask[tokq * 64];
    auto bias_of = [&](int jj) -> f32x16 {
        f32x16 Bv;
        const int D0 = (qt - jj) * 32;
        if (hot >= 3) { Bv = (f32x16){}; } else
        if (D0 < 192) {
            const lf32* tp = nearR + (223 - D0 - q + 4 * h);
#pragma unroll
            for (int r = 0; r < 16; ++r) Bv[r] = tp[CROW(r)];
        } else {
            const f32x4_t ft = *(const LAS f32x4_t*)(lds + L_FT + (hb * 64 + (qt - jj)) * 16);
            const float lo = ft[0], hi = ft[1];
            if (__builtin_amdgcn_readfirstlane(__float_as_int(ft[3])) == 0) {
#pragma unroll
                for (int r = 0; r < 16; ++r) Bv[r] = lo;
            } else {
                const int x = __float_as_int(ft[2]) + q - 4 * h;
#pragma unroll
                for (int r = 0; r < 16; ++r) Bv[r] = (x >= CROW(r)) ? hi : lo;
            }
        }
        return Bv;
    };
    f32x16 Bv = bias_of(0);
    for (int j = 0; j <= qt; ++j) {
#pragma unroll
        for (int db = 0; db < 2; ++db)
#pragma unroll
            for (int sk = 0; sk < 2; ++sk) vf[db][sk] = *(const GAS h16x8*)(vp + (size_t)(hot ? 0 : j) * 2048 + (db * 2 + sk) * 512);
        f32x16 S[NMAP];
#pragma unroll
        for (int mp = 0; mp < NMAP; ++mp) { S[mp] = Bv;
#pragma unroll
            for (int ks = 0; ks < NKS; ++ks) S[mp] = mfma32(kf[mp][ks], qf[mp][ks], S[mp]); }
        {
            const int jn = hot ? 0 : (j < qt ? j + 1 : j);
#pragma unroll
            for (int mp = 0; mp < NMAP; ++mp)
#pragma unroll
                for (int ks = 0; ks < NKS; ++ks) kf[mp][ks] = *(const GAS h16x8*)(kp + (size_t)jn * 2048 + (mp * NKS + ks) * 512);
            if (MASK) mwn = mask[tokq * 64 + jn];
        }
        if (MASK && hot < 3) {
#pragma unroll
            for (int r = 0; r < 16; ++r) S[0][r] = (((mw >> (4 * h)) >> CROW(r)) & 1u) ? S[0][r] : -3e38f;
        }
#pragma unroll
        for (int mp = 0; mp < NMAP; ++mp) {
            softmax_tile_h(S[mp], m[mp], l[mp], O[mp][0], O[mp][1], hot);
            const h16x8 p0 = pack8(S[mp], 0), p1 = pack8(S[mp], 1);
            if (hot < 4) {
            O[mp][0] = mfma32(vf[0][0], p0, O[mp][0]); O[mp][0] = mfma32(vf[0][1], p1, O[mp][0]);
            O[mp][1] = mfma32(vf[1][0], p0, O[mp][1]); O[mp][1] = mfma32(vf[1][1], p1, O[mp][1]);
            } else { O[mp][0][0] += (float)p0[0] + (float)p1[0]; }
        }
        mw = mwn;
        Bv = bias_of(j < qt ? j + 1 : j);
    }
    f32x16 R0, R1;
    if (NMAP == 2) {
        const float lam = *(const lf32*)(lds + L_LAM);
        const float i0 = 1.f / xh_sum(l[0]), i1 = lam / xh_sum(l[NMAP - 1]);
        R0 = O[0][0] * i0 - O[NMAP - 1][0] * i1; R1 = O[0][1] * i0 - O[NMAP - 1][1] * i1;
        float ss = 0.f;
#pragma unroll
        for (int r = 0; r < 16; ++r) ss += R0[r] * R0[r] + R1[r] * R1[r];
        ss = xh_sum(ss);
        const float rs = rsqrtf(ss * (1.f / 64.f) + EPS) * (1.f - lambda_init);
        R0 *= rs; R1 *= rs;
    } else {
        const float il = 1.f / xh_sum(l[0]);
        R0 = O[0][0] * il; R1 = O[0][1] * il;
    }
    epi_rows<NMAP == 2>(R0, R1, 1.f, gate + mixcol + hh * 64, subln, mix + mixcol + hh * 64, (size_t)b * SEQ + qt * 32, 1, 16, lds, hot);
}

template <int BR>
DEVI void flashQ2_item(int b, int hh, int pr, const gh16* Q, const gh16* KF, const gh16* KRF, const gh16* VF, const gu32* mask, const gf32* biasTab, const lu8* lds,
                       const gh16* gate, gh16* mix, int mixcol, int hb, int hot = 0) {
    constexpr int NQK = BR == 0 ? 6 : 4;
    const int lane = otid() & 63, q = lane & 31, h = lane >> 5, bh = b * 4 + hh;
    const int qt1 = 2 * pr + 1;
    size_t tokq[2]; h16x8 qf[2][NQK];
#pragma unroll
    for (int qi = 0; qi < 2; ++qi) { tokq[qi] = (size_t)b * SEQ + (2 * pr + qi) * 32 + q;
#pragma unroll
        for (int ks = 0; ks < NQK; ++ks) qf[qi][ks] = *(const GAS h16x8*)(Q + tokq[qi] * (BR == 0 ? 384 : 256) + hh * (BR == 0 ? 96 : 64) + ks * 16 + 8 * h); }
    f32x16 O[2][2]; float m[2], l[2];
#pragma unroll
    for (int qi = 0; qi < 2; ++qi) { O[qi][0] = (f32x16){}; O[qi][1] = (f32x16){}; m[qi] = -1e30f; l[qi] = 0.f; }
    const gh16* kp = KF + (size_t)bh * 64 * 2048 + lane * 8;
    const gh16* rp = KRF + (size_t)b * 64 * 1024 + lane * 8;
    const gh16* vp = VF + (size_t)bh * 64 * 2048 + lane * 8;
    const lf32* nearR = (const lf32*)(lds + L_NEAR) + hb * 256;
    const gf32* bt = biasTab + hb * 2048;
    h16x8 kf[NQK], vf[4];
#pragma unroll
    for (int ks = 0; ks < NQK; ++ks) kf[ks] = (BR == 0 && ks >= 4) ? *(const GAS h16x8*)(rp + (ks - 4) * 512) : *(const GAS h16x8*)(kp + ks * 512);
    unsigned mw[2] = {0xffffffffu, 0xffffffffu}, mwn[2] = {0xffffffffu, 0xffffffffu};
    const gu32* mrow = mask + (size_t)b * 64 * SEQ + (2 * pr) * 32 + q;
    if (BR == 1) { mw[0] = mrow[0]; mw[1] = mrow[32]; }
#pragma unroll 1
    for (int j = 0; j <= qt1; ++j) {
#pragma unroll
        for (int f = 0; f < 4; ++f) vf[f] = *(const GAS h16x8*)(vp + (size_t)(hot ? 0 : j) * 2048 + f * 512);
        f32x16 S[2];
#pragma unroll
        for (int qi = 0; qi < 2; ++qi) { S[qi] = (f32x16){};
#pragma unroll
            for (int ks = 0; ks < NQK; ++ks) S[qi] = mfma32(kf[ks], qf[qi][ks], S[qi]); }
        {
            const int jn = hot ? 0 : (j < qt1 ? j + 1 : j);
#pragma unroll
            for (int ks = 0; ks < NQK; ++ks) kf[ks] = (BR == 0 && ks >= 4) ? *(const GAS h16x8*)(rp + (size_t)jn * 1024 + (ks - 4) * 512) : *(const GAS h16x8*)(kp + (size_t)jn * 2048 + ks * 512);
            if (BR == 1) { mwn[0] = mrow[(size_t)jn * SEQ]; mwn[1] = mrow[(size_t)jn * SEQ + 32]; }
        }
#pragma unroll
        for (int qi = 0; qi < 2; ++qi) {
            const int qt = 2 * pr + qi;
            if (j <= qt) {
                const int D0 = (qt - j) * 32;
                if (hot >= 3) {} else
                if (BR == 0) {
                    if (D0 == 0) {
#pragma unroll
                        for (int r = 0; r < 16; ++r) S[qi][r] = (CROW(r) + 4 * h > q) ? -3e38f : S[qi][r];
                    }
                } else {
                    if (D0 < 192) {
                        const lf32* tp = nearR + (223 - D0 - q + 4 * h);
#pragma unroll
                        for (int r = 0; r < 16; ++r) S[qi][r] += tp[CROW(r)];
                    } else {
                        const f32x4_t ft = *(const LAS f32x4_t*)(lds + L_FT + (hb * 64 + (qt - j)) * 16);
                        const float lo = ft[0], hi = ft[1];
                        if (__builtin_amdgcn_readfirstlane(__float_as_int(ft[3])) == 0) S[qi] += lo;
                        else {
                            const int x = __float_as_int(ft[2]) + q - 4 * h;
#pragma unroll
                            for (int r = 0; r < 16; ++r) S[qi][r] += (x >= CROW(r)) ? hi : lo;
                        }
                    }
                    const unsigned mm = mw[qi] >> (4 * h);
#pragma unroll
                    for (int r = 0; r < 16; ++r) { const unsigned keepm = (unsigned)__builtin_amdgcn_sbfe((int)mm, CROW(r), 1);
                        S[qi][r] = __uint_as_float((__float_as_uint(S[qi][r]) & keepm) | (0xff61b1e6u & ~keepm)); }
                }
                softmax_tile_h(S[qi], m[qi], l[qi], O[qi][0], O[qi][1], hot);
                const h16x8 p0 = pack8(S[qi], 0), p1 = pack8(S[qi], 1);
                if (hot < 4) {
                O[qi][0] = mfma32(vf[0], p0, O[qi][0]); O[qi][0] = mfma32(vf[1], p1, O[qi][0]);
                O[qi][1] = mfma32(vf[2], p0, O[qi][1]); O[qi][1] = mfma32(vf[3], p1, O[qi][1]);
                } else { O[qi][0][0] += (float)p0[0] + (float)p1[0]; }
            }
        }
        mw[0] = mwn[0]; mw[1] = mwn[1];
    }
#pragma unroll
    for (int qi = 0; qi < 2; ++qi) {
        const float il = 1.f / xh_sum(l[qi]);
        epi_rows<false>(O[qi][0], O[qi][1], il, gate + mixcol + hh * 64, nullptr, mix + mixcol + hh * 64, (size_t)b * SEQ + (2 * pr + qi) * 32, 1, 16, lds, hot);
    }
}

template <int BR>
DEVI void flashWG_item(int b, int hh, int Qb, const gh16* Q, const gh16* KF, const gh16* KRF, const gh16* VF, const gu32* mask, lu8* lds,
                       const gf32* subln, float lambda_init, const gh16* gate, gh16* mix, int mixcol, int hb) {
    constexpr int NMAP = BR == 2 ? 2 : 1, NQK = BR == 0 ? 6 : 4, NKS = NQK / NMAP, NP = NQK + 4, TB = NP * 1024, NDMA = BR == 2 ? 1 : 2, DD = 3;
    const int tid = otid(), lane = tid & 63, q = lane & 31, h = lane >> 5, wv = __builtin_amdgcn_readfirstlane(tid >> 6);
    const int qt = 8 * Qb + wv, last = 8 * Qb + 7, bh = b * 4 + hh;
    const size_t tokq = (size_t)b * SEQ + qt * 32 + q;
    h16x8 qf[NQK];
#pragma unroll
    for (int ks = 0; ks < NQK; ++ks) qf[ks] = *(const GAS h16x8*)(Q + tokq * (BR == 0 ? 384 : 256) + hh * (BR == 0 ? 96 : 64) + ks * 16 + 8 * h);
    f32x16 O[NMAP][2]; float m[NMAP], l[NMAP];
#pragma unroll
    for (int mp = 0; mp < NMAP; ++mp) { O[mp][0] = (f32x16){}; O[mp][1] = (f32x16){}; m[mp] = -1e30f; l[mp] = 0.f; }
    asm volatile("s_waitcnt vmcnt(0)" ::: "memory");
    __syncthreads();
    lu8* ring = lds + L_RING; lu8* mring = lds + L_MRING;
    auto issue = [&](int jt) {
        const int jc = jt < last ? jt : last, slot = jt & 3;
        {
            const int pc = wv;
            const gh16* src = pc < 4 ? KF + ((size_t)bh * 64 + jc) * 2048 + pc * 512
                            : (BR == 0 && pc < 6) ? KRF + ((size_t)b * 64 + jc) * 1024 + (pc - 4) * 512
                            : VF + ((size_t)bh * 64 + jc) * 2048 + (pc - NQK) * 512;
            __builtin_amdgcn_global_load_lds((const GAS unsigned*)(src + lane * 8), (LAS unsigned*)(ring + slot * TB + pc * 1024), 16, 0, 0);
        }
        if (BR == 0) {
            const int pc = 8 + (wv & 1);
            const gh16* src = VF + ((size_t)bh * 64 + jc) * 2048 + (pc - NQK) * 512;
            __builtin_amdgcn_global_load_lds((const GAS unsigned*)(src + lane * 8), (LAS unsigned*)(ring + slot * TB + pc * 1024), 16, 0, 0);
        }
        if (BR == 1) __builtin_amdgcn_global_load_lds((const GAS unsigned*)(mask + tokq * 64 + (jc <= qt ? jc : qt)), (LAS unsigned*)(mring + (slot * 8 + wv) * 256), 4, 0, 0);
    };
#pragma unroll
    for (int jt = 0; jt < DD; ++jt) issue(jt);
    const lf32* nearR = (const lf32*)(lds + L_NEAR) + hb * 256;
    const lf32* biasL = (const lf32*)(lds + L_BIASL) + hb * 32;
    f32x16 S[NMAP], Sn[NMAP];
    asm volatile("s_waitcnt vmcnt(%0)" :: "n"((DD - 1) * NDMA) : "memory");
    __builtin_amdgcn_s_barrier();
#pragma unroll
    for (int mp = 0; mp < NMAP; ++mp) { S[mp] = (f32x16){};
#pragma unroll
        for (int ks = 0; ks < NKS; ++ks) S[mp] = mfma32(*(const LAS h16x8*)(ring + lane * 16 + (mp * NKS + ks) * 1024), qf[mp * NKS + ks], S[mp]); }
#pragma unroll 1
    for (int j = 0; j <= last; ++j) {
        asm volatile("s_waitcnt vmcnt(%0)" :: "n"((DD - 2) * NDMA) : "memory");
        __builtin_amdgcn_s_barrier();
        issue(j + DD);
        if (j <= qt) {
            const lu8* sl = ring + (j & 3) * TB + lane * 16;
            if (j + 1 <= qt) {
                const lu8* sn = ring + ((j + 1) & 3) * TB + lane * 16;
#pragma unroll
                for (int mp = 0; mp < NMAP; ++mp) { Sn[mp] = (f32x16){};
#pragma unroll
                    for (int ks = 0; ks < NKS; ++ks) Sn[mp] = mfma32(*(const LAS h16x8*)(sn + (mp * NKS + ks) * 1024), qf[mp * NKS + ks], Sn[mp]); }
            }
            h16x8 vf[4];
#pragma unroll
            for (int f = 0; f < 4; ++f) vf[f] = *(const LAS h16x8*)(sl + (NQK + f) * 1024);
            const int D0 = (qt - j) * 32;
            if (BR == 0) {
                if (D0 == 0) {
#pragma unroll
                    for (int r = 0; r < 16; ++r) S[0][r] = (CROW(r) + 4 * h > q) ? -3e38f : S[0][r];
                }
            } else if (D0 < 192) {
                const lf32* tp = nearR + (223 - D0 - q + 4 * h);
#pragma unroll
                for (int r = 0; r < 16; ++r) { const float bv = tp[CROW(r)];
#pragma unroll
                    for (int mp = 0; mp < NMAP; ++mp) S[mp][r] += bv; }
            } else {
                int blo = 23, bhi = 23;
#pragma unroll
                for (int jj = 8; jj < 16; ++jj) { blo += (D0 - 31 >= kBucketStart[jj]) ? 1 : 0; bhi += (D0 + 31 >= kBucketStart[jj]) ? 1 : 0; }
                const float lo = biasL[blo], hi = biasL[bhi];
                if (blo == bhi) {
#pragma unroll
                    for (int mp = 0; mp < NMAP; ++mp) S[mp] += lo;
                } else {
                    const int x = D0 + q - 4 * h - kBucketStart[bhi - 16];
#pragma unroll
                    for (int r = 0; r < 16; ++r) { const float bv = (x >= CROW(r)) ? hi : lo;
#pragma unroll
                        for (int mp = 0; mp < NMAP; ++mp) S[mp][r] += bv; }
                }
            }
            if (BR == 1) {
                const unsigned mw = *(const LAS unsigned*)(mring + ((j & 3) * 8 + wv) * 256 + lane * 4) >> (4 * h);
#pragma unroll
                for (int r = 0; r < 16; ++r) S[0][r] = ((mw >> CROW(r)) & 1u) ? S[0][r] : -3e38f;
            }
#pragma unroll
            for (int mp = 0; mp < NMAP; ++mp) {
                softmax_tile(S[mp], m[mp], l[mp], O[mp][0], O[mp][1]);
                const h16x8 p0 = pack8(S[mp], 0), p1 = pack8(S[mp], 1);
                O[mp][0] = mfma32(vf[0], p0, O[mp][0]); O[mp][0] = mfma32(vf[1], p1, O[mp][0]);
                O[mp][1] = mfma32(vf[2], p0, O[mp][1]); O[mp][1] = mfma32(vf[3], p1, O[mp][1]);
            }
#pragma unroll
            for (int mp = 0; mp < NMAP; ++mp) S[mp] = Sn[mp];
        }
    }
    asm volatile("s_waitcnt vmcnt(0)" ::: "memory");
    f32x16 R0, R1;
    if (NMAP == 2) {
        const float lam = *(const lf32*)(lds + L_LAM);
        const float i0 = 1.f / xh_sum(l[0]), i1 = lam / xh_sum(l[NMAP - 1]);
        R0 = O[0][0] * i0 - O[NMAP - 1][0] * i1; R1 = O[0][1] * i0 - O[NMAP - 1][1] * i1;
        float ss = 0.f;
#pragma unroll
        for (int r = 0; r < 16; ++r) ss += R0[r] * R0[r] + R1[r] * R1[r];
        ss = xh_sum(ss);
        const float rs = rsqrtf(ss * (1.f / 64.f) + EPS) * (1.f - lambda_init);
        R0 *= rs; R1 *= rs;
    } else {
        const float il = 1.f / xh_sum(l[0]);
        R0 = O[0][0] * il; R1 = O[0][1] * il;
    }
    const gh16* gp = gate + tokq * 1024 + mixcol + hh * 64 + 4 * h;
#pragma unroll
    for (int db = 0; db < 2; ++db)
#pragma unroll
        for (int g = 0; g < 4; ++g) {
            const h16x4 gv = *(const GAS h16x4*)(gp + db * 32 + 8 * g); h16x4 o;
#pragma unroll
            for (int e = 0; e < 4; ++e) { float v = (db ? R1[4 * g + e] : R0[4 * g + e]) * (float)gv[e];
                if (NMAP == 2) v *= subln[db * 32 + 8 * g + 4 * h + e];
                o[e] = (h16)v; }
            *(GAS h16x4*)(mix + mixf_off(tokq, mixcol + hh * 64 + db * 32 + 8 * g + 4 * h)) = o;
        }
}

constexpr int L_RING2 = 41984, L_MRING2 = L_RING2 + 8 * 10240, L_WQ2 = L_MRING2 + 8 * 8 * 256;
template <int BR>
DEVI void flashWG2_item(int b, int hh, int Qb, const gh16* Q, const gh16* KF, const gh16* KRF, const gh16* VF, const gu32* mask, lu8* lds,
                        const gf32* subln, float lambda_init, const gh16* gate, gh16* mix, int mixcol, int hb) {
    constexpr int NMAP = BR == 2 ? 2 : 1, NQK = BR == 0 ? 6 : 4, NKS = NQK / NMAP, NP = NQK + 4, TB = NP * 1024;
    const int tid = otid(), lane = tid & 63, q = lane & 31, h = lane >> 5, wv = __builtin_amdgcn_readfirstlane(tid >> 6);
    const int qt = 8 * Qb + wv, NS = 2 * Qb + 2, bh = b * 4 + hh;
    const size_t tokq = (size_t)b * SEQ + qt * 32 + q;
    h16x8 qf[NQK];
#pragma unroll
    for (int ks = 0; ks < NQK; ++ks) qf[ks] = *(const GAS h16x8*)(Q + tokq * (BR == 0 ? 384 : 256) + hh * (BR == 0 ? 96 : 64) + ks * 16 + 8 * h);
    f32x16 O[NMAP][2]; float m[NMAP], l[NMAP];
#pragma unroll
    for (int mp = 0; mp < NMAP; ++mp) { O[mp][0] = (f32x16){}; O[mp][1] = (f32x16){}; m[mp] = -1e30f; l[mp] = 0.f; }
    lu8* ring = lds + L_RING2; lu8* mring = lds + L_MRING2;
    auto issue = [&](int st) {
#pragma unroll
        for (int u = 0; u < (4 * NP + 7) / 8; ++u) {
            const int id = wv + 8 * u;
            if (id < 4 * NP) {
                const int ti = id / NP, pc = id % NP, jt = 4 * st + ti, slot = jt & 7;
                const gh16* src = pc < 4 ? KF + ((size_t)bh * 64 + jt) * 2048 + pc * 512
                                : (BR == 0 && pc < 6) ? KRF + ((size_t)b * 64 + jt) * 1024 + (pc - 4) * 512
                                : VF + ((size_t)bh * 64 + jt) * 2048 + (pc - NQK) * 512;
                __builtin_amdgcn_global_load_lds((const GAS unsigned*)(src + lane * 8), (LAS unsigned*)(ring + slot * TB + pc * 1024), 16, 0, 0);
            }
        }
        if (BR == 1) {
#pragma unroll
            for (int ti = 0; ti < 4; ++ti) { const int jt = 4 * st + ti;
                __builtin_amdgcn_global_load_lds((const GAS unsigned*)(mask + tokq * 64 + (jt <= qt ? jt : qt)), (LAS unsigned*)(mring + ((jt & 7) * 8 + wv) * 256), 4, 0, 0); }
        }
    };
    asm volatile("s_waitcnt vmcnt(0)" ::: "memory");
    __syncthreads();
    issue(0);
    const lf32* nearR = (const lf32*)(lds + L_NEAR) + hb * 256;
    const lf32* biasL = (const lf32*)(lds + L_BIASL) + hb * 32;
#pragma unroll 1
    for (int st = 0; st < NS; ++st) {
        asm volatile("s_waitcnt vmcnt(0)" ::: "memory");
        __builtin_amdgcn_s_barrier();
        if (st + 1 < NS) issue(st + 1);
#pragma unroll 1
        for (int j = 4 * st; j < 4 * st + 4; ++j) {
            if (j > qt) break;
            const lu8* sl = ring + (j & 7) * TB + lane * 16;
            f32x16 S[NMAP];
#pragma unroll
            for (int mp = 0; mp < NMAP; ++mp) { S[mp] = (f32x16){};
#pragma unroll
                for (int ks = 0; ks < NKS; ++ks) S[mp] = mfma32(*(const LAS h16x8*)(sl + (mp * NKS + ks) * 1024), qf[mp * NKS + ks], S[mp]); }
            h16x8 vf[4];
#pragma unroll
            for (int f = 0; f < 4; ++f) vf[f] = *(const LAS h16x8*)(sl + (NQK + f) * 1024);
            const int D0 = (qt - j) * 32;
            if (BR == 0) {
                if (D0 == 0) {
#pragma unroll
                    for (int r = 0; r < 16; ++r) S[0][r] = (CROW(r) + 4 * h > q) ? -3e38f : S[0][r];
                }
            } else if (D0 < 192) {
                const lf32* tp = nearR + (223 - D0 - q + 4 * h);
#pragma unroll
                for (int r = 0; r < 16; ++r) { const float bv = tp[CROW(r)];
#pragma unroll
                    for (int mp = 0; mp < NMAP; ++mp) S[mp][r] += bv; }
            } else {
                const int blo = far_bucket(D0 - 31), bhi = far_bucket(D0 + 31);
                const float lo = biasL[blo], hi = biasL[bhi];
                if (blo == bhi) {
#pragma unroll
                    for (int mp = 0; mp < NMAP; ++mp) S[mp] += lo;
                } else {
                    const int x = D0 + q - 4 * h - far_start(bhi);
#pragma unroll
                    for (int r = 0; r < 16; ++r) { const float bv = (x >= CROW(r)) ? hi : lo;
#pragma unroll
                        for (int mp = 0; mp < NMAP; ++mp) S[mp][r] += bv; }
                }
            }
            if (BR == 1) {
                const unsigned mw = *(const LAS unsigned*)(mring + ((j & 7) * 8 + wv) * 256 + lane * 4) >> (4 * h);
#pragma unroll
                for (int r = 0; r < 16; ++r) S[0][r] = ((mw >> CROW(r)) & 1u) ? S[0][r] : -3e38f;
            }
#pragma unroll
            for (int mp = 0; mp < NMAP; ++mp) {
                softmax_tile(S[mp], m[mp], l[mp], O[mp][0], O[mp][1]);
                const h16x8 p0 = pack8(S[mp], 0), p1 = pack8(S[mp], 1);
                O[mp][0] = mfma32(vf[0], p0, O[mp][0]); O[mp][0] = mfma32(vf[1], p1, O[mp][0]);
                O[mp][1] = mfma32(vf[2], p0, O[mp][1]); O[mp][1] = mfma32(vf[3], p1, O[mp][1]);
            }
        }
    }
    asm volatile("s_waitcnt vmcnt(0)" ::: "memory");
    f32x16 R0, R1;
    if (NMAP == 2) {
        const float lam = *(const lf32*)(lds + L_LAM);
        const float i0 = 1.f / xh_sum(l[0]), i1 = lam / xh_sum(l[NMAP - 1]);
        R0 = O[0][0] * i0 - O[NMAP - 1][0] * i1; R1 = O[0][1] * i0 - O[NMAP - 1][1] * i1;
        float ss = 0.f;
#pragma unroll
        for (int r = 0; r < 16; ++r) ss += R0[r] * R0[r] + R1[r] * R1[r];
        ss = xh_sum(ss);
        const float rs = rsqrtf(ss * (1.f / 64.f) + EPS) * (1.f - lambda_init);
        R0 *= rs; R1 *= rs;
    } else {
        const float il = 1.f / xh_sum(l[0]);
        R0 = O[0][0] * il; R1 = O[0][1] * il;
    }
    const gh16* gp = gate + tokq * 1024 + mixcol + hh * 64 + 4 * h;
#pragma unroll
    for (int db = 0; db < 2; ++db)
#pragma unroll
        for (int g = 0; g < 4; ++g) {
            const h16x4 gv = *(const GAS h16x4*)(gp + db * 32 + 8 * g); h16x4 o;
#pragma unroll
            for (int e = 0; e < 4; ++e) { float v = (db ? R1[4 * g + e] : R0[4 * g + e]) * (float)gv[e];
                if (NMAP == 2) v *= subln[db * 32 + 8 * g + 4 * h + e];
                o[e] = (h16)v; }
            *(GAS h16x4*)(mix + mixf_off(tokq, mixcol + hh * 64 + db * 32 + 8 * g + 4 * h)) = o;
        }
}


DEVI void probe_item(int ntile, int mode) {
    const int lane = otid() & 63;
    h16x8 a, bq;
#pragma unroll
    for (int e = 0; e < 8; ++e) { a[e] = (h16)(lane * 0.001f + e); bq[e] = (h16)(e * 0.01f); }
    f32x16 O0 = {}, O1 = {}; float m = -1e30f, l = 0.f;
#pragma unroll 1
    for (int j = 0; j < ntile; ++j) {
        f32x16 S = {};
#pragma unroll
        for (int ks = 0; ks < 6; ++ks) S = mfma32(a, bq, S);
        if (mode >= 1) softmax_tile(S, m, l, O0, O1);
        const h16x8 p0 = pack8(S, 0), p1 = pack8(S, 1);
        O0 = mfma32(a, p0, O0); O0 = mfma32(a, p1, O0);
        O1 = mfma32(a, p0, O1); O1 = mfma32(a, p1, O1);
    }
    asm volatile("" :: "v"(O0), "v"(O1), "v"(l));
}
DEVI void flashB_tile(const h16x8 (&qf)[4], const h16x8 (&kf)[4], const h16x8 (&vf)[4], const lf32* tp, f32x16& O0, f32x16& O1, float& m, float& l, int hot) {
    f32x16 S = {};
#pragma unroll
    for (int ks = 0; ks < 4; ++ks) S = mfma32(kf[ks], qf[ks], S);
    if (hot < 3) {
#pragma unroll
    for (int r = 0; r < 16; ++r) S[r] += tp[CROW(r)];
    }
    if (hot < 2) softmax_tile_b(S, m, l, O0, O1); else l += S[0];
    const h16x8 p0 = pack8(S, 0), p1 = pack8(S, 1);
    if (hot < 4) {
    O0 = mfma32(vf[0], p0, O0); O0 = mfma32(vf[1], p1, O0);
    O1 = mfma32(vf[2], p0, O1); O1 = mfma32(vf[3], p1, O1);
    } else { O0[0] += (float)p0[0] + (float)p1[0]; }
}
DEVI void flashB_item(int b, int hh, int rp, int qh, const gh16* Q, const gh16* KF, const gh16* VF, const lu8* lds, const gh16* gate, gh16* mix, int hot = 0) {
    const int lane = otid() & 63, q = lane & 31, h = lane >> 5, bh = b * 4 + hh;
    const int r0 = (rp & 3) + 8 * (rp >> 2), i16 = q & 15, rs = q >> 4, rq = r0 + 4 * rs;
    const size_t tokq = (size_t)b * SEQ + qh * 256 + 16 * i16 + rq;
    h16x8 qf[4];
#pragma unroll
    for (int ks = 0; ks < 4; ++ks) qf[ks] = *(const GAS h16x8*)(Q + tokq * 256 + hh * 64 + ks * 16 + 8 * h);
    f32x16 O0 = {}, O1 = {}; float m = -1e30f, l = 0.f;
    const int n3 = (qh >> 1) + 1, lo2 = qh >= 2 ? 2 * qh - 4 : 0, n2 = 2 * qh + 1 - lo2 + 1, lo1 = qh >= 1 ? 8 * qh - 4 : 0, n1 = 8 * qh + 7 - lo1 + 1;
    const int s3b = n3, s2 = 2 * n3, s1 = s2 + n2, N = s1 + n1;
    const size_t base3 = 2 * FSZ + ((size_t)bh * 16 + r0) * 4 * 2048 + lane * 8, base2 = FSZ + ((size_t)bh * 4 + (r0 & 3)) * 16 * 2048 + lane * 8, base1 = (size_t)bh * 64 * 2048 + lane * 8;
    const lf32* R3 = (const lf32*)(lds + L_R3) + hh * 192;
    const lf32* R3me = R3 + (159 - qh * 16 - i16 + 4 * h), * R3off = R3 + 160;
    const lf32* R3a = rs == 0 ? R3me : R3off, * R3b = rs == 1 ? R3me : R3off;
    const lf32* R2 = (const lf32*)(lds + L_R2) + hh * 384 + (255 - qh * 64 - 4 * i16 - (rq >> 2) + 4 * h);
    const lf32* R1 = (const lf32*)(lds + L_R1) + hh * 1152 + (639 - qh * 256 - 16 * i16 - rq + 4 * h);
    const long jA = (long)(16 - s3b) * 2048;
    const long jB = (long)(base2 + (size_t)(lo2 - s2) * 2048) - (long)(base3 + (size_t)16 * 2048 - (size_t)s3b * 2048);
    const long jC = (long)(base1 + (size_t)(lo1 - s1) * 2048) - (long)(base2 + (size_t)(lo2 - s2) * 2048);
    auto off_of = [&](int st) -> size_t {
        if (hot) return base1;
        return (size_t)((long)base3 + (long)st * 2048 + (st >= s3b ? jA : 0) + (st >= s2 ? jB : 0) + (st >= s1 ? jC : 0)); };
    const lf32* t0 = R3a; const int k0 = rs == 0 ? 32 : 0;
    const lf32* t1 = R3b - (rs == 1 ? s3b * 32 : 0); const int k1 = rs == 1 ? 32 : 0;
    const lf32* t2 = R2 + (lo2 - s2) * 32, * t3 = R1 + (lo1 - s1) * 32;
    auto tab_of = [&](int st) -> const lf32* {
        const lf32* tb = st >= s1 ? t3 : st >= s2 ? t2 : st >= s3b ? t1 : t0; const int kk = st >= s2 ? 32 : st >= s3b ? k1 : k0;
        return tb + st * kk; };
    h16x8 ka[4], va[4], kb[4], vb[4];
#define FB_LOAD(K_, V_, st_) do { const size_t o_ = off_of(st_); _Pragma("unroll") for (int f = 0; f < 4; ++f) { K_[f] = *(const GAS h16x8*)(KF + o_ + f * 512); V_[f] = *(const GAS h16x8*)(VF + o_ + f * 512); } } while (0)
    FB_LOAD(ka, va, 0);
    int st = 0;
#pragma unroll 1
    for (; st + 1 < N; st += 2) {
        FB_LOAD(kb, vb, st + 1);
        flashB_tile(qf, ka, va, tab_of(st), O0, O1, m, l, hot);
        if (st + 2 < N) FB_LOAD(ka, va, st + 2);
        flashB_tile(qf, kb, vb, tab_of(st + 1), O0, O1, m, l, hot);
    }
    if (st < N) flashB_tile(qf, ka, va, tab_of(st), O0, O1, m, l, hot);
#undef FB_LOAD
    const float il = 1.f / xh_sum(l);
    epi_rows<false>(O0, O1, il, gate + 256 + hh * 64, nullptr, mix + 256 + hh * 64, (size_t)b * SEQ + qh * 256 + r0, 16, 4, lds, hot);
}

typedef float f32x4v __attribute__((ext_vector_type(4)));
typedef unsigned u32x4v __attribute__((ext_vector_type(4)));
DEVI f32x4v mfma16(h16x8 a, h16x8 b, f32x4v c) { return __builtin_amdgcn_mfma_f32_16x16x32_f16(a, b, c, 0, 0, 0); }
constexpr int TK_KSTRIDE = 2308;
constexpr int TK_KEYS = 0, TK_MISC = 16 * TK_KSTRIDE * 4, TK_END = TK_MISC + 64;
DEVI void topk_select_half(int b, int t0, int wv, int lane, const lu32* keys, gu32* mask) {
    typedef unsigned short u16x2 __attribute__((ext_vector_type(2)));
    const int nw32 = (t0 + 16 + 31) >> 5, hl = lane & 31, hf = lane >> 5;
    unsigned k[32];
    {
        const lu32* rp = keys + (2 * wv + hf) * TK_KSTRIDE + 36 * hl;
        const bool have = hl < nw32;
#pragma unroll
        for (int i = 0; i < 8; ++i) {
            u32x4v v = {0u, 0u, 0u, 0u};
            if (have) v = *(const LAS u32x4v*)(rp + 4 * i);
#pragma unroll
            for (int r = 0; r < 4; ++r) k[4 * i + r] = v[r];
        }
    }
    u16x2 kh[16];
#pragma unroll
    for (int i = 0; i < 16; ++i) kh[i] = (u16x2){(unsigned short)(k[2 * i] >> 7), (unsigned short)(k[2 * i + 1] >> 7)};
    auto half_sum = [&](unsigned v, unsigned& lo, unsigned& hi) {
        v += (unsigned)__builtin_amdgcn_update_dpp(0, (int)v, 0x111, 0xf, 0xf, false);
        v += (unsigned)__builtin_amdgcn_update_dpp(0, (int)v, 0x112, 0xf, 0xf, false);
        v += (unsigned)__builtin_amdgcn_update_dpp(0, (int)v, 0x114, 0xf, 0xf, false);
        v += (unsigned)__builtin_amdgcn_update_dpp(0, (int)v, 0x118, 0xf, 0xf, false);
        v += (unsigned)__builtin_amdgcn_update_dpp(0, (int)v, 0x142, 0xa, 0xf, false);
        lo = (unsigned)__builtin_amdgcn_readlane((int)v, 31); hi = (unsigned)__builtin_amdgcn_readlane((int)v, 63);
    };
    const u16x2 one2 = {1, 1};
    unsigned skl = 0u;
#pragma unroll
    for (int i = 0; i < 16; ++i) skl = __builtin_amdgcn_udot2(kh[i], one2, skl, false);
    unsigned SKa, SKc; half_sum(skl, SKa, SKc);
    auto count = [&](unsigned Pa, unsigned Pc, unsigned& ca, unsigned& cc) {
        const unsigned short p1 = (unsigned short)((hf ? Pc : Pa) - 1u);
        unsigned a = 0u;
#pragma unroll
        for (int i = 0; i < 16; ++i) a = __builtin_amdgcn_udot2((u16x2){p1, p1} - kh[i], one2, a, false);
        unsigned ta, tc; half_sum(a, ta, tc);
        ca = (ta + SKa - 1024u * (Pa - 1u)) >> 16; cc = (tc + SKc - 1024u * (Pc - 1u)) >> 16;
    };
    int hb;
    {
        u16x2 mx = {0, 0};
#pragma unroll
        for (int i = 0; i < 16; ++i) mx = __builtin_elementwise_max(mx, kh[i]);
        unsigned v = (unsigned)mx[0] | (unsigned)mx[1];
        v |= (unsigned)__builtin_amdgcn_update_dpp(0, (int)v, 0x111, 0xf, 0xf, false);
        v |= (unsigned)__builtin_amdgcn_update_dpp(0, (int)v, 0x112, 0xf, 0xf, false);
        v |= (unsigned)__builtin_amdgcn_update_dpp(0, (int)v, 0x114, 0xf, 0xf, false);
        v |= (unsigned)__builtin_amdgcn_update_dpp(0, (int)v, 0x118, 0xf, 0xf, false);
        v |= (unsigned)__builtin_amdgcn_update_dpp(0, (int)v, 0x142, 0xa, 0xf, false);
        const unsigned all = (unsigned)__builtin_amdgcn_readlane((int)v, 31) | (unsigned)__builtin_amdgcn_readlane((int)v, 63) | 1u;
        hb = 31 - __builtin_clz(all); hb = hb > 14 ? 14 : hb;
    }
    unsigned T15a = 0u, T15c = 0u;
    unsigned cnta = 0xffffu, cntc = 0xffffu;
#pragma unroll 1
    for (int bit = hb; bit >= 0; --bit) { const unsigned Pa = T15a | (1u << bit), Pc = T15c | (1u << bit); unsigned ca, cc; count(Pa, Pc, ca, cc);
        if (ca >= 256u) { T15a = Pa; cnta = ca; }
        if (cc >= 256u) { T15c = Pc; cntc = cc; } }
    const unsigned T15 = hf ? T15c : T15a;
    const bool exact = cnta == 256u && cntc == 256u;
    unsigned lowa = 0u, lowc = 0u;
    if (!exact) {
    unsigned aba, abc; count(T15a + 1u, T15c + 1u, aba, abc);
    unsigned m0 = ~0u, m1 = ~0u; const unsigned TT = T15 << 7;
#pragma unroll
    for (int i = 0; i < 32; ++i) { const unsigned m = k[i] ^ TT; unsigned md; asm("v_med3_u32 %0, %1, %2, %3" : "=v"(md) : "v"(m0), "v"(m1), "v"(m)); m1 = md; m0 = m0 < m ? m0 : m; }
    const unsigned c0 = m0 < 128u ? m0 + 1u : 0u, c1 = m1 < 128u ? m1 + 1u : 0u;
    const unsigned long long f0 = __ballot(m0 < 128u), f1 = __ballot(m1 < 128u);
    const unsigned fa = (unsigned)(__builtin_popcount((unsigned)f0) + __builtin_popcount((unsigned)f1)), fc = (unsigned)(__builtin_popcount((unsigned)(f0 >> 32)) + __builtin_popcount((unsigned)(f1 >> 32)));
    if (T15a != 0u && T15c != 0u && fa == cnta - aba && fc == cntc - abc) {
#pragma unroll 1
        for (int bit = 6; bit >= 0; --bit) { const unsigned Pa = lowa | (1u << bit), Pc = lowc | (1u << bit), P = hf ? Pc : Pa;
            const unsigned lc = (c0 > P ? 1u : 0u) + (c1 > P ? 1u : 0u);
            const unsigned long long b1 = __ballot(lc & 1u), b2 = __ballot(lc >> 1);
            const unsigned ca = aba + (unsigned)__builtin_popcount((unsigned)b1) + 2u * (unsigned)__builtin_popcount((unsigned)b2);
            const unsigned cc = abc + (unsigned)__builtin_popcount((unsigned)(b1 >> 32)) + 2u * (unsigned)__builtin_popcount((unsigned)(b2 >> 32));
            if (ca >= 256u) lowa = Pa;
            if (cc >= 256u) lowc = Pc; }
    } else {
#pragma unroll 1
        for (int bit = 6; bit >= 0; --bit) { const unsigned Pa = (T15a << 7) | lowa | (1u << bit), Pc = (T15c << 7) | lowc | (1u << bit), P = hf ? Pc : Pa;
            unsigned lc = 0u;
#pragma unroll
            for (int i = 0; i < 32; ++i) lc += (k[i] >= P) ? 1u : 0u;
            unsigned ca = 0u, cc = 0u;
#pragma unroll
            for (int bp = 0; bp < 6; ++bp) { const unsigned long long mm = __ballot((lc >> bp) & 1u); ca += (unsigned)__builtin_popcount((unsigned)mm) << bp; cc += (unsigned)__builtin_popcount((unsigned)(mm >> 32)) << bp; }
            if (ca >= 256u) lowa |= (1u << bit);
            if (cc >= 256u) lowc |= (1u << bit); }
    }
    }
    const unsigned T = exact ? (T15 << 7) - 1u : ((T15 << 7) | (hf ? lowc : lowa));
    unsigned gt = 0u, eq = 0u;
#pragma unroll
    for (int i = 31; i >= 0; --i) { const unsigned kk = k[i];
        gt = __builtin_amdgcn_alignbit(gt, T - kk, 31u); eq = __builtin_amdgcn_alignbit(eq, T - 1u - kk, 31u); }
    eq &= ~gt;
    const unsigned pcg = (unsigned)__builtin_popcount(gt), pce = (unsigned)__builtin_popcount(eq);
    int tga = 0, tgc = 0, before = 0;
#pragma unroll
    for (int bp = 0; bp < 6; ++bp) {
        const unsigned long long mg = __ballot((pcg >> bp) & 1u);
        tga += __builtin_popcount((unsigned)mg) << bp; tgc += __builtin_popcount((unsigned)(mg >> 32)) << bp;
        const unsigned long long mk = __ballot((pce >> bp) & 1u);
        before += (int)__builtin_amdgcn_mbcnt_hi((unsigned)(mk >> 32), __builtin_amdgcn_mbcnt_lo(hf ? 0u : (unsigned)mk, 0u)) << bp;
    }
    const int R = 256 - (hf ? tgc : tga);
    int allow = R - before; allow = allow < 0 ? 0 : (allow > (int)pce ? (int)pce : allow);
    unsigned keep = eq;
    if (allow < (int)pce) { keep = 0u; unsigned e = eq; for (int c = 0; c < allow; ++c) { const unsigned bit = e & (0u - e); keep |= bit; e ^= bit; } }
    if (hl < nw32) mask[((size_t)b * 64 + hl) * SEQ + t0 + 2 * wv + hf] = gt | keep;
}
DEVI int topk_item(int e_self, int nitem, unsigned nxt, h16x8 (&pq)[13], int& pq_for, const gh16* idx, const gh16* KIF, gu32* mask, lu8* lds, int skip = 0) {
    const int tid = otid(), lane = tid & 63, wv = __builtin_amdgcn_readfirstlane(tid >> 6);
    const int b = e_self & 7, T16 = 127 - ((e_self & 1023) >> 3);
    const int t0 = T16 * 16;
    lu32* keys = (lu32*)(lds + TK_KEYS);
    lu32* slot = (lu32*)(lds + TK_MISC);
    auto load_pq = [&](int e) {
        const int b_ = e & 7, T_ = 127 - ((e & 1023) >> 3), nb_ = T_ + 1; const size_t tq_ = (size_t)b_ * SEQ + T_ * 16 + (lane & 15);
#pragma unroll
        for (int u = 0; u < 4; ++u) { const int kb = wv + 8 * u < nb_ ? wv + 8 * u : 0; pq[u] = *(const GAS h16x8*)(KIF + ((size_t)(b_ * 128 + kb) * 64 + lane) * 8); }
#pragma unroll
        for (int hd = 0; hd < 8; ++hd) pq[4 + hd] = *(const GAS h16x8*)(idx + tq_ * 320 + hd * 32 + 8 * (lane >> 4));
        pq[12] = *(const GAS h16x8*)(idx + tq_ * 320 + 288);
    };
    if (T16 < 16 || skip == 2) {
        if (tid == 0) *slot = nxt;
        __syncthreads();
    }
    if (T16 < 16) {
        const int sq = tid & 15, sc_ = tid >> 4;
        const unsigned tk = (unsigned)(b * 64 + 2 * sc_) * (unsigned)SEQ + (unsigned)(t0 + sq);
        unsigned ones = 0xffffffffu; asm volatile("" : "+v"(ones));
        if (sc_ < 4) { mask[tk] = ones; mask[tk + SEQ] = ones; }
        return (int)*slot;
    }
    if (skip == 2) return (int)*slot;
    if (pq_for != e_self) load_pq(e_self);
    {
        const int q = lane & 15, kq = lane >> 4;
        const size_t tokq = (size_t)b * SEQ + t0 + q;
        h16x8 qf[8], ql; float sg[8]; float P = 0.f, N = 0.f; float lin[8];
        const int nblk = T16 + 1, nblk2 = (nblk + 1) & ~1;
        h16x8 kf4[4], kn4[4];
#pragma unroll
        for (int u = 0; u < 4; ++u) kf4[u] = pq[u];
        h16x8 raw8[8]; const h16x8 cw = pq[12];
#pragma unroll
        for (int hd = 0; hd < 8; ++hd) raw8[hd] = pq[4 + hd];
#pragma unroll
        for (int e = 0; e < 8; ++e) lin[e] = 0.f;
#pragma unroll
        for (int hd = 0; hd < 8; ++hd) {
            const h16x8 raw = raw8[hd];
            const float c = (float)cw[hd] * (0.5f * 0.35355339059327373f), ac = fabsf(c);
            float nn = 0.f;
#pragma unroll
            for (int e = 0; e < 8; ++e) { const float v = (float)raw[e]; nn += v * v; lin[e] += c * v; qf[hd][e] = (h16)(ac * v); }
            nn = xh_sum(x16_sum(nn));
            const float bd = 2.f * ac * sqrtf(nn) * 12.f;
            if (c > 0.f) P += bd; else N += bd;
            sg[hd] = c >= 0.f ? 1.f : -1.f;
        }
#pragma unroll
        for (int e = 0; e < 8; ++e) ql[e] = (h16)lin[e];
        const float lo = -N, scl = 2097151.f / fmaxf(P + N, 1e-20f), off1 = 1.f - lo * scl;
#pragma unroll 1
        for (int rpS = 0; rpS < (DUP_PHASE == 7 ? 2 : 1); ++rpS)
        {
            if (rpS) {
#pragma unroll
                for (int u = 0; u < 4; ++u) { const int kb = wv + 8 * u < nblk ? wv + 8 * u : 0; kf4[u] = *(const GAS h16x8*)(KIF + ((size_t)(b * 128 + kb) * 64 + lane) * 8); }
            }
#pragma unroll 1
            for (int kb0 = wv; kb0 < nblk2; kb0 += 32) {
                if (kb0 + 32 < nblk2) {
#pragma unroll
                    for (int u = 0; u < 4; ++u) { const int kb = kb0 + 32 + 8 * u < nblk ? kb0 + 32 + 8 * u : 0; kn4[u] = *(const GAS h16x8*)(KIF + ((size_t)(b * 128 + kb) * 64 + lane) * 8); }
                }
#pragma unroll
                for (int u = 0; u < 4; ++u) {
                    const int kb = kb0 + 8 * u;
                    if (kb < nblk2) {
                        const h16x8 kf = kf4[u];
                        f32x4v sc = mfma16(kf, ql, (f32x4v){0.f, 0.f, 0.f, 0.f});
#pragma unroll
                        for (int hd = 0; hd < 8; ++hd) { const f32x4v x = mfma16(kf, qf[hd], (f32x4v){0.f, 0.f, 0.f, 0.f});
#pragma unroll
                            for (int r = 0; r < 4; ++r) sc[r] = __builtin_fmaf(__builtin_fabsf(x[r]), sg[hd], sc[r]); }
                        u32x4v kv;
#pragma unroll
                        for (int r = 0; r < 4; ++r) kv[r] = (unsigned)__builtin_amdgcn_fmed3f(__builtin_fmaf(sc[r], scl, off1), 1.f, 2097152.f);
                        if (kb >= T16) {
#pragma unroll
                            for (int r = 0; r < 4; ++r) if (16 * kb + 4 * kq + r > t0 + q) kv[r] = 0u;
                        }
                        const int k = 16 * kb + 4 * kq;
                        *(LAS u32x4v*)(keys + q * TK_KSTRIDE + k + 4 * (k >> 5)) = kv;
                    }
                }
#pragma unroll
                for (int u = 0; u < 4; ++u) kf4[u] = kn4[u];
            }
        }
    }
    if (tid == 0) *slot = nxt;
    __syncthreads();
    const int e_next = (int)*slot;
    if (e_next < nitem && 127 - ((e_next & 1023) >> 3) >= 16) { load_pq(e_next); pq_for = e_next; }
    if (skip == 1) return e_next;
    if (T16 < 64) { topk_select_half(b, t0, wv, lane, keys, mask); return e_next; }
    const int nw32 = (t0 + 16 + 31) >> 5;
    unsigned ka[32], kc[32];
    {
        const lu32* ra = keys + (2 * wv) * TK_KSTRIDE + 36 * lane, * rc = keys + (2 * wv + 1) * TK_KSTRIDE + 36 * lane;
        const bool have = lane < nw32;
#pragma unroll
        for (int i = 0; i < 8; ++i) {
            u32x4v va = {0u, 0u, 0u, 0u}, vc = {0u, 0u, 0u, 0u};
            if (have) { va = *(const LAS u32x4v*)(ra + 4 * i); vc = *(const LAS u32x4v*)(rc + 4 * i); }
#pragma unroll
            for (int r = 0; r < 4; ++r) { ka[4 * i + r] = va[r]; kc[4 * i + r] = vc[r]; }
        }
    }
    typedef unsigned short u16x2 __attribute__((ext_vector_type(2)));
    u16x2 kha[16], khc[16];
#pragma unroll
    for (int i = 0; i < 16; ++i) { kha[i] = (u16x2){(unsigned short)(ka[2 * i] >> 7), (unsigned short)(ka[2 * i + 1] >> 7)}; khc[i] = (u16x2){(unsigned short)(kc[2 * i] >> 7), (unsigned short)(kc[2 * i + 1] >> 7)}; }
    auto wave_sum2 = [&](unsigned v) -> unsigned {
        v += (unsigned)__builtin_amdgcn_update_dpp(0, (int)v, 0x111, 0xf, 0xf, false);
        v += (unsigned)__builtin_amdgcn_update_dpp(0, (int)v, 0x112, 0xf, 0xf, false);
        v += (unsigned)__builtin_amdgcn_update_dpp(0, (int)v, 0x114, 0xf, 0xf, false);
        v += (unsigned)__builtin_amdgcn_update_dpp(0, (int)v, 0x118, 0xf, 0xf, false);
        v += (unsigned)__builtin_amdgcn_update_dpp(0, (int)v, 0x142, 0xa, 0xf, false);
        v += (unsigned)__builtin_amdgcn_update_dpp(0, (int)v, 0x143, 0xc, 0xf, false);
        return (unsigned)__builtin_amdgcn_readlane((int)v, 63);
    };
    const u16x2 one2 = {1, 1};
    unsigned ska = 0u, skc = 0u;
#pragma unroll
    for (int i = 0; i < 16; ++i) { ska = __builtin_amdgcn_udot2(kha[i], one2, ska, false); skc = __builtin_amdgcn_udot2(khc[i], one2, skc, false); }
    const unsigned SKa = wave_sum2(ska), SKc = wave_sum2(skc);
    auto count2 = [&](unsigned Pa, unsigned Pc) -> unsigned {
        const unsigned short pa1 = (unsigned short)(Pa - 1u), pc1 = (unsigned short)(Pc - 1u);
        unsigned sa = 0u, sc = 0u;
#pragma unroll
        for (int i = 0; i < 16; ++i) { sa = __builtin_amdgcn_udot2((u16x2){pa1, pa1} - kha[i], one2, sa, false); sc = __builtin_amdgcn_udot2((u16x2){pc1, pc1} - khc[i], one2, sc, false); }
        const unsigned ca = (wave_sum2(sa) + SKa - 2048u * (Pa - 1u)) >> 16, cc = (wave_sum2(sc) + SKc - 2048u * (Pc - 1u)) >> 16;
        return ca | (cc << 16);
    };
    unsigned T15a = 0u, T15c = 0u;
    int hb;
    {
        u16x2 mx = {0, 0};
#pragma unroll
        for (int i = 0; i < 16; ++i) { mx = __builtin_elementwise_max(mx, kha[i]); mx = __builtin_elementwise_max(mx, khc[i]); }
        unsigned v = (unsigned)mx[0] | (unsigned)mx[1];
        v |= (unsigned)__builtin_amdgcn_update_dpp(0, (int)v, 0x111, 0xf, 0xf, false);
        v |= (unsigned)__builtin_amdgcn_update_dpp(0, (int)v, 0x112, 0xf, 0xf, false);
        v |= (unsigned)__builtin_amdgcn_update_dpp(0, (int)v, 0x114, 0xf, 0xf, false);
        v |= (unsigned)__builtin_amdgcn_update_dpp(0, (int)v, 0x118, 0xf, 0xf, false);
        v |= (unsigned)__builtin_amdgcn_update_dpp(0, (int)v, 0x142, 0xa, 0xf, false);
        v |= (unsigned)__builtin_amdgcn_update_dpp(0, (int)v, 0x143, 0xc, 0xf, false);
        const unsigned all = (unsigned)__builtin_amdgcn_readlane((int)v, 63) | 1u;
        hb = 31 - __builtin_clz(all); hb = hb > 14 ? 14 : hb;
    }
    unsigned cnta = 0xffffu, cntc = 0xffffu;
#pragma unroll 1
    for (int bit = hb; bit >= 0; --bit) { const unsigned Pa = T15a | (1u << bit), Pc = T15c | (1u << bit); const unsigned c = count2(Pa, Pc);
        if ((c & 0xffffu) >= 256u) { T15a = Pa; cnta = c & 0xffffu; }
        if ((c >> 16) >= 256u) { T15c = Pc; cntc = c >> 16; } }
    const bool exa = cnta == 256u, exc = cntc == 256u;
    unsigned cab = 0u;
    if (!(exa && exc)) cab = count2(T15a + 1u, T15c + 1u);
    unsigned Tq[2];
#pragma unroll
    for (int qq = 0; qq < 2; ++qq) {
        const unsigned T15 = qq ? T15c : T15a; const int above = (int)(qq ? (cab >> 16) : (cab & 0xffffu));
        if (qq ? exc : exa) { Tq[qq] = (T15 << 7) - 1u; continue; }
        unsigned m0 = ~0u, m1 = ~0u; const unsigned TT = T15 << 7;
#pragma unroll
        for (int i = 0; i < 32; ++i) { const unsigned m = (qq ? kc[i] : ka[i]) ^ TT; unsigned md; asm("v_med3_u32 %0, %1, %2, %3" : "=v"(md) : "v"(m0), "v"(m1), "v"(m)); m1 = md; m0 = m0 < m ? m0 : m; }
        const unsigned c0 = m0 < 128u ? m0 + 1u : 0u, c1 = m1 < 128u ? m1 + 1u : 0u;
        const int found = __builtin_popcountll(__ballot(m0 < 128u)) + __builtin_popcountll(__ballot(m1 < 128u));
        const int bucket = (int)(qq ? cntc : cnta) - above;
        unsigned low = 0u;
        if (T15 != 0u && found == bucket) {
#pragma unroll 1
            for (int bit = 6; bit >= 0; --bit) { const unsigned P = low | (1u << bit);
                const unsigned lc = (c0 > P ? 1u : 0u) + (c1 > P ? 1u : 0u);
                const int c = above + __builtin_popcountll(__ballot(lc & 1u)) + 2 * __builtin_popcountll(__ballot(lc >> 1));
                if (c >= 256) low = P; }
        } else {
#pragma unroll 1
            for (int bit = 6; bit >= 0; --bit) { const unsigned P = (T15 << 7) | low | (1u << bit);
                unsigned lc = 0u;
#pragma unroll
                for (int i = 0; i < 32; ++i) lc += ((qq ? kc[i] : ka[i]) >= P) ? 1u : 0u;
                int c = 0;
#pragma unroll
                for (int bp = 0; bp < 6; ++bp) c += __builtin_popcountll(__ballot((lc >> bp) & 1u)) << bp;
                if (c >= 256) low |= (1u << bit); }
        }
        Tq[qq] = (T15 << 7) | low;
    }
    const unsigned Ta = Tq[0], Tc = Tq[1];
    unsigned mword[2];
#pragma unroll
    for (int qq = 0; qq < 2; ++qq) {
        const unsigned T = qq ? Tc : Ta;
        unsigned gt = 0u, eq = 0u;
#pragma unroll
        for (int i = 31; i >= 0; --i) { const unsigned k = qq ? kc[i] : ka[i];
            gt = __builtin_amdgcn_alignbit(gt, T - k, 31u); eq = __builtin_amdgcn_alignbit(eq, T - 1u - k, 31u); }
        eq &= ~gt;
        const unsigned pcg = (unsigned)__builtin_popcount(gt), pce = (unsigned)__builtin_popcount(eq);
        int totg = 0, before = 0;
#pragma unroll
        for (int bp = 0; bp < 6; ++bp) {
            totg += __builtin_popcountll(__ballot((pcg >> bp) & 1u)) << bp;
            const unsigned long long mk = __ballot((pce >> bp) & 1u);
            before += (int)__builtin_amdgcn_mbcnt_hi((unsigned)(mk >> 32), __builtin_amdgcn_mbcnt_lo((unsigned)mk, 0u)) << bp;
        }
        const int R = 256 - totg;
        int allow = R - before; allow = allow < 0 ? 0 : (allow > pce ? pce : allow);
        unsigned keep = eq;
        if (allow < pce) { keep = 0u; unsigned e = eq; for (int c = 0; c < allow; ++c) { const unsigned bit = e & (0u - e); keep |= bit; e ^= bit; } }
        mword[qq] = gt | keep;
    }
    typedef unsigned u32x2m __attribute__((ext_vector_type(2)));
    if (lane < nw32) *(GAS u32x2m*)(mask + ((size_t)b * 64 + lane) * SEQ + t0 + 2 * wv) = (u32x2m){mword[0], mword[1]};
    return e_next;
}
DEVI void ph_topk(const gh16* idx, const gh16* KIF, gu32* mask, gu32* ctr, lu8* lds, int nrep) {
    lu32* slot = (lu32*)(lds + TK_MISC);
    const bool lead = otid() == 0;
    __syncthreads();
    if (lead) *slot = __hip_atomic_fetch_add(ctr, 1u, __ATOMIC_RELAXED, __HIP_MEMORY_SCOPE_AGENT);
    __syncthreads();
    int e = (int)*slot;
    h16x8 pq[13]; int pq_for = -1;
#pragma unroll
    for (int i = 0; i < 13; ++i) pq[i] = (h16x8){};
    const int nitem = 1024 * nrep;
#pragma unroll 1
    while (e < nitem) {
        __syncthreads();
        unsigned nxt = 0u;
        if (lead) nxt = __hip_atomic_fetch_add(ctr, 1u, __ATOMIC_RELAXED, __HIP_MEMORY_SCOPE_AGENT);
        e = topk_item(e, nitem, nxt, pq, pq_for, idx, KIF, mask, lds, (DUP_PHASE >= 30 && e >= 1024) ? DUP_PHASE - 29 : 0);
    }
}

DEVI void ph_out(const gh16* mix, const gh16* WoT, const gf32* __restrict__ gpost, const gf32* h_in, gf32* h_out, gh16* h16o, gf32* rstd_next, bool write_next, lu8* lds) {
    const int tid = otid(), lane = tid & 63, q = lane & 31, h = lane >> 5, wv = __builtin_amdgcn_readfirstlane(tid >> 6);
    lf32* red = (lf32*)lds;
    for (int u = blockIdx.x; u < NT / 64; u += gridDim.x) {
        f32x16 acc[4][2];
#pragma unroll
        for (int rb = 0; rb < 4; ++rb) { acc[rb][0] = (f32x16){}; acc[rb][1] = (f32x16){}; }
        const gh16* apu = WoT + (size_t)(wv * 4) * 64 * 512;
        const gh16* bpu = mix + (size_t)(u * 2) * 64 * 512;
        const unsigned lo8 = lane * 8;
#define ap(off) (apu + (off) + lo8)
#define bp(off) (bpu + (off) + lo8)
        h16x8 a0[4], b0[2], a1[4], b1[2], a2[4], b2[2];
#define P3_LOAD(A, B, ks_) do { const int ko_ = ((ks_) < 64 ? (ks_) : 63) * 512; _Pragma("unroll") for (int rb = 0; rb < 4; ++rb) A[rb] = *(const GAS h16x8*)(ap(rb * 64 * 512 + ko_)); \
        _Pragma("unroll") for (int tb = 0; tb < 2; ++tb) B[tb] = *(const GAS h16x8*)(bp(tb * 64 * 512 + ko_)); } while (0)
#define P3_MMA(A, B) do { _Pragma("unroll") for (int rb = 0; rb < 4; ++rb) _Pragma("unroll") for (int tb = 0; tb < 2; ++tb) acc[rb][tb] = mfma32(A[rb], B[tb], acc[rb][tb]); } while (0)
        P3_LOAD(a0, b0, 0); P3_LOAD(a1, b1, 1);
#pragma unroll 1
        for (int ks = 0; ks < 63; ks += 3) {
            P3_LOAD(a2, b2, ks + 2); __builtin_amdgcn_sched_barrier(0); P3_MMA(a0, b0); __builtin_amdgcn_sched_barrier(0);
            P3_LOAD(a0, b0, ks + 3); __builtin_amdgcn_sched_barrier(0); P3_MMA(a1, b1); __builtin_amdgcn_sched_barrier(0);
            P3_LOAD(a1, b1, ks + 4); __builtin_amdgcn_sched_barrier(0); P3_MMA(a2, b2); __builtin_amdgcn_sched_barrier(0);
        }
        P3_MMA(a0, b0);
#undef P3_LOAD
#undef P3_MMA
#undef ap
#undef bp
        int qe = q, he = h; asm volatile("" : "+v"(qe), "+v"(he));
        __syncthreads();
#pragma unroll
        for (int tb = 0; tb < 2; ++tb) {
            float ss = 0.f;
#pragma unroll
            for (int rb = 0; rb < 4; ++rb)
#pragma unroll
                for (int r = 0; r < 16; ++r) ss += acc[rb][tb][r] * acc[rb][tb][r];
            ss = xh_sum(ss);
            if (he == 0) red[wv * 64 + tb * 32 + qe] = ss;
        }
        __syncthreads();
        float ssn[2] = {0.f, 0.f};
#pragma unroll
        for (int tb = 0; tb < 2; ++tb) {
            float tot = 0.f;
#pragma unroll
            for (int w2 = 0; w2 < 8; ++w2) tot += red[w2 * 64 + tb * 32 + qe];
            const float rs = rsqrtf(tot * (1.f / DM) + EPS);
            const size_t rowoff = (size_t)(u * 64 + tb * 32 + qe) * DM;
#pragma unroll
            for (int rb = 0; rb < 4; ++rb)
#pragma unroll
                for (int g = 0; g < 4; ++g) {
                    const int n = wv * 128 + rb * 32 + 8 * g + 4 * he;
                    const f32x4_t hv = *(const GAS f32x4_t*)(h_in + rowoff + n), gv = *(const GAS f32x4_t*)(gpost + n);
                    f32x4_t o;
                    o[0] = hv[0] + acc[rb][tb][4 * g + 0] * rs * gv[0]; o[1] = hv[1] + acc[rb][tb][4 * g + 1] * rs * gv[1];
                    o[2] = hv[2] + acc[rb][tb][4 * g + 2] * rs * gv[2]; o[3] = hv[3] + acc[rb][tb][4 * g + 3] * rs * gv[3];
                    *(GAS f32x4_t*)(h_out + rowoff + n) = o;
                    if (write_next) { h16x4 oh; oh[0] = (h16)o[0]; oh[1] = (h16)o[1]; oh[2] = (h16)o[2]; oh[3] = (h16)o[3]; *(GAS h16x4*)(h16o + rowoff + n) = oh;
                        ssn[tb] += o[0] * o[0] + o[1] * o[1] + o[2] * o[2] + o[3] * o[3]; }
                }
        }
        if (write_next) {
#pragma unroll
            for (int tb = 0; tb < 2; ++tb) { const float v = xh_sum(ssn[tb]); if (he == 0) red[512 + wv * 64 + tb * 32 + qe] = v; }
            __syncthreads();
            if (tid < 64) { float tot = 0.f;
#pragma unroll
                for (int w2 = 0; w2 < 8; ++w2) tot += red[512 + w2 * 64 + tid];
                rstd_next[u * 64 + tid] = rsqrtf(tot * (1.f / DM) + EPS); }
        }
    }
}

DEVI void mla_item(int it, const gh16* cA, const gh16* WuqT, const gh16* WukvT, const gf32* cosT, const gf32* sinT, gh16* qA, gh16* KFA, gh16* KRF, gh16* VFA) {
    const int lane = otid() & 63, q = lane & 31, h = lane >> 5;
    const size_t tok = (size_t)it * 32 + q; const int b = it >> 6, j = it & 63, s = j * 32 + q;
    const float qs = 0.10206207261596577f * LOG2E;
    {
        h16x8 cf[12]; float ss = 0.f;
#pragma unroll
        for (int ks = 0; ks < 12; ++ks) { cf[ks] = *(const GAS h16x8*)(cA + tok * 384 + ks * 16 + 8 * h);
#pragma unroll
            for (int e = 0; e < 8; ++e) { const float v = (float)cf[ks][e]; ss += v * v; } }
        const float rs = rsqrtf(xh_sum(ss) * (1.f / 192.f) + EPS) * qs;
        float rc[8], rsn[8];
#pragma unroll
        for (int r = 0; r < 8; ++r) { const int i = CROW(r) + 4 * h; rc[r] = cosT[s * 16 + i]; rsn[r] = sinT[s * 16 + i]; }
        h16x8 wf[12], wn[12];
#pragma unroll
        for (int ks = 0; ks < 12; ++ks) wf[ks] = *(const GAS h16x8*)(WuqT + lane * 8 + ks * 512);
#pragma unroll 1
        for (int nb = 0; nb < 12; ++nb) {
            f32x16 acc = {};
            if (nb + 1 < 12) {
                const gh16* wp = WuqT + (size_t)(nb + 1) * 12 * 512 + lane * 8;
#pragma unroll
                for (int ks = 0; ks < 12; ++ks) wn[ks] = *(const GAS h16x8*)(wp + ks * 512);
            }
            __builtin_amdgcn_sched_barrier(0);
#pragma unroll
            for (int ks = 0; ks < 12; ++ks) acc = mfma32(wf[ks], cf[ks], acc);
#pragma unroll
            for (int ks = 0; ks < 12; ++ks) wf[ks] = wn[ks];
            acc *= rs;
            const int hh = nb / 3, part = nb % 3;
            if (part == 2) {
#pragma unroll
                for (int r = 0; r < 8; ++r) { const float c = rc[r], sn = rsn[r], x1 = acc[r], x2 = acc[r + 8];
                    acc[r] = x1 * c - x2 * sn; acc[r + 8] = x1 * sn + x2 * c; }
            }
            gh16* op = qA + tok * 384 + hh * 96 + part * 32 + 4 * h;
#pragma unroll
            for (int g = 0; g < 4; ++g) { h16x4 o; o[0] = (h16)acc[4 * g]; o[1] = (h16)acc[4 * g + 1]; o[2] = (h16)acc[4 * g + 2]; o[3] = (h16)acc[4 * g + 3]; *(GAS h16x4*)(op + 8 * g) = o; }
        }
    }
    {
        h16x8 cf[8]; float ss = 0.f;
#pragma unroll
        for (int ks = 0; ks < 8; ++ks) { cf[ks] = *(const GAS h16x8*)(cA + tok * 384 + 192 + ks * 16 + 8 * h);
#pragma unroll
            for (int e = 0; e < 8; ++e) { const float v = (float)cf[ks][e]; ss += v * v; } }
        const float rs = rsqrtf(xh_sum(ss) * (1.f / 128.f) + EPS);
#pragma unroll
        for (int ks = 0; ks < 8; ++ks)
#pragma unroll
            for (int e = 0; e < 8; ++e) cf[ks][e] = (h16)((float)cf[ks][e] * rs);
        h16x8 wf[8], wn[8];
#pragma unroll
        for (int ks = 0; ks < 8; ++ks) wf[ks] = *(const GAS h16x8*)(WukvT + lane * 8 + ks * 512);
#pragma unroll 1
        for (int nb = 0; nb < 16; ++nb) {
            const int hh = nb >> 2, sub = nb & 3, bh = b * 4 + hh;
            f32x16 acc = {};
            if (nb + 1 < 16) {
                const gh16* wp = WukvT + (size_t)(nb + 1) * 8 * 512 + lane * 8;
#pragma unroll
                for (int ks = 0; ks < 8; ++ks) wn[ks] = *(const GAS h16x8*)(wp + ks * 512);
            }
            __builtin_amdgcn_sched_barrier(0);
            if (sub < 2) {
#pragma unroll
                for (int ks = 0; ks < 8; ++ks) acc = mfma32(wf[ks], cf[ks], acc);
#pragma unroll
                for (int g = 0; g < 4; ++g) { h16x4 o; o[0] = (h16)acc[4 * g]; o[1] = (h16)acc[4 * g + 1]; o[2] = (h16)acc[4 * g + 2]; o[3] = (h16)acc[4 * g + 3];
                    *(GAS h16x4*)(KFA + ((((size_t)bh * 64 + j) * 4 + 2 * sub + (g >> 1)) * 64 + q + 32 * (g & 1)) * 8 + 4 * h) = o; }
            } else {
#pragma unroll
                for (int ks = 0; ks < 8; ++ks) acc = mfma32(cf[ks], wf[ks], acc);
#pragma unroll
                for (int sk = 0; sk < 2; ++sk) { h16x8 o;
#pragma unroll
                    for (int e = 0; e < 8; ++e) o[e] = (h16)acc[8 * sk + e];
                    *(GAS h16x8*)(VFA + ((((size_t)bh * 64 + j) * 4 + (sub - 2) * 2 + sk) * 64 + lane) * 8) = o; }
            }
#pragma unroll
            for (int ks = 0; ks < 8; ++ks) wf[ks] = wn[ks];
        }
    }
    {
        const h16x8 a = *(const GAS h16x8*)(cA + tok * 384 + 320 + 8 * h), c2 = *(const GAS h16x8*)(cA + tok * 384 + 336 + 8 * h);
        h16x8 o1, o2;
#pragma unroll
        for (int e = 0; e < 8; ++e) { const int i = 8 * h + e; const float c = cosT[s * 16 + i], sn = sinT[s * 16 + i], x1 = (float)a[e], x2 = (float)c2[e];
            o1[e] = (h16)(x1 * c - x2 * sn); o2[e] = (h16)(x1 * sn + x2 * c); }
        *(GAS h16x8*)(KRF + (((size_t)b * 64 + j) * 2 + 0) * 512 + lane * 8) = o1; *(GAS h16x8*)(KRF + (((size_t)b * 64 + j) * 2 + 1) * 512 + lane * 8) = o2;
    }
}
DEVI void ph_small_weights(const gf32* w_uq, const gf32* qn, const gf32* w_ukv, const gf32* kvn, gh16* WuqF, gh16* WukvF) {
    const int gt = blockIdx.x * NTHR + otid(), nthr = gridDim.x * NTHR;
    for (int i = gt; i < 2 * 12 * 12 * 64; i += nthr) { const int lane = i & 63, ks = (i >> 6) % 12, nb = (i / (64 * 12)) % 12, l = i / (64 * 144);
        h16x8 o;
#pragma unroll
        for (int e = 0; e < 8; ++e) { const int k = 16 * ks + 8 * (lane >> 5) + e; o[e] = (h16)(w_uq[(size_t)l * 192 * 384 + k * 384 + nb * 32 + (lane & 31)] * qn[l * 192 + k]); }
        *(GAS h16x8*)(WuqF + (size_t)i * 8) = o; }
    for (int i = gt; i < 2 * 16 * 8 * 64; i += nthr) { const int lane = i & 63, ks = (i >> 6) & 7, nb = (i >> 9) & 15, l = i >> 13;
        h16x8 o;
#pragma unroll
        for (int e = 0; e < 8; ++e) { const int k = 16 * ks + 8 * (lane >> 5) + e; o[e] = (h16)(w_ukv[(size_t)l * 128 * 512 + k * 512 + nb * 32 + (lane & 31)] * kvn[l * 128 + k]); }
        *(GAS h16x8*)(WukvF + (size_t)i * 8) = o; }
}

constexpr int LDS_BYTES = 160 * 1024;
struct Params { const float* in[12]; float* out; unsigned char* ws; };

DEVI void ph_tables(const gf32* __restrict__ rel_bias, gf32* biasTab, gf32* cosT, gf32* sinT) {
    for (int i = blockIdx.x * NTHR + threadIdx.x; i < 2048 * 16; i += gridDim.x * NTHR) {
        if (i < 12 * 2048) { int hh = i / 2048, n = i % 2048; biasTab[i] = rel_bias[t5_bucket(n) * 12 + hh] * LOG2E; }
        int pos = i / 16, j = i % 16;
        float inv = (float)pow(10000.0, -(double)(2 * j) / 32.0);
        float ang = (float)pos * inv;
        cosT[i] = (float)cos((double)ang); sinT[i] = (float)sin((double)ang);
    }
}

extern __shared__ __attribute__((aligned(16))) unsigned char smem[];
constexpr int LDS_BAR_OFF = 160 * 1024 - 16;

#define REP(k) for (int rep_ = 0; rep_ < ((DUP_PHASE == (k)) ? 2 : 1); ++rep_)
DEVI gu8* ows(unsigned char* w0) { gu8* w = (gu8*)w0; asm volatile("" : "+s"(w)); return w; }
#define WSP(T, off) ((GAS T*)(w + (off)))
#define OSP(T, off) ((GAS T*)(wo + (off)))
DEVI const gf32* gin_(int k) { const __attribute__((address_space(4))) char* ka = (const __attribute__((address_space(4))) char*)__builtin_amdgcn_kernarg_segment_ptr(); int off = k * 8; asm volatile("" : "+s"(off));
    return (const gf32*)*(const float* const __attribute__((address_space(4)))*)(ka + off); }
#define GIN(k) gin_(k)

DEVI lu8* olds() { lu8* l = (lu8*)smem; asm volatile("" : "+s"(l)); return l; }
__global__ void __launch_bounds__(NTHR, 2) mega(Params p) {
    if (threadIdx.x == 0) *(uint4*)(smem + LDS_BAR_OFF) = make_uint4(0u, 0u, 0u, 0u);
    __syncthreads();
    XcdBarrier bar = xcd_barrier_post((unsigned*)(p.ws + OFF_CTL), (volatile LAS unsigned*)(smem + LDS_BAR_OFF));
    const int nw = gridDim.x * NWAVE;

    {
        gu8* w = ows(p.ws);
        ph_transposes(GIN(1), GIN(3), GIN(2), WSP(h16, OFF_WINT), WSP(h16, OFF_WOUTT), olds(), 0, 0, 1024);
        ph_rowstat_cvt(GIN(0), WSP(float, OFF_SSQH), WSP(h16, OFF_H16));
    }
    if (otid() == 0 && bar.st[0] == 0u) { unsigned nloc, nx; xcd_barrier_complete(bar.bar, bar.x, nloc, nx); bar.st[0] = nloc; bar.st[1] = nx; }
    sb_arrive(bar, SB_P0);
    {
        gu8* w = ows(p.ws);
        ph_tables(GIN(11), WSP(float, OFF_BIAS), WSP(float, OFF_COS), WSP(float, OFF_SIN));
        ph_small_weights(GIN(7), GIN(5), GIN(8), GIN(6), WSP(h16, OFF_WUQT), WSP(h16, OFF_WUKVT));
        ph_transposes(GIN(1), GIN(3), GIN(2), WSP(h16, OFF_WINT), WSP(h16, OFF_WOUTT), olds(), 0, 1024, 1280);
    }
    sb_wait_wg(bar, SB_P0);
    for (int layer = 0; layer < 2; ++layer) {
        const float lambda_init = layer == 0 ? 0.2f : 0.35550906759f;
        REP(2) {
            if (rep_) xcd_barrier(bar);
            gu8* w = ows(p.ws);
            pg8::Gemm g{(const pg8::bf16_t*)(p.ws + OFF_H16), (const pg8::bf16_t*)(p.ws + OFF_WINT) + (size_t)layer * MYC * DM, NT, MYC, DM};
            int bid_ = (int)blockIdx.x; asm volatile("" : "+s"(bid_));
            for (int g_ = (bid_ >> 3) & 7; g_ > 0; --g_) __builtin_amdgcn_s_sleep(80);
            pg8::EarlyOrder S; S.init(NT, MYC, (int)gridDim.x, bid_);
            S.layer = layer;
            EpiRoute E{w, WSP(float, OFF_SSQH)};
            pg8::gemm_phase<EpiRoute, pg8::EarlyOrder, true, true>(olds(), g, S, E);
        }
        if (gridDim.x == 256) sb_wait_wg(bar, SB_E(layer)); else xcd_barrier(bar);
        REP(3) {
            gu8* w = ows(p.ws); gu8* wo = ows((unsigned char*)p.out);
            for (int it = ogw(); it < NT / 32; it += nw) mla_item(it, WSP(h16, OFF_CA), WSP(h16, OFF_WUQT) + (size_t)layer * 384 * 192, WSP(h16, OFF_WUKVT) + (size_t)layer * 512 * 128, WSP(float, OFF_COS), WSP(float, OFF_SIN), OSP(h16, OUT_QA), OSP(h16, OUT_KFA), OSP(h16, OUT_KRF), OSP(h16, OUT_VFA));
        }
        REP(3) {
            gu8* w = ows(p.ws);
            ph_vtrans(WSP(h16, OFF_VTMP), WSP(h16, OFF_VF), olds());
        }
        sb_arrive(bar, SB_WORDS(layer, 0));
        {
            gu8* w = ows(p.ws);
            ph_topk(WSP(h16, OFF_IDX), WSP(h16, OFF_KIF), WSP(unsigned, OFF_MASK), WSP(unsigned, OFF_CTL) + 3600 + 16 * (40 + layer), olds(), (DUP_PHASE == 4 || DUP_PHASE >= 30) ? 2 : 1);
        }
        {
            gu8* w = ows(p.ws);
            p2_setup(WSP(float, OFF_BIAS), GIN(9) + layer * 128, lambda_init, olds());
        }
        sb_arrive(bar, SB_WORDS(layer, 1));
        sb_wait_wg(bar, SB_WORDS(layer, 0));
        bool yok = false;
        for (int rep_ = 0; rep_ < ((DUP_PHASE == 5 || DUP_PHASE >= 10) ? 2 : 1); ++rep_) {
            if (rep_) xcd_barrier(bar);
            const int hot_ = (DUP_PHASE >= 10 && rep_) ? DUP_PHASE - 9 : 0;
            gu8* w = ows(p.ws); gu8* wo = ows((unsigned char*)p.out);
            if (rep_) p2_setup(WSP(float, OFF_BIAS), GIN(9) + layer * 128, lambda_init, olds());
            if (DUP_PHASE >= 20 && rep_) { probe_item(130, DUP_PHASE - 20); continue; }
            const int xcc = (int)(xb_xcc_id() & 7u);
            bool first = false;
            for (int dq = 0; dq < 8; ++dq) {
                const int bq_ = (xcc + dq) & 7;
                gu32* ctr = WSP(unsigned, OFF_CTL) + 3600 + 16 * (bq_ + 8 * layer + 16 * rep_);
                for (;;) {
                    int bq, e;
                    if (first) { first = false; int bi = (int)blockIdx.x; asm volatile("" : "+s"(bi)); bq = bi & 7; e = (bi >> 3) * 8 + __builtin_amdgcn_readfirstlane(otid() >> 6); }
                    else {
                        volatile lu32* qd = (volatile lu32*)(olds() + L_QDONE) + bq_;
                        if (*qd) break;
                        e = wq_next(ctr);
                        if (e >= 768) { *qd = 1u; break; }
                        bq = bq_;
                    }
                    if (e >= 512) { const int e2 = e - 512, hh = (e2 >> 3) & 3, qhB = 7 - (e2 >> 5);
                        flashB_item(bq, hh, e2 & 7, qhB, WSP(h16, OFF_QB), WSP(h16, OFF_KFB), WSP(h16, OFF_VF), olds(), WSP(h16, OFF_GATE), WSP(h16, OFF_MIX), hot_); }
                    else if (e >= 384) { const int e2 = e - 384, hh = e2 >> 5, pr = 31 - (e2 & 31);
                        flashQ2_item<0>(bq, hh, pr, OSP(h16, OUT_QA), OSP(h16, OUT_KFA), OSP(h16, OUT_KRF), OSP(h16, OUT_VFA), nullptr, WSP(float, OFF_BIAS), olds(), WSP(h16, OFF_GATE), WSP(h16, OFF_MIX), 0, 0, hot_); }
                    else if (e >= 256) { const int e2 = e - 256, hh = e2 >> 5, pr = 31 - (e2 & 31);
                        if (!yok) { sb_wait_wave(bar, SB_WORDS(layer, 1)); yok = true; }
                        flashQ2_item<1>(bq, hh, pr, WSP(h16, OFF_QC), WSP(h16, OFF_KFC), nullptr, WSP(h16, OFF_VF) + 3 * FSZ, WSP(unsigned, OFF_MASK), WSP(float, OFF_BIAS), olds(), WSP(h16, OFF_GATE), WSP(h16, OFF_MIX), 512, 4 + hh, hot_); }
                    else { const int hh = e >> 6, lvl = 63 - (e & 63);
                        flashCD_item<2, false>(bq, hh, lvl, 8 + hh, WSP(h16, OFF_QD), WSP(h16, OFF_KFD), WSP(h16, OFF_VF) + 4 * FSZ, nullptr, WSP(float, OFF_BIAS), olds(),
                                               GIN(10) + layer * 64, lambda_init, WSP(h16, OFF_GATE), WSP(h16, OFF_MIX), 768, hot_); }
                }
            }
        }
        if (layer == 0) {
            sb_arrive(bar, SB_WORDS(0, 2));
            { gu8* w = ows(p.ws); ph_transposes(GIN(1), GIN(3), GIN(2), WSP(h16, OFF_WINT), WSP(h16, OFF_WOUTT), olds(), 1, 0, 1024); }
            sb_wait_wg(bar, SB_WORDS(0, 2));
        } else { sb_arrive(bar, SB_WORDS(1, 2)); sb_wait_wg(bar, SB_WORDS(1, 2)); }
        for (int rep_ = 0; rep_ < ((DUP_PHASE == 6 && layer == 0) ? 2 : 1); ++rep_) {
            if (rep_) xcd_barrier(bar);
            gu8* w = ows(p.ws);
int bid_ = (int)blockIdx.x; asm volatile("" : "+s"(bid_));
            pg8::Gemm g{(const pg8::bf16_t*)(p.ws + OFF_MIX), (const pg8::bf16_t*)(p.ws + OFF_WOUTT) + (size_t)layer * DM * DM, NT, DM, DM};
            pg8::StaticOrder S; S.init(NT, DM, (int)gridDim.x, bid_);
            EpiOut E{(gf32*)p.out, WSP(h16, OFF_H16), GIN(4) + layer * DM, layer == 0 ? WSP(float, OFF_SSQY) : WSP(float, OFF_QB), WSP(float, OFF_SSQH), WSP(unsigned, OFF_CTL) + 4608 + 16 * 64 * layer, layer == 0};
            pg8::gemm_phase<EpiOut, pg8::StaticOrder, false, true>(olds(), g, S, E);
        }
        if (layer == 0) {
            sb_arrive(bar, SB_G3);
            { gu8* w = ows(p.ws); ph_transposes(GIN(1), GIN(3), GIN(2), WSP(h16, OFF_WINT), WSP(h16, OFF_WOUTT), olds(), 1, 1024, 1280); }
            sb_wait_wg(bar, SB_G3);
        }
    }
}

extern "C" void kernel_launch(void* const* d_in, const int* in_sizes, int n_in, void* d_out, int out_size, void* d_ws, size_t ws_size, hipStream_t stream) {
    static int grid = 0;
    if (grid == 0) {
        int dev = 0, cus = 0, per_cu = 0;
        (void)hipGetDevice(&dev);
        (void)hipDeviceGetAttribute(&cus, hipDeviceAttributeMultiprocessorCount, dev);
        (void)hipFuncSetAttribute((const void*)mega, hipFuncAttributeMaxDynamicSharedMemorySize, LDS_BYTES);
        (void)hipOccupancyMaxActiveBlocksPerMultiprocessor(&per_cu, (const void*)mega, NTHR, LDS_BYTES);
        (void)hipGetLastError();
        grid = (cus > 0 && cus < 256) ? cus : 256;
    }
    (void)hipMemsetAsync((char*)d_ws + OFF_CTL, 0, 40960, stream);
    Params p{};
    for (int i = 0; i < 12; ++i) p.in[i] = (const float*)d_in[i];
    p.out = (float*)d_out; p.ws = (unsigned char*)d_ws;
    hipLaunchKernelGGL(mega, dim3(grid), dim3(NTHR), LDS_BYTES, stream, p);
}
```
